# Optimizing an MI355X kernel written in HIP

```python
import jax, jax.numpy as jnp
from jax import lax
import numpy as np

D_MODEL = 1024
BATCH = 2
SEQ = 8192
DEPTH = 2

CTX_LEN = 256
GRID_W = 64
Q_BLOCK = 128
ROPE_THETA = 10000.0
NORM_EPS = 1e-6
N_MIXERS = 2

GQA_HEADS = 16
GQA_KV_HEADS = 4
GQA_GROUP = GQA_HEADS // GQA_KV_HEADS
GQA_HEAD_DIM = 64
GQA_WIDTH = GQA_HEADS * GQA_HEAD_DIM
GQA_KV_WIDTH = GQA_KV_HEADS * GQA_HEAD_DIM
GQA_IN_COLS = 2 * GQA_KV_WIDTH + 2 * GQA_WIDTH
GQA_CTX_COLS = 2 * GQA_KV_WIDTH

MLA_HEADS = 16
MLA_NOPE = 64
MLA_ROPE = 32
MLA_V = 64
MLA_Q_LORA = 384
MLA_KV_LORA = 256
MLA_WIDTH = MLA_HEADS * MLA_V
MLA_CTX_COLS = MLA_KV_LORA + MLA_ROPE
MLA_IN_COLS = MLA_CTX_COLS + MLA_Q_LORA + MLA_WIDTH

kernel_name = "hybrid_gqa_mla_diffusion_block"


def rms_norm(x, w):
    xf = x.astype(jnp.float32)
    y = xf * lax.rsqrt(jnp.mean(xf * xf, axis=-1, keepdims=True) + NORM_EPS)
    return (y * w.astype(jnp.float32)).astype(x.dtype)


def adaln_params(cond, w_mod, b_mod):
    mod = jax.nn.silu(cond) @ w_mod + b_mod
    return jnp.split(mod, 3, axis=-1)


def axial_rope_tables(n_tokens, rot_dim, dtype):
    rows = n_tokens // GRID_W
    row = jnp.repeat(jnp.arange(rows, dtype=jnp.float32), GRID_W)
    col = jnp.tile(jnp.arange(GRID_W, dtype=jnp.float32), rows)
    axis_dim = rot_dim // 2
    inv_freq = jnp.power(ROPE_THETA, -jnp.arange(0, axis_dim, 2, dtype=jnp.float32) / axis_dim)
    ang_r = row[:, None] * inv_freq[None, :]
    ang_c = col[:, None] * inv_freq[None, :]
    ang = jnp.concatenate([ang_r, ang_r, ang_c, ang_c], axis=-1)
    return jnp.cos(ang).astype(dtype), jnp.sin(ang).astype(dtype)


def apply_axial_rope(x, cos, sin):
    shape = (1, cos.shape[0]) + (1,) * (x.ndim - 3) + (cos.shape[-1],)
    cos = cos.reshape(shape)
    sin = sin.reshape(shape)
    x1, x2, x3, x4 = jnp.split(x, 4, axis=-1)
    rotated = jnp.concatenate([-x2, x1, -x4, x3], axis=-1)
    return x * cos + rotated * sin


def sweep_query_blocks(fn, *q_arrays):
    B, S = q_arrays[0].shape[:2]
    nb = S // Q_BLOCK
    blocks = tuple(jnp.moveaxis(a.reshape((B, nb, Q_BLOCK) + a.shape[2:]), 1, 0) for a in q_arrays)
    out = lax.map(lambda blk: fn(*blk), blocks)
    out = jnp.moveaxis(out, 0, 1)
    return out.reshape((B, S) + out.shape[3:])


def gqa_attend(q, k, v):
    s = jnp.einsum('bqhgd,bkhd->bhgqk', q, k).astype(jnp.float32) * (GQA_HEAD_DIM ** -0.5)
    p = jax.nn.softmax(s, axis=-1).astype(v.dtype)
    return jnp.einsum('bhgqk,bkhd->bqhgd', p, v)


def mla_attend(q_nope, q_rope, k_nope, k_rope, v):
    s = (jnp.einsum('bqhd,bkhd->bhqk', q_nope, k_nope)
         + jnp.einsum('bqhr,bkr->bhqk', q_rope, k_rope)).astype(jnp.float32) * ((MLA_NOPE + MLA_ROPE) ** -0.5)
    p = jax.nn.softmax(s, axis=-1).astype(v.dtype)
    return jnp.einsum('bhqk,bkhd->bqhd', p, v)


def gqa_mixer(h, hc, p, cos, sin, with_ctx_out):
    B, S, _ = h.shape
    L = hc.shape[1]
    cuts = [GQA_KV_WIDTH, 2 * GQA_KV_WIDTH, 2 * GQA_KV_WIDTH + GQA_WIDTH]
    k, v, q, g = jnp.split(h @ p["w_in"], cuts, axis=-1)
    q = apply_axial_rope(rms_norm(q.reshape(B, S, GQA_KV_HEADS, GQA_GROUP, GQA_HEAD_DIM), p["q_norm"]), cos, sin)
    k = apply_axial_rope(rms_norm(k.reshape(B, S, GQA_KV_HEADS, GQA_HEAD_DIM), p["k_norm"]), cos, sin)
    v = v.reshape(B, S, GQA_KV_HEADS, GQA_HEAD_DIM)
    w_ctx = p["w_in"] if with_ctx_out else p["w_in"][:, :GQA_CTX_COLS]
    proj_c = hc @ w_ctx
    kc = rms_norm(proj_c[..., :GQA_KV_WIDTH].reshape(B, L, GQA_KV_HEADS, GQA_HEAD_DIM), p["k_norm"])
    vc = proj_c[..., GQA_KV_WIDTH:GQA_CTX_COLS].reshape(B, L, GQA_KV_HEADS, GQA_HEAD_DIM)
    k_all = jnp.concatenate([kc, k], axis=1)
    v_all = jnp.concatenate([vc, v], axis=1)
    o = sweep_query_blocks(lambda qb: gqa_attend(qb, k_all, v_all), q).reshape(B, S, GQA_WIDTH)
    y = (o * jax.nn.silu(g)) @ p["w_out"]
    yc = None
    if with_ctx_out:
        qc = rms_norm(proj_c[..., GQA_CTX_COLS:GQA_CTX_COLS + GQA_WIDTH]
                      .reshape(B, L, GQA_KV_HEADS, GQA_GROUP, GQA_HEAD_DIM), p["q_norm"])
        gc = proj_c[..., GQA_CTX_COLS + GQA_WIDTH:]
        oc = gqa_attend(qc, kc, vc).reshape(B, L, GQA_WIDTH)
        yc = (oc * jax.nn.silu(gc)) @ p["w_out"]
    return y, yc


def mla_mixer(h, hc, p, cos, sin, with_ctx_out):
    B, S, _ = h.shape
    L = hc.shape[1]

    def kv_heads(kv_a, k_r, n):
        kv = (rms_norm(kv_a, p["kv_a_norm"]) @ p["w_kv_b"]).reshape(B, n, MLA_HEADS, MLA_NOPE + MLA_V)
        k_nope, v = jnp.split(kv, [MLA_NOPE], axis=-1)
        return rms_norm(k_nope, p["k_nope_norm"]), rms_norm(k_r, p["k_rope_norm"]), v

    def q_heads(q_a, n):
        q = (rms_norm(q_a, p["q_a_norm"]) @ p["w_q_b"]).reshape(B, n, MLA_HEADS, MLA_NOPE + MLA_ROPE)
        q = rms_norm(q, p["q_norm"])
        return jnp.split(q, [MLA_NOPE], axis=-1)

    cuts = [MLA_KV_LORA, MLA_CTX_COLS, MLA_CTX_COLS + MLA_Q_LORA]
    kv_a, k_r, q_a, g = jnp.split(h @ p["w_in"], cuts, axis=-1)
    k_nope, k_rope, v = kv_heads(kv_a, k_r, S)
    k_rope = apply_axial_rope(k_rope, cos, sin)
    q_nope, q_rope = q_heads(q_a, S)
    q_rope = apply_axial_rope(q_rope, cos, sin)
    w_ctx = p["w_in"] if with_ctx_out else p["w_in"][:, :MLA_CTX_COLS]
    proj_c = hc @ w_ctx
    kc_nope, kc_rope, vc = kv_heads(proj_c[..., :MLA_KV_LORA], proj_c[..., MLA_KV_LORA:MLA_CTX_COLS], L)
    kn_all = jnp.concatenate([kc_nope, k_nope], axis=1)
    kr_all = jnp.concatenate([kc_rope, k_rope], axis=1)
    v_all = jnp.concatenate([vc, v], axis=1)
    o = sweep_query_blocks(lambda qn, qr: mla_attend(qn, qr, kn_all, kr_all, v_all), q_nope, q_rope)
    y = (o.reshape(B, S, MLA_WIDTH) * jax.nn.silu(g)) @ p["w_out"]
    yc = None
    if with_ctx_out:
        qc_nope, qc_rope = q_heads(proj_c[..., MLA_CTX_COLS:MLA_CTX_COLS + MLA_Q_LORA], L)
        gc = proj_c[..., MLA_CTX_COLS + MLA_Q_LORA:]
        oc = mla_attend(qc_nope, qc_rope, kc_nope, kc_rope, vc).reshape(B, L, MLA_WIDTH)
        yc = (oc * jax.nn.silu(gc)) @ p["w_out"]
    return y, yc


def hybrid_layer(x, ctx, c, c_ctx, w_mod, b_mod, norm_w, mixer, mixer_params, cos, sin, with_ctx_out):
    shift, scale, gate = adaln_params(c, w_mod, b_mod)
    shift_c, scale_c, gate_c = adaln_params(c_ctx, w_mod, b_mod)
    h = rms_norm(x, norm_w) * (1.0 + scale[:, None, :]) + shift[:, None, :]
    hc = rms_norm(ctx, norm_w) * (1.0 + scale_c) + shift_c
    y, yc = mixer(h, hc, mixer_params, cos, sin, with_ctx_out)
    x = x + gate[:, None, :] * y
    if with_ctx_out:
        ctx = ctx + gate_c * yc
    return x, ctx


def _normal(key, shape, scale):
    return jax.random.normal(key, shape, dtype=jnp.float32) * scale


def _gain(key, n):
    return 1.0 + 0.01 * jax.random.normal(key, (n,), dtype=jnp.float32)


def setup_inputs(seed: int = 0) -> dict:
    key = jax.random.key(seed)
    ks = jax.random.split(key, 24)
    D = D_MODEL
    return {
        "x": _normal(ks[0], (BATCH, SEQ, D), 1.0),
        "c": _normal(ks[1], (BATCH, D), 1.0),
        "ctx": _normal(ks[2], (BATCH, CTX_LEN, D), 1.0),
        "c_ctx": _normal(ks[3], (D,), 1.0),
        "l0_w_mod": _normal(ks[4], (D, 3 * D), 0.5 * D ** -0.5),
        "l0_b_mod": _normal(ks[5], (3 * D,), 0.01),
        "l0_norm": _gain(ks[6], D),
        "l0_w_in": _normal(ks[7], (D, GQA_IN_COLS), D ** -0.5),
        "l0_q_norm": _gain(ks[8], GQA_HEAD_DIM),
        "l0_k_norm": _gain(ks[9], GQA_HEAD_DIM),
        "l0_w_out": _normal(ks[10], (GQA_WIDTH, D), GQA_WIDTH ** -0.5),
        "l1_w_mod": _normal(ks[11], (D, 3 * D), 0.5 * D ** -0.5),
        "l1_b_mod": _normal(ks[12], (3 * D,), 0.01),
        "l1_norm": _gain(ks[13], D),
        "l1_w_in": _normal(ks[14], (D, MLA_IN_COLS), D ** -0.5),
        "l1_kv_a_norm": _gain(ks[15], MLA_KV_LORA),
        "l1_w_kv_b": _normal(ks[16], (MLA_KV_LORA, MLA_HEADS * (MLA_NOPE + MLA_V)), MLA_KV_LORA ** -0.5),
        "l1_q_a_norm": _gain(ks[17], MLA_Q_LORA),
        "l1_w_q_b": _normal(ks[18], (MLA_Q_LORA, MLA_HEADS * (MLA_NOPE + MLA_ROPE)), MLA_Q_LORA ** -0.5),
        "l1_q_norm": _gain(ks[19], MLA_NOPE + MLA_ROPE),
        "l1_k_nope_norm": _gain(ks[20], MLA_NOPE),
        "l1_k_rope_norm": _gain(ks[21], MLA_ROPE),
        "l1_w_out": _normal(ks[22], (MLA_WIDTH, D), MLA_WIDTH ** -0.5),
    }


def reference(x, c, ctx, c_ctx,
              l0_w_mod, l0_b_mod, l0_norm, l0_w_in, l0_q_norm, l0_k_norm, l0_w_out,
              l1_w_mod, l1_b_mod, l1_norm, l1_w_in, l1_kv_a_norm, l1_w_kv_b, l1_q_a_norm, l1_w_q_b,
              l1_q_norm, l1_k_nope_norm, l1_k_rope_norm, l1_w_out):
    n_tokens = x.shape[1]
    cos_a, sin_a = axial_rope_tables(n_tokens, GQA_HEAD_DIM, x.dtype)
    cos_b, sin_b = axial_rope_tables(n_tokens, MLA_ROPE, x.dtype)
    gqa_params = {"w_in": l0_w_in, "q_norm": l0_q_norm, "k_norm": l0_k_norm, "w_out": l0_w_out}
    mla_params = {"w_in": l1_w_in, "kv_a_norm": l1_kv_a_norm, "w_kv_b": l1_w_kv_b,
                  "q_a_norm": l1_q_a_norm, "w_q_b": l1_w_q_b, "q_norm": l1_q_norm,
                  "k_nope_norm": l1_k_nope_norm, "k_rope_norm": l1_k_rope_norm, "w_out": l1_w_out}
    layers = [
        (l0_w_mod, l0_b_mod, l0_norm, gqa_mixer, gqa_params, cos_a, sin_a),
        (l1_w_mod, l1_b_mod, l1_norm, mla_mixer, mla_params, cos_b, sin_b),
    ]
    for i in range(DEPTH):
        w_mod, b_mod, norm_w, mixer, params, cos, sin = layers[i]
        x, ctx = hybrid_layer(x, ctx, c, c_ctx, w_mod, b_mod, norm_w, mixer, params, cos, sin,
                              with_ctx_out=(i < DEPTH - 1))
    return x
```

```cpp
#include <hip/hip_runtime.h>
#include <hip/hip_bf16.h>
#include <cstdio>
#include <cstdint>

#define DEVI __device__ __forceinline__
#define LAS __attribute__((address_space(3)))
#define GAS __attribute__((address_space(1)))

constexpr int NB = 2, SEQ = 8192, DM = 1024, CTXL = 256, TK = SEQ + CTXL;
constexpr int ML = NB * SEQ, MC = NB * CTXL, MT = ML + MC;
constexpr int GRIDW = 64;
constexpr float EPS = 1e-6f;
constexpr float LOG2E = 1.4426950408889634f;
constexpr int N_IN0 = 2560, N_IN1 = 1696, N_IN1P = 1792;
constexpr float C2_GQA = 0.125f * LOG2E;
constexpr float C2_MLA = 0.10206207261596575f * LOG2E;

typedef unsigned short bf16_t;
typedef short bf16x8 __attribute__((ext_vector_type(8)));
typedef short s16x4 __attribute__((ext_vector_type(4)));
typedef float f32x4 __attribute__((ext_vector_type(4)));
typedef float f32x2 __attribute__((ext_vector_type(2)));
typedef float f32x16 __attribute__((ext_vector_type(16)));
typedef unsigned u32x4 __attribute__((ext_vector_type(4)));
typedef unsigned u32x2 __attribute__((ext_vector_type(2)));

DEVI float bf2f(bf16_t v) { return __uint_as_float((unsigned)v << 16); }
DEVI unsigned f2bf(float f) { unsigned u = __float_as_uint(f); return (u + 0x7fffu + ((u >> 16) & 1u)) >> 16; }
DEVI unsigned pk2(float lo, float hi) { return f2bf(lo) | (f2bf(hi) << 16); }
DEVI float wave_sum(float v) {
#pragma unroll
    for (int o = 1; o < 64; o <<= 1) v += __shfl_xor(v, o);
    return v;
}
DEVI float silu_f(float v) { return v / (1.f + __expf(-v)); }
namespace pg8 {
#define PG8_LAS __attribute__((address_space(3)))
typedef unsigned short bf16_t;
typedef short bf16x8 __attribute__((ext_vector_type(8)));
typedef float f32x4 __attribute__((ext_vector_type(4)));
typedef unsigned u32x4 __attribute__((ext_vector_type(4)));
constexpr int BM = 256, BK = 64, HALF = 128, HTB = HALF * BK * 2  , STAGE_BYTES = 8 * HTB, NXCD = 8, WGM = 8;

__host__ __device__ __forceinline__ int lds_byte(int r, int c) { const int st = (r >> 4) * 2 + (c >> 5), rr = r & 15, cc = c & 31, ob = rr * 64 + cc * 2; return st * 1024 + (ob ^ (((ob >> 9) & 1) << 5)); }
__host__ __device__ __forceinline__ void stage_rc(int b, int& R, int& C) { const int st = b / 1024, sb = b % 1024, swz = sb ^ (((sb >> 9) & 1) << 5); R = (st >> 1) * 16 + swz / 64; C = (st & 1) * 32 + (swz % 64) / 2; }
__host__ __device__ __forceinline__ int perm32(int rho) { const int n = rho >> 4, i = rho & 15; return 8 * (i >> 2) + 4 * n + (i & 3); }

struct Unit { int pm, pn; };
struct Gemm { const bf16_t* A; const bf16_t* Bt; int M, N, K; };

struct StaticOrder {
    int nM, nN, nwg, G, c;
    __host__ __device__ void init(int M, int N, int G_, int c_) { nM = M / BM; nN = N / BM; nwg = nM * nN; G = G_; c = c_; }
    __host__ __device__ bool next(int i, Unit& u) const {
        const long L = (long)i * G + c; if (L >= nwg) return false;
        int wgid = (int)L; { const int q = nwg / NXCD, r = nwg % NXCD, xcd = wgid % NXCD, off = wgid / NXCD; wgid = (xcd < r ? xcd * (q + 1) : r * (q + 1) + (xcd - r) * q) + off; }
        const int nig = WGM * nN, gid = wgid / nig, fm = gid * WGM, gsz = (nM - fm) < WGM ? (nM - fm) : WGM;
        u.pm = fm + ((wgid % nig) % gsz); u.pn = (wgid % nig) / gsz; return true;
    }
    __device__ __forceinline__ void a_ready(const Unit&) const {}
    __device__ __forceinline__ void done(const Unit&) const {}
};


struct ROrder {
    int pm0, nM, nN, nwg, G, c;
    __host__ __device__ void init(int pm0_, int npm, int N, int G_, int c_) { pm0 = pm0_; nM = npm; nN = N / BM; nwg = nM * nN; G = G_; c = c_; }
    __host__ __device__ bool next(int i, Unit& u) const {
        const long L = (long)i * G + c; if (L >= nwg) return false;
        int wgid = (int)L; { const int q = nwg / NXCD, r = nwg % NXCD, xcd = wgid % NXCD, off = wgid / NXCD; wgid = (xcd < r ? xcd * (q + 1) : r * (q + 1) + (xcd - r) * q) + off; }
        const int nig = WGM * nN, gid = wgid / nig, fm = gid * WGM, gsz = (nM - fm) < WGM ? (nM - fm) : WGM;
        u.pm = pm0 + fm + ((wgid % nig) % gsz); u.pn = (wgid % nig) / gsz; return true;
    }
    __device__ __forceinline__ void a_ready(const Unit&) const {}
    __device__ __forceinline__ void done(const Unit&) const {}
};

struct EpiF32 {
    static constexpr bool PERM = true, AFTER_DRAIN = false;
    float* O; int ldc; int pmbase;
    __device__ __forceinline__ void operator()(const f32x4 (&acc)[2][2][4][2], const Unit& u, int wr, int wc, int fr, int fq) const {
        const int row0 = (u.pm - pmbase) * BM + wr * 64 + fr, col0 = u.pn * BM + wc * 32 + 8 * fq;
#pragma unroll
        for (int ai = 0; ai < 2; ++ai)
#pragma unroll
            for (int m = 0; m < 4; ++m) { float* rowp = O + (size_t)(row0 + ai * HALF + m * 16) * ldc + col0;
#pragma unroll
                for (int bj = 0; bj < 2; ++bj) { *(f32x4*)(rowp + bj * HALF) = acc[ai][bj][m][0]; *(f32x4*)(rowp + bj * HALF + 4) = acc[ai][bj][m][1]; } }
    }
};
template <class Epi, class Sched, bool ALIGN_EPI = false, bool SP2 = false>
__device__ __forceinline__ void gemm_phase(PG8_LAS unsigned char* lds, const Gemm g, const Sched& S, const Epi& E) {
    const int tid = threadIdx.x, wid = __builtin_amdgcn_readfirstlane(tid >> 6), lane = tid & 63, wr = wid >> 2, wc = wid & 3, fr = lane & 15, fq = lane >> 4;
    const int K = g.K, nt = K / BK;
    unsigned voffA[2], voffB[2];
#pragma unroll
    for (int i = 0; i < 2; ++i) { int R, C; stage_rc(tid * 16 + i * 8192, R, C); const int Rb = Epi::PERM ? ((R & ~31) + perm32(R & 31)) : R;
        voffA[i] = (unsigned)(R * K + C) * 2u; voffB[i] = (unsigned)(Rb * K + C) * 2u; }
    const size_t kstep = (size_t)(BK * 2);
    const size_t hstep = (size_t)HALF * K * 2;
    const size_t tstep = 2 * hstep;
    const unsigned ldsw = (unsigned)wid * 1024u;
    const int aoff = lds_byte(wr * 64 + fr, fq * 8), boff = lds_byte(wc * 32 + fr, fq * 8);
#define PG8_SA(b, h) (((b) * 2 + (h)) * HTB)
#define PG8_SB(b, h) ((4 + (b) * 2 + (h)) * HTB)
#define PG8_STAGE(bufoff, gbase, voff) do { _Pragma("unroll") for (int _i = 0; _i < 2; ++_i) \
        __builtin_amdgcn_global_load_lds((const unsigned*)((const char*)(gbase) + (voff)[_i]), (PG8_LAS unsigned*)(lds + (bufoff) + ldsw + _i * 8192), 16, 0, 0); } while (0)
#define PG8_LDA(dst, b, h) do { _Pragma("unroll") for (int m = 0; m < 4; ++m) _Pragma("unroll") for (int k = 0; k < 2; ++k) dst[m][k] = *(const PG8_LAS bf16x8*)(lds + PG8_SA(b, h) + aoff + m * 2048 + k * 1024); } while (0)
#define PG8_LDB(dst, b, h) do { _Pragma("unroll") for (int n = 0; n < 2; ++n) _Pragma("unroll") for (int k = 0; k < 2; ++k) dst[n][k] = *(const PG8_LAS bf16x8*)(lds + PG8_SB(b, h) + boff + n * 2048 + k * 1024); } while (0)
#define PG8_MMA(ai, bj, At, Bt) do { __builtin_amdgcn_s_setprio(1); _Pragma("unroll") for (int m = 0; m < 4; ++m) _Pragma("unroll") for (int n = 0; n < 2; ++n) _Pragma("unroll") for (int k = 0; k < 2; ++k) \
        acc[ai][bj][m][n] = __builtin_amdgcn_mfma_f32_16x16x32_bf16(Bt[n][k], At[m][k], acc[ai][bj][m][n], 0, 0, 0); __builtin_amdgcn_s_setprio(0); } while (0)
#define PG8_WAIT_V(n) asm volatile("s_waitcnt vmcnt(" #n ")" ::: "memory")
#define PG8_WAIT_L(n) asm volatile("s_waitcnt lgkmcnt(" #n ")" ::: "memory")
#define PG8_BAR __builtin_amdgcn_s_barrier()
#define PG8_SCHED __builtin_amdgcn_sched_barrier(0)
    Unit cur, nxt; int ui = 0;
    if (!S.next(0, cur)) return;
    f32x4 acc[2][2][4][2];
#pragma unroll
    for (int a = 0; a < 2; ++a)
#pragma unroll
        for (int b = 0; b < 2; ++b)
#pragma unroll
            for (int m = 0; m < 4; ++m)
#pragma unroll
                for (int n = 0; n < 2; ++n) acc[a][b][m][n] = (f32x4){0.f, 0.f, 0.f, 0.f};
    bf16x8 At[4][2], B0[2][2], B1[2][2];
    const char* cA = (const char*)g.A + (size_t)cur.pm * tstep; const char* cB = (const char*)g.Bt + (size_t)cur.pn * tstep;
    S.a_ready(cur);
    if constexpr (SP2) {
        PG8_STAGE(PG8_SB(0, 0), cB, voffB); PG8_STAGE(PG8_SB(0, 1), cB + hstep, voffB); PG8_STAGE(PG8_SA(0, 0), cA, voffA); PG8_STAGE(PG8_SA(0, 1), cA + hstep, voffA);
        if (wr == 1) PG8_BAR;
        PG8_WAIT_V(2); PG8_BAR;
        PG8_STAGE(PG8_SB(1, 0), cB + kstep, voffB); PG8_STAGE(PG8_SA(1, 0), cA + kstep, voffA); PG8_STAGE(PG8_SB(1, 1), cB + hstep + kstep, voffB);
        PG8_WAIT_V(6); PG8_BAR;
    } else {
        PG8_STAGE(PG8_SB(0, 0), cB, voffB); PG8_STAGE(PG8_SA(0, 0), cA, voffA); PG8_STAGE(PG8_SB(0, 1), cB + hstep, voffB); PG8_STAGE(PG8_SA(0, 1), cA + hstep, voffA);
        if (wr == 1) PG8_BAR;
        PG8_WAIT_V(4); PG8_BAR;
        PG8_STAGE(PG8_SB(1, 0), cB + kstep, voffB); PG8_STAGE(PG8_SA(1, 0), cA + kstep, voffA); PG8_STAGE(PG8_SB(1, 1), cB + hstep + kstep, voffB);
        PG8_WAIT_V(6); PG8_BAR;
    }
    for (;;) {
        const bool has_next = S.next(ui + 1, nxt);
        const char* nA = has_next ? (const char*)g.A + (size_t)nxt.pm * tstep : cA; const char* nB = has_next ? (const char*)g.Bt + (size_t)nxt.pn * tstep : cB;
        for (int t = 0; t < nt; t += 2) {
            const bool last = (t == nt - 2);
            const char* a1 = cA + (size_t)(t + 1) * kstep;
            const char* a2 = last ? nA : cA + (size_t)(t + 2) * kstep; const char* b2 = last ? nB : cB + (size_t)(t + 2) * kstep;
            const char* a3 = a2 + kstep; const char* b3 = b2 + kstep;
            if (last && has_next) S.a_ready(nxt);
            if constexpr (SP2) {
            PG8_LDB(B0, 0, 0); PG8_LDB(B1, 0, 1); PG8_SCHED; PG8_LDA(At, 0, 0); PG8_STAGE(PG8_SA(1, 1), a1 + hstep, voffA);
            PG8_WAIT_V(8); PG8_WAIT_L(0); PG8_BAR; PG8_MMA(0, 0, At, B0); PG8_MMA(0, 1, At, B1); PG8_BAR; PG8_SCHED;
            PG8_LDA(At, 0, 1); PG8_STAGE(PG8_SB(0, 0), b2, voffB); PG8_STAGE(PG8_SB(0, 1), b2 + hstep, voffB); PG8_STAGE(PG8_SA(0, 0), a2, voffA);
            PG8_WAIT_V(8); PG8_WAIT_L(0); PG8_BAR; PG8_MMA(1, 0, At, B0); PG8_MMA(1, 1, At, B1); PG8_BAR; PG8_SCHED;
            PG8_LDB(B0, 1, 0); PG8_LDB(B1, 1, 1); PG8_SCHED; PG8_LDA(At, 1, 0); PG8_STAGE(PG8_SA(0, 1), a2 + hstep, voffA);
            PG8_WAIT_V(8); PG8_WAIT_L(0); PG8_BAR; PG8_MMA(0, 0, At, B0); PG8_MMA(0, 1, At, B1); PG8_BAR; PG8_SCHED;
            PG8_LDA(At, 1, 1); PG8_STAGE(PG8_SB(1, 0), b3, voffB); PG8_STAGE(PG8_SB(1, 1), b3 + hstep, voffB); PG8_STAGE(PG8_SA(1, 0), a3, voffA);
            PG8_WAIT_V(8); PG8_WAIT_L(0); PG8_BAR; PG8_MMA(1, 0, At, B0); PG8_MMA(1, 1, At, B1); PG8_BAR; PG8_SCHED;
            } else {
            PG8_LDB(B0, 0, 0); PG8_SCHED; PG8_LDA(At, 0, 0); PG8_STAGE(PG8_SA(1, 1), a1 + hstep, voffA);
            PG8_WAIT_L(8); PG8_BAR; PG8_WAIT_L(0); PG8_MMA(0, 0, At, B0); PG8_BAR; PG8_SCHED;
            PG8_LDB(B1, 0, 1); PG8_STAGE(PG8_SB(0, 0), b2, voffB);
            PG8_BAR; PG8_WAIT_L(0); PG8_MMA(0, 1, At, B1); PG8_BAR;
            PG8_LDA(At, 0, 1); PG8_STAGE(PG8_SA(0, 0), a2, voffA);
            PG8_BAR; PG8_WAIT_L(0); PG8_MMA(1, 0, At, B0); PG8_BAR; PG8_SCHED;
            PG8_STAGE(PG8_SB(0, 1), b2 + hstep, voffB);
            PG8_WAIT_V(6); PG8_BAR; PG8_MMA(1, 1, At, B1); PG8_BAR;
            PG8_LDB(B0, 1, 0); PG8_SCHED; PG8_LDA(At, 1, 0); PG8_STAGE(PG8_SA(0, 1), a2 + hstep, voffA);
            PG8_WAIT_L(8); PG8_BAR; PG8_WAIT_L(0); PG8_MMA(0, 0, At, B0); PG8_BAR; PG8_SCHED;
            PG8_LDB(B1, 1, 1); PG8_STAGE(PG8_SB(1, 0), b3, voffB);
            PG8_BAR; PG8_WAIT_L(0); PG8_MMA(0, 1, At, B1); PG8_BAR;
            PG8_LDA(At, 1, 1); PG8_STAGE(PG8_SA(1, 0), a3, voffA);
            PG8_BAR; PG8_WAIT_L(0); PG8_MMA(1, 0, At, B0); PG8_BAR; PG8_SCHED;
            PG8_STAGE(PG8_SB(1, 1), b3 + hstep, voffB);
            PG8_WAIT_V(6); PG8_BAR; PG8_MMA(1, 1, At, B1); PG8_BAR;
            }
        }
        if constexpr (ALIGN_EPI) { if (wr == 0) PG8_BAR; }
        if constexpr (!Epi::AFTER_DRAIN) { E(acc, cur, wr, wc, fr, fq); S.done(cur); }
        if (!has_next) break;
#pragma unroll
        for (int a = 0; a < 2; ++a)
#pragma unroll
            for (int b = 0; b < 2; ++b)
#pragma unroll
                for (int m = 0; m < 4; ++m)
#pragma unroll
                    for (int n = 0; n < 2; ++n) acc[a][b][m][n] = (f32x4){0.f, 0.f, 0.f, 0.f};
        cur = nxt; cA = nA; cB = nB; ++ui;
        if constexpr (ALIGN_EPI) { if (wr == 1) PG8_BAR; }
    }
    PG8_WAIT_V(0);
    if constexpr (!ALIGN_EPI) { if (wr == 0) PG8_BAR; }
    PG8_BAR;
    if constexpr (Epi::AFTER_DRAIN) { E.fused(acc, cur, wr, wc, fr, fq, lds, wid, lane); S.done(cur); }
#undef PG8_SA
#undef PG8_SB
#undef PG8_STAGE
#undef PG8_LDA
#undef PG8_LDB
#undef PG8_MMA
#undef PG8_WAIT_V
#undef PG8_WAIT_L
#undef PG8_BAR
#undef PG8_SCHED
}
}

__global__ __launch_bounds__(256) void k_mod(const float* __restrict__ c, const float* __restrict__ c_ctx, const float* __restrict__ w0, const float* __restrict__ b0,
                                             const float* __restrict__ w1, const float* __restrict__ b1, float* __restrict__ mod) {
    __shared__ float sc[3][1024]; __shared__ float red[4][3][64];
    const int tid = threadIdx.x, layer = blockIdx.y; const float* w = layer ? w1 : w0; const float* bb = layer ? b1 : b0;
    for (int i = tid; i < 3072; i += 256) { const int r = i >> 10, k = i & 1023; const float v = r < 2 ? c[r * 1024 + k] : c_ctx[k]; sc[r][k] = v / (1.f + expf(-v)); }
    __syncthreads();
    const int cl = tid & 63, col = blockIdx.x * 64 + cl, kq = tid >> 6;
    float a0 = 0.f, a1 = 0.f, a2 = 0.f;
#pragma unroll 8
    for (int k = kq * 256; k < kq * 256 + 256; ++k) { const float wv = w[(size_t)k * 3072 + col]; a0 += sc[0][k] * wv; a1 += sc[1][k] * wv; a2 += sc[2][k] * wv; }
    red[kq][0][cl] = a0; red[kq][1][cl] = a1; red[kq][2][cl] = a2;
    __syncthreads();
    if (tid < 192) { const int r = tid >> 6; const float s = (red[0][r][cl] + red[1][r][cl]) + (red[2][r][cl] + red[3][r][cl]);
        mod[(size_t)(layer * 3 + r) * 3072 + col] = s + bb[col]; }
}

DEVI void sincos_pos(float ang, float& cs, float& sn) {
    const double TWO_PI = 6.283185307179586476925286766559; const double a = (double)ang; const double k = __builtin_rint(a * (1.0 / TWO_PI));
    const float r = (float)(a - k * TWO_PI);
    cs = cosf(r); sn = sinf(r);
}
__global__ __launch_bounds__(256) void k_tables(f32x2* __restrict__ tabA, f32x2* __restrict__ tabB) {
    const int i = blockIdx.x * 256 + threadIdx.x;
    if (i < 128 * 16) { const int pos = i >> 4, f = i & 15; const float invf = powf(10000.f, -(float)f / 16.f); const float ang = (float)pos * invf; float cs, sn; sincos_pos(ang, cs, sn); tabA[i] = (f32x2){cs, sn}; }
    else if (i < 128 * 16 + 128 * 8) { const int j = i - 128 * 16, pos = j >> 3, f = j & 7; const float invf = powf(10000.f, -(float)f / 8.f); const float ang = (float)pos * invf; float cs, sn; sincos_pos(ang, cs, sn); tabB[j] = (f32x2){cs, sn}; }
}

DEVI int cmap(int mode, int p) {
    switch (mode) {
    default: return p;
    }
}
__global__ __launch_bounds__(256) void k_wconv(const float* __restrict__ W, int K, int Nsrc, bf16_t* __restrict__ Bt, int Np, int mode, const float* __restrict__ ks) {
    const int total = Np * (K / 8);
    for (int i = blockIdx.x * 256 + threadIdx.x; i < total; i += gridDim.x * 256) {
        const int p = i % Np, k8 = i / Np; int cc = cmap(mode, p); if (cc >= Nsrc) cc = -1;
        float v[8];
#pragma unroll
        for (int j = 0; j < 8; ++j) { const int k = k8 * 8 + j; v[j] = cc >= 0 ? W[(size_t)k * Nsrc + cc] * (ks ? ks[k] : 1.f) : 0.f; }
        u32x4 o; o.x = pk2(v[0], v[1]); o.y = pk2(v[2], v[3]); o.z = pk2(v[4], v[5]); o.w = pk2(v[6], v[7]);
        *(u32x4*)(Bt + (size_t)p * K + k8 * 8) = o;
    }
}

struct PrepArgs { const float* xa; const float* xb; const float* Y; const float* modPrev; float* X1; float* X1b; const float* nw; const float* mod; bf16_t* H; int nrows; int pad; };
__global__ __launch_bounds__(256) void k_prep(PrepArgs a) {
    const int lane = threadIdx.x & 63; const int row = blockIdx.x * 4 + (threadIdx.x >> 6); if (row >= a.nrows) return;
    const int r = row < SEQ ? 0 : (row < ML ? 1 : 2);
    const float* src = row < ML ? a.xa + (size_t)row * DM : a.xb + (size_t)(row - ML) * DM;
    f32x4 v[4]; float ss = 0.f;
#pragma unroll
    for (int j = 0; j < 4; ++j) { const int cidx = 4 * lane + 256 * j; v[j] = *(const f32x4*)(src + cidx);
        if (a.Y) { const f32x4 y = *(const f32x4*)(a.Y + (size_t)row * DM + cidx); const f32x4 g = *(const f32x4*)(a.modPrev + (size_t)r * 3072 + 2048 + cidx); v[j] = v[j] + g * y; }
        if (a.X1) { float* xd = row < ML ? a.X1 + (size_t)row * DM : a.X1b + (size_t)(row - ML) * DM; *(f32x4*)(xd + cidx) = v[j]; }
        ss += (v[j].x * v[j].x + v[j].y * v[j].y) + (v[j].z * v[j].z + v[j].w * v[j].w); }
    if (!a.H) return;
    const float rinv = rsqrtf(wave_sum(ss) * (1.f / DM) + EPS);
#pragma unroll
    for (int j = 0; j < 4; ++j) { const int cidx = 4 * lane + 256 * j; const f32x4 w = *(const f32x4*)(a.nw + cidx);
        const f32x4 sh = *(const f32x4*)(a.mod + (size_t)r * 3072 + cidx), scl = *(const f32x4*)(a.mod + (size_t)r * 3072 + 1024 + cidx);
        const f32x4 h = (v[j] * rinv) * w * (scl + 1.f) + sh;
        u32x2 o; o.x = pk2(h.x, h.y); o.y = pk2(h.z, h.w); *(u32x2*)(a.H + (size_t)row * DM + cidx) = o; }
}

DEVI void row_info(int row, int& b, int& j, bool& lat, int& trow, int& tcol) {
    if (row < ML) { b = row >> 13; const int t = row & (SEQ - 1); j = CTXL + t; lat = true; trow = t >> 6; tcol = t & 63; }
    else { const int rr = row - ML; b = rr >> 8; j = rr & 255; lat = false; trow = 0; tcol = 0; }
}

struct Post0Args { const float* P; int row0; int nrows; const float* qn; const float* kn; const f32x2* tabA; bf16_t* K0; bf16_t* V0; bf16_t* Q0; bf16_t* G0; };
__global__ __launch_bounds__(256) void k_post0(Post0Args a) {
    const int lane = threadIdx.x & 63; const int lr = blockIdx.x * 4 + (threadIdx.x >> 6); if (lr >= a.nrows) return;
    const int row = a.row0 + lr; int b, j; bool lat; int trow, tcol; row_info(row, b, j, lat, trow, tcol);
    const float* p = a.P + (size_t)lr * N_IN0;
    const int q4 = lane >> 4, fi = lane & 15; const int pos = q4 < 2 ? trow : tcol; const f32x2 cs = a.tabA[pos * 16 + fi];
    const float kw = a.kn[lane], qw = a.qn[lane];
    bf16_t* Kd = a.K0 + ((size_t)b * TK + j) * 256; bf16_t* Vd = a.V0 + ((size_t)b * TK + j) * 256;
    for (int h = 0; h < 4; ++h) { const float v = p[h * 64 + lane]; const float ss = wave_sum(v * v); float y = v * rsqrtf(ss * (1.f / 64.f) + EPS) * kw;
        const float pr = __shfl_xor(y, 16); if (lat) y = y * cs.x + ((q4 & 1) ? pr : -pr) * cs.y;
        Kd[h * 64 + lane] = (bf16_t)f2bf(y); }
    for (int h = 0; h < 4; ++h) Vd[h * 64 + lane] = (bf16_t)f2bf(p[256 + h * 64 + lane]);
    bf16_t* Qd = a.Q0 + (size_t)row * DM; bf16_t* Gd = a.G0 + (size_t)row * DM;
    for (int h = 0; h < 16; ++h) { const float v = p[512 + h * 64 + lane]; const float ss = wave_sum(v * v); float y = v * rsqrtf(ss * (1.f / 64.f) + EPS) * qw;
        const float pr = __shfl_xor(y, 16); if (lat) y = y * cs.x + ((q4 & 1) ? pr : -pr) * cs.y;
        Qd[h * 64 + lane] = (bf16_t)f2bf(y * C2_GQA); }
    for (int h = 0; h < 16; ++h) Gd[h * 64 + lane] = (bf16_t)f2bf(silu_f(p[1536 + h * 64 + lane]));
}

struct Post1aArgs { const float* P; int row0; int nrows; const float* kvn_w; const float* krn_w; const float* qan_w; const f32x2* tabB; bf16_t* KVN; bf16_t* K1c; bf16_t* QAN; bf16_t* G1; };
__global__ __launch_bounds__(256) void k_post1a(Post1aArgs a) {
    const int lane = threadIdx.x & 63; const int lr = blockIdx.x * 4 + (threadIdx.x >> 6); if (lr >= a.nrows) return;
    const int row = a.row0 + lr; int b, j; bool lat; int trow, tcol; row_info(row, b, j, lat, trow, tcol);
    const float* p = a.P + (size_t)lr * N_IN1P;
    { float v[4]; float ss = 0.f;
#pragma unroll
      for (int i = 0; i < 4; ++i) { v[i] = p[lane + 64 * i]; ss += v[i] * v[i]; }
      const float rinv = rsqrtf(wave_sum(ss) * (1.f / 256.f) + EPS);
#pragma unroll
      for (int i = 0; i < 4; ++i) a.KVN[(size_t)row * 256 + lane + 64 * i] = (bf16_t)f2bf(v[i] * rinv * a.kvn_w[lane + 64 * i]); }
    { const int l32 = lane & 31; const float v = lane < 32 ? p[256 + l32] : 0.f; const float ss = wave_sum(v * v); float y = v * rsqrtf(ss * (1.f / 32.f) + EPS) * a.krn_w[l32];
      const int q4 = l32 >> 3, fi = l32 & 7; const int pos = q4 < 2 ? trow : tcol; const f32x2 cs = a.tabB[pos * 8 + fi];
      const float pr = __shfl_xor(y, 8); if (lat) y = y * cs.x + ((q4 & 1) ? pr : -pr) * cs.y;
      if (lane < 32) { bf16_t* Kd = a.K1c + ((size_t)b * TK + j) * 1536 + 64 + l32; const bf16_t yb = (bf16_t)f2bf(y);
#pragma unroll
        for (int h = 0; h < 16; ++h) Kd[h * 96] = yb; } }
    if (lat) {
      float v[6]; float ss = 0.f;
#pragma unroll
      for (int i = 0; i < 6; ++i) { v[i] = p[288 + lane + 64 * i]; ss += v[i] * v[i]; }
      const float rinv = rsqrtf(wave_sum(ss) * (1.f / 384.f) + EPS);
#pragma unroll
      for (int i = 0; i < 6; ++i) a.QAN[(size_t)row * 384 + lane + 64 * i] = (bf16_t)f2bf(v[i] * rinv * a.qan_w[lane + 64 * i]);
#pragma unroll
      for (int i = 0; i < 16; ++i) a.G1[(size_t)row * DM + lane + 64 * i] = (bf16_t)f2bf(silu_f(p[672 + lane + 64 * i]));
    }
}
struct Post1bArgs { const float* P; int row0; int nrows; const float* knn_w; bf16_t* K1c; bf16_t* V1; };
__global__ __launch_bounds__(256) void k_post1b(Post1bArgs a) {
    const int lane = threadIdx.x & 63; const int lr = blockIdx.x * 4 + (threadIdx.x >> 6); if (lr >= a.nrows) return;
    const int row = a.row0 + lr; int b, j; bool lat; int trow, tcol; row_info(row, b, j, lat, trow, tcol);
    const float* p = a.P + (size_t)lr * 2048; const float w = a.knn_w[lane];
    bf16_t* Kd = a.K1c + ((size_t)b * TK + j) * 1536; bf16_t* Vd = a.V1 + ((size_t)b * TK + j) * DM;
    for (int h = 0; h < 16; ++h) { const float v = p[h * 128 + lane]; const float ss = wave_sum(v * v);
        Kd[h * 96 + lane] = (bf16_t)f2bf(v * rsqrtf(ss * (1.f / 64.f) + EPS) * w);
        Vd[h * 64 + lane] = (bf16_t)f2bf(p[h * 128 + 64 + lane]); }
}
struct Post1cArgs { const float* P; int row0; int nrows; const float* qn_w; const f32x2* tabB; bf16_t* Q1; };
__global__ __launch_bounds__(256) void k_post1c(Post1cArgs a) {
    const int lane = threadIdx.x & 63; const int lr = blockIdx.x * 4 + (threadIdx.x >> 6); if (lr >= a.nrows) return;
    const int row = a.row0 + lr; int b, j; bool lat; int trow, tcol; row_info(row, b, j, lat, trow, tcol);
    const float* p = a.P + (size_t)lr * 1536; const int l32 = lane & 31;
    const float wn = a.qn_w[lane], wr = a.qn_w[64 + l32];
    const int q4 = l32 >> 3, fi = l32 & 7; const int pos = q4 < 2 ? trow : tcol; const f32x2 cs = a.tabB[pos * 8 + fi];
    bf16_t* Qd = a.Q1 + (size_t)row * 1536;
    for (int h = 0; h < 16; ++h) { const float vn = p[h * 96 + lane]; const float vr = lane < 32 ? p[h * 96 + 64 + l32] : 0.f;
        const float rinv = rsqrtf(wave_sum(vn * vn + vr * vr) * (1.f / 96.f) + EPS);
        Qd[h * 96 + lane] = (bf16_t)f2bf(vn * rinv * wn * C2_MLA);
        float y = vr * rinv * wr; const float pr = __shfl_xor(y, 8); y = y * cs.x + ((q4 & 1) ? pr : -pr) * cs.y;
        if (lane < 32) Qd[h * 96 + 64 + l32] = (bf16_t)f2bf(y * C2_MLA); }
}

namespace av1 {
#define SBAR() __builtin_amdgcn_sched_barrier(0)
DEVI int crow(int r, int hi) { return (r & 3) + 8 * (r >> 2) + 4 * hi; }
DEVI unsigned cvtpk(float lo, float hi) { unsigned r; asm volatile("v_cvt_pk_bf16_f32 %0, %1, %2" : "=v"(r) : "v"(lo), "v"(hi)); return r; }
constexpr int NCB = 2;
DEVI int v_st(int k, int c) { const int kk = (k & ~0xC) | ((k & 4) << 1) | ((k & 8) >> 1); return ((kk >> 3) * NCB + (c >> 5)) * 512 + ((kk & 7) * 32 + (c & 31)) * 2; }
DEVI int v_rd_base(int lane) { return ((lane & 3) << 3) | (((lane >> 2) & 3) << 6) | (((lane >> 4) & 1) << 5) | (((lane >> 5) & 1) << 8); }
constexpr int v_rd_off(int d0, int ks, int half) { return d0 * 512 + ks * (2 * NCB * 512) + half * (NCB * 512); }
template <int OFF> DEVI s16x4 tr_read(int vb) { s16x4 r; asm volatile("ds_read_b64_tr_b16 %0, %1 offset:%2" : "=&v"(r) : "v"(vb), "i"(OFF) : "memory"); return r; }
template <int D0> DEVI void pv_one(f32x16& od, int vb, bf16x8 pa0, bf16x8 pa1, bf16x8 pa2, bf16x8 pa3) {
    const s16x4 l0 = tr_read<v_rd_off(D0, 0, 0)>(vb), h0 = tr_read<v_rd_off(D0, 0, 1)>(vb), l1 = tr_read<v_rd_off(D0, 1, 0)>(vb), h1 = tr_read<v_rd_off(D0, 1, 1)>(vb);
    const s16x4 l2 = tr_read<v_rd_off(D0, 2, 0)>(vb), h2 = tr_read<v_rd_off(D0, 2, 1)>(vb), l3 = tr_read<v_rd_off(D0, 3, 0)>(vb), h3 = tr_read<v_rd_off(D0, 3, 1)>(vb);
    asm volatile("s_waitcnt lgkmcnt(0)" ::: "memory"); SBAR();
#define PK(L, H) (bf16x8){L[0], L[1], L[2], L[3], H[0], H[1], H[2], H[3]}
    od = __builtin_amdgcn_mfma_f32_32x32x16_bf16(pa0, PK(l0, h0), od, 0, 0, 0);
    od = __builtin_amdgcn_mfma_f32_32x32x16_bf16(pa1, PK(l1, h1), od, 0, 0, 0);
    od = __builtin_amdgcn_mfma_f32_32x32x16_bf16(pa2, PK(l2, h2), od, 0, 0, 0);
    od = __builtin_amdgcn_mfma_f32_32x32x16_bf16(pa3, PK(l3, h3), od, 0, 0, 0);
#undef PK
}
DEVI void expA(f32x16& p0) {
#pragma unroll
    for (int r = 0; r < 16; ++r) p0[r] = __builtin_amdgcn_exp2f(p0[r]);
}
DEVI void finishSM(f32x16& p0, f32x16& p1, float& l_reg, bf16x8& pa0, bf16x8& pa1, bf16x8& pa2, bf16x8& pa3) {
#pragma unroll
    for (int r = 0; r < 16; ++r) p1[r] = __builtin_amdgcn_exp2f(p1[r]);
    float ps = 0;
#pragma unroll
    for (int r = 0; r < 16; ++r) ps += p0[r];
#pragma unroll
    for (int r = 0; r < 16; ++r) ps += p1[r];
    { auto rr = __builtin_amdgcn_permlane32_swap(__float_as_uint(ps), __float_as_uint(ps), false, false); ps = __uint_as_float(rr[0]) + __uint_as_float(rr[1]); }
    l_reg += ps;
#define PK4(P, BASE, OUT) do { unsigned a0 = cvtpk(P[BASE + 0], P[BASE + 1]), a1 = cvtpk(P[BASE + 2], P[BASE + 3]);   \
    unsigned b0 = cvtpk(P[BASE + 4], P[BASE + 5]), b1 = cvtpk(P[BASE + 6], P[BASE + 7]);                              \
    auto r0 = __builtin_amdgcn_permlane32_swap(a0, b0, false, false); auto r1 = __builtin_amdgcn_permlane32_swap(a1, b1, false, false); \
    u32x4 w = {r0[0], r1[0], r0[1], r1[1]}; OUT = *reinterpret_cast<bf16x8*>(&w); } while (0)
    PK4(p0, 0, pa0); PK4(p0, 8, pa1); PK4(p1, 0, pa2); PK4(p1, 8, pa3);
#undef PK4
}
template <int DQK> DEVI void qkt(f32x16& p0, f32x16& p1, const char* Ks, const bf16x8* qr, int r32, int hi) {
    constexpr int KSTR = DQK * 2 + 16;
    p0 = f32x16{}; p1 = f32x16{};
#pragma unroll
    for (int d0 = 0; d0 < DQK / 16; ++d0) { const int cb = (d0 * 16 + hi * 8) * 2;
        const bf16x8 b0 = *reinterpret_cast<const bf16x8*>(Ks + r32 * KSTR + cb);
        const bf16x8 b1 = *reinterpret_cast<const bf16x8*>(Ks + (32 + r32) * KSTR + cb);
        p0 = __builtin_amdgcn_mfma_f32_32x32x16_bf16(b0, qr[d0], p0, 0, 0, 0);
        p1 = __builtin_amdgcn_mfma_f32_32x32x16_bf16(b1, qr[d0], p1, 0, 0, 0); }
}
template <int DQK> struct Cfg { static constexpr int KSTR = DQK * 2 + 16, NCH = DQK / 8, SHM_K = 64 * KSTR, SHM_V = 64 * 64 * 2, LDS_BYTES = 2 * SHM_V + 2 * SHM_K + 8 * 64 * 4; };

template <int DQK>
DEVI void attn_unit(const bf16_t* __restrict__ Qb, int ldq, const bf16_t* __restrict__ Kh, int ldk, const bf16_t* __restrict__ Vh, int ldv, int NT,
                    bf16_t* __restrict__ Ob, const bf16_t* __restrict__ Gb, int ldo, char* lds) {
    using C = Cfg<DQK>; constexpr int KSTR = C::KSTR, NCH = C::NCH; constexpr int SHM_V = C::SHM_V, SHM_K = C::SHM_K;
    const int tid = threadIdx.x, wid = tid >> 6, lane = tid & 63, r32 = lane & 31, hi = lane >> 5;
    char* V_lds = lds; char* K_lds = lds + 2 * SHM_V; float* ws = (float*)(lds + 2 * SHM_V + 2 * SHM_K) + wid * 64;
    float l_reg = 0.f; f32x16 o[2] = {}; bf16x8 qr[DQK / 16];
    const bf16_t* Qw = Qb + (size_t)(wid * 32 + r32) * ldq + hi * 8;
#pragma unroll
    for (int d0 = 0; d0 < DQK / 16; ++d0) qr[d0] = *reinterpret_cast<const bf16x8*>(Qw + d0 * 16);
    const int vk = tid >> 3, vc = (tid & 7) * 8, vst = v_st(vk, vc);
    const int ks0 = tid / NCH, kc0 = tid % NCH, ks1 = (tid + 512) / NCH, kc1 = (tid + 512) % NCH; constexpr bool K2 = (64 * NCH > 512); const bool k2on = K2 && (tid + 512 < 64 * NCH);
    const int vb0 = (int)(uintptr_t)V_lds + v_rd_base(lane);
    struct { bf16x8 v, k0, k1; } st[2];
#define SLOAD(i, key0) do { st[i].v = *reinterpret_cast<const bf16x8*>(Vh + (size_t)((key0) + vk) * ldv + vc); \
    st[i].k0 = *reinterpret_cast<const bf16x8*>(Kh + (size_t)((key0) + ks0) * ldk + kc0 * 8); \
    if (K2) { if (k2on) st[i].k1 = *reinterpret_cast<const bf16x8*>(Kh + (size_t)((key0) + ks1) * ldk + kc1 * 8); } } while (0)
#define SWRITE(b, i) do { *(bf16x8*)(V_lds + (b) * SHM_V + vst) = st[i].v; *(bf16x8*)(K_lds + (b) * SHM_K + ks0 * KSTR + kc0 * 16) = st[i].k0; \
    if (K2) { if (k2on) *(bf16x8*)(K_lds + (b) * SHM_K + ks1 * KSTR + kc1 * 16) = st[i].k1; } } while (0)
    f32x16 pA0, pA1, pB0, pB1; bf16x8 pa0, pa1, pa2, pa3;
    constexpr int SE = 0, SO = 1;
    SLOAD(SE, 0); SWRITE(0, SE); __syncthreads();
    qkt<DQK>(pA0, pA1, K_lds, qr, r32, hi); expA(pA0);
    SLOAD(SO, 64); if (2 < NT) SLOAD(SE, 128);
    SWRITE(1, SO); __syncthreads();
    for (int j = 1; j + 1 < NT; j += 2) {
        SBAR(); qkt<DQK>(pB0, pB1, K_lds + SHM_K, qr, r32, hi);
        finishSM(pA0, pA1, l_reg, pa0, pa1, pa2, pa3); SBAR();
        SLOAD(SO, (j + 2) * 64); SBAR();
        pv_one<0>(o[0], vb0, pa0, pa1, pa2, pa3); pv_one<1>(o[1], vb0, pa0, pa1, pa2, pa3); expA(pB0);
        __syncthreads(); SWRITE(0, SE); __syncthreads();
        SBAR(); qkt<DQK>(pA0, pA1, K_lds, qr, r32, hi);
        finishSM(pB0, pB1, l_reg, pa0, pa1, pa2, pa3); SBAR();
        if (j + 3 < NT) SLOAD(SE, (j + 3) * 64); SBAR();
        pv_one<0>(o[0], vb0 + SHM_V, pa0, pa1, pa2, pa3); pv_one<1>(o[1], vb0 + SHM_V, pa0, pa1, pa2, pa3); expA(pA0);
        __syncthreads(); SWRITE(1, SO); __syncthreads();
    }
    SBAR(); qkt<DQK>(pB0, pB1, K_lds + SHM_K, qr, r32, hi);
    finishSM(pA0, pA1, l_reg, pa0, pa1, pa2, pa3); SBAR();
    pv_one<0>(o[0], vb0, pa0, pa1, pa2, pa3); pv_one<1>(o[1], vb0, pa0, pa1, pa2, pa3); expA(pB0);
    finishSM(pB0, pB1, l_reg, pa0, pa1, pa2, pa3); SBAR();
    pv_one<0>(o[0], vb0 + SHM_V, pa0, pa1, pa2, pa3); pv_one<1>(o[1], vb0 + SHM_V, pa0, pa1, pa2, pa3);
    if (hi == 0) ws[r32] = l_reg; asm volatile("s_waitcnt lgkmcnt(0)" ::: "memory");
    float rli[16];
#pragma unroll
    for (int r = 0; r < 16; ++r) rli[r] = __builtin_amdgcn_rcpf(ws[crow(r, hi)]);
#pragma unroll
    for (int r = 0; r < 16; ++r) { const size_t off = (size_t)(wid * 32 + crow(r, hi)) * ldo + r32;
#pragma unroll
        for (int d0 = 0; d0 < 2; ++d0) Ob[off + d0 * 32] = (bf16_t)f2bf(o[d0][r] * rli[r] * bf2f(Gb[off + d0 * 32])); }
    __syncthreads();
#undef SLOAD
#undef SWRITE
}
#undef SBAR
}

struct AttnArgs { const bf16_t* Q; const bf16_t* K; const bf16_t* V; bf16_t* O; const bf16_t* G; int layer; int pad; };
template <int DQK> __global__ __launch_bounds__(512, 2) void k_attn_v1(AttnArgs a) {
    extern __shared__ __attribute__((aligned(16))) char lds[];
    const int u = blockIdx.x;
    if (u < 1024) { const int b = u >> 9, h = (u >> 5) & 15, qb = u & 31; const size_t row0 = (size_t)b * SEQ + qb * 256;
        if (DQK == 64) av1::attn_unit<DQK>(a.Q + row0 * DM + h * 64, DM, a.K + (size_t)b * TK * 256 + (h >> 2) * 64, 256, a.V + (size_t)b * TK * 256 + (h >> 2) * 64, 256, TK / 64,
                                            a.O + row0 * DM + h * 64, a.G + row0 * DM + h * 64, DM, lds);
        else av1::attn_unit<DQK>(a.Q + row0 * 1536 + h * 96, 1536, a.K + (size_t)b * TK * 1536 + h * 96, 1536, a.V + (size_t)b * TK * DM + h * 64, DM, TK / 64,
                                 a.O + row0 * DM + h * 64, a.G + row0 * DM + h * 64, DM, lds);
    } else { const int b = (u - 1024) >> 4, h = (u - 1024) & 15; const size_t row0 = (size_t)ML + b * CTXL;
        av1::attn_unit<DQK>(a.Q + row0 * DM + h * 64, DM, a.K + (size_t)b * TK * 256 + (h >> 2) * 64, 256, a.V + (size_t)b * TK * 256 + (h >> 2) * 64, 256, CTXL / 64,
                            a.O + row0 * DM + h * 64, a.G + row0 * DM + h * 64, DM, lds); }
}

struct GemmArgs { const bf16_t* A; const bf16_t* Bt; float* O; int N, K, pm0, npm; };
__global__ __launch_bounds__(512, 2) void k_gemm_raw(GemmArgs g) {
    extern __shared__ __attribute__((aligned(16))) unsigned char glds[];
    pg8::Gemm gg{g.A, g.Bt, 0, g.N, g.K}; pg8::ROrder S; S.init(g.pm0, g.npm, g.N, (int)gridDim.x, (int)blockIdx.x);
    pg8::EpiF32 E{g.O, g.N, g.pm0};
    pg8::gemm_phase<pg8::EpiF32, pg8::ROrder, true, true>((PG8_LAS unsigned char*)glds, gg, S, E);
}

constexpr size_t MiB = 1u << 20;
constexpr size_t WS_MOD = 1 * MiB;
constexpr size_t WS_TABA = WS_MOD + 128 * 1024;
constexpr size_t WS_TABB = WS_TABA + 32 * 1024;
constexpr size_t WS_WIN0 = 2 * MiB;
constexpr size_t WS_WOUT0 = 7 * MiB;
constexpr size_t WS_WIN1 = 9 * MiB;
constexpr size_t WS_WKVB = 13 * MiB;
constexpr size_t WS_WQB = 14 * MiB;
constexpr size_t WS_WOUT1 = 16 * MiB;
constexpr size_t WS_CTX1 = 18 * MiB;
constexpr size_t WS_R1 = 20 * MiB;
constexpr size_t WS_R2 = 53 * MiB;
constexpr size_t WS_R4 = 103 * MiB;
constexpr size_t WS_R5 = 136 * MiB;
constexpr size_t WS_R6 = 169 * MiB;
constexpr size_t WS_Q1 = WS_R6, WS_KVN = WS_R6 + 48 * MiB, WS_QAN = WS_KVN + 9 * MiB, WS_Y = WS_R6;
constexpr size_t WS_X1 = 0;
constexpr size_t WS_END = 256 * MiB;

static void launch_gemm(const bf16_t* A, const bf16_t* Bt, float* O, int N, int K, int pm0, int npm, hipStream_t s) {
    GemmArgs g{A, Bt, O, N, K, pm0, npm};
    hipLaunchKernelGGL(k_gemm_raw, dim3(256), dim3(512), 131072, s, g);
}

extern "C" void kernel_launch(void* const* d_in, const int* in_sizes, int n_in, void* d_out, int out_size, void* d_ws, size_t ws_size, hipStream_t stream) {
    static int ok = 0;
    if (!ok) {
        if (n_in != 23 || out_size != ML * DM || ws_size < WS_END) { fprintf(stderr, "kernel_launch: unexpected shapes n_in %d out %d ws %zu\n", n_in, out_size, ws_size); return; }
        hipFuncSetAttribute((const void*)k_gemm_raw, hipFuncAttributeMaxDynamicSharedMemorySize, 131072);
        ok = 1;
    }
    const float* x = (const float*)d_in[0]; const float* c = (const float*)d_in[1]; const float* ctx = (const float*)d_in[2]; const float* c_ctx = (const float*)d_in[3];
    const float* l0_w_mod = (const float*)d_in[4]; const float* l0_b_mod = (const float*)d_in[5]; const float* l0_norm = (const float*)d_in[6]; const float* l0_w_in = (const float*)d_in[7];
    const float* l0_q_norm = (const float*)d_in[8]; const float* l0_k_norm = (const float*)d_in[9]; const float* l0_w_out = (const float*)d_in[10];
    const float* l1_w_mod = (const float*)d_in[11]; const float* l1_b_mod = (const float*)d_in[12]; const float* l1_norm = (const float*)d_in[13]; const float* l1_w_in = (const float*)d_in[14];
    const float* l1_kv_a_norm = (const float*)d_in[15]; const float* l1_w_kv_b = (const float*)d_in[16]; const float* l1_q_a_norm = (const float*)d_in[17]; const float* l1_w_q_b = (const float*)d_in[18];
    const float* l1_q_norm = (const float*)d_in[19]; const float* l1_k_nope_norm = (const float*)d_in[20]; const float* l1_k_rope_norm = (const float*)d_in[21]; const float* l1_w_out = (const float*)d_in[22];
    char* ws = (char*)d_ws; float* out = (float*)d_out;
    float* mod = (float*)(ws + WS_MOD); f32x2* tabA = (f32x2*)(ws + WS_TABA); f32x2* tabB = (f32x2*)(ws + WS_TABB);
    bf16_t* Win0 = (bf16_t*)(ws + WS_WIN0); bf16_t* Wout0 = (bf16_t*)(ws + WS_WOUT0); bf16_t* Win1 = (bf16_t*)(ws + WS_WIN1); bf16_t* Wkvb = (bf16_t*)(ws + WS_WKVB);
    bf16_t* Wqb = (bf16_t*)(ws + WS_WQB); bf16_t* Wout1 = (bf16_t*)(ws + WS_WOUT1);
    bf16_t* H = (bf16_t*)(ws + WS_R1); bf16_t* OG0 = H; bf16_t* V1 = H;
    bf16_t* Q0 = (bf16_t*)(ws + WS_R2); bf16_t* K0 = (bf16_t*)(ws + WS_R2 + 33 * MiB); bf16_t* V0 = (bf16_t*)(ws + WS_R2 + 33 * MiB + (size_t)NB * TK * 256 * 2); bf16_t* K1c = Q0;
    bf16_t* G = (bf16_t*)(ws + WS_R4);
    float* RAW = (float*)(ws + WS_R5); bf16_t* OG1 = (bf16_t*)(ws + WS_R5);
    bf16_t* Q1 = (bf16_t*)(ws + WS_Q1); bf16_t* KVN = (bf16_t*)(ws + WS_KVN); bf16_t* QAN = (bf16_t*)(ws + WS_QAN); float* Y = (float*)(ws + WS_Y);
    float* X1c = (float*)(ws + WS_CTX1);

    hipLaunchKernelGGL(k_mod, dim3(48, 2), dim3(256), 0, stream, c, c_ctx, l0_w_mod, l0_b_mod, l1_w_mod, l1_b_mod, mod);
    hipLaunchKernelGGL(k_tables, dim3(12), dim3(256), 0, stream, tabA, tabB);
    hipLaunchKernelGGL(k_wconv, dim3(1024), dim3(256), 0, stream, l0_w_in, 1024, N_IN0, Win0, N_IN0, 0, (const float*)nullptr);
    hipLaunchKernelGGL(k_wconv, dim3(512), dim3(256), 0, stream, l0_w_out, 1024, 1024, Wout0, 1024, 0, (const float*)nullptr);
    hipLaunchKernelGGL(k_wconv, dim3(1024), dim3(256), 0, stream, l1_w_in, 1024, N_IN1, Win1, N_IN1P, 0, (const float*)nullptr);
    hipLaunchKernelGGL(k_wconv, dim3(256), dim3(256), 0, stream, l1_w_kv_b, 256, 2048, Wkvb, 2048, 0, (const float*)nullptr);
    hipLaunchKernelGGL(k_wconv, dim3(256), dim3(256), 0, stream, l1_w_q_b, 384, 1536, Wqb, 1536, 0, (const float*)nullptr);
    hipLaunchKernelGGL(k_wconv, dim3(512), dim3(256), 0, stream, l1_w_out, 1024, 1024, Wout1, 1024, 0, (const float*)nullptr);
    { PrepArgs p{x, ctx, nullptr, nullptr, nullptr, nullptr, l0_norm, mod, H, MT, 0}; hipLaunchKernelGGL(k_prep, dim3(MT / 4), dim3(256), 0, stream, p); }
    for (int ch = 0; ch < 6; ++ch) { const int pm0 = ch * 11, npm = 11;
        launch_gemm(H, Win0, RAW, N_IN0, 1024, pm0, npm, stream);
        Post0Args p{RAW, pm0 * 256, npm * 256, l0_q_norm, l0_k_norm, tabA, K0, V0, Q0, G}; hipLaunchKernelGGL(k_post0, dim3(npm * 64), dim3(256), 0, stream, p); }
    { AttnArgs a{Q0, K0, V0, OG0, G, 0, 0}; hipLaunchKernelGGL(k_attn_v1<64>, dim3(1056), dim3(512), av1::Cfg<64>::LDS_BYTES, stream, a); }
    launch_gemm(OG0, Wout0, Y, 1024, 1024, 0, 66, stream);
    { PrepArgs p{x, ctx, Y, mod, out, X1c, l1_norm, mod + 3 * 3072, H, MT, 0}; hipLaunchKernelGGL(k_prep, dim3(MT / 4), dim3(256), 0, stream, p); }
    for (int ch = 0; ch < 6; ++ch) { const int pm0 = ch * 11, npm = 11;
        launch_gemm(H, Win1, RAW, N_IN1P, 1024, pm0, npm, stream);
        Post1aArgs p{RAW, pm0 * 256, npm * 256, l1_kv_a_norm, l1_k_rope_norm, l1_q_a_norm, tabB, KVN, K1c, QAN, G}; hipLaunchKernelGGL(k_post1a, dim3(npm * 64), dim3(256), 0, stream, p); }
    for (int ch = 0; ch < 6; ++ch) { const int pm0 = ch * 11, npm = 11;
        launch_gemm(KVN, Wkvb, RAW, 2048, 256, pm0, npm, stream);
        Post1bArgs p{RAW, pm0 * 256, npm * 256, l1_k_nope_norm, K1c, V1}; hipLaunchKernelGGL(k_post1b, dim3(npm * 64), dim3(256), 0, stream, p); }
    for (int ch = 0; ch < 4; ++ch) { const int pm0 = ch * 16, npm = 16;
        launch_gemm(QAN, Wqb, RAW, 1536, 384, pm0, npm, stream);
        Post1cArgs p{RAW, pm0 * 256, npm * 256, l1_q_norm, tabB, Q1}; hipLaunchKernelGGL(k_post1c, dim3(npm * 64), dim3(256), 0, stream, p); }
    { AttnArgs a{Q1, K1c, V1, OG1, G, 1, 0}; hipLaunchKernelGGL(k_attn_v1<96>, dim3(1024), dim3(512), av1::Cfg<96>::LDS_BYTES, stream, a); }
    launch_gemm(OG1, Wout1, Y, 1024, 1024, 0, 64, stream);
    { PrepArgs p{out, nullptr, Y, mod + 3 * 3072, out, nullptr, nullptr, nullptr, nullptr, ML, 0}; hipLaunchKernelGGL(k_prep, dim3(ML / 4), dim3(256), 0, stream, p); }
    const hipError_t le = hipPeekAtLastError();
    if (le != hipSuccess) fprintf(stderr, "kernel_launch: launch failed: %s\n", hipGetErrorName(le));
}
```

```cpp
#include <hip/hip_runtime.h>
#include <hip/hip_bf16.h>
#include <cstdio>
#include <cstdint>

#define DEVI __device__ __forceinline__
#define LAS __attribute__((address_space(3)))
#define GAS __attribute__((address_space(1)))

constexpr int NB = 2, SEQ = 8192, DM = 1024, CTXL = 256, TK = SEQ + CTXL;
constexpr int ML = NB * SEQ, MC = NB * CTXL, MT = ML + MC;
constexpr int GRIDW = 64;
constexpr float EPS = 1e-6f;
constexpr float LOG2E = 1.4426950408889634f;
constexpr int N_IN0 = 2560, N_IN1 = 1696, N_IN1P = 1792;
constexpr float C2_GQA = 0.125f * LOG2E;
constexpr float C2_MLA = 0.10206207261596575f * LOG2E;

typedef unsigned short bf16_t;
typedef short bf16x8 __attribute__((ext_vector_type(8)));
typedef short s16x4 __attribute__((ext_vector_type(4)));
typedef float f32x4 __attribute__((ext_vector_type(4)));
typedef float f32x2 __attribute__((ext_vector_type(2)));
typedef float f32x16 __attribute__((ext_vector_type(16)));
typedef unsigned u32x4 __attribute__((ext_vector_type(4)));
typedef unsigned u32x2 __attribute__((ext_vector_type(2)));

DEVI float bf2f(bf16_t v) { return __uint_as_float((unsigned)v << 16); }
DEVI unsigned f2bf(float f) { unsigned u = __float_as_uint(f); return (u + 0x7fffu + ((u >> 16) & 1u)) >> 16; }
DEVI unsigned pk2(float lo, float hi) { return f2bf(lo) | (f2bf(hi) << 16); }
DEVI float wave_sum(float v) {
#pragma unroll
    for (int o = 1; o < 64; o <<= 1) v += __shfl_xor(v, o);
    return v;
}
DEVI float silu_f(float v) { return v / (1.f + __expf(-v)); }
namespace pg8 {
#define PG8_LAS __attribute__((address_space(3)))
typedef unsigned short bf16_t;
typedef short bf16x8 __attribute__((ext_vector_type(8)));
typedef float f32x4 __attribute__((ext_vector_type(4)));
typedef unsigned u32x4 __attribute__((ext_vector_type(4)));
constexpr int BM = 256, BK = 64, HALF = 128, HTB = HALF * BK * 2  , STAGE_BYTES = 8 * HTB, NXCD = 8, WGM = 8;

__host__ __device__ __forceinline__ int lds_byte(int r, int c) { const int st = (r >> 4) * 2 + (c >> 5), rr = r & 15, cc = c & 31, ob = rr * 64 + cc * 2; return st * 1024 + (ob ^ (((ob >> 9) & 1) << 5)); }
__host__ __device__ __forceinline__ void stage_rc(int b, int& R, int& C) { const int st = b / 1024, sb = b % 1024, swz = sb ^ (((sb >> 9) & 1) << 5); R = (st >> 1) * 16 + swz / 64; C = (st & 1) * 32 + (swz % 64) / 2; }
__host__ __device__ __forceinline__ int perm32(int rho) { const int n = rho >> 4, i = rho & 15; return 8 * (i >> 2) + 4 * n + (i & 3); }

struct Unit { int pm, pn; };
struct Gemm { const bf16_t* A; const bf16_t* Bt; int M, N, K; };

struct StaticOrder {
    int nM, nN, nwg, G, c;
    __host__ __device__ void init(int M, int N, int G_, int c_) { nM = M / BM; nN = N / BM; nwg = nM * nN; G = G_; c = c_; }
    __host__ __device__ bool next(int i, Unit& u) const {
        const long L = (long)i * G + c; if (L >= nwg) return false;
        int wgid = (int)L; { const int q = nwg / NXCD, r = nwg % NXCD, xcd = wgid % NXCD, off = wgid / NXCD; wgid = (xcd < r ? xcd * (q + 1) : r * (q + 1) + (xcd - r) * q) + off; }
        const int nig = WGM * nN, gid = wgid / nig, fm = gid * WGM, gsz = (nM - fm) < WGM ? (nM - fm) : WGM;
        u.pm = fm + ((wgid % nig) % gsz); u.pn = (wgid % nig) / gsz; return true;
    }
    __device__ __forceinline__ void a_ready(const Unit&) const {}
    __device__ __forceinline__ void done(const Unit&) const {}
};


struct ROrder {
    int pm0, nM, nN, nwg, G, c;
    __host__ __device__ void init(int pm0_, int npm, int N, int G_, int c_) { pm0 = pm0_; nM = npm; nN = N / BM; nwg = nM * nN; G = G_; c = c_; }
    __host__ __device__ bool next(int i, Unit& u) const {
        const long L = (long)i * G + c; if (L >= nwg) return false;
        int wgid = (int)L; { const int q = nwg / NXCD, r = nwg % NXCD, xcd = wgid % NXCD, off = wgid / NXCD; wgid = (xcd < r ? xcd * (q + 1) : r * (q + 1) + (xcd - r) * q) + off; }
        const int nig = WGM * nN, gid = wgid / nig, fm = gid * WGM, gsz = (nM - fm) < WGM ? (nM - fm) : WGM;
        u.pm = pm0 + fm + ((wgid % nig) % gsz); u.pn = (wgid % nig) / gsz; return true;
    }
    __device__ __forceinline__ void a_ready(const Unit&) const {}
    __device__ __forceinline__ void done(const Unit&) const {}
};

struct EpiF32 {
    static constexpr bool PERM = true, AFTER_DRAIN = false;
    float* O; int ldc; int pmbase;
    __device__ __forceinline__ void operator()(const f32x4 (&acc)[2][2][4][2], const Unit& u, int wr, int wc, int fr, int fq) const {
        const int row0 = (u.pm - pmbase) * BM + wr * 64 + fr, col0 = u.pn * BM + wc * 32 + 8 * fq;
#pragma unroll
        for (int ai = 0; ai < 2; ++ai)
#pragma unroll
            for (int m = 0; m < 4; ++m) { float* rowp = O + (size_t)(row0 + ai * HALF + m * 16) * ldc + col0;
#pragma unroll
                for (int bj = 0; bj < 2; ++bj) { *(f32x4*)(rowp + bj * HALF) = acc[ai][bj][m][0]; *(f32x4*)(rowp + bj * HALF + 4) = acc[ai][bj][m][1]; } }
    }
};

DEVI unsigned cvt_pk_bf16(float lo, float hi) { unsigned r; asm volatile("v_cvt_pk_bf16_f32 %0, %1, %2" : "=v"(r) : "v"(lo), "v"(hi)); return r; }
DEVI u32x4 pack8(const f32x4 a, const f32x4 b) { u32x4 w; w.x = cvt_pk_bf16(a[0], a[1]); w.y = cvt_pk_bf16(a[2], a[3]); w.z = cvt_pk_bf16(b[0], b[1]); w.w = cvt_pk_bf16(b[2], b[3]); return w; }
DEVI float quad_sum(float s) { s += __shfl_xor(s, 16); s += __shfl_xor(s, 32); return s; }
DEVI float sq4(const f32x4 v) { return (v[0] * v[0] + v[1] * v[1]) + (v[2] * v[2] + v[3] * v[3]); }
DEVI f32x4 silu4(const f32x4 v) { f32x4 o; o[0] = silu_f(v[0]); o[1] = silu_f(v[1]); o[2] = silu_f(v[2]); o[3] = silu_f(v[3]); return o; }
DEVI int key_slot(int R) { return R < ML ? (R >> 13) * TK + CTXL + (R & (SEQ - 1)) : ((R - ML) >> 8) * TK + ((R - ML) & 255); }
DEVI void rot4(f32x4& x1, f32x4& x2, const f32x4 cs01, const f32x4 cs23) {
    const f32x4 c = {cs01[0], cs01[2], cs23[0], cs23[2]}, s = {cs01[1], cs01[3], cs23[1], cs23[3]};
    const f32x4 a = x1 * c - x2 * s, b = x2 * c + x1 * s; x1 = a; x2 = b;
}

DEVI int drope32(int i) { const int fq = i >> 3, n = (i >> 2) & 1, j = i & 3; return 16 * (fq >> 1) + 8 * n + 4 * (fq & 1) + j; }
DEVI int wmap(int mode, int p) {
    const int pn = p >> 8, q = p & 255, bj = q >> 7, wc = (q >> 5) & 3, i = q & 31;
    switch (mode) {
    case 1: {
        if (pn == 0 || (pn >= 2 && pn <= 5)) { const int fq = i >> 3, n = (i >> 2) & 1, j = i & 3; return 256 * pn + 64 * wc + 32 * bj + 16 * n + 4 * fq + j; }
        return p; }
    case 2: {
        if (pn == 0) return q;
        if (pn == 1) return 288 + q;
        if (pn == 2) { if (wc < 2) return 288 + 256 + 64 * wc + 32 * bj + i; if (wc == 2 && bj == 0) return 256 + drope32(i); return -1; }
        return 672 + 256 * (pn - 3) + q; }
    case 3: { const int head = 2 * pn + (wc >> 1), type = wc & 1; return 128 * head + 64 * type + 32 * bj + i; }
    case 4: { const int head = 2 * pn + (wc >> 1), type = wc & 1; if (type == 0) return 96 * head + 32 * bj + i; return bj == 0 ? 96 * head + 64 + drope32(i) : -1; }
    default: return p;
    }
}

struct EpiIn0 {
    static constexpr bool PERM = true, AFTER_DRAIN = false;
    const float* qn; const float* kn; const f32x4* tabA; bf16_t* K0; bf16_t* V0; bf16_t* Q0; bf16_t* G0;
    __device__ __forceinline__ void operator()(const f32x4 (&acc)[2][2][4][2], const Unit& u, int wr, int wc, int fr_, int fq_) const {
        int fr = fr_, fq = fq_; asm volatile("" : "+v"(fr), "+v"(fq));
        const int pn = u.pn; const bool lat = u.pm < ML / BM;
        if (pn == 0 || (pn >= 2 && pn <= 5)) {
            const float* wsrc = pn == 0 ? kn : qn; const float outs = pn == 0 ? 1.f : C2_GQA;
            f32x4 wv[2][2];
#pragma unroll
            for (int bj = 0; bj < 2; ++bj)
#pragma unroll
                for (int n = 0; n < 2; ++n) wv[bj][n] = *(const f32x4*)(wsrc + 32 * bj + 16 * n + 4 * fq) * outs;
#pragma unroll
            for (int ai = 0; ai < 2; ++ai)
#pragma unroll
                for (int m = 0; m < 4; ++m) {
                    const int R = u.pm * BM + ai * HALF + wr * 64 + m * 16 + fr;
                    f32x4 x[2][2]; float ss = 0.f;
#pragma unroll
                    for (int bj = 0; bj < 2; ++bj)
#pragma unroll
                        for (int n = 0; n < 2; ++n) { x[bj][n] = acc[ai][bj][m][n]; ss += sq4(x[bj][n]); }
                    const float rinv = rsqrtf(quad_sum(ss) * (1.f / 64.f) + EPS);
#pragma unroll
                    for (int bj = 0; bj < 2; ++bj)
#pragma unroll
                        for (int n = 0; n < 2; ++n) x[bj][n] = x[bj][n] * rinv * wv[bj][n];
                    if (lat) { const int t = R & (SEQ - 1), trow = t >> 6, tcol = t & 63;
                        const f32x4* tr = tabA + (trow * 16 + 4 * fq) / 2; const f32x4* tc = tabA + (tcol * 16 + 4 * fq) / 2;
                        rot4(x[0][0], x[0][1], tr[0], tr[1]); rot4(x[1][0], x[1][1], tc[0], tc[1]); }
                    if (pn == 0) { bf16_t* dst = K0 + (size_t)key_slot(R) * 256 + wc * 64 + 8 * fq;
                        *(u32x4*)dst = pack8(x[0][0], x[0][1]); *(u32x4*)(dst + 32) = pack8(x[1][0], x[1][1]); }
                    else { bf16_t* dst = Q0 + (size_t)R * DM + ((pn - 2) * 4 + wc) * 64 + 8 * fq;
                        *(u32x4*)dst = pack8(x[0][0], x[0][1]); *(u32x4*)(dst + 32) = pack8(x[1][0], x[1][1]); }
                }
        } else if (pn == 1) {
#pragma unroll
            for (int ai = 0; ai < 2; ++ai)
#pragma unroll
                for (int m = 0; m < 4; ++m) { const int R = u.pm * BM + ai * HALF + wr * 64 + m * 16 + fr; bf16_t* dst = V0 + (size_t)key_slot(R) * 256 + wc * 32 + 8 * fq;
#pragma unroll
                    for (int bj = 0; bj < 2; ++bj) *(u32x4*)(dst + bj * HALF) = pack8(acc[ai][bj][m][0], acc[ai][bj][m][1]); }
        } else {
#pragma unroll
            for (int ai = 0; ai < 2; ++ai)
#pragma unroll
                for (int m = 0; m < 4; ++m) { const int R = u.pm * BM + ai * HALF + wr * 64 + m * 16 + fr; bf16_t* dst = G0 + (size_t)R * DM + (pn - 6) * BM + wc * 32 + 8 * fq;
#pragma unroll
                    for (int bj = 0; bj < 2; ++bj) *(u32x4*)(dst + bj * HALF) = pack8(silu4(acc[ai][bj][m][0]), silu4(acc[ai][bj][m][1])); }
        }
    }
};

struct EpiOut {
    static constexpr bool PERM = true, AFTER_DRAIN = false;
    const float* baseL; const float* baseC; float* dstL; float* dstC; const float* gate;
    __device__ __forceinline__ void operator()(const f32x4 (&acc)[2][2][4][2], const Unit& u, int wr, int wc, int fr_, int fq_) const {
        int fr = fr_, fq = fq_; asm volatile("" : "+v"(fr), "+v"(fq));
        const int col0 = u.pn * BM + wc * 32 + 8 * fq;
#pragma unroll
        for (int ai = 0; ai < 2; ++ai)
#pragma unroll
            for (int m = 0; m < 4; ++m) { const int R = u.pm * BM + ai * HALF + wr * 64 + m * 16 + fr; const int r = R < SEQ ? 0 : (R < ML ? 1 : 2);
                const float* b = R < ML ? baseL + (size_t)R * DM : baseC + (size_t)(R - ML) * DM; float* d = R < ML ? dstL + (size_t)R * DM : dstC + (size_t)(R - ML) * DM;
                const float* g = gate + (size_t)r * 3072;
#pragma unroll
                for (int bj = 0; bj < 2; ++bj)
#pragma unroll
                    for (int n = 0; n < 2; ++n) { const int c = col0 + bj * HALF + 4 * n; *(f32x4*)(d + c) = *(const f32x4*)(b + c) + *(const f32x4*)(g + c) * acc[ai][bj][m][n]; } }
    }
};

struct EpiIn1 {
    static constexpr bool PERM = true, AFTER_DRAIN = false;
    const float* krn; const f32x4* tabB; bf16_t* KVA; float* SSKV; bf16_t* QA; float* SSQ; bf16_t* KR; bf16_t* G1;
    __device__ __forceinline__ void operator()(const f32x4 (&acc)[2][2][4][2], const Unit& u, int wr, int wc, int fr_, int fq_) const {
        int fr = fr_, fq = fq_; asm volatile("" : "+v"(fr), "+v"(fq));
        const int pn = u.pn; const bool lat = u.pm < ML / BM;
        if (pn >= 3) {
#pragma unroll
            for (int ai = 0; ai < 2; ++ai)
#pragma unroll
                for (int m = 0; m < 4; ++m) { const int R = u.pm * BM + ai * HALF + wr * 64 + m * 16 + fr; bf16_t* dst = G1 + (size_t)R * DM + (pn - 3) * BM + wc * 32 + 8 * fq;
#pragma unroll
                    for (int bj = 0; bj < 2; ++bj) *(u32x4*)(dst + bj * HALF) = pack8(silu4(acc[ai][bj][m][0]), silu4(acc[ai][bj][m][1])); }
        } else if (pn == 2 && wc == 2) {
            f32x4 wv[2];
#pragma unroll
            for (int n = 0; n < 2; ++n) wv[n] = *(const f32x4*)(krn + 16 * (fq >> 1) + 8 * n + 4 * (fq & 1));
#pragma unroll
            for (int ai = 0; ai < 2; ++ai)
#pragma unroll
                for (int m = 0; m < 4; ++m) { const int R = u.pm * BM + ai * HALF + wr * 64 + m * 16 + fr;
                    f32x4 x0 = acc[ai][0][m][0], x1 = acc[ai][0][m][1];
                    const float rinv = rsqrtf(quad_sum(sq4(x0) + sq4(x1)) * (1.f / 32.f) + EPS);
                    x0 = x0 * rinv * wv[0]; x1 = x1 * rinv * wv[1];
                    if (lat) { const int t = R & (SEQ - 1); const int pos = (fq >> 1) ? (t & 63) : (t >> 6); const f32x4* tp = tabB + (pos * 8 + 4 * (fq & 1)) / 2; rot4(x0, x1, tp[0], tp[1]); }
                    *(u32x4*)(KR + (size_t)key_slot(R) * 32 + 8 * fq) = pack8(x0, x1); }
        } else if (pn == 2 && wc == 3) {
        } else if (pn == 0 || lat) {
            bf16_t* base; float* ssb; int ld, cbase, nss, iss;
            if (pn == 0) { base = KVA; ld = 256; cbase = wc * 32; ssb = SSKV; nss = 4; iss = wc; }
            else if (pn == 1) { base = QA; ld = 384; cbase = wc * 32; ssb = SSQ; nss = 6; iss = wc; }
            else { base = QA; ld = 384; cbase = 256 + wc * 64; ssb = SSQ; nss = 6; iss = 4 + wc; }
            const int bjs = pn == 2 ? 32 : HALF;
#pragma unroll
            for (int ai = 0; ai < 2; ++ai)
#pragma unroll
                for (int m = 0; m < 4; ++m) { const int R = u.pm * BM + ai * HALF + wr * 64 + m * 16 + fr; bf16_t* dst = base + (size_t)R * ld + cbase + 8 * fq; float ss = 0.f;
#pragma unroll
                    for (int bj = 0; bj < 2; ++bj) { ss += sq4(acc[ai][bj][m][0]) + sq4(acc[ai][bj][m][1]); *(u32x4*)(dst + bj * bjs) = pack8(acc[ai][bj][m][0], acc[ai][bj][m][1]); }
                    ss = quad_sum(ss); if (fq == 0) ssb[(size_t)R * nss + iss] = ss; }
        }
    }
};

struct EpiKvb {
    static constexpr bool PERM = true, AFTER_DRAIN = false;
    const float* SSKV; const float* knn; bf16_t* K1; bf16_t* V1;
    __device__ __forceinline__ void operator()(const f32x4 (&acc)[2][2][4][2], const Unit& u, int wr, int wc, int fr_, int fq_) const {
        int fr = fr_, fq = fq_; asm volatile("" : "+v"(fr), "+v"(fq));
        const int head = 2 * u.pn + (wc >> 1), type = wc & 1;
#pragma unroll
        for (int ai = 0; ai < 2; ++ai)
#pragma unroll
            for (int m = 0; m < 4; ++m) { const int R = u.pm * BM + ai * HALF + wr * 64 + m * 16 + fr;
                asm volatile("" ::: "memory");
                const f32x4 s4 = *(const f32x4*)(SSKV + (size_t)R * 4); const float rkv = rsqrtf(((s4[0] + s4[1]) + (s4[2] + s4[3])) * (1.f / 256.f) + EPS);
                f32x4 x[2][2]; float ss = 0.f;
#pragma unroll
                for (int bj = 0; bj < 2; ++bj)
#pragma unroll
                    for (int n = 0; n < 2; ++n) { x[bj][n] = acc[ai][bj][m][n] * rkv; ss += sq4(x[bj][n]); }
                bf16_t* dst = (type == 0 ? K1 : V1) + (size_t)key_slot(R) * DM + head * 64 + 8 * fq;
                if (type == 0) { const float rinv = rsqrtf(quad_sum(ss) * (1.f / 64.f) + EPS);
#pragma unroll
                    for (int bj = 0; bj < 2; ++bj)
#pragma unroll
                        for (int n = 0; n < 2; ++n) x[bj][n] = x[bj][n] * rinv * *(const f32x4*)(knn + 32 * bj + 8 * fq + 4 * n); }
                *(u32x4*)dst = pack8(x[0][0], x[0][1]); *(u32x4*)(dst + 32) = pack8(x[1][0], x[1][1]); }
    }
};

struct EpiQb {
    static constexpr bool PERM = true, AFTER_DRAIN = false;
    const float* SSQ; const float* qnw; const f32x4* tabB; bf16_t* Q1N; bf16_t* Q1R; float* SSH;
    __device__ __forceinline__ float rqa_of(int R) const { const float* sp = SSQ + (size_t)R * 6; const f32x2 sa = *(const f32x2*)sp, sb = *(const f32x2*)(sp + 2), sc = *(const f32x2*)(sp + 4);
        return rsqrtf(((sa[0] + sa[1]) + (sb[0] + sb[1]) + (sc[0] + sc[1])) * (1.f / 384.f) + EPS); }
    __device__ __forceinline__ void operator()(const f32x4 (&acc)[2][2][4][2], const Unit& u, int wr, int wc, int fr_, int fq_) const {
        int fr = fr_, fq = fq_; asm volatile("" : "+v"(fr), "+v"(fq));
        const int head = 2 * u.pn + (wc >> 1);
        if ((wc & 1) == 0) {
#pragma unroll
            for (int ai = 0; ai < 2; ++ai)
#pragma unroll
                for (int m = 0; m < 4; ++m) { const int R = u.pm * BM + ai * HALF + wr * 64 + m * 16 + fr;
                    asm volatile("" ::: "memory");
                    const float rqa = rqa_of(R); float ss = 0.f; bf16_t* dst = Q1N + (size_t)R * DM + head * 64 + 8 * fq;
#pragma unroll
                    for (int bj = 0; bj < 2; ++bj) { f32x4 x0 = acc[ai][bj][m][0] * rqa, x1 = acc[ai][bj][m][1] * rqa; ss += sq4(x0) + sq4(x1);
                        x0 = x0 * *(const f32x4*)(qnw + 32 * bj + 8 * fq); x1 = x1 * *(const f32x4*)(qnw + 32 * bj + 8 * fq + 4); *(u32x4*)(dst + 32 * bj) = pack8(x0, x1); }
                    ss = quad_sum(ss); if (fq == 0) SSH[((size_t)R * 16 + head) * 2] = ss; }
        } else {
#pragma unroll
            for (int ai = 0; ai < 2; ++ai)
#pragma unroll
                for (int m = 0; m < 4; ++m) { const int R = u.pm * BM + ai * HALF + wr * 64 + m * 16 + fr;
                    asm volatile("" ::: "memory");
                    const float rqa = rqa_of(R);
                    f32x4 x0 = acc[ai][0][m][0] * rqa, x1 = acc[ai][0][m][1] * rqa; const float ss = quad_sum(sq4(x0) + sq4(x1)); if (fq == 0) SSH[((size_t)R * 16 + head) * 2 + 1] = ss;
                    const float* wp = qnw + 64 + 16 * (fq >> 1) + 4 * (fq & 1); x0 = x0 * *(const f32x4*)wp; x1 = x1 * *(const f32x4*)(wp + 8);
                    const int t = R & (SEQ - 1); const int pos = (fq >> 1) ? (t & 63) : (t >> 6); const f32x4* tp = tabB + (pos * 8 + 4 * (fq & 1)) / 2; rot4(x0, x1, tp[0], tp[1]);
                    *(u32x4*)(Q1R + (size_t)R * 512 + head * 32 + 8 * fq) = pack8(x0, x1); }
        }
    }
};

struct In1Order {
    int G, c; ROrder lat;
    __host__ __device__ void init(int G_, int c_) { G = G_; c = c_; lat.init(0, ML / BM, N_IN1P, G_, c_); }
    __host__ __device__ bool next(int i, Unit& u) const {
        const long L = (long)i * G + c; if (L < lat.nwg) return lat.next(i, u);
        const int e = (int)(L - lat.nwg); if (e >= 4) return false; u.pm = ML / BM + (e >> 1); u.pn = (e & 1) * 2; return true;
    }
    __device__ __forceinline__ void a_ready(const Unit&) const {}
    __device__ __forceinline__ void done(const Unit&) const {}
};
template <class Epi, class Sched, bool ALIGN_EPI = false, bool SP2 = false>
__device__ __forceinline__ void gemm_phase(PG8_LAS unsigned char* lds, const Gemm g, const Sched& S, const Epi& E) {
    const int tid = threadIdx.x, wid = __builtin_amdgcn_readfirstlane(tid >> 6), lane = tid & 63, wr = wid >> 2, wc = wid & 3, fr = lane & 15, fq = lane >> 4;
    const int K = g.K, nt = K / BK;
    unsigned voffA[2], voffB[2];
#pragma unroll
    for (int i = 0; i < 2; ++i) { int R, C; stage_rc(tid * 16 + i * 8192, R, C); const int Rb = Epi::PERM ? ((R & ~31) + perm32(R & 31)) : R;
        voffA[i] = (unsigned)(R * K + C) * 2u; voffB[i] = (unsigned)(Rb * K + C) * 2u; }
    const size_t kstep = (size_t)(BK * 2);
    const size_t hstep = (size_t)HALF * K * 2;
    const size_t tstep = 2 * hstep;
    const unsigned ldsw = (unsigned)wid * 1024u;
    const int aoff = lds_byte(wr * 64 + fr, fq * 8), boff = lds_byte(wc * 32 + fr, fq * 8);
#define PG8_SA(b, h) (((b) * 2 + (h)) * HTB)
#define PG8_SB(b, h) ((4 + (b) * 2 + (h)) * HTB)
#define PG8_STAGE(bufoff, gbase, voff) do { _Pragma("unroll") for (int _i = 0; _i < 2; ++_i) \
        __builtin_amdgcn_global_load_lds((const unsigned*)((const char*)(gbase) + (voff)[_i]), (PG8_LAS unsigned*)(lds + (bufoff) + ldsw + _i * 8192), 16, 0, 0); } while (0)
#define PG8_LDA(dst, b, h) do { _Pragma("unroll") for (int m = 0; m < 4; ++m) _Pragma("unroll") for (int k = 0; k < 2; ++k) dst[m][k] = *(const PG8_LAS bf16x8*)(lds + PG8_SA(b, h) + aoff + m * 2048 + k * 1024); } while (0)
#define PG8_LDB(dst, b, h) do { _Pragma("unroll") for (int n = 0; n < 2; ++n) _Pragma("unroll") for (int k = 0; k < 2; ++k) dst[n][k] = *(const PG8_LAS bf16x8*)(lds + PG8_SB(b, h) + boff + n * 2048 + k * 1024); } while (0)
#define PG8_MMA(ai, bj, At, Bt) do { __builtin_amdgcn_s_setprio(1); _Pragma("unroll") for (int m = 0; m < 4; ++m) _Pragma("unroll") for (int n = 0; n < 2; ++n) _Pragma("unroll") for (int k = 0; k < 2; ++k) \
        acc[ai][bj][m][n] = __builtin_amdgcn_mfma_f32_16x16x32_bf16(Bt[n][k], At[m][k], acc[ai][bj][m][n], 0, 0, 0); __builtin_amdgcn_s_setprio(0); } while (0)
#define PG8_WAIT_V(n) asm volatile("s_waitcnt vmcnt(" #n ")" ::: "memory")
#define PG8_WAIT_L(n) asm volatile("s_waitcnt lgkmcnt(" #n ")" ::: "memory")
#define PG8_BAR __builtin_amdgcn_s_barrier()
#define PG8_SCHED __builtin_amdgcn_sched_barrier(0)
    Unit cur, nxt; int ui = 0;
    if (!S.next(0, cur)) return;
    f32x4 acc[2][2][4][2];
#pragma unroll
    for (int a = 0; a < 2; ++a)
#pragma unroll
        for (int b = 0; b < 2; ++b)
#pragma unroll
            for (int m = 0; m < 4; ++m)
#pragma unroll
                for (int n = 0; n < 2; ++n) acc[a][b][m][n] = (f32x4){0.f, 0.f, 0.f, 0.f};
    bf16x8 At[4][2], B0[2][2], B1[2][2];
    const char* cA = (const char*)g.A + (size_t)cur.pm * tstep; const char* cB = (const char*)g.Bt + (size_t)cur.pn * tstep;
    S.a_ready(cur);
    if constexpr (SP2) {
        PG8_STAGE(PG8_SB(0, 0), cB, voffB); PG8_STAGE(PG8_SB(0, 1), cB + hstep, voffB); PG8_STAGE(PG8_SA(0, 0), cA, voffA); PG8_STAGE(PG8_SA(0, 1), cA + hstep, voffA);
        if (wr == 1) PG8_BAR;
        PG8_WAIT_V(2); PG8_BAR;
        PG8_STAGE(PG8_SB(1, 0), cB + kstep, voffB); PG8_STAGE(PG8_SA(1, 0), cA + kstep, voffA); PG8_STAGE(PG8_SB(1, 1), cB + hstep + kstep, voffB);
        PG8_WAIT_V(6); PG8_BAR;
    } else {
        PG8_STAGE(PG8_SB(0, 0), cB, voffB); PG8_STAGE(PG8_SA(0, 0), cA, voffA); PG8_STAGE(PG8_SB(0, 1), cB + hstep, voffB); PG8_STAGE(PG8_SA(0, 1), cA + hstep, voffA);
        if (wr == 1) PG8_BAR;
        PG8_WAIT_V(4); PG8_BAR;
        PG8_STAGE(PG8_SB(1, 0), cB + kstep, voffB); PG8_STAGE(PG8_SA(1, 0), cA + kstep, voffA); PG8_STAGE(PG8_SB(1, 1), cB + hstep + kstep, voffB);
        PG8_WAIT_V(6); PG8_BAR;
    }
    for (;;) {
        const bool has_next = S.next(ui + 1, nxt);
        const char* nA = has_next ? (const char*)g.A + (size_t)nxt.pm * tstep : cA; const char* nB = has_next ? (const char*)g.Bt + (size_t)nxt.pn * tstep : cB;
        _Pragma("nounroll") for (int t = 0; t < nt; t += 2) {
            const bool last = (t == nt - 2);
            const char* a1 = cA + (size_t)(t + 1) * kstep;
            const char* a2 = last ? nA : cA + (size_t)(t + 2) * kstep; const char* b2 = last ? nB : cB + (size_t)(t + 2) * kstep;
            const char* a3 = a2 + kstep; const char* b3 = b2 + kstep;
            if (last && has_next) S.a_ready(nxt);
            if constexpr (SP2) {
            PG8_LDB(B0, 0, 0); PG8_LDB(B1, 0, 1); PG8_SCHED; PG8_LDA(At, 0, 0); PG8_STAGE(PG8_SA(1, 1), a1 + hstep, voffA);
            PG8_WAIT_V(8); PG8_WAIT_L(0); PG8_BAR; PG8_MMA(0, 0, At, B0); PG8_MMA(0, 1, At, B1); PG8_BAR; PG8_SCHED;
            PG8_LDA(At, 0, 1); PG8_STAGE(PG8_SB(0, 0), b2, voffB); PG8_STAGE(PG8_SB(0, 1), b2 + hstep, voffB); PG8_STAGE(PG8_SA(0, 0), a2, voffA);
            PG8_WAIT_V(8); PG8_WAIT_L(0); PG8_BAR; PG8_MMA(1, 0, At, B0); PG8_MMA(1, 1, At, B1); PG8_BAR; PG8_SCHED;
            PG8_LDB(B0, 1, 0); PG8_LDB(B1, 1, 1); PG8_SCHED; PG8_LDA(At, 1, 0); PG8_STAGE(PG8_SA(0, 1), a2 + hstep, voffA);
            PG8_WAIT_V(8); PG8_WAIT_L(0); PG8_BAR; PG8_MMA(0, 0, At, B0); PG8_MMA(0, 1, At, B1); PG8_BAR; PG8_SCHED;
            PG8_LDA(At, 1, 1); PG8_STAGE(PG8_SB(1, 0), b3, voffB); PG8_STAGE(PG8_SB(1, 1), b3 + hstep, voffB); PG8_STAGE(PG8_SA(1, 0), a3, voffA);
            PG8_WAIT_V(8); PG8_WAIT_L(0); PG8_BAR; PG8_MMA(1, 0, At, B0); PG8_MMA(1, 1, At, B1); PG8_BAR; PG8_SCHED;
            } else {
            PG8_LDB(B0, 0, 0); PG8_SCHED; PG8_LDA(At, 0, 0); PG8_STAGE(PG8_SA(1, 1), a1 + hstep, voffA);
            PG8_WAIT_L(8); PG8_BAR; PG8_WAIT_L(0); PG8_MMA(0, 0, At, B0); PG8_BAR; PG8_SCHED;
            PG8_LDB(B1, 0, 1); PG8_STAGE(PG8_SB(0, 0), b2, voffB);
            PG8_BAR; PG8_WAIT_L(0); PG8_MMA(0, 1, At, B1); PG8_BAR;
            PG8_LDA(At, 0, 1); PG8_STAGE(PG8_SA(0, 0), a2, voffA);
            PG8_BAR; PG8_WAIT_L(0); PG8_MMA(1, 0, At, B0); PG8_BAR; PG8_SCHED;
            PG8_STAGE(PG8_SB(0, 1), b2 + hstep, voffB);
            PG8_WAIT_V(6); PG8_BAR; PG8_MMA(1, 1, At, B1); PG8_BAR;
            PG8_LDB(B0, 1, 0); PG8_SCHED; PG8_LDA(At, 1, 0); PG8_STAGE(PG8_SA(0, 1), a2 + hstep, voffA);
            PG8_WAIT_L(8); PG8_BAR; PG8_WAIT_L(0); PG8_MMA(0, 0, At, B0); PG8_BAR; PG8_SCHED;
            PG8_LDB(B1, 1, 1); PG8_STAGE(PG8_SB(1, 0), b3, voffB);
            PG8_BAR; PG8_WAIT_L(0); PG8_MMA(0, 1, At, B1); PG8_BAR;
            PG8_LDA(At, 1, 1); PG8_STAGE(PG8_SA(1, 0), a3, voffA);
            PG8_BAR; PG8_WAIT_L(0); PG8_MMA(1, 0, At, B0); PG8_BAR; PG8_SCHED;
            PG8_STAGE(PG8_SB(1, 1), b3 + hstep, voffB);
            PG8_WAIT_V(6); PG8_BAR; PG8_MMA(1, 1, At, B1); PG8_BAR;
            }
        }
        if constexpr (ALIGN_EPI) { if (wr == 0) PG8_BAR; }
        if constexpr (!Epi::AFTER_DRAIN) { E(acc, cur, wr, wc, fr, fq); S.done(cur); }
        if (!has_next) break;
#pragma unroll
        for (int a = 0; a < 2; ++a)
#pragma unroll
            for (int b = 0; b < 2; ++b)
#pragma unroll
                for (int m = 0; m < 4; ++m)
#pragma unroll
                    for (int n = 0; n < 2; ++n) acc[a][b][m][n] = (f32x4){0.f, 0.f, 0.f, 0.f};
        cur = nxt; cA = nA; cB = nB; ++ui;
        if constexpr (ALIGN_EPI) { if (wr == 1) PG8_BAR; }
    }
    PG8_WAIT_V(0);
    if constexpr (!ALIGN_EPI) { if (wr == 0) PG8_BAR; }
    PG8_BAR;
    if constexpr (Epi::AFTER_DRAIN) { E.fused(acc, cur, wr, wc, fr, fq, lds, wid, lane); S.done(cur); }
#undef PG8_SA
#undef PG8_SB
#undef PG8_STAGE
#undef PG8_LDA
#undef PG8_LDB
#undef PG8_MMA
#undef PG8_WAIT_V
#undef PG8_WAIT_L
#undef PG8_BAR
#undef PG8_SCHED
}
}

DEVI void sincos_pos(float ang, float& cs, float& sn) {
    const double TWO_PI = 6.283185307179586476925286766559; const double a = (double)ang; const double k = __builtin_rint(a * (1.0 / TWO_PI));
    const float r = (float)(a - k * TWO_PI);
    cs = cosf(r); sn = sinf(r);
}

namespace afast {
constexpr int NW = 8, KVBLK = 64, SLOTK = 12288, SLOTV = 8192, KROFF = 8192;
constexpr int LDS_K = 0, LDS_V = 3 * SLOTK, LDS_WS = LDS_V + 3 * SLOTV, LDS_OST = LDS_WS + NW * 256, LDS_BYTES = LDS_OST + NW * 4096;
#define SBAR() __builtin_amdgcn_sched_barrier(0)
#define PIN(x) asm volatile("" : "+v"(x))
#define MFMA(a, b, c) __builtin_amdgcn_mfma_f32_32x32x16_bf16(a, b, c, 0, 0, 0)
#define WAIT_BAR(N) asm volatile("s_waitcnt vmcnt(" #N ") lgkmcnt(0)\n\ts_barrier" ::: "memory")
DEVI int crow(int r, int hi) { return (r & 3) + 8 * (r >> 2) + 4 * hi; }
DEVI unsigned cvtpk(float lo, float hi) { unsigned r; asm("v_cvt_pk_bf16_f32 %0, %1, %2" : "=v"(r) : "v"(lo), "v"(hi)); return r; }
DEVI void glds16(const void* g, unsigned lds_base) {
    unsigned sv; asm volatile("s_mov_b32 %0, m0\n\ts_mov_b32 m0, %2\n\ts_nop 0\n\tglobal_load_lds_dwordx4 %1, off\n\ts_mov_b32 m0, %0" : "=&s"(sv) : "v"(g), "s"(lds_base) : "memory"); }
typedef __attribute__((address_space(3))) const char* lds_cptr;
typedef short v4i16_t __attribute__((ext_vector_type(4)));
DEVI bf16x8 ldsb128(lds_cptr p) { return *(const __attribute__((address_space(3))) bf16x8*)p; }
DEVI s16x4 vtr(lds_cptr p) { return __builtin_bit_cast(s16x4, __builtin_amdgcn_ds_read_tr16_b64_v4i16((__attribute__((address_space(3))) v4i16_t*)p)); }
DEVI bf16x8 scale8(bf16x8 v, float s) {
    u32x4 w = __builtin_bit_cast(u32x4, v); u32x4 o;
#pragma unroll
    for (int i = 0; i < 4; ++i) { const float lo = __uint_as_float(w[i] << 16) * s, hi = __uint_as_float(w[i] & 0xffff0000u) * s; o[i] = cvtpk(lo, hi); }
    return __builtin_bit_cast(bf16x8, o);
}

template <int ROPE>
DEVI void attn_unit(const bf16_t* Qn, int ldq, const bf16_t* Qr, const float* ssh, const bf16_t* __restrict__ Kn, int ldk, const bf16_t* __restrict__ Kr,
                    const bf16_t* __restrict__ V, int ldv, int NT, bf16_t* O, const bf16_t* G, int ldo, char* lds) {
    const int tid = threadIdx.x, lane = tid & 63, r32 = lane & 31, hi = lane >> 5; const int wid = __builtin_amdgcn_readfirstlane(tid >> 6);
    const unsigned lds0 = (unsigned)(uintptr_t)lds; float* wsf = (float*)(lds + LDS_WS) + wid * 64;
    const bf16_t* ksrc = Kn + (size_t)lane * ldk + wid * 8;
    const bf16_t* vsrc = V + (size_t)(16 * (wid & 3) + (lane >> 2)) * ldv + (wid >> 2) * 32 + (lane & 3) * 8;
    const bf16_t* krsrc = ROPE ? Kr + (size_t)(32 * (wid & 1) + r32) * 32 + 8 * (2 * ((wid >> 1) & 1) + hi) : nullptr;
    const unsigned kdst = lds0 + LDS_K + wid * 1024, vdst = lds0 + LDS_V + wid * 1024, krdst = lds0 + LDS_K + KROFF + (wid & 3) * 1024;
    const bool rwave = ROPE && wid < 4;
#define DMA_K(t, slot) do { if (ROPE) { if (rwave) glds16(krsrc + (size_t)(t) * KVBLK * 32, (unsigned)__builtin_amdgcn_readfirstlane(krdst + (slot))); } \
        glds16(ksrc + (size_t)(t) * KVBLK * ldk, (unsigned)__builtin_amdgcn_readfirstlane(kdst + (slot))); } while (0)
#define DMA_V(t, slot) glds16(vsrc + (size_t)(t) * KVBLK * ldv, (unsigned)__builtin_amdgcn_readfirstlane(vdst + (slot)))
    const lds_cptr vp0 = (lds_cptr)lds + LDS_V + ((lane >> 4) & 1) * 32 + (lane & 3) * 8 + (4 * hi + ((lane & 15) >> 2)) * 64;
    const lds_cptr kp0 = (lds_cptr)lds + LDS_K + hi * 1024 + r32 * 16;
    const lds_cptr krp0 = (lds_cptr)lds + LDS_K + KROFF + hi * 512 + r32 * 16;
    DMA_K(0, 0); DMA_V(0, 0); DMA_K(1, SLOTK);
    bf16x8 qr[4]; bf16x8 qrr[2];
    { const bf16_t* Qw = Qn + (size_t)(wid * 32 + r32) * ldq + hi * 8;
#pragma unroll
      for (int d0 = 0; d0 < 4; ++d0) qr[d0] = *reinterpret_cast<const bf16x8*>(Qw + d0 * 16);
      if (ROPE) { const bf16_t* Qrw = Qr + (size_t)(wid * 32 + r32) * 512 + hi * 8;
#pragma unroll
          for (int d0 = 0; d0 < 2; ++d0) qrr[d0] = *reinterpret_cast<const bf16x8*>(Qrw + d0 * 16);
          const f32x2 s2 = *(const f32x2*)(ssh + (size_t)(wid * 32 + r32) * 32); const float sc = rsqrtf((s2[0] + s2[1]) * (1.f / 96.f) + EPS) * C2_MLA;
#pragma unroll
          for (int d0 = 0; d0 < 4; ++d0) qr[d0] = scale8(qr[d0], sc);
#pragma unroll
          for (int d0 = 0; d0 < 2; ++d0) qrr[d0] = scale8(qrr[d0], sc); } }
    float l_reg = 0.f; f32x16 o[2]; o[0] = f32x16{}; o[1] = f32x16{};
    const f32x16 zero16 = f32x16{};
    f32x16 pA0, pA1, pB0, pB1; bf16x8 kf[8]; bf16x8 kfr[4]; s16x4 vlo[8], vhi[8]; u32x4 pw0, pw1, pw2, pw3;
    int sl_prev = 0, sl_cur = 0, sl_next = SLOTK;
#define VSL(s) (((s) / (SLOTK / 1024)) * (SLOTV / 1024))
#define ROT() do { sl_prev = sl_cur; sl_cur = sl_next; sl_next = (sl_next == 2 * SLOTK) ? 0 : sl_next + SLOTK; } while (0)
#define EX(v) __builtin_amdgcn_exp2f(v)
#define KLOADALL(slot) do { _Pragma("unroll") for (int d0 = 0; d0 < 4; ++d0) { kf[2 * d0] = ldsb128(kp0 + (slot) + d0 * 2048); kf[2 * d0 + 1] = ldsb128(kp0 + (slot) + d0 * 2048 + 512); } \
        if (ROPE) { _Pragma("unroll") for (int q = 0; q < 4; ++q) kfr[q] = ldsb128(krp0 + (slot) + q * 1024); } } while (0)
    DMA_K(2, 2 * SLOTK);
    WAIT_BAR(3);
    KLOADALL(0);
    pA0 = MFMA(kf[0], qr[0], zero16); pA1 = MFMA(kf[1], qr[0], zero16); pA0 = MFMA(kf[2], qr[1], pA0); pA1 = MFMA(kf[3], qr[1], pA1);
    pA0 = MFMA(kf[4], qr[2], pA0); pA1 = MFMA(kf[5], qr[2], pA1); pA0 = MFMA(kf[6], qr[3], pA0); pA1 = MFMA(kf[7], qr[3], pA1);
    if (ROPE) { pA0 = MFMA(kfr[0], qrr[0], pA0); pA1 = MFMA(kfr[1], qrr[0], pA1); pA0 = MFMA(kfr[2], qrr[1], pA0); pA1 = MFMA(kfr[3], qrr[1], pA1); }
#pragma unroll
    for (int r = 0; r < 16; ++r) { pA0[r] = EX(pA0[r]); pA1[r] = EX(pA1[r]); }
    WAIT_BAR(0);
    DMA_K(3, 0); DMA_V(1, SLOTV); ROT();
    KLOADALL(sl_cur);
    WAIT_BAR(2);
#define PKW(P, i) cvtpk(P[i], P[i + 1])
#define PAF(k) __builtin_bit_cast(bf16x8, pw##k)
#define VFR(i) (bf16x8){vlo[i][0], vlo[i][1], vlo[i][2], vlo[i][3], vhi[i][0], vhi[i][1], vhi[i][2], vhi[i][3]}
#define VRD(i) do { vlo[i] = vtr(vp_ + (((i) >> 2) * 4096 + ((i) & 3) * 1024)); vhi[i] = vtr(vp_ + (((i) >> 2) * 4096 + ((i) & 3) * 1024 + 512)); } while (0)
#define KRD(G, d0) do { if (G) { kf[2 * (d0)] = ldsb128(kp0 + sl_next + (d0) * 2048); kf[2 * (d0) + 1] = ldsb128(kp0 + sl_next + (d0) * 2048 + 512); SBAR(); } } while (0)
#define KRR(G, q) do { if (ROPE) { if (G) { kfr[2 * (q)] = ldsb128(krp0 + sl_next + (2 * (q)) * 1024); kfr[2 * (q) + 1] = ldsb128(krp0 + sl_next + (2 * (q) + 1) * 1024); SBAR(); } } } while (0)
#define GAPA4(CX, MF, a0, a1, a2, a3, W0, W1, PW) do { MF; sacc += a0; sacc += a1; sacc += a2; sacc += a3; W0; W1; PIN(PW); PIN(sacc); PIN(CX); SBAR(); } while (0)
#define GAPA3(CX, MF, a0, a1, a2, W0, W1, PW) do { MF; sacc += a0; sacc += a1; sacc += a2; W0; W1; PIN(PW); PIN(sacc); PIN(CX); SBAR(); } while (0)
#define GAPA31(CX, MF, a0, a1, a2, W0, PW) do { MF; sacc += a0; sacc += a1; sacc += a2; W0; PIN(PW); PIN(sacc); PIN(CX); SBAR(); } while (0)
#define GAPA21(CX, MF, a0, a1, W0, PW) do { MF; sacc += a0; sacc += a1; W0; PIN(PW); PIN(sacc); PIN(CX); SBAR(); } while (0)
#define GAPB(MF, X, i) do { MF; X[i] = EX(X[i]); X[i + 1] = EX(X[i + 1]); X[i + 2] = EX(X[i + 2]); X[i + 3] = EX(X[i + 3]); PIN(X); SBAR(); } while (0)
#define STEP(C0, C1, P0, P1, t, GK, GV, GL) do { SBAR(); \
    const lds_cptr vp_ = vp0 + VSL(sl_prev); \
    VRD(0); SBAR(); float sacc = P0[0] + P0[1]; \
    if (!ROPE) { \
                        GAPA4(C0, C0 = MFMA(kf[0], qr[0], zero16), P0[2], P0[3], P0[4], P0[5],     pw0[0] = PKW(P0, 0),  pw0[1] = PKW(P0, 2),  pw0); \
        VRD(4); SBAR(); GAPA4(C1, C1 = MFMA(kf[1], qr[0], zero16), P0[6], P0[7], P0[8], P0[9],     pw0[2] = PKW(P0, 4),  pw0[3] = PKW(P0, 6),  pw0); \
        VRD(1); SBAR(); GAPA4(C0, C0 = MFMA(kf[2], qr[1], C0),    P0[10], P0[11], P0[12], P0[13], pw1[0] = PKW(P0, 8),  pw1[1] = PKW(P0, 10), pw1); \
        VRD(5); SBAR(); GAPA4(C1, C1 = MFMA(kf[3], qr[1], C1),    P0[14], P0[15], P1[0], P1[1],   pw1[2] = PKW(P0, 12), pw1[3] = PKW(P0, 14), pw1); \
        VRD(2); SBAR(); GAPA4(C0, C0 = MFMA(kf[4], qr[2], C0),    P1[2], P1[3], P1[4], P1[5],     pw2[0] = PKW(P1, 0),  pw2[1] = PKW(P1, 2),  pw2); \
        VRD(6); SBAR(); GAPA4(C1, C1 = MFMA(kf[5], qr[2], C1),    P1[6], P1[7], P1[8], P1[9],     pw2[2] = PKW(P1, 4),  pw2[3] = PKW(P1, 6),  pw2); \
        VRD(3); SBAR(); GAPA4(C0, C0 = MFMA(kf[6], qr[3], C0),    P1[10], P1[11], P1[12], P1[13], pw3[0] = PKW(P1, 8),  pw3[1] = PKW(P1, 10), pw3); \
        VRD(7); SBAR(); GAPA4(C1, C1 = MFMA(kf[7], qr[3], C1),    P1[14], P1[15], 0.f, 0.f,       pw3[2] = PKW(P1, 12), pw3[3] = PKW(P1, 14), pw3); \
    } else { \
                        GAPA3(C0, C0 = MFMA(kf[0], qr[0], zero16), P0[2], P0[3], P0[4],    pw0[0] = PKW(P0, 0),  pw0[1] = PKW(P0, 2),  pw0); \
        VRD(4); SBAR(); GAPA3(C1, C1 = MFMA(kf[1], qr[0], zero16), P0[5], P0[6], P0[7],    pw0[2] = PKW(P0, 4),  pw0[3] = PKW(P0, 6),  pw0); \
        VRD(1); SBAR(); GAPA3(C0, C0 = MFMA(kf[2], qr[1], C0),    P0[8], P0[9], P0[10],   pw1[0] = PKW(P0, 8),  pw1[1] = PKW(P0, 10), pw1); \
        VRD(5); SBAR(); GAPA3(C1, C1 = MFMA(kf[3], qr[1], C1),    P0[11], P0[12], P0[13], pw1[2] = PKW(P0, 12), pw1[3] = PKW(P0, 14), pw1); \
        VRD(2); SBAR(); GAPA31(C0, C0 = MFMA(kf[4], qr[2], C0),   P0[14], P0[15], P1[0],  pw2[0] = PKW(P1, 0),  pw2); \
        VRD(6); SBAR(); GAPA31(C1, C1 = MFMA(kf[5], qr[2], C1),   P1[1], P1[2], P1[3],    pw2[1] = PKW(P1, 2),  pw2); \
        VRD(3); SBAR(); GAPA21(C0, C0 = MFMA(kf[6], qr[3], C0),   P1[4], P1[5],           pw2[2] = PKW(P1, 4),  pw2); \
        VRD(7); SBAR(); GAPA21(C1, C1 = MFMA(kf[7], qr[3], C1),   P1[6], P1[7],           pw2[3] = PKW(P1, 6),  pw2); \
                        GAPA21(C0, C0 = MFMA(kfr[0], qrr[0], C0), P1[8], P1[9],           pw3[0] = PKW(P1, 8),  pw3); \
                        GAPA21(C1, C1 = MFMA(kfr[1], qrr[0], C1), P1[10], P1[11],         pw3[1] = PKW(P1, 10), pw3); \
                        GAPA21(C0, C0 = MFMA(kfr[2], qrr[1], C0), P1[12], P1[13],         pw3[2] = PKW(P1, 12), pw3); \
                        GAPA21(C1, C1 = MFMA(kfr[3], qrr[1], C1), P1[14], P1[15],         pw3[3] = PKW(P1, 14), pw3); \
    } \
    l_reg += sacc; \
    if (GK) DMA_K((t) + 3, sl_cur); if (GV) DMA_V((t) + 1, VSL(sl_next)); \
    SBAR(); \
    GAPB(o[0] = MFMA(PAF(0), VFR(0), o[0]), C0, 0); \
    KRD(GL, 0); GAPB(o[1] = MFMA(PAF(0), VFR(4), o[1]), C0, 4); \
    KRD(GL, 1); GAPB(o[0] = MFMA(PAF(1), VFR(1), o[0]), C0, 8); \
    KRD(GL, 2); GAPB(o[1] = MFMA(PAF(1), VFR(5), o[1]), C0, 12); \
    KRD(GL, 3); GAPB(o[0] = MFMA(PAF(2), VFR(2), o[0]), C1, 0); \
    KRR(GL, 0); GAPB(o[1] = MFMA(PAF(2), VFR(6), o[1]), C1, 4); \
    KRR(GL, 1); GAPB(o[0] = MFMA(PAF(3), VFR(3), o[0]), C1, 8); \
    GAPB(o[1] = MFMA(PAF(3), VFR(7), o[1]), C1, 12); \
    } while (0)
    int t = 1;
    for (; t + 5 < NT; t += 2) {
        STEP(pB0, pB1, pA0, pA1, t, true, true, true);     WAIT_BAR(2); ROT();
        STEP(pA0, pA1, pB0, pB1, t + 1, true, true, true); WAIT_BAR(2); ROT();
    }
#define ENDW(tt) do { if ((tt) + 3 < NT) { WAIT_BAR(2); } else if ((tt) + 2 < NT) { WAIT_BAR(1); } else { WAIT_BAR(0); } } while (0)
    for (; t + 1 < NT; t += 2) {
        STEP(pB0, pB1, pA0, pA1, t, (t + 3 < NT), (t + 1 < NT), (t + 1 < NT));         ENDW(t);     ROT();
        STEP(pA0, pA1, pB0, pB1, t + 1, (t + 4 < NT), (t + 2 < NT), (t + 2 < NT));     ENDW(t + 1); ROT();
    }
    STEP(pB0, pB1, pA0, pA1, NT - 1, false, false, false);
    { float sacc = pB0[0] + pB0[1];
#pragma unroll
      for (int r = 2; r < 16; ++r) sacc += pB0[r];
#pragma unroll
      for (int r = 0; r < 16; ++r) sacc += pB1[r];
      l_reg += sacc;
      pw0 = (u32x4){PKW(pB0, 0), PKW(pB0, 2), PKW(pB0, 4), PKW(pB0, 6)}; pw1 = (u32x4){PKW(pB0, 8), PKW(pB0, 10), PKW(pB0, 12), PKW(pB0, 14)};
      pw2 = (u32x4){PKW(pB1, 0), PKW(pB1, 2), PKW(pB1, 4), PKW(pB1, 6)}; pw3 = (u32x4){PKW(pB1, 8), PKW(pB1, 10), PKW(pB1, 12), PKW(pB1, 14)};
      const lds_cptr vp_ = vp0 + VSL(sl_cur); _Pragma("unroll") for (int i = 0; i < 8; ++i) VRD(i);
      o[0] = MFMA(PAF(0), VFR(0), o[0]); o[1] = MFMA(PAF(0), VFR(4), o[1]); o[0] = MFMA(PAF(1), VFR(1), o[0]); o[1] = MFMA(PAF(1), VFR(5), o[1]);
      o[0] = MFMA(PAF(2), VFR(2), o[0]); o[1] = MFMA(PAF(2), VFR(6), o[1]); o[0] = MFMA(PAF(3), VFR(3), o[0]); o[1] = MFMA(PAF(3), VFR(7), o[1]); }
    { auto rr = __builtin_amdgcn_permlane32_swap(__float_as_uint(l_reg), __float_as_uint(l_reg), false, false); l_reg = __uint_as_float(rr[0]) + __uint_as_float(rr[1]); }
    if (hi == 0) wsf[32 + r32] = l_reg; asm volatile("s_waitcnt lgkmcnt(0)" ::: "memory");
    float rli[16];
#pragma unroll
    for (int r = 0; r < 16; ++r) rli[r] = __builtin_amdgcn_rcpf(wsf[32 + crow(r, hi)]);
    bf16_t* stg = (bf16_t*)(lds + LDS_OST) + wid * 2048;
#pragma unroll
    for (int r = 0; r < 16; ++r) { const int orow = crow(r, hi);
#pragma unroll
        for (int d0 = 0; d0 < 2; ++d0) stg[orow * 64 + d0 * 32 + r32] = (bf16_t)f2bf(o[d0][r] * rli[r]); }
    asm volatile("s_waitcnt lgkmcnt(0)" ::: "memory");
#pragma unroll
    for (int i = 0; i < 4; ++i) { const int row = i * 8 + (lane >> 3), ch = lane & 7; const size_t goff = (size_t)(wid * 32 + row) * ldo + ch * 8;
        const u32x4 ov = *(const u32x4*)(stg + row * 64 + ch * 8); const u32x4 gv = *(const u32x4*)(G + goff); u32x4 w;
#pragma unroll
        for (int q = 0; q < 4; ++q) { const float lo = __uint_as_float(ov[q] << 16) * __uint_as_float(gv[q] << 16), hh = __uint_as_float(ov[q] & 0xffff0000u) * __uint_as_float(gv[q] & 0xffff0000u); w[q] = cvtpk(lo, hh); }
        *(u32x4*)(O + goff) = w; }
    asm volatile("s_waitcnt lgkmcnt(0)\n\ts_barrier" ::: "memory");
#undef DMA_K
#undef DMA_V
#undef VSL
#undef ROT
#undef EX
#undef KLOADALL
#undef PKW
#undef PAF
#undef VFR
#undef VRD
#undef KRD
#undef KRR
#undef GAPA4
#undef GAPA3
#undef GAPA31
#undef GAPA21
#undef GAPB
#undef STEP
#undef ENDW
}
#undef SBAR
#undef PIN
#undef MFMA
#undef WAIT_BAR
}

#include <hip/hip_cooperative_groups.h>
namespace cg = cooperative_groups;
constexpr int NWAVES = 8, NTHREADS = 512, LDS_BYTES = 147456, RING_BYTES = 131072;
constexpr size_t MiB = 1u << 20;
constexpr size_t WS_MOD = 1 * MiB;
constexpr size_t WS_TABA = WS_MOD + 128 * 1024;
constexpr size_t WS_TABB = WS_TABA + 32 * 1024;
constexpr size_t WS_WIN0 = 2 * MiB;
constexpr size_t WS_WOUT0 = 7 * MiB;
constexpr size_t WS_WIN1 = 9 * MiB;
constexpr size_t WS_WKVB = 13 * MiB;
constexpr size_t WS_WQB = 14 * MiB;
constexpr size_t WS_WOUT1 = 16 * MiB;
constexpr size_t WS_X1C = 18 * MiB;
constexpr size_t WS_H = 20 * MiB;
constexpr size_t WS_Q = 53 * MiB;
constexpr size_t WS_K = 86 * MiB;
constexpr size_t WS_V0 = 95 * MiB;
constexpr size_t WS_G = 120 * MiB;
constexpr size_t WS_V1 = 153 * MiB;
constexpr size_t WS_KVA = 186 * MiB;
constexpr size_t WS_QA = 195 * MiB;
constexpr size_t WS_Q1R = 207 * MiB;
constexpr size_t WS_KR = 223 * MiB;
constexpr size_t WS_SSKV = 225 * MiB;
constexpr size_t WS_SSQ = 226 * MiB;
constexpr size_t WS_SSH = 227 * MiB;
constexpr size_t WS_END = 256 * MiB;
static_assert(WS_K + (size_t)NB * TK * DM * 2 <= WS_G && WS_G + (size_t)MT * DM * 2 <= WS_V1 && WS_V1 + (size_t)NB * TK * DM * 2 <= WS_KVA && WS_SSH + (size_t)ML * 32 * 4 <= WS_END, "ws map");

struct Args { const float* in[23]; float* out; unsigned char* ws; int ph_lo, ph_hi, coop, pad; };

DEVI void phase0(const Args& a, unsigned char* ws, LAS unsigned char* lds, int vb, int G) {
    const int tid = threadIdx.x, wave = tid >> 6, lane = tid & 63;
    float* mod = (float*)(ws + WS_MOD);
    if (vb < 96) {
        LAS float* sc = (LAS float*)lds; LAS float* red = sc + 3 * 1024;
        const int layer = vb / 48, cs = vb % 48; const float* w = a.in[layer ? 11 : 4]; const float* bb = a.in[layer ? 12 : 5];
        for (int i = tid; i < 3072; i += NTHREADS) { const int r = i >> 10, k = i & 1023; const float v = r < 2 ? a.in[1][r * 1024 + k] : a.in[3][k]; sc[i] = v / (1.f + expf(-v)); }
        __syncthreads();
        const int col = cs * 64 + lane; float a0 = 0.f, a1 = 0.f, a2 = 0.f;
#pragma unroll 8
        for (int k = wave * 128; k < wave * 128 + 128; ++k) { const float wv = w[(size_t)k * 3072 + col]; a0 += sc[k] * wv; a1 += sc[1024 + k] * wv; a2 += sc[2048 + k] * wv; }
        red[(wave * 3 + 0) * 64 + lane] = a0; red[(wave * 3 + 1) * 64 + lane] = a1; red[(wave * 3 + 2) * 64 + lane] = a2;
        __syncthreads();
        if (tid < 192) { const int r = tid >> 6; float s = 0.f;
#pragma unroll
            for (int q = 0; q < 8; ++q) s += red[(q * 3 + r) * 64 + lane];
            mod[(size_t)(layer * 3 + r) * 3072 + col] = s + bb[col]; }
        __syncthreads();
    } else if (vb == 96) {
        f32x2* tabA = (f32x2*)(ws + WS_TABA); f32x2* tabB = (f32x2*)(ws + WS_TABB);
        for (int i = tid; i < 128 * 24; i += NTHREADS) {
            if (i < 128 * 16) { const int pos = i >> 4, f = i & 15; const float invf = powf(10000.f, -(float)f / 16.f); float cs_, sn_; sincos_pos((float)pos * invf, cs_, sn_); tabA[i] = (f32x2){cs_, sn_}; }
            else { const int j = i - 128 * 16, pos = j >> 3, f = j & 7; const float invf = powf(10000.f, -(float)f / 8.f); float cs_, sn_; sincos_pos((float)pos * invf, cs_, sn_); tabB[j] = (f32x2){cs_, sn_}; } }
    }
    struct WD { int src, K, Nsrc, Np, mode, ks; size_t dst; };
    const WD wd[6] = {{7, 1024, N_IN0, 2560, 1, -1, WS_WIN0}, {10, 1024, 1024, 1024, 0, -1, WS_WOUT0}, {14, 1024, N_IN1, N_IN1P, 2, -1, WS_WIN1},
                      {16, 256, 2048, 2048, 3, 15, WS_WKVB}, {18, 384, 1536, 2048, 4, 17, WS_WQB}, {22, 1024, 1024, 1024, 0, -1, WS_WOUT1}};
#pragma unroll
    for (int m = 0; m < 6; ++m) {
        const float* W = a.in[wd[m].src]; const float* ks = wd[m].ks >= 0 ? a.in[wd[m].ks] : nullptr; bf16_t* Bt = (bf16_t*)(ws + wd[m].dst);
        const int K = wd[m].K, Nsrc = wd[m].Nsrc, Np = wd[m].Np, total = Np * (K / 8);
        for (int i = vb * NTHREADS + tid; i < total; i += G * NTHREADS) {
            const int p = i % Np, k8 = i / Np; int cc = pg8::wmap(wd[m].mode, p); if (cc >= Nsrc) cc = -1;
            float v[8];
#pragma unroll
            for (int j = 0; j < 8; ++j) { const int k = k8 * 8 + j; v[j] = cc >= 0 ? W[(size_t)k * Nsrc + cc] * (ks ? ks[k] : 1.f) : 0.f; }
            u32x4 o; o.x = pk2(v[0], v[1]); o.y = pk2(v[2], v[3]); o.z = pk2(v[4], v[5]); o.w = pk2(v[6], v[7]);
            *(u32x4*)(Bt + (size_t)p * K + k8 * 8) = o;
        }
    }
}

DEVI void phase_prep(const float* xa, const float* xb, const float* nw, const float* mod, bf16_t* H, int gw, int NGW, int lane) {
    for (int row = gw; row < MT; row += NGW) {
        const int r = row < SEQ ? 0 : (row < ML ? 1 : 2);
        const float* src = row < ML ? xa + (size_t)row * DM : xb + (size_t)(row - ML) * DM;
        f32x4 v[4]; float ss = 0.f;
#pragma unroll
        for (int j = 0; j < 4; ++j) { v[j] = *(const f32x4*)(src + 4 * lane + 256 * j); ss += (v[j].x * v[j].x + v[j].y * v[j].y) + (v[j].z * v[j].z + v[j].w * v[j].w); }
        const float rinv = rsqrtf(wave_sum(ss) * (1.f / DM) + EPS);
#pragma unroll
        for (int j = 0; j < 4; ++j) { const int cidx = 4 * lane + 256 * j; const f32x4 w = *(const f32x4*)(nw + cidx);
            const f32x4 sh = *(const f32x4*)(mod + (size_t)r * 3072 + cidx), scl = *(const f32x4*)(mod + (size_t)r * 3072 + 1024 + cidx);
            const f32x4 h = (v[j] * rinv) * w * (scl + 1.f) + sh;
            u32x2 o; o.x = pk2(h.x, h.y); o.y = pk2(h.z, h.w); *(u32x2*)(H + (size_t)row * DM + cidx) = o; }
    }
}

__global__ void __launch_bounds__(NTHREADS, 2) mega(Args a) {
    extern __shared__ __attribute__((aligned(16))) unsigned char lds[];
    const int tid = threadIdx.x, lane = tid & 63; const int wave = __builtin_amdgcn_readfirstlane(tid >> 6);
    const int G = gridDim.x, bx = blockIdx.x; const int vcu = (G % 8 == 0) ? (bx % 8) * (G / 8) + bx / 8 : bx;
    unsigned char* ws = a.ws; float* out = a.out;
    const float* x = a.in[0]; const float* ctx = a.in[2];
    float* mod = (float*)(ws + WS_MOD); const f32x4* tabA = (const f32x4*)(ws + WS_TABA); const f32x4* tabB = (const f32x4*)(ws + WS_TABB);
    bf16_t* H = (bf16_t*)(ws + WS_H); bf16_t* Qb = (bf16_t*)(ws + WS_Q); bf16_t* K0 = (bf16_t*)(ws + WS_K); bf16_t* V0 = (bf16_t*)(ws + WS_V0); bf16_t* K1 = (bf16_t*)(ws + WS_K);
    bf16_t* Gb = (bf16_t*)(ws + WS_G); bf16_t* V1 = (bf16_t*)(ws + WS_V1); bf16_t* KVA = (bf16_t*)(ws + WS_KVA); bf16_t* QA = (bf16_t*)(ws + WS_QA); bf16_t* Q1R = (bf16_t*)(ws + WS_Q1R);
    bf16_t* KR = (bf16_t*)(ws + WS_KR); float* SSKV = (float*)(ws + WS_SSKV); float* SSQ = (float*)(ws + WS_SSQ); float* SSH = (float*)(ws + WS_SSH); float* X1c = (float*)(ws + WS_X1C);
    const int lo = a.ph_lo, hi_ = a.ph_hi;
#ifndef ONLY_PHASE
#define ONLY_PHASE -1
#endif
#define IN(k) ((ONLY_PHASE < 0 || ONLY_PHASE == (k)) && lo <= (k) && (k) < hi_)
#define SEAM(k) do { if (IN(k) && IN((k) + 1)) { cg::this_grid().sync(); } } while (0)
    PG8_LAS unsigned char* ring = (PG8_LAS unsigned char*)lds;

    if (IN(0)) { phase0(a, ws, (LAS unsigned char*)lds, bx, G); } SEAM(0);
    if (IN(1)) { phase_prep(x, ctx, a.in[6], mod, H, vcu * NWAVES + wave, G * NWAVES, lane); } SEAM(1);
    if (IN(2)) { pg8::Gemm g{H, (const bf16_t*)(ws + WS_WIN0), MT, N_IN0, 1024}; pg8::ROrder S; S.init(0, MT / 256, N_IN0, G, bx);
        pg8::EpiIn0 E{a.in[8], a.in[9], tabA, K0, V0, Qb, Gb};
        pg8::gemm_phase<pg8::EpiIn0, pg8::ROrder, true, true>(ring, g, S, E); } SEAM(2);
    if (IN(3)) {
        const int xg = vcu >> 5, c = vcu & 31, b = xg >> 2, kvh = xg & 3; const size_t kbase = (size_t)b * TK * 256 + kvh * 64;
        for (int i = 0; i < 4; ++i) { const int h = kvh * 4 + i; const size_t q0 = ((size_t)b * SEQ + c * 256) * DM + h * 64;
            afast::attn_unit<0>(Qb + q0, DM, nullptr, nullptr, K0 + kbase, 256, nullptr, V0 + kbase, 256, TK / 64, Qb + q0, Gb + q0, DM, (char*)lds); }
        if (c < 4) { const int h = kvh * 4 + c; const size_t q0 = ((size_t)ML + b * CTXL) * DM + h * 64;
            afast::attn_unit<0>(Qb + q0, DM, nullptr, nullptr, K0 + kbase, 256, nullptr, V0 + kbase, 256, CTXL / 64, Qb + q0, Gb + q0, DM, (char*)lds); }
    } SEAM(3);
    if (IN(4)) { pg8::Gemm g{Qb, (const bf16_t*)(ws + WS_WOUT0), MT, 1024, 1024}; pg8::ROrder S; S.init(0, MT / 256, 1024, G, bx);
        pg8::EpiOut E{x, ctx, out, X1c, mod + 2048};
        pg8::gemm_phase<pg8::EpiOut, pg8::ROrder, true, true>(ring, g, S, E); } SEAM(4);
    if (IN(5)) { phase_prep(out, X1c, a.in[13], mod + 3 * 3072, H, vcu * NWAVES + wave, G * NWAVES, lane); } SEAM(5);
    if (IN(6)) { pg8::Gemm g{H, (const bf16_t*)(ws + WS_WIN1), MT, N_IN1P, 1024}; pg8::In1Order S; S.init(G, bx);
        pg8::EpiIn1 E{a.in[21], tabB, KVA, SSKV, QA, SSQ, KR, Gb};
        pg8::gemm_phase<pg8::EpiIn1, pg8::In1Order, true, true>(ring, g, S, E); } SEAM(6);
    if (IN(7)) {
        { pg8::Gemm g{KVA, (const bf16_t*)(ws + WS_WKVB), MT, 2048, 256}; pg8::ROrder S; S.init(0, MT / 256, 2048, G, bx);
          pg8::EpiKvb E{SSKV, a.in[20], K1, V1};
          pg8::gemm_phase<pg8::EpiKvb, pg8::ROrder, true, true>(ring, g, S, E); }
        { pg8::Gemm g{QA, (const bf16_t*)(ws + WS_WQB), ML, 2048, 384}; pg8::ROrder S; S.init(0, ML / 256, 2048, G, bx);
          pg8::EpiQb E{SSQ, a.in[19], tabB, Qb, Q1R, SSH};
          pg8::gemm_phase<pg8::EpiQb, pg8::ROrder, true, true>(ring, g, S, E); }
    } SEAM(7);
    if (IN(8)) {
        const int xg = vcu >> 5, c = vcu & 31;
        for (int i = 0; i < 4; ++i) { const int s = xg + 8 * i, b = s >> 4, h = s & 15; const size_t row0 = (size_t)b * SEQ + c * 256, q0 = row0 * DM + h * 64;
            afast::attn_unit<1>(Qb + q0, DM, Q1R + row0 * 512 + h * 32, SSH + (row0 * 16 + h) * 2, K1 + (size_t)b * TK * DM + h * 64, DM, KR + (size_t)b * TK * 32,
                                V1 + (size_t)b * TK * DM + h * 64, DM, TK / 64, Qb + q0, Gb + q0, DM, (char*)lds); }
    } SEAM(8);
    if (IN(9)) { pg8::Gemm g{Qb, (const bf16_t*)(ws + WS_WOUT1), ML, 1024, 1024}; pg8::ROrder S; S.init(0, ML / 256, 1024, G, bx);
        pg8::EpiOut E{out, nullptr, out, nullptr, mod + 3 * 3072 + 2048};
        pg8::gemm_phase<pg8::EpiOut, pg8::ROrder, true, true>(ring, g, S, E); }
#undef IN
#undef SEAM
}

constexpr int NPHASE = 10;
#ifndef MK_ONE_LAUNCH
#define MK_ONE_LAUNCH 1
#endif
extern "C" void kernel_launch(void* const* d_in, const int* in_sizes, int n_in, void* d_out, int out_size, void* d_ws, size_t ws_size, hipStream_t stream) {
    static int grid = 0;
    if (grid == 0) {
        if (n_in != 23 || out_size != ML * DM || ws_size < WS_END) { fprintf(stderr, "kernel_launch: unexpected shapes n_in %d out %d ws %zu\n", n_in, out_size, ws_size); grid = -1; return; }
        int dev = 0, cus = 0, per_cu = 0;
        if (hipGetDevice(&dev) != hipSuccess || hipDeviceGetAttribute(&cus, hipDeviceAttributeMultiprocessorCount, dev) != hipSuccess) { grid = -1; return; }
        if (hipFuncSetAttribute((const void*)mega, hipFuncAttributeMaxDynamicSharedMemorySize, LDS_BYTES) != hipSuccess) { fprintf(stderr, "kernel_launch: hipFuncSetAttribute failed\n"); grid = -1; return; }
        if (hipOccupancyMaxActiveBlocksPerMultiprocessor(&per_cu, (const void*)mega, NTHREADS, LDS_BYTES) != hipSuccess || per_cu < 1) { fprintf(stderr, "kernel_launch: occupancy query says %d\n", per_cu); grid = -1; return; }
        grid = cus;
        if (grid != 256) fprintf(stderr, "kernel_launch: %d CUs (built for 256)\n", grid);
    }
    if (grid < 0) return;
    Args a{};
    for (int i = 0; i < 23; ++i) a.in[i] = (const float*)d_in[i];
    a.out = (float*)d_out; a.ws = (unsigned char*)d_ws;
#if MK_ONE_LAUNCH
    a.ph_lo = 0; a.ph_hi = NPHASE; a.coop = 1;
    void* args[] = {&a};
    const hipError_t e = hipLaunchCooperativeKernel((const void*)mega, dim3(grid), dim3(NTHREADS), args, LDS_BYTES, stream);
    if (e != hipSuccess) fprintf(stderr, "kernel_launch: cooperative launch failed: %s (grid %d)\n", hipGetErrorString(e), grid);
#else
    for (int p = 0; p < NPHASE; ++p) { a.ph_lo = p; a.ph_hi = p + 1; a.coop = 0; hipLaunchKernelGGL(mega, dim3(grid), dim3(NTHREADS), LDS_BYTES, stream, a); }
    const hipError_t le = hipPeekAtLastError();
    if (le != hipSuccess) fprintf(stderr, "kernel_launch: launch failed: %s\n", hipGetErrorName(le));
#endif
}
```

```cpp
#include <hip/hip_runtime.h>
#include <hip/hip_bf16.h>
#include <cstdio>
#include <cstdint>

#define DEVI __device__ __forceinline__
#define LAS __attribute__((address_space(3)))
#define GAS __attribute__((address_space(1)))

constexpr int NB = 2, SEQ = 8192, DM = 1024, CTXL = 256, TK = SEQ + CTXL;
constexpr int ML = NB * SEQ, MC = NB * CTXL, MT = ML + MC;
constexpr int GRIDW = 64;
constexpr float EPS = 1e-6f;
constexpr float LOG2E = 1.4426950408889634f;
constexpr int N_IN0 = 2560, N_IN1 = 1696, N_IN1P = 1792;
constexpr float C2_GQA = 0.125f * LOG2E;
constexpr float C2_MLA = 0.10206207261596575f * LOG2E;

typedef unsigned short bf16_t;
typedef short bf16x8 __attribute__((ext_vector_type(8)));
typedef short s16x4 __attribute__((ext_vector_type(4)));
typedef float f32x4 __attribute__((ext_vector_type(4)));
typedef float f32x2 __attribute__((ext_vector_type(2)));
typedef float f32x16 __attribute__((ext_vector_type(16)));
typedef unsigned u32x4 __attribute__((ext_vector_type(4)));
typedef unsigned u32x2 __attribute__((ext_vector_type(2)));

DEVI float bf2f(bf16_t v) { return __uint_as_float((unsigned)v << 16); }
DEVI unsigned f2bf(float f) { unsigned u = __float_as_uint(f); return (u + 0x7fffu + ((u >> 16) & 1u)) >> 16; }
DEVI unsigned pk2(float lo, float hi) { return f2bf(lo) | (f2bf(hi) << 16); }
DEVI float wave_sum(float v) {
#pragma unroll
    for (int o = 1; o < 64; o <<= 1) v += __shfl_xor(v, o);
    return v;
}
DEVI float silu_f(float v) { return v / (1.f + __expf(-v)); }
namespace pg8 {
#define PG8_LAS __attribute__((address_space(3)))
typedef unsigned short bf16_t;
typedef short bf16x8 __attribute__((ext_vector_type(8)));
typedef float f32x4 __attribute__((ext_vector_type(4)));
typedef unsigned u32x4 __attribute__((ext_vector_type(4)));
constexpr int BM = 256, BK = 64, HALF = 128, HTB = HALF * BK * 2  , STAGE_BYTES = 8 * HTB, NXCD = 8, WGM = 8;

__host__ __device__ __forceinline__ int lds_byte(int r, int c) { const int st = (r >> 4) * 2 + (c >> 5), rr = r & 15, cc = c & 31, ob = rr * 64 + cc * 2; return st * 1024 + (ob ^ (((ob >> 9) & 1) << 5)); }
__host__ __device__ __forceinline__ void stage_rc(int b, int& R, int& C) { const int st = b / 1024, sb = b % 1024, swz = sb ^ (((sb >> 9) & 1) << 5); R = (st >> 1) * 16 + swz / 64; C = (st & 1) * 32 + (swz % 64) / 2; }
__host__ __device__ __forceinline__ int perm32(int rho) { const int n = rho >> 4, i = rho & 15; return 8 * (i >> 2) + 4 * n + (i & 3); }

struct Unit { int pm, pn; };
struct Gemm { const bf16_t* A; const bf16_t* Bt; int M, N, K; };

struct StaticOrder {
    int nM, nN, nwg, G, c;
    __host__ __device__ void init(int M, int N, int G_, int c_) { nM = M / BM; nN = N / BM; nwg = nM * nN; G = G_; c = c_; }
    __host__ __device__ bool next(int i, Unit& u) const {
        const long L = (long)i * G + c; if (L >= nwg) return false;
        int wgid = (int)L; { const int q = nwg / NXCD, r = nwg % NXCD, xcd = wgid % NXCD, off = wgid / NXCD; wgid = (xcd < r ? xcd * (q + 1) : r * (q + 1) + (xcd - r) * q) + off; }
        const int nig = WGM * nN, gid = wgid / nig, fm = gid * WGM, gsz = (nM - fm) < WGM ? (nM - fm) : WGM;
        u.pm = fm + ((wgid % nig) % gsz); u.pn = (wgid % nig) / gsz; return true;
    }
    __device__ __forceinline__ void a_ready(const Unit&) const {}
    __device__ __forceinline__ void done(const Unit&) const {}
};


struct ROrder {
    int pm0, nM, nN, nwg, G, c;
    __host__ __device__ void init(int pm0_, int npm, int N, int G_, int c_) { pm0 = pm0_; nM = npm; nN = N / BM; nwg = nM * nN; G = G_; c = c_; }
    __host__ __device__ bool next(int i, Unit& u) const {
        const long L = (long)i * G + c; if (L >= nwg) return false;
        int wgid = (int)L; { const int q = nwg / NXCD, r = nwg % NXCD, xcd = wgid % NXCD, off = wgid / NXCD; wgid = (xcd < r ? xcd * (q + 1) : r * (q + 1) + (xcd - r) * q) + off; }
        const int nig = WGM * nN, gid = wgid / nig, fm = gid * WGM, gsz = (nM - fm) < WGM ? (nM - fm) : WGM;
        u.pm = pm0 + fm + ((wgid % nig) % gsz); u.pn = (wgid % nig) / gsz; return true;
    }
    __device__ __forceinline__ void a_ready(const Unit&) const {}
    __device__ __forceinline__ void done(const Unit&) const {}
};

struct EpiF32 {
    static constexpr bool PERM = true, AFTER_DRAIN = false;
    float* O; int ldc; int pmbase;
    __device__ __forceinline__ void operator()(const f32x4 (&acc)[2][2][4][2], const Unit& u, int wr, int wc, int fr, int fq) const {
        const int row0 = (u.pm - pmbase) * BM + wr * 64 + fr, col0 = u.pn * BM + wc * 32 + 8 * fq;
#pragma unroll
        for (int ai = 0; ai < 2; ++ai)
#pragma unroll
            for (int m = 0; m < 4; ++m) { float* rowp = O + (size_t)(row0 + ai * HALF + m * 16) * ldc + col0;
#pragma unroll
                for (int bj = 0; bj < 2; ++bj) { *(f32x4*)(rowp + bj * HALF) = acc[ai][bj][m][0]; *(f32x4*)(rowp + bj * HALF + 4) = acc[ai][bj][m][1]; } }
    }
};

DEVI unsigned cvt_pk_bf16(float lo, float hi) { unsigned r; asm volatile("v_cvt_pk_bf16_f32 %0, %1, %2" : "=v"(r) : "v"(lo), "v"(hi)); return r; }
DEVI u32x4 pack8(const f32x4 a, const f32x4 b) { u32x4 w; w.x = cvt_pk_bf16(a[0], a[1]); w.y = cvt_pk_bf16(a[2], a[3]); w.z = cvt_pk_bf16(b[0], b[1]); w.w = cvt_pk_bf16(b[2], b[3]); return w; }
DEVI float quad_sum(float s) { s += __shfl_xor(s, 16); s += __shfl_xor(s, 32); return s; }
DEVI float sq4(const f32x4 v) { return (v[0] * v[0] + v[1] * v[1]) + (v[2] * v[2] + v[3] * v[3]); }
DEVI f32x4 silu4(const f32x4 v) { f32x4 o; o[0] = silu_f(v[0]); o[1] = silu_f(v[1]); o[2] = silu_f(v[2]); o[3] = silu_f(v[3]); return o; }
DEVI int key_slot(int R) { return R < ML ? (R >> 13) * TK + CTXL + (R & (SEQ - 1)) : ((R - ML) >> 8) * TK + ((R - ML) & 255); }
DEVI void rot4(f32x4& x1, f32x4& x2, const f32x4 cs01, const f32x4 cs23) {
    const f32x4 c = {cs01[0], cs01[2], cs23[0], cs23[2]}, s = {cs01[1], cs01[3], cs23[1], cs23[3]};
    const f32x4 a = x1 * c - x2 * s, b = x2 * c + x1 * s; x1 = a; x2 = b;
}

DEVI int drope32(int i) { const int fq = i >> 3, n = (i >> 2) & 1, j = i & 3; return 16 * (fq >> 1) + 8 * n + 4 * (fq & 1) + j; }
DEVI int wmap(int mode, int p) {
    const int pn = p >> 8, q = p & 255, bj = q >> 7, wc = (q >> 5) & 3, i = q & 31;
    switch (mode) {
    case 1: {
        if (pn == 0 || (pn >= 2 && pn <= 5)) { const int fq = i >> 3, n = (i >> 2) & 1, j = i & 3; return 256 * pn + 64 * wc + 32 * bj + 16 * n + 4 * fq + j; }
        return p; }
    case 2: {
        if (pn == 0) return q;
        if (pn == 1) return 288 + q;
        if (pn == 2) { if (wc < 2) return 288 + 256 + 64 * wc + 32 * bj + i; if (wc == 2 && bj == 0) return 256 + drope32(i); return -1; }
        return 672 + 256 * (pn - 3) + q; }
    case 3: { const int head = 2 * pn + (wc >> 1), type = wc & 1; return 128 * head + 64 * type + 32 * bj + i; }
    case 4: { const int head = 2 * pn + (wc >> 1), type = wc & 1; if (type == 0) return 96 * head + 32 * bj + i; return bj == 0 ? 96 * head + 64 + drope32(i) : -1; }
    default: return p;
    }
}

struct EpiIn0 {
    static constexpr bool PERM = true, AFTER_DRAIN = false;
    const float* qn; const float* kn; const f32x4* tabA; bf16_t* K0; bf16_t* V0; bf16_t* Q0; bf16_t* G0;
    __device__ __forceinline__ void operator()(const f32x4 (&acc)[2][2][4][2], const Unit& u, int wr, int wc, int fr_, int fq_) const {
        int fr = fr_, fq = fq_; asm volatile("" : "+v"(fr), "+v"(fq));
        const int pn = u.pn; const bool lat = u.pm < ML / BM;
        if (pn == 0 || (pn >= 2 && pn <= 5)) {
            const float* wsrc = pn == 0 ? kn : qn; const float outs = pn == 0 ? 1.f : C2_GQA;
            f32x4 wv[2][2];
#pragma unroll
            for (int bj = 0; bj < 2; ++bj)
#pragma unroll
                for (int n = 0; n < 2; ++n) wv[bj][n] = *(const f32x4*)(wsrc + 32 * bj + 16 * n + 4 * fq) * outs;
#pragma unroll
            for (int ai = 0; ai < 2; ++ai)
#pragma unroll
                for (int m = 0; m < 4; ++m) {
                    const int R = u.pm * BM + ai * HALF + wr * 64 + m * 16 + fr;
                    f32x4 x[2][2]; float ss = 0.f;
#pragma unroll
                    for (int bj = 0; bj < 2; ++bj)
#pragma unroll
                        for (int n = 0; n < 2; ++n) { x[bj][n] = acc[ai][bj][m][n]; ss += sq4(x[bj][n]); }
                    const float rinv = rsqrtf(quad_sum(ss) * (1.f / 64.f) + EPS);
#pragma unroll
                    for (int bj = 0; bj < 2; ++bj)
#pragma unroll
                        for (int n = 0; n < 2; ++n) x[bj][n] = x[bj][n] * rinv * wv[bj][n];
                    if (lat) { const int t = R & (SEQ - 1), trow = t >> 6, tcol = t & 63;
                        const f32x4* tr = tabA + (trow * 16 + 4 * fq) / 2; const f32x4* tc = tabA + (tcol * 16 + 4 * fq) / 2;
                        rot4(x[0][0], x[0][1], tr[0], tr[1]); rot4(x[1][0], x[1][1], tc[0], tc[1]); }
                    if (pn == 0) { bf16_t* dst = K0 + (size_t)key_slot(R) * 256 + wc * 64 + 8 * fq;
                        *(u32x4*)dst = pack8(x[0][0], x[0][1]); *(u32x4*)(dst + 32) = pack8(x[1][0], x[1][1]); }
                    else { bf16_t* dst = Q0 + (size_t)R * DM + ((pn - 2) * 4 + wc) * 64 + 8 * fq;
                        *(u32x4*)dst = pack8(x[0][0], x[0][1]); *(u32x4*)(dst + 32) = pack8(x[1][0], x[1][1]); }
                }
        } else if (pn == 1) {
#pragma unroll
            for (int ai = 0; ai < 2; ++ai)
#pragma unroll
                for (int m = 0; m < 4; ++m) { const int R = u.pm * BM + ai * HALF + wr * 64 + m * 16 + fr; bf16_t* dst = V0 + (size_t)key_slot(R) * 256 + wc * 32 + 8 * fq;
#pragma unroll
                    for (int bj = 0; bj < 2; ++bj) *(u32x4*)(dst + bj * HALF) = pack8(acc[ai][bj][m][0], acc[ai][bj][m][1]); }
        } else {
#pragma unroll
            for (int ai = 0; ai < 2; ++ai)
#pragma unroll
                for (int m = 0; m < 4; ++m) { const int R = u.pm * BM + ai * HALF + wr * 64 + m * 16 + fr; bf16_t* dst = G0 + (size_t)R * DM + (pn - 6) * BM + wc * 32 + 8 * fq;
#pragma unroll
                    for (int bj = 0; bj < 2; ++bj) *(u32x4*)(dst + bj * HALF) = pack8(silu4(acc[ai][bj][m][0]), silu4(acc[ai][bj][m][1])); }
        }
    }
};

struct EpiOut {
    static constexpr bool PERM = true, AFTER_DRAIN = false;
    const float* baseL; const float* baseC; float* dstL; float* dstC; const float* gate;
    __device__ __forceinline__ void operator()(const f32x4 (&acc)[2][2][4][2], const Unit& u, int wr, int wc, int fr_, int fq_) const {
        int fr = fr_, fq = fq_; asm volatile("" : "+v"(fr), "+v"(fq));
        const int col0 = u.pn * BM + wc * 32 + 8 * fq;
#pragma unroll
        for (int ai = 0; ai < 2; ++ai)
#pragma unroll
            for (int m = 0; m < 4; ++m) { const int R = u.pm * BM + ai * HALF + wr * 64 + m * 16 + fr; const int r = R < SEQ ? 0 : (R < ML ? 1 : 2);
                const float* b = R < ML ? baseL + (size_t)R * DM : baseC + (size_t)(R - ML) * DM; float* d = R < ML ? dstL + (size_t)R * DM : dstC + (size_t)(R - ML) * DM;
                const float* g = gate + (size_t)r * 3072;
#pragma unroll
                for (int bj = 0; bj < 2; ++bj)
#pragma unroll
                    for (int n = 0; n < 2; ++n) { const int c = col0 + bj * HALF + 4 * n; *(f32x4*)(d + c) = *(const f32x4*)(b + c) + *(const f32x4*)(g + c) * acc[ai][bj][m][n]; } }
    }
};

struct EpiIn1 {
    static constexpr bool PERM = true, AFTER_DRAIN = false;
    const float* krn; const f32x4* tabB; bf16_t* KVA; float* SSKV; bf16_t* QA; float* SSQ; bf16_t* KR; bf16_t* G1;
    __device__ __forceinline__ void operator()(const f32x4 (&acc)[2][2][4][2], const Unit& u, int wr, int wc, int fr_, int fq_) const {
        int fr = fr_, fq = fq_; asm volatile("" : "+v"(fr), "+v"(fq));
        const int pn = u.pn; const bool lat = u.pm < ML / BM;
        if (pn >= 3) {
#pragma unroll
            for (int ai = 0; ai < 2; ++ai)
#pragma unroll
                for (int m = 0; m < 4; ++m) { const int R = u.pm * BM + ai * HALF + wr * 64 + m * 16 + fr; bf16_t* dst = G1 + (size_t)R * DM + (pn - 3) * BM + wc * 32 + 8 * fq;
#pragma unroll
                    for (int bj = 0; bj < 2; ++bj) *(u32x4*)(dst + bj * HALF) = pack8(silu4(acc[ai][bj][m][0]), silu4(acc[ai][bj][m][1])); }
        } else if (pn == 2 && wc == 2) {
            f32x4 wv[2];
#pragma unroll
            for (int n = 0; n < 2; ++n) wv[n] = *(const f32x4*)(krn + 16 * (fq >> 1) + 8 * n + 4 * (fq & 1));
#pragma unroll
            for (int ai = 0; ai < 2; ++ai)
#pragma unroll
                for (int m = 0; m < 4; ++m) { const int R = u.pm * BM + ai * HALF + wr * 64 + m * 16 + fr;
                    f32x4 x0 = acc[ai][0][m][0], x1 = acc[ai][0][m][1];
                    const float rinv = rsqrtf(quad_sum(sq4(x0) + sq4(x1)) * (1.f / 32.f) + EPS);
                    x0 = x0 * rinv * wv[0]; x1 = x1 * rinv * wv[1];
                    if (lat) { const int t = R & (SEQ - 1); const int pos = (fq >> 1) ? (t & 63) : (t >> 6); const f32x4* tp = tabB + (pos * 8 + 4 * (fq & 1)) / 2; rot4(x0, x1, tp[0], tp[1]); }
                    *(u32x4*)(KR + (size_t)key_slot(R) * 32 + 8 * fq) = pack8(x0, x1); }
        } else if (pn == 2 && wc == 3) {
        } else if (pn == 0 || lat) {
            bf16_t* base; float* ssb; int ld, cbase, nss, iss;
            if (pn == 0) { base = KVA; ld = 256; cbase = wc * 32; ssb = SSKV; nss = 4; iss = wc; }
            else if (pn == 1) { base = QA; ld = 384; cbase = wc * 32; ssb = SSQ; nss = 6; iss = wc; }
            else { base = QA; ld = 384; cbase = 256 + wc * 64; ssb = SSQ; nss = 6; iss = 4 + wc; }
            const int bjs = pn == 2 ? 32 : HALF;
#pragma unroll
            for (int ai = 0; ai < 2; ++ai)
#pragma unroll
                for (int m = 0; m < 4; ++m) { const int R = u.pm * BM + ai * HALF + wr * 64 + m * 16 + fr; bf16_t* dst = base + (size_t)R * ld + cbase + 8 * fq; float ss = 0.f;
#pragma unroll
                    for (int bj = 0; bj < 2; ++bj) { ss += sq4(acc[ai][bj][m][0]) + sq4(acc[ai][bj][m][1]); *(u32x4*)(dst + bj * bjs) = pack8(acc[ai][bj][m][0], acc[ai][bj][m][1]); }
                    ss = quad_sum(ss); if (fq == 0) ssb[(size_t)R * nss + iss] = ss; }
        }
    }
};

struct EpiKvb {
    static constexpr bool PERM = true, AFTER_DRAIN = false;
    const float* SSKV; const float* knn; bf16_t* K1; bf16_t* V1;
    __device__ __forceinline__ void operator()(const f32x4 (&acc)[2][2][4][2], const Unit& u, int wr, int wc, int fr_, int fq_) const {
        int fr = fr_, fq = fq_; asm volatile("" : "+v"(fr), "+v"(fq));
        const int head = 2 * u.pn + (wc >> 1), type = wc & 1;
#pragma unroll
        for (int ai = 0; ai < 2; ++ai)
#pragma unroll
            for (int m = 0; m < 4; ++m) { const int R = u.pm * BM + ai * HALF + wr * 64 + m * 16 + fr;
                asm volatile("" ::: "memory");
                const f32x4 s4 = *(const f32x4*)(SSKV + (size_t)R * 4); const float rkv = rsqrtf(((s4[0] + s4[1]) + (s4[2] + s4[3])) * (1.f / 256.f) + EPS);
                f32x4 x[2][2]; float ss = 0.f;
#pragma unroll
                for (int bj = 0; bj < 2; ++bj)
#pragma unroll
                    for (int n = 0; n < 2; ++n) { x[bj][n] = acc[ai][bj][m][n] * rkv; ss += sq4(x[bj][n]); }
                bf16_t* dst = (type == 0 ? K1 : V1) + (size_t)key_slot(R) * DM + head * 64 + 8 * fq;
                if (type == 0) { const float rinv = rsqrtf(quad_sum(ss) * (1.f / 64.f) + EPS);
#pragma unroll
                    for (int bj = 0; bj < 2; ++bj)
#pragma unroll
                        for (int n = 0; n < 2; ++n) x[bj][n] = x[bj][n] * rinv * *(const f32x4*)(knn + 32 * bj + 8 * fq + 4 * n); }
                *(u32x4*)dst = pack8(x[0][0], x[0][1]); *(u32x4*)(dst + 32) = pack8(x[1][0], x[1][1]); }
    }
};

struct EpiQb {
    static constexpr bool PERM = true, AFTER_DRAIN = false;
    const float* SSQ; const float* qnw; const f32x4* tabB; bf16_t* Q1N; bf16_t* Q1R; float* SSH;
    __device__ __forceinline__ float rqa_of(int R) const { const float* sp = SSQ + (size_t)R * 6; const f32x2 sa = *(const f32x2*)sp, sb = *(const f32x2*)(sp + 2), sc = *(const f32x2*)(sp + 4);
        return rsqrtf(((sa[0] + sa[1]) + (sb[0] + sb[1]) + (sc[0] + sc[1])) * (1.f / 384.f) + EPS); }
    __device__ __forceinline__ void operator()(const f32x4 (&acc)[2][2][4][2], const Unit& u, int wr, int wc, int fr_, int fq_) const {
        int fr = fr_, fq = fq_; asm volatile("" : "+v"(fr), "+v"(fq));
        const int head = 2 * u.pn + (wc >> 1);
        if ((wc & 1) == 0) {
#pragma unroll
            for (int ai = 0; ai < 2; ++ai)
#pragma unroll
                for (int m = 0; m < 4; ++m) { const int R = u.pm * BM + ai * HALF + wr * 64 + m * 16 + fr;
                    asm volatile("" ::: "memory");
                    const float rqa = rqa_of(R); float ss = 0.f; bf16_t* dst = Q1N + (size_t)R * DM + head * 64 + 8 * fq;
#pragma unroll
                    for (int bj = 0; bj < 2; ++bj) { f32x4 x0 = acc[ai][bj][m][0] * rqa, x1 = acc[ai][bj][m][1] * rqa; ss += sq4(x0) + sq4(x1);
                        x0 = x0 * *(const f32x4*)(qnw + 32 * bj + 8 * fq); x1 = x1 * *(const f32x4*)(qnw + 32 * bj + 8 * fq + 4); *(u32x4*)(dst + 32 * bj) = pack8(x0, x1); }
                    ss = quad_sum(ss); if (fq == 0) SSH[((size_t)R * 16 + head) * 2] = ss; }
        } else {
#pragma unroll
            for (int ai = 0; ai < 2; ++ai)
#pragma unroll
                for (int m = 0; m < 4; ++m) { const int R = u.pm * BM + ai * HALF + wr * 64 + m * 16 + fr;
                    asm volatile("" ::: "memory");
                    const float rqa = rqa_of(R);
                    f32x4 x0 = acc[ai][0][m][0] * rqa, x1 = acc[ai][0][m][1] * rqa; const float ss = quad_sum(sq4(x0) + sq4(x1)); if (fq == 0) SSH[((size_t)R * 16 + head) * 2 + 1] = ss;
                    const float* wp = qnw + 64 + 16 * (fq >> 1) + 4 * (fq & 1); x0 = x0 * *(const f32x4*)wp; x1 = x1 * *(const f32x4*)(wp + 8);
                    const int t = R & (SEQ - 1); const int pos = (fq >> 1) ? (t & 63) : (t >> 6); const f32x4* tp = tabB + (pos * 8 + 4 * (fq & 1)) / 2; rot4(x0, x1, tp[0], tp[1]);
                    *(u32x4*)(Q1R + (size_t)R * 512 + head * 32 + 8 * fq) = pack8(x0, x1); }
        }
    }
};

struct In1Order {
    int G, c; ROrder lat;
    __host__ __device__ void init(int G_, int c_) { G = G_; c = c_; lat.init(0, ML / BM, N_IN1P, G_, c_); }
    __host__ __device__ bool next(int i, Unit& u) const {
        const long L = (long)i * G + c; if (L < lat.nwg) return lat.next(i, u);
        const int e = (int)(L - lat.nwg); if (e >= 4) return false; u.pm = ML / BM + (e >> 1); u.pn = (e & 1) * 2; return true;
    }
    __device__ __forceinline__ void a_ready(const Unit&) const {}
    __device__ __forceinline__ void done(const Unit&) const {}
};
template <class Epi, class Sched, bool ALIGN_EPI = false, bool SP2 = false>
__device__ __forceinline__ void gemm_phase(PG8_LAS unsigned char* lds, const Gemm g, const Sched& S, const Epi& E) {
    const int tid = threadIdx.x, wid = __builtin_amdgcn_readfirstlane(tid >> 6), lane = tid & 63, wr = wid >> 2, wc = wid & 3, fr = lane & 15, fq = lane >> 4;
    const int K = g.K, nt = K / BK;
    unsigned voffA[2], voffB[2];
#pragma unroll
    for (int i = 0; i < 2; ++i) { int R, C; stage_rc(tid * 16 + i * 8192, R, C); const int Rb = Epi::PERM ? ((R & ~31) + perm32(R & 31)) : R;
        voffA[i] = (unsigned)(R * K + C) * 2u; voffB[i] = (unsigned)(Rb * K + C) * 2u; }
    const size_t kstep = (size_t)(BK * 2);
    const size_t hstep = (size_t)HALF * K * 2;
    const size_t tstep = 2 * hstep;
    const unsigned ldsw = (unsigned)wid * 1024u;
    const int aoff = lds_byte(wr * 64 + fr, fq * 8), boff = lds_byte(wc * 32 + fr, fq * 8);
#define PG8_SA(b, h) (((b) * 2 + (h)) * HTB)
#define PG8_SB(b, h) ((4 + (b) * 2 + (h)) * HTB)
#define PG8_STAGE(bufoff, gbase, voff) do { _Pragma("unroll") for (int _i = 0; _i < 2; ++_i) \
        __builtin_amdgcn_global_load_lds((const unsigned*)((const char*)(gbase) + (voff)[_i]), (PG8_LAS unsigned*)(lds + (bufoff) + ldsw + _i * 8192), 16, 0, 0); } while (0)
#define PG8_LDA(dst, b, h) do { _Pragma("unroll") for (int m = 0; m < 4; ++m) _Pragma("unroll") for (int k = 0; k < 2; ++k) dst[m][k] = *(const PG8_LAS bf16x8*)(lds + PG8_SA(b, h) + aoff + m * 2048 + k * 1024); } while (0)
#define PG8_LDB(dst, b, h) do { _Pragma("unroll") for (int n = 0; n < 2; ++n) _Pragma("unroll") for (int k = 0; k < 2; ++k) dst[n][k] = *(const PG8_LAS bf16x8*)(lds + PG8_SB(b, h) + boff + n * 2048 + k * 1024); } while (0)
#define PG8_MMA(ai, bj, At, Bt) do { __builtin_amdgcn_s_setprio(1); _Pragma("unroll") for (int m = 0; m < 4; ++m) _Pragma("unroll") for (int n = 0; n < 2; ++n) _Pragma("unroll") for (int k = 0; k < 2; ++k) \
        acc[ai][bj][m][n] = __builtin_amdgcn_mfma_f32_16x16x32_bf16(Bt[n][k], At[m][k], acc[ai][bj][m][n], 0, 0, 0); __builtin_amdgcn_s_setprio(0); } while (0)
#define PG8_WAIT_V(n) asm volatile("s_waitcnt vmcnt(" #n ")" ::: "memory")
#define PG8_WAIT_L(n) asm volatile("s_waitcnt lgkmcnt(" #n ")" ::: "memory")
#define PG8_BAR __builtin_amdgcn_s_barrier()
#define PG8_SCHED __builtin_amdgcn_sched_barrier(0)
    Unit cur, nxt; int ui = 0;
    if (!S.next(0, cur)) return;
    f32x4 acc[2][2][4][2];
#pragma unroll
    for (int a = 0; a < 2; ++a)
#pragma unroll
        for (int b = 0; b < 2; ++b)
#pragma unroll
            for (int m = 0; m < 4; ++m)
#pragma unroll
                for (int n = 0; n < 2; ++n) acc[a][b][m][n] = (f32x4){0.f, 0.f, 0.f, 0.f};
    bf16x8 At[4][2], B0[2][2], B1[2][2];
    const char* cA = (const char*)g.A + (size_t)cur.pm * tstep; const char* cB = (const char*)g.Bt + (size_t)cur.pn * tstep;
    S.a_ready(cur);
    if constexpr (SP2) {
        PG8_STAGE(PG8_SB(0, 0), cB, voffB); PG8_STAGE(PG8_SB(0, 1), cB + hstep, voffB); PG8_STAGE(PG8_SA(0, 0), cA, voffA); PG8_STAGE(PG8_SA(0, 1), cA + hstep, voffA);
        if (wr == 1) PG8_BAR;
        PG8_WAIT_V(2); PG8_BAR;
        PG8_STAGE(PG8_SB(1, 0), cB + kstep, voffB); PG8_STAGE(PG8_SA(1, 0), cA + kstep, voffA); PG8_STAGE(PG8_SB(1, 1), cB + hstep + kstep, voffB);
        PG8_WAIT_V(6); PG8_BAR;
    } else {
        PG8_STAGE(PG8_SB(0, 0), cB, voffB); PG8_STAGE(PG8_SA(0, 0), cA, voffA); PG8_STAGE(PG8_SB(0, 1), cB + hstep, voffB); PG8_STAGE(PG8_SA(0, 1), cA + hstep, voffA);
        if (wr == 1) PG8_BAR;
        PG8_WAIT_V(4); PG8_BAR;
        PG8_STAGE(PG8_SB(1, 0), cB + kstep, voffB); PG8_STAGE(PG8_SA(1, 0), cA + kstep, voffA); PG8_STAGE(PG8_SB(1, 1), cB + hstep + kstep, voffB);
        PG8_WAIT_V(6); PG8_BAR;
    }
    for (;;) {
        const bool has_next = S.next(ui + 1, nxt);
        const char* nA = has_next ? (const char*)g.A + (size_t)nxt.pm * tstep : cA; const char* nB = has_next ? (const char*)g.Bt + (size_t)nxt.pn * tstep : cB;
        _Pragma("nounroll") for (int t = 0; t < nt; t += 2) {
            const bool last = (t == nt - 2);
            const char* a1 = cA + (size_t)(t + 1) * kstep;
            const char* a2 = last ? nA : cA + (size_t)(t + 2) * kstep; const char* b2 = last ? nB : cB + (size_t)(t + 2) * kstep;
            const char* a3 = a2 + kstep; const char* b3 = b2 + kstep;
            if (last && has_next) S.a_ready(nxt);
            if constexpr (SP2) {
            PG8_LDB(B0, 0, 0); PG8_LDB(B1, 0, 1); PG8_SCHED; PG8_LDA(At, 0, 0); PG8_STAGE(PG8_SA(1, 1), a1 + hstep, voffA);
            PG8_WAIT_V(8); PG8_WAIT_L(0); PG8_BAR; PG8_MMA(0, 0, At, B0); PG8_MMA(0, 1, At, B1); PG8_BAR; PG8_SCHED;
            PG8_LDA(At, 0, 1); PG8_STAGE(PG8_SB(0, 0), b2, voffB); PG8_STAGE(PG8_SB(0, 1), b2 + hstep, voffB); PG8_STAGE(PG8_SA(0, 0), a2, voffA);
            PG8_WAIT_V(8); PG8_WAIT_L(0); PG8_BAR; PG8_MMA(1, 0, At, B0); PG8_MMA(1, 1, At, B1); PG8_BAR; PG8_SCHED;
            PG8_LDB(B0, 1, 0); PG8_LDB(B1, 1, 1); PG8_SCHED; PG8_LDA(At, 1, 0); PG8_STAGE(PG8_SA(0, 1), a2 + hstep, voffA);
            PG8_WAIT_V(8); PG8_WAIT_L(0); PG8_BAR; PG8_MMA(0, 0, At, B0); PG8_MMA(0, 1, At, B1); PG8_BAR; PG8_SCHED;
            PG8_LDA(At, 1, 1); PG8_STAGE(PG8_SB(1, 0), b3, voffB); PG8_STAGE(PG8_SB(1, 1), b3 + hstep, voffB); PG8_STAGE(PG8_SA(1, 0), a3, voffA);
            PG8_WAIT_V(8); PG8_WAIT_L(0); PG8_BAR; PG8_MMA(1, 0, At, B0); PG8_MMA(1, 1, At, B1); PG8_BAR; PG8_SCHED;
            } else {
            PG8_LDB(B0, 0, 0); PG8_SCHED; PG8_LDA(At, 0, 0); PG8_STAGE(PG8_SA(1, 1), a1 + hstep, voffA);
            PG8_WAIT_L(8); PG8_BAR; PG8_WAIT_L(0); PG8_MMA(0, 0, At, B0); PG8_BAR; PG8_SCHED;
            PG8_LDB(B1, 0, 1); PG8_STAGE(PG8_SB(0, 0), b2, voffB);
            PG8_BAR; PG8_WAIT_L(0); PG8_MMA(0, 1, At, B1); PG8_BAR;
            PG8_LDA(At, 0, 1); PG8_STAGE(PG8_SA(0, 0), a2, voffA);
            PG8_BAR; PG8_WAIT_L(0); PG8_MMA(1, 0, At, B0); PG8_BAR; PG8_SCHED;
            PG8_STAGE(PG8_SB(0, 1), b2 + hstep, voffB);
            PG8_WAIT_V(6); PG8_BAR; PG8_MMA(1, 1, At, B1); PG8_BAR;
            PG8_LDB(B0, 1, 0); PG8_SCHED; PG8_LDA(At, 1, 0); PG8_STAGE(PG8_SA(0, 1), a2 + hstep, voffA);
            PG8_WAIT_L(8); PG8_BAR; PG8_WAIT_L(0); PG8_MMA(0, 0, At, B0); PG8_BAR; PG8_SCHED;
            PG8_LDB(B1, 1, 1); PG8_STAGE(PG8_SB(1, 0), b3, voffB);
            PG8_BAR; PG8_WAIT_L(0); PG8_MMA(0, 1, At, B1); PG8_BAR;
            PG8_LDA(At, 1, 1); PG8_STAGE(PG8_SA(1, 0), a3, voffA);
            PG8_BAR; PG8_WAIT_L(0); PG8_MMA(1, 0, At, B0); PG8_BAR; PG8_SCHED;
            PG8_STAGE(PG8_SB(1, 1), b3 + hstep, voffB);
            PG8_WAIT_V(6); PG8_BAR; PG8_MMA(1, 1, At, B1); PG8_BAR;
            }
        }
        if constexpr (ALIGN_EPI) { if (wr == 0) PG8_BAR; }
        if constexpr (!Epi::AFTER_DRAIN) { E(acc, cur, wr, wc, fr, fq); S.done(cur); }
        if (!has_next) break;
#pragma unroll
        for (int a = 0; a < 2; ++a)
#pragma unroll
            for (int b = 0; b < 2; ++b)
#pragma unroll
                for (int m = 0; m < 4; ++m)
#pragma unroll
                    for (int n = 0; n < 2; ++n) acc[a][b][m][n] = (f32x4){0.f, 0.f, 0.f, 0.f};
        cur = nxt; cA = nA; cB = nB; ++ui;
        if constexpr (ALIGN_EPI) { if (wr == 1) PG8_BAR; }
    }
    PG8_WAIT_V(0);
    if constexpr (!ALIGN_EPI) { if (wr == 0) PG8_BAR; }
    PG8_BAR;
    if constexpr (Epi::AFTER_DRAIN) { E.fused(acc, cur, wr, wc, fr, fq, lds, wid, lane); S.done(cur); }
#undef PG8_SA
#undef PG8_SB
#undef PG8_STAGE
#undef PG8_LDA
#undef PG8_LDB
#undef PG8_MMA
#undef PG8_WAIT_V
#undef PG8_WAIT_L
#undef PG8_BAR
#undef PG8_SCHED
}
}

DEVI void sincos_pos(float ang, float& cs, float& sn) {
    const double TWO_PI = 6.283185307179586476925286766559; const double a = (double)ang; const double k = __builtin_rint(a * (1.0 / TWO_PI));
    const float r = (float)(a - k * TWO_PI);
    cs = cosf(r); sn = sinf(r);
}

namespace afast {
constexpr int NW = 8, KVBLK = 64, SLOTK = 12288, SLOTV = 8192, KROFF = 8192;
constexpr int LDS_K = 0, LDS_V = 3 * SLOTK, LDS_WS = LDS_V + 3 * SLOTV, LDS_OST = LDS_WS + NW * 256, LDS_BYTES = LDS_OST + NW * 4096;
#define SBAR() __builtin_amdgcn_sched_barrier(0)
#define PIN(x) asm volatile("" : "+v"(x))
#define MFMA(a, b, c) __builtin_amdgcn_mfma_f32_32x32x16_bf16(a, b, c, 0, 0, 0)
#define WAIT_BAR(N) asm volatile("s_waitcnt vmcnt(" #N ") lgkmcnt(0)\n\ts_barrier" ::: "memory")
DEVI int crow(int r, int hi) { return (r & 3) + 8 * (r >> 2) + 4 * hi; }
DEVI unsigned cvtpk(float lo, float hi) { unsigned r; asm("v_cvt_pk_bf16_f32 %0, %1, %2" : "=v"(r) : "v"(lo), "v"(hi)); return r; }
DEVI void glds16(const void* g, unsigned lds_base) {
    unsigned sv; asm volatile("s_mov_b32 %0, m0\n\ts_mov_b32 m0, %2\n\ts_nop 0\n\tglobal_load_lds_dwordx4 %1, off\n\ts_mov_b32 m0, %0" : "=&s"(sv) : "v"(g), "s"(lds_base) : "memory"); }
typedef __attribute__((address_space(3))) const char* lds_cptr;
typedef short v4i16_t __attribute__((ext_vector_type(4)));
DEVI bf16x8 ldsb128(lds_cptr p) { return *(const __attribute__((address_space(3))) bf16x8*)p; }
DEVI s16x4 vtr(lds_cptr p) { return __builtin_bit_cast(s16x4, __builtin_amdgcn_ds_read_tr16_b64_v4i16((__attribute__((address_space(3))) v4i16_t*)p)); }
DEVI bf16x8 scale8(bf16x8 v, float s) {
    u32x4 w = __builtin_bit_cast(u32x4, v); u32x4 o;
#pragma unroll
    for (int i = 0; i < 4; ++i) { const float lo = __uint_as_float(w[i] << 16) * s, hi = __uint_as_float(w[i] & 0xffff0000u) * s; o[i] = cvtpk(lo, hi); }
    return __builtin_bit_cast(bf16x8, o);
}

template <int ROPE>
DEVI void attn_unit(const bf16_t* Qn, int ldq, const bf16_t* Qr, const float* ssh, const bf16_t* __restrict__ Kn, int ldk, const bf16_t* __restrict__ Kr,
                    const bf16_t* __restrict__ V, int ldv, int NT, bf16_t* O, const bf16_t* G, int ldo, char* lds) {
    const int tid = threadIdx.x, lane = tid & 63, r32 = lane & 31, hi = lane >> 5; const int wid = __builtin_amdgcn_readfirstlane(tid >> 6);
    const unsigned lds0 = (unsigned)(uintptr_t)lds; float* wsf = (float*)(lds + LDS_WS) + wid * 64;
    const bf16_t* ksrc = Kn + (size_t)lane * ldk + wid * 8;
    const bf16_t* vsrc = V + (size_t)(16 * (wid & 3) + (lane >> 2)) * ldv + (wid >> 2) * 32 + (lane & 3) * 8;
    const bf16_t* krsrc = ROPE ? Kr + (size_t)(32 * (wid & 1) + r32) * 32 + 8 * (2 * ((wid >> 1) & 1) + hi) : nullptr;
    const unsigned kdst = lds0 + LDS_K + wid * 1024, vdst = lds0 + LDS_V + wid * 1024, krdst = lds0 + LDS_K + KROFF + (wid & 3) * 1024;
    const bool rwave = ROPE && wid < 4;
#define DMA_K(t, slot) do { if (ROPE) { if (rwave) glds16(krsrc + (size_t)(t) * KVBLK * 32, (unsigned)__builtin_amdgcn_readfirstlane(krdst + (slot))); } \
        glds16(ksrc + (size_t)(t) * KVBLK * ldk, (unsigned)__builtin_amdgcn_readfirstlane(kdst + (slot))); } while (0)
#define DMA_V(t, slot) glds16(vsrc + (size_t)(t) * KVBLK * ldv, (unsigned)__builtin_amdgcn_readfirstlane(vdst + (slot)))
    const lds_cptr vp0 = (lds_cptr)lds + LDS_V + ((lane >> 4) & 1) * 32 + (lane & 3) * 8 + (4 * hi + ((lane & 15) >> 2)) * 64;
    const lds_cptr kp0 = (lds_cptr)lds + LDS_K + hi * 1024 + r32 * 16;
    const lds_cptr krp0 = (lds_cptr)lds + LDS_K + KROFF + hi * 512 + r32 * 16;
    DMA_K(0, 0); DMA_V(0, 0); DMA_K(1, SLOTK);
    bf16x8 qr[4]; bf16x8 qrr[2];
    { const bf16_t* Qw = Qn + (size_t)(wid * 32 + r32) * ldq + hi * 8;
#pragma unroll
      for (int d0 = 0; d0 < 4; ++d0) qr[d0] = *reinterpret_cast<const bf16x8*>(Qw + d0 * 16);
      if (ROPE) { const bf16_t* Qrw = Qr + (size_t)(wid * 32 + r32) * 512 + hi * 8;
#pragma unroll
          for (int d0 = 0; d0 < 2; ++d0) qrr[d0] = *reinterpret_cast<const bf16x8*>(Qrw + d0 * 16);
          const f32x2 s2 = *(const f32x2*)(ssh + (size_t)(wid * 32 + r32) * 32); const float sc = rsqrtf((s2[0] + s2[1]) * (1.f / 96.f) + EPS) * C2_MLA;
#pragma unroll
          for (int d0 = 0; d0 < 4; ++d0) qr[d0] = scale8(qr[d0], sc);
#pragma unroll
          for (int d0 = 0; d0 < 2; ++d0) qrr[d0] = scale8(qrr[d0], sc); } }
    float l_reg = 0.f; f32x16 o[2]; o[0] = f32x16{}; o[1] = f32x16{};
    const f32x16 zero16 = f32x16{};
    f32x16 pA0, pA1, pB0, pB1; bf16x8 kf[8]; bf16x8 kfr[4]; s16x4 vlo[8], vhi[8]; u32x4 pw0, pw1, pw2, pw3;
    int sl_prev = 0, sl_cur = 0, sl_next = SLOTK;
#define VSL(s) (((s) / (SLOTK / 1024)) * (SLOTV / 1024))
#define ROT() do { sl_prev = sl_cur; sl_cur = sl_next; sl_next = (sl_next == 2 * SLOTK) ? 0 : sl_next + SLOTK; } while (0)
#define EX(v) __builtin_amdgcn_exp2f(v)
#define KLOADALL(slot) do { _Pragma("unroll") for (int d0 = 0; d0 < 4; ++d0) { kf[2 * d0] = ldsb128(kp0 + (slot) + d0 * 2048); kf[2 * d0 + 1] = ldsb128(kp0 + (slot) + d0 * 2048 + 512); } \
        if (ROPE) { _Pragma("unroll") for (int q = 0; q < 4; ++q) kfr[q] = ldsb128(krp0 + (slot) + q * 1024); } } while (0)
    DMA_K(2, 2 * SLOTK);
    WAIT_BAR(3);
    KLOADALL(0);
    pA0 = MFMA(kf[0], qr[0], zero16); pA1 = MFMA(kf[1], qr[0], zero16); pA0 = MFMA(kf[2], qr[1], pA0); pA1 = MFMA(kf[3], qr[1], pA1);
    pA0 = MFMA(kf[4], qr[2], pA0); pA1 = MFMA(kf[5], qr[2], pA1); pA0 = MFMA(kf[6], qr[3], pA0); pA1 = MFMA(kf[7], qr[3], pA1);
    if (ROPE) { pA0 = MFMA(kfr[0], qrr[0], pA0); pA1 = MFMA(kfr[1], qrr[0], pA1); pA0 = MFMA(kfr[2], qrr[1], pA0); pA1 = MFMA(kfr[3], qrr[1], pA1); }
#pragma unroll
    for (int r = 0; r < 16; ++r) { pA0[r] = EX(pA0[r]); pA1[r] = EX(pA1[r]); }
    WAIT_BAR(0);
    DMA_K(3, 0); DMA_V(1, SLOTV); ROT();
    KLOADALL(sl_cur);
    WAIT_BAR(2);
#define PKW(P, i) cvtpk(P[i], P[i + 1])
#define PAF(k) __builtin_bit_cast(bf16x8, pw##k)
#define VFR(i) (bf16x8){vlo[i][0], vlo[i][1], vlo[i][2], vlo[i][3], vhi[i][0], vhi[i][1], vhi[i][2], vhi[i][3]}
#define VRD(i) do { vlo[i] = vtr(vp_ + (((i) >> 2) * 4096 + ((i) & 3) * 1024)); vhi[i] = vtr(vp_ + (((i) >> 2) * 4096 + ((i) & 3) * 1024 + 512)); } while (0)
#define KRD(G, d0) do { if (G) { kf[2 * (d0)] = ldsb128(kp0 + sl_next + (d0) * 2048); kf[2 * (d0) + 1] = ldsb128(kp0 + sl_next + (d0) * 2048 + 512); SBAR(); } } while (0)
#define KRR(G, q) do { if (ROPE) { if (G) { kfr[2 * (q)] = ldsb128(krp0 + sl_next + (2 * (q)) * 1024); kfr[2 * (q) + 1] = ldsb128(krp0 + sl_next + (2 * (q) + 1) * 1024); SBAR(); } } } while (0)
#define GAPA4(CX, MF, a0, a1, a2, a3, W0, W1, PW) do { MF; sacc += a0; sacc += a1; sacc += a2; sacc += a3; W0; W1; PIN(PW); PIN(sacc); PIN(CX); SBAR(); } while (0)
#define GAPA3(CX, MF, a0, a1, a2, W0, W1, PW) do { MF; sacc += a0; sacc += a1; sacc += a2; W0; W1; PIN(PW); PIN(sacc); PIN(CX); SBAR(); } while (0)
#define GAPA31(CX, MF, a0, a1, a2, W0, PW) do { MF; sacc += a0; sacc += a1; sacc += a2; W0; PIN(PW); PIN(sacc); PIN(CX); SBAR(); } while (0)
#define GAPA21(CX, MF, a0, a1, W0, PW) do { MF; sacc += a0; sacc += a1; W0; PIN(PW); PIN(sacc); PIN(CX); SBAR(); } while (0)
#define GAPB(MF, X, i) do { MF; X[i] = EX(X[i]); X[i + 1] = EX(X[i + 1]); X[i + 2] = EX(X[i + 2]); X[i + 3] = EX(X[i + 3]); PIN(X); SBAR(); } while (0)
#define STEP(C0, C1, P0, P1, t, GK, GV, GL) do { SBAR(); \
    const lds_cptr vp_ = vp0 + VSL(sl_prev); \
    VRD(0); SBAR(); float sacc = P0[0] + P0[1]; \
    if (!ROPE) { \
                        GAPA4(C0, C0 = MFMA(kf[0], qr[0], zero16), P0[2], P0[3], P0[4], P0[5],     pw0[0] = PKW(P0, 0),  pw0[1] = PKW(P0, 2),  pw0); \
        VRD(4); SBAR(); GAPA4(C1, C1 = MFMA(kf[1], qr[0], zero16), P0[6], P0[7], P0[8], P0[9],     pw0[2] = PKW(P0, 4),  pw0[3] = PKW(P0, 6),  pw0); \
        VRD(1); SBAR(); GAPA4(C0, C0 = MFMA(kf[2], qr[1], C0),    P0[10], P0[11], P0[12], P0[13], pw1[0] = PKW(P0, 8),  pw1[1] = PKW(P0, 10), pw1); \
        VRD(5); SBAR(); GAPA4(C1, C1 = MFMA(kf[3], qr[1], C1),    P0[14], P0[15], P1[0], P1[1],   pw1[2] = PKW(P0, 12), pw1[3] = PKW(P0, 14), pw1); \
        VRD(2); SBAR(); GAPA4(C0, C0 = MFMA(kf[4], qr[2], C0),    P1[2], P1[3], P1[4], P1[5],     pw2[0] = PKW(P1, 0),  pw2[1] = PKW(P1, 2),  pw2); \
        VRD(6); SBAR(); GAPA4(C1, C1 = MFMA(kf[5], qr[2], C1),    P1[6], P1[7], P1[8], P1[9],     pw2[2] = PKW(P1, 4),  pw2[3] = PKW(P1, 6),  pw2); \
        VRD(3); SBAR(); GAPA4(C0, C0 = MFMA(kf[6], qr[3], C0),    P1[10], P1[11], P1[12], P1[13], pw3[0] = PKW(P1, 8),  pw3[1] = PKW(P1, 10), pw3); \
        VRD(7); SBAR(); GAPA4(C1, C1 = MFMA(kf[7], qr[3], C1),    P1[14], P1[15], 0.f, 0.f,       pw3[2] = PKW(P1, 12), pw3[3] = PKW(P1, 14), pw3); \
    } else { \
                        GAPA3(C0, C0 = MFMA(kf[0], qr[0], zero16), P0[2], P0[3], P0[4],    pw0[0] = PKW(P0, 0),  pw0[1] = PKW(P0, 2),  pw0); \
        VRD(4); SBAR(); GAPA3(C1, C1 = MFMA(kf[1], qr[0], zero16), P0[5], P0[6], P0[7],    pw0[2] = PKW(P0, 4),  pw0[3] = PKW(P0, 6),  pw0); \
        VRD(1); SBAR(); GAPA3(C0, C0 = MFMA(kf[2], qr[1], C0),    P0[8], P0[9], P0[10],   pw1[0] = PKW(P0, 8),  pw1[1] = PKW(P0, 10), pw1); \
        VRD(5); SBAR(); GAPA3(C1, C1 = MFMA(kf[3], qr[1], C1),    P0[11], P0[12], P0[13], pw1[2] = PKW(P0, 12), pw1[3] = PKW(P0, 14), pw1); \
        VRD(2); SBAR(); GAPA31(C0, C0 = MFMA(kf[4], qr[2], C0),   P0[14], P0[15], P1[0],  pw2[0] = PKW(P1, 0),  pw2); \
        VRD(6); SBAR(); GAPA31(C1, C1 = MFMA(kf[5], qr[2], C1),   P1[1], P1[2], P1[3],    pw2[1] = PKW(P1, 2),  pw2); \
        VRD(3); SBAR(); GAPA21(C0, C0 = MFMA(kf[6], qr[3], C0),   P1[4], P1[5],           pw2[2] = PKW(P1, 4),  pw2); \
        VRD(7); SBAR(); GAPA21(C1, C1 = MFMA(kf[7], qr[3], C1),   P1[6], P1[7],           pw2[3] = PKW(P1, 6),  pw2); \
                        GAPA21(C0, C0 = MFMA(kfr[0], qrr[0], C0), P1[8], P1[9],           pw3[0] = PKW(P1, 8),  pw3); \
                        GAPA21(C1, C1 = MFMA(kfr[1], qrr[0], C1), P1[10], P1[11],         pw3[1] = PKW(P1, 10), pw3); \
                        GAPA21(C0, C0 = MFMA(kfr[2], qrr[1], C0), P1[12], P1[13],         pw3[2] = PKW(P1, 12), pw3); \
                        GAPA21(C1, C1 = MFMA(kfr[3], qrr[1], C1), P1[14], P1[15],         pw3[3] = PKW(P1, 14), pw3); \
    } \
    l_reg += sacc; \
    if (GK) DMA_K((t) + 3, sl_cur); if (GV) DMA_V((t) + 1, VSL(sl_next)); \
    SBAR(); \
    GAPB(o[0] = MFMA(PAF(0), VFR(0), o[0]), C0, 0); \
    KRD(GL, 0); GAPB(o[1] = MFMA(PAF(0), VFR(4), o[1]), C0, 4); \
    KRD(GL, 1); GAPB(o[0] = MFMA(PAF(1), VFR(1), o[0]), C0, 8); \
    KRD(GL, 2); GAPB(o[1] = MFMA(PAF(1), VFR(5), o[1]), C0, 12); \
    KRD(GL, 3); GAPB(o[0] = MFMA(PAF(2), VFR(2), o[0]), C1, 0); \
    KRR(GL, 0); GAPB(o[1] = MFMA(PAF(2), VFR(6), o[1]), C1, 4); \
    KRR(GL, 1); GAPB(o[0] = MFMA(PAF(3), VFR(3), o[0]), C1, 8); \
    GAPB(o[1] = MFMA(PAF(3), VFR(7), o[1]), C1, 12); \
    } while (0)
    int t = 1;
    for (; t + 5 < NT; t += 2) {
        STEP(pB0, pB1, pA0, pA1, t, true, true, true);     WAIT_BAR(2); ROT();
        STEP(pA0, pA1, pB0, pB1, t + 1, true, true, true); WAIT_BAR(2); ROT();
    }
#define ENDW(tt) do { if ((tt) + 3 < NT) { WAIT_BAR(2); } else if ((tt) + 2 < NT) { WAIT_BAR(1); } else { WAIT_BAR(0); } } while (0)
    for (; t + 1 < NT; t += 2) {
        STEP(pB0, pB1, pA0, pA1, t, (t + 3 < NT), (t + 1 < NT), (t + 1 < NT));         ENDW(t);     ROT();
        STEP(pA0, pA1, pB0, pB1, t + 1, (t + 4 < NT), (t + 2 < NT), (t + 2 < NT));     ENDW(t + 1); ROT();
    }
    STEP(pB0, pB1, pA0, pA1, NT - 1, false, false, false);
    { float sacc = pB0[0] + pB0[1];
#pragma unroll
      for (int r = 2; r < 16; ++r) sacc += pB0[r];
#pragma unroll
      for (int r = 0; r < 16; ++r) sacc += pB1[r];
      l_reg += sacc;
      pw0 = (u32x4){PKW(pB0, 0), PKW(pB0, 2), PKW(pB0, 4), PKW(pB0, 6)}; pw1 = (u32x4){PKW(pB0, 8), PKW(pB0, 10), PKW(pB0, 12), PKW(pB0, 14)};
      pw2 = (u32x4){PKW(pB1, 0), PKW(pB1, 2), PKW(pB1, 4), PKW(pB1, 6)}; pw3 = (u32x4){PKW(pB1, 8), PKW(pB1, 10), PKW(pB1, 12), PKW(pB1, 14)};
      const lds_cptr vp_ = vp0 + VSL(sl_cur); _Pragma("unroll") for (int i = 0; i < 8; ++i) VRD(i);
      o[0] = MFMA(PAF(0), VFR(0), o[0]); o[1] = MFMA(PAF(0), VFR(4), o[1]); o[0] = MFMA(PAF(1), VFR(1), o[0]); o[1] = MFMA(PAF(1), VFR(5), o[1]);
      o[0] = MFMA(PAF(2), VFR(2), o[0]); o[1] = MFMA(PAF(2), VFR(6), o[1]); o[0] = MFMA(PAF(3), VFR(3), o[0]); o[1] = MFMA(PAF(3), VFR(7), o[1]); }
    { auto rr = __builtin_amdgcn_permlane32_swap(__float_as_uint(l_reg), __float_as_uint(l_reg), false, false); l_reg = __uint_as_float(rr[0]) + __uint_as_float(rr[1]); }
    if (hi == 0) wsf[32 + r32] = l_reg; asm volatile("s_waitcnt lgkmcnt(0)" ::: "memory");
    float rli[16];
#pragma unroll
    for (int r = 0; r < 16; ++r) rli[r] = __builtin_amdgcn_rcpf(wsf[32 + crow(r, hi)]);
    bf16_t* stg = (bf16_t*)(lds + LDS_OST) + wid * 2048;
#pragma unroll
    for (int r = 0; r < 16; ++r) { const int orow = crow(r, hi);
#pragma unroll
        for (int d0 = 0; d0 < 2; ++d0) stg[orow * 64 + d0 * 32 + r32] = (bf16_t)f2bf(o[d0][r] * rli[r]); }
    asm volatile("s_waitcnt lgkmcnt(0)" ::: "memory");
#pragma unroll
    for (int i = 0; i < 4; ++i) { const int row = i * 8 + (lane >> 3), ch = lane & 7; const size_t goff = (size_t)(wid * 32 + row) * ldo + ch * 8;
        const u32x4 ov = *(const u32x4*)(stg + row * 64 + ch * 8); const u32x4 gv = *(const u32x4*)(G + goff); u32x4 w;
#pragma unroll
        for (int q = 0; q < 4; ++q) { const float lo = __uint_as_float(ov[q] << 16) * __uint_as_float(gv[q] << 16), hh = __uint_as_float(ov[q] & 0xffff0000u) * __uint_as_float(gv[q] & 0xffff0000u); w[q] = cvtpk(lo, hh); }
        *(u32x4*)(O + goff) = w; }
    asm volatile("s_waitcnt lgkmcnt(0)\n\ts_barrier" ::: "memory");
#undef DMA_K
#undef DMA_V
#undef VSL
#undef ROT
#undef EX
#undef KLOADALL
#undef PKW
#undef PAF
#undef VFR
#undef VRD
#undef KRD
#undef KRR
#undef GAPA4
#undef GAPA3
#undef GAPA31
#undef GAPA21
#undef GAPB
#undef STEP
#undef ENDW
}
#undef SBAR
#undef PIN
#undef MFMA
#undef WAIT_BAR
}

#include <hip/hip_cooperative_groups.h>
namespace cg = cooperative_groups;
constexpr int NWAVES = 8, NTHREADS = 512, LDS_BYTES = 147456, RING_BYTES = 131072;
constexpr size_t MiB = 1u << 20;
constexpr size_t WS_MOD = 1 * MiB;
constexpr size_t WS_TABA = WS_MOD + 128 * 1024;
constexpr size_t WS_TABB = WS_TABA + 32 * 1024;
constexpr size_t WS_WIN0 = 2 * MiB;
constexpr size_t WS_WOUT0 = 7 * MiB;
constexpr size_t WS_WIN1 = 9 * MiB;
constexpr size_t WS_WKVB = 13 * MiB;
constexpr size_t WS_WQB = 14 * MiB;
constexpr size_t WS_WOUT1 = 16 * MiB;
constexpr size_t WS_X1C = 18 * MiB;
constexpr size_t WS_H = 20 * MiB;
constexpr size_t WS_Q = 53 * MiB;
constexpr size_t WS_K = 86 * MiB;
constexpr size_t WS_V0 = 95 * MiB;
constexpr size_t WS_G = 120 * MiB;
constexpr size_t WS_V1 = 153 * MiB;
constexpr size_t WS_KVA = 186 * MiB;
constexpr size_t WS_QA = 195 * MiB;
constexpr size_t WS_Q1R = 207 * MiB;
constexpr size_t WS_KR = 223 * MiB;
constexpr size_t WS_SSKV = 225 * MiB;
constexpr size_t WS_SSQ = 226 * MiB;
constexpr size_t WS_SSH = 227 * MiB;
constexpr size_t WS_END = 256 * MiB;
static_assert(WS_K + (size_t)NB * TK * DM * 2 <= WS_G && WS_G + (size_t)MT * DM * 2 <= WS_V1 && WS_V1 + (size_t)NB * TK * DM * 2 <= WS_KVA && WS_SSH + (size_t)ML * 32 * 4 <= WS_END, "ws map");

struct Args { const float* in[23]; float* out; unsigned char* ws; int ph_lo, ph_hi, coop, pad; };

DEVI void phase0(const Args& a, unsigned char* ws, LAS unsigned char* lds, int vb, int G) {
    const int tid = threadIdx.x, wave = tid >> 6, lane = tid & 63;
    float* mod = (float*)(ws + WS_MOD);
    if (vb < 96) {
        LAS float* sc = (LAS float*)lds; LAS float* red = sc + 3 * 1024;
        const int layer = vb / 48, cs = vb % 48; const float* w = a.in[layer ? 11 : 4]; const float* bb = a.in[layer ? 12 : 5];
        for (int i = tid; i < 3072; i += NTHREADS) { const int r = i >> 10, k = i & 1023; const float v = r < 2 ? a.in[1][r * 1024 + k] : a.in[3][k]; sc[i] = v / (1.f + expf(-v)); }
        __syncthreads();
        const int col = cs * 64 + lane; float a0 = 0.f, a1 = 0.f, a2 = 0.f;
#pragma unroll 8
        for (int k = wave * 128; k < wave * 128 + 128; ++k) { const float wv = w[(size_t)k * 3072 + col]; a0 += sc[k] * wv; a1 += sc[1024 + k] * wv; a2 += sc[2048 + k] * wv; }
        red[(wave * 3 + 0) * 64 + lane] = a0; red[(wave * 3 + 1) * 64 + lane] = a1; red[(wave * 3 + 2) * 64 + lane] = a2;
        __syncthreads();
        if (tid < 192) { const int r = tid >> 6; float s = 0.f;
#pragma unroll
            for (int q = 0; q < 8; ++q) s += red[(q * 3 + r) * 64 + lane];
            mod[(size_t)(layer * 3 + r) * 3072 + col] = s + bb[col]; }
        __syncthreads();
    } else if (vb == 96) {
        f32x2* tabA = (f32x2*)(ws + WS_TABA); f32x2* tabB = (f32x2*)(ws + WS_TABB);
        for (int i = tid; i < 128 * 24; i += NTHREADS) {
            if (i < 128 * 16) { const int pos = i >> 4, f = i & 15; const float invf = powf(10000.f, -(float)f / 16.f); float cs_, sn_; sincos_pos((float)pos * invf, cs_, sn_); tabA[i] = (f32x2){cs_, sn_}; }
            else { const int j = i - 128 * 16, pos = j >> 3, f = j & 7; const float invf = powf(10000.f, -(float)f / 8.f); float cs_, sn_; sincos_pos((float)pos * invf, cs_, sn_); tabB[j] = (f32x2){cs_, sn_}; } }
    }
    struct WD { int src, K, Nsrc, Np, mode, ks; size_t dst; };
    const WD wd[6] = {{7, 1024, N_IN0, 2560, 1, -1, WS_WIN0}, {10, 1024, 1024, 1024, 0, -1, WS_WOUT0}, {14, 1024, N_IN1, N_IN1P, 2, -1, WS_WIN1},
                      {16, 256, 2048, 2048, 3, 15, WS_WKVB}, {18, 384, 1536, 2048, 4, 17, WS_WQB}, {22, 1024, 1024, 1024, 0, -1, WS_WOUT1}};
#pragma unroll
    for (int m = 0; m < 6; ++m) {
        const float* W = a.in[wd[m].src]; const float* ks = wd[m].ks >= 0 ? a.in[wd[m].ks] : nullptr; bf16_t* Bt = (bf16_t*)(ws + wd[m].dst);
        const int K = wd[m].K, Nsrc = wd[m].Nsrc, Np = wd[m].Np, total = Np * (K / 8);
        for (int i = vb * NTHREADS + tid; i < total; i += G * NTHREADS) {
            const int p = i % Np, k8 = i / Np; int cc = pg8::wmap(wd[m].mode, p); if (cc >= Nsrc) cc = -1;
            float v[8];
#pragma unroll
            for (int j = 0; j < 8; ++j) { const int k = k8 * 8 + j; v[j] = cc >= 0 ? W[(size_t)k * Nsrc + cc] * (ks ? ks[k] : 1.f) : 0.f; }
            u32x4 o; o.x = pk2(v[0], v[1]); o.y = pk2(v[2], v[3]); o.z = pk2(v[4], v[5]); o.w = pk2(v[6], v[7]);
            *(u32x4*)(Bt + (size_t)p * K + k8 * 8) = o;
        }
    }
}

DEVI void phase_prep(const float* xa, const float* xb, const float* nw, const float* mod, bf16_t* H, int gw, int NGW, int lane) {
    for (int row = gw; row < MT; row += NGW) {
        const int r = row < SEQ ? 0 : (row < ML ? 1 : 2);
        const float* src = row < ML ? xa + (size_t)row * DM : xb + (size_t)(row - ML) * DM;
        f32x4 v[4]; float ss = 0.f;
#pragma unroll
        for (int j = 0; j < 4; ++j) { v[j] = *(const f32x4*)(src + 4 * lane + 256 * j); ss += (v[j].x * v[j].x + v[j].y * v[j].y) + (v[j].z * v[j].z + v[j].w * v[j].w); }
        const float rinv = rsqrtf(wave_sum(ss) * (1.f / DM) + EPS);
#pragma unroll
        for (int j = 0; j < 4; ++j) { const int cidx = 4 * lane + 256 * j; const f32x4 w = *(const f32x4*)(nw + cidx);
            const f32x4 sh = *(const f32x4*)(mod + (size_t)r * 3072 + cidx), scl = *(const f32x4*)(mod + (size_t)r * 3072 + 1024 + cidx);
            const f32x4 h = (v[j] * rinv) * w * (scl + 1.f) + sh;
            u32x2 o; o.x = pk2(h.x, h.y); o.y = pk2(h.z, h.w); *(u32x2*)(H + (size_t)row * DM + cidx) = o; }
    }
}

__global__ void __launch_bounds__(NTHREADS, 2) mega(Args a) {
    extern __shared__ __attribute__((aligned(16))) unsigned char lds[];
    const int tid = threadIdx.x, lane = tid & 63; const int wave = __builtin_amdgcn_readfirstlane(tid >> 6);
    const int G = gridDim.x, bx = blockIdx.x; const int vcu = (G % 8 == 0) ? (bx % 8) * (G / 8) + bx / 8 : bx;
    unsigned char* ws = a.ws; float* out = a.out;
    const float* x = a.in[0]; const float* ctx = a.in[2];
    float* mod = (float*)(ws + WS_MOD); const f32x4* tabA = (const f32x4*)(ws + WS_TABA); const f32x4* tabB = (const f32x4*)(ws + WS_TABB);
    bf16_t* H = (bf16_t*)(ws + WS_H); bf16_t* Qb = (bf16_t*)(ws + WS_Q); bf16_t* K0 = (bf16_t*)(ws + WS_K); bf16_t* V0 = (bf16_t*)(ws + WS_V0); bf16_t* K1 = (bf16_t*)(ws + WS_K);
    bf16_t* Gb = (bf16_t*)(ws + WS_G); bf16_t* V1 = (bf16_t*)(ws + WS_V1); bf16_t* KVA = (bf16_t*)(ws + WS_KVA); bf16_t* QA = (bf16_t*)(ws + WS_QA); bf16_t* Q1R = (bf16_t*)(ws + WS_Q1R);
    bf16_t* O0 = (bf16_t*)(ws + WS_V1); bf16_t* O1 = (bf16_t*)(ws + WS_H); bf16_t* KR = (bf16_t*)(ws + WS_KR); float* SSKV = (float*)(ws + WS_SSKV); float* SSQ = (float*)(ws + WS_SSQ); float* SSH = (float*)(ws + WS_SSH); float* X1c = (float*)(ws + WS_X1C);
    const int lo = a.ph_lo, hi_ = a.ph_hi;
#ifndef ONLY_PHASE
#define ONLY_PHASE -1
#endif
#define IN(k) ((ONLY_PHASE < 0 || ONLY_PHASE == (k)) && lo <= (k) && (k) < hi_)
#ifndef MK_REP_MASK
#define MK_REP_MASK 0
#endif
#define REPS(k) (((MK_REP_MASK >> (k)) & 1) ? 2 : 1)
#define SEAM(k) do { if (IN(k) && IN((k) + 1)) { cg::this_grid().sync(); } } while (0)
    PG8_LAS unsigned char* ring = (PG8_LAS unsigned char*)lds;

    if (IN(0)) for (int rep_ = 0; rep_ < REPS(0); ++rep_) { phase0(a, ws, (LAS unsigned char*)lds, bx, G); } SEAM(0);
    if (IN(1)) for (int rep_ = 0; rep_ < REPS(1); ++rep_) { phase_prep(x, ctx, a.in[6], mod, H, vcu * NWAVES + wave, G * NWAVES, lane); } SEAM(1);
    if (IN(2)) for (int rep_ = 0; rep_ < REPS(2); ++rep_) { pg8::Gemm g{H, (const bf16_t*)(ws + WS_WIN0), MT, N_IN0, 1024}; pg8::ROrder S; S.init(0, MT / 256, N_IN0, G, bx);
        pg8::EpiIn0 E{a.in[8], a.in[9], tabA, K0, V0, Qb, Gb};
        pg8::gemm_phase<pg8::EpiIn0, pg8::ROrder, true, true>(ring, g, S, E); } SEAM(2);
    if (IN(3)) for (int rep_ = 0; rep_ < REPS(3); ++rep_) {
        const int xg = vcu >> 5, c = vcu & 31, b = xg >> 2, kvh = xg & 3; const size_t kbase = (size_t)b * TK * 256 + kvh * 64;
        for (int i = 0; i < 4; ++i) { const int h = kvh * 4 + i; const size_t q0 = ((size_t)b * SEQ + c * 256) * DM + h * 64;
            afast::attn_unit<0>(Qb + q0, DM, nullptr, nullptr, K0 + kbase, 256, nullptr, V0 + kbase, 256, TK / 64, O0 + q0, Gb + q0, DM, (char*)lds); }
        if (c < 4) { const int h = kvh * 4 + c; const size_t q0 = ((size_t)ML + b * CTXL) * DM + h * 64;
            afast::attn_unit<0>(Qb + q0, DM, nullptr, nullptr, K0 + kbase, 256, nullptr, V0 + kbase, 256, CTXL / 64, O0 + q0, Gb + q0, DM, (char*)lds); }
    } SEAM(3);
    if (IN(4)) for (int rep_ = 0; rep_ < REPS(4); ++rep_) { pg8::Gemm g{O0, (const bf16_t*)(ws + WS_WOUT0), MT, 1024, 1024}; pg8::ROrder S; S.init(0, MT / 256, 1024, G, bx);
        pg8::EpiOut E{x, ctx, out, X1c, mod + 2048};
        pg8::gemm_phase<pg8::EpiOut, pg8::ROrder, true, true>(ring, g, S, E); } SEAM(4);
    if (IN(5)) for (int rep_ = 0; rep_ < REPS(5); ++rep_) { phase_prep(out, X1c, a.in[13], mod + 3 * 3072, H, vcu * NWAVES + wave, G * NWAVES, lane); } SEAM(5);
    if (IN(6)) for (int rep_ = 0; rep_ < REPS(6); ++rep_) { pg8::Gemm g{H, (const bf16_t*)(ws + WS_WIN1), MT, N_IN1P, 1024}; pg8::In1Order S; S.init(G, bx);
        pg8::EpiIn1 E{a.in[21], tabB, KVA, SSKV, QA, SSQ, KR, Gb};
        pg8::gemm_phase<pg8::EpiIn1, pg8::In1Order, true, true>(ring, g, S, E); } SEAM(6);
    if (IN(7)) for (int rep_ = 0; rep_ < REPS(7); ++rep_) {
        { pg8::Gemm g{KVA, (const bf16_t*)(ws + WS_WKVB), MT, 2048, 256}; pg8::ROrder S; S.init(0, MT / 256, 2048, G, bx);
          pg8::EpiKvb E{SSKV, a.in[20], K1, V1};
          pg8::gemm_phase<pg8::EpiKvb, pg8::ROrder, true, true>(ring, g, S, E); }
        { pg8::Gemm g{QA, (const bf16_t*)(ws + WS_WQB), ML, 2048, 384}; pg8::ROrder S; S.init(0, ML / 256, 2048, G, bx);
          pg8::EpiQb E{SSQ, a.in[19], tabB, Qb, Q1R, SSH};
          pg8::gemm_phase<pg8::EpiQb, pg8::ROrder, true, true>(ring, g, S, E); }
    } SEAM(7);
    if (IN(8)) for (int rep_ = 0; rep_ < REPS(8); ++rep_) {
        const int xg = vcu >> 5, c = vcu & 31;
        for (int i = 0; i < 4; ++i) { const int s = xg + 8 * i, b = s >> 4, h = s & 15; const size_t row0 = (size_t)b * SEQ + c * 256, q0 = row0 * DM + h * 64;
            afast::attn_unit<1>(Qb + q0, DM, Q1R + row0 * 512 + h * 32, SSH + (row0 * 16 + h) * 2, K1 + (size_t)b * TK * DM + h * 64, DM, KR + (size_t)b * TK * 32,
                                V1 + (size_t)b * TK * DM + h * 64, DM, TK / 64, O1 + q0, Gb + q0, DM, (char*)lds); }
    } SEAM(8);
    if (IN(9)) { pg8::Gemm g{O1, (const bf16_t*)(ws + WS_WOUT1), ML, 1024, 1024}; pg8::ROrder S; S.init(0, ML / 256, 1024, G, bx);
        pg8::EpiOut E{out, nullptr, out, nullptr, mod + 3 * 3072 + 2048};
        pg8::gemm_phase<pg8::EpiOut, pg8::ROrder, true, true>(ring, g, S, E); }
#undef IN
#undef SEAM
}

constexpr int NPHASE = 10;
#ifndef MK_ONE_LAUNCH
#define MK_ONE_LAUNCH 1
#endif
extern "C" void kernel_launch(void* const* d_in, const int* in_sizes, int n_in, void* d_out, int out_size, void* d_ws, size_t ws_size, hipStream_t stream) {
    static int grid = 0;
    if (grid == 0) {
        if (n_in != 23 || out_size != ML * DM || ws_size < WS_END) { fprintf(stderr, "kernel_launch: unexpected shapes n_in %d out %d ws %zu\n", n_in, out_size, ws_size); grid = -1; return; }
        int dev = 0, cus = 0, per_cu = 0;
        if (hipGetDevice(&dev) != hipSuccess || hipDeviceGetAttribute(&cus, hipDeviceAttributeMultiprocessorCount, dev) != hipSuccess) { grid = -1; return; }
        if (hipFuncSetAttribute((const void*)mega, hipFuncAttributeMaxDynamicSharedMemorySize, LDS_BYTES) != hipSuccess) { fprintf(stderr, "kernel_launch: hipFuncSetAttribute failed\n"); grid = -1; return; }
        if (hipOccupancyMaxActiveBlocksPerMultiprocessor(&per_cu, (const void*)mega, NTHREADS, LDS_BYTES) != hipSuccess || per_cu < 1) { fprintf(stderr, "kernel_launch: occupancy query says %d\n", per_cu); grid = -1; return; }
        grid = cus;
        if (grid != 256) fprintf(stderr, "kernel_launch: %d CUs (built for 256)\n", grid);
    }
    if (grid < 0) return;
    Args a{};
    for (int i = 0; i < 23; ++i) a.in[i] = (const float*)d_in[i];
    a.out = (float*)d_out; a.ws = (unsigned char*)d_ws;
#if MK_ONE_LAUNCH
    a.ph_lo = 0; a.ph_hi = NPHASE; a.coop = 1;
    void* args[] = {&a};
    const hipError_t e = hipLaunchCooperativeKernel((const void*)mega, dim3(grid), dim3(NTHREADS), args, LDS_BYTES, stream);
    if (e != hipSuccess) fprintf(stderr, "kernel_launch: cooperative launch failed: %s (grid %d)\n", hipGetErrorString(e), grid);
#else
    for (int p = 0; p < NPHASE; ++p) { a.ph_lo = p; a.ph_hi = p + 1; a.coop = 0; hipLaunchKernelGGL(mega, dim3(grid), dim3(NTHREADS), LDS_BYTES, stream, a); }
    const hipError_t le = hipPeekAtLastError();
    if (le != hipSuccess) fprintf(stderr, "kernel_launch: launch failed: %s\n", hipGetErrorName(le));
#endif
}
```

```cpp
#include <hip/hip_runtime.h>
#include <hip/hip_bf16.h>
#include <cstdio>
#include <cstdint>

#define DEVI __device__ __forceinline__
#define LAS __attribute__((address_space(3)))
#define GAS __attribute__((address_space(1)))

constexpr int NB = 2, SEQ = 8192, DM = 1024, CTXL = 256, TK = SEQ + CTXL;
constexpr int ML = NB * SEQ, MC = NB * CTXL, MT = ML + MC;
constexpr int GRIDW = 64;
constexpr float EPS = 1e-6f;
constexpr float LOG2E = 1.4426950408889634f;
constexpr int N_IN0 = 2560, N_IN1 = 1696, N_IN1P = 1792;
constexpr float C2_GQA = 0.125f * LOG2E;
constexpr float C2_MLA = 0.10206207261596575f * LOG2E;

typedef unsigned short bf16_t;
typedef short bf16x8 __attribute__((ext_vector_type(8)));
typedef short s16x4 __attribute__((ext_vector_type(4)));
typedef float f32x4 __attribute__((ext_vector_type(4)));
typedef float f32x2 __attribute__((ext_vector_type(2)));
typedef float f32x16 __attribute__((ext_vector_type(16)));
typedef unsigned u32x4 __attribute__((ext_vector_type(4)));
typedef unsigned u32x2 __attribute__((ext_vector_type(2)));

DEVI float bf2f(bf16_t v) { return __uint_as_float((unsigned)v << 16); }
DEVI unsigned f2bf(float f) { unsigned u = __float_as_uint(f); return (u + 0x7fffu + ((u >> 16) & 1u)) >> 16; }
DEVI unsigned pk2(float lo, float hi) { return f2bf(lo) | (f2bf(hi) << 16); }
DEVI float wave_sum(float v) {
#pragma unroll
    for (int o = 1; o < 64; o <<= 1) v += __shfl_xor(v, o);
    return v;
}
DEVI float silu_f(float v) { return v / (1.f + __expf(-v)); }
namespace pg8 {
#define PG8_LAS __attribute__((address_space(3)))
typedef unsigned short bf16_t;
typedef short bf16x8 __attribute__((ext_vector_type(8)));
typedef float f32x4 __attribute__((ext_vector_type(4)));
typedef unsigned u32x4 __attribute__((ext_vector_type(4)));
constexpr int BM = 256, BK = 64, HALF = 128, HTB = HALF * BK * 2  , STAGE_BYTES = 8 * HTB, NXCD = 8, WGM = 8;

__host__ __device__ __forceinline__ int lds_byte(int r, int c) { const int st = (r >> 4) * 2 + (c >> 5), rr = r & 15, cc = c & 31, ob = rr * 64 + cc * 2; return st * 1024 + (ob ^ (((ob >> 9) & 1) << 5)); }
__host__ __device__ __forceinline__ void stage_rc(int b, int& R, int& C) { const int st = b / 1024, sb = b % 1024, swz = sb ^ (((sb >> 9) & 1) << 5); R = (st >> 1) * 16 + swz / 64; C = (st & 1) * 32 + (swz % 64) / 2; }
__host__ __device__ __forceinline__ int perm32(int rho) { const int n = rho >> 4, i = rho & 15; return 8 * (i >> 2) + 4 * n + (i & 3); }

struct Unit { int pm, pn; };
struct Gemm { const bf16_t* A; const bf16_t* Bt; int M, N, K; };

struct StaticOrder {
    int nM, nN, nwg, G, c;
    __host__ __device__ void init(int M, int N, int G_, int c_) { nM = M / BM; nN = N / BM; nwg = nM * nN; G = G_; c = c_; }
    __host__ __device__ bool next(int i, Unit& u) const {
        const long L = (long)i * G + c; if (L >= nwg) return false;
        int wgid = (int)L; { const int q = nwg / NXCD, r = nwg % NXCD, xcd = wgid % NXCD, off = wgid / NXCD; wgid = (xcd < r ? xcd * (q + 1) : r * (q + 1) + (xcd - r) * q) + off; }
        const int nig = WGM * nN, gid = wgid / nig, fm = gid * WGM, gsz = (nM - fm) < WGM ? (nM - fm) : WGM;
        u.pm = fm + ((wgid % nig) % gsz); u.pn = (wgid % nig) / gsz; return true;
    }
    __device__ __forceinline__ void a_ready(const Unit&) const {}
    __device__ __forceinline__ void done(const Unit&) const {}
};


struct ROrder {
    int pm0, nM, nN, nwg, G, c, rep;
    __host__ __device__ void init(int pm0_, int npm, int N, int G_, int c_, int rep_ = 1) { pm0 = pm0_; nM = npm; nN = N / BM; nwg = nM * nN; G = G_; c = c_; rep = rep_; }
    __host__ __device__ bool next(int i, Unit& u) const {
        const long L = (long)i * G + c; if (L >= (long)nwg * rep) return false;
        int wgid = (int)(L % nwg); { const int q = nwg / NXCD, r = nwg % NXCD, xcd = wgid % NXCD, off = wgid / NXCD; wgid = (xcd < r ? xcd * (q + 1) : r * (q + 1) + (xcd - r) * q) + off; }
        const int nig = WGM * nN, gid = wgid / nig, fm = gid * WGM, gsz = (nM - fm) < WGM ? (nM - fm) : WGM;
        u.pm = pm0 + fm + ((wgid % nig) % gsz); u.pn = (wgid % nig) / gsz; return true;
    }
    __device__ __forceinline__ void a_ready(const Unit&) const {}
    __device__ __forceinline__ void done(const Unit&) const {}
};

struct EpiF32 {
    static constexpr bool PERM = true, AFTER_DRAIN = false;
    float* O; int ldc; int pmbase;
    __device__ __forceinline__ void operator()(const f32x4 (&acc)[2][2][4][2], const Unit& u, int wr, int wc, int fr, int fq) const {
        const int row0 = (u.pm - pmbase) * BM + wr * 64 + fr, col0 = u.pn * BM + wc * 32 + 8 * fq;
#pragma unroll
        for (int ai = 0; ai < 2; ++ai)
#pragma unroll
            for (int m = 0; m < 4; ++m) { float* rowp = O + (size_t)(row0 + ai * HALF + m * 16) * ldc + col0;
#pragma unroll
                for (int bj = 0; bj < 2; ++bj) { *(f32x4*)(rowp + bj * HALF) = acc[ai][bj][m][0]; *(f32x4*)(rowp + bj * HALF + 4) = acc[ai][bj][m][1]; } }
    }
};

DEVI unsigned cvt_pk_bf16(float lo, float hi) { unsigned r; asm volatile("v_cvt_pk_bf16_f32 %0, %1, %2" : "=v"(r) : "v"(lo), "v"(hi)); return r; }
DEVI u32x4 pack8(const f32x4 a, const f32x4 b) { u32x4 w; w.x = cvt_pk_bf16(a[0], a[1]); w.y = cvt_pk_bf16(a[2], a[3]); w.z = cvt_pk_bf16(b[0], b[1]); w.w = cvt_pk_bf16(b[2], b[3]); return w; }
DEVI float quad_sum(float s) { s += __shfl_xor(s, 16); s += __shfl_xor(s, 32); return s; }
DEVI float sq4(const f32x4 v) { return (v[0] * v[0] + v[1] * v[1]) + (v[2] * v[2] + v[3] * v[3]); }
DEVI f32x4 silu4(const f32x4 v) { f32x4 o; o[0] = silu_f(v[0]); o[1] = silu_f(v[1]); o[2] = silu_f(v[2]); o[3] = silu_f(v[3]); return o; }
DEVI int key_slot(int R) { return R < ML ? (R >> 13) * TK + CTXL + (R & (SEQ - 1)) : ((R - ML) >> 8) * TK + ((R - ML) & 255); }
DEVI void rot4(f32x4& x1, f32x4& x2, const f32x4 cs01, const f32x4 cs23) {
    const f32x4 c = {cs01[0], cs01[2], cs23[0], cs23[2]}, s = {cs01[1], cs01[3], cs23[1], cs23[3]};
    const f32x4 a = x1 * c - x2 * s, b = x2 * c + x1 * s; x1 = a; x2 = b;
}

DEVI int drope32(int i) { const int fq = i >> 3, n = (i >> 2) & 1, j = i & 3; return 16 * (fq >> 1) + 8 * n + 4 * (fq & 1) + j; }
DEVI int wmap(int mode, int p) {
    const int pn = p >> 8, q = p & 255, bj = q >> 7, wc = (q >> 5) & 3, i = q & 31;
    switch (mode) {
    case 1: {
        if (pn == 0 || (pn >= 2 && pn <= 5)) { const int fq = i >> 3, n = (i >> 2) & 1, j = i & 3; return 256 * pn + 64 * wc + 32 * bj + 16 * n + 4 * fq + j; }
        return p; }
    case 2: {
        if (pn == 0) return q;
        if (pn == 1) return 288 + q;
        if (pn == 2) { if (wc < 2) return 288 + 256 + 64 * wc + 32 * bj + i; if (wc == 2 && bj == 0) return 256 + drope32(i); return -1; }
        return 672 + 256 * (pn - 3) + q; }
    case 3: { const int head = 2 * pn + (wc >> 1), type = wc & 1; return 128 * head + 64 * type + 32 * bj + i; }
    case 4: { const int head = 2 * pn + (wc >> 1), type = wc & 1; if (type == 0) return 96 * head + 32 * bj + i; return bj == 0 ? 96 * head + 64 + drope32(i) : -1; }
    default: return p;
    }
}

struct EpiIn0 {
    static constexpr bool PERM = true, AFTER_DRAIN = false;
    const float* qn; const float* kn; const f32x4* tabA; bf16_t* K0; bf16_t* V0; bf16_t* Q0; bf16_t* G0;
    __device__ __forceinline__ void operator()(const f32x4 (&acc)[2][2][4][2], const Unit& u, int wr, int wc, int fr_, int fq_) const {
        int fr = fr_, fq = fq_; asm volatile("" : "+v"(fr), "+v"(fq));
        const int pn = u.pn; const bool lat = u.pm < ML / BM;
        if (pn == 0 || (pn >= 2 && pn <= 5)) {
            const float* wsrc = pn == 0 ? kn : qn; const float outs = pn == 0 ? 1.f : C2_GQA;
            f32x4 wv[2][2];
#pragma unroll
            for (int bj = 0; bj < 2; ++bj)
#pragma unroll
                for (int n = 0; n < 2; ++n) wv[bj][n] = *(const f32x4*)(wsrc + 32 * bj + 16 * n + 4 * fq) * outs;
#pragma unroll
            for (int ai = 0; ai < 2; ++ai)
#pragma unroll
                for (int m = 0; m < 4; ++m) {
                    const int R = u.pm * BM + ai * HALF + wr * 64 + m * 16 + fr;
                    f32x4 x[2][2]; float ss = 0.f;
#pragma unroll
                    for (int bj = 0; bj < 2; ++bj)
#pragma unroll
                        for (int n = 0; n < 2; ++n) { x[bj][n] = acc[ai][bj][m][n]; ss += sq4(x[bj][n]); }
                    const float rinv = rsqrtf(quad_sum(ss) * (1.f / 64.f) + EPS);
#pragma unroll
                    for (int bj = 0; bj < 2; ++bj)
#pragma unroll
                        for (int n = 0; n < 2; ++n) x[bj][n] = x[bj][n] * rinv * wv[bj][n];
                    if (lat) { const int t = R & (SEQ - 1), trow = t >> 6, tcol = t & 63;
                        const f32x4* tr = tabA + (trow * 16 + 4 * fq) / 2; const f32x4* tc = tabA + (tcol * 16 + 4 * fq) / 2;
                        rot4(x[0][0], x[0][1], tr[0], tr[1]); rot4(x[1][0], x[1][1], tc[0], tc[1]); }
                    if (pn == 0) { bf16_t* dst = K0 + (size_t)key_slot(R) * 256 + wc * 64 + 8 * fq;
                        *(u32x4*)dst = pack8(x[0][0], x[0][1]); *(u32x4*)(dst + 32) = pack8(x[1][0], x[1][1]); }
                    else { bf16_t* dst = Q0 + (size_t)R * DM + ((pn - 2) * 4 + wc) * 64 + 8 * fq;
                        *(u32x4*)dst = pack8(x[0][0], x[0][1]); *(u32x4*)(dst + 32) = pack8(x[1][0], x[1][1]); }
                }
        } else if (pn == 1) {
#pragma unroll
            for (int ai = 0; ai < 2; ++ai)
#pragma unroll
                for (int m = 0; m < 4; ++m) { const int R = u.pm * BM + ai * HALF + wr * 64 + m * 16 + fr; bf16_t* dst = V0 + (size_t)key_slot(R) * 256 + wc * 32 + 8 * fq;
#pragma unroll
                    for (int bj = 0; bj < 2; ++bj) *(u32x4*)(dst + bj * HALF) = pack8(acc[ai][bj][m][0], acc[ai][bj][m][1]); }
        } else {
#pragma unroll
            for (int ai = 0; ai < 2; ++ai)
#pragma unroll
                for (int m = 0; m < 4; ++m) { const int R = u.pm * BM + ai * HALF + wr * 64 + m * 16 + fr; bf16_t* dst = G0 + (size_t)R * DM + (pn - 6) * BM + wc * 32 + 8 * fq;
#pragma unroll
                    for (int bj = 0; bj < 2; ++bj) *(u32x4*)(dst + bj * HALF) = pack8(silu4(acc[ai][bj][m][0]), silu4(acc[ai][bj][m][1])); }
        }
    }
};

struct EpiOut {
    static constexpr bool PERM = true, AFTER_DRAIN = false;
    const float* baseL; const float* baseC; float* dstL; float* dstC; const float* gate;
    __device__ __forceinline__ void operator()(const f32x4 (&acc)[2][2][4][2], const Unit& u, int wr, int wc, int fr_, int fq_) const {
        int fr = fr_, fq = fq_; asm volatile("" : "+v"(fr), "+v"(fq));
        const int col0 = u.pn * BM + wc * 32 + 8 * fq;
#pragma unroll
        for (int ai = 0; ai < 2; ++ai)
#pragma unroll
            for (int m = 0; m < 4; ++m) { const int R = u.pm * BM + ai * HALF + wr * 64 + m * 16 + fr; const int r = R < SEQ ? 0 : (R < ML ? 1 : 2);
                const float* b = R < ML ? baseL + (size_t)R * DM : baseC + (size_t)(R - ML) * DM; float* d = R < ML ? dstL + (size_t)R * DM : dstC + (size_t)(R - ML) * DM;
                const float* g = gate + (size_t)r * 3072;
#pragma unroll
                for (int bj = 0; bj < 2; ++bj)
#pragma unroll
                    for (int n = 0; n < 2; ++n) { const int c = col0 + bj * HALF + 4 * n; *(f32x4*)(d + c) = *(const f32x4*)(b + c) + *(const f32x4*)(g + c) * acc[ai][bj][m][n]; } }
    }
};

struct EpiIn1 {
    static constexpr bool PERM = true, AFTER_DRAIN = false;
    const float* krn; const f32x4* tabB; bf16_t* KVA; float* SSKV; bf16_t* QA; float* SSQ; bf16_t* KR; bf16_t* G1;
    __device__ __forceinline__ void operator()(const f32x4 (&acc)[2][2][4][2], const Unit& u, int wr, int wc, int fr_, int fq_) const {
        int fr = fr_, fq = fq_; asm volatile("" : "+v"(fr), "+v"(fq));
        const int pn = u.pn; const bool lat = u.pm < ML / BM;
        if (pn >= 3) {
#pragma unroll
            for (int ai = 0; ai < 2; ++ai)
#pragma unroll
                for (int m = 0; m < 4; ++m) { const int R = u.pm * BM + ai * HALF + wr * 64 + m * 16 + fr; bf16_t* dst = G1 + (size_t)R * DM + (pn - 3) * BM + wc * 32 + 8 * fq;
#pragma unroll
                    for (int bj = 0; bj < 2; ++bj) *(u32x4*)(dst + bj * HALF) = pack8(silu4(acc[ai][bj][m][0]), silu4(acc[ai][bj][m][1])); }
        } else if (pn == 2 && wc == 2) {
            f32x4 wv[2];
#pragma unroll
            for (int n = 0; n < 2; ++n) wv[n] = *(const f32x4*)(krn + 16 * (fq >> 1) + 8 * n + 4 * (fq & 1));
#pragma unroll
            for (int ai = 0; ai < 2; ++ai)
#pragma unroll
                for (int m = 0; m < 4; ++m) { const int R = u.pm * BM + ai * HALF + wr * 64 + m * 16 + fr;
                    f32x4 x0 = acc[ai][0][m][0], x1 = acc[ai][0][m][1];
                    const float rinv = rsqrtf(quad_sum(sq4(x0) + sq4(x1)) * (1.f / 32.f) + EPS);
                    x0 = x0 * rinv * wv[0]; x1 = x1 * rinv * wv[1];
                    if (lat) { const int t = R & (SEQ - 1); const int pos = (fq >> 1) ? (t & 63) : (t >> 6); const f32x4* tp = tabB + (pos * 8 + 4 * (fq & 1)) / 2; rot4(x0, x1, tp[0], tp[1]); }
                    *(u32x4*)(KR + (size_t)key_slot(R) * 32 + 8 * fq) = pack8(x0, x1); }
        } else if (pn == 2 && wc == 3) {
        } else if (pn == 0 || lat) {
            bf16_t* base; float* ssb; int ld, cbase, nss, iss;
            if (pn == 0) { base = KVA; ld = 256; cbase = wc * 32; ssb = SSKV; nss = 4; iss = wc; }
            else if (pn == 1) { base = QA; ld = 384; cbase = wc * 32; ssb = SSQ; nss = 6; iss = wc; }
            else { base = QA; ld = 384; cbase = 256 + wc * 64; ssb = SSQ; nss = 6; iss = 4 + wc; }
            const int bjs = pn == 2 ? 32 : HALF;
#pragma unroll
            for (int ai = 0; ai < 2; ++ai)
#pragma unroll
                for (int m = 0; m < 4; ++m) { const int R = u.pm * BM + ai * HALF + wr * 64 + m * 16 + fr; bf16_t* dst = base + (size_t)R * ld + cbase + 8 * fq; float ss = 0.f;
#pragma unroll
                    for (int bj = 0; bj < 2; ++bj) { ss += sq4(acc[ai][bj][m][0]) + sq4(acc[ai][bj][m][1]); *(u32x4*)(dst + bj * bjs) = pack8(acc[ai][bj][m][0], acc[ai][bj][m][1]); }
                    ss = quad_sum(ss); if (fq == 0) ssb[(size_t)R * nss + iss] = ss; }
        }
    }
};

struct EpiKvb {
    static constexpr bool PERM = true, AFTER_DRAIN = false;
    const float* SSKV; const float* knn; bf16_t* K1; bf16_t* V1;
    __device__ __forceinline__ void operator()(const f32x4 (&acc)[2][2][4][2], const Unit& u, int wr, int wc, int fr_, int fq_) const {
        int fr = fr_, fq = fq_; asm volatile("" : "+v"(fr), "+v"(fq));
        const int head = 2 * u.pn + (wc >> 1), type = wc & 1;
#pragma unroll
        for (int ai = 0; ai < 2; ++ai)
#pragma unroll
            for (int m = 0; m < 4; ++m) { const int R = u.pm * BM + ai * HALF + wr * 64 + m * 16 + fr;
                asm volatile("" ::: "memory");
                const f32x4 s4 = *(const f32x4*)(SSKV + (size_t)R * 4); const float rkv = rsqrtf(((s4[0] + s4[1]) + (s4[2] + s4[3])) * (1.f / 256.f) + EPS);
                f32x4 x[2][2]; float ss = 0.f;
#pragma unroll
                for (int bj = 0; bj < 2; ++bj)
#pragma unroll
                    for (int n = 0; n < 2; ++n) { x[bj][n] = acc[ai][bj][m][n] * rkv; ss += sq4(x[bj][n]); }
                bf16_t* dst = (type == 0 ? K1 : V1) + (size_t)key_slot(R) * DM + head * 64 + 8 * fq;
                if (type == 0) { const float rinv = rsqrtf(quad_sum(ss) * (1.f / 64.f) + EPS);
#pragma unroll
                    for (int bj = 0; bj < 2; ++bj)
#pragma unroll
                        for (int n = 0; n < 2; ++n) x[bj][n] = x[bj][n] * rinv * *(const f32x4*)(knn + 32 * bj + 8 * fq + 4 * n); }
                *(u32x4*)dst = pack8(x[0][0], x[0][1]); *(u32x4*)(dst + 32) = pack8(x[1][0], x[1][1]); }
    }
};

struct EpiQb {
    static constexpr bool PERM = true, AFTER_DRAIN = false;
    const float* SSQ; const float* qnw; const f32x4* tabB; bf16_t* Q1N; bf16_t* Q1R; float* SSH;
    __device__ __forceinline__ float rqa_of(int R) const { const float* sp = SSQ + (size_t)R * 6; const f32x2 sa = *(const f32x2*)sp, sb = *(const f32x2*)(sp + 2), sc = *(const f32x2*)(sp + 4);
        return rsqrtf(((sa[0] + sa[1]) + (sb[0] + sb[1]) + (sc[0] + sc[1])) * (1.f / 384.f) + EPS); }
    __device__ __forceinline__ void operator()(const f32x4 (&acc)[2][2][4][2], const Unit& u, int wr, int wc, int fr_, int fq_) const {
        int fr = fr_, fq = fq_; asm volatile("" : "+v"(fr), "+v"(fq));
        const int head = 2 * u.pn + (wc >> 1);
        if ((wc & 1) == 0) {
#pragma unroll
            for (int ai = 0; ai < 2; ++ai)
#pragma unroll
                for (int m = 0; m < 4; ++m) { const int R = u.pm * BM + ai * HALF + wr * 64 + m * 16 + fr;
                    asm volatile("" ::: "memory");
                    const float rqa = rqa_of(R); float ss = 0.f; bf16_t* dst = Q1N + (size_t)R * DM + head * 64 + 8 * fq;
#pragma unroll
                    for (int bj = 0; bj < 2; ++bj) { f32x4 x0 = acc[ai][bj][m][0] * rqa, x1 = acc[ai][bj][m][1] * rqa; ss += sq4(x0) + sq4(x1);
                        x0 = x0 * *(const f32x4*)(qnw + 32 * bj + 8 * fq); x1 = x1 * *(const f32x4*)(qnw + 32 * bj + 8 * fq + 4); *(u32x4*)(dst + 32 * bj) = pack8(x0, x1); }
                    ss = quad_sum(ss); if (fq == 0) SSH[((size_t)R * 16 + head) * 2] = ss; }
        } else {
#pragma unroll
            for (int ai = 0; ai < 2; ++ai)
#pragma unroll
                for (int m = 0; m < 4; ++m) { const int R = u.pm * BM + ai * HALF + wr * 64 + m * 16 + fr;
                    asm volatile("" ::: "memory");
                    const float rqa = rqa_of(R);
                    f32x4 x0 = acc[ai][0][m][0] * rqa, x1 = acc[ai][0][m][1] * rqa; const float ss = quad_sum(sq4(x0) + sq4(x1)); if (fq == 0) SSH[((size_t)R * 16 + head) * 2 + 1] = ss;
                    const float* wp = qnw + 64 + 16 * (fq >> 1) + 4 * (fq & 1); x0 = x0 * *(const f32x4*)wp; x1 = x1 * *(const f32x4*)(wp + 8);
                    const int t = R & (SEQ - 1); const int pos = (fq >> 1) ? (t & 63) : (t >> 6); const f32x4* tp = tabB + (pos * 8 + 4 * (fq & 1)) / 2; rot4(x0, x1, tp[0], tp[1]);
                    *(u32x4*)(Q1R + (size_t)R * 512 + head * 32 + 8 * fq) = pack8(x0, x1); }
        }
    }
};

struct In1Order {
    int G, c; ROrder lat;
    __host__ __device__ void init(int G_, int c_) { G = G_; c = c_; lat.init(0, ML / BM, N_IN1P, G_, c_); }
    __host__ __device__ bool next(int i, Unit& u) const {
        const long L = (long)i * G + c; if (L < lat.nwg) return lat.next(i, u);
        const int e = (int)(L - lat.nwg); if (e >= 4) return false; u.pm = ML / BM + (e >> 1); u.pn = (e & 1) * 2; return true;
    }
    __device__ __forceinline__ void a_ready(const Unit&) const {}
    __device__ __forceinline__ void done(const Unit&) const {}
};
template <class Epi, class Sched, bool ALIGN_EPI = false, bool SP2 = false>
__device__ __forceinline__ void gemm_phase(PG8_LAS unsigned char* lds, const Gemm g, const Sched& S, const Epi& E) {
    const int tid = threadIdx.x, wid = __builtin_amdgcn_readfirstlane(tid >> 6), lane = tid & 63, wr = wid >> 2, wc = wid & 3, fr = lane & 15, fq = lane >> 4;
    const int K = g.K, nt = K / BK;
    unsigned voffA[2], voffB[2];
#pragma unroll
    for (int i = 0; i < 2; ++i) { int R, C; stage_rc(tid * 16 + i * 8192, R, C); const int Rb = Epi::PERM ? ((R & ~31) + perm32(R & 31)) : R;
        voffA[i] = (unsigned)(R * K + C) * 2u; voffB[i] = (unsigned)(Rb * K + C) * 2u; }
    const size_t kstep = (size_t)(BK * 2);
    const size_t hstep = (size_t)HALF * K * 2;
    const size_t tstep = 2 * hstep;
    const unsigned ldsw = (unsigned)wid * 1024u;
    const int aoff = lds_byte(wr * 64 + fr, fq * 8), boff = lds_byte(wc * 32 + fr, fq * 8);
#define PG8_SA(b, h) (((b) * 2 + (h)) * HTB)
#define PG8_SB(b, h) ((4 + (b) * 2 + (h)) * HTB)
#define PG8_STAGE(bufoff, gbase, voff) do { _Pragma("unroll") for (int _i = 0; _i < 2; ++_i) \
        __builtin_amdgcn_global_load_lds((const unsigned*)((const char*)(gbase) + (voff)[_i]), (PG8_LAS unsigned*)(lds + (bufoff) + ldsw + _i * 8192), 16, 0, 0); } while (0)
#define PG8_LDA(dst, b, h) do { _Pragma("unroll") for (int m = 0; m < 4; ++m) _Pragma("unroll") for (int k = 0; k < 2; ++k) dst[m][k] = *(const PG8_LAS bf16x8*)(lds + PG8_SA(b, h) + aoff + m * 2048 + k * 1024); } while (0)
#define PG8_LDB(dst, b, h) do { _Pragma("unroll") for (int n = 0; n < 2; ++n) _Pragma("unroll") for (int k = 0; k < 2; ++k) dst[n][k] = *(const PG8_LAS bf16x8*)(lds + PG8_SB(b, h) + boff + n * 2048 + k * 1024); } while (0)
#define PG8_MMA(ai, bj, At, Bt) do { __builtin_amdgcn_s_setprio(1); _Pragma("unroll") for (int m = 0; m < 4; ++m) _Pragma("unroll") for (int n = 0; n < 2; ++n) _Pragma("unroll") for (int k = 0; k < 2; ++k) \
        acc[ai][bj][m][n] = __builtin_amdgcn_mfma_f32_16x16x32_bf16(Bt[n][k], At[m][k], acc[ai][bj][m][n], 0, 0, 0); __builtin_amdgcn_s_setprio(0); } while (0)
#define PG8_WAIT_V(n) asm volatile("s_waitcnt vmcnt(" #n ")" ::: "memory")
#define PG8_WAIT_L(n) asm volatile("s_waitcnt lgkmcnt(" #n ")" ::: "memory")
#define PG8_BAR __builtin_amdgcn_s_barrier()
#define PG8_SCHED __builtin_amdgcn_sched_barrier(0)
    Unit cur, nxt; int ui = 0;
    if (!S.next(0, cur)) return;
    f32x4 acc[2][2][4][2];
#pragma unroll
    for (int a = 0; a < 2; ++a)
#pragma unroll
        for (int b = 0; b < 2; ++b)
#pragma unroll
            for (int m = 0; m < 4; ++m)
#pragma unroll
                for (int n = 0; n < 2; ++n) acc[a][b][m][n] = (f32x4){0.f, 0.f, 0.f, 0.f};
    bf16x8 At[4][2], B0[2][2], B1[2][2];
    const char* cA = (const char*)g.A + (size_t)cur.pm * tstep; const char* cB = (const char*)g.Bt + (size_t)cur.pn * tstep;
    S.a_ready(cur);
    if constexpr (SP2) {
        PG8_STAGE(PG8_SB(0, 0), cB, voffB); PG8_STAGE(PG8_SB(0, 1), cB + hstep, voffB); PG8_STAGE(PG8_SA(0, 0), cA, voffA); PG8_STAGE(PG8_SA(0, 1), cA + hstep, voffA);
        if (wr == 1) PG8_BAR;
        PG8_WAIT_V(2); PG8_BAR;
        PG8_STAGE(PG8_SB(1, 0), cB + kstep, voffB); PG8_STAGE(PG8_SA(1, 0), cA + kstep, voffA); PG8_STAGE(PG8_SB(1, 1), cB + hstep + kstep, voffB);
        PG8_WAIT_V(6); PG8_BAR;
    } else {
        PG8_STAGE(PG8_SB(0, 0), cB, voffB); PG8_STAGE(PG8_SA(0, 0), cA, voffA); PG8_STAGE(PG8_SB(0, 1), cB + hstep, voffB); PG8_STAGE(PG8_SA(0, 1), cA + hstep, voffA);
        if (wr == 1) PG8_BAR;
        PG8_WAIT_V(4); PG8_BAR;
        PG8_STAGE(PG8_SB(1, 0), cB + kstep, voffB); PG8_STAGE(PG8_SA(1, 0), cA + kstep, voffA); PG8_STAGE(PG8_SB(1, 1), cB + hstep + kstep, voffB);
        PG8_WAIT_V(6); PG8_BAR;
    }
    for (;;) {
        const bool has_next = S.next(ui + 1, nxt);
        const char* nA = has_next ? (const char*)g.A + (size_t)nxt.pm * tstep : cA; const char* nB = has_next ? (const char*)g.Bt + (size_t)nxt.pn * tstep : cB;
        _Pragma("nounroll") for (int t = 0; t < nt; t += 2) {
            const bool last = (t == nt - 2);
            const char* a1 = cA + (size_t)(t + 1) * kstep;
            const char* a2 = last ? nA : cA + (size_t)(t + 2) * kstep; const char* b2 = last ? nB : cB + (size_t)(t + 2) * kstep;
            const char* a3 = a2 + kstep; const char* b3 = b2 + kstep;
            if (last && has_next) S.a_ready(nxt);
            if constexpr (SP2) {
            PG8_LDB(B0, 0, 0); PG8_LDB(B1, 0, 1); PG8_SCHED; PG8_LDA(At, 0, 0); PG8_STAGE(PG8_SA(1, 1), a1 + hstep, voffA);
            PG8_WAIT_V(8); PG8_WAIT_L(0); PG8_BAR; PG8_MMA(0, 0, At, B0); PG8_MMA(0, 1, At, B1); PG8_BAR; PG8_SCHED;
            PG8_LDA(At, 0, 1); PG8_STAGE(PG8_SB(0, 0), b2, voffB); PG8_STAGE(PG8_SB(0, 1), b2 + hstep, voffB); PG8_STAGE(PG8_SA(0, 0), a2, voffA);
            PG8_WAIT_V(8); PG8_WAIT_L(0); PG8_BAR; PG8_MMA(1, 0, At, B0); PG8_MMA(1, 1, At, B1); PG8_BAR; PG8_SCHED;
            PG8_LDB(B0, 1, 0); PG8_LDB(B1, 1, 1); PG8_SCHED; PG8_LDA(At, 1, 0); PG8_STAGE(PG8_SA(0, 1), a2 + hstep, voffA);
            PG8_WAIT_V(8); PG8_WAIT_L(0); PG8_BAR; PG8_MMA(0, 0, At, B0); PG8_MMA(0, 1, At, B1); PG8_BAR; PG8_SCHED;
            PG8_LDA(At, 1, 1); PG8_STAGE(PG8_SB(1, 0), b3, voffB); PG8_STAGE(PG8_SB(1, 1), b3 + hstep, voffB); PG8_STAGE(PG8_SA(1, 0), a3, voffA);
            PG8_WAIT_V(8); PG8_WAIT_L(0); PG8_BAR; PG8_MMA(1, 0, At, B0); PG8_MMA(1, 1, At, B1); PG8_BAR; PG8_SCHED;
            } else {
            PG8_LDB(B0, 0, 0); PG8_SCHED; PG8_LDA(At, 0, 0); PG8_STAGE(PG8_SA(1, 1), a1 + hstep, voffA);
            PG8_WAIT_L(8); PG8_BAR; PG8_WAIT_L(0); PG8_MMA(0, 0, At, B0); PG8_BAR; PG8_SCHED;
            PG8_LDB(B1, 0, 1); PG8_STAGE(PG8_SB(0, 0), b2, voffB);
            PG8_BAR; PG8_WAIT_L(0); PG8_MMA(0, 1, At, B1); PG8_BAR;
            PG8_LDA(At, 0, 1); PG8_STAGE(PG8_SA(0, 0), a2, voffA);
            PG8_BAR; PG8_WAIT_L(0); PG8_MMA(1, 0, At, B0); PG8_BAR; PG8_SCHED;
            PG8_STAGE(PG8_SB(0, 1), b2 + hstep, voffB);
            PG8_WAIT_V(6); PG8_BAR; PG8_MMA(1, 1, At, B1); PG8_BAR;
            PG8_LDB(B0, 1, 0); PG8_SCHED; PG8_LDA(At, 1, 0); PG8_STAGE(PG8_SA(0, 1), a2 + hstep, voffA);
            PG8_WAIT_L(8); PG8_BAR; PG8_WAIT_L(0); PG8_MMA(0, 0, At, B0); PG8_BAR; PG8_SCHED;
            PG8_LDB(B1, 1, 1); PG8_STAGE(PG8_SB(1, 0), b3, voffB);
            PG8_BAR; PG8_WAIT_L(0); PG8_MMA(0, 1, At, B1); PG8_BAR;
            PG8_LDA(At, 1, 1); PG8_STAGE(PG8_SA(1, 0), a3, voffA);
            PG8_BAR; PG8_WAIT_L(0); PG8_MMA(1, 0, At, B0); PG8_BAR; PG8_SCHED;
            PG8_STAGE(PG8_SB(1, 1), b3 + hstep, voffB);
            PG8_WAIT_V(6); PG8_BAR; PG8_MMA(1, 1, At, B1); PG8_BAR;
            }
        }
        if constexpr (ALIGN_EPI) { if (wr == 0) PG8_BAR; }
        if constexpr (!Epi::AFTER_DRAIN) { E(acc, cur, wr, wc, fr, fq); S.done(cur); }
        if (!has_next) break;
#pragma unroll
        for (int a = 0; a < 2; ++a)
#pragma unroll
            for (int b = 0; b < 2; ++b)
#pragma unroll
                for (int m = 0; m < 4; ++m)
#pragma unroll
                    for (int n = 0; n < 2; ++n) acc[a][b][m][n] = (f32x4){0.f, 0.f, 0.f, 0.f};
        cur = nxt; cA = nA; cB = nB; ++ui;
        if constexpr (ALIGN_EPI) { if (wr == 1) PG8_BAR; }
    }
    PG8_WAIT_V(0);
    if constexpr (!ALIGN_EPI) { if (wr == 0) PG8_BAR; }
    PG8_BAR;
    if constexpr (Epi::AFTER_DRAIN) { E.fused(acc, cur, wr, wc, fr, fq, lds, wid, lane); S.done(cur); }
#undef PG8_SA
#undef PG8_SB
#undef PG8_STAGE
#undef PG8_LDA
#undef PG8_LDB
#undef PG8_MMA
#undef PG8_WAIT_V
#undef PG8_WAIT_L
#undef PG8_BAR
#undef PG8_SCHED
}
}

DEVI void sincos_pos(float ang, float& cs, float& sn) {
    const double TWO_PI = 6.283185307179586476925286766559; const double a = (double)ang; const double k = __builtin_rint(a * (1.0 / TWO_PI));
    const float r = (float)(a - k * TWO_PI);
    cs = cosf(r); sn = sinf(r);
}

namespace afast {
constexpr int NW = 8, KVBLK = 64, SLOTK = 12288, SLOTV = 8192, KROFF = 8192;
constexpr int LDS_K = 0, LDS_V = 3 * SLOTK, LDS_WS = LDS_V + 3 * SLOTV, LDS_OST = LDS_WS + NW * 256, LDS_BYTES = LDS_OST + NW * 4096;
#define SBAR() __builtin_amdgcn_sched_barrier(0)
#define PIN(x) asm volatile("" : "+v"(x))
#define MFMA(a, b, c) __builtin_amdgcn_mfma_f32_32x32x16_bf16(a, b, c, 0, 0, 0)
#define WAIT_BAR(N) asm volatile("s_waitcnt vmcnt(" #N ") lgkmcnt(0)\n\ts_barrier" ::: "memory")
DEVI int crow(int r, int hi) { return (r & 3) + 8 * (r >> 2) + 4 * hi; }
DEVI unsigned cvtpk(float lo, float hi) { unsigned r; asm("v_cvt_pk_bf16_f32 %0, %1, %2" : "=v"(r) : "v"(lo), "v"(hi)); return r; }
DEVI void glds16(const void* g, unsigned lds_base) {
    unsigned sv; asm volatile("s_mov_b32 %0, m0\n\ts_mov_b32 m0, %2\n\ts_nop 0\n\tglobal_load_lds_dwordx4 %1, off\n\ts_mov_b32 m0, %0" : "=&s"(sv) : "v"(g), "s"(lds_base) : "memory"); }
typedef __attribute__((address_space(3))) const char* lds_cptr;
typedef short v4i16_t __attribute__((ext_vector_type(4)));
DEVI bf16x8 ldsb128(lds_cptr p) { return *(const __attribute__((address_space(3))) bf16x8*)p; }
DEVI s16x4 vtr(lds_cptr p) { return __builtin_bit_cast(s16x4, __builtin_amdgcn_ds_read_tr16_b64_v4i16((__attribute__((address_space(3))) v4i16_t*)p)); }
DEVI bf16x8 scale8(bf16x8 v, float s) {
    u32x4 w = __builtin_bit_cast(u32x4, v); u32x4 o;
#pragma unroll
    for (int i = 0; i < 4; ++i) { const float lo = __uint_as_float(w[i] << 16) * s, hi = __uint_as_float(w[i] & 0xffff0000u) * s; o[i] = cvtpk(lo, hi); }
    return __builtin_bit_cast(bf16x8, o);
}

template <int ROPE>
DEVI void attn_unit(const bf16_t* Qn, int ldq, const bf16_t* Qr, const float* ssh, const bf16_t* __restrict__ Kn, int ldk, const bf16_t* __restrict__ Kr,
                    const bf16_t* __restrict__ V, int ldv, int NT, bf16_t* O, const bf16_t* G, int ldo, char* lds) {
    const int tid = threadIdx.x, lane = tid & 63, r32 = lane & 31, hi = lane >> 5; const int wid = __builtin_amdgcn_readfirstlane(tid >> 6);
    const unsigned lds0 = (unsigned)(uintptr_t)lds; float* wsf = (float*)(lds + LDS_WS) + wid * 64;
    const bf16_t* ksrc = Kn + (size_t)lane * ldk + wid * 8;
    const bf16_t* vsrc = V + (size_t)(16 * (wid & 3) + (lane >> 2)) * ldv + (wid >> 2) * 32 + (lane & 3) * 8;
    const bf16_t* krsrc = ROPE ? Kr + (size_t)(32 * (wid & 1) + r32) * 32 + 8 * (2 * ((wid >> 1) & 1) + hi) : nullptr;
    const unsigned kdst = lds0 + LDS_K + wid * 1024, vdst = lds0 + LDS_V + wid * 1024, krdst = lds0 + LDS_K + KROFF + (wid & 3) * 1024;
    const bool rwave = ROPE && wid < 4;
#define DMA_K(t, slot) do { if (ROPE) { if (rwave) glds16(krsrc + (size_t)(t) * KVBLK * 32, (unsigned)__builtin_amdgcn_readfirstlane(krdst + (slot))); } \
        glds16(ksrc + (size_t)(t) * KVBLK * ldk, (unsigned)__builtin_amdgcn_readfirstlane(kdst + (slot))); } while (0)
#define DMA_V(t, slot) glds16(vsrc + (size_t)(t) * KVBLK * ldv, (unsigned)__builtin_amdgcn_readfirstlane(vdst + (slot)))
    const lds_cptr vp0 = (lds_cptr)lds + LDS_V + ((lane >> 4) & 1) * 32 + (lane & 3) * 8 + (4 * hi + ((lane & 15) >> 2)) * 64;
    const lds_cptr kp0 = (lds_cptr)lds + LDS_K + hi * 1024 + r32 * 16;
    const lds_cptr krp0 = (lds_cptr)lds + LDS_K + KROFF + hi * 512 + r32 * 16;
    DMA_K(0, 0); DMA_V(0, 0); DMA_K(1, SLOTK);
    bf16x8 qr[4]; bf16x8 qrr[2];
    { const bf16_t* Qw = Qn + (size_t)(wid * 32 + r32) * ldq + hi * 8;
#pragma unroll
      for (int d0 = 0; d0 < 4; ++d0) qr[d0] = *reinterpret_cast<const bf16x8*>(Qw + d0 * 16);
      if (ROPE) { const bf16_t* Qrw = Qr + (size_t)(wid * 32 + r32) * 512 + hi * 8;
#pragma unroll
          for (int d0 = 0; d0 < 2; ++d0) qrr[d0] = *reinterpret_cast<const bf16x8*>(Qrw + d0 * 16);
          const f32x2 s2 = *(const f32x2*)(ssh + (size_t)(wid * 32 + r32) * 32); const float sc = rsqrtf((s2[0] + s2[1]) * (1.f / 96.f) + EPS) * C2_MLA;
#pragma unroll
          for (int d0 = 0; d0 < 4; ++d0) qr[d0] = scale8(qr[d0], sc);
#pragma unroll
          for (int d0 = 0; d0 < 2; ++d0) qrr[d0] = scale8(qrr[d0], sc); } }
    float l_reg = 0.f; f32x16 o[2]; o[0] = f32x16{}; o[1] = f32x16{};
    const f32x16 zero16 = f32x16{};
    f32x16 pA0, pA1, pB0, pB1; bf16x8 kf[8]; bf16x8 kfr[4]; s16x4 vlo[8], vhi[8]; u32x4 pw0, pw1, pw2, pw3;
    int sl_prev = 0, sl_cur = 0, sl_next = SLOTK;
#define VSL(s) (((s) / (SLOTK / 1024)) * (SLOTV / 1024))
#define ROT() do { sl_prev = sl_cur; sl_cur = sl_next; sl_next = (sl_next == 2 * SLOTK) ? 0 : sl_next + SLOTK; } while (0)
#define EX(v) __builtin_amdgcn_exp2f(v)
#define KLOADALL(slot) do { _Pragma("unroll") for (int d0 = 0; d0 < 4; ++d0) { kf[2 * d0] = ldsb128(kp0 + (slot) + d0 * 2048); kf[2 * d0 + 1] = ldsb128(kp0 + (slot) + d0 * 2048 + 512); } \
        if (ROPE) { _Pragma("unroll") for (int q = 0; q < 4; ++q) kfr[q] = ldsb128(krp0 + (slot) + q * 1024); } } while (0)
    DMA_K(2, 2 * SLOTK);
    WAIT_BAR(3);
    KLOADALL(0);
    pA0 = MFMA(kf[0], qr[0], zero16); pA1 = MFMA(kf[1], qr[0], zero16); pA0 = MFMA(kf[2], qr[1], pA0); pA1 = MFMA(kf[3], qr[1], pA1);
    pA0 = MFMA(kf[4], qr[2], pA0); pA1 = MFMA(kf[5], qr[2], pA1); pA0 = MFMA(kf[6], qr[3], pA0); pA1 = MFMA(kf[7], qr[3], pA1);
    if (ROPE) { pA0 = MFMA(kfr[0], qrr[0], pA0); pA1 = MFMA(kfr[1], qrr[0], pA1); pA0 = MFMA(kfr[2], qrr[1], pA0); pA1 = MFMA(kfr[3], qrr[1], pA1); }
#pragma unroll
    for (int r = 0; r < 16; ++r) { pA0[r] = EX(pA0[r]); pA1[r] = EX(pA1[r]); }
    WAIT_BAR(0);
    DMA_K(3, 0); DMA_V(1, SLOTV); ROT();
    KLOADALL(sl_cur);
    WAIT_BAR(2);
#define PKW(P, i) cvtpk(P[i], P[i + 1])
#define PAF(k) __builtin_bit_cast(bf16x8, pw##k)
#define VFR(i) (bf16x8){vlo[i][0], vlo[i][1], vlo[i][2], vlo[i][3], vhi[i][0], vhi[i][1], vhi[i][2], vhi[i][3]}
#define VRD(i) do { vlo[i] = vtr(vp_ + (((i) >> 2) * 4096 + ((i) & 3) * 1024)); vhi[i] = vtr(vp_ + (((i) >> 2) * 4096 + ((i) & 3) * 1024 + 512)); } while (0)
#define KRD(G, d0) do { if (G) { kf[2 * (d0)] = ldsb128(kp0 + sl_next + (d0) * 2048); kf[2 * (d0) + 1] = ldsb128(kp0 + sl_next + (d0) * 2048 + 512); SBAR(); } } while (0)
#define KRR(G, q) do { if (ROPE) { if (G) { kfr[2 * (q)] = ldsb128(krp0 + sl_next + (2 * (q)) * 1024); kfr[2 * (q) + 1] = ldsb128(krp0 + sl_next + (2 * (q) + 1) * 1024); SBAR(); } } } while (0)
#define GAPA4(CX, MF, a0, a1, a2, a3, W0, W1, PW) do { MF; sacc += a0; sacc += a1; sacc += a2; sacc += a3; W0; W1; PIN(PW); PIN(sacc); PIN(CX); SBAR(); } while (0)
#define GAPA3(CX, MF, a0, a1, a2, W0, W1, PW) do { MF; sacc += a0; sacc += a1; sacc += a2; W0; W1; PIN(PW); PIN(sacc); PIN(CX); SBAR(); } while (0)
#define GAPA31(CX, MF, a0, a1, a2, W0, PW) do { MF; sacc += a0; sacc += a1; sacc += a2; W0; PIN(PW); PIN(sacc); PIN(CX); SBAR(); } while (0)
#define GAPA21(CX, MF, a0, a1, W0, PW) do { MF; sacc += a0; sacc += a1; W0; PIN(PW); PIN(sacc); PIN(CX); SBAR(); } while (0)
#define GAPB(MF, X, i) do { MF; X[i] = EX(X[i]); X[i + 1] = EX(X[i + 1]); X[i + 2] = EX(X[i + 2]); X[i + 3] = EX(X[i + 3]); PIN(X); SBAR(); } while (0)
#define STEP(C0, C1, P0, P1, t, GK, GV, GL) do { SBAR(); \
    const lds_cptr vp_ = vp0 + VSL(sl_prev); \
    VRD(0); SBAR(); float sacc = P0[0] + P0[1]; \
    if (!ROPE) { \
                        GAPA4(C0, C0 = MFMA(kf[0], qr[0], zero16), P0[2], P0[3], P0[4], P0[5],     pw0[0] = PKW(P0, 0),  pw0[1] = PKW(P0, 2),  pw0); \
        VRD(4); SBAR(); GAPA4(C1, C1 = MFMA(kf[1], qr[0], zero16), P0[6], P0[7], P0[8], P0[9],     pw0[2] = PKW(P0, 4),  pw0[3] = PKW(P0, 6),  pw0); \
        VRD(1); SBAR(); GAPA4(C0, C0 = MFMA(kf[2], qr[1], C0),    P0[10], P0[11], P0[12], P0[13], pw1[0] = PKW(P0, 8),  pw1[1] = PKW(P0, 10), pw1); \
        VRD(5); SBAR(); GAPA4(C1, C1 = MFMA(kf[3], qr[1], C1),    P0[14], P0[15], P1[0], P1[1],   pw1[2] = PKW(P0, 12), pw1[3] = PKW(P0, 14), pw1); \
        VRD(2); SBAR(); GAPA4(C0, C0 = MFMA(kf[4], qr[2], C0),    P1[2], P1[3], P1[4], P1[5],     pw2[0] = PKW(P1, 0),  pw2[1] = PKW(P1, 2),  pw2); \
        VRD(6); SBAR(); GAPA4(C1, C1 = MFMA(kf[5], qr[2], C1),    P1[6], P1[7], P1[8], P1[9],     pw2[2] = PKW(P1, 4),  pw2[3] = PKW(P1, 6),  pw2); \
        VRD(3); SBAR(); GAPA4(C0, C0 = MFMA(kf[6], qr[3], C0),    P1[10], P1[11], P1[12], P1[13], pw3[0] = PKW(P1, 8),  pw3[1] = PKW(P1, 10), pw3); \
        VRD(7); SBAR(); GAPA4(C1, C1 = MFMA(kf[7], qr[3], C1),    P1[14], P1[15], 0.f, 0.f,       pw3[2] = PKW(P1, 12), pw3[3] = PKW(P1, 14), pw3); \
    } else { \
                        GAPA3(C0, C0 = MFMA(kf[0], qr[0], zero16), P0[2], P0[3], P0[4],    pw0[0] = PKW(P0, 0),  pw0[1] = PKW(P0, 2),  pw0); \
        VRD(4); SBAR(); GAPA3(C1, C1 = MFMA(kf[1], qr[0], zero16), P0[5], P0[6], P0[7],    pw0[2] = PKW(P0, 4),  pw0[3] = PKW(P0, 6),  pw0); \
        VRD(1); SBAR(); GAPA3(C0, C0 = MFMA(kf[2], qr[1], C0),    P0[8], P0[9], P0[10],   pw1[0] = PKW(P0, 8),  pw1[1] = PKW(P0, 10), pw1); \
        VRD(5); SBAR(); GAPA3(C1, C1 = MFMA(kf[3], qr[1], C1),    P0[11], P0[12], P0[13], pw1[2] = PKW(P0, 12), pw1[3] = PKW(P0, 14), pw1); \
        VRD(2); SBAR(); GAPA31(C0, C0 = MFMA(kf[4], qr[2], C0),   P0[14], P0[15], P1[0],  pw2[0] = PKW(P1, 0),  pw2); \
        VRD(6); SBAR(); GAPA31(C1, C1 = MFMA(kf[5], qr[2], C1),   P1[1], P1[2], P1[3],    pw2[1] = PKW(P1, 2),  pw2); \
        VRD(3); SBAR(); GAPA21(C0, C0 = MFMA(kf[6], qr[3], C0),   P1[4], P1[5],           pw2[2] = PKW(P1, 4),  pw2); \
        VRD(7); SBAR(); GAPA21(C1, C1 = MFMA(kf[7], qr[3], C1),   P1[6], P1[7],           pw2[3] = PKW(P1, 6),  pw2); \
                        GAPA21(C0, C0 = MFMA(kfr[0], qrr[0], C0), P1[8], P1[9],           pw3[0] = PKW(P1, 8),  pw3); \
                        GAPA21(C1, C1 = MFMA(kfr[1], qrr[0], C1), P1[10], P1[11],         pw3[1] = PKW(P1, 10), pw3); \
                        GAPA21(C0, C0 = MFMA(kfr[2], qrr[1], C0), P1[12], P1[13],         pw3[2] = PKW(P1, 12), pw3); \
                        GAPA21(C1, C1 = MFMA(kfr[3], qrr[1], C1), P1[14], P1[15],         pw3[3] = PKW(P1, 14), pw3); \
    } \
    l_reg += sacc; \
    if (GK) DMA_K((t) + 3, sl_cur); if (GV) DMA_V((t) + 1, VSL(sl_next)); \
    SBAR(); \
    GAPB(o[0] = MFMA(PAF(0), VFR(0), o[0]), C0, 0); \
    KRD(GL, 0); GAPB(o[1] = MFMA(PAF(0), VFR(4), o[1]), C0, 4); \
    KRD(GL, 1); GAPB(o[0] = MFMA(PAF(1), VFR(1), o[0]), C0, 8); \
    KRD(GL, 2); GAPB(o[1] = MFMA(PAF(1), VFR(5), o[1]), C0, 12); \
    KRD(GL, 3); GAPB(o[0] = MFMA(PAF(2), VFR(2), o[0]), C1, 0); \
    KRR(GL, 0); GAPB(o[1] = MFMA(PAF(2), VFR(6), o[1]), C1, 4); \
    KRR(GL, 1); GAPB(o[0] = MFMA(PAF(3), VFR(3), o[0]), C1, 8); \
    GAPB(o[1] = MFMA(PAF(3), VFR(7), o[1]), C1, 12); \
    } while (0)
    int t = 1;
    for (; t + 5 < NT; t += 2) {
        STEP(pB0, pB1, pA0, pA1, t, true, true, true);     WAIT_BAR(2); ROT();
        STEP(pA0, pA1, pB0, pB1, t + 1, true, true, true); WAIT_BAR(2); ROT();
    }
#define ENDW(tt) do { if ((tt) + 3 < NT) { WAIT_BAR(2); } else if ((tt) + 2 < NT) { WAIT_BAR(1); } else { WAIT_BAR(0); } } while (0)
    for (; t + 1 < NT; t += 2) {
        STEP(pB0, pB1, pA0, pA1, t, (t + 3 < NT), (t + 1 < NT), (t + 1 < NT));         ENDW(t);     ROT();
        STEP(pA0, pA1, pB0, pB1, t + 1, (t + 4 < NT), (t + 2 < NT), (t + 2 < NT));     ENDW(t + 1); ROT();
    }
    STEP(pB0, pB1, pA0, pA1, NT - 1, false, false, false);
    { float sacc = pB0[0] + pB0[1];
#pragma unroll
      for (int r = 2; r < 16; ++r) sacc += pB0[r];
#pragma unroll
      for (int r = 0; r < 16; ++r) sacc += pB1[r];
      l_reg += sacc;
      pw0 = (u32x4){PKW(pB0, 0), PKW(pB0, 2), PKW(pB0, 4), PKW(pB0, 6)}; pw1 = (u32x4){PKW(pB0, 8), PKW(pB0, 10), PKW(pB0, 12), PKW(pB0, 14)};
      pw2 = (u32x4){PKW(pB1, 0), PKW(pB1, 2), PKW(pB1, 4), PKW(pB1, 6)}; pw3 = (u32x4){PKW(pB1, 8), PKW(pB1, 10), PKW(pB1, 12), PKW(pB1, 14)};
      const lds_cptr vp_ = vp0 + VSL(sl_cur); _Pragma("unroll") for (int i = 0; i < 8; ++i) VRD(i);
      o[0] = MFMA(PAF(0), VFR(0), o[0]); o[1] = MFMA(PAF(0), VFR(4), o[1]); o[0] = MFMA(PAF(1), VFR(1), o[0]); o[1] = MFMA(PAF(1), VFR(5), o[1]);
      o[0] = MFMA(PAF(2), VFR(2), o[0]); o[1] = MFMA(PAF(2), VFR(6), o[1]); o[0] = MFMA(PAF(3), VFR(3), o[0]); o[1] = MFMA(PAF(3), VFR(7), o[1]); }
    { auto rr = __builtin_amdgcn_permlane32_swap(__float_as_uint(l_reg), __float_as_uint(l_reg), false, false); l_reg = __uint_as_float(rr[0]) + __uint_as_float(rr[1]); }
    if (hi == 0) wsf[32 + r32] = l_reg; asm volatile("s_waitcnt lgkmcnt(0)" ::: "memory");
    float rli[16];
#pragma unroll
    for (int r = 0; r < 16; ++r) rli[r] = __builtin_amdgcn_rcpf(wsf[32 + crow(r, hi)]);
    bf16_t* stg = (bf16_t*)(lds + LDS_OST) + wid * 2048;
#pragma unroll
    for (int r = 0; r < 16; ++r) { const int orow = crow(r, hi);
#pragma unroll
        for (int d0 = 0; d0 < 2; ++d0) stg[orow * 64 + d0 * 32 + r32] = (bf16_t)f2bf(o[d0][r] * rli[r]); }
    asm volatile("s_waitcnt lgkmcnt(0)" ::: "memory");
#pragma unroll
    for (int i = 0; i < 4; ++i) { const int row = i * 8 + (lane >> 3), ch = lane & 7; const size_t goff = (size_t)(wid * 32 + row) * ldo + ch * 8;
        const u32x4 ov = *(const u32x4*)(stg + row * 64 + ch * 8); const u32x4 gv = *(const u32x4*)(G + goff); u32x4 w;
#pragma unroll
        for (int q = 0; q < 4; ++q) { const float lo = __uint_as_float(ov[q] << 16) * __uint_as_float(gv[q] << 16), hh = __uint_as_float(ov[q] & 0xffff0000u) * __uint_as_float(gv[q] & 0xffff0000u); w[q] = cvtpk(lo, hh); }
        *(u32x4*)(O + goff) = w; }
    asm volatile("s_waitcnt lgkmcnt(0)\n\ts_barrier" ::: "memory");
#undef DMA_K
#undef DMA_V
#undef VSL
#undef ROT
#undef EX
#undef KLOADALL
#undef PKW
#undef PAF
#undef VFR
#undef VRD
#undef KRD
#undef KRR
#undef GAPA4
#undef GAPA3
#undef GAPA31
#undef GAPA21
#undef GAPB
#undef STEP
#undef ENDW
}
#undef SBAR
#undef PIN
#undef MFMA
#undef WAIT_BAR
}

#define RLX_AGENT __ATOMIC_RELAXED, __HIP_MEMORY_SCOPE_AGENT
#define XB_TMO      128
#define XB_XCNT(j)  (256  + 64 * (j))
#define XB_XSUB(j)  (1280 + 64 * (j))
#define XB_XGEN(j)  (2304 + 64 * (j))
#define XB_TOP      3328
#define XB_TOPGEN   3392
#define XCD_BAR_WORDS 3456
#define XB_SPIN_CAP (1u << 18)

__device__ __forceinline__ unsigned xb_ld(unsigned* p)              { return __hip_atomic_load(p, __ATOMIC_RELAXED, __HIP_MEMORY_SCOPE_AGENT); }
__device__ __forceinline__ unsigned xb_add(unsigned* p, unsigned v) { return __hip_atomic_fetch_add(p, v, __ATOMIC_RELAXED, __HIP_MEMORY_SCOPE_AGENT); }
__device__ __forceinline__ unsigned xb_xcc_id() { return (unsigned)__builtin_amdgcn_s_getreg((3 << 11) | 20) & 0xFu; }
#define XB_SPIN(cond, bar) do { unsigned _sp = 0; while (cond) { __builtin_amdgcn_s_sleep(1); \
    if ((++_sp & 255u) == 0u) { if (xb_ld(&(bar)[XB_TMO])) break; if (_sp > XB_SPIN_CAP) { atomicAdd(&(bar)[XB_TMO], 1u); break; } } } } while (0)

struct XcdBarrier {
    unsigned* bar; unsigned x;
    volatile LAS unsigned* st;
};

__device__ __forceinline__ XcdBarrier xcd_barrier_post(unsigned* bar, volatile LAS unsigned* st) {
    XcdBarrier b; b.bar = bar; b.x = xb_xcc_id(); b.st = st;
    if (threadIdx.x == 0) (void)xb_add(&bar[XB_XCNT(b.x)], 1u);
    return b;
}
__device__ __forceinline__ void xcd_barrier_complete(unsigned* bar, unsigned x, unsigned& nloc, unsigned& nx) {
    const unsigned G = gridDim.x * gridDim.y * gridDim.z;
    unsigned sum, cnt, mine, sp = 0u;
    for (;;) {
        sum = 0u; cnt = 0u; mine = 0u;
#pragma unroll
        for (unsigned j = 0; j < 16; ++j) { const unsigned c = xb_ld(&bar[XB_XCNT(j)]); sum += c; cnt += (c > 0u) ? 1u : 0u; mine = (j == x) ? c : mine; }
        if (sum == G) break;
        __builtin_amdgcn_s_sleep(1);
        if ((++sp & 255u) == 0u) { if (xb_ld(&bar[XB_TMO])) break; if (sp > XB_SPIN_CAP) { atomicAdd(&bar[XB_TMO], 1u); break; } }
    }
    nloc = mine > 0u ? mine : 1u; nx = cnt > 0u ? cnt : 1u;
}

__device__ __forceinline__ void xcd_barrier(const XcdBarrier& b) {
    asm volatile("s_waitcnt vmcnt(0)" ::: "memory");
    __syncthreads();
    if (threadIdx.x == 0) {
        unsigned* bar = b.bar;
        __builtin_amdgcn_s_waitcnt(0);
        unsigned nloc = b.st[0], nx = b.st[1];
        if (nloc == 0u) { xcd_barrier_complete(bar, b.x, nloc, nx); b.st[0] = nloc; b.st[1] = nx; }
        const unsigned old = xb_add(&bar[XB_XSUB(b.x)], 1u);
        const unsigned gen = old / nloc;
        if (old + 1u == (gen + 1u) * nloc) {
            __builtin_amdgcn_fence(__ATOMIC_RELEASE, "agent");
            asm volatile("s_waitcnt vmcnt(0)" ::: "memory");
            const unsigned og = xb_add(&bar[XB_TOP], 1u);
            const unsigned tg = og / nx;
            if (og + 1u == (tg + 1u) * nx) xb_add(&bar[XB_TOPGEN], 1u);
            else XB_SPIN(xb_ld(&bar[XB_TOPGEN]) == tg, bar);
            __builtin_amdgcn_fence(__ATOMIC_ACQUIRE, "agent");
            xb_add(&bar[XB_XGEN(b.x)], 1u);
            asm volatile("s_waitcnt vmcnt(0)" ::: "memory");
        } else {
            XB_SPIN(xb_ld(&bar[XB_XGEN(b.x)]) == gen, bar);
            __builtin_amdgcn_fence(__ATOMIC_ACQUIRE, "agent");
            asm volatile("s_waitcnt vmcnt(0)" ::: "memory");
        }
    }
    __syncthreads();
}


#include <hip/hip_cooperative_groups.h>
namespace cg = cooperative_groups;
constexpr int NWAVES = 8, NTHREADS = 512, LDS_BYTES = 147456, RING_BYTES = 131072;
constexpr size_t MiB = 1u << 20;
constexpr size_t WS_MOD = 1 * MiB;
constexpr size_t WS_TABA = WS_MOD + 128 * 1024;
constexpr size_t WS_TABB = WS_TABA + 32 * 1024;
constexpr size_t WS_WIN0 = 2 * MiB;
constexpr size_t WS_WOUT0 = 7 * MiB;
constexpr size_t WS_WIN1 = 9 * MiB;
constexpr size_t WS_WKVB = 13 * MiB;
constexpr size_t WS_WQB = 14 * MiB;
constexpr size_t WS_WOUT1 = 16 * MiB;
constexpr size_t WS_X1C = 18 * MiB;
constexpr size_t WS_H = 20 * MiB;
constexpr size_t WS_Q = 53 * MiB;
constexpr size_t WS_K = 86 * MiB;
constexpr size_t WS_V0 = 95 * MiB;
constexpr size_t WS_G = 120 * MiB;
constexpr size_t WS_V1 = 153 * MiB;
constexpr size_t WS_KVA = 186 * MiB;
constexpr size_t WS_QA = 195 * MiB;
constexpr size_t WS_Q1R = 207 * MiB;
constexpr size_t WS_KR = 223 * MiB;
constexpr size_t WS_SSKV = 225 * MiB;
constexpr size_t WS_SSQ = 226 * MiB;
constexpr size_t WS_SSH = 227 * MiB;
constexpr size_t WS_END = 256 * MiB;
static_assert(WS_K + (size_t)NB * TK * DM * 2 <= WS_G && WS_G + (size_t)MT * DM * 2 <= WS_V1 && WS_V1 + (size_t)NB * TK * DM * 2 <= WS_KVA && WS_SSH + (size_t)ML * 32 * 4 <= WS_END, "ws map");

struct Args { const float* in[23]; float* out; unsigned char* ws; int ph_lo, ph_hi, coop, pad; };

DEVI void phase0(const Args& a, unsigned char* ws, LAS unsigned char* lds, int vb, int G) {
    const int tid = threadIdx.x, wave = tid >> 6, lane = tid & 63;
    float* mod = (float*)(ws + WS_MOD);
    if (vb < 96) {
        LAS float* sc = (LAS float*)lds; LAS float* red = sc + 3 * 1024;
        const int layer = vb / 48, cs = vb % 48; const float* w = a.in[layer ? 11 : 4]; const float* bb = a.in[layer ? 12 : 5];
        for (int i = tid; i < 3072; i += NTHREADS) { const int r = i >> 10, k = i & 1023; const float v = r < 2 ? a.in[1][r * 1024 + k] : a.in[3][k]; sc[i] = v / (1.f + expf(-v)); }
        __syncthreads();
        const int col = cs * 64 + lane; float a0 = 0.f, a1 = 0.f, a2 = 0.f;
#pragma unroll 8
        for (int k = wave * 128; k < wave * 128 + 128; ++k) { const float wv = w[(size_t)k * 3072 + col]; a0 += sc[k] * wv; a1 += sc[1024 + k] * wv; a2 += sc[2048 + k] * wv; }
        red[(wave * 3 + 0) * 64 + lane] = a0; red[(wave * 3 + 1) * 64 + lane] = a1; red[(wave * 3 + 2) * 64 + lane] = a2;
        __syncthreads();
        if (tid < 192) { const int r = tid >> 6; float s = 0.f;
#pragma unroll
            for (int q = 0; q < 8; ++q) s += red[(q * 3 + r) * 64 + lane];
            mod[(size_t)(layer * 3 + r) * 3072 + col] = s + bb[col]; }
        __syncthreads();
    } else if (vb == 96) {
        f32x2* tabA = (f32x2*)(ws + WS_TABA); f32x2* tabB = (f32x2*)(ws + WS_TABB);
        for (int i = tid; i < 128 * 24; i += NTHREADS) {
            if (i < 128 * 16) { const int pos = i >> 4, f = i & 15; const float invf = powf(10000.f, -(float)f / 16.f); float cs_, sn_; sincos_pos((float)pos * invf, cs_, sn_); tabA[i] = (f32x2){cs_, sn_}; }
            else { const int j = i - 128 * 16, pos = j >> 3, f = j & 7; const float invf = powf(10000.f, -(float)f / 8.f); float cs_, sn_; sincos_pos((float)pos * invf, cs_, sn_); tabB[j] = (f32x2){cs_, sn_}; } }
    }
    struct WD { int src, K, Nsrc, Np, mode, ks; size_t dst; };
    const WD wd[6] = {{7, 1024, N_IN0, 2560, 1, -1, WS_WIN0}, {10, 1024, 1024, 1024, 0, -1, WS_WOUT0}, {14, 1024, N_IN1, N_IN1P, 2, -1, WS_WIN1},
                      {16, 256, 2048, 2048, 3, 15, WS_WKVB}, {18, 384, 1536, 2048, 4, 17, WS_WQB}, {22, 1024, 1024, 1024, 0, -1, WS_WOUT1}};
#pragma unroll
    for (int m = 0; m < 6; ++m) {
        const float* W = a.in[wd[m].src]; const float* ks = wd[m].ks >= 0 ? a.in[wd[m].ks] : nullptr; bf16_t* Bt = (bf16_t*)(ws + wd[m].dst);
        const int K = wd[m].K, Nsrc = wd[m].Nsrc, Np = wd[m].Np, total = Np * (K / 8);
        for (int i = vb * NTHREADS + tid; i < total; i += G * NTHREADS) {
            const int p = i % Np, k8 = i / Np; int cc = pg8::wmap(wd[m].mode, p); if (cc >= Nsrc) cc = -1;
            float v[8];
#pragma unroll
            for (int j = 0; j < 8; ++j) { const int k = k8 * 8 + j; v[j] = cc >= 0 ? W[(size_t)k * Nsrc + cc] * (ks ? ks[k] : 1.f) : 0.f; }
            u32x4 o; o.x = pk2(v[0], v[1]); o.y = pk2(v[2], v[3]); o.z = pk2(v[4], v[5]); o.w = pk2(v[6], v[7]);
            *(u32x4*)(Bt + (size_t)p * K + k8 * 8) = o;
        }
    }
}

DEVI void phase_prep(const float* xa, const float* xb, const float* nw, const float* mod, bf16_t* H, int gw, int NGW, int lane) {
    for (int row = gw; row < MT; row += NGW) {
        const int r = row < SEQ ? 0 : (row < ML ? 1 : 2);
        const float* src = row < ML ? xa + (size_t)row * DM : xb + (size_t)(row - ML) * DM;
        f32x4 v[4]; float ss = 0.f;
#pragma unroll
        for (int j = 0; j < 4; ++j) { v[j] = *(const f32x4*)(src + 4 * lane + 256 * j); ss += (v[j].x * v[j].x + v[j].y * v[j].y) + (v[j].z * v[j].z + v[j].w * v[j].w); }
        const float rinv = rsqrtf(wave_sum(ss) * (1.f / DM) + EPS);
#pragma unroll
        for (int j = 0; j < 4; ++j) { const int cidx = 4 * lane + 256 * j; const f32x4 w = *(const f32x4*)(nw + cidx);
            const f32x4 sh = *(const f32x4*)(mod + (size_t)r * 3072 + cidx), scl = *(const f32x4*)(mod + (size_t)r * 3072 + 1024 + cidx);
            const f32x4 h = (v[j] * rinv) * w * (scl + 1.f) + sh;
            u32x2 o; o.x = pk2(h.x, h.y); o.y = pk2(h.z, h.w); *(u32x2*)(H + (size_t)row * DM + cidx) = o; }
    }
}

__global__ void __launch_bounds__(NTHREADS, 2) mega(Args a) {
    extern __shared__ __attribute__((aligned(16))) unsigned char lds[];
    const int tid = threadIdx.x, lane = tid & 63; const int wave = __builtin_amdgcn_readfirstlane(tid >> 6);
    const int G = gridDim.x, bx = blockIdx.x; const int vcu = (G % 8 == 0) ? (bx % 8) * (G / 8) + bx / 8 : bx;
    unsigned char* ws = a.ws; float* out = a.out;
    const float* x = a.in[0]; const float* ctx = a.in[2];
    float* mod = (float*)(ws + WS_MOD); const f32x4* tabA = (const f32x4*)(ws + WS_TABA); const f32x4* tabB = (const f32x4*)(ws + WS_TABB);
    bf16_t* H = (bf16_t*)(ws + WS_H); bf16_t* Qb = (bf16_t*)(ws + WS_Q); bf16_t* K0 = (bf16_t*)(ws + WS_K); bf16_t* V0 = (bf16_t*)(ws + WS_V0); bf16_t* K1 = (bf16_t*)(ws + WS_K);
    bf16_t* Gb = (bf16_t*)(ws + WS_G); bf16_t* V1 = (bf16_t*)(ws + WS_V1); bf16_t* KVA = (bf16_t*)(ws + WS_KVA); bf16_t* QA = (bf16_t*)(ws + WS_QA); bf16_t* Q1R = (bf16_t*)(ws + WS_Q1R);
    bf16_t* O0 = (bf16_t*)(ws + WS_V1); bf16_t* O1 = (bf16_t*)(ws + WS_H); bf16_t* KR = (bf16_t*)(ws + WS_KR); float* SSKV = (float*)(ws + WS_SSKV); float* SSQ = (float*)(ws + WS_SSQ); float* SSH = (float*)(ws + WS_SSH); float* X1c = (float*)(ws + WS_X1C);
    const int lo = a.ph_lo, hi_ = a.ph_hi;
#ifndef ONLY_PHASE
#define ONLY_PHASE -1
#endif
#define IN(k) ((ONLY_PHASE < 0 || ONLY_PHASE == (k)) && lo <= (k) && (k) < hi_)
#ifndef MK_REP_MASK
#define MK_REP_MASK 0
#endif
#define REPS(k) (((MK_REP_MASK >> (k)) & 1) ? 2 : 1)
#define SEAM(k) do { if (IN(k) && IN((k) + 1)) { if ((k) == 0) cg::this_grid().sync(); else xcd_barrier(xbar); } } while (0)
    PG8_LAS unsigned char* ring = (PG8_LAS unsigned char*)lds;
    volatile LAS unsigned* xst = (volatile LAS unsigned*)((LAS unsigned char*)lds + RING_BYTES + 512);
    if (tid < 4) xst[tid] = 0u;
    __syncthreads();
    XcdBarrier xbar; xbar.bar = (unsigned*)ws; xbar.x = 0; xbar.st = xst;
    if (a.coop) xbar = xcd_barrier_post((unsigned*)ws, xst);

    if (IN(0)) for (int rep_ = 0; rep_ < REPS(0); ++rep_) { phase0(a, ws, (LAS unsigned char*)lds, bx, G); } SEAM(0);
    if (IN(1)) for (int rep_ = 0; rep_ < REPS(1); ++rep_) { phase_prep(x, ctx, a.in[6], mod, H, vcu * NWAVES + wave, G * NWAVES, lane); } SEAM(1);
    if (IN(2)) { pg8::Gemm g{H, (const bf16_t*)(ws + WS_WIN0), MT, N_IN0, 1024}; pg8::ROrder S; S.init(0, MT / 256, N_IN0, G, bx, REPS(2));
        pg8::EpiIn0 E{a.in[8], a.in[9], tabA, K0, V0, Qb, Gb};
        pg8::gemm_phase<pg8::EpiIn0, pg8::ROrder, true, true>(ring, g, S, E); } SEAM(2);
    if (IN(3)) for (int rep_ = 0; rep_ < REPS(3); ++rep_) {
        const int xg = vcu >> 5, c = vcu & 31, b = xg >> 2, kvh = xg & 3; const size_t kbase = (size_t)b * TK * 256 + kvh * 64;
        for (int i = 0; i < 4; ++i) { const int h = kvh * 4 + i; const size_t q0 = ((size_t)b * SEQ + c * 256) * DM + h * 64;
            afast::attn_unit<0>(Qb + q0, DM, nullptr, nullptr, K0 + kbase, 256, nullptr, V0 + kbase, 256, TK / 64, O0 + q0, Gb + q0, DM, (char*)lds); }
        if (c < 4) { const int h = kvh * 4 + c; const size_t q0 = ((size_t)ML + b * CTXL) * DM + h * 64;
            afast::attn_unit<0>(Qb + q0, DM, nullptr, nullptr, K0 + kbase, 256, nullptr, V0 + kbase, 256, CTXL / 64, O0 + q0, Gb + q0, DM, (char*)lds); }
    } SEAM(3);
    if (IN(4)) { pg8::Gemm g{O0, (const bf16_t*)(ws + WS_WOUT0), MT, 1024, 1024}; pg8::ROrder S; S.init(0, MT / 256, 1024, G, bx, REPS(4));
        pg8::EpiOut E{x, ctx, out, X1c, mod + 2048};
        pg8::gemm_phase<pg8::EpiOut, pg8::ROrder, true, true>(ring, g, S, E); } SEAM(4);
    if (IN(5)) for (int rep_ = 0; rep_ < REPS(5); ++rep_) { phase_prep(out, X1c, a.in[13], mod + 3 * 3072, H, vcu * NWAVES + wave, G * NWAVES, lane); } SEAM(5);
    if (IN(6)) { pg8::Gemm g{H, (const bf16_t*)(ws + WS_WIN1), MT, N_IN1P, 1024}; pg8::In1Order S; S.init(G, bx);
        pg8::EpiIn1 E{a.in[21], tabB, KVA, SSKV, QA, SSQ, KR, Gb};
        pg8::gemm_phase<pg8::EpiIn1, pg8::In1Order, true, true>(ring, g, S, E); } SEAM(6);
    if (IN(7)) {
        { pg8::Gemm g{KVA, (const bf16_t*)(ws + WS_WKVB), MT, 2048, 256}; pg8::ROrder S; S.init(0, MT / 256, 2048, G, bx, REPS(7));
          pg8::EpiKvb E{SSKV, a.in[20], K1, V1};
          pg8::gemm_phase<pg8::EpiKvb, pg8::ROrder, true, true>(ring, g, S, E); }
        { pg8::Gemm g{QA, (const bf16_t*)(ws + WS_WQB), ML, 2048, 384}; pg8::ROrder S; S.init(0, ML / 256, 2048, G, bx, REPS(7));
          pg8::EpiQb E{SSQ, a.in[19], tabB, Qb, Q1R, SSH};
          pg8::gemm_phase<pg8::EpiQb, pg8::ROrder, true, true>(ring, g, S, E); }
    } SEAM(7);
    if (IN(8)) for (int rep_ = 0; rep_ < REPS(8); ++rep_) {
        const int xg = vcu >> 5, c = vcu & 31;
        for (int i = 0; i < 4; ++i) { const int s = xg + 8 * i, b = s >> 4, h = s & 15; const size_t row0 = (size_t)b * SEQ + c * 256, q0 = row0 * DM + h * 64;
            afast::attn_unit<1>(Qb + q0, DM, Q1R + row0 * 512 + h * 32, SSH + (row0 * 16 + h) * 2, K1 + (size_t)b * TK * DM + h * 64, DM, KR + (size_t)b * TK * 32,
                                V1 + (size_t)b * TK * DM + h * 64, DM, TK / 64, O1 + q0, Gb + q0, DM, (char*)lds); }
    } SEAM(8);
    if (IN(9)) { pg8::Gemm g{O1, (const bf16_t*)(ws + WS_WOUT1), ML, 1024, 1024}; pg8::ROrder S; S.init(0, ML / 256, 1024, G, bx);
        pg8::EpiOut E{out, nullptr, out, nullptr, mod + 3 * 3072 + 2048};
        pg8::gemm_phase<pg8::EpiOut, pg8::ROrder, true, true>(ring, g, S, E); }
#undef IN
#undef SEAM
}

constexpr int NPHASE = 10;
#ifndef MK_ONE_LAUNCH
#define MK_ONE_LAUNCH 1
#endif
extern "C" void kernel_launch(void* const* d_in, const int* in_sizes, int n_in, void* d_out, int out_size, void* d_ws, size_t ws_size, hipStream_t stream) {
    static int grid = 0;
    if (grid == 0) {
        if (n_in != 23 || out_size != ML * DM || ws_size < WS_END) { fprintf(stderr, "kernel_launch: unexpected shapes n_in %d out %d ws %zu\n", n_in, out_size, ws_size); grid = -1; return; }
        int dev = 0, cus = 0, per_cu = 0;
        if (hipGetDevice(&dev) != hipSuccess || hipDeviceGetAttribute(&cus, hipDeviceAttributeMultiprocessorCount, dev) != hipSuccess) { grid = -1; return; }
        if (hipFuncSetAttribute((const void*)mega, hipFuncAttributeMaxDynamicSharedMemorySize, LDS_BYTES) != hipSuccess) { fprintf(stderr, "kernel_launch: hipFuncSetAttribute failed\n"); grid = -1; return; }
        if (hipOccupancyMaxActiveBlocksPerMultiprocessor(&per_cu, (const void*)mega, NTHREADS, LDS_BYTES) != hipSuccess || per_cu < 1) { fprintf(stderr, "kernel_launch: occupancy query says %d\n", per_cu); grid = -1; return; }
        grid = cus;
        if (grid != 256) fprintf(stderr, "kernel_launch: %d CUs (built for 256)\n", grid);
    }
    if (grid < 0) return;
    if (hipMemsetAsync(d_ws, 0, 16384, stream) != hipSuccess) { fprintf(stderr, "kernel_launch: memset failed\n"); return; }
    Args a{};
    for (int i = 0; i < 23; ++i) a.in[i] = (const float*)d_in[i];
    a.out = (float*)d_out; a.ws = (unsigned char*)d_ws;
#if MK_ONE_LAUNCH
    a.ph_lo = 0; a.ph_hi = NPHASE; a.coop = 1;
    void* args[] = {&a};
    const hipError_t e = hipLaunchCooperativeKernel((const void*)mega, dim3(grid), dim3(NTHREADS), args, LDS_BYTES, stream);
    if (e != hipSuccess) fprintf(stderr, "kernel_launch: cooperative launch failed: %s (grid %d)\n", hipGetErrorString(e), grid);
#else
    for (int p = 0; p < NPHASE; ++p) { a.ph_lo = p; a.ph_hi = p + 1; a.coop = 0; hipLaunchKernelGGL(mega, dim3(grid), dim3(NTHREADS), LDS_BYTES, stream, a); }
    const hipError_t le = hipPeekAtLastError();
    if (le != hipSuccess) fprintf(stderr, "kernel_launch: launch failed: %s\n", hipGetErrorName(le));
#endif
}
```

```cpp
#include <hip/hip_runtime.h>
#include <hip/hip_bf16.h>
#include <cstdio>
#include <cstdint>

#define DEVI __device__ __forceinline__
#define LAS __attribute__((address_space(3)))
#define GAS __attribute__((address_space(1)))

constexpr int NB = 2, SEQ = 8192, DM = 1024, CTXL = 256, TK = SEQ + CTXL;
constexpr int ML = NB * SEQ, MC = NB * CTXL, MT = ML + MC;
constexpr int GRIDW = 64;
constexpr float EPS = 1e-6f;
constexpr float LOG2E = 1.4426950408889634f;
constexpr int N_IN0 = 2560, N_IN1 = 1696, N_IN1P = 1792;
constexpr float C2_GQA = 0.125f * LOG2E;
constexpr float C2_MLA = 0.10206207261596575f * LOG2E;

typedef unsigned short bf16_t;
typedef short bf16x8 __attribute__((ext_vector_type(8)));
typedef short s16x4 __attribute__((ext_vector_type(4)));
typedef float f32x4 __attribute__((ext_vector_type(4)));
typedef float f32x2 __attribute__((ext_vector_type(2)));
typedef float f32x16 __attribute__((ext_vector_type(16)));
typedef unsigned u32x4 __attribute__((ext_vector_type(4)));
typedef unsigned u32x2 __attribute__((ext_vector_type(2)));

DEVI float bf2f(bf16_t v) { return __uint_as_float((unsigned)v << 16); }
DEVI unsigned f2bf(float f) { unsigned u = __float_as_uint(f); return (u + 0x7fffu + ((u >> 16) & 1u)) >> 16; }
DEVI unsigned pk2(float lo, float hi) { return f2bf(lo) | (f2bf(hi) << 16); }
DEVI float wave_sum(float v) {
#pragma unroll
    for (int o = 1; o < 64; o <<= 1) v += __shfl_xor(v, o);
    return v;
}
DEVI float silu_f(float v) { return v / (1.f + __expf(-v)); }
namespace pg8 {
#define PG8_LAS __attribute__((address_space(3)))
typedef unsigned short bf16_t;
typedef short bf16x8 __attribute__((ext_vector_type(8)));
typedef float f32x4 __attribute__((ext_vector_type(4)));
typedef unsigned u32x4 __attribute__((ext_vector_type(4)));
constexpr int BM = 256, BK = 64, HALF = 128, HTB = HALF * BK * 2  , STAGE_BYTES = 8 * HTB, NXCD = 8, WGM = 8;

__host__ __device__ __forceinline__ int lds_byte(int r, int c) { const int st = (r >> 4) * 2 + (c >> 5), rr = r & 15, cc = c & 31, ob = rr * 64 + cc * 2; return st * 1024 + (ob ^ (((ob >> 9) & 1) << 5)); }
__host__ __device__ __forceinline__ void stage_rc(int b, int& R, int& C) { const int st = b / 1024, sb = b % 1024, swz = sb ^ (((sb >> 9) & 1) << 5); R = (st >> 1) * 16 + swz / 64; C = (st & 1) * 32 + (swz % 64) / 2; }
__host__ __device__ __forceinline__ int perm32(int rho) { const int n = rho >> 4, i = rho & 15; return 8 * (i >> 2) + 4 * n + (i & 3); }

struct Unit { int pm, pn; };
struct Gemm { const bf16_t* A; const bf16_t* Bt; int M, N, K; };

struct StaticOrder {
    int nM, nN, nwg, G, c;
    __host__ __device__ void init(int M, int N, int G_, int c_) { nM = M / BM; nN = N / BM; nwg = nM * nN; G = G_; c = c_; }
    __host__ __device__ bool next(int i, Unit& u) const {
        const long L = (long)i * G + c; if (L >= nwg) return false;
        int wgid = (int)L; { const int q = nwg / NXCD, r = nwg % NXCD, xcd = wgid % NXCD, off = wgid / NXCD; wgid = (xcd < r ? xcd * (q + 1) : r * (q + 1) + (xcd - r) * q) + off; }
        const int nig = WGM * nN, gid = wgid / nig, fm = gid * WGM, gsz = (nM - fm) < WGM ? (nM - fm) : WGM;
        u.pm = fm + ((wgid % nig) % gsz); u.pn = (wgid % nig) / gsz; return true;
    }
    __device__ __forceinline__ void a_ready(const Unit&) const {}
    __device__ __forceinline__ void done(const Unit&) const {}
};


struct ROrder {
    int pm0, nM, nN, nwg, G, c, rep;
    __host__ __device__ void init(int pm0_, int npm, int N, int G_, int c_, int rep_ = 1) { pm0 = pm0_; nM = npm; nN = N / BM; nwg = nM * nN; G = G_; c = c_; rep = rep_; }
    __host__ __device__ bool next(int i, Unit& u) const {
        const long L = (long)i * G + c; if (L >= (long)nwg * rep) return false;
        int wgid = (int)(L % nwg); { const int q = nwg / NXCD, r = nwg % NXCD, xcd = wgid % NXCD, off = wgid / NXCD; wgid = (xcd < r ? xcd * (q + 1) : r * (q + 1) + (xcd - r) * q) + off; }
        const int nig = WGM * nN, gid = wgid / nig, fm = gid * WGM, gsz = (nM - fm) < WGM ? (nM - fm) : WGM;
        u.pm = pm0 + fm + ((wgid % nig) % gsz); u.pn = (wgid % nig) / gsz; return true;
    }
    __device__ __forceinline__ void a_ready(const Unit&) const {}
    __device__ __forceinline__ void done(const Unit&) const {}
};

struct EpiF32 {
    static constexpr bool PERM = true, AFTER_DRAIN = false;
    float* O; int ldc; int pmbase;
    __device__ __forceinline__ void operator()(const f32x4 (&acc)[2][2][4][2], const Unit& u, int wr, int wc, int fr, int fq) const {
        const int row0 = (u.pm - pmbase) * BM + wr * 64 + fr, col0 = u.pn * BM + wc * 32 + 8 * fq;
#pragma unroll
        for (int ai = 0; ai < 2; ++ai)
#pragma unroll
            for (int m = 0; m < 4; ++m) { float* rowp = O + (size_t)(row0 + ai * HALF + m * 16) * ldc + col0;
#pragma unroll
                for (int bj = 0; bj < 2; ++bj) { *(f32x4*)(rowp + bj * HALF) = acc[ai][bj][m][0]; *(f32x4*)(rowp + bj * HALF + 4) = acc[ai][bj][m][1]; } }
    }
};

DEVI unsigned cvt_pk_bf16(float lo, float hi) { unsigned r; asm volatile("v_cvt_pk_bf16_f32 %0, %1, %2" : "=v"(r) : "v"(lo), "v"(hi)); return r; }
DEVI u32x4 pack8(const f32x4 a, const f32x4 b) { u32x4 w; w.x = cvt_pk_bf16(a[0], a[1]); w.y = cvt_pk_bf16(a[2], a[3]); w.z = cvt_pk_bf16(b[0], b[1]); w.w = cvt_pk_bf16(b[2], b[3]); return w; }
DEVI float quad_sum(float s) { s += __shfl_xor(s, 16); s += __shfl_xor(s, 32); return s; }
DEVI float sq4(const f32x4 v) { return (v[0] * v[0] + v[1] * v[1]) + (v[2] * v[2] + v[3] * v[3]); }
DEVI f32x4 silu4(const f32x4 v) { f32x4 o; o[0] = silu_f(v[0]); o[1] = silu_f(v[1]); o[2] = silu_f(v[2]); o[3] = silu_f(v[3]); return o; }
DEVI int key_slot(int R) { return R < ML ? (R >> 13) * TK + CTXL + (R & (SEQ - 1)) : ((R - ML) >> 8) * TK + ((R - ML) & 255); }
DEVI void rot4(f32x4& x1, f32x4& x2, const f32x4 cs01, const f32x4 cs23) {
    const f32x4 c = {cs01[0], cs01[2], cs23[0], cs23[2]}, s = {cs01[1], cs01[3], cs23[1], cs23[3]};
    const f32x4 a = x1 * c - x2 * s, b = x2 * c + x1 * s; x1 = a; x2 = b;
}

DEVI int drope32(int i) { const int fq = i >> 3, n = (i >> 2) & 1, j = i & 3; return 16 * (fq >> 1) + 8 * n + 4 * (fq & 1) + j; }
DEVI int wmap(int mode, int p) {
    const int pn = p >> 8, q = p & 255, bj = q >> 7, wc = (q >> 5) & 3, i = q & 31;
    switch (mode) {
    case 1: {
        if (pn == 0 || (pn >= 2 && pn <= 5)) { const int fq = i >> 3, n = (i >> 2) & 1, j = i & 3; return 256 * pn + 64 * wc + 32 * bj + 16 * n + 4 * fq + j; }
        return p; }
    case 2: {
        if (pn == 0) return q;
        if (pn == 1) return 288 + q;
        if (pn == 2) { if (wc < 2) return 288 + 256 + 64 * wc + 32 * bj + i; if (wc == 2 && bj == 0) return 256 + drope32(i); return -1; }
        return 672 + 256 * (pn - 3) + q; }
    case 3: { const int head = 2 * pn + (wc >> 1), type = wc & 1; return 128 * head + 64 * type + 32 * bj + i; }
    case 4: { const int head = 2 * pn + (wc >> 1), type = wc & 1; if (type == 0) return 96 * head + 32 * bj + i; return bj == 0 ? 96 * head + 64 + drope32(i) : -1; }
    default: return p;
    }
}

struct EpiIn0 {
    static constexpr bool PERM = true, AFTER_DRAIN = false;
    const float* qn; const float* kn; const f32x4* tabA; bf16_t* K0; bf16_t* V0; bf16_t* Q0; bf16_t* G0;
    __device__ __forceinline__ void operator()(const f32x4 (&acc)[2][2][4][2], const Unit& u, int wr, int wc, int fr_, int fq_) const {
        int fr = fr_, fq = fq_; asm volatile("" : "+v"(fr), "+v"(fq));
        const int pn = u.pn; const bool lat = u.pm < ML / BM;
        if (pn == 0 || (pn >= 2 && pn <= 5)) {
            const float* wsrc = pn == 0 ? kn : qn; const float outs = pn == 0 ? 1.f : C2_GQA;
            f32x4 wv[2][2];
#pragma unroll
            for (int bj = 0; bj < 2; ++bj)
#pragma unroll
                for (int n = 0; n < 2; ++n) wv[bj][n] = *(const f32x4*)(wsrc + 32 * bj + 16 * n + 4 * fq) * outs;
#pragma unroll
            for (int ai = 0; ai < 2; ++ai)
#pragma unroll
                for (int m = 0; m < 4; ++m) {
                    const int R = u.pm * BM + ai * HALF + wr * 64 + m * 16 + fr;
                    f32x4 x[2][2]; float ss = 0.f;
#pragma unroll
                    for (int bj = 0; bj < 2; ++bj)
#pragma unroll
                        for (int n = 0; n < 2; ++n) { x[bj][n] = acc[ai][bj][m][n]; ss += sq4(x[bj][n]); }
                    const float rinv = rsqrtf(quad_sum(ss) * (1.f / 64.f) + EPS);
#pragma unroll
                    for (int bj = 0; bj < 2; ++bj)
#pragma unroll
                        for (int n = 0; n < 2; ++n) x[bj][n] = x[bj][n] * rinv * wv[bj][n];
                    if (lat) { const int t = R & (SEQ - 1), trow = t >> 6, tcol = t & 63;
                        const f32x4* tr = tabA + (trow * 16 + 4 * fq) / 2; const f32x4* tc = tabA + (tcol * 16 + 4 * fq) / 2;
                        rot4(x[0][0], x[0][1], tr[0], tr[1]); rot4(x[1][0], x[1][1], tc[0], tc[1]); }
                    if (pn == 0) { bf16_t* dst = K0 + (size_t)key_slot(R) * 256 + wc * 64 + 8 * fq;
                        *(u32x4*)dst = pack8(x[0][0], x[0][1]); *(u32x4*)(dst + 32) = pack8(x[1][0], x[1][1]); }
                    else { bf16_t* dst = Q0 + (size_t)R * DM + ((pn - 2) * 4 + wc) * 64 + 8 * fq;
                        *(u32x4*)dst = pack8(x[0][0], x[0][1]); *(u32x4*)(dst + 32) = pack8(x[1][0], x[1][1]); }
                }
        } else if (pn == 1) {
#pragma unroll
            for (int ai = 0; ai < 2; ++ai)
#pragma unroll
                for (int m = 0; m < 4; ++m) { const int R = u.pm * BM + ai * HALF + wr * 64 + m * 16 + fr; bf16_t* dst = V0 + (size_t)key_slot(R) * 256 + wc * 32 + 8 * fq;
#pragma unroll
                    for (int bj = 0; bj < 2; ++bj) *(u32x4*)(dst + bj * HALF) = pack8(acc[ai][bj][m][0], acc[ai][bj][m][1]); }
        } else {
#pragma unroll
            for (int ai = 0; ai < 2; ++ai)
#pragma unroll
                for (int m = 0; m < 4; ++m) { const int R = u.pm * BM + ai * HALF + wr * 64 + m * 16 + fr; bf16_t* dst = G0 + (size_t)R * DM + (pn - 6) * BM + wc * 32 + 8 * fq;
#pragma unroll
                    for (int bj = 0; bj < 2; ++bj) *(u32x4*)(dst + bj * HALF) = pack8(silu4(acc[ai][bj][m][0]), silu4(acc[ai][bj][m][1])); }
        }
    }
};

struct EpiOut {
    static constexpr bool PERM = true, AFTER_DRAIN = false;
    const float* baseL; const float* baseC; float* dstL; float* dstC; const float* gate;
    __device__ __forceinline__ void operator()(const f32x4 (&acc)[2][2][4][2], const Unit& u, int wr, int wc, int fr_, int fq_) const {
        int fr = fr_, fq = fq_; asm volatile("" : "+v"(fr), "+v"(fq));
        const int col0 = u.pn * BM + wc * 32 + 8 * fq;
#pragma unroll
        for (int ai = 0; ai < 2; ++ai)
#pragma unroll
            for (int m = 0; m < 4; ++m) { const int R = u.pm * BM + ai * HALF + wr * 64 + m * 16 + fr; const int r = R < SEQ ? 0 : (R < ML ? 1 : 2);
                const float* b = R < ML ? baseL + (size_t)R * DM : baseC + (size_t)(R - ML) * DM; float* d = R < ML ? dstL + (size_t)R * DM : dstC + (size_t)(R - ML) * DM;
                const float* g = gate + (size_t)r * 3072;
#pragma unroll
                for (int bj = 0; bj < 2; ++bj)
#pragma unroll
                    for (int n = 0; n < 2; ++n) { const int c = col0 + bj * HALF + 4 * n; *(f32x4*)(d + c) = *(const f32x4*)(b + c) + *(const f32x4*)(g + c) * acc[ai][bj][m][n]; } }
    }
};

struct EpiIn1 {
    static constexpr bool PERM = true, AFTER_DRAIN = false;
    const float* krn; const f32x4* tabB; bf16_t* KVA; float* SSKV; bf16_t* QA; float* SSQ; bf16_t* KR; bf16_t* G1;
    __device__ __forceinline__ void operator()(const f32x4 (&acc)[2][2][4][2], const Unit& u, int wr, int wc, int fr_, int fq_) const {
        int fr = fr_, fq = fq_; asm volatile("" : "+v"(fr), "+v"(fq));
        const int pn = u.pn; const bool lat = u.pm < ML / BM;
        if (pn >= 3) {
#pragma unroll
            for (int ai = 0; ai < 2; ++ai)
#pragma unroll
                for (int m = 0; m < 4; ++m) { const int R = u.pm * BM + ai * HALF + wr * 64 + m * 16 + fr; bf16_t* dst = G1 + (size_t)R * DM + (pn - 3) * BM + wc * 32 + 8 * fq;
#pragma unroll
                    for (int bj = 0; bj < 2; ++bj) *(u32x4*)(dst + bj * HALF) = pack8(silu4(acc[ai][bj][m][0]), silu4(acc[ai][bj][m][1])); }
        } else if (pn == 2 && wc == 2) {
            f32x4 wv[2];
#pragma unroll
            for (int n = 0; n < 2; ++n) wv[n] = *(const f32x4*)(krn + 16 * (fq >> 1) + 8 * n + 4 * (fq & 1));
#pragma unroll
            for (int ai = 0; ai < 2; ++ai)
#pragma unroll
                for (int m = 0; m < 4; ++m) { const int R = u.pm * BM + ai * HALF + wr * 64 + m * 16 + fr;
                    f32x4 x0 = acc[ai][0][m][0], x1 = acc[ai][0][m][1];
                    const float rinv = rsqrtf(quad_sum(sq4(x0) + sq4(x1)) * (1.f / 32.f) + EPS);
                    x0 = x0 * rinv * wv[0]; x1 = x1 * rinv * wv[1];
                    if (lat) { const int t = R & (SEQ - 1); const int pos = (fq >> 1) ? (t & 63) : (t >> 6); const f32x4* tp = tabB + (pos * 8 + 4 * (fq & 1)) / 2; rot4(x0, x1, tp[0], tp[1]); }
                    *(u32x4*)(KR + (size_t)key_slot(R) * 32 + 8 * fq) = pack8(x0, x1); }
        } else if (pn == 2 && wc == 3) {
        } else if (pn == 0 || lat) {
            bf16_t* base; float* ssb; int ld, cbase, nss, iss;
            if (pn == 0) { base = KVA; ld = 256; cbase = wc * 32; ssb = SSKV; nss = 4; iss = wc; }
            else if (pn == 1) { base = QA; ld = 384; cbase = wc * 32; ssb = SSQ; nss = 6; iss = wc; }
            else { base = QA; ld = 384; cbase = 256 + wc * 64; ssb = SSQ; nss = 6; iss = 4 + wc; }
            const int bjs = pn == 2 ? 32 : HALF;
#pragma unroll
            for (int ai = 0; ai < 2; ++ai)
#pragma unroll
                for (int m = 0; m < 4; ++m) { const int R = u.pm * BM + ai * HALF + wr * 64 + m * 16 + fr; bf16_t* dst = base + (size_t)R * ld + cbase + 8 * fq; float ss = 0.f;
#pragma unroll
                    for (int bj = 0; bj < 2; ++bj) { ss += sq4(acc[ai][bj][m][0]) + sq4(acc[ai][bj][m][1]); *(u32x4*)(dst + bj * bjs) = pack8(acc[ai][bj][m][0], acc[ai][bj][m][1]); }
                    ss = quad_sum(ss); if (fq == 0) ssb[(size_t)R * nss + iss] = ss; }
        }
    }
};

struct EpiKvb {
    static constexpr bool PERM = true, AFTER_DRAIN = false;
    const float* SSKV; const float* knn; bf16_t* K1; bf16_t* V1;
    __device__ __forceinline__ void operator()(const f32x4 (&acc)[2][2][4][2], const Unit& u, int wr, int wc, int fr_, int fq_) const {
        int fr = fr_, fq = fq_; asm volatile("" : "+v"(fr), "+v"(fq));
        const int head = 2 * u.pn + (wc >> 1), type = wc & 1;
#pragma unroll
        for (int ai = 0; ai < 2; ++ai)
#pragma unroll
            for (int m = 0; m < 4; ++m) { const int R = u.pm * BM + ai * HALF + wr * 64 + m * 16 + fr;
                asm volatile("" ::: "memory");
                const f32x4 s4 = *(const f32x4*)(SSKV + (size_t)R * 4); const float rkv = rsqrtf(((s4[0] + s4[1]) + (s4[2] + s4[3])) * (1.f / 256.f) + EPS);
                f32x4 x[2][2]; float ss = 0.f;
#pragma unroll
                for (int bj = 0; bj < 2; ++bj)
#pragma unroll
                    for (int n = 0; n < 2; ++n) { x[bj][n] = acc[ai][bj][m][n] * rkv; ss += sq4(x[bj][n]); }
                bf16_t* dst = (type == 0 ? K1 : V1) + (size_t)key_slot(R) * DM + head * 64 + 8 * fq;
                if (type == 0) { const float rinv = rsqrtf(quad_sum(ss) * (1.f / 64.f) + EPS);
#pragma unroll
                    for (int bj = 0; bj < 2; ++bj)
#pragma unroll
                        for (int n = 0; n < 2; ++n) x[bj][n] = x[bj][n] * rinv * *(const f32x4*)(knn + 32 * bj + 8 * fq + 4 * n); }
                *(u32x4*)dst = pack8(x[0][0], x[0][1]); *(u32x4*)(dst + 32) = pack8(x[1][0], x[1][1]); }
    }
};

struct EpiQb {
    static constexpr bool PERM = true, AFTER_DRAIN = false;
    const float* SSQ; const float* qnw; const f32x4* tabB; bf16_t* Q1N; bf16_t* Q1R; float* SSH;
    __device__ __forceinline__ float rqa_of(int R) const { const float* sp = SSQ + (size_t)R * 6; const f32x2 sa = *(const f32x2*)sp, sb = *(const f32x2*)(sp + 2), sc = *(const f32x2*)(sp + 4);
        return rsqrtf(((sa[0] + sa[1]) + (sb[0] + sb[1]) + (sc[0] + sc[1])) * (1.f / 384.f) + EPS); }
    __device__ __forceinline__ void operator()(const f32x4 (&acc)[2][2][4][2], const Unit& u, int wr, int wc, int fr_, int fq_) const {
        int fr = fr_, fq = fq_; asm volatile("" : "+v"(fr), "+v"(fq));
        const int head = 2 * u.pn + (wc >> 1);
        if ((wc & 1) == 0) {
#pragma unroll
            for (int ai = 0; ai < 2; ++ai)
#pragma unroll
                for (int m = 0; m < 4; ++m) { const int R = u.pm * BM + ai * HALF + wr * 64 + m * 16 + fr;
                    asm volatile("" ::: "memory");
                    const float rqa = rqa_of(R); float ss = 0.f; bf16_t* dst = Q1N + (size_t)R * DM + head * 64 + 8 * fq;
#pragma unroll
                    for (int bj = 0; bj < 2; ++bj) { f32x4 x0 = acc[ai][bj][m][0] * rqa, x1 = acc[ai][bj][m][1] * rqa; ss += sq4(x0) + sq4(x1);
                        x0 = x0 * *(const f32x4*)(qnw + 32 * bj + 8 * fq); x1 = x1 * *(const f32x4*)(qnw + 32 * bj + 8 * fq + 4); *(u32x4*)(dst + 32 * bj) = pack8(x0, x1); }
                    ss = quad_sum(ss); if (fq == 0) SSH[((size_t)R * 16 + head) * 2] = ss; }
        } else {
#pragma unroll
            for (int ai = 0; ai < 2; ++ai)
#pragma unroll
                for (int m = 0; m < 4; ++m) { const int R = u.pm * BM + ai * HALF + wr * 64 + m * 16 + fr;
                    asm volatile("" ::: "memory");
                    const float rqa = rqa_of(R);
                    f32x4 x0 = acc[ai][0][m][0] * rqa, x1 = acc[ai][0][m][1] * rqa; const float ss = quad_sum(sq4(x0) + sq4(x1)); if (fq == 0) SSH[((size_t)R * 16 + head) * 2 + 1] = ss;
                    const float* wp = qnw + 64 + 16 * (fq >> 1) + 4 * (fq & 1); x0 = x0 * *(const f32x4*)wp; x1 = x1 * *(const f32x4*)(wp + 8);
                    const int t = R & (SEQ - 1); const int pos = (fq >> 1) ? (t & 63) : (t >> 6); const f32x4* tp = tabB + (pos * 8 + 4 * (fq & 1)) / 2; rot4(x0, x1, tp[0], tp[1]);
                    *(u32x4*)(Q1R + (size_t)R * 512 + head * 32 + 8 * fq) = pack8(x0, x1); }
        }
    }
};

struct In1Order {
    int G, c; ROrder lat;
    __host__ __device__ void init(int G_, int c_) { G = G_; c = c_; lat.init(0, ML / BM, N_IN1P, G_, c_); }
    __host__ __device__ bool next(int i, Unit& u) const {
        const long L = (long)i * G + c; if (L < lat.nwg) return lat.next(i, u);
        const int e = (int)(L - lat.nwg); if (e >= 4) return false; u.pm = ML / BM + (e >> 1); u.pn = (e & 1) * 2; return true;
    }
    __device__ __forceinline__ void a_ready(const Unit&) const {}
    __device__ __forceinline__ void done(const Unit&) const {}
};
template <class Epi, class Sched, bool ALIGN_EPI = false, bool SP2 = false>
__device__ __forceinline__ void gemm_phase(PG8_LAS unsigned char* lds, const Gemm g, const Sched& S, const Epi& E) {
    const int tid = threadIdx.x, wid = __builtin_amdgcn_readfirstlane(tid >> 6), lane = tid & 63, wr = wid >> 2, wc = wid & 3, fr = lane & 15, fq = lane >> 4;
    const int K = g.K, nt = K / BK;
    unsigned voffA[2], voffB[2];
#pragma unroll
    for (int i = 0; i < 2; ++i) { int R, C; stage_rc(tid * 16 + i * 8192, R, C); const int Rb = Epi::PERM ? ((R & ~31) + perm32(R & 31)) : R;
        voffA[i] = (unsigned)(R * K + C) * 2u; voffB[i] = (unsigned)(Rb * K + C) * 2u; }
    const size_t kstep = (size_t)(BK * 2);
    const size_t hstep = (size_t)HALF * K * 2;
    const size_t tstep = 2 * hstep;
    const unsigned ldsw = (unsigned)wid * 1024u;
    const int aoff = lds_byte(wr * 64 + fr, fq * 8), boff = lds_byte(wc * 32 + fr, fq * 8);
#define PG8_SA(b, h) (((b) * 2 + (h)) * HTB)
#define PG8_SB(b, h) ((4 + (b) * 2 + (h)) * HTB)
#define PG8_STAGE(bufoff, gbase, voff) do { _Pragma("unroll") for (int _i = 0; _i < 2; ++_i) \
        __builtin_amdgcn_global_load_lds((const unsigned*)((const char*)(gbase) + (voff)[_i]), (PG8_LAS unsigned*)(lds + (bufoff) + ldsw + _i * 8192), 16, 0, 0); } while (0)
#define PG8_LDA(dst, b, h) do { _Pragma("unroll") for (int m = 0; m < 4; ++m) _Pragma("unroll") for (int k = 0; k < 2; ++k) dst[m][k] = *(const PG8_LAS bf16x8*)(lds + PG8_SA(b, h) + aoff + m * 2048 + k * 1024); } while (0)
#define PG8_LDB(dst, b, h) do { _Pragma("unroll") for (int n = 0; n < 2; ++n) _Pragma("unroll") for (int k = 0; k < 2; ++k) dst[n][k] = *(const PG8_LAS bf16x8*)(lds + PG8_SB(b, h) + boff + n * 2048 + k * 1024); } while (0)
#define PG8_MMA(ai, bj, At, Bt) do { __builtin_amdgcn_s_setprio(1); _Pragma("unroll") for (int m = 0; m < 4; ++m) _Pragma("unroll") for (int n = 0; n < 2; ++n) _Pragma("unroll") for (int k = 0; k < 2; ++k) \
        acc[ai][bj][m][n] = __builtin_amdgcn_mfma_f32_16x16x32_bf16(Bt[n][k], At[m][k], acc[ai][bj][m][n], 0, 0, 0); __builtin_amdgcn_s_setprio(0); } while (0)
#define PG8_WAIT_V(n) asm volatile("s_waitcnt vmcnt(" #n ")" ::: "memory")
#define PG8_WAIT_L(n) asm volatile("s_waitcnt lgkmcnt(" #n ")" ::: "memory")
#define PG8_BAR __builtin_amdgcn_s_barrier()
#define PG8_SCHED __builtin_amdgcn_sched_barrier(0)
    Unit cur, nxt; int ui = 0;
    if (!S.next(0, cur)) return;
    f32x4 acc[2][2][4][2];
#pragma unroll
    for (int a = 0; a < 2; ++a)
#pragma unroll
        for (int b = 0; b < 2; ++b)
#pragma unroll
            for (int m = 0; m < 4; ++m)
#pragma unroll
                for (int n = 0; n < 2; ++n) acc[a][b][m][n] = (f32x4){0.f, 0.f, 0.f, 0.f};
    bf16x8 At[4][2], B0[2][2], B1[2][2];
    const char* cA = (const char*)g.A + (size_t)cur.pm * tstep; const char* cB = (const char*)g.Bt + (size_t)cur.pn * tstep;
    S.a_ready(cur);
    if constexpr (SP2) {
        PG8_STAGE(PG8_SB(0, 0), cB, voffB); PG8_STAGE(PG8_SB(0, 1), cB + hstep, voffB); PG8_STAGE(PG8_SA(0, 0), cA, voffA); PG8_STAGE(PG8_SA(0, 1), cA + hstep, voffA);
        if (wr == 1) PG8_BAR;
        PG8_WAIT_V(2); PG8_BAR;
        PG8_STAGE(PG8_SB(1, 0), cB + kstep, voffB); PG8_STAGE(PG8_SA(1, 0), cA + kstep, voffA); PG8_STAGE(PG8_SB(1, 1), cB + hstep + kstep, voffB);
        PG8_WAIT_V(6); PG8_BAR;
    } else {
        PG8_STAGE(PG8_SB(0, 0), cB, voffB); PG8_STAGE(PG8_SA(0, 0), cA, voffA); PG8_STAGE(PG8_SB(0, 1), cB + hstep, voffB); PG8_STAGE(PG8_SA(0, 1), cA + hstep, voffA);
        if (wr == 1) PG8_BAR;
        PG8_WAIT_V(4); PG8_BAR;
        PG8_STAGE(PG8_SB(1, 0), cB + kstep, voffB); PG8_STAGE(PG8_SA(1, 0), cA + kstep, voffA); PG8_STAGE(PG8_SB(1, 1), cB + hstep + kstep, voffB);
        PG8_WAIT_V(6); PG8_BAR;
    }
    for (;;) {
        const bool has_next = S.next(ui + 1, nxt);
        const char* nA = has_next ? (const char*)g.A + (size_t)nxt.pm * tstep : cA; const char* nB = has_next ? (const char*)g.Bt + (size_t)nxt.pn * tstep : cB;
        _Pragma("nounroll") for (int t = 0; t < nt; t += 2) {
            const bool last = (t == nt - 2);
            const char* a1 = cA + (size_t)(t + 1) * kstep;
            const char* a2 = last ? nA : cA + (size_t)(t + 2) * kstep; const char* b2 = last ? nB : cB + (size_t)(t + 2) * kstep;
            const char* a3 = a2 + kstep; const char* b3 = b2 + kstep;
            if (last && has_next) S.a_ready(nxt);
            if constexpr (SP2) {
            PG8_LDB(B0, 0, 0); PG8_LDB(B1, 0, 1); PG8_SCHED; PG8_LDA(At, 0, 0); PG8_STAGE(PG8_SA(1, 1), a1 + hstep, voffA);
            PG8_WAIT_V(8); PG8_WAIT_L(0); PG8_BAR; PG8_MMA(0, 0, At, B0); PG8_MMA(0, 1, At, B1); PG8_BAR; PG8_SCHED;
            PG8_LDA(At, 0, 1); PG8_STAGE(PG8_SB(0, 0), b2, voffB); PG8_STAGE(PG8_SB(0, 1), b2 + hstep, voffB); PG8_STAGE(PG8_SA(0, 0), a2, voffA);
            PG8_WAIT_V(8); PG8_WAIT_L(0); PG8_BAR; PG8_MMA(1, 0, At, B0); PG8_MMA(1, 1, At, B1); PG8_BAR; PG8_SCHED;
            PG8_LDB(B0, 1, 0); PG8_LDB(B1, 1, 1); PG8_SCHED; PG8_LDA(At, 1, 0); PG8_STAGE(PG8_SA(0, 1), a2 + hstep, voffA);
            PG8_WAIT_V(8); PG8_WAIT_L(0); PG8_BAR; PG8_MMA(0, 0, At, B0); PG8_MMA(0, 1, At, B1); PG8_BAR; PG8_SCHED;
            PG8_LDA(At, 1, 1); PG8_STAGE(PG8_SB(1, 0), b3, voffB); PG8_STAGE(PG8_SB(1, 1), b3 + hstep, voffB); PG8_STAGE(PG8_SA(1, 0), a3, voffA);
            PG8_WAIT_V(8); PG8_WAIT_L(0); PG8_BAR; PG8_MMA(1, 0, At, B0); PG8_MMA(1, 1, At, B1); PG8_BAR; PG8_SCHED;
            } else {
            PG8_LDB(B0, 0, 0); PG8_SCHED; PG8_LDA(At, 0, 0); PG8_STAGE(PG8_SA(1, 1), a1 + hstep, voffA);
            PG8_WAIT_L(8); PG8_BAR; PG8_WAIT_L(0); PG8_MMA(0, 0, At, B0); PG8_BAR; PG8_SCHED;
            PG8_LDB(B1, 0, 1); PG8_STAGE(PG8_SB(0, 0), b2, voffB);
            PG8_BAR; PG8_WAIT_L(0); PG8_MMA(0, 1, At, B1); PG8_BAR;
            PG8_LDA(At, 0, 1); PG8_STAGE(PG8_SA(0, 0), a2, voffA);
            PG8_BAR; PG8_WAIT_L(0); PG8_MMA(1, 0, At, B0); PG8_BAR; PG8_SCHED;
            PG8_STAGE(PG8_SB(0, 1), b2 + hstep, voffB);
            PG8_WAIT_V(6); PG8_BAR; PG8_MMA(1, 1, At, B1); PG8_BAR;
            PG8_LDB(B0, 1, 0); PG8_SCHED; PG8_LDA(At, 1, 0); PG8_STAGE(PG8_SA(0, 1), a2 + hstep, voffA);
            PG8_WAIT_L(8); PG8_BAR; PG8_WAIT_L(0); PG8_MMA(0, 0, At, B0); PG8_BAR; PG8_SCHED;
            PG8_LDB(B1, 1, 1); PG8_STAGE(PG8_SB(1, 0), b3, voffB);
            PG8_BAR; PG8_WAIT_L(0); PG8_MMA(0, 1, At, B1); PG8_BAR;
            PG8_LDA(At, 1, 1); PG8_STAGE(PG8_SA(1, 0), a3, voffA);
            PG8_BAR; PG8_WAIT_L(0); PG8_MMA(1, 0, At, B0); PG8_BAR; PG8_SCHED;
            PG8_STAGE(PG8_SB(1, 1), b3 + hstep, voffB);
            PG8_WAIT_V(6); PG8_BAR; PG8_MMA(1, 1, At, B1); PG8_BAR;
            }
        }
        if constexpr (ALIGN_EPI) { if (wr == 0) PG8_BAR; }
        if constexpr (!Epi::AFTER_DRAIN) { E(acc, cur, wr, wc, fr, fq); S.done(cur); }
        if (!has_next) break;
#pragma unroll
        for (int a = 0; a < 2; ++a)
#pragma unroll
            for (int b = 0; b < 2; ++b)
#pragma unroll
                for (int m = 0; m < 4; ++m)
#pragma unroll
                    for (int n = 0; n < 2; ++n) acc[a][b][m][n] = (f32x4){0.f, 0.f, 0.f, 0.f};
        cur = nxt; cA = nA; cB = nB; ++ui;
        if constexpr (ALIGN_EPI) { if (wr == 1) PG8_BAR; }
    }
    PG8_WAIT_V(0);
    if constexpr (!ALIGN_EPI) { if (wr == 0) PG8_BAR; }
    PG8_BAR;
    if constexpr (Epi::AFTER_DRAIN) { E.fused(acc, cur, wr, wc, fr, fq, lds, wid, lane); S.done(cur); }
#undef PG8_SA
#undef PG8_SB
#undef PG8_STAGE
#undef PG8_LDA
#undef PG8_LDB
#undef PG8_MMA
#undef PG8_WAIT_V
#undef PG8_WAIT_L
#undef PG8_BAR
#undef PG8_SCHED
}
}

DEVI void sincos_pos(float ang, float& cs, float& sn) {
    const double TWO_PI = 6.283185307179586476925286766559; const double a = (double)ang; const double k = __builtin_rint(a * (1.0 / TWO_PI));
    const float r = (float)(a - k * TWO_PI);
    cs = cosf(r); sn = sinf(r);
}

namespace afast {
constexpr int NW = 8, KVBLK = 64, SLOTK = 12288, SLOTV = 8192, KROFF = 8192;
constexpr int LDS_K = 0, LDS_V = 3 * SLOTK, LDS_WS = LDS_V + 3 * SLOTV, LDS_OST = LDS_WS + NW * 256, LDS_BYTES = LDS_OST + NW * 4096;
#define SBAR() __builtin_amdgcn_sched_barrier(0)
#define PIN(x) asm volatile("" : "+v"(x))
#define MFMA(a, b, c) __builtin_amdgcn_mfma_f32_32x32x16_bf16(a, b, c, 0, 0, 0)
#define WAIT_BAR(N) asm volatile("s_waitcnt vmcnt(" #N ") lgkmcnt(0)\n\ts_barrier" ::: "memory")
DEVI int crow(int r, int hi) { return (r & 3) + 8 * (r >> 2) + 4 * hi; }
DEVI unsigned cvtpk(float lo, float hi) { unsigned r; asm("v_cvt_pk_bf16_f32 %0, %1, %2" : "=v"(r) : "v"(lo), "v"(hi)); return r; }
DEVI void glds16(const void* g, unsigned lds_base) {
    unsigned sv; asm volatile("s_mov_b32 %0, m0\n\ts_mov_b32 m0, %2\n\ts_nop 0\n\tglobal_load_lds_dwordx4 %1, off\n\ts_mov_b32 m0, %0" : "=&s"(sv) : "v"(g), "s"(lds_base) : "memory"); }
typedef __attribute__((address_space(3))) const char* lds_cptr;
typedef short v4i16_t __attribute__((ext_vector_type(4)));
DEVI bf16x8 ldsb128(lds_cptr p) { return *(const __attribute__((address_space(3))) bf16x8*)p; }
DEVI s16x4 vtr(lds_cptr p) { return __builtin_bit_cast(s16x4, __builtin_amdgcn_ds_read_tr16_b64_v4i16((__attribute__((address_space(3))) v4i16_t*)p)); }
DEVI bf16x8 scale8(bf16x8 v, float s) {
    u32x4 w = __builtin_bit_cast(u32x4, v); u32x4 o;
#pragma unroll
    for (int i = 0; i < 4; ++i) { const float lo = __uint_as_float(w[i] << 16) * s, hi = __uint_as_float(w[i] & 0xffff0000u) * s; o[i] = cvtpk(lo, hi); }
    return __builtin_bit_cast(bf16x8, o);
}

template <int ROPE>
DEVI void attn_unit(const bf16_t* Qn, int ldq, const bf16_t* Qr, const float* ssh, const bf16_t* __restrict__ Kn, int ldk, const bf16_t* __restrict__ Kr,
                    const bf16_t* __restrict__ V, int ldv, int NT, bf16_t* O, const bf16_t* G, int ldo, char* lds) {
    const int tid = threadIdx.x, lane = tid & 63, r32 = lane & 31, hi = lane >> 5; const int wid = __builtin_amdgcn_readfirstlane(tid >> 6);
    const unsigned lds0 = (unsigned)(uintptr_t)lds; float* wsf = (float*)(lds + LDS_WS) + wid * 64;
    const bf16_t* ksrc = Kn + (size_t)lane * ldk + wid * 8;
    const bf16_t* vsrc = V + (size_t)(16 * (wid & 3) + (lane >> 2)) * ldv + (wid >> 2) * 32 + (lane & 3) * 8;
    const bf16_t* krsrc = ROPE ? Kr + (size_t)(32 * (wid & 1) + r32) * 32 + 8 * (2 * ((wid >> 1) & 1) + hi) : nullptr;
    const unsigned kdst = lds0 + LDS_K + wid * 1024, vdst = lds0 + LDS_V + wid * 1024, krdst = lds0 + LDS_K + KROFF + (wid & 3) * 1024;
    const bool rwave = ROPE && wid < 4;
#define DMA_K(t, slot) do { if (ROPE) { if (rwave) glds16(krsrc + (size_t)(t) * KVBLK * 32, (unsigned)__builtin_amdgcn_readfirstlane(krdst + (slot))); } \
        glds16(ksrc + (size_t)(t) * KVBLK * ldk, (unsigned)__builtin_amdgcn_readfirstlane(kdst + (slot))); } while (0)
#define DMA_V(t, slot) glds16(vsrc + (size_t)(t) * KVBLK * ldv, (unsigned)__builtin_amdgcn_readfirstlane(vdst + (slot)))
    const lds_cptr vp0 = (lds_cptr)lds + LDS_V + ((lane >> 4) & 1) * 32 + (lane & 3) * 8 + (4 * hi + ((lane & 15) >> 2)) * 64;
    const lds_cptr kp0 = (lds_cptr)lds + LDS_K + hi * 1024 + r32 * 16;
    const lds_cptr krp0 = (lds_cptr)lds + LDS_K + KROFF + hi * 512 + r32 * 16;
    DMA_K(0, 0); DMA_V(0, 0); DMA_K(1, SLOTK);
    bf16x8 qr[4]; bf16x8 qrr[2];
    { const bf16_t* Qw = Qn + (size_t)(wid * 32 + r32) * ldq + hi * 8;
#pragma unroll
      for (int d0 = 0; d0 < 4; ++d0) qr[d0] = *reinterpret_cast<const bf16x8*>(Qw + d0 * 16);
      if (ROPE) { const bf16_t* Qrw = Qr + (size_t)(wid * 32 + r32) * 512 + hi * 8;
#pragma unroll
          for (int d0 = 0; d0 < 2; ++d0) qrr[d0] = *reinterpret_cast<const bf16x8*>(Qrw + d0 * 16);
          const f32x2 s2 = *(const f32x2*)(ssh + (size_t)(wid * 32 + r32) * 32); const float sc = rsqrtf((s2[0] + s2[1]) * (1.f / 96.f) + EPS) * C2_MLA;
#pragma unroll
          for (int d0 = 0; d0 < 4; ++d0) qr[d0] = scale8(qr[d0], sc);
#pragma unroll
          for (int d0 = 0; d0 < 2; ++d0) qrr[d0] = scale8(qrr[d0], sc); } }
    float l_reg = 0.f; f32x16 o[2]; o[0] = f32x16{}; o[1] = f32x16{};
    const f32x16 zero16 = f32x16{};
    f32x16 pA0, pA1, pB0, pB1; bf16x8 kf[8]; bf16x8 kfr[4]; s16x4 vlo[8], vhi[8]; u32x4 pw0, pw1, pw2, pw3;
    int sl_prev = 0, sl_cur = 0, sl_next = SLOTK;
#define VSL(s) (((s) / (SLOTK / 1024)) * (SLOTV / 1024))
#define ROT() do { sl_prev = sl_cur; sl_cur = sl_next; sl_next = (sl_next == 2 * SLOTK) ? 0 : sl_next + SLOTK; } while (0)
#define EX(v) __builtin_amdgcn_exp2f(v)
#define KLOADALL(slot) do { _Pragma("unroll") for (int d0 = 0; d0 < 4; ++d0) { kf[2 * d0] = ldsb128(kp0 + (slot) + d0 * 2048); kf[2 * d0 + 1] = ldsb128(kp0 + (slot) + d0 * 2048 + 512); } \
        if (ROPE) { _Pragma("unroll") for (int q = 0; q < 4; ++q) kfr[q] = ldsb128(krp0 + (slot) + q * 1024); } } while (0)
    DMA_K(2, 2 * SLOTK);
    WAIT_BAR(3);
    KLOADALL(0);
    pA0 = MFMA(kf[0], qr[0], zero16); pA1 = MFMA(kf[1], qr[0], zero16); pA0 = MFMA(kf[2], qr[1], pA0); pA1 = MFMA(kf[3], qr[1], pA1);
    pA0 = MFMA(kf[4], qr[2], pA0); pA1 = MFMA(kf[5], qr[2], pA1); pA0 = MFMA(kf[6], qr[3], pA0); pA1 = MFMA(kf[7], qr[3], pA1);
    if (ROPE) { pA0 = MFMA(kfr[0], qrr[0], pA0); pA1 = MFMA(kfr[1], qrr[0], pA1); pA0 = MFMA(kfr[2], qrr[1], pA0); pA1 = MFMA(kfr[3], qrr[1], pA1); }
#pragma unroll
    for (int r = 0; r < 16; ++r) { pA0[r] = EX(pA0[r]); pA1[r] = EX(pA1[r]); }
    WAIT_BAR(0);
    DMA_K(3, 0); DMA_V(1, SLOTV); ROT();
    KLOADALL(sl_cur);
    WAIT_BAR(2);
#define PKW(P, i) cvtpk(P[i], P[i + 1])
#define PAF(k) __builtin_bit_cast(bf16x8, pw##k)
#define VFR(i) (bf16x8){vlo[i][0], vlo[i][1], vlo[i][2], vlo[i][3], vhi[i][0], vhi[i][1], vhi[i][2], vhi[i][3]}
#define VRD(i) do { vlo[i] = vtr(vp_ + (((i) >> 2) * 4096 + ((i) & 3) * 1024)); vhi[i] = vtr(vp_ + (((i) >> 2) * 4096 + ((i) & 3) * 1024 + 512)); } while (0)
#define KRD(G, d0) do { if (G) { kf[2 * (d0)] = ldsb128(kp0 + sl_next + (d0) * 2048); kf[2 * (d0) + 1] = ldsb128(kp0 + sl_next + (d0) * 2048 + 512); SBAR(); } } while (0)
#define KRR(G, q) do { if (ROPE) { if (G) { kfr[2 * (q)] = ldsb128(krp0 + sl_next + (2 * (q)) * 1024); kfr[2 * (q) + 1] = ldsb128(krp0 + sl_next + (2 * (q) + 1) * 1024); SBAR(); } } } while (0)
#define GAPA4(CX, MF, a0, a1, a2, a3, W0, W1, PW) do { MF; sacc += a0; sacc += a1; sacc += a2; sacc += a3; W0; W1; PIN(PW); PIN(sacc); PIN(CX); SBAR(); } while (0)
#define GAPA3(CX, MF, a0, a1, a2, W0, W1, PW) do { MF; sacc += a0; sacc += a1; sacc += a2; W0; W1; PIN(PW); PIN(sacc); PIN(CX); SBAR(); } while (0)
#define GAPA31(CX, MF, a0, a1, a2, W0, PW) do { MF; sacc += a0; sacc += a1; sacc += a2; W0; PIN(PW); PIN(sacc); PIN(CX); SBAR(); } while (0)
#define GAPA21(CX, MF, a0, a1, W0, PW) do { MF; sacc += a0; sacc += a1; W0; PIN(PW); PIN(sacc); PIN(CX); SBAR(); } while (0)
#define GAPB(MF, X, i) do { MF; X[i] = EX(X[i]); X[i + 1] = EX(X[i + 1]); X[i + 2] = EX(X[i + 2]); X[i + 3] = EX(X[i + 3]); PIN(X); SBAR(); } while (0)
#define STEP(C0, C1, P0, P1, t, GK, GV, GL) do { SBAR(); \
    const lds_cptr vp_ = vp0 + VSL(sl_prev); \
    VRD(0); SBAR(); float sacc = P0[0] + P0[1]; \
    if (!ROPE) { \
                        GAPA4(C0, C0 = MFMA(kf[0], qr[0], zero16), P0[2], P0[3], P0[4], P0[5],     pw0[0] = PKW(P0, 0),  pw0[1] = PKW(P0, 2),  pw0); \
        VRD(4); SBAR(); GAPA4(C1, C1 = MFMA(kf[1], qr[0], zero16), P0[6], P0[7], P0[8], P0[9],     pw0[2] = PKW(P0, 4),  pw0[3] = PKW(P0, 6),  pw0); \
        VRD(1); SBAR(); GAPA4(C0, C0 = MFMA(kf[2], qr[1], C0),    P0[10], P0[11], P0[12], P0[13], pw1[0] = PKW(P0, 8),  pw1[1] = PKW(P0, 10), pw1); \
        VRD(5); SBAR(); GAPA4(C1, C1 = MFMA(kf[3], qr[1], C1),    P0[14], P0[15], P1[0], P1[1],   pw1[2] = PKW(P0, 12), pw1[3] = PKW(P0, 14), pw1); \
        VRD(2); SBAR(); GAPA4(C0, C0 = MFMA(kf[4], qr[2], C0),    P1[2], P1[3], P1[4], P1[5],     pw2[0] = PKW(P1, 0),  pw2[1] = PKW(P1, 2),  pw2); \
        VRD(6); SBAR(); GAPA4(C1, C1 = MFMA(kf[5], qr[2], C1),    P1[6], P1[7], P1[8], P1[9],     pw2[2] = PKW(P1, 4),  pw2[3] = PKW(P1, 6),  pw2); \
        VRD(3); SBAR(); GAPA4(C0, C0 = MFMA(kf[6], qr[3], C0),    P1[10], P1[11], P1[12], P1[13], pw3[0] = PKW(P1, 8),  pw3[1] = PKW(P1, 10), pw3); \
        VRD(7); SBAR(); GAPA4(C1, C1 = MFMA(kf[7], qr[3], C1),    P1[14], P1[15], 0.f, 0.f,       pw3[2] = PKW(P1, 12), pw3[3] = PKW(P1, 14), pw3); \
    } else { \
                        GAPA3(C0, C0 = MFMA(kf[0], qr[0], zero16), P0[2], P0[3], P0[4],    pw0[0] = PKW(P0, 0),  pw0[1] = PKW(P0, 2),  pw0); \
        VRD(4); SBAR(); GAPA3(C1, C1 = MFMA(kf[1], qr[0], zero16), P0[5], P0[6], P0[7],    pw0[2] = PKW(P0, 4),  pw0[3] = PKW(P0, 6),  pw0); \
        VRD(1); SBAR(); GAPA3(C0, C0 = MFMA(kf[2], qr[1], C0),    P0[8], P0[9], P0[10],   pw1[0] = PKW(P0, 8),  pw1[1] = PKW(P0, 10), pw1); \
        VRD(5); SBAR(); GAPA3(C1, C1 = MFMA(kf[3], qr[1], C1),    P0[11], P0[12], P0[13], pw1[2] = PKW(P0, 12), pw1[3] = PKW(P0, 14), pw1); \
        VRD(2); SBAR(); GAPA31(C0, C0 = MFMA(kf[4], qr[2], C0),   P0[14], P0[15], P1[0],  pw2[0] = PKW(P1, 0),  pw2); \
        VRD(6); SBAR(); GAPA31(C1, C1 = MFMA(kf[5], qr[2], C1),   P1[1], P1[2], P1[3],    pw2[1] = PKW(P1, 2),  pw2); \
        VRD(3); SBAR(); GAPA21(C0, C0 = MFMA(kf[6], qr[3], C0),   P1[4], P1[5],           pw2[2] = PKW(P1, 4),  pw2); \
        VRD(7); SBAR(); GAPA21(C1, C1 = MFMA(kf[7], qr[3], C1),   P1[6], P1[7],           pw2[3] = PKW(P1, 6),  pw2); \
                        GAPA21(C0, C0 = MFMA(kfr[0], qrr[0], C0), P1[8], P1[9],           pw3[0] = PKW(P1, 8),  pw3); \
                        GAPA21(C1, C1 = MFMA(kfr[1], qrr[0], C1), P1[10], P1[11],         pw3[1] = PKW(P1, 10), pw3); \
                        GAPA21(C0, C0 = MFMA(kfr[2], qrr[1], C0), P1[12], P1[13],         pw3[2] = PKW(P1, 12), pw3); \
                        GAPA21(C1, C1 = MFMA(kfr[3], qrr[1], C1), P1[14], P1[15],         pw3[3] = PKW(P1, 14), pw3); \
    } \
    l_reg += sacc; \
    if (GK) DMA_K((t) + 3, sl_cur); if (GV) DMA_V((t) + 1, VSL(sl_next)); \
    SBAR(); \
    GAPB(o[0] = MFMA(PAF(0), VFR(0), o[0]), C0, 0); \
    KRD(GL, 0); GAPB(o[1] = MFMA(PAF(0), VFR(4), o[1]), C0, 4); \
    KRD(GL, 1); GAPB(o[0] = MFMA(PAF(1), VFR(1), o[0]), C0, 8); \
    KRD(GL, 2); GAPB(o[1] = MFMA(PAF(1), VFR(5), o[1]), C0, 12); \
    KRD(GL, 3); GAPB(o[0] = MFMA(PAF(2), VFR(2), o[0]), C1, 0); \
    KRR(GL, 0); GAPB(o[1] = MFMA(PAF(2), VFR(6), o[1]), C1, 4); \
    KRR(GL, 1); GAPB(o[0] = MFMA(PAF(3), VFR(3), o[0]), C1, 8); \
    GAPB(o[1] = MFMA(PAF(3), VFR(7), o[1]), C1, 12); \
    } while (0)
    int t = 1;
    for (; t + 5 < NT; t += 2) {
        STEP(pB0, pB1, pA0, pA1, t, true, true, true);     WAIT_BAR(2); ROT();
        STEP(pA0, pA1, pB0, pB1, t + 1, true, true, true); WAIT_BAR(2); ROT();
    }
#define ENDW(tt) do { if ((tt) + 3 < NT) { WAIT_BAR(2); } else if ((tt) + 2 < NT) { WAIT_BAR(1); } else { WAIT_BAR(0); } } while (0)
    for (; t + 1 < NT; t += 2) {
        STEP(pB0, pB1, pA0, pA1, t, (t + 3 < NT), (t + 1 < NT), (t + 1 < NT));         ENDW(t);     ROT();
        STEP(pA0, pA1, pB0, pB1, t + 1, (t + 4 < NT), (t + 2 < NT), (t + 2 < NT));     ENDW(t + 1); ROT();
    }
    STEP(pB0, pB1, pA0, pA1, NT - 1, false, false, false);
    { float sacc = pB0[0] + pB0[1];
#pragma unroll
      for (int r = 2; r < 16; ++r) sacc += pB0[r];
#pragma unroll
      for (int r = 0; r < 16; ++r) sacc += pB1[r];
      l_reg += sacc;
      pw0 = (u32x4){PKW(pB0, 0), PKW(pB0, 2), PKW(pB0, 4), PKW(pB0, 6)}; pw1 = (u32x4){PKW(pB0, 8), PKW(pB0, 10), PKW(pB0, 12), PKW(pB0, 14)};
      pw2 = (u32x4){PKW(pB1, 0), PKW(pB1, 2), PKW(pB1, 4), PKW(pB1, 6)}; pw3 = (u32x4){PKW(pB1, 8), PKW(pB1, 10), PKW(pB1, 12), PKW(pB1, 14)};
      const lds_cptr vp_ = vp0 + VSL(sl_cur); _Pragma("unroll") for (int i = 0; i < 8; ++i) VRD(i);
      o[0] = MFMA(PAF(0), VFR(0), o[0]); o[1] = MFMA(PAF(0), VFR(4), o[1]); o[0] = MFMA(PAF(1), VFR(1), o[0]); o[1] = MFMA(PAF(1), VFR(5), o[1]);
      o[0] = MFMA(PAF(2), VFR(2), o[0]); o[1] = MFMA(PAF(2), VFR(6), o[1]); o[0] = MFMA(PAF(3), VFR(3), o[0]); o[1] = MFMA(PAF(3), VFR(7), o[1]); }
    { auto rr = __builtin_amdgcn_permlane32_swap(__float_as_uint(l_reg), __float_as_uint(l_reg), false, false); l_reg = __uint_as_float(rr[0]) + __uint_as_float(rr[1]); }
    if (hi == 0) wsf[32 + r32] = l_reg; asm volatile("s_waitcnt lgkmcnt(0)" ::: "memory");
    float rli[16];
#pragma unroll
    for (int r = 0; r < 16; ++r) rli[r] = __builtin_amdgcn_rcpf(wsf[32 + crow(r, hi)]);
    bf16_t* stg = (bf16_t*)(lds + LDS_OST) + wid * 2048;
#pragma unroll
    for (int r = 0; r < 16; ++r) { const int orow = crow(r, hi);
#pragma unroll
        for (int d0 = 0; d0 < 2; ++d0) stg[orow * 64 + d0 * 32 + r32] = (bf16_t)f2bf(o[d0][r] * rli[r]); }
    asm volatile("s_waitcnt lgkmcnt(0)" ::: "memory");
#pragma unroll
    for (int i = 0; i < 4; ++i) { const int row = i * 8 + (lane >> 3), ch = lane & 7; const size_t goff = (size_t)(wid * 32 + row) * ldo + ch * 8;
        const u32x4 ov = *(const u32x4*)(stg + row * 64 + ch * 8); const u32x4 gv = *(const u32x4*)(G + goff); u32x4 w;
#pragma unroll
        for (int q = 0; q < 4; ++q) { const float lo = __uint_as_float(ov[q] << 16) * __uint_as_float(gv[q] << 16), hh = __uint_as_float(ov[q] & 0xffff0000u) * __uint_as_float(gv[q] & 0xffff0000u); w[q] = cvtpk(lo, hh); }
        *(u32x4*)(O + goff) = w; }
    asm volatile("s_waitcnt lgkmcnt(0)\n\ts_barrier" ::: "memory");
#undef DMA_K
#undef DMA_V
#undef VSL
#undef ROT
#undef EX
#undef KLOADALL
#undef PKW
#undef PAF
#undef VFR
#undef VRD
#undef KRD
#undef KRR
#undef GAPA4
#undef GAPA3
#undef GAPA31
#undef GAPA21
#undef GAPB
#undef STEP
#undef ENDW
}
#undef SBAR
#undef PIN
#undef MFMA
#undef WAIT_BAR
}

#define RLX_AGENT __ATOMIC_RELAXED, __HIP_MEMORY_SCOPE_AGENT
#define XB_TMO      128
#define XB_XCNT(j)  (256  + 64 * (j))
#define XB_XSUB(j)  (1280 + 64 * (j))
#define XB_XGEN(j)  (2304 + 64 * (j))
#define XB_TOP      3328
#define XB_TOPGEN   3392
#define XCD_BAR_WORDS 3456
#define XB_SPIN_CAP (1u << 18)

__device__ __forceinline__ unsigned xb_ld(unsigned* p)              { return __hip_atomic_load(p, __ATOMIC_RELAXED, __HIP_MEMORY_SCOPE_AGENT); }
__device__ __forceinline__ unsigned xb_add(unsigned* p, unsigned v) { return __hip_atomic_fetch_add(p, v, __ATOMIC_RELAXED, __HIP_MEMORY_SCOPE_AGENT); }
__device__ __forceinline__ unsigned xb_xcc_id() { return (unsigned)__builtin_amdgcn_s_getreg((3 << 11) | 20) & 0xFu; }
#define XB_SPIN(cond, bar) do { unsigned _sp = 0; while (cond) { __builtin_amdgcn_s_sleep(1); \
    if ((++_sp & 255u) == 0u) { if (xb_ld(&(bar)[XB_TMO])) break; if (_sp > XB_SPIN_CAP) { atomicAdd(&(bar)[XB_TMO], 1u); break; } } } } while (0)

struct XcdBarrier {
    unsigned* bar; unsigned x;
    volatile LAS unsigned* st;
};

__device__ __forceinline__ XcdBarrier xcd_barrier_post(unsigned* bar, volatile LAS unsigned* st) {
    XcdBarrier b; b.bar = bar; b.x = xb_xcc_id(); b.st = st;
    if (threadIdx.x == 0) (void)xb_add(&bar[XB_XCNT(b.x)], 1u);
    return b;
}
__device__ __forceinline__ void xcd_barrier_complete(unsigned* bar, unsigned x, unsigned& nloc, unsigned& nx) {
    const unsigned G = gridDim.x * gridDim.y * gridDim.z;
    unsigned sum, cnt, mine, sp = 0u;
    for (;;) {
        sum = 0u; cnt = 0u; mine = 0u;
#pragma unroll
        for (unsigned j = 0; j < 16; ++j) { const unsigned c = xb_ld(&bar[XB_XCNT(j)]); sum += c; cnt += (c > 0u) ? 1u : 0u; mine = (j == x) ? c : mine; }
        if (sum == G) break;
        __builtin_amdgcn_s_sleep(1);
        if ((++sp & 255u) == 0u) { if (xb_ld(&bar[XB_TMO])) break; if (sp > XB_SPIN_CAP) { atomicAdd(&bar[XB_TMO], 1u); break; } }
    }
    nloc = mine > 0u ? mine : 1u; nx = cnt > 0u ? cnt : 1u;
}

__device__ __forceinline__ void xcd_barrier(const XcdBarrier& b) {
    asm volatile("s_waitcnt vmcnt(0)" ::: "memory");
    __syncthreads();
    if (threadIdx.x == 0) {
        unsigned* bar = b.bar;
        __builtin_amdgcn_s_waitcnt(0);
        unsigned nloc = b.st[0], nx = b.st[1];
        if (nloc == 0u) { xcd_barrier_complete(bar, b.x, nloc, nx); b.st[0] = nloc; b.st[1] = nx; }
        const unsigned old = xb_add(&bar[XB_XSUB(b.x)], 1u);
        const unsigned gen = old / nloc;
        if (old + 1u == (gen + 1u) * nloc) {
            __builtin_amdgcn_fence(__ATOMIC_RELEASE, "agent");
            asm volatile("s_waitcnt vmcnt(0)" ::: "memory");
            const unsigned og = xb_add(&bar[XB_TOP], 1u);
            const unsigned tg = og / nx;
            if (og + 1u == (tg + 1u) * nx) xb_add(&bar[XB_TOPGEN], 1u);
            else XB_SPIN(xb_ld(&bar[XB_TOPGEN]) == tg, bar);
            __builtin_amdgcn_fence(__ATOMIC_ACQUIRE, "agent");
            xb_add(&bar[XB_XGEN(b.x)], 1u);
            asm volatile("s_waitcnt vmcnt(0)" ::: "memory");
        } else {
            XB_SPIN(xb_ld(&bar[XB_XGEN(b.x)]) == gen, bar);
            __builtin_amdgcn_fence(__ATOMIC_ACQUIRE, "agent");
            asm volatile("s_waitcnt vmcnt(0)" ::: "memory");
        }
    }
    __syncthreads();
}


#include <hip/hip_cooperative_groups.h>
namespace cg = cooperative_groups;
constexpr int NWAVES = 8, NTHREADS = 512, LDS_BYTES = 147456, RING_BYTES = 131072;
constexpr size_t MiB = 1u << 20;
constexpr size_t WS_MOD = 1 * MiB;
constexpr size_t WS_TABA = WS_MOD + 128 * 1024;
constexpr size_t WS_TABB = WS_TABA + 32 * 1024;
constexpr size_t WS_WIN0 = 2 * MiB;
constexpr size_t WS_WOUT0 = 7 * MiB;
constexpr size_t WS_WIN1 = 9 * MiB;
constexpr size_t WS_WKVB = 13 * MiB;
constexpr size_t WS_WQB = 14 * MiB;
constexpr size_t WS_WOUT1 = 16 * MiB;
constexpr size_t WS_X1C = 18 * MiB;
constexpr size_t WS_H = 20 * MiB;
constexpr size_t WS_Q = 53 * MiB;
constexpr size_t WS_K = 86 * MiB;
constexpr size_t WS_V0 = 95 * MiB;
constexpr size_t WS_G = 120 * MiB;
constexpr size_t WS_V1 = 153 * MiB;
constexpr size_t WS_KVA = 186 * MiB;
constexpr size_t WS_QA = 195 * MiB;
constexpr size_t WS_Q1R = 207 * MiB;
constexpr size_t WS_KR = 223 * MiB;
constexpr size_t WS_SSKV = 225 * MiB;
constexpr size_t WS_SSQ = 226 * MiB;
constexpr size_t WS_SSH = 227 * MiB;
constexpr size_t WS_END = 256 * MiB;
static_assert(WS_K + (size_t)NB * TK * DM * 2 <= WS_G && WS_G + (size_t)MT * DM * 2 <= WS_V1 && WS_V1 + (size_t)NB * TK * DM * 2 <= WS_KVA && WS_SSH + (size_t)ML * 32 * 4 <= WS_END, "ws map");

struct Args { const float* in[23]; float* out; unsigned char* ws; int ph_lo, ph_hi, coop, pad; };

DEVI void phase0(const Args& a, unsigned char* ws, LAS unsigned char* lds, int vb, int G) {
    const int tid = threadIdx.x, wave = tid >> 6, lane = tid & 63;
    float* mod = (float*)(ws + WS_MOD);
    if (vb < 96) {
        LAS float* sc = (LAS float*)lds; LAS float* red = sc + 3 * 1024;
        const int layer = vb / 48, cs = vb % 48; const float* w = a.in[layer ? 11 : 4]; const float* bb = a.in[layer ? 12 : 5];
        for (int i = tid; i < 3072; i += NTHREADS) { const int r = i >> 10, k = i & 1023; const float v = r < 2 ? a.in[1][r * 1024 + k] : a.in[3][k]; sc[i] = v / (1.f + expf(-v)); }
        __syncthreads();
        const int col = cs * 64 + lane; float a0 = 0.f, a1 = 0.f, a2 = 0.f;
#pragma unroll 8
        for (int k = wave * 128; k < wave * 128 + 128; ++k) { const float wv = w[(size_t)k * 3072 + col]; a0 += sc[k] * wv; a1 += sc[1024 + k] * wv; a2 += sc[2048 + k] * wv; }
        red[(wave * 3 + 0) * 64 + lane] = a0; red[(wave * 3 + 1) * 64 + lane] = a1; red[(wave * 3 + 2) * 64 + lane] = a2;
        __syncthreads();
        if (tid < 192) { const int r = tid >> 6; float s = 0.f;
#pragma unroll
            for (int q = 0; q < 8; ++q) s += red[(q * 3 + r) * 64 + lane];
            mod[(size_t)(layer * 3 + r) * 3072 + col] = s + bb[col]; }
        __syncthreads();
    } else if (vb == 96) {
        f32x2* tabA = (f32x2*)(ws + WS_TABA); f32x2* tabB = (f32x2*)(ws + WS_TABB);
        for (int i = tid; i < 128 * 24; i += NTHREADS) {
            if (i < 128 * 16) { const int pos = i >> 4, f = i & 15; const float invf = powf(10000.f, -(float)f / 16.f); float cs_, sn_; sincos_pos((float)pos * invf, cs_, sn_); tabA[i] = (f32x2){cs_, sn_}; }
            else { const int j = i - 128 * 16, pos = j >> 3, f = j & 7; const float invf = powf(10000.f, -(float)f / 8.f); float cs_, sn_; sincos_pos((float)pos * invf, cs_, sn_); tabB[j] = (f32x2){cs_, sn_}; } }
    }
    struct WD { int src, K, Nsrc, Np, mode, ks; size_t dst; };
    const WD wd[6] = {{7, 1024, N_IN0, 2560, 1, -1, WS_WIN0}, {10, 1024, 1024, 1024, 0, -1, WS_WOUT0}, {14, 1024, N_IN1, N_IN1P, 2, -1, WS_WIN1},
                      {16, 256, 2048, 2048, 3, 15, WS_WKVB}, {18, 384, 1536, 2048, 4, 17, WS_WQB}, {22, 1024, 1024, 1024, 0, -1, WS_WOUT1}};
#pragma unroll
    for (int m = 0; m < 6; ++m) {
        const float* W = a.in[wd[m].src]; const float* ks = wd[m].ks >= 0 ? a.in[wd[m].ks] : nullptr; bf16_t* Bt = (bf16_t*)(ws + wd[m].dst);
        const int K = wd[m].K, Nsrc = wd[m].Nsrc, Np = wd[m].Np, total = Np * (K / 8);
        for (int i = vb * NTHREADS + tid; i < total; i += G * NTHREADS) {
            const int p = i % Np, k8 = i / Np; int cc = pg8::wmap(wd[m].mode, p); if (cc >= Nsrc) cc = -1;
            float v[8];
#pragma unroll
            for (int j = 0; j < 8; ++j) { const int k = k8 * 8 + j; v[j] = cc >= 0 ? W[(size_t)k * Nsrc + cc] * (ks ? ks[k] : 1.f) : 0.f; }
            u32x4 o; o.x = pk2(v[0], v[1]); o.y = pk2(v[2], v[3]); o.z = pk2(v[4], v[5]); o.w = pk2(v[6], v[7]);
            *(u32x4*)(Bt + (size_t)p * K + k8 * 8) = o;
        }
    }
}

DEVI void phase_prep(const float* xa, const float* xb, const float* nw, const float* mod, bf16_t* H, int gw, int NGW, int lane) {
    for (int row = gw; row < MT; row += NGW) {
        const int r = row < SEQ ? 0 : (row < ML ? 1 : 2);
        const float* src = row < ML ? xa + (size_t)row * DM : xb + (size_t)(row - ML) * DM;
        f32x4 v[4]; float ss = 0.f;
#pragma unroll
        for (int j = 0; j < 4; ++j) { v[j] = *(const f32x4*)(src + 4 * lane + 256 * j); ss += (v[j].x * v[j].x + v[j].y * v[j].y) + (v[j].z * v[j].z + v[j].w * v[j].w); }
        const float rinv = rsqrtf(wave_sum(ss) * (1.f / DM) + EPS);
#pragma unroll
        for (int j = 0; j < 4; ++j) { const int cidx = 4 * lane + 256 * j; const f32x4 w = *(const f32x4*)(nw + cidx);
            const f32x4 sh = *(const f32x4*)(mod + (size_t)r * 3072 + cidx), scl = *(const f32x4*)(mod + (size_t)r * 3072 + 1024 + cidx);
            const f32x4 h = (v[j] * rinv) * w * (scl + 1.f) + sh;
            u32x2 o; o.x = pk2(h.x, h.y); o.y = pk2(h.z, h.w); *(u32x2*)(H + (size_t)row * DM + cidx) = o; }
    }
}

__global__ void __launch_bounds__(NTHREADS, 2) mega(Args a) {
    extern __shared__ __attribute__((aligned(16))) unsigned char lds[];
    const int tid = threadIdx.x, lane = tid & 63; const int wave = __builtin_amdgcn_readfirstlane(tid >> 6);
    const int G = gridDim.x, bx = blockIdx.x; const int vcu = (G % 8 == 0) ? (bx % 8) * (G / 8) + bx / 8 : bx;
    unsigned char* ws = a.ws; float* out = a.out;
    const float* x = a.in[0]; const float* ctx = a.in[2];
    float* mod = (float*)(ws + WS_MOD); const f32x4* tabA = (const f32x4*)(ws + WS_TABA); const f32x4* tabB = (const f32x4*)(ws + WS_TABB);
    bf16_t* H = (bf16_t*)(ws + WS_H); bf16_t* Qb = (bf16_t*)(ws + WS_Q); bf16_t* K0 = (bf16_t*)(ws + WS_K); bf16_t* V0 = (bf16_t*)(ws + WS_V0); bf16_t* K1 = (bf16_t*)(ws + WS_K);
    bf16_t* Gb = (bf16_t*)(ws + WS_G); bf16_t* V1 = (bf16_t*)(ws + WS_V1); bf16_t* KVA = (bf16_t*)(ws + WS_KVA); bf16_t* QA = (bf16_t*)(ws + WS_QA); bf16_t* Q1R = (bf16_t*)(ws + WS_Q1R);
    bf16_t* O0 = (bf16_t*)(ws + WS_V1); bf16_t* O1 = (bf16_t*)(ws + WS_H); bf16_t* KR = (bf16_t*)(ws + WS_KR); float* SSKV = (float*)(ws + WS_SSKV); float* SSQ = (float*)(ws + WS_SSQ); float* SSH = (float*)(ws + WS_SSH); float* X1c = (float*)(ws + WS_X1C);
    const int lo = a.ph_lo, hi_ = a.ph_hi;
#ifndef ONLY_PHASE
#define ONLY_PHASE -1
#endif
#define IN(k) ((ONLY_PHASE < 0 || ONLY_PHASE == (k)) && lo <= (k) && (k) < hi_)
#ifndef MK_REP_MASK
#define MK_REP_MASK 0
#endif
#define REPS(k) (((MK_REP_MASK >> (k)) & 1) ? 2 : 1)
#define SEAM(k) do { if (IN(k) && IN((k) + 1)) { xcd_barrier(xbar); } } while (0)
    PG8_LAS unsigned char* ring = (PG8_LAS unsigned char*)lds;
    volatile LAS unsigned* xst = (volatile LAS unsigned*)((LAS unsigned char*)lds + RING_BYTES + 512);
    if (tid < 4) xst[tid] = 0u;
    __syncthreads();
    XcdBarrier xbar; xbar.bar = (unsigned*)ws; xbar.x = 0; xbar.st = xst;
    if (a.coop) xbar = xcd_barrier_post((unsigned*)ws, xst);
    if (a.coop == 0x7fffffff) cg::this_grid().sync();

    if (IN(0)) for (int rep_ = 0; rep_ < REPS(0); ++rep_) { phase0(a, ws, (LAS unsigned char*)lds, bx, G); } SEAM(0);
    if (IN(1)) for (int rep_ = 0; rep_ < REPS(1); ++rep_) { phase_prep(x, ctx, a.in[6], mod, H, vcu * NWAVES + wave, G * NWAVES, lane); } SEAM(1);
    if (IN(2)) { pg8::Gemm g{H, (const bf16_t*)(ws + WS_WIN0), MT, N_IN0, 1024}; pg8::ROrder S; S.init(0, MT / 256, N_IN0, G, bx, REPS(2));
        pg8::EpiIn0 E{a.in[8], a.in[9], tabA, K0, V0, Qb, Gb};
        pg8::gemm_phase<pg8::EpiIn0, pg8::ROrder, true, true>(ring, g, S, E); } SEAM(2);
    if (IN(3)) for (int rep_ = 0; rep_ < REPS(3); ++rep_) {
        const int xg = vcu >> 5, c = vcu & 31, b = xg >> 2, kvh = xg & 3; const size_t kbase = (size_t)b * TK * 256 + kvh * 64;
        for (int i = 0; i < 4; ++i) { const int h = kvh * 4 + i; const size_t q0 = ((size_t)b * SEQ + c * 256) * DM + h * 64;
            afast::attn_unit<0>(Qb + q0, DM, nullptr, nullptr, K0 + kbase, 256, nullptr, V0 + kbase, 256, TK / 64, O0 + q0, Gb + q0, DM, (char*)lds); }
        if (c < 4) { const int h = kvh * 4 + c; const size_t q0 = ((size_t)ML + b * CTXL) * DM + h * 64;
            afast::attn_unit<0>(Qb + q0, DM, nullptr, nullptr, K0 + kbase, 256, nullptr, V0 + kbase, 256, CTXL / 64, O0 + q0, Gb + q0, DM, (char*)lds); }
    } SEAM(3);
    if (IN(4)) { pg8::Gemm g{O0, (const bf16_t*)(ws + WS_WOUT0), MT, 1024, 1024}; pg8::ROrder S; S.init(0, MT / 256, 1024, G, bx, REPS(4));
        pg8::EpiOut E{x, ctx, out, X1c, mod + 2048};
        pg8::gemm_phase<pg8::EpiOut, pg8::ROrder, true, true>(ring, g, S, E); } SEAM(4);
    if (IN(5)) for (int rep_ = 0; rep_ < REPS(5); ++rep_) { phase_prep(out, X1c, a.in[13], mod + 3 * 3072, H, vcu * NWAVES + wave, G * NWAVES, lane); } SEAM(5);
    if (IN(6)) { pg8::Gemm g{H, (const bf16_t*)(ws + WS_WIN1), MT, N_IN1P, 1024}; pg8::In1Order S; S.init(G, bx);
        pg8::EpiIn1 E{a.in[21], tabB, KVA, SSKV, QA, SSQ, KR, Gb};
        pg8::gemm_phase<pg8::EpiIn1, pg8::In1Order, true, true>(ring, g, S, E); } SEAM(6);
    if (IN(7)) {
        { pg8::Gemm g{KVA, (const bf16_t*)(ws + WS_WKVB), MT, 2048, 256}; pg8::ROrder S; S.init(0, MT / 256, 2048, G, bx, REPS(7));
          pg8::EpiKvb E{SSKV, a.in[20], K1, V1};
          pg8::gemm_phase<pg8::EpiKvb, pg8::ROrder, true, true>(ring, g, S, E); }
        { pg8::Gemm g{QA, (const bf16_t*)(ws + WS_WQB), ML, 2048, 384}; pg8::ROrder S; S.init(0, ML / 256, 2048, G, bx, REPS(7));
          pg8::EpiQb E{SSQ, a.in[19], tabB, Qb, Q1R, SSH};
          pg8::gemm_phase<pg8::EpiQb, pg8::ROrder, true, true>(ring, g, S, E); }
    } SEAM(7);
    if (IN(8)) for (int rep_ = 0; rep_ < REPS(8); ++rep_) {
        const int xg = vcu >> 5, c = vcu & 31;
        for (int i = 0; i < 4; ++i) { const int s = xg + 8 * i, b = s >> 4, h = s & 15; const size_t row0 = (size_t)b * SEQ + c * 256, q0 = row0 * DM + h * 64;
            afast::attn_unit<1>(Qb + q0, DM, Q1R + row0 * 512 + h * 32, SSH + (row0 * 16 + h) * 2, K1 + (size_t)b * TK * DM + h * 64, DM, KR + (size_t)b * TK * 32,
                                V1 + (size_t)b * TK * DM + h * 64, DM, TK / 64, O1 + q0, Gb + q0, DM, (char*)lds); }
    } SEAM(8);
    if (IN(9)) { pg8::Gemm g{O1, (const bf16_t*)(ws + WS_WOUT1), ML, 1024, 1024}; pg8::ROrder S; S.init(0, ML / 256, 1024, G, bx);
        pg8::EpiOut E{out, nullptr, out, nullptr, mod + 3 * 3072 + 2048};
        pg8::gemm_phase<pg8::EpiOut, pg8::ROrder, true, true>(ring, g, S, E); }
#undef IN
#undef SEAM
}

constexpr int NPHASE = 10;
#ifndef MK_ONE_LAUNCH
#define MK_ONE_LAUNCH 1
#endif
extern "C" void kernel_launch(void* const* d_in, const int* in_sizes, int n_in, void* d_out, int out_size, void* d_ws, size_t ws_size, hipStream_t stream) {
    static int grid = 0;
    if (grid == 0) {
        if (n_in != 23 || out_size != ML * DM || ws_size < WS_END) { fprintf(stderr, "kernel_launch: unexpected shapes n_in %d out %d ws %zu\n", n_in, out_size, ws_size); grid = -1; return; }
        int dev = 0, cus = 0, per_cu = 0;
        if (hipGetDevice(&dev) != hipSuccess || hipDeviceGetAttribute(&cus, hipDeviceAttributeMultiprocessorCount, dev) != hipSuccess) { grid = -1; return; }
        if (hipFuncSetAttribute((const void*)mega, hipFuncAttributeMaxDynamicSharedMemorySize, LDS_BYTES) != hipSuccess) { fprintf(stderr, "kernel_launch: hipFuncSetAttribute failed\n"); grid = -1; return; }
        if (hipOccupancyMaxActiveBlocksPerMultiprocessor(&per_cu, (const void*)mega, NTHREADS, LDS_BYTES) != hipSuccess || per_cu < 1) { fprintf(stderr, "kernel_launch: occupancy query says %d\n", per_cu); grid = -1; return; }
        grid = cus;
        if (grid != 256) fprintf(stderr, "kernel_launch: %d CUs (built for 256)\n", grid);
    }
    if (grid < 0) return;
    if (hipMemsetAsync(d_ws, 0, 16384, stream) != hipSuccess) { fprintf(stderr, "kernel_launch: memset failed\n"); return; }
    Args a{};
    for (int i = 0; i < 23; ++i) a.in[i] = (const float*)d_in[i];
    a.out = (float*)d_out; a.ws = (unsigned char*)d_ws;
#if MK_ONE_LAUNCH
    a.ph_lo = 0; a.ph_hi = NPHASE; a.coop = 1;
    void* args[] = {&a};
    const hipError_t e = hipLaunchCooperativeKernel((const void*)mega, dim3(grid), dim3(NTHREADS), args, LDS_BYTES, stream);
    if (e != hipSuccess) fprintf(stderr, "kernel_launch: cooperative launch failed: %s (grid %d)\n", hipGetErrorString(e), grid);
#else
    for (int p = 0; p < NPHASE; ++p) { a.ph_lo = p; a.ph_hi = p + 1; a.coop = 0; hipLaunchKernelGGL(mega, dim3(grid), dim3(NTHREADS), LDS_BYTES, stream, a); }
    const hipError_t le = hipPeekAtLastError();
    if (le != hipSuccess) fprintf(stderr, "kernel_launch: launch failed: %s\n", hipGetErrorName(le));
#endif
}
```

```cpp
#include <hip/hip_runtime.h>
#include <hip/hip_bf16.h>
#include <cstdio>
#include <cstdint>

#define DEVI __device__ __forceinline__
#define LAS __attribute__((address_space(3)))
#define GAS __attribute__((address_space(1)))

constexpr int NB = 2, SEQ = 8192, DM = 1024, CTXL = 256, TK = SEQ + CTXL;
constexpr int ML = NB * SEQ, MC = NB * CTXL, MT = ML + MC;
constexpr int GRIDW = 64;
constexpr float EPS = 1e-6f;
constexpr float LOG2E = 1.4426950408889634f;
constexpr int N_IN0 = 2560, N_IN1 = 1696, N_IN1P = 1792;
constexpr float C2_GQA = 0.125f * LOG2E;
constexpr float C2_MLA = 0.10206207261596575f * LOG2E;

typedef unsigned short bf16_t;
typedef short bf16x8 __attribute__((ext_vector_type(8)));
typedef short s16x4 __attribute__((ext_vector_type(4)));
typedef float f32x4 __attribute__((ext_vector_type(4)));
typedef float f32x2 __attribute__((ext_vector_type(2)));
typedef float f32x16 __attribute__((ext_vector_type(16)));
typedef unsigned u32x4 __attribute__((ext_vector_type(4)));
typedef unsigned u32x2 __attribute__((ext_vector_type(2)));

DEVI float bf2f(bf16_t v) { return __uint_as_float((unsigned)v << 16); }
DEVI unsigned f2bf(float f) { unsigned u = __float_as_uint(f); return (u + 0x7fffu + ((u >> 16) & 1u)) >> 16; }
DEVI unsigned pk2(float lo, float hi) { return f2bf(lo) | (f2bf(hi) << 16); }
DEVI float wave_sum(float v) {
#pragma unroll
    for (int o = 1; o < 64; o <<= 1) v += __shfl_xor(v, o);
    return v;
}
DEVI float silu_f(float v) { return v / (1.f + __expf(-v)); }
namespace pg8 {
#define PG8_LAS __attribute__((address_space(3)))
typedef unsigned short bf16_t;
typedef short bf16x8 __attribute__((ext_vector_type(8)));
typedef float f32x4 __attribute__((ext_vector_type(4)));
typedef unsigned u32x4 __attribute__((ext_vector_type(4)));
constexpr int BM = 256, BK = 64, HALF = 128, HTB = HALF * BK * 2  , STAGE_BYTES = 8 * HTB, NXCD = 8, WGM = 8;

__host__ __device__ __forceinline__ int lds_byte(int r, int c) { const int st = (r >> 4) * 2 + (c >> 5), rr = r & 15, cc = c & 31, ob = rr * 64 + cc * 2; return st * 1024 + (ob ^ (((ob >> 9) & 1) << 5)); }
__host__ __device__ __forceinline__ void stage_rc(int b, int& R, int& C) { const int st = b / 1024, sb = b % 1024, swz = sb ^ (((sb >> 9) & 1) << 5); R = (st >> 1) * 16 + swz / 64; C = (st & 1) * 32 + (swz % 64) / 2; }
__host__ __device__ __forceinline__ int perm32(int rho) { const int n = rho >> 4, i = rho & 15; return 8 * (i >> 2) + 4 * n + (i & 3); }

struct Unit { int pm, pn, ko; };
struct Gemm { const bf16_t* A; const bf16_t* Bt; int M, N, K, Kloop; };

struct StaticOrder {
    int nM, nN, nwg, G, c;
    __host__ __device__ void init(int M, int N, int G_, int c_) { nM = M / BM; nN = N / BM; nwg = nM * nN; G = G_; c = c_; }
    __host__ __device__ bool next(int i, Unit& u) const {
        const long L = (long)i * G + c; if (L >= nwg) return false;
        int wgid = (int)L; { const int q = nwg / NXCD, r = nwg % NXCD, xcd = wgid % NXCD, off = wgid / NXCD; wgid = (xcd < r ? xcd * (q + 1) : r * (q + 1) + (xcd - r) * q) + off; }
        const int nig = WGM * nN, gid = wgid / nig, fm = gid * WGM, gsz = (nM - fm) < WGM ? (nM - fm) : WGM;
        u.pm = fm + ((wgid % nig) % gsz); u.pn = (wgid % nig) / gsz; u.ko = 0; return true;
    }
    __device__ __forceinline__ void a_ready(const Unit&) const {}
    __device__ __forceinline__ void done(const Unit&) const {}
};


struct ROrder {
    int pm0, nM, nN, nwg, G, c, rep;
    __host__ __device__ void init(int pm0_, int npm, int N, int G_, int c_, int rep_ = 1) { pm0 = pm0_; nM = npm; nN = N / BM; nwg = nM * nN; G = G_; c = c_; rep = rep_; }
    __host__ __device__ bool next(int i, Unit& u) const {
        const long L = (long)i * G + c; if (L >= (long)nwg * rep) return false;
        int wgid = (int)(L % nwg); { const int q = nwg / NXCD, r = nwg % NXCD, xcd = wgid % NXCD, off = wgid / NXCD; wgid = (xcd < r ? xcd * (q + 1) : r * (q + 1) + (xcd - r) * q) + off; }
        const int nig = WGM * nN, gid = wgid / nig, fm = gid * WGM, gsz = (nM - fm) < WGM ? (nM - fm) : WGM;
        u.pm = pm0 + fm + ((wgid % nig) % gsz); u.pn = (wgid % nig) / gsz; u.ko = 0; return true;
    }
    __device__ __forceinline__ void a_ready(const Unit&) const {}
    __device__ __forceinline__ void done(const Unit&) const {}
};

struct EpiF32 {
    static constexpr bool PERM = true, AFTER_DRAIN = false;
    float* O; int ldc; int pmbase;
    __device__ __forceinline__ void operator()(const f32x4 (&acc)[2][2][4][2], const Unit& u, int wr, int wc, int fr, int fq) const {
        const int row0 = (u.pm - pmbase) * BM + wr * 64 + fr, col0 = u.pn * BM + wc * 32 + 8 * fq;
#pragma unroll
        for (int ai = 0; ai < 2; ++ai)
#pragma unroll
            for (int m = 0; m < 4; ++m) { float* rowp = O + (size_t)(row0 + ai * HALF + m * 16) * ldc + col0;
#pragma unroll
                for (int bj = 0; bj < 2; ++bj) { *(f32x4*)(rowp + bj * HALF) = acc[ai][bj][m][0]; *(f32x4*)(rowp + bj * HALF + 4) = acc[ai][bj][m][1]; } }
    }
};

DEVI unsigned cvt_pk_bf16(float lo, float hi) { unsigned r; asm volatile("v_cvt_pk_bf16_f32 %0, %1, %2" : "=v"(r) : "v"(lo), "v"(hi)); return r; }
DEVI u32x4 pack8(const f32x4 a, const f32x4 b) { u32x4 w; w.x = cvt_pk_bf16(a[0], a[1]); w.y = cvt_pk_bf16(a[2], a[3]); w.z = cvt_pk_bf16(b[0], b[1]); w.w = cvt_pk_bf16(b[2], b[3]); return w; }
DEVI u32x2 pack8_fp8(const f32x4 a, const f32x4 b) { int w0 = 0, w1 = 0; w0 = __builtin_amdgcn_cvt_pk_fp8_f32(a[0], a[1], w0, false); w0 = __builtin_amdgcn_cvt_pk_fp8_f32(a[2], a[3], w0, true);
    w1 = __builtin_amdgcn_cvt_pk_fp8_f32(b[0], b[1], w1, false); w1 = __builtin_amdgcn_cvt_pk_fp8_f32(b[2], b[3], w1, true); return (u32x2){(unsigned)w0, (unsigned)w1}; }
DEVI unsigned pack8_fp4(const f32x4 a, const f32x4 b) { unsigned w; asm volatile("" : "=v"(w)); w = __builtin_amdgcn_cvt_scalef32_pk_fp4_f32(w, a[0], a[1], 1.0f, 0); w = __builtin_amdgcn_cvt_scalef32_pk_fp4_f32(w, a[2], a[3], 1.0f, 1);
    w = __builtin_amdgcn_cvt_scalef32_pk_fp4_f32(w, b[0], b[1], 1.0f, 2); w = __builtin_amdgcn_cvt_scalef32_pk_fp4_f32(w, b[2], b[3], 1.0f, 3); return w; }
DEVI float quad_sum(float s) { s += __shfl_xor(s, 16); s += __shfl_xor(s, 32); return s; }
DEVI float sq4(const f32x4 v) { return (v[0] * v[0] + v[1] * v[1]) + (v[2] * v[2] + v[3] * v[3]); }
DEVI f32x4 silu4(const f32x4 v) { f32x4 o; o[0] = silu_f(v[0]); o[1] = silu_f(v[1]); o[2] = silu_f(v[2]); o[3] = silu_f(v[3]); return o; }
DEVI int key_slot(int R) { return R < ML ? (R >> 13) * TK + CTXL + (R & (SEQ - 1)) : ((R - ML) >> 8) * TK + ((R - ML) & 255); }
DEVI void rot4(f32x4& x1, f32x4& x2, const f32x4 cs01, const f32x4 cs23) {
    const f32x4 c = {cs01[0], cs01[2], cs23[0], cs23[2]}, s = {cs01[1], cs01[3], cs23[1], cs23[3]};
    const f32x4 a = x1 * c - x2 * s, b = x2 * c + x1 * s; x1 = a; x2 = b;
}

DEVI int drope32(int i) { const int fq = i >> 3, n = (i >> 2) & 1, j = i & 3; return 16 * (fq >> 1) + 8 * n + 4 * (fq & 1) + j; }
DEVI int wmap(int mode, int p) {
    const int pn = p >> 8, q = p & 255, bj = q >> 7, wc = (q >> 5) & 3, i = q & 31;
    switch (mode) {
    case 1: {
        if (pn == 0 || (pn >= 2 && pn <= 5)) { const int fq = i >> 3, n = (i >> 2) & 1, j = i & 3; return 256 * pn + 64 * wc + 32 * bj + 16 * n + 4 * fq + j; }
        return p; }
    case 2: {
        if (pn == 0) return q;
        if (pn == 1) return 288 + q;
        if (pn == 2) { if (wc < 2) return 288 + 256 + 64 * wc + 32 * bj + i; if (wc == 2 && bj == 0) return 256 + drope32(i); return -1; }
        return 672 + 256 * (pn - 3) + q; }
    case 3: { const int head = 2 * pn + (wc >> 1), type = wc & 1; return 128 * head + 64 * type + 32 * bj + i; }
    case 4: { const int head = 2 * pn + (wc >> 1), type = wc & 1; if (type == 0) return 96 * head + 32 * bj + i; return bj == 0 ? 96 * head + 64 + drope32(i) : -1; }
    default: return p;
    }
}

template <bool F8> struct EpiIn0 {
    static constexpr bool PERM = true, AFTER_DRAIN = false;
    const float* qn; const float* kn; const f32x4* tabA; bf16_t* K0; bf16_t* V0; bf16_t* Q0; bf16_t* G0;
    __device__ __forceinline__ void operator()(const f32x4 (&acc)[2][2][4][2], const Unit& u, int wr, int wc, int fr_, int fq_) const {
        int fr = fr_, fq = fq_; asm volatile("" : "+v"(fr), "+v"(fq));
        const int pn = u.pn; const bool lat = u.pm < ML / BM;
        if (pn == 0 || (pn >= 2 && pn <= 5)) {
            const float* wsrc = pn == 0 ? kn : qn; const float outs = pn == 0 ? (F8 ? 2.f : 1.f) : (F8 ? C2_GQA * 8.f : C2_GQA);
            f32x4 wv[2][2];
#pragma unroll
            for (int bj = 0; bj < 2; ++bj)
#pragma unroll
                for (int n = 0; n < 2; ++n) wv[bj][n] = *(const f32x4*)(wsrc + 32 * bj + 16 * n + 4 * fq) * outs;
#pragma unroll
            for (int ai = 0; ai < 2; ++ai)
#pragma unroll
                for (int m = 0; m < 4; ++m) {
                    const int R = u.pm * BM + ai * HALF + wr * 64 + m * 16 + fr;
                    f32x4 x[2][2]; float ss = 0.f;
#pragma unroll
                    for (int bj = 0; bj < 2; ++bj)
#pragma unroll
                        for (int n = 0; n < 2; ++n) { x[bj][n] = acc[ai][bj][m][n]; ss += sq4(x[bj][n]); }
                    const float rinv = rsqrtf(quad_sum(ss) * (1.f / 64.f) + EPS);
#pragma unroll
                    for (int bj = 0; bj < 2; ++bj)
#pragma unroll
                        for (int n = 0; n < 2; ++n) x[bj][n] = x[bj][n] * rinv * wv[bj][n];
                    if (lat) { const int t = R & (SEQ - 1), trow = t >> 6, tcol = t & 63;
                        const f32x4* tr = tabA + (trow * 16 + 4 * fq) / 2; const f32x4* tc = tabA + (tcol * 16 + 4 * fq) / 2;
                        rot4(x[0][0], x[0][1], tr[0], tr[1]); rot4(x[1][0], x[1][1], tc[0], tc[1]); }
                    if (F8 && pn == 0) { unsigned char* dst = (unsigned char*)K0 + (size_t)key_slot(R) * 128 + wc * 32 + 4 * fq;
                        *(unsigned*)dst = pack8_fp4(x[0][0], x[0][1]); *(unsigned*)(dst + 16) = pack8_fp4(x[1][0], x[1][1]); }
                    else if (pn == 0) { bf16_t* dst = K0 + (size_t)key_slot(R) * 256 + wc * 64 + 8 * fq;
                        *(u32x4*)dst = pack8(x[0][0], x[0][1]); *(u32x4*)(dst + 32) = pack8(x[1][0], x[1][1]); }
                    else { bf16_t* dst = Q0 + (size_t)R * DM + ((pn - 2) * 4 + wc) * 64 + 8 * fq;
                        *(u32x4*)dst = pack8(x[0][0], x[0][1]); *(u32x4*)(dst + 32) = pack8(x[1][0], x[1][1]); }
                }
        } else if (pn == 1) {
#pragma unroll
            for (int ai = 0; ai < 2; ++ai)
#pragma unroll
                for (int m = 0; m < 4; ++m) { const int R = u.pm * BM + ai * HALF + wr * 64 + m * 16 + fr;
                    if (F8) { unsigned char* dst = (unsigned char*)V0 + (size_t)key_slot(R) * 256 + wc * 32 + 8 * fq;
#pragma unroll
                        for (int bj = 0; bj < 2; ++bj) *(u32x2*)(dst + bj * HALF) = pack8_fp8(acc[ai][bj][m][0], acc[ai][bj][m][1]); }
                    else { bf16_t* dst = V0 + (size_t)key_slot(R) * 256 + wc * 32 + 8 * fq;
#pragma unroll
                        for (int bj = 0; bj < 2; ++bj) *(u32x4*)(dst + bj * HALF) = pack8(acc[ai][bj][m][0], acc[ai][bj][m][1]); } }
        } else {
#pragma unroll
            for (int ai = 0; ai < 2; ++ai)
#pragma unroll
                for (int m = 0; m < 4; ++m) { const int R = u.pm * BM + ai * HALF + wr * 64 + m * 16 + fr; bf16_t* dst = G0 + (size_t)R * DM + (pn - 6) * BM + wc * 32 + 8 * fq;
#pragma unroll
                    for (int bj = 0; bj < 2; ++bj) *(u32x4*)(dst + bj * HALF) = pack8(silu4(acc[ai][bj][m][0]), silu4(acc[ai][bj][m][1])); }
        }
    }
};

struct EpiOut {
    static constexpr bool PERM = true, AFTER_DRAIN = false;
    const float* baseL; const float* baseC; float* dstL; float* dstC; const float* gate;
    __device__ __forceinline__ void operator()(const f32x4 (&acc)[2][2][4][2], const Unit& u, int wr, int wc, int fr_, int fq_) const {
        int fr = fr_, fq = fq_; asm volatile("" : "+v"(fr), "+v"(fq));
        const int col0 = u.pn * BM + wc * 32 + 8 * fq;
#pragma unroll
        for (int ai = 0; ai < 2; ++ai)
#pragma unroll
            for (int m = 0; m < 4; ++m) { const int R = u.pm * BM + ai * HALF + wr * 64 + m * 16 + fr; const int r = R < SEQ ? 0 : (R < ML ? 1 : 2);
                const float* b = R < ML ? baseL + (size_t)R * DM : baseC + (size_t)(R - ML) * DM; float* d = R < ML ? dstL + (size_t)R * DM : dstC + (size_t)(R - ML) * DM;
                const float* g = gate + (size_t)r * 3072;
#pragma unroll
                for (int bj = 0; bj < 2; ++bj)
#pragma unroll
                    for (int n = 0; n < 2; ++n) { const int c = col0 + bj * HALF + 4 * n; *(f32x4*)(d + c) = *(const f32x4*)(b + c) + *(const f32x4*)(g + c) * acc[ai][bj][m][n]; } }
    }
};

struct EpiOutF {
    static constexpr bool PERM = true, AFTER_DRAIN = false;
    const float* base; float* dst; const float* gate; const float* nwm; bf16_t* Hn; float* SSX;
    __device__ __forceinline__ void operator()(const f32x4 (&acc)[2][2][4][2], const Unit& u, int wr, int wc, int fr_, int fq_) const {
        int fr = fr_, fq = fq_; asm volatile("" : "+v"(fr), "+v"(fq));
        const int col0 = u.pn * BM + wc * 32 + 8 * fq;
#pragma unroll
        for (int ai = 0; ai < 2; ++ai)
#pragma unroll
            for (int m = 0; m < 4; ++m) { const int R = u.pm * BM + ai * HALF + wr * 64 + m * 16 + fr; const int r = R < SEQ ? 0 : 1;
                asm volatile("" ::: "memory");
                const float* b = base + (size_t)R * DM; float* d = dst + (size_t)R * DM; const float* g = gate + (size_t)r * 3072; const float* nw = nwm + (size_t)r * 1024; float ss = 0.f;
#pragma unroll
                for (int bj = 0; bj < 2; ++bj) { const int c = col0 + bj * HALF;
                    const f32x4 x0 = *(const f32x4*)(b + c) + *(const f32x4*)(g + c) * acc[ai][bj][m][0], x1 = *(const f32x4*)(b + c + 4) + *(const f32x4*)(g + c + 4) * acc[ai][bj][m][1];
                    *(f32x4*)(d + c) = x0; *(f32x4*)(d + c + 4) = x1; ss += sq4(x0) + sq4(x1);
                    *(u32x4*)(Hn + (size_t)R * DM + c) = pack8(x0 * *(const f32x4*)(nw + c), x1 * *(const f32x4*)(nw + c + 4)); }
                ss = quad_sum(ss); if (fq == 0) SSX[(size_t)R * 16 + u.pn * 4 + wc] = ss; }
    }
};
struct EpiOutSlab {
    static constexpr bool PERM = true, AFTER_DRAIN = false;
    float* slab; int klen;
    __device__ __forceinline__ void operator()(const f32x4 (&acc)[2][2][4][2], const Unit& u, int wr, int wc, int fr_, int fq_) const {
        int fr = fr_, fq = fq_; asm volatile("" : "+v"(fr), "+v"(fq));
        const int col0 = u.pn * BM + wc * 32 + 8 * fq; float* sb = slab + (size_t)(u.ko / klen) * MC * DM;
#pragma unroll
        for (int ai = 0; ai < 2; ++ai)
#pragma unroll
            for (int m = 0; m < 4; ++m) { const int R = u.pm * BM + ai * HALF + wr * 64 + m * 16 + fr; float* d = sb + (size_t)(R - ML) * DM + col0;
#pragma unroll
                for (int bj = 0; bj < 2; ++bj) { *(f32x4*)(d + bj * HALF) = acc[ai][bj][m][0]; *(f32x4*)(d + bj * HALF + 4) = acc[ai][bj][m][1]; } }
    }
};
struct CtxSplitOrder {
    int c, KS, klen;
    __host__ __device__ void init(int c_, int KS_, int klen_) { c = c_; KS = KS_; klen = klen_; }
    __host__ __device__ bool next(int i, Unit& u) const { if (i > 0 || c >= 8 * KS) return false; const int t = c / KS; u.pm = ML / BM + (t >> 2); u.pn = t & 3; u.ko = (c % KS) * klen; return true; }
    __device__ __forceinline__ void a_ready(const Unit&) const {}
    __device__ __forceinline__ void done(const Unit&) const {}
};

template <bool F8> struct EpiIn1 {
    static constexpr bool PERM = true, AFTER_DRAIN = false;
    const float* krn; const f32x4* tabB; bf16_t* KVA; float* SSKV; bf16_t* QA; float* SSQ; bf16_t* KR; bf16_t* G1; const float* SSX; const float* bias;
    __device__ __forceinline__ void xrow(const f32x4 (&acc)[2][2][4][2], int ai, int m, int R, int pcol0, f32x4 (&x)[2][2]) const {
        const float rinv = SSX[R];
        const float* bp = bias + (size_t)(R < SEQ ? 0 : (R < ML ? 1 : 2)) * N_IN1P + pcol0;
#pragma unroll
        for (int bj = 0; bj < 2; ++bj)
#pragma unroll
            for (int n = 0; n < 2; ++n) x[bj][n] = acc[ai][bj][m][n] * rinv + *(const f32x4*)(bp + bj * HALF + 4 * n);
    }
    __device__ __forceinline__ void operator()(const f32x4 (&acc)[2][2][4][2], const Unit& u, int wr, int wc, int fr_, int fq_) const {
        int fr = fr_, fq = fq_; asm volatile("" : "+v"(fr), "+v"(fq));
        const int pn = u.pn; const bool lat = u.pm < ML / BM; const int pcol0 = pn * BM + wc * 32 + 8 * fq;
        if (pn >= 3) {
#pragma unroll
            for (int ai = 0; ai < 2; ++ai)
#pragma unroll
                for (int m = 0; m < 4; ++m) { const int R = u.pm * BM + ai * HALF + wr * 64 + m * 16 + fr; bf16_t* dst = G1 + (size_t)R * DM + (pn - 3) * BM + wc * 32 + 8 * fq;
                    asm volatile("" ::: "memory"); f32x4 x[2][2]; xrow(acc, ai, m, R, pcol0, x);
#pragma unroll
                    for (int bj = 0; bj < 2; ++bj) *(u32x4*)(dst + bj * HALF) = pack8(silu4(x[bj][0]), silu4(x[bj][1])); }
        } else if (pn == 2 && wc == 2) {
            f32x4 wv[2];
#pragma unroll
            for (int n = 0; n < 2; ++n) wv[n] = *(const f32x4*)(krn + 16 * (fq >> 1) + 8 * n + 4 * (fq & 1));
#pragma unroll
            for (int ai = 0; ai < 2; ++ai)
#pragma unroll
                for (int m = 0; m < 4; ++m) { const int R = u.pm * BM + ai * HALF + wr * 64 + m * 16 + fr;
                    asm volatile("" ::: "memory"); f32x4 xx[2][2]; xrow(acc, ai, m, R, pcol0, xx); f32x4 x0 = xx[0][0], x1 = xx[0][1];
                    const float rinv = rsqrtf(quad_sum(sq4(x0) + sq4(x1)) * (1.f / 32.f) + EPS);
                    x0 = x0 * rinv * wv[0]; x1 = x1 * rinv * wv[1];
                    if (lat) { const int t = R & (SEQ - 1); const int pos = (fq >> 1) ? (t & 63) : (t >> 6); const f32x4* tp = tabB + (pos * 8 + 4 * (fq & 1)) / 2; rot4(x0, x1, tp[0], tp[1]); }
                    if (F8) *(unsigned*)((unsigned char*)KR + (size_t)key_slot(R) * 16 + 4 * fq) = pack8_fp4(x0 * 2.f, x1 * 2.f); else *(u32x4*)(KR + (size_t)key_slot(R) * 32 + 8 * fq) = pack8(x0, x1); }
        } else if (pn == 2 && wc == 3) {
        } else if (pn == 0 || lat) {
            bf16_t* base; float* ssb; int ld, cbase, nss, iss;
            if (pn == 0) { base = KVA; ld = 256; cbase = wc * 32; ssb = SSKV; nss = 4; iss = wc; }
            else if (pn == 1) { base = QA; ld = 384; cbase = wc * 32; ssb = SSQ; nss = 6; iss = wc; }
            else { base = QA; ld = 384; cbase = 256 + wc * 64; ssb = SSQ; nss = 6; iss = 4 + wc; }
            const int bjs = pn == 2 ? 32 : HALF;
#pragma unroll
            for (int ai = 0; ai < 2; ++ai)
#pragma unroll
                for (int m = 0; m < 4; ++m) { const int R = u.pm * BM + ai * HALF + wr * 64 + m * 16 + fr; bf16_t* dst = base + (size_t)R * ld + cbase + 8 * fq; float ss = 0.f;
                    asm volatile("" ::: "memory"); f32x4 x[2][2]; xrow(acc, ai, m, R, pcol0, x);
#pragma unroll
                    for (int bj = 0; bj < 2; ++bj) { ss += sq4(x[bj][0]) + sq4(x[bj][1]); *(u32x4*)(dst + bj * bjs) = pack8(x[bj][0], x[bj][1]); }
                    ss = quad_sum(ss); if (fq == 0) ssb[(size_t)R * nss + iss] = ss; }
        }
    }
};

template <bool F8> struct EpiKvb {
    static constexpr bool PERM = true, AFTER_DRAIN = false;
    const float* SSKV; const float* knn; bf16_t* K1; bf16_t* V1;
    __device__ __forceinline__ void operator()(const f32x4 (&acc)[2][2][4][2], const Unit& u, int wr, int wc, int fr_, int fq_) const {
        int fr = fr_, fq = fq_; asm volatile("" : "+v"(fr), "+v"(fq));
        const int head = 2 * u.pn + (wc >> 1), type = wc & 1;
#pragma unroll
        for (int ai = 0; ai < 2; ++ai)
#pragma unroll
            for (int m = 0; m < 4; ++m) { const int R = u.pm * BM + ai * HALF + wr * 64 + m * 16 + fr;
                asm volatile("" ::: "memory");
                const f32x4 s4 = *(const f32x4*)(SSKV + (size_t)R * 4); const float rkv = rsqrtf(((s4[0] + s4[1]) + (s4[2] + s4[3])) * (1.f / 256.f) + EPS);
                f32x4 x[2][2]; float ss = 0.f;
#pragma unroll
                for (int bj = 0; bj < 2; ++bj)
#pragma unroll
                    for (int n = 0; n < 2; ++n) { x[bj][n] = acc[ai][bj][m][n] * rkv; ss += sq4(x[bj][n]); }
                if (type == 0) { const float rinv = rsqrtf(quad_sum(ss) * (1.f / 64.f) + EPS);
#pragma unroll
                    for (int bj = 0; bj < 2; ++bj)
#pragma unroll
                        for (int n = 0; n < 2; ++n) x[bj][n] = x[bj][n] * rinv * *(const f32x4*)(knn + 32 * bj + 8 * fq + 4 * n); }
                const size_t eo = (size_t)key_slot(R) * DM + head * 64 + 8 * fq;
                if (F8) { if (type == 0) { unsigned char* dst = (unsigned char*)K1 + (size_t)key_slot(R) * 512 + head * 32 + 4 * fq; *(unsigned*)dst = pack8_fp4(x[0][0] * 2.f, x[0][1] * 2.f); *(unsigned*)(dst + 16) = pack8_fp4(x[1][0] * 2.f, x[1][1] * 2.f); }
                          else { unsigned char* dst = (unsigned char*)V1 + eo; *(u32x2*)dst = pack8_fp8(x[0][0], x[0][1]); *(u32x2*)(dst + 32) = pack8_fp8(x[1][0], x[1][1]); } }
                else { bf16_t* dst = (type == 0 ? K1 : V1) + eo; *(u32x4*)dst = pack8(x[0][0], x[0][1]); *(u32x4*)(dst + 32) = pack8(x[1][0], x[1][1]); } }
    }
};

struct EpiQb {
    static constexpr bool PERM = true, AFTER_DRAIN = false;
    const float* SSQ; const float* qnw; const f32x4* tabB; bf16_t* Q1N; bf16_t* Q1R; float* SSH;
    __device__ __forceinline__ float rqa_of(int R) const { const float* sp = SSQ + (size_t)R * 6; const f32x2 sa = *(const f32x2*)sp, sb = *(const f32x2*)(sp + 2), sc = *(const f32x2*)(sp + 4);
        return rsqrtf(((sa[0] + sa[1]) + (sb[0] + sb[1]) + (sc[0] + sc[1])) * (1.f / 384.f) + EPS); }
    __device__ __forceinline__ void operator()(const f32x4 (&acc)[2][2][4][2], const Unit& u, int wr, int wc, int fr_, int fq_) const {
        int fr = fr_, fq = fq_; asm volatile("" : "+v"(fr), "+v"(fq));
        const int head = 2 * u.pn + (wc >> 1);
        if ((wc & 1) == 0) {
#pragma unroll
            for (int ai = 0; ai < 2; ++ai)
#pragma unroll
                for (int m = 0; m < 4; ++m) { const int R = u.pm * BM + ai * HALF + wr * 64 + m * 16 + fr;
                    asm volatile("" ::: "memory");
                    const float rqa = rqa_of(R); float ss = 0.f; bf16_t* dst = Q1N + (size_t)R * DM + head * 64 + 8 * fq;
#pragma unroll
                    for (int bj = 0; bj < 2; ++bj) { f32x4 x0 = acc[ai][bj][m][0] * rqa, x1 = acc[ai][bj][m][1] * rqa; ss += sq4(x0) + sq4(x1);
                        x0 = x0 * *(const f32x4*)(qnw + 32 * bj + 8 * fq); x1 = x1 * *(const f32x4*)(qnw + 32 * bj + 8 * fq + 4); *(u32x4*)(dst + 32 * bj) = pack8(x0, x1); }
                    ss = quad_sum(ss); if (fq == 0) SSH[((size_t)R * 16 + head) * 2] = ss; }
        } else {
#pragma unroll
            for (int ai = 0; ai < 2; ++ai)
#pragma unroll
                for (int m = 0; m < 4; ++m) { const int R = u.pm * BM + ai * HALF + wr * 64 + m * 16 + fr;
                    asm volatile("" ::: "memory");
                    const float rqa = rqa_of(R);
                    f32x4 x0 = acc[ai][0][m][0] * rqa, x1 = acc[ai][0][m][1] * rqa; const float ss = quad_sum(sq4(x0) + sq4(x1)); if (fq == 0) SSH[((size_t)R * 16 + head) * 2 + 1] = ss;
                    const float* wp = qnw + 64 + 16 * (fq >> 1) + 4 * (fq & 1); x0 = x0 * *(const f32x4*)wp; x1 = x1 * *(const f32x4*)(wp + 8);
                    const int t = R & (SEQ - 1); const int pos = (fq >> 1) ? (t & 63) : (t >> 6); const f32x4* tp = tabB + (pos * 8 + 4 * (fq & 1)) / 2; rot4(x0, x1, tp[0], tp[1]);
                    *(u32x4*)(Q1R + (size_t)R * 512 + head * 32 + 8 * fq) = pack8(x0, x1); }
        }
    }
};

struct In1Order {
    int G, c; ROrder lat;
    __host__ __device__ void init(int G_, int c_) { G = G_; c = c_; lat.init(0, ML / BM, N_IN1P, G_, c_); }
    __host__ __device__ bool next(int i, Unit& u) const {
        const long L = (long)i * G + c; if (L < lat.nwg) return lat.next(i, u);
        const int e = (int)(L - lat.nwg); if (e >= 4) return false; u.pm = ML / BM + (e >> 1); u.pn = (e & 1) * 2; u.ko = 0; return true;
    }
    __device__ __forceinline__ void a_ready(const Unit&) const {}
    __device__ __forceinline__ void done(const Unit&) const {}
};
template <class Epi, class Sched, bool ALIGN_EPI = false, bool SP2 = false>
__device__ __forceinline__ void gemm_phase(PG8_LAS unsigned char* lds, const Gemm g, const Sched& S, const Epi& E) {
    const int tid = threadIdx.x, wid = __builtin_amdgcn_readfirstlane(tid >> 6), lane = tid & 63, wr = wid >> 2, wc = wid & 3, fr = lane & 15, fq = lane >> 4;
    const int K = g.K, nt = (g.Kloop ? g.Kloop : K) / BK;
    unsigned voffA[2], voffB[2];
#pragma unroll
    for (int i = 0; i < 2; ++i) { int R, C; stage_rc(tid * 16 + i * 8192, R, C); const int Rb = Epi::PERM ? ((R & ~31) + perm32(R & 31)) : R;
        voffA[i] = (unsigned)(R * K + C) * 2u; voffB[i] = (unsigned)(Rb * K + C) * 2u; }
    const size_t kstep = (size_t)(BK * 2);
    const size_t hstep = (size_t)HALF * K * 2;
    const size_t tstep = 2 * hstep;
    const unsigned ldsw = (unsigned)wid * 1024u;
    const int aoff = lds_byte(wr * 64 + fr, fq * 8), boff = lds_byte(wc * 32 + fr, fq * 8);
#define PG8_SA(b, h) (((b) * 2 + (h)) * HTB)
#define PG8_SB(b, h) ((4 + (b) * 2 + (h)) * HTB)
#define PG8_STAGE(bufoff, gbase, voff) do { _Pragma("unroll") for (int _i = 0; _i < 2; ++_i) \
        __builtin_amdgcn_global_load_lds((const unsigned*)((const char*)(gbase) + (voff)[_i]), (PG8_LAS unsigned*)(lds + (bufoff) + ldsw + _i * 8192), 16, 0, 0); } while (0)
#define PG8_LDA(dst, b, h) do { _Pragma("unroll") for (int m = 0; m < 4; ++m) _Pragma("unroll") for (int k = 0; k < 2; ++k) dst[m][k] = *(const PG8_LAS bf16x8*)(lds + PG8_SA(b, h) + aoff + m * 2048 + k * 1024); } while (0)
#define PG8_LDB(dst, b, h) do { _Pragma("unroll") for (int n = 0; n < 2; ++n) _Pragma("unroll") for (int k = 0; k < 2; ++k) dst[n][k] = *(const PG8_LAS bf16x8*)(lds + PG8_SB(b, h) + boff + n * 2048 + k * 1024); } while (0)
#define PG8_MMA(ai, bj, At, Bt) do { __builtin_amdgcn_s_setprio(1); _Pragma("unroll") for (int m = 0; m < 4; ++m) _Pragma("unroll") for (int n = 0; n < 2; ++n) _Pragma("unroll") for (int k = 0; k < 2; ++k) \
        acc[ai][bj][m][n] = __builtin_amdgcn_mfma_f32_16x16x32_bf16(Bt[n][k], At[m][k], acc[ai][bj][m][n], 0, 0, 0); __builtin_amdgcn_s_setprio(0); } while (0)
#define PG8_WAIT_V(n) asm volatile("s_waitcnt vmcnt(" #n ")" ::: "memory")
#define PG8_WAIT_L(n) asm volatile("s_waitcnt lgkmcnt(" #n ")" ::: "memory")
#define PG8_BAR __builtin_amdgcn_s_barrier()
#define PG8_SCHED __builtin_amdgcn_sched_barrier(0)
    Unit cur, nxt; int ui = 0;
    if (!S.next(0, cur)) return;
    f32x4 acc[2][2][4][2];
#pragma unroll
    for (int a = 0; a < 2; ++a)
#pragma unroll
        for (int b = 0; b < 2; ++b)
#pragma unroll
            for (int m = 0; m < 4; ++m)
#pragma unroll
                for (int n = 0; n < 2; ++n) acc[a][b][m][n] = (f32x4){0.f, 0.f, 0.f, 0.f};
    bf16x8 At[4][2], B0[2][2], B1[2][2];
    const char* cA = (const char*)g.A + (size_t)cur.pm * tstep + (size_t)cur.ko * 2; const char* cB = (const char*)g.Bt + (size_t)cur.pn * tstep + (size_t)cur.ko * 2;
    S.a_ready(cur);
    if constexpr (SP2) {
        PG8_STAGE(PG8_SB(0, 0), cB, voffB); PG8_STAGE(PG8_SB(0, 1), cB + hstep, voffB); PG8_STAGE(PG8_SA(0, 0), cA, voffA); PG8_STAGE(PG8_SA(0, 1), cA + hstep, voffA);
        if (wr == 1) PG8_BAR;
        PG8_WAIT_V(2); PG8_BAR;
        PG8_STAGE(PG8_SB(1, 0), cB + kstep, voffB); PG8_STAGE(PG8_SA(1, 0), cA + kstep, voffA); PG8_STAGE(PG8_SB(1, 1), cB + hstep + kstep, voffB);
        PG8_WAIT_V(6); PG8_BAR;
    } else {
        PG8_STAGE(PG8_SB(0, 0), cB, voffB); PG8_STAGE(PG8_SA(0, 0), cA, voffA); PG8_STAGE(PG8_SB(0, 1), cB + hstep, voffB); PG8_STAGE(PG8_SA(0, 1), cA + hstep, voffA);
        if (wr == 1) PG8_BAR;
        PG8_WAIT_V(4); PG8_BAR;
        PG8_STAGE(PG8_SB(1, 0), cB + kstep, voffB); PG8_STAGE(PG8_SA(1, 0), cA + kstep, voffA); PG8_STAGE(PG8_SB(1, 1), cB + hstep + kstep, voffB);
        PG8_WAIT_V(6); PG8_BAR;
    }
    for (;;) {
        const bool has_next = S.next(ui + 1, nxt);
        const char* nA = has_next ? (const char*)g.A + (size_t)nxt.pm * tstep + (size_t)nxt.ko * 2 : cA; const char* nB = has_next ? (const char*)g.Bt + (size_t)nxt.pn * tstep + (size_t)nxt.ko * 2 : cB;
        _Pragma("nounroll") for (int t = 0; t < nt; t += 2) {
            const bool last = (t == nt - 2);
            const char* a1 = cA + (size_t)(t + 1) * kstep;
            const char* a2 = last ? nA : cA + (size_t)(t + 2) * kstep; const char* b2 = last ? nB : cB + (size_t)(t + 2) * kstep;
            const char* a3 = a2 + kstep; const char* b3 = b2 + kstep;
            if (last && has_next) S.a_ready(nxt);
            if constexpr (SP2) {
            PG8_LDB(B0, 0, 0); PG8_LDB(B1, 0, 1); PG8_SCHED; PG8_LDA(At, 0, 0); PG8_STAGE(PG8_SA(1, 1), a1 + hstep, voffA);
            PG8_WAIT_V(8); PG8_WAIT_L(0); PG8_BAR; PG8_MMA(0, 0, At, B0); PG8_MMA(0, 1, At, B1); PG8_BAR; PG8_SCHED;
            PG8_LDA(At, 0, 1); PG8_STAGE(PG8_SB(0, 0), b2, voffB); PG8_STAGE(PG8_SB(0, 1), b2 + hstep, voffB); PG8_STAGE(PG8_SA(0, 0), a2, voffA);
            PG8_WAIT_V(8); PG8_WAIT_L(0); PG8_BAR; PG8_MMA(1, 0, At, B0); PG8_MMA(1, 1, At, B1); PG8_BAR; PG8_SCHED;
            PG8_LDB(B0, 1, 0); PG8_LDB(B1, 1, 1); PG8_SCHED; PG8_LDA(At, 1, 0); PG8_STAGE(PG8_SA(0, 1), a2 + hstep, voffA);
            PG8_WAIT_V(8); PG8_WAIT_L(0); PG8_BAR; PG8_MMA(0, 0, At, B0); PG8_MMA(0, 1, At, B1); PG8_BAR; PG8_SCHED;
            PG8_LDA(At, 1, 1); PG8_STAGE(PG8_SB(1, 0), b3, voffB); PG8_STAGE(PG8_SB(1, 1), b3 + hstep, voffB); PG8_STAGE(PG8_SA(1, 0), a3, voffA);
            PG8_WAIT_V(8); PG8_WAIT_L(0); PG8_BAR; PG8_MMA(1, 0, At, B0); PG8_MMA(1, 1, At, B1); PG8_BAR; PG8_SCHED;
            } else {
            PG8_LDB(B0, 0, 0); PG8_SCHED; PG8_LDA(At, 0, 0); PG8_STAGE(PG8_SA(1, 1), a1 + hstep, voffA);
            PG8_WAIT_L(8); PG8_BAR; PG8_WAIT_L(0); PG8_MMA(0, 0, At, B0); PG8_BAR; PG8_SCHED;
            PG8_LDB(B1, 0, 1); PG8_STAGE(PG8_SB(0, 0), b2, voffB);
            PG8_BAR; PG8_WAIT_L(0); PG8_MMA(0, 1, At, B1); PG8_BAR;
            PG8_LDA(At, 0, 1); PG8_STAGE(PG8_SA(0, 0), a2, voffA);
            PG8_BAR; PG8_WAIT_L(0); PG8_MMA(1, 0, At, B0); PG8_BAR; PG8_SCHED;
            PG8_STAGE(PG8_SB(0, 1), b2 + hstep, voffB);
            PG8_WAIT_V(6); PG8_BAR; PG8_MMA(1, 1, At, B1); PG8_BAR;
            PG8_LDB(B0, 1, 0); PG8_SCHED; PG8_LDA(At, 1, 0); PG8_STAGE(PG8_SA(0, 1), a2 + hstep, voffA);
            PG8_WAIT_L(8); PG8_BAR; PG8_WAIT_L(0); PG8_MMA(0, 0, At, B0); PG8_BAR; PG8_SCHED;
            PG8_LDB(B1, 1, 1); PG8_STAGE(PG8_SB(1, 0), b3, voffB);
            PG8_BAR; PG8_WAIT_L(0); PG8_MMA(0, 1, At, B1); PG8_BAR;
            PG8_LDA(At, 1, 1); PG8_STAGE(PG8_SA(1, 0), a3, voffA);
            PG8_BAR; PG8_WAIT_L(0); PG8_MMA(1, 0, At, B0); PG8_BAR; PG8_SCHED;
            PG8_STAGE(PG8_SB(1, 1), b3 + hstep, voffB);
            PG8_WAIT_V(6); PG8_BAR; PG8_MMA(1, 1, At, B1); PG8_BAR;
            }
        }
        if constexpr (ALIGN_EPI) { if (wr == 0) PG8_BAR; }
        if constexpr (!Epi::AFTER_DRAIN) { E(acc, cur, wr, wc, fr, fq); S.done(cur); }
        if (!has_next) break;
#pragma unroll
        for (int a = 0; a < 2; ++a)
#pragma unroll
            for (int b = 0; b < 2; ++b)
#pragma unroll
                for (int m = 0; m < 4; ++m)
#pragma unroll
                    for (int n = 0; n < 2; ++n) acc[a][b][m][n] = (f32x4){0.f, 0.f, 0.f, 0.f};
        cur = nxt; cA = nA; cB = nB; ++ui;
        if constexpr (ALIGN_EPI) { if (wr == 1) PG8_BAR; }
    }
    PG8_WAIT_V(0);
    if constexpr (!ALIGN_EPI) { if (wr == 0) PG8_BAR; }
    PG8_BAR;
    if constexpr (Epi::AFTER_DRAIN) { E.fused(acc, cur, wr, wc, fr, fq, lds, wid, lane); S.done(cur); }
#undef PG8_SA
#undef PG8_SB
#undef PG8_STAGE
#undef PG8_LDA
#undef PG8_LDB
#undef PG8_MMA
#undef PG8_WAIT_V
#undef PG8_WAIT_L
#undef PG8_BAR
#undef PG8_SCHED
}
}

DEVI void sincos_pos(float ang, float& cs, float& sn) {
    const double TWO_PI = 6.283185307179586476925286766559; const double a = (double)ang; const double k = __builtin_rint(a * (1.0 / TWO_PI));
    const float r = (float)(a - k * TWO_PI);
    cs = cosf(r); sn = sinf(r);
}

namespace afast {
#ifndef ATT_PRIO
#define ATT_PRIO 2
#endif
#ifndef ATT_DUP
#define ATT_DUP 0
#endif
constexpr int NW = 8, KVBLK = 64, SLOTK = 12288, SLOTV = 8192, KROFF = 8192;
constexpr int LDS_K = 0, LDS_V = 3 * SLOTK, LDS_WS = LDS_V + 3 * SLOTV, LDS_OST = LDS_WS + NW * 256, LDS_BYTES = LDS_OST + NW * 4096;
#define SBAR() __builtin_amdgcn_sched_barrier(0)
#define PIN(x) asm volatile("" : "+v"(x))
#define MFMA(a, b, c) __builtin_amdgcn_mfma_f32_32x32x16_bf16(a, b, c, 0, 0, 0)
#ifndef ATT_AGPR_O
#define ATT_AGPR_O 0
#endif
#if ATT_AGPR_O
#define PVMFMA(acc, a, b) asm volatile("s_nop 1\n\tv_mfma_f32_32x32x16_bf16 %0, %1, %2, %0" : "+a"(acc) : "v"(a), "v"(b))
#else
#define PVMFMA(acc, a, b) acc = __builtin_amdgcn_mfma_f32_32x32x16_bf16(a, b, acc, 0, 0, 0)
#endif
#define WAIT_BAR_(N) asm volatile("s_waitcnt vmcnt(" #N ") lgkmcnt(0)\n\ts_barrier" ::: "memory")
#define WAIT_BAR_0() WAIT_BAR_(0)
#define WAIT_BAR_1() do { if (ATT_DUP & 1) WAIT_BAR_(2); else WAIT_BAR_(1); } while (0)
#define WAIT_BAR_2() do { if (ATT_DUP & 1) WAIT_BAR_(4); else WAIT_BAR_(2); } while (0)
#define WAIT_BAR_3() do { if (ATT_DUP & 1) WAIT_BAR_(6); else WAIT_BAR_(3); } while (0)
#define WAIT_BAR(N) do { WAIT_BAR_##N(); if (ATT_DUP & 2) asm volatile("s_barrier" ::: "memory"); } while (0)
DEVI int crow(int r, int hi) { return (r & 3) + 8 * (r >> 2) + 4 * hi; }
DEVI unsigned cvtpk(float lo, float hi) { unsigned r; asm("v_cvt_pk_bf16_f32 %0, %1, %2" : "=v"(r) : "v"(lo), "v"(hi)); return r; }
DEVI void glds16(const void* g, unsigned lds_base) {
    unsigned sv; asm volatile("s_mov_b32 %0, m0\n\ts_mov_b32 m0, %2\n\ts_nop 0\n\tglobal_load_lds_dwordx4 %1, off\n\ts_mov_b32 m0, %0" : "=&s"(sv) : "v"(g), "s"(lds_base) : "memory"); }
typedef __attribute__((address_space(3))) const char* lds_cptr;
typedef short v4i16_t __attribute__((ext_vector_type(4)));
DEVI bf16x8 ldsb128(lds_cptr p) { return *(const __attribute__((address_space(3))) bf16x8*)p; }
DEVI s16x4 vtr(lds_cptr p) { return __builtin_bit_cast(s16x4, __builtin_amdgcn_ds_read_tr16_b64_v4i16((__attribute__((address_space(3))) v4i16_t*)p)); }
DEVI bf16x8 scale8(bf16x8 v, float s) {
    u32x4 w = __builtin_bit_cast(u32x4, v); u32x4 o;
#pragma unroll
    for (int i = 0; i < 4; ++i) { const float lo = __uint_as_float(w[i] << 16) * s, hi = __uint_as_float(w[i] & 0xffff0000u) * s; o[i] = cvtpk(lo, hi); }
    return __builtin_bit_cast(bf16x8, o);
}

template <int ROPE>
DEVI void attn_unit(const bf16_t* Qn, int ldq, const bf16_t* Qr, const float* ssh, const bf16_t* __restrict__ Kn, int ldk, const bf16_t* __restrict__ Kr,
                    const bf16_t* __restrict__ V, int ldv, int NT, bf16_t* O, const bf16_t* G, int ldo, char* lds) {
    const int tid = threadIdx.x, lane = tid & 63, r32 = lane & 31, hi = lane >> 5; const int wid = __builtin_amdgcn_readfirstlane(tid >> 6);
    const unsigned lds0 = (unsigned)(uintptr_t)lds; float* wsf = (float*)(lds + LDS_WS) + wid * 64;
    const bf16_t* ksrc = Kn + (size_t)lane * ldk + wid * 8;
    const bf16_t* vsrc = V + (size_t)(16 * (wid & 3) + (lane >> 2)) * ldv + (wid >> 2) * 32 + (lane & 3) * 8;
    const bf16_t* krsrc = ROPE ? Kr + (size_t)(32 * (wid & 1) + r32) * 32 + 8 * (2 * ((wid >> 1) & 1) + hi) : nullptr;
    const unsigned kdst = lds0 + LDS_K + wid * 1024, vdst = lds0 + LDS_V + wid * 1024, krdst = lds0 + LDS_K + KROFF + (wid & 3) * 1024;
    const bool rwave = ROPE && wid < 4;
#define DMA_K(t, slot) do { DMA_K1(t, slot); if (ATT_DUP & 1) DMA_K1(t, slot); } while (0)
#define DMA_K1(t, slot) do { if (ROPE) { if (rwave) glds16(krsrc + (size_t)(t) * KVBLK * 32, (unsigned)__builtin_amdgcn_readfirstlane(krdst + (slot))); } \
        glds16(ksrc + (size_t)(t) * KVBLK * ldk, (unsigned)__builtin_amdgcn_readfirstlane(kdst + (slot))); } while (0)
#define DMA_V1(t, slot) glds16(vsrc + (size_t)(t) * KVBLK * ldv, (unsigned)__builtin_amdgcn_readfirstlane(vdst + (slot)))
#define DMA_V(t, slot) do { DMA_V1(t, slot); if (ATT_DUP & 1) DMA_V1(t, slot); } while (0)
    const lds_cptr vp0 = (lds_cptr)lds + LDS_V + ((lane >> 4) & 1) * 32 + (lane & 3) * 8 + (4 * hi + ((lane & 15) >> 2)) * 64;
    const lds_cptr kp0 = (lds_cptr)lds + LDS_K + hi * 1024 + r32 * 16;
    const lds_cptr krp0 = (lds_cptr)lds + LDS_K + KROFF + hi * 512 + r32 * 16;
    DMA_K(0, 0); DMA_V(0, 0); DMA_K(1, SLOTK);
    bf16x8 qr[4]; bf16x8 qrr[2];
    { const bf16_t* Qw = Qn + (size_t)(wid * 32 + r32) * ldq + hi * 8;
#pragma unroll
      for (int d0 = 0; d0 < 4; ++d0) qr[d0] = *reinterpret_cast<const bf16x8*>(Qw + d0 * 16);
      if (ROPE) { const bf16_t* Qrw = Qr + (size_t)(wid * 32 + r32) * 512 + hi * 8;
#pragma unroll
          for (int d0 = 0; d0 < 2; ++d0) qrr[d0] = *reinterpret_cast<const bf16x8*>(Qrw + d0 * 16);
          const f32x2 s2 = *(const f32x2*)(ssh + (size_t)(wid * 32 + r32) * 32); const float sc = rsqrtf((s2[0] + s2[1]) * (1.f / 96.f) + EPS) * C2_MLA;
#pragma unroll
          for (int d0 = 0; d0 < 4; ++d0) qr[d0] = scale8(qr[d0], sc);
#pragma unroll
          for (int d0 = 0; d0 < 2; ++d0) qrr[d0] = scale8(qrr[d0], sc); } }
    float l_reg = 0.f; f32x16 o[2]; o[0] = f32x16{}; o[1] = f32x16{};
    const f32x16 zero16 = f32x16{};
    f32x16 dacc = f32x16{}; f32x16 pA0, pA1, pB0, pB1; bf16x8 kf[8]; bf16x8 kfr[4]; s16x4 vlo[8], vhi[8]; u32x4 pw0, pw1, pw2, pw3;
    int sl_prev = 0, sl_cur = 0, sl_next = SLOTK;
#define VSL(s) (((s) / (SLOTK / 1024)) * (SLOTV / 1024))
#define ROT() do { sl_prev = sl_cur; sl_cur = sl_next; sl_next = (sl_next == 2 * SLOTK) ? 0 : sl_next + SLOTK; } while (0)
#define EX(v) __builtin_amdgcn_exp2f(v)
#define KLOADALL(slot) do { _Pragma("unroll") for (int d0 = 0; d0 < 4; ++d0) { kf[2 * d0] = ldsb128(kp0 + (slot) + d0 * 2048); kf[2 * d0 + 1] = ldsb128(kp0 + (slot) + d0 * 2048 + 512); } \
        if (ROPE) { _Pragma("unroll") for (int q = 0; q < 4; ++q) kfr[q] = ldsb128(krp0 + (slot) + q * 1024); } } while (0)
    DMA_K(2, 2 * SLOTK);
    WAIT_BAR(3);
    KLOADALL(0);
    pA0 = MFMA(kf[0], qr[0], zero16); pA1 = MFMA(kf[1], qr[0], zero16); pA0 = MFMA(kf[2], qr[1], pA0); pA1 = MFMA(kf[3], qr[1], pA1);
    pA0 = MFMA(kf[4], qr[2], pA0); pA1 = MFMA(kf[5], qr[2], pA1); pA0 = MFMA(kf[6], qr[3], pA0); pA1 = MFMA(kf[7], qr[3], pA1);
    if (ROPE) { pA0 = MFMA(kfr[0], qrr[0], pA0); pA1 = MFMA(kfr[1], qrr[0], pA1); pA0 = MFMA(kfr[2], qrr[1], pA0); pA1 = MFMA(kfr[3], qrr[1], pA1); }
#pragma unroll
    for (int r = 0; r < 16; ++r) { pA0[r] = EX(pA0[r]); pA1[r] = EX(pA1[r]); }
    WAIT_BAR(0);
    DMA_K(3, 0); DMA_V(1, SLOTV); ROT();
    KLOADALL(sl_cur);
    WAIT_BAR(2);
#define PKW(P, i) cvtpk(P[i], P[i + 1])
#define PAF(k) __builtin_bit_cast(bf16x8, pw##k)
#define VFR(i) (bf16x8){vlo[i][0], vlo[i][1], vlo[i][2], vlo[i][3], vhi[i][0], vhi[i][1], vhi[i][2], vhi[i][3]}
#define VRD(i) do { vlo[i] = vtr(vp_ + (((i) >> 2) * 4096 + ((i) & 3) * 1024)); vhi[i] = vtr(vp_ + (((i) >> 2) * 4096 + ((i) & 3) * 1024 + 512)); } while (0)
#define KRD(G, d0) do { if (G) { kf[2 * (d0)] = ldsb128(kp0 + sl_next + (d0) * 2048); kf[2 * (d0) + 1] = ldsb128(kp0 + sl_next + (d0) * 2048 + 512); \
        if (ATT_DUP & 16) { bf16x8 d0_, d1_; asm volatile("ds_read_b128 %0, %2 offset:0\n\tds_read_b128 %1, %2 offset:512\n\ts_waitcnt lgkmcnt(0)" : "=&v"(d0_), "=&v"(d1_) : "v"((unsigned)(uintptr_t)(kp0 + sl_next + (d0) * 2048)) : "memory"); } SBAR(); } } while (0)
#define KRR(G, q) do { if (ROPE) { if (G) { kfr[2 * (q)] = ldsb128(krp0 + sl_next + (2 * (q)) * 1024); kfr[2 * (q) + 1] = ldsb128(krp0 + sl_next + (2 * (q) + 1) * 1024); SBAR(); } } } while (0)
#define GAPA4(CX, MF, a0, a1, a2, a3, W0, W1, PW) do { MF; sacc += a0; sacc += a1; sacc += a2; sacc += a3; W0; W1; PIN(PW); PIN(sacc); PIN(CX); if ((ATT_DUP & 8) && !ROPE) { dacc = MFMA(kf[0], qr[0], dacc); PIN(dacc); } SBAR(); } while (0)
#define GAPA3(CX, MF, a0, a1, a2, W0, W1, PW) do { MF; sacc += a0; sacc += a1; sacc += a2; W0; W1; PIN(PW); PIN(sacc); PIN(CX); if ((ATT_DUP & 8) && !ROPE) { dacc = MFMA(kf[0], qr[0], dacc); PIN(dacc); } SBAR(); } while (0)
#define GAPA31(CX, MF, a0, a1, a2, W0, PW) do { MF; sacc += a0; sacc += a1; sacc += a2; W0; PIN(PW); PIN(sacc); PIN(CX); if ((ATT_DUP & 8) && !ROPE) { dacc = MFMA(kf[0], qr[0], dacc); PIN(dacc); } SBAR(); } while (0)
#define GAPA21(CX, MF, a0, a1, W0, PW) do { MF; sacc += a0; sacc += a1; W0; PIN(PW); PIN(sacc); PIN(CX); if ((ATT_DUP & 8) && !ROPE) { dacc = MFMA(kf[0], qr[0], dacc); PIN(dacc); } SBAR(); } while (0)
#define XEXP(v) do { if (ATT_DUP & 4) { float d_; asm volatile("v_exp_f32 %0, %1" : "=v"(d_) : "v"(v)); } } while (0)
#define GAPB(MF, X, i) do { MF; X[i] = EX(X[i]); X[i + 1] = EX(X[i + 1]); X[i + 2] = EX(X[i + 2]); X[i + 3] = EX(X[i + 3]); XEXP(X[i]); XEXP(X[i + 1]); XEXP(X[i + 2]); XEXP(X[i + 3]); PIN(X); SBAR(); } while (0)
#define STEP(C0, C1, P0, P1, t, GK, GV, GL) do { SBAR(); if (ATT_PRIO == 2) __builtin_amdgcn_s_setprio(1); if (ATT_PRIO == 3) __builtin_amdgcn_s_setprio(0); \
    const lds_cptr vp_ = vp0 + VSL(sl_prev); \
    VRD(0); SBAR(); float sacc = P0[0] + P0[1]; \
    if (!ROPE) { \
                        GAPA4(C0, C0 = MFMA(kf[0], qr[0], zero16), P0[2], P0[3], P0[4], P0[5],     pw0[0] = PKW(P0, 0),  pw0[1] = PKW(P0, 2),  pw0); \
        VRD(4); SBAR(); GAPA4(C1, C1 = MFMA(kf[1], qr[0], zero16), P0[6], P0[7], P0[8], P0[9],     pw0[2] = PKW(P0, 4),  pw0[3] = PKW(P0, 6),  pw0); \
        VRD(1); SBAR(); GAPA4(C0, C0 = MFMA(kf[2], qr[1], C0),    P0[10], P0[11], P0[12], P0[13], pw1[0] = PKW(P0, 8),  pw1[1] = PKW(P0, 10), pw1); \
        VRD(5); SBAR(); GAPA4(C1, C1 = MFMA(kf[3], qr[1], C1),    P0[14], P0[15], P1[0], P1[1],   pw1[2] = PKW(P0, 12), pw1[3] = PKW(P0, 14), pw1); \
        VRD(2); SBAR(); GAPA4(C0, C0 = MFMA(kf[4], qr[2], C0),    P1[2], P1[3], P1[4], P1[5],     pw2[0] = PKW(P1, 0),  pw2[1] = PKW(P1, 2),  pw2); \
        VRD(6); SBAR(); GAPA4(C1, C1 = MFMA(kf[5], qr[2], C1),    P1[6], P1[7], P1[8], P1[9],     pw2[2] = PKW(P1, 4),  pw2[3] = PKW(P1, 6),  pw2); \
        VRD(3); SBAR(); GAPA4(C0, C0 = MFMA(kf[6], qr[3], C0),    P1[10], P1[11], P1[12], P1[13], pw3[0] = PKW(P1, 8),  pw3[1] = PKW(P1, 10), pw3); \
        VRD(7); SBAR(); GAPA4(C1, C1 = MFMA(kf[7], qr[3], C1),    P1[14], P1[15], 0.f, 0.f,       pw3[2] = PKW(P1, 12), pw3[3] = PKW(P1, 14), pw3); \
    } else { \
                        GAPA3(C0, C0 = MFMA(kf[0], qr[0], zero16), P0[2], P0[3], P0[4],    pw0[0] = PKW(P0, 0),  pw0[1] = PKW(P0, 2),  pw0); \
        VRD(4); SBAR(); GAPA3(C1, C1 = MFMA(kf[1], qr[0], zero16), P0[5], P0[6], P0[7],    pw0[2] = PKW(P0, 4),  pw0[3] = PKW(P0, 6),  pw0); \
        VRD(1); SBAR(); GAPA3(C0, C0 = MFMA(kf[2], qr[1], C0),    P0[8], P0[9], P0[10],   pw1[0] = PKW(P0, 8),  pw1[1] = PKW(P0, 10), pw1); \
        VRD(5); SBAR(); GAPA3(C1, C1 = MFMA(kf[3], qr[1], C1),    P0[11], P0[12], P0[13], pw1[2] = PKW(P0, 12), pw1[3] = PKW(P0, 14), pw1); \
        VRD(2); SBAR(); GAPA31(C0, C0 = MFMA(kf[4], qr[2], C0),   P0[14], P0[15], P1[0],  pw2[0] = PKW(P1, 0),  pw2); \
        VRD(6); SBAR(); GAPA31(C1, C1 = MFMA(kf[5], qr[2], C1),   P1[1], P1[2], P1[3],    pw2[1] = PKW(P1, 2),  pw2); \
        VRD(3); SBAR(); GAPA21(C0, C0 = MFMA(kf[6], qr[3], C0),   P1[4], P1[5],           pw2[2] = PKW(P1, 4),  pw2); \
        VRD(7); SBAR(); GAPA21(C1, C1 = MFMA(kf[7], qr[3], C1),   P1[6], P1[7],           pw2[3] = PKW(P1, 6),  pw2); \
                        GAPA21(C0, C0 = MFMA(kfr[0], qrr[0], C0), P1[8], P1[9],           pw3[0] = PKW(P1, 8),  pw3); \
                        GAPA21(C1, C1 = MFMA(kfr[1], qrr[0], C1), P1[10], P1[11],         pw3[1] = PKW(P1, 10), pw3); \
                        GAPA21(C0, C0 = MFMA(kfr[2], qrr[1], C0), P1[12], P1[13],         pw3[2] = PKW(P1, 12), pw3); \
                        GAPA21(C1, C1 = MFMA(kfr[3], qrr[1], C1), P1[14], P1[15],         pw3[3] = PKW(P1, 14), pw3); \
    } \
    l_reg += sacc; \
    if (GK) DMA_K((t) + 3, sl_cur); if (GV) DMA_V((t) + 1, VSL(sl_next)); \
    SBAR(); if (ATT_PRIO == 2) __builtin_amdgcn_s_setprio(0); if (ATT_PRIO == 3) __builtin_amdgcn_s_setprio(1); \
    GAPB(PVMFMA(o[0], PAF(0), VFR(0)), C0, 0); \
    KRD(GL, 0); GAPB(PVMFMA(o[1], PAF(0), VFR(4)), C0, 4); \
    KRD(GL, 1); GAPB(PVMFMA(o[0], PAF(1), VFR(1)), C0, 8); \
    KRD(GL, 2); GAPB(PVMFMA(o[1], PAF(1), VFR(5)), C0, 12); \
    KRD(GL, 3); GAPB(PVMFMA(o[0], PAF(2), VFR(2)), C1, 0); \
    KRR(GL, 0); GAPB(PVMFMA(o[1], PAF(2), VFR(6)), C1, 4); \
    KRR(GL, 1); GAPB(PVMFMA(o[0], PAF(3), VFR(3)), C1, 8); \
    GAPB(PVMFMA(o[1], PAF(3), VFR(7)), C1, 12); \
    } while (0)
    if (ATT_PRIO == 1) { if (wid >= 4) __builtin_amdgcn_s_setprio(1); }
    int t = 1;
    for (; t + 5 < NT; t += 2) {
        STEP(pB0, pB1, pA0, pA1, t, true, true, true);     WAIT_BAR(2); ROT();
        STEP(pA0, pA1, pB0, pB1, t + 1, true, true, true); WAIT_BAR(2); ROT();
    }
#define ENDW(tt) do { if ((tt) + 3 < NT) { WAIT_BAR(2); } else if ((tt) + 2 < NT) { WAIT_BAR(1); } else { WAIT_BAR(0); } } while (0)
    for (; t + 1 < NT; t += 2) {
        STEP(pB0, pB1, pA0, pA1, t, (t + 3 < NT), (t + 1 < NT), (t + 1 < NT));         ENDW(t);     ROT();
        STEP(pA0, pA1, pB0, pB1, t + 1, (t + 4 < NT), (t + 2 < NT), (t + 2 < NT));     ENDW(t + 1); ROT();
    }
    STEP(pB0, pB1, pA0, pA1, NT - 1, false, false, false);
    if (ATT_PRIO != 0) __builtin_amdgcn_s_setprio(0);
    { float sacc = pB0[0] + pB0[1];
#pragma unroll
      for (int r = 2; r < 16; ++r) sacc += pB0[r];
#pragma unroll
      for (int r = 0; r < 16; ++r) sacc += pB1[r];
      l_reg += sacc;
      pw0 = (u32x4){PKW(pB0, 0), PKW(pB0, 2), PKW(pB0, 4), PKW(pB0, 6)}; pw1 = (u32x4){PKW(pB0, 8), PKW(pB0, 10), PKW(pB0, 12), PKW(pB0, 14)};
      pw2 = (u32x4){PKW(pB1, 0), PKW(pB1, 2), PKW(pB1, 4), PKW(pB1, 6)}; pw3 = (u32x4){PKW(pB1, 8), PKW(pB1, 10), PKW(pB1, 12), PKW(pB1, 14)};
      const lds_cptr vp_ = vp0 + VSL(sl_cur); _Pragma("unroll") for (int i = 0; i < 8; ++i) VRD(i);
      PVMFMA(o[0], PAF(0), VFR(0)); PVMFMA(o[1], PAF(0), VFR(4)); PVMFMA(o[0], PAF(1), VFR(1)); PVMFMA(o[1], PAF(1), VFR(5));
      PVMFMA(o[0], PAF(2), VFR(2)); PVMFMA(o[1], PAF(2), VFR(6)); PVMFMA(o[0], PAF(3), VFR(3)); PVMFMA(o[1], PAF(3), VFR(7)); }
#if ATT_AGPR_O
    asm volatile("s_nop 15\n\ts_nop 7" : "+a"(o[0]), "+a"(o[1]));
#endif
    { auto rr = __builtin_amdgcn_permlane32_swap(__float_as_uint(l_reg), __float_as_uint(l_reg), false, false); l_reg = __uint_as_float(rr[0]) + __uint_as_float(rr[1]); }
    if (hi == 0) wsf[32 + r32] = l_reg; asm volatile("s_waitcnt lgkmcnt(0)" ::: "memory");
    float rli[16];
#pragma unroll
    for (int r = 0; r < 16; ++r) rli[r] = __builtin_amdgcn_rcpf(wsf[32 + crow(r, hi)]);
    bf16_t* stg = (bf16_t*)(lds + LDS_OST) + wid * 2048;
#pragma unroll
    for (int r = 0; r < 16; ++r) { const int orow = crow(r, hi);
#pragma unroll
        for (int d0 = 0; d0 < 2; ++d0) stg[orow * 64 + d0 * 32 + r32] = (bf16_t)f2bf(o[d0][r] * rli[r]); }
    asm volatile("s_waitcnt lgkmcnt(0)" ::: "memory");
#pragma unroll
    for (int i = 0; i < 4; ++i) { const int row = i * 8 + (lane >> 3), ch = lane & 7; const size_t goff = (size_t)(wid * 32 + row) * ldo + ch * 8;
        const u32x4 ov = *(const u32x4*)(stg + row * 64 + ch * 8); const u32x4 gv = *(const u32x4*)(G + goff); u32x4 w;
#pragma unroll
        for (int q = 0; q < 4; ++q) { const float lo = __uint_as_float(ov[q] << 16) * __uint_as_float(gv[q] << 16), hh = __uint_as_float(ov[q] & 0xffff0000u) * __uint_as_float(gv[q] & 0xffff0000u); w[q] = cvtpk(lo, hh); }
        *(u32x4*)(O + goff) = w; }
    asm volatile("s_waitcnt lgkmcnt(0)\n\ts_barrier" ::: "memory");
#undef DMA_K
#undef DMA_K1
#undef DMA_V1
#undef XEXP
#undef DMA_V
#undef VSL
#undef ROT
#undef EX
#undef KLOADALL
#undef PKW
#undef PAF
#undef VFR
#undef VRD
#undef KRD
#undef KRR
#undef GAPA4
#undef GAPA3
#undef GAPA31
#undef GAPA21
#undef GAPB
#undef STEP
#undef ENDW
}
#undef SBAR
#undef PIN
#undef MFMA
#undef PVMFMA
#undef WAIT_BAR
#undef WAIT_BAR_
#undef WAIT_BAR_0
#undef WAIT_BAR_1
#undef WAIT_BAR_2
#undef WAIT_BAR_3
}

namespace af8 {
#ifndef F8_DUP
#define F8_DUP 0
#endif
typedef int v8i __attribute__((ext_vector_type(8)));
typedef int v4i __attribute__((ext_vector_type(4)));
typedef int v2i __attribute__((ext_vector_type(2)));
constexpr int NW = 8, KVBLK = 64, SLOT = 4096, KSLOT = 2048;
constexpr int KRSLOT = 1024 + 64;
constexpr int LDS_K = 0, LDS_V = 3 * KSLOT, LDS_KR = LDS_V + 3 * SLOT, LDS_WS = LDS_KR + 3 * KRSLOT, LDS_OST = LDS_WS + NW * 256, LDS_BYTES = LDS_OST + NW * 4096;
constexpr float YOFF = 56.0f;
#define SBAR() __builtin_amdgcn_sched_barrier(0)
#define PIN(x) asm volatile("" : "+v"(x))
#define WAIT_BAR0() asm volatile("s_waitcnt vmcnt(0) lgkmcnt(0)\n\ts_barrier" ::: "memory")
#define WAIT_BAR1() asm volatile("s_waitcnt vmcnt(1) lgkmcnt(0)\n\ts_barrier" ::: "memory")
#define V8(x) ((v8i){(x)[0], (x)[1], (x)[2], (x)[3], 0, 0, 0, 0})
#define V6(x) ((v8i){(int)(x)[0], (int)(x)[1], (int)(x)[2], (int)(x)[3], (int)(x)[4], (int)(x)[5], 0, 0})
#define QKMFMA(a, b, c) __builtin_amdgcn_mfma_scale_f32_32x32x64_f8f6f4(V8(a), V6(b), c, 4, 2, 0, 126, 0, 126)
#define PVMFMA8(a, b, c) __builtin_amdgcn_mfma_scale_f32_32x32x64_f8f6f4(a, b, c, 1, 0, 0, 127, 0, 127)
DEVI int crow(int r, int hi) { return (r & 3) + 8 * (r >> 2) + 4 * hi; }
DEVI unsigned cvtpk(float lo, float hi) { unsigned r; asm("v_cvt_pk_bf16_f32 %0, %1, %2" : "=v"(r) : "v"(lo), "v"(hi)); return r; }
DEVI void glds16(const void* g, unsigned lds_base) {
    unsigned sv; asm volatile("s_mov_b32 %0, m0\n\ts_mov_b32 m0, %2\n\ts_nop 0\n\tglobal_load_lds_dwordx4 %1, off\n\ts_mov_b32 m0, %0" : "=&s"(sv) : "v"(g), "s"(lds_base) : "memory"); }
typedef __attribute__((address_space(3))) const char* lds_cptr;
DEVI v4i lds128(lds_cptr p) { return *(const __attribute__((address_space(3))) v4i*)p; }
DEVI v2i vtr8(lds_cptr p) { return __builtin_amdgcn_ds_read_tr8_b64_v2i32((__attribute__((address_space(3))) v2i*)p); }
#define PK16U8(P, PF, B) do { unsigned a_, b_, c_, d_; asm volatile("" : "=v"(a_), "=v"(b_), "=v"(c_), "=v"(d_)); \
    _Pragma("unroll") for (int k_ = 0; k_ < 4; ++k_) { a_ = __builtin_amdgcn_cvt_pk_u8_f32(P[k_], k_, a_); b_ = __builtin_amdgcn_cvt_pk_u8_f32(P[4 + k_], k_, b_); \
        c_ = __builtin_amdgcn_cvt_pk_u8_f32(P[8 + k_], k_, c_); d_ = __builtin_amdgcn_cvt_pk_u8_f32(P[12 + k_], k_, d_); } \
    PF[B] = (int)a_; PF[(B) + 1] = (int)b_; PF[(B) + 2] = (int)c_; PF[(B) + 3] = (int)d_; } while (0)
DEVI int pk4bf8(float a, float b, float c, float d) { unsigned w; asm volatile("" : "=v"(w)); w = __builtin_amdgcn_cvt_pk_u8_f32(a, 0, w); w = __builtin_amdgcn_cvt_pk_u8_f32(b, 1, w); w = __builtin_amdgcn_cvt_pk_u8_f32(c, 2, w); w = __builtin_amdgcn_cvt_pk_u8_f32(d, 3, w); return (int)w; }

DEVI int pk4fp8(float a, float b, float c, float d) { int w; asm volatile("" : "=v"(w)); w = __builtin_amdgcn_cvt_pk_fp8_f32(a, b, w, false); w = __builtin_amdgcn_cvt_pk_fp8_f32(c, d, w, true); return w; }
#ifndef F6_INTERLEAVED
#define F6_INTERLEAVED 1
#endif
typedef float v16f __attribute__((ext_vector_type(16)));
typedef unsigned v6u __attribute__((ext_vector_type(6)));
DEVI v6u q32_to_fp6(const bf16_t* p, float sc) { v16f a, b;
#pragma unroll
    for (int c = 0; c < 4; ++c) { const u32x4 w = *(const u32x4*)(p + 8 * c);
#pragma unroll
        for (int k = 0; k < 4; ++k) { const float lo = __uint_as_float(w[k] << 16) * sc, hi = __uint_as_float(w[k] & 0xffff0000u) * sc; const int i = 4 * c + k;
            if (F6_INTERLEAVED) { a[i] = lo; b[i] = hi; } else if (i < 8) { a[2 * i] = lo; a[2 * i + 1] = hi; } else { b[2 * i - 16] = lo; b[2 * i - 15] = hi; } } }
    return __builtin_amdgcn_cvt_scalef32_2xpk16_fp6_f32(a, b, 1.0f); }
template <int ROPE>
DEVI void attn_unit(const void* Qv, int ldq, const bf16_t* Qr, const float* ssh, const unsigned char* __restrict__ K, int ldk, const unsigned char* __restrict__ Kr,
                    const unsigned char* __restrict__ V, int ldv, int NT, bf16_t* O, const bf16_t* G, int ldo, char* lds) {
    int tid_ = threadIdx.x; asm volatile("" : "+v"(tid_));
    const int tid = tid_, lane = tid & 63, r32 = lane & 31, hi = lane >> 5; const int wid = __builtin_amdgcn_readfirstlane(tid >> 6);
    const unsigned lds0 = (unsigned)(uintptr_t)lds; float* wsf = (float*)(lds + LDS_WS) + wid * 64;
    const int role = wid < 2 ? 0 : (wid >= 4 ? 1 : ((ROPE && wid == 2) ? 2 : 3)); const bool kwave = role != 1; const int dlead = kwave ? 3 : 1;
    const int kkey = 32 * (wid & 1) + (lane >> 1), vkey = 16 * (wid & 3) + (lane >> 2);
    const unsigned char* dsrc = role == 0 ? K + (size_t)kkey * ldk + 16 * ((lane & 1) ^ ((kkey >> 3) & 1))
                              : role == 1 ? V + (size_t)vkey * ldv + 16 * ((lane & 3) ^ (2 * ((vkey >> 3) & 1)))
                              : (ROPE ? Kr + (size_t)lane * 16 : K);
    const size_t dstep = (size_t)KVBLK * (role == 0 ? ldk : (role == 1 ? ldv : 16));
    const unsigned ddst = lds0 + (role == 0 ? LDS_K + (wid & 1) * 1024 : (role == 1 ? LDS_V + (wid & 3) * 1024 : LDS_KR));
    const int dslot = role == 0 ? KSLOT : (role == 1 ? SLOT : KRSLOT); const bool dma_on = role != 3;
#define DMA(t, si) glds16(dsrc + (size_t)(t) * dstep, (unsigned)__builtin_amdgcn_readfirstlane(ddst + (si) * dslot))
    const lds_cptr kpa = (lds_cptr)lds + LDS_K + r32 * 32 + ((hi ^ ((r32 >> 3) & 1)) * 16);
    const int vg = (lane >> 4) & 1, vq = (lane & 15) >> 1, vp = lane & 1, vfk = (vq >> 2) & 1;
    const int vrow = (8 * (vq >> 2) + 4 * hi + (vq & 3)) * 64 + 8 * vp + 16 * vg;
    const lds_cptr vp0 = (lds_cptr)lds + LDS_V + vrow + 32 * vfk, vp1 = (lds_cptr)lds + LDS_V + vrow + 32 * (1 - vfk);
    const lds_cptr ra0 = (lds_cptr)lds + LDS_KR + (hi ? 1024 : r32 * 16), ra1 = (lds_cptr)lds + LDS_KR + (hi ? 1024 : 512 + r32 * 16);
    if (ROPE) { if (tid < 12) *(int*)(lds + LDS_KR + (tid >> 2) * KRSLOT + 1024 + (tid & 3) * 4) = 0; }
    if (dma_on) { if (kwave) { DMA(0, 0); DMA(1, 1); DMA(2, 2); } else { DMA(0, 0); } }
    v6u qf, qrf;
    if (!ROPE) { qf = q32_to_fp6((const bf16_t*)Qv + (size_t)(wid * 32 + r32) * ldq + hi * 32, 1.0f); qrf = qf; }
    else { const f32x2 s2 = *(const f32x2*)(ssh + (size_t)(wid * 32 + r32) * 32); const float sc = rsqrtf((s2[0] + s2[1]) * (1.f / 96.f) + EPS) * (C2_MLA * 8.f);
        qf = q32_to_fp6((const bf16_t*)Qv + (size_t)(wid * 32 + r32) * ldq + hi * 32, sc);
        qrf = q32_to_fp6(Qr + (size_t)(wid * 32 + r32) * 512, hi ? 0.f : sc); }
    f32x16 o[2]; o[0] = f32x16{}; o[1] = f32x16{}; f32x16 lacc = f32x16{};
    v8i ones;
#pragma unroll
    for (int i = 0; i < 8; ++i) ones[i] = 0x38383838;
    PIN(ones);
    f32x16 m4;
    { float y_ = YOFF; asm volatile("" : "+v"(y_));
#pragma unroll
      for (int r = 0; r < 16; ++r) m4[r] = y_; }
    PIN(m4);
    v4i kf0, kf1, krf0, krf1; v8i vf0, vf1, pfA, pfB;
    int sl_prev = 0, sl_cur = 0, sl_next = 1;
#define ROT() do { sl_prev = sl_cur; sl_cur = sl_next; sl_next = (sl_next == 2) ? 0 : sl_next + 1; } while (0)
#define EX(v) __builtin_amdgcn_exp2f(v)
#define KLOAD(si) do { kf0 = lds128(kpa + (si) * KSLOT); kf1 = lds128(kpa + (si) * KSLOT + 1024); if (ROPE) { krf0 = lds128(ra0 + (si) * KRSLOT); krf1 = lds128(ra1 + (si) * KRSLOT); } } while (0)
    WAIT_BAR0();
    KLOAD(0);
    f32x16 C0, C1; v4i kg0, kg1, krg0, krg1;
    const bool grpB = wid >= 4;
    C0 = QKMFMA(kf0, qf, m4); C1 = QKMFMA(kf1, qf, m4);
    if (ROPE) { C0 = QKMFMA(krf0, qrf, C0); C1 = QKMFMA(krf1, qrf, C1); }
    if (!grpB) { PK16U8(C0, pfA, 0); PK16U8(C1, pfA, 4); }
    WAIT_BAR0();
    if (dma_on) { if (kwave) DMA(3, 0); else DMA(1, 1); }
    ROT();
    KLOAD(sl_cur);
    WAIT_BAR1();
#define VRD2(m) do { const v2i a_ = vtr8(vp0 + vsl_ * SLOT + (m) * 1024), b_ = vtr8(vp1 + vsl_ * SLOT + (m) * 1024); vf0[2 * (m)] = a_[0]; vf0[2 * (m) + 1] = a_[1]; vf1[2 * (m)] = b_[0]; vf1[2 * (m) + 1] = b_[1]; } while (0)
#define STEP(t, PFP, PFN, GK, GV, GL) do { SBAR(); \
    const int vsl_ = sl_prev; \
    VRD2(0); VRD2(1); SBAR(); \
    C0 = QKMFMA(kf0, qf, m4); if (ROPE) C0 = QKMFMA(krf0, qrf, C0); PIN(C0); SBAR(); \
    VRD2(2); VRD2(3); SBAR(); \
    C1 = QKMFMA(kf1, qf, m4); if (ROPE) C1 = QKMFMA(krf1, qrf, C1); PIN(C1); SBAR(); \
    if (GL) { KLOAD(sl_next); } \
    { const bool mine_ = dma_on && (kwave ? (GK) : (GV)); if (mine_) DMA((t) + dlead, kwave ? sl_cur : sl_next); } \
    SBAR(); \
    lacc = PVMFMA8(PFP, ones, lacc); PIN(lacc); SBAR(); \
    PK16U8(C0, PFN, 0); PIN(PFN); SBAR(); \
    o[0] = PVMFMA8(PFP, vf0, o[0]); PIN(o[0]); SBAR(); \
    PK16U8(C1, PFN, 4); PIN(PFN); SBAR(); \
    o[1] = PVMFMA8(PFP, vf1, o[1]); PIN(o[1]); SBAR(); \
    { const bool mine_ = dma_on && (kwave ? (GK) : (GV)); if (mine_) WAIT_BAR1(); else WAIT_BAR0(); } \
    } while (0)
#define KLOADX(KF0, KF1, KRF0, KRF1, si) do { KF0 = lds128(kpa + (si) * KSLOT); KF1 = lds128(kpa + (si) * KSLOT + 1024); if (ROPE) { KRF0 = lds128(ra0 + (si) * KRSLOT); KRF1 = lds128(ra1 + (si) * KRSLOT); } } while (0)
#define STEP_B(t, PFP, PFN, KC0, KC1, KRC0, KRC1, KN0, KN1, KRN0, KRN1, GV, GL, HASPV) do { SBAR(); \
    const int vsl_ = sl_prev; \
    if (GL) { KLOADX(KN0, KN1, KRN0, KRN1, sl_next); } SBAR(); \
    if (HASPV) { lacc = PVMFMA8(PFP, ones, lacc); PIN(lacc); SBAR(); } \
    PK16U8(C0, PFN, 0); PIN(PFN); SBAR(); \
    if (HASPV) { o[0] = PVMFMA8(PFP, vf0, o[0]); PIN(o[0]); SBAR(); } \
    PK16U8(C1, PFN, 4); PIN(PFN); SBAR(); \
    if (HASPV) { o[1] = PVMFMA8(PFP, vf1, o[1]); PIN(o[1]); SBAR(); } \
    VRD2(0); VRD2(1); VRD2(2); VRD2(3); SBAR(); \
    C0 = QKMFMA(KC0, qf, m4); if (ROPE) C0 = QKMFMA(KRC0, qrf, C0); PIN(C0); SBAR(); \
    C1 = QKMFMA(KC1, qf, m4); if (ROPE) C1 = QKMFMA(KRC1, qrf, C1); PIN(C1); SBAR(); \
    if (GV) { DMA((t) + 1, sl_next); WAIT_BAR1(); } else { WAIT_BAR0(); } \
    } while (0)
#define STEP_BX(t, PFP, PFN, GV, GL, HASPV) STEP_B(t, PFP, PFN, kf0, kf1, krf0, krf1, kg0, kg1, krg0, krg1, GV, GL, HASPV)
#define STEP_BY(t, PFP, PFN, GV, GL, HASPV) STEP_B(t, PFP, PFN, kg0, kg1, krg0, krg1, kf0, kf1, krf0, krf1, GV, GL, HASPV)
    int vdrain;
    if (!grpB) {
        int t = 1;
        for (; t + 5 < NT; t += 2) {
            STEP(t, pfA, pfB, true, true, true);     ROT();
            STEP(t + 1, pfB, pfA, true, true, true); ROT();
        }
        for (; t + 1 < NT; t += 2) {
            STEP(t, pfA, pfB, (t + 3 < NT), (t + 1 < NT), (t + 1 < NT));         ROT();
            STEP(t + 1, pfB, pfA, (t + 4 < NT), (t + 2 < NT), (t + 2 < NT));     ROT();
        }
        STEP(NT - 1, pfA, pfB, false, false, false);
        vdrain = sl_cur;
    } else {
        STEP_BX(1, pfB, pfA, (2 < NT), (2 < NT), false); ROT();
        int t = 2;
        for (; t + 5 < NT; t += 2) {
            STEP_BY(t, pfA, pfB, true, true, true);     ROT();
            STEP_BX(t + 1, pfB, pfA, true, true, true); ROT();
        }
        for (; t + 1 < NT; t += 2) {
            STEP_BY(t, pfA, pfB, (t + 1 < NT), (t + 1 < NT), true);     ROT();
            STEP_BX(t + 1, pfB, pfA, (t + 2 < NT), (t + 2 < NT), true); ROT();
        }
        lacc = PVMFMA8(pfA, ones, lacc); PK16U8(C0, pfB, 0); o[0] = PVMFMA8(pfA, vf0, o[0]); PK16U8(C1, pfB, 4); o[1] = PVMFMA8(pfA, vf1, o[1]); PIN(o[1]);
        vdrain = sl_prev;
    }
    { const int vsl_ = vdrain; VRD2(0); VRD2(1); VRD2(2); VRD2(3);
      lacc = PVMFMA8(pfB, ones, lacc); o[0] = PVMFMA8(pfB, vf0, o[0]); o[1] = PVMFMA8(pfB, vf1, o[1]); }
    float rli[16];
#pragma unroll
    for (int r = 0; r < 16; ++r) rli[r] = __builtin_amdgcn_rcpf(lacc[r]);
    bf16_t* stg = (bf16_t*)(lds + LDS_OST) + wid * 2048;
#pragma unroll
    for (int r = 0; r < 16; ++r) { const int orow = crow(r, hi);
#pragma unroll
        for (int d0 = 0; d0 < 2; ++d0) stg[orow * 64 + d0 * 32 + r32] = (bf16_t)f2bf(o[d0][r] * rli[r]); }
    asm volatile("s_waitcnt lgkmcnt(0)" ::: "memory");
#pragma unroll
    for (int i = 0; i < 4; ++i) { const int row = i * 8 + (lane >> 3), ch = lane & 7; const size_t goff = (size_t)(wid * 32 + row) * ldo + ch * 8;
        const u32x4 ov = *(const u32x4*)(stg + row * 64 + ch * 8); const u32x4 gv = *(const u32x4*)(G + goff); u32x4 w;
#pragma unroll
        for (int q = 0; q < 4; ++q) { const float lo = __uint_as_float(ov[q] << 16) * __uint_as_float(gv[q] << 16), hh = __uint_as_float(ov[q] & 0xffff0000u) * __uint_as_float(gv[q] & 0xffff0000u); w[q] = cvtpk(lo, hh); }
        *(u32x4*)(O + goff) = w; }
    asm volatile("s_waitcnt lgkmcnt(0)\n\ts_barrier" ::: "memory");
#undef DMA
#undef ROT
#undef EX
#undef KLOAD
#undef VRD2
#undef STEP
#undef STEP_B
#undef KLOADX
#undef STEP_BX
#undef STEP_BY
}
#undef SBAR
#undef PIN
#undef WAIT_BAR0
#undef WAIT_BAR1
#undef QKMFMA
#undef V8
#undef V6
#undef PVMFMA8
}

#define RLX_AGENT __ATOMIC_RELAXED, __HIP_MEMORY_SCOPE_AGENT
#define XB_TMO      128
#define XB_XCNT(j)  (256  + 64 * (j))
#define XB_XSUB(j)  (1280 + 64 * (j))
#define XB_XGEN(j)  (2304 + 64 * (j))
#define XB_TOP      3328
#define XB_TOPGEN   3392
#define XCD_BAR_WORDS 3456
#define XB_SPIN_CAP (1u << 18)

__device__ __forceinline__ unsigned xb_ld(unsigned* p)              { return __hip_atomic_load(p, __ATOMIC_RELAXED, __HIP_MEMORY_SCOPE_AGENT); }
__device__ __forceinline__ unsigned xb_add(unsigned* p, unsigned v) { return __hip_atomic_fetch_add(p, v, __ATOMIC_RELAXED, __HIP_MEMORY_SCOPE_AGENT); }
__device__ __forceinline__ unsigned xb_xcc_id() { return (unsigned)__builtin_amdgcn_s_getreg((3 << 11) | 20) & 0xFu; }
#define XB_SPIN(cond, bar) do { unsigned _sp = 0; while (cond) { __builtin_amdgcn_s_sleep(1); \
    if ((++_sp & 255u) == 0u) { if (xb_ld(&(bar)[XB_TMO])) break; if (_sp > XB_SPIN_CAP) { atomicAdd(&(bar)[XB_TMO], 1u); break; } } } } while (0)

struct XcdBarrier {
    unsigned* bar; unsigned x;
    volatile LAS unsigned* st;
};

__device__ __forceinline__ XcdBarrier xcd_barrier_post(unsigned* bar, volatile LAS unsigned* st) {
    XcdBarrier b; b.bar = bar; b.x = xb_xcc_id(); b.st = st;
    if (threadIdx.x == 0) (void)xb_add(&bar[XB_XCNT(b.x)], 1u);
    return b;
}
__device__ __forceinline__ void xcd_barrier_complete(unsigned* bar, unsigned x, unsigned& nloc, unsigned& nx) {
    const unsigned G = gridDim.x * gridDim.y * gridDim.z;
    unsigned sum, cnt, mine, sp = 0u;
    for (;;) {
        sum = 0u; cnt = 0u; mine = 0u;
#pragma unroll
        for (unsigned j = 0; j < 16; ++j) { const unsigned c = xb_ld(&bar[XB_XCNT(j)]); sum += c; cnt += (c > 0u) ? 1u : 0u; mine = (j == x) ? c : mine; }
        if (sum == G) break;
        __builtin_amdgcn_s_sleep(1);
        if ((++sp & 255u) == 0u) { if (xb_ld(&bar[XB_TMO])) break; if (sp > XB_SPIN_CAP) { atomicAdd(&bar[XB_TMO], 1u); break; } }
    }
    nloc = mine > 0u ? mine : 1u; nx = cnt > 0u ? cnt : 1u;
}

__device__ __forceinline__ void xcd_barrier(const XcdBarrier& b) {
    asm volatile("s_waitcnt vmcnt(0)" ::: "memory");
    __syncthreads();
    if (threadIdx.x == 0) {
        unsigned* bar = b.bar;
        __builtin_amdgcn_s_waitcnt(0);
        unsigned nloc = b.st[0], nx = b.st[1];
        if (nloc == 0u) { xcd_barrier_complete(bar, b.x, nloc, nx); b.st[0] = nloc; b.st[1] = nx; }
        const unsigned old = xb_add(&bar[XB_XSUB(b.x)], 1u);
        const unsigned gen = old / nloc;
        if (old + 1u == (gen + 1u) * nloc) {
            __builtin_amdgcn_fence(__ATOMIC_RELEASE, "agent");
            asm volatile("s_waitcnt vmcnt(0)" ::: "memory");
            const unsigned og = xb_add(&bar[XB_TOP], 1u);
            const unsigned tg = og / nx;
            if (og + 1u == (tg + 1u) * nx) xb_add(&bar[XB_TOPGEN], 1u);
            else XB_SPIN(xb_ld(&bar[XB_TOPGEN]) == tg, bar);
            __builtin_amdgcn_fence(__ATOMIC_ACQUIRE, "agent");
            xb_add(&bar[XB_XGEN(b.x)], 1u);
            asm volatile("s_waitcnt vmcnt(0)" ::: "memory");
        } else {
            XB_SPIN(xb_ld(&bar[XB_XGEN(b.x)]) == gen, bar);
            __builtin_amdgcn_fence(__ATOMIC_ACQUIRE, "agent");
            asm volatile("s_waitcnt vmcnt(0)" ::: "memory");
        }
    }
    __syncthreads();
}


#include <hip/hip_cooperative_groups.h>
namespace cg = cooperative_groups;
constexpr int NWAVES = 8, NTHREADS = 512, LDS_BYTES = 147456, RING_BYTES = 131072;
constexpr size_t MiB = 1u << 20;
constexpr size_t WS_MOD = 1 * MiB;
constexpr size_t WS_TABA = WS_MOD + 128 * 1024;
constexpr size_t WS_TABB = WS_TABA + 32 * 1024;
constexpr size_t WS_WIN0 = 2 * MiB;
constexpr size_t WS_WOUT0 = 7 * MiB;
constexpr size_t WS_WIN1 = 9 * MiB;
constexpr size_t WS_WKVB = 13 * MiB;
constexpr size_t WS_WQB = 14 * MiB;
constexpr size_t WS_WOUT1 = 16 * MiB;
constexpr size_t WS_X1C = 18 * MiB;
constexpr size_t WS_H = 20 * MiB;
constexpr size_t WS_Q = 53 * MiB;
constexpr size_t WS_K = 86 * MiB;
constexpr size_t WS_V0 = 95 * MiB;
constexpr size_t WS_G = 120 * MiB;
constexpr size_t WS_V1 = 153 * MiB;
constexpr size_t WS_KVA = 186 * MiB;
constexpr size_t WS_QA = 195 * MiB;
constexpr size_t WS_Q1R = 207 * MiB;
constexpr size_t WS_KR = 223 * MiB;
constexpr size_t WS_SSKV = 225 * MiB;
constexpr size_t WS_SSQ = 226 * MiB;
constexpr size_t WS_SSH = 227 * MiB;
constexpr size_t WS_SSX = 229 * MiB;
constexpr size_t WS_BIAS1 = WS_MOD + 80 * 1024;
constexpr size_t WS_NWM1 = WS_MOD + 104 * 1024;
constexpr size_t WS_RINV = 230 * MiB + 512 * 1024;
constexpr size_t WS_SLAB = 231 * MiB;
constexpr size_t WS_END = 256 * MiB;
static_assert(WS_K + (size_t)NB * TK * DM * 2 <= WS_G && WS_G + (size_t)MT * DM * 2 <= WS_V1 && WS_V1 + (size_t)NB * TK * DM * 2 <= WS_KVA && WS_SSH + (size_t)ML * 32 * 4 <= WS_END, "ws map");

#ifndef ATT1_F8
#define ATT1_F8 1
#endif
#ifndef ATT0_F8
#define ATT0_F8 1
#endif
struct Args { const float* in[23]; float* out; unsigned char* ws; int ph_lo, ph_hi, coop, pad; };

DEVI void phase0(const Args& a, unsigned char* ws, LAS unsigned char* lds, int vb, int G) {
    const int tid = threadIdx.x, wave = tid >> 6, lane = tid & 63;
    float* mod = (float*)(ws + WS_MOD);
    if (vb < 96) {
        LAS float* sc = (LAS float*)lds; LAS float* red = sc + 3 * 1024;
        const int layer = vb / 48, cs = vb % 48; const float* w = a.in[layer ? 11 : 4]; const float* bb = a.in[layer ? 12 : 5];
        for (int i = tid; i < 3072; i += NTHREADS) { const int r = i >> 10, k = i & 1023; const float v = r < 2 ? a.in[1][r * 1024 + k] : a.in[3][k]; sc[i] = v / (1.f + expf(-v)); }
        __syncthreads();
        const int col = cs * 64 + lane; float a0 = 0.f, a1 = 0.f, a2 = 0.f;
#pragma unroll 8
        for (int k = wave * 128; k < wave * 128 + 128; ++k) { const float wv = w[(size_t)k * 3072 + col]; a0 += sc[k] * wv; a1 += sc[1024 + k] * wv; a2 += sc[2048 + k] * wv; }
        red[(wave * 3 + 0) * 64 + lane] = a0; red[(wave * 3 + 1) * 64 + lane] = a1; red[(wave * 3 + 2) * 64 + lane] = a2;
        __syncthreads();
        if (tid < 192) { const int r = tid >> 6; float s = 0.f;
#pragma unroll
            for (int q = 0; q < 8; ++q) s += red[(q * 3 + r) * 64 + lane];
            mod[(size_t)(layer * 3 + r) * 3072 + col] = s + bb[col]; }
        __syncthreads();
    } else if (vb < 102) {
        f32x2* tabA = (f32x2*)(ws + WS_TABA); f32x2* tabB = (f32x2*)(ws + WS_TABB);
        const int i = (vb - 96) * NTHREADS + tid;
        if (i < 128 * 16) { const int pos = i >> 4, f = i & 15; const float invf = powf(10000.f, -(float)f / 16.f); float cs_, sn_; sincos_pos((float)pos * invf, cs_, sn_); tabA[i] = (f32x2){cs_, sn_}; }
        else if (i < 128 * 24) { const int j = i - 128 * 16, pos = j >> 3, f = j & 7; const float invf = powf(10000.f, -(float)f / 8.f); float cs_, sn_; sincos_pos((float)pos * invf, cs_, sn_); tabB[j] = (f32x2){cs_, sn_}; }
    }
    if (vb < 102 || G <= 102) { if (G > 102) return; }
    struct WD { int src, K, Nsrc, Np, mode, ks; size_t dst; };
    const WD wd[6] = {{7, 1024, N_IN0, 2560, 1, -1, WS_WIN0}, {10, 1024, 1024, 1024, 0, -1, WS_WOUT0}, {14, 1024, N_IN1, N_IN1P, 2, -1, WS_WIN1},
                      {16, 256, 2048, 2048, 3, 15, WS_WKVB}, {18, 384, 1536, 2048, 4, 17, WS_WQB}, {22, 1024, 1024, 1024, 0, -1, WS_WOUT1}};
    LAS float* tl = (LAS float*)lds; int tbase = 0;
#pragma unroll
    for (int m = 0; m < 6; ++m) {
        const float* W = a.in[wd[m].src]; const float* ks = wd[m].ks >= 0 ? a.in[wd[m].ks] : nullptr; bf16_t* Bt = (bf16_t*)(ws + wd[m].dst);
        const int K = wd[m].K, Nsrc = wd[m].Nsrc, Np = wd[m].Np, npb = Np / 256, ntile = (K / 64) * npb;
        for (int it = ((vb - 102) - tbase % (G - 102) + (G - 102)) % (G - 102); it < ntile; it += (G - 102)) {
            const int kb = it / npb, pb = it % npb, k0 = 64 * kb, p0 = 256 * pb;
            const int pl = tid & 255, kh = tid >> 8; int cc = pg8::wmap(wd[m].mode, p0 + pl); if (cc >= Nsrc) cc = -1;
            float v[32];
#pragma unroll
            for (int i = 0; i < 32; ++i) { const int k = k0 + 2 * i + kh; v[i] = cc >= 0 ? W[(size_t)k * Nsrc + cc] * (ks ? ks[k] : 1.f) : 0.f; }
#pragma unroll
            for (int i = 0; i < 32; ++i) tl[pl * 65 + 2 * i + kh] = v[i];
            __syncthreads();
#pragma unroll
            for (int j = 0; j < 4; ++j) { const int q = tid + 512 * j, pr = q >> 3, c = q & 7; const LAS float* sp = tl + pr * 65 + 8 * c;
                u32x4 o; o.x = pk2(sp[0], sp[1]); o.y = pk2(sp[2], sp[3]); o.z = pk2(sp[4], sp[5]); o.w = pk2(sp[6], sp[7]);
                *(u32x4*)(Bt + (size_t)(p0 + pr) * K + k0 + 8 * c) = o; }
            __syncthreads();
        }
        tbase += ntile;
    }
}

DEVI void phase_prep(const float* xa, const float* xb, const float* nw, const float* mod, bf16_t* H, int gw, int NGW, int lane) {
    for (int row0 = gw; row0 < MT; row0 += 4 * NGW) {
        f32x4 v[4][4]; float ss[4];
#pragma unroll
        for (int q = 0; q < 4; ++q) { const int row = row0 + q * NGW; ss[q] = 0.f;
            if (row < MT) { const float* src = row < ML ? xa + (size_t)row * DM : xb + (size_t)(row - ML) * DM;
#pragma unroll
                for (int j = 0; j < 4; ++j) v[q][j] = *(const f32x4*)(src + 4 * lane + 256 * j); } }
#pragma unroll
        for (int q = 0; q < 4; ++q) { const int row = row0 + q * NGW;
            if (row < MT) {
#pragma unroll
                for (int j = 0; j < 4; ++j) ss[q] += (v[q][j].x * v[q][j].x + v[q][j].y * v[q][j].y) + (v[q][j].z * v[q][j].z + v[q][j].w * v[q][j].w); } }
#pragma unroll
        for (int o = 1; o < 64; o <<= 1) {
#pragma unroll
            for (int q = 0; q < 4; ++q) ss[q] += __shfl_xor(ss[q], o); }
#pragma unroll
        for (int q = 0; q < 4; ++q) { const int row = row0 + q * NGW;
            if (row < MT) { const int r = row < SEQ ? 0 : (row < ML ? 1 : 2); const float rinv = rsqrtf(ss[q] * (1.f / DM) + EPS);
#pragma unroll
                for (int j = 0; j < 4; ++j) { const int cidx = 4 * lane + 256 * j; const f32x4 w = *(const f32x4*)(nw + cidx);
                    const f32x4 sh = *(const f32x4*)(mod + (size_t)r * 3072 + cidx), scl = *(const f32x4*)(mod + (size_t)r * 3072 + 1024 + cidx);
                    const f32x4 h = (v[q][j] * rinv) * w * (scl + 1.f) + sh;
                    u32x2 o; o.x = pk2(h.x, h.y); o.y = pk2(h.z, h.w); *(u32x2*)(H + (size_t)row * DM + cidx) = o; } } }
    }
}

DEVI float sq4f(const f32x4 v) { return (v[0] * v[0] + v[1] * v[1]) + (v[2] * v[2] + v[3] * v[3]); }
DEVI void phase1_extras(const float* nw1, const float* mod1, const bf16_t* Win1t, float* nwm1, float* bias1, const float* ctx, float* X1c, int gw, int NGW, int lane) {
    for (int p = gw; p < N_IN1P; p += NGW) {
        const u32x4 w0 = *(const u32x4*)(Win1t + (size_t)p * DM + lane * 16), w1 = *(const u32x4*)(Win1t + (size_t)p * DM + lane * 16 + 8); float acc3[3];
#pragma unroll
        for (int r = 0; r < 3; ++r) { const float* mp = mod1 + (size_t)r * 3072 + lane * 16; const f32x4 m0 = *(const f32x4*)mp, m1 = *(const f32x4*)(mp + 4), m2 = *(const f32x4*)(mp + 8), m3 = *(const f32x4*)(mp + 12);
            const float mm[16] = {m0[0], m0[1], m0[2], m0[3], m1[0], m1[1], m1[2], m1[3], m2[0], m2[1], m2[2], m2[3], m3[0], m3[1], m3[2], m3[3]}; float a = 0.f;
#pragma unroll
            for (int i = 0; i < 8; ++i) { const unsigned ww = i < 4 ? w0[i] : w1[i - 4]; a += mm[2 * i] * __uint_as_float(ww << 16) + mm[2 * i + 1] * __uint_as_float(ww & 0xffff0000u); }
            acc3[r] = wave_sum(a); }
        if (lane == 0) { bias1[p] = acc3[0]; bias1[N_IN1P + p] = acc3[1]; bias1[2 * N_IN1P + p] = acc3[2]; }
    }
    for (int i = gw * 64 + lane; i < 3 * DM; i += NGW * 64) { const int r = i >> 10, c = i & 1023; nwm1[i] = nw1[c] * (1.f + mod1[(size_t)r * 3072 + 1024 + c]); }
}
DEVI void phase_ctxprep(const float* ctx, const float* slab, const float* gatec, float* X1c, const float* nwm1, bf16_t* H, const float* SSX, float* RINV, int gw, int NGW, int lane) {
    for (int rr = gw; rr < MC; rr += NGW) { const int R = ML + rr; float ss = 0.f;
#pragma unroll
        for (int j = 0; j < 4; ++j) { const int c = 4 * lane + 256 * j; f32x4 y = *(const f32x4*)(slab + (size_t)rr * DM + c);
#pragma unroll
            for (int ks = 1; ks < 8; ++ks) y = y + *(const f32x4*)(slab + ((size_t)ks * MC + rr) * DM + c);
            const f32x4 v = *(const f32x4*)(ctx + (size_t)rr * DM + c) + *(const f32x4*)(gatec + c) * y; *(f32x4*)(X1c + (size_t)rr * DM + c) = v;
            ss += sq4f(v); const f32x4 h = v * *(const f32x4*)(nwm1 + 2 * DM + c);
            u32x2 o; o.x = pk2(h.x, h.y); o.y = pk2(h.z, h.w); *(u32x2*)(H + (size_t)R * DM + c) = o; }
        ss = wave_sum(ss); if (lane == 0) RINV[R] = rsqrtf(ss * (1.f / DM) + EPS); }
    for (int R = gw * 64 + lane; R < ML; R += NGW * 64) { const f32x4 s0 = *(const f32x4*)(SSX + (size_t)R * 16), s1 = *(const f32x4*)(SSX + (size_t)R * 16 + 4), s2 = *(const f32x4*)(SSX + (size_t)R * 16 + 8), s3 = *(const f32x4*)(SSX + (size_t)R * 16 + 12);
        const f32x4 st = (s0 + s1) + (s2 + s3); RINV[R] = rsqrtf(((st[0] + st[1]) + (st[2] + st[3])) * (1.f / DM) + EPS); }
}

#ifdef MK_UBENCH
DEVI void ubench(int wave) {
    typedef int v8i __attribute__((ext_vector_type(8)));
    if ((MK_UBENCH & 4) && wave >= 4) return;
    v8i a, b; f32x16 acc = f32x16{}; float e[8]; float d = 0.f;
#pragma unroll
    for (int i = 0; i < 8; ++i) { a[i] = 0x38383838; b[i] = 0x38383838; e[i] = 0.001f * (float)(i + 1); }
    asm volatile("" : "+v"(a), "+v"(b));
    bf16x8 ha, hb; asm volatile("" : "=v"(ha), "=v"(hb));
    for (int it = 0; it < 1500; ++it) {
        if (MK_UBENCH & 1) { if (MK_UBENCH & 16) { acc = __builtin_amdgcn_mfma_f32_32x32x16_bf16(ha, hb, acc, 0, 0, 0); acc = __builtin_amdgcn_mfma_f32_32x32x16_bf16(ha, hb, acc, 0, 0, 0); }
                             else acc = __builtin_amdgcn_mfma_scale_f32_32x32x64_f8f6f4(a, b, acc, 0, 0, 0, 127, 0, 127); }
        if (MK_UBENCH & 2) {
#pragma unroll
            for (int i = 0; i < 8; ++i) e[i] = __builtin_amdgcn_exp2f(e[i]) * 0.5f; }
        if (MK_UBENCH & 8) {
#pragma unroll
            for (int i = 0; i < 16; ++i) asm volatile("v_add_f32 %0, %0, %1" : "+v"(e[i & 7]) : "v"(d)); }
        asm volatile("" : "+v"(acc)); __builtin_amdgcn_sched_barrier(0);
    }
#pragma unroll
    for (int i = 0; i < 8; ++i) asm volatile("" :: "v"(e[i]));
    asm volatile("" :: "v"(acc));
}
#endif
__global__ void __launch_bounds__(NTHREADS, 2) mega(Args a) {
    extern __shared__ __attribute__((aligned(16))) unsigned char lds[];
    const int tid = threadIdx.x, lane = tid & 63; const int wave = __builtin_amdgcn_readfirstlane(tid >> 6);
    const int G = gridDim.x, bx = blockIdx.x; const int vcu = (G % 8 == 0) ? (bx % 8) * (G / 8) + bx / 8 : bx;
    unsigned char* ws = a.ws; float* out = a.out;
    const float* x = a.in[0]; const float* ctx = a.in[2];
    float* mod = (float*)(ws + WS_MOD); const f32x4* tabA = (const f32x4*)(ws + WS_TABA); const f32x4* tabB = (const f32x4*)(ws + WS_TABB);
    bf16_t* H = (bf16_t*)(ws + WS_H); bf16_t* Qb = (bf16_t*)(ws + WS_Q); bf16_t* K0 = (bf16_t*)(ws + WS_K); bf16_t* V0 = (bf16_t*)(ws + WS_V0); bf16_t* K1 = (bf16_t*)(ws + WS_K);
    bf16_t* Gb = (bf16_t*)(ws + WS_G); bf16_t* V1 = (bf16_t*)(ws + WS_V1); bf16_t* KVA = (bf16_t*)(ws + WS_KVA); bf16_t* QA = (bf16_t*)(ws + WS_QA); bf16_t* Q1R = (bf16_t*)(ws + WS_Q1R);
    bf16_t* O0 = (bf16_t*)(ws + WS_V1); bf16_t* O1 = (bf16_t*)(ws + WS_H); bf16_t* KR = (bf16_t*)(ws + WS_KR); float* SSKV = (float*)(ws + WS_SSKV); float* SSQ = (float*)(ws + WS_SSQ); float* SSH = (float*)(ws + WS_SSH); float* X1c = (float*)(ws + WS_X1C); float* SSX = (float*)(ws + WS_SSX); float* BIAS1 = (float*)(ws + WS_BIAS1); float* NWM1 = (float*)(ws + WS_NWM1);
#ifdef MK_TS
#define MK_TS_SEAM (MK_TS >= 100 ? (MK_TS % 100) : MK_TS / 2)
#define MK_TS_WHAT (MK_TS % 2)
#endif
#ifdef MK_TS_SEAM
    const unsigned long long ts0 = __builtin_amdgcn_s_memrealtime(); unsigned long long ts1 = ts0, ts2 = ts0;
#endif
    const int lo = a.ph_lo, hi_ = a.ph_hi;
#ifndef ONLY_PHASE
#define ONLY_PHASE -1
#endif
#define IN(k) ((ONLY_PHASE < 0 || ONLY_PHASE == (k)) && lo <= (k) && (k) < hi_)
#ifndef MK_REP_MASK
#define MK_REP_MASK 0
#endif
#define REPS(k) (((MK_REP_MASK >> (k)) & 1) ? 2 : 1)
#ifdef MK_TS_SEAM
#define SEAM(k) do { if (IN(k) && IN((k) + 1)) { if ((k) == MK_TS_SEAM) { ts1 = __builtin_amdgcn_s_memrealtime(); if (tid == 0) { atomicMax((unsigned*)ws + 4000, (unsigned)(ts1 - ts0)); atomicMax((unsigned*)ws + 4001, ((unsigned)(ts1 - ts0) << 10) | (unsigned)bx); } } xcd_barrier(xbar); if ((k) == MK_TS_SEAM) ts2 = __builtin_amdgcn_s_memrealtime(); } } while (0)
#else
#define SEAM(k) do { if (IN(k) && IN((k) + 1)) { xcd_barrier(xbar); } } while (0)
#endif
    PG8_LAS unsigned char* ring = (PG8_LAS unsigned char*)lds;
    volatile LAS unsigned* xst = (volatile LAS unsigned*)((LAS unsigned char*)lds + RING_BYTES + 512);
    if (tid < 4) xst[tid] = 0u;
    __syncthreads();
    XcdBarrier xbar; xbar.bar = (unsigned*)ws; xbar.x = 0; xbar.st = xst;
    if (a.coop) xbar = xcd_barrier_post((unsigned*)ws, xst);
    if (a.coop == 0x7fffffff) cg::this_grid().sync();

    if (IN(0)) for (int rep_ = 0; rep_ < REPS(0); ++rep_) { phase0(a, ws, (LAS unsigned char*)lds, bx, G); } SEAM(0);
    if (IN(1)) for (int rep_ = 0; rep_ < REPS(1); ++rep_) { phase1_extras(a.in[13], mod + 3 * 3072, (const bf16_t*)(ws + WS_WIN1), NWM1, BIAS1, ctx, X1c, vcu * NWAVES + wave, G * NWAVES, lane);
        phase_prep(x, ctx, a.in[6], mod, H, vcu * NWAVES + wave, G * NWAVES, lane); } SEAM(1);
    if (IN(2)) { pg8::Gemm g{H, (const bf16_t*)(ws + WS_WIN0), MT, N_IN0, 1024}; pg8::ROrder S; S.init(0, MT / 256, N_IN0, G, bx, REPS(2));
        pg8::EpiIn0<ATT0_F8> E{a.in[8], a.in[9], tabA, K0, V0, Qb, Gb};
        pg8::gemm_phase<pg8::EpiIn0<ATT0_F8>, pg8::ROrder, true, true>(ring, g, S, E); } SEAM(2);
#ifdef MK_CLOCK_PROBE
    unsigned long long pc0 = 0, pr0 = 0, pc1 = 0, pr1 = 0;
    if (IN(3)) { pc0 = __builtin_readcyclecounter(); pr0 = __builtin_amdgcn_s_memrealtime(); }
#endif
    if (IN(3)) for (int rep_ = 0; rep_ < REPS(3); ++rep_) {
        const int xg = vcu >> 5, c = vcu & 31, b = xg >> 2, kvh = xg & 3; const size_t kbase = (size_t)b * TK * 256 + kvh * 64;
#if ATT0_F8
        const unsigned char* K8 = (const unsigned char*)K0 + (size_t)b * TK * 128 + kvh * 32; const unsigned char* V8 = (const unsigned char*)V0 + kbase;
        for (int i = 0; i < 4; ++i) { const int h = kvh * 4 + i; const size_t q0 = ((size_t)b * SEQ + c * 256) * DM + h * 64;
            af8::attn_unit<0>(Qb + q0, DM, nullptr, nullptr, K8, 128, nullptr, V8, 256, TK / 64, O0 + q0, Gb + q0, DM, (char*)lds); }
        if (c < 4) { const int h = kvh * 4 + c; const size_t q0 = ((size_t)ML + b * CTXL) * DM + h * 64;
            af8::attn_unit<0>(Qb + q0, DM, nullptr, nullptr, K8, 128, nullptr, V8, 256, CTXL / 64, O0 + q0, Gb + q0, DM, (char*)lds); }
#else
        for (int i = 0; i < 4; ++i) { const int h = kvh * 4 + i; const size_t q0 = ((size_t)b * SEQ + c * 256) * DM + h * 64;
            afast::attn_unit<0>(Qb + q0, DM, nullptr, nullptr, K0 + kbase, 256, nullptr, V0 + kbase, 256, TK / 64, O0 + q0, Gb + q0, DM, (char*)lds); }
        if (c < 4) { const int h = kvh * 4 + c; const size_t q0 = ((size_t)ML + b * CTXL) * DM + h * 64;
            afast::attn_unit<0>(Qb + q0, DM, nullptr, nullptr, K0 + kbase, 256, nullptr, V0 + kbase, 256, CTXL / 64, O0 + q0, Gb + q0, DM, (char*)lds); }
#endif
    } SEAM(3);
#ifdef MK_CLOCK_PROBE
    if (IN(3)) { pc1 = __builtin_readcyclecounter(); pr1 = __builtin_amdgcn_s_memrealtime(); }
#endif
    if (IN(4)) {
        { pg8::Gemm g{O0, (const bf16_t*)(ws + WS_WOUT0), ML, 1024, 1024, 0}; pg8::ROrder S; S.init(0, ML / 256, 1024, G, bx, REPS(4));
          pg8::EpiOutF E{x, out, mod + 2048, NWM1, H, SSX};
          pg8::gemm_phase<pg8::EpiOutF, pg8::ROrder, true, true>(ring, g, S, E); }
        { pg8::Gemm g{O0, (const bf16_t*)(ws + WS_WOUT0), MT, 1024, 1024, 128}; pg8::CtxSplitOrder S; S.init(bx, 8, 128);
          pg8::EpiOutSlab E{(float*)(ws + WS_SLAB), 128};
          pg8::gemm_phase<pg8::EpiOutSlab, pg8::CtxSplitOrder, true, true>(ring, g, S, E); }
    } SEAM(4);
    if (IN(5)) { phase_ctxprep(ctx, (const float*)(ws + WS_SLAB), mod + 2048 + 2 * 3072, X1c, NWM1, H, SSX, (float*)(ws + WS_RINV), vcu * NWAVES + wave, G * NWAVES, lane); } SEAM(5);
    if (IN(6)) { pg8::Gemm g{H, (const bf16_t*)(ws + WS_WIN1), MT, N_IN1P, 1024}; pg8::In1Order S; S.init(G, bx);
        pg8::EpiIn1<ATT1_F8> E{a.in[21], tabB, KVA, SSKV, QA, SSQ, KR, Gb, (const float*)(ws + WS_RINV), BIAS1};
        pg8::gemm_phase<pg8::EpiIn1<ATT1_F8>, pg8::In1Order, true, true>(ring, g, S, E); } SEAM(6);
    if (IN(7)) {
        { pg8::Gemm g{KVA, (const bf16_t*)(ws + WS_WKVB), MT, 2048, 256}; pg8::ROrder S; S.init(0, MT / 256, 2048, G, bx, REPS(7));
          pg8::EpiKvb<ATT1_F8> E{SSKV, a.in[20], K1, V1};
          pg8::gemm_phase<pg8::EpiKvb<ATT1_F8>, pg8::ROrder, true, true>(ring, g, S, E); }
        { pg8::Gemm g{QA, (const bf16_t*)(ws + WS_WQB), ML, 2048, 384}; pg8::ROrder S; S.init(0, ML / 256, 2048, G, bx, REPS(7));
          pg8::EpiQb E{SSQ, a.in[19], tabB, Qb, Q1R, SSH};
          pg8::gemm_phase<pg8::EpiQb, pg8::ROrder, true, true>(ring, g, S, E); }
    } SEAM(7);
    if (IN(8)) for (int rep_ = 0; rep_ < REPS(8); ++rep_) {
        const int xg = vcu >> 5, c = vcu & 31;
        for (int i = 0; i < 4; ++i) { const int s = xg + 8 * i, b = s >> 4, h = s & 15; const size_t row0 = (size_t)b * SEQ + c * 256, q0 = row0 * DM + h * 64;
#if ATT1_F8
            af8::attn_unit<1>(Qb + q0, DM, Q1R + row0 * 512 + h * 32, SSH + (row0 * 16 + h) * 2, (const unsigned char*)K1 + (size_t)b * TK * 512 + h * 32, 512, (const unsigned char*)KR + (size_t)b * TK * 16,
                              (const unsigned char*)V1 + (size_t)b * TK * DM + h * 64, DM, TK / 64, O1 + q0, Gb + q0, DM, (char*)lds); }
#else
            afast::attn_unit<1>(Qb + q0, DM, Q1R + row0 * 512 + h * 32, SSH + (row0 * 16 + h) * 2, K1 + (size_t)b * TK * DM + h * 64, DM, KR + (size_t)b * TK * 32,
                                V1 + (size_t)b * TK * DM + h * 64, DM, TK / 64, O1 + q0, Gb + q0, DM, (char*)lds); }
#endif
    } SEAM(8);
    if (IN(9)) { pg8::Gemm g{O1, (const bf16_t*)(ws + WS_WOUT1), ML, 1024, 1024}; pg8::ROrder S; S.init(0, ML / 256, 1024, G, bx);
        pg8::EpiOut E{out, nullptr, out, nullptr, mod + 3 * 3072 + 2048};
        pg8::gemm_phase<pg8::EpiOut, pg8::ROrder, true, true>(ring, g, S, E); }
#ifdef MK_TS_SEAM
    if (bx == 0 && wave == 0) { const unsigned long long tend_ = __builtin_amdgcn_s_memrealtime(); const unsigned long long w = MK_TS == 99 ? (tend_ - ts0) : MK_TS >= 100 ? (MK_TS >= 200 ? (unsigned long long)(((unsigned*)ws)[4001] & 1023u) * 100ull : (unsigned long long)((unsigned*)ws)[4000]) : (MK_TS_WHAT ? (ts2 - ts1) * 10ull : (ts1 - ts0)); const unsigned long long t0 = __builtin_amdgcn_s_memrealtime(); while (__builtin_amdgcn_s_memrealtime() - t0 < w) __builtin_amdgcn_s_sleep(8); }
#endif
#ifdef MK_UBENCH
    ubench(wave);
#endif
#ifdef MK_CLOCK_PROBE
    if (bx == 0 && wave == 0) { const unsigned long long dc = pc1 - pc0, dr = pr1 - pr0;
        const unsigned long long mhz = dr ? (dc * 100ull) / dr : 0ull;
        const unsigned long long t0 = __builtin_amdgcn_s_memrealtime(); const unsigned long long wait_ticks = mhz * 10ull;
        while (__builtin_amdgcn_s_memrealtime() - t0 < wait_ticks) __builtin_amdgcn_s_sleep(8); }
#endif
#undef IN
#undef SEAM
}

constexpr int NPHASE = 10;
#ifndef MK_ONE_LAUNCH
#define MK_ONE_LAUNCH 1
#endif
extern "C" void kernel_launch(void* const* d_in, const int* in_sizes, int n_in, void* d_out, int out_size, void* d_ws, size_t ws_size, hipStream_t stream) {
    static int grid = 0;
    if (grid == 0) {
        if (n_in != 23 || out_size != ML * DM || ws_size < WS_END) { fprintf(stderr, "kernel_launch: unexpected shapes n_in %d out %d ws %zu\n", n_in, out_size, ws_size); grid = -1; return; }
        int dev = 0, cus = 0, per_cu = 0;
        if (hipGetDevice(&dev) != hipSuccess || hipDeviceGetAttribute(&cus, hipDeviceAttributeMultiprocessorCount, dev) != hipSuccess) { grid = -1; return; }
        if (hipFuncSetAttribute((const void*)mega, hipFuncAttributeMaxDynamicSharedMemorySize, LDS_BYTES) != hipSuccess) { fprintf(stderr, "kernel_launch: hipFuncSetAttribute failed\n"); grid = -1; return; }
        if (hipOccupancyMaxActiveBlocksPerMultiprocessor(&per_cu, (const void*)mega, NTHREADS, LDS_BYTES) != hipSuccess || per_cu < 1) { fprintf(stderr, "kernel_launch: occupancy query says %d\n", per_cu); grid = -1; return; }
        grid = cus;
        if (grid != 256) fprintf(stderr, "kernel_launch: %d CUs (built for 256)\n", grid);
    }
    if (grid < 0) return;
    if (hipMemsetAsync(d_ws, 0, 16384, stream) != hipSuccess) { fprintf(stderr, "kernel_launch: memset failed\n"); return; }
    Args a{};
    for (int i = 0; i < 23; ++i) a.in[i] = (const float*)d_in[i];
    a.out = (float*)d_out; a.ws = (unsigned char*)d_ws;
#if MK_ONE_LAUNCH
    a.ph_lo = 0; a.ph_hi = NPHASE; a.coop = 1;
    void* args[] = {&a};
#ifdef MK_PLAIN_LAUNCH
    (void)args; hipLaunchKernelGGL(mega, dim3(grid), dim3(NTHREADS), LDS_BYTES, stream, a);
#else
    const hipError_t e = hipLaunchCooperativeKernel((const void*)mega, dim3(grid), dim3(NTHREADS), args, LDS_BYTES, stream);
    if (e != hipSuccess) fprintf(stderr, "kernel_launch: cooperative launch failed: %s (grid %d)\n", hipGetErrorString(e), grid);
#endif
#else
    for (int p = 0; p < NPHASE; ++p) { a.ph_lo = p; a.ph_hi = p + 1; a.coop = 0; hipLaunchKernelGGL(mega, dim3(grid), dim3(NTHREADS), LDS_BYTES, stream, a); }
    const hipError_t le = hipPeekAtLastError();
    if (le != hipSuccess) fprintf(stderr, "kernel_launch: launch failed: %s\n", hipGetErrorName(le));
#endif
}
```

```cpp
#include <hip/hip_runtime.h>
#include <hip/hip_bf16.h>
#include <cstdio>
#include <cstdint>

#define DEVI __device__ __forceinline__
#define LAS __attribute__((address_space(3)))
#define GAS __attribute__((address_space(1)))

constexpr int NB = 2, SEQ = 8192, DM = 1024, CTXL = 256, TK = SEQ + CTXL;
constexpr int ML = NB * SEQ, MC = NB * CTXL, MT = ML + MC;
constexpr int GRIDW = 64;
constexpr float EPS = 1e-6f;
constexpr float LOG2E = 1.4426950408889634f;
constexpr int N_IN0 = 2560, N_IN1 = 1696, N_IN1P = 1792;
constexpr float C2_GQA = 0.125f * LOG2E;
constexpr float C2_MLA = 0.10206207261596575f * LOG2E;

typedef unsigned short bf16_t;
typedef short bf16x8 __attribute__((ext_vector_type(8)));
typedef short s16x4 __attribute__((ext_vector_type(4)));
typedef float f32x4 __attribute__((ext_vector_type(4)));
typedef float f32x2 __attribute__((ext_vector_type(2)));
typedef float f32x16 __attribute__((ext_vector_type(16)));
typedef unsigned u32x4 __attribute__((ext_vector_type(4)));
typedef unsigned u32x2 __attribute__((ext_vector_type(2)));

DEVI float bf2f(bf16_t v) { return __uint_as_float((unsigned)v << 16); }
DEVI unsigned f2bf(float f) { unsigned u = __float_as_uint(f); return (u + 0x7fffu + ((u >> 16) & 1u)) >> 16; }
DEVI unsigned pk2(float lo, float hi) { return f2bf(lo) | (f2bf(hi) << 16); }
DEVI float wave_sum(float v) {
#pragma unroll
    for (int o = 1; o < 64; o <<= 1) v += __shfl_xor(v, o);
    return v;
}
DEVI float silu_f(float v) { return v / (1.f + __expf(-v)); }
namespace pg8 {
#define PG8_LAS __attribute__((address_space(3)))
typedef unsigned short bf16_t;
typedef short bf16x8 __attribute__((ext_vector_type(8)));
typedef float f32x4 __attribute__((ext_vector_type(4)));
typedef unsigned u32x4 __attribute__((ext_vector_type(4)));
constexpr int BM = 256, BK = 64, HALF = 128, HTB = HALF * BK * 2  , STAGE_BYTES = 8 * HTB, NXCD = 8, WGM = 8;

__host__ __device__ __forceinline__ int lds_byte(int r, int c) { const int st = (r >> 4) * 2 + (c >> 5), rr = r & 15, cc = c & 31, ob = rr * 64 + cc * 2; return st * 1024 + (ob ^ (((ob >> 9) & 1) << 5)); }
__host__ __device__ __forceinline__ void stage_rc(int b, int& R, int& C) { const int st = b / 1024, sb = b % 1024, swz = sb ^ (((sb >> 9) & 1) << 5); R = (st >> 1) * 16 + swz / 64; C = (st & 1) * 32 + (swz % 64) / 2; }
__host__ __device__ __forceinline__ int perm32(int rho) { const int n = rho >> 4, i = rho & 15; return 8 * (i >> 2) + 4 * n + (i & 3); }

struct Unit { int pm, pn, ko; };
struct Gemm { const bf16_t* A; const bf16_t* Bt; int M, N, K, Kloop; };

struct StaticOrder {
    int nM, nN, nwg, G, c;
    __host__ __device__ void init(int M, int N, int G_, int c_) { nM = M / BM; nN = N / BM; nwg = nM * nN; G = G_; c = c_; }
    __host__ __device__ bool next(int i, Unit& u) const {
        const long L = (long)i * G + c; if (L >= nwg) return false;
        int wgid = (int)L; { const int q = nwg / NXCD, r = nwg % NXCD, xcd = wgid % NXCD, off = wgid / NXCD; wgid = (xcd < r ? xcd * (q + 1) : r * (q + 1) + (xcd - r) * q) + off; }
        const int nig = WGM * nN, gid = wgid / nig, fm = gid * WGM, gsz = (nM - fm) < WGM ? (nM - fm) : WGM;
        u.pm = fm + ((wgid % nig) % gsz); u.pn = (wgid % nig) / gsz; u.ko = 0; return true;
    }
    __device__ __forceinline__ void a_ready(const Unit&) const {}
    __device__ __forceinline__ void done(const Unit&) const {}
};


struct ROrder {
    int pm0, nM, nN, nwg, G, c, rep;
    __host__ __device__ void init(int pm0_, int npm, int N, int G_, int c_, int rep_ = 1) { pm0 = pm0_; nM = npm; nN = N / BM; nwg = nM * nN; G = G_; c = c_; rep = rep_; }
    __host__ __device__ bool next(int i, Unit& u) const {
        const long L = (long)i * G + c; if (L >= (long)nwg * rep) return false;
        int wgid = (int)(L % nwg); { const int q = nwg / NXCD, r = nwg % NXCD, xcd = wgid % NXCD, off = wgid / NXCD; wgid = (xcd < r ? xcd * (q + 1) : r * (q + 1) + (xcd - r) * q) + off; }
        const int nig = WGM * nN, gid = wgid / nig, fm = gid * WGM, gsz = (nM - fm) < WGM ? (nM - fm) : WGM;
        u.pm = pm0 + fm + ((wgid % nig) % gsz); u.pn = (wgid % nig) / gsz; u.ko = 0; return true;
    }
    __device__ __forceinline__ void a_ready(const Unit&) const {}
    __device__ __forceinline__ void done(const Unit&) const {}
};

struct EpiF32 {
    static constexpr bool PERM = true, AFTER_DRAIN = false;
    float* O; int ldc; int pmbase;
    __device__ __forceinline__ void operator()(const f32x4 (&acc)[2][2][4][2], const Unit& u, int wr, int wc, int fr, int fq) const {
        const int row0 = (u.pm - pmbase) * BM + wr * 64 + fr, col0 = u.pn * BM + wc * 32 + 8 * fq;
#pragma unroll
        for (int ai = 0; ai < 2; ++ai)
#pragma unroll
            for (int m = 0; m < 4; ++m) { float* rowp = O + (size_t)(row0 + ai * HALF + m * 16) * ldc + col0;
#pragma unroll
                for (int bj = 0; bj < 2; ++bj) { *(f32x4*)(rowp + bj * HALF) = acc[ai][bj][m][0]; *(f32x4*)(rowp + bj * HALF + 4) = acc[ai][bj][m][1]; } }
    }
};

DEVI unsigned cvt_pk_bf16(float lo, float hi) { unsigned r; asm volatile("v_cvt_pk_bf16_f32 %0, %1, %2" : "=v"(r) : "v"(lo), "v"(hi)); return r; }
DEVI u32x4 pack8(const f32x4 a, const f32x4 b) { u32x4 w; w.x = cvt_pk_bf16(a[0], a[1]); w.y = cvt_pk_bf16(a[2], a[3]); w.z = cvt_pk_bf16(b[0], b[1]); w.w = cvt_pk_bf16(b[2], b[3]); return w; }
DEVI u32x2 pack8_fp8(const f32x4 a, const f32x4 b) { int w0 = 0, w1 = 0; w0 = __builtin_amdgcn_cvt_pk_fp8_f32(a[0], a[1], w0, false); w0 = __builtin_amdgcn_cvt_pk_fp8_f32(a[2], a[3], w0, true);
    w1 = __builtin_amdgcn_cvt_pk_fp8_f32(b[0], b[1], w1, false); w1 = __builtin_amdgcn_cvt_pk_fp8_f32(b[2], b[3], w1, true); return (u32x2){(unsigned)w0, (unsigned)w1}; }
DEVI unsigned pack8_fp4(const f32x4 a, const f32x4 b) { unsigned w; asm volatile("" : "=v"(w)); w = __builtin_amdgcn_cvt_scalef32_pk_fp4_f32(w, a[0], a[1], 1.0f, 0); w = __builtin_amdgcn_cvt_scalef32_pk_fp4_f32(w, a[2], a[3], 1.0f, 1);
    w = __builtin_amdgcn_cvt_scalef32_pk_fp4_f32(w, b[0], b[1], 1.0f, 2); w = __builtin_amdgcn_cvt_scalef32_pk_fp4_f32(w, b[2], b[3], 1.0f, 3); return w; }
DEVI float quad_sum(float s) { s += __shfl_xor(s, 16); s += __shfl_xor(s, 32); return s; }
DEVI float sq4(const f32x4 v) { return (v[0] * v[0] + v[1] * v[1]) + (v[2] * v[2] + v[3] * v[3]); }
DEVI f32x4 silu4(const f32x4 v) { f32x4 o; o[0] = silu_f(v[0]); o[1] = silu_f(v[1]); o[2] = silu_f(v[2]); o[3] = silu_f(v[3]); return o; }
DEVI int key_slot(int R) { return R < ML ? (R >> 13) * TK + CTXL + (R & (SEQ - 1)) : ((R - ML) >> 8) * TK + ((R - ML) & 255); }
DEVI void rot4(f32x4& x1, f32x4& x2, const f32x4 cs01, const f32x4 cs23) {
    const f32x4 c = {cs01[0], cs01[2], cs23[0], cs23[2]}, s = {cs01[1], cs01[3], cs23[1], cs23[3]};
    const f32x4 a = x1 * c - x2 * s, b = x2 * c + x1 * s; x1 = a; x2 = b;
}

DEVI int drope32(int i) { const int fq = i >> 3, n = (i >> 2) & 1, j = i & 3; return 16 * (fq >> 1) + 8 * n + 4 * (fq & 1) + j; }
DEVI int wmap(int mode, int p) {
    const int pn = p >> 8, q = p & 255, bj = q >> 7, wc = (q >> 5) & 3, i = q & 31;
    switch (mode) {
    case 1: {
        if (pn == 0 || (pn >= 2 && pn <= 5)) { const int fq = i >> 3, n = (i >> 2) & 1, j = i & 3; return 256 * pn + 64 * wc + 32 * bj + 16 * n + 4 * fq + j; }
        return p; }
    case 2: {
        if (pn == 0) return q;
        if (pn == 1) return 288 + q;
        if (pn == 2) { if (wc < 2) return 288 + 256 + 64 * wc + 32 * bj + i; if (wc == 2 && bj == 0) return 256 + drope32(i); return -1; }
        return 672 + 256 * (pn - 3) + q; }
    case 3: { const int head = 2 * pn + (wc >> 1), type = wc & 1; return 128 * head + 64 * type + 32 * bj + i; }
    case 4: { const int head = 2 * pn + (wc >> 1), type = wc & 1; if (type == 0) return 96 * head + 32 * bj + i; return bj == 0 ? 96 * head + 64 + drope32(i) : -1; }
    default: return p;
    }
}

template <bool F8> struct EpiIn0 {
    static constexpr bool PERM = true, AFTER_DRAIN = false;
    const float* qn; const float* kn; const f32x4* tabA; bf16_t* K0; bf16_t* V0; bf16_t* Q0; bf16_t* G0;
    __device__ __forceinline__ void operator()(const f32x4 (&acc)[2][2][4][2], const Unit& u, int wr, int wc, int fr_, int fq_) const {
        int fr = fr_, fq = fq_; asm volatile("" : "+v"(fr), "+v"(fq));
        const int pn = u.pn; const bool lat = u.pm < ML / BM;
        if (pn == 0 || (pn >= 2 && pn <= 5)) {
            const float* wsrc = pn == 0 ? kn : qn; const float outs = pn == 0 ? (F8 ? 2.f : 1.f) : (F8 ? C2_GQA * 8.f : C2_GQA);
            f32x4 wv[2][2];
#pragma unroll
            for (int bj = 0; bj < 2; ++bj)
#pragma unroll
                for (int n = 0; n < 2; ++n) wv[bj][n] = *(const f32x4*)(wsrc + 32 * bj + 16 * n + 4 * fq) * outs;
#pragma unroll
            for (int ai = 0; ai < 2; ++ai)
#pragma unroll
                for (int m = 0; m < 4; ++m) {
                    const int R = u.pm * BM + ai * HALF + wr * 64 + m * 16 + fr;
                    f32x4 x[2][2]; float ss = 0.f;
#pragma unroll
                    for (int bj = 0; bj < 2; ++bj)
#pragma unroll
                        for (int n = 0; n < 2; ++n) { x[bj][n] = acc[ai][bj][m][n]; ss += sq4(x[bj][n]); }
                    const float rinv = rsqrtf(quad_sum(ss) * (1.f / 64.f) + EPS);
#pragma unroll
                    for (int bj = 0; bj < 2; ++bj)
#pragma unroll
                        for (int n = 0; n < 2; ++n) x[bj][n] = x[bj][n] * rinv * wv[bj][n];
                    if (lat) { const int t = R & (SEQ - 1), trow = t >> 6, tcol = t & 63;
                        const f32x4* tr = tabA + (trow * 16 + 4 * fq) / 2; const f32x4* tc = tabA + (tcol * 16 + 4 * fq) / 2;
                        rot4(x[0][0], x[0][1], tr[0], tr[1]); rot4(x[1][0], x[1][1], tc[0], tc[1]); }
                    if (F8 && pn == 0) { unsigned char* dst = (unsigned char*)K0 + (size_t)key_slot(R) * 128 + wc * 32 + 4 * fq;
                        *(unsigned*)dst = pack8_fp4(x[0][0], x[0][1]); *(unsigned*)(dst + 16) = pack8_fp4(x[1][0], x[1][1]); }
                    else if (pn == 0) { bf16_t* dst = K0 + (size_t)key_slot(R) * 256 + wc * 64 + 8 * fq;
                        *(u32x4*)dst = pack8(x[0][0], x[0][1]); *(u32x4*)(dst + 32) = pack8(x[1][0], x[1][1]); }
                    else { bf16_t* dst = Q0 + (size_t)R * DM + ((pn - 2) * 4 + wc) * 64 + 8 * fq;
                        *(u32x4*)dst = pack8(x[0][0], x[0][1]); *(u32x4*)(dst + 32) = pack8(x[1][0], x[1][1]); }
                }
        } else if (pn == 1) {
#pragma unroll
            for (int ai = 0; ai < 2; ++ai)
#pragma unroll
                for (int m = 0; m < 4; ++m) { const int R = u.pm * BM + ai * HALF + wr * 64 + m * 16 + fr;
                    if (F8) { unsigned char* dst = (unsigned char*)V0 + (size_t)key_slot(R) * 256 + wc * 32 + 8 * fq;
#pragma unroll
                        for (int bj = 0; bj < 2; ++bj) *(u32x2*)(dst + bj * HALF) = pack8_fp8(acc[ai][bj][m][0], acc[ai][bj][m][1]); }
                    else { bf16_t* dst = V0 + (size_t)key_slot(R) * 256 + wc * 32 + 8 * fq;
#pragma unroll
                        for (int bj = 0; bj < 2; ++bj) *(u32x4*)(dst + bj * HALF) = pack8(acc[ai][bj][m][0], acc[ai][bj][m][1]); } }
        } else {
#pragma unroll
            for (int ai = 0; ai < 2; ++ai)
#pragma unroll
                for (int m = 0; m < 4; ++m) { const int R = u.pm * BM + ai * HALF + wr * 64 + m * 16 + fr; bf16_t* dst = G0 + (size_t)R * DM + (pn - 6) * BM + wc * 32 + 8 * fq;
#pragma unroll
                    for (int bj = 0; bj < 2; ++bj) *(u32x4*)(dst + bj * HALF) = pack8(silu4(acc[ai][bj][m][0]), silu4(acc[ai][bj][m][1])); }
        }
    }
};

struct EpiOut {
    static constexpr bool PERM = true, AFTER_DRAIN = false;
    const float* baseL; const float* baseC; float* dstL; float* dstC; const float* gate;
    __device__ __forceinline__ void operator()(const f32x4 (&acc)[2][2][4][2], const Unit& u, int wr, int wc, int fr_, int fq_) const {
        int fr = fr_, fq = fq_; asm volatile("" : "+v"(fr), "+v"(fq));
        const int col0 = u.pn * BM + wc * 32 + 8 * fq;
#pragma unroll
        for (int ai = 0; ai < 2; ++ai)
#pragma unroll
            for (int m = 0; m < 4; ++m) { const int R = u.pm * BM + ai * HALF + wr * 64 + m * 16 + fr; const int r = R < SEQ ? 0 : (R < ML ? 1 : 2);
                const float* b = R < ML ? baseL + (size_t)R * DM : baseC + (size_t)(R - ML) * DM; float* d = R < ML ? dstL + (size_t)R * DM : dstC + (size_t)(R - ML) * DM;
                const float* g = gate + (size_t)r * 3072;
#pragma unroll
                for (int bj = 0; bj < 2; ++bj)
#pragma unroll
                    for (int n = 0; n < 2; ++n) { const int c = col0 + bj * HALF + 4 * n; *(f32x4*)(d + c) = *(const f32x4*)(b + c) + *(const f32x4*)(g + c) * acc[ai][bj][m][n]; } }
    }
};

struct EpiOutF {
    static constexpr bool PERM = true, AFTER_DRAIN = false;
    const float* base; float* dst; const float* gate; const float* nwm; bf16_t* Hn; float* SSX;
    __device__ __forceinline__ void operator()(const f32x4 (&acc)[2][2][4][2], const Unit& u, int wr, int wc, int fr_, int fq_) const {
        int fr = fr_, fq = fq_; asm volatile("" : "+v"(fr), "+v"(fq));
        const int col0 = u.pn * BM + wc * 32 + 8 * fq;
#pragma unroll
        for (int ai = 0; ai < 2; ++ai)
#pragma unroll
            for (int m = 0; m < 4; ++m) { const int R = u.pm * BM + ai * HALF + wr * 64 + m * 16 + fr; const int r = R < SEQ ? 0 : 1;
                asm volatile("" ::: "memory");
                const float* b = base + (size_t)R * DM; float* d = dst + (size_t)R * DM; const float* g = gate + (size_t)r * 3072; const float* nw = nwm + (size_t)r * 1024; float ss = 0.f;
#pragma unroll
                for (int bj = 0; bj < 2; ++bj) { const int c = col0 + bj * HALF;
                    const f32x4 x0 = *(const f32x4*)(b + c) + *(const f32x4*)(g + c) * acc[ai][bj][m][0], x1 = *(const f32x4*)(b + c + 4) + *(const f32x4*)(g + c + 4) * acc[ai][bj][m][1];
                    *(f32x4*)(d + c) = x0; *(f32x4*)(d + c + 4) = x1; ss += sq4(x0) + sq4(x1);
                    *(u32x4*)(Hn + (size_t)R * DM + c) = pack8(x0 * *(const f32x4*)(nw + c), x1 * *(const f32x4*)(nw + c + 4)); }
                ss = quad_sum(ss); if (fq == 0) SSX[(size_t)R * 16 + u.pn * 4 + wc] = ss; }
    }
};
struct EpiOutSlab {
    static constexpr bool PERM = true, AFTER_DRAIN = false;
    float* slab; int klen;
    __device__ __forceinline__ void operator()(const f32x4 (&acc)[2][2][4][2], const Unit& u, int wr, int wc, int fr_, int fq_) const {
        int fr = fr_, fq = fq_; asm volatile("" : "+v"(fr), "+v"(fq));
        const int col0 = u.pn * BM + wc * 32 + 8 * fq; float* sb = slab + (size_t)(u.ko / klen) * MC * DM;
#pragma unroll
        for (int ai = 0; ai < 2; ++ai)
#pragma unroll
            for (int m = 0; m < 4; ++m) { const int R = u.pm * BM + ai * HALF + wr * 64 + m * 16 + fr; float* d = sb + (size_t)(R - ML) * DM + col0;
#pragma unroll
                for (int bj = 0; bj < 2; ++bj) { *(f32x4*)(d + bj * HALF) = acc[ai][bj][m][0]; *(f32x4*)(d + bj * HALF + 4) = acc[ai][bj][m][1]; } }
    }
};
struct CtxSplitOrder {
    int c, KS, klen;
    __host__ __device__ void init(int c_, int KS_, int klen_) { c = c_; KS = KS_; klen = klen_; }
    __host__ __device__ bool next(int i, Unit& u) const { if (i > 0 || c >= 8 * KS) return false; const int t = c / KS; u.pm = ML / BM + (t >> 2); u.pn = t & 3; u.ko = (c % KS) * klen; return true; }
    __device__ __forceinline__ void a_ready(const Unit&) const {}
    __device__ __forceinline__ void done(const Unit&) const {}
};

template <bool F8> struct EpiIn1 {
    static constexpr bool PERM = true, AFTER_DRAIN = false;
    const float* krn; const f32x4* tabB; bf16_t* KVA; float* SSKV; bf16_t* QA; float* SSQ; bf16_t* KR; bf16_t* G1; const float* SSX; const float* bias;
    __device__ __forceinline__ void xrow(const f32x4 (&acc)[2][2][4][2], int ai, int m, int R, int pcol0, f32x4 (&x)[2][2]) const {
        const float rinv = SSX[R];
        const float* bp = bias + (size_t)(R < SEQ ? 0 : (R < ML ? 1 : 2)) * N_IN1P + pcol0;
#pragma unroll
        for (int bj = 0; bj < 2; ++bj)
#pragma unroll
            for (int n = 0; n < 2; ++n) x[bj][n] = acc[ai][bj][m][n] * rinv + *(const f32x4*)(bp + bj * HALF + 4 * n);
    }
    __device__ __forceinline__ void operator()(const f32x4 (&acc)[2][2][4][2], const Unit& u, int wr, int wc, int fr_, int fq_) const {
        int fr = fr_, fq = fq_; asm volatile("" : "+v"(fr), "+v"(fq));
        const int pn = u.pn; const bool lat = u.pm < ML / BM; const int pcol0 = pn * BM + wc * 32 + 8 * fq;
        if (pn >= 3) {
#pragma unroll
            for (int ai = 0; ai < 2; ++ai)
#pragma unroll
                for (int m = 0; m < 4; ++m) { const int R = u.pm * BM + ai * HALF + wr * 64 + m * 16 + fr; bf16_t* dst = G1 + (size_t)R * DM + (pn - 3) * BM + wc * 32 + 8 * fq;
                    asm volatile("" ::: "memory"); f32x4 x[2][2]; xrow(acc, ai, m, R, pcol0, x);
#pragma unroll
                    for (int bj = 0; bj < 2; ++bj) *(u32x4*)(dst + bj * HALF) = pack8(silu4(x[bj][0]), silu4(x[bj][1])); }
        } else if (pn == 2 && wc == 2) {
            f32x4 wv[2];
#pragma unroll
            for (int n = 0; n < 2; ++n) wv[n] = *(const f32x4*)(krn + 16 * (fq >> 1) + 8 * n + 4 * (fq & 1));
#pragma unroll
            for (int ai = 0; ai < 2; ++ai)
#pragma unroll
                for (int m = 0; m < 4; ++m) { const int R = u.pm * BM + ai * HALF + wr * 64 + m * 16 + fr;
                    asm volatile("" ::: "memory"); f32x4 xx[2][2]; xrow(acc, ai, m, R, pcol0, xx); f32x4 x0 = xx[0][0], x1 = xx[0][1];
                    const float rinv = rsqrtf(quad_sum(sq4(x0) + sq4(x1)) * (1.f / 32.f) + EPS);
                    x0 = x0 * rinv * wv[0]; x1 = x1 * rinv * wv[1];
                    if (lat) { const int t = R & (SEQ - 1); const int pos = (fq >> 1) ? (t & 63) : (t >> 6); const f32x4* tp = tabB + (pos * 8 + 4 * (fq & 1)) / 2; rot4(x0, x1, tp[0], tp[1]); }
                    if (F8) *(unsigned*)((unsigned char*)KR + (size_t)key_slot(R) * 16 + 4 * fq) = pack8_fp4(x0 * 2.f, x1 * 2.f); else *(u32x4*)(KR + (size_t)key_slot(R) * 32 + 8 * fq) = pack8(x0, x1); }
        } else if (pn == 2 && wc == 3) {
        } else if (pn == 0 || lat) {
            bf16_t* base; float* ssb; int ld, cbase, nss, iss;
            if (pn == 0) { base = KVA; ld = 256; cbase = wc * 32; ssb = SSKV; nss = 4; iss = wc; }
            else if (pn == 1) { base = QA; ld = 384; cbase = wc * 32; ssb = SSQ; nss = 6; iss = wc; }
            else { base = QA; ld = 384; cbase = 256 + wc * 64; ssb = SSQ; nss = 6; iss = 4 + wc; }
            const int bjs = pn == 2 ? 32 : HALF;
#pragma unroll
            for (int ai = 0; ai < 2; ++ai)
#pragma unroll
                for (int m = 0; m < 4; ++m) { const int R = u.pm * BM + ai * HALF + wr * 64 + m * 16 + fr; bf16_t* dst = base + (size_t)R * ld + cbase + 8 * fq; float ss = 0.f;
                    asm volatile("" ::: "memory"); f32x4 x[2][2]; xrow(acc, ai, m, R, pcol0, x);
#pragma unroll
                    for (int bj = 0; bj < 2; ++bj) { ss += sq4(x[bj][0]) + sq4(x[bj][1]); *(u32x4*)(dst + bj * bjs) = pack8(x[bj][0], x[bj][1]); }
                    ss = quad_sum(ss); if (fq == 0) ssb[(size_t)R * nss + iss] = ss; }
        }
    }
};

template <bool F8> struct EpiKvb {
    static constexpr bool PERM = true, AFTER_DRAIN = false;
    const float* SSKV; const float* knn; bf16_t* K1; bf16_t* V1;
    __device__ __forceinline__ void operator()(const f32x4 (&acc)[2][2][4][2], const Unit& u, int wr, int wc, int fr_, int fq_) const {
        int fr = fr_, fq = fq_; asm volatile("" : "+v"(fr), "+v"(fq));
        const int head = 2 * u.pn + (wc >> 1), type = wc & 1;
#pragma unroll
        for (int ai = 0; ai < 2; ++ai)
#pragma unroll
            for (int m = 0; m < 4; ++m) { const int R = u.pm * BM + ai * HALF + wr * 64 + m * 16 + fr;
                asm volatile("" ::: "memory");
                const f32x4 s4 = *(const f32x4*)(SSKV + (size_t)R * 4); const float rkv = rsqrtf(((s4[0] + s4[1]) + (s4[2] + s4[3])) * (1.f / 256.f) + EPS);
                f32x4 x[2][2]; float ss = 0.f;
#pragma unroll
                for (int bj = 0; bj < 2; ++bj)
#pragma unroll
                    for (int n = 0; n < 2; ++n) { x[bj][n] = acc[ai][bj][m][n] * rkv; ss += sq4(x[bj][n]); }
                if (type == 0) { const float rinv = rsqrtf(quad_sum(ss) * (1.f / 64.f) + EPS);
#pragma unroll
                    for (int bj = 0; bj < 2; ++bj)
#pragma unroll
                        for (int n = 0; n < 2; ++n) x[bj][n] = x[bj][n] * rinv * *(const f32x4*)(knn + 32 * bj + 8 * fq + 4 * n); }
                const size_t eo = (size_t)key_slot(R) * DM + head * 64 + 8 * fq;
                if (F8) { if (type == 0) { unsigned char* dst = (unsigned char*)K1 + (size_t)key_slot(R) * 512 + head * 32 + 4 * fq; *(unsigned*)dst = pack8_fp4(x[0][0] * 2.f, x[0][1] * 2.f); *(unsigned*)(dst + 16) = pack8_fp4(x[1][0] * 2.f, x[1][1] * 2.f); }
                          else { unsigned char* dst = (unsigned char*)V1 + eo; *(u32x2*)dst = pack8_fp8(x[0][0], x[0][1]); *(u32x2*)(dst + 32) = pack8_fp8(x[1][0], x[1][1]); } }
                else { bf16_t* dst = (type == 0 ? K1 : V1) + eo; *(u32x4*)dst = pack8(x[0][0], x[0][1]); *(u32x4*)(dst + 32) = pack8(x[1][0], x[1][1]); } }
    }
};

struct EpiQb {
    static constexpr bool PERM = true, AFTER_DRAIN = false;
    const float* SSQ; const float* qnw; const f32x4* tabB; bf16_t* Q1N; bf16_t* Q1R; float* SSH;
    __device__ __forceinline__ float rqa_of(int R) const { const float* sp = SSQ + (size_t)R * 6; const f32x2 sa = *(const f32x2*)sp, sb = *(const f32x2*)(sp + 2), sc = *(const f32x2*)(sp + 4);
        return rsqrtf(((sa[0] + sa[1]) + (sb[0] + sb[1]) + (sc[0] + sc[1])) * (1.f / 384.f) + EPS); }
    __device__ __forceinline__ void operator()(const f32x4 (&acc)[2][2][4][2], const Unit& u, int wr, int wc, int fr_, int fq_) const {
        int fr = fr_, fq = fq_; asm volatile("" : "+v"(fr), "+v"(fq));
        const int head = 2 * u.pn + (wc >> 1);
        if ((wc & 1) == 0) {
#pragma unroll
            for (int ai = 0; ai < 2; ++ai)
#pragma unroll
                for (int m = 0; m < 4; ++m) { const int R = u.pm * BM + ai * HALF + wr * 64 + m * 16 + fr;
                    asm volatile("" ::: "memory");
                    const float rqa = rqa_of(R); float ss = 0.f; bf16_t* dst = Q1N + (size_t)R * DM + head * 64 + 8 * fq;
#pragma unroll
                    for (int bj = 0; bj < 2; ++bj) { f32x4 x0 = acc[ai][bj][m][0] * rqa, x1 = acc[ai][bj][m][1] * rqa; ss += sq4(x0) + sq4(x1);
                        x0 = x0 * *(const f32x4*)(qnw + 32 * bj + 8 * fq); x1 = x1 * *(const f32x4*)(qnw + 32 * bj + 8 * fq + 4); *(u32x4*)(dst + 32 * bj) = pack8(x0, x1); }
                    ss = quad_sum(ss); if (fq == 0) SSH[((size_t)R * 16 + head) * 2] = ss; }
        } else {
#pragma unroll
            for (int ai = 0; ai < 2; ++ai)
#pragma unroll
                for (int m = 0; m < 4; ++m) { const int R = u.pm * BM + ai * HALF + wr * 64 + m * 16 + fr;
                    asm volatile("" ::: "memory");
                    const float rqa = rqa_of(R);
                    f32x4 x0 = acc[ai][0][m][0] * rqa, x1 = acc[ai][0][m][1] * rqa; const float ss = quad_sum(sq4(x0) + sq4(x1)); if (fq == 0) SSH[((size_t)R * 16 + head) * 2 + 1] = ss;
                    const float* wp = qnw + 64 + 16 * (fq >> 1) + 4 * (fq & 1); x0 = x0 * *(const f32x4*)wp; x1 = x1 * *(const f32x4*)(wp + 8);
                    const int t = R & (SEQ - 1); const int pos = (fq >> 1) ? (t & 63) : (t >> 6); const f32x4* tp = tabB + (pos * 8 + 4 * (fq & 1)) / 2; rot4(x0, x1, tp[0], tp[1]);
                    *(u32x4*)(Q1R + (size_t)R * 512 + head * 32 + 8 * fq) = pack8(x0, x1); }
        }
    }
};

struct In1Order {
    int G, c; ROrder lat;
    __host__ __device__ void init(int G_, int c_) { G = G_; c = c_; lat.init(0, ML / BM, N_IN1P, G_, c_); }
    __host__ __device__ bool next(int i, Unit& u) const {
        const long L = (long)i * G + c; if (L < lat.nwg) return lat.next(i, u);
        const int e = (int)(L - lat.nwg); if (e >= 4) return false; u.pm = ML / BM + (e >> 1); u.pn = (e & 1) * 2; u.ko = 0; return true;
    }
    __device__ __forceinline__ void a_ready(const Unit&) const {}
    __device__ __forceinline__ void done(const Unit&) const {}
};
template <class Epi, class Sched, bool ALIGN_EPI = false, bool SP2 = false>
__device__ __forceinline__ void gemm_phase(PG8_LAS unsigned char* lds, const Gemm g, const Sched& S, const Epi& E) {
    const int tid = threadIdx.x, wid = __builtin_amdgcn_readfirstlane(tid >> 6), lane = tid & 63, wr = wid >> 2, wc = wid & 3, fr = lane & 15, fq = lane >> 4;
    const int K = g.K, nt = (g.Kloop ? g.Kloop : K) / BK;
    unsigned voffA[2], voffB[2];
#pragma unroll
    for (int i = 0; i < 2; ++i) { int R, C; stage_rc(tid * 16 + i * 8192, R, C); const int Rb = Epi::PERM ? ((R & ~31) + perm32(R & 31)) : R;
        voffA[i] = (unsigned)(R * K + C) * 2u; voffB[i] = (unsigned)(Rb * K + C) * 2u; }
    const size_t kstep = (size_t)(BK * 2);
    const size_t hstep = (size_t)HALF * K * 2;
    const size_t tstep = 2 * hstep;
    const unsigned ldsw = (unsigned)wid * 1024u;
    const int aoff = lds_byte(wr * 64 + fr, fq * 8), boff = lds_byte(wc * 32 + fr, fq * 8);
#define PG8_SA(b, h) (((b) * 2 + (h)) * HTB)
#define PG8_SB(b, h) ((4 + (b) * 2 + (h)) * HTB)
#define PG8_STAGE(bufoff, gbase, voff) do { _Pragma("unroll") for (int _i = 0; _i < 2; ++_i) \
        __builtin_amdgcn_global_load_lds((const unsigned*)((const char*)(gbase) + (voff)[_i]), (PG8_LAS unsigned*)(lds + (bufoff) + ldsw + _i * 8192), 16, 0, 0); } while (0)
#define PG8_LDA(dst, b, h) do { _Pragma("unroll") for (int m = 0; m < 4; ++m) _Pragma("unroll") for (int k = 0; k < 2; ++k) dst[m][k] = *(const PG8_LAS bf16x8*)(lds + PG8_SA(b, h) + aoff + m * 2048 + k * 1024); } while (0)
#define PG8_LDB(dst, b, h) do { _Pragma("unroll") for (int n = 0; n < 2; ++n) _Pragma("unroll") for (int k = 0; k < 2; ++k) dst[n][k] = *(const PG8_LAS bf16x8*)(lds + PG8_SB(b, h) + boff + n * 2048 + k * 1024); } while (0)
#define PG8_MMA(ai, bj, At, Bt) do { __builtin_amdgcn_s_setprio(1); _Pragma("unroll") for (int m = 0; m < 4; ++m) _Pragma("unroll") for (int n = 0; n < 2; ++n) _Pragma("unroll") for (int k = 0; k < 2; ++k) \
        acc[ai][bj][m][n] = __builtin_amdgcn_mfma_f32_16x16x32_bf16(Bt[n][k], At[m][k], acc[ai][bj][m][n], 0, 0, 0); __builtin_amdgcn_s_setprio(0); } while (0)
#define PG8_WAIT_V(n) asm volatile("s_waitcnt vmcnt(" #n ")" ::: "memory")
#define PG8_WAIT_L(n) asm volatile("s_waitcnt lgkmcnt(" #n ")" ::: "memory")
#define PG8_BAR __builtin_amdgcn_s_barrier()
#define PG8_SCHED __builtin_amdgcn_sched_barrier(0)
    Unit cur, nxt; int ui = 0;
    if (!S.next(0, cur)) return;
    f32x4 acc[2][2][4][2];
#pragma unroll
    for (int a = 0; a < 2; ++a)
#pragma unroll
        for (int b = 0; b < 2; ++b)
#pragma unroll
            for (int m = 0; m < 4; ++m)
#pragma unroll
                for (int n = 0; n < 2; ++n) acc[a][b][m][n] = (f32x4){0.f, 0.f, 0.f, 0.f};
    bf16x8 At[4][2], B0[2][2], B1[2][2];
    const char* cA = (const char*)g.A + (size_t)cur.pm * tstep + (size_t)cur.ko * 2; const char* cB = (const char*)g.Bt + (size_t)cur.pn * tstep + (size_t)cur.ko * 2;
    S.a_ready(cur);
    if constexpr (SP2) {
        PG8_STAGE(PG8_SB(0, 0), cB, voffB); PG8_STAGE(PG8_SB(0, 1), cB + hstep, voffB); PG8_STAGE(PG8_SA(0, 0), cA, voffA); PG8_STAGE(PG8_SA(0, 1), cA + hstep, voffA);
        if (wr == 1) PG8_BAR;
        PG8_WAIT_V(2); PG8_BAR;
        PG8_STAGE(PG8_SB(1, 0), cB + kstep, voffB); PG8_STAGE(PG8_SA(1, 0), cA + kstep, voffA); PG8_STAGE(PG8_SB(1, 1), cB + hstep + kstep, voffB);
        PG8_WAIT_V(6); PG8_BAR;
    } else {
        PG8_STAGE(PG8_SB(0, 0), cB, voffB); PG8_STAGE(PG8_SA(0, 0), cA, voffA); PG8_STAGE(PG8_SB(0, 1), cB + hstep, voffB); PG8_STAGE(PG8_SA(0, 1), cA + hstep, voffA);
        if (wr == 1) PG8_BAR;
        PG8_WAIT_V(4); PG8_BAR;
        PG8_STAGE(PG8_SB(1, 0), cB + kstep, voffB); PG8_STAGE(PG8_SA(1, 0), cA + kstep, voffA); PG8_STAGE(PG8_SB(1, 1), cB + hstep + kstep, voffB);
        PG8_WAIT_V(6); PG8_BAR;
    }
    for (;;) {
        const bool has_next = S.next(ui + 1, nxt);
        const char* nA = has_next ? (const char*)g.A + (size_t)nxt.pm * tstep + (size_t)nxt.ko * 2 : cA; const char* nB = has_next ? (const char*)g.Bt + (size_t)nxt.pn * tstep + (size_t)nxt.ko * 2 : cB;
        _Pragma("nounroll") for (int t = 0; t < nt; t += 2) {
            const bool last = (t == nt - 2);
            const char* a1 = cA + (size_t)(t + 1) * kstep;
            const char* a2 = last ? nA : cA + (size_t)(t + 2) * kstep; const char* b2 = last ? nB : cB + (size_t)(t + 2) * kstep;
            const char* a3 = a2 + kstep; const char* b3 = b2 + kstep;
            if (last && has_next) S.a_ready(nxt);
            if constexpr (SP2) {
            PG8_LDB(B0, 0, 0); PG8_LDB(B1, 0, 1); PG8_SCHED; PG8_LDA(At, 0, 0); PG8_STAGE(PG8_SA(1, 1), a1 + hstep, voffA);
            PG8_WAIT_V(8); PG8_WAIT_L(0); PG8_BAR; PG8_MMA(0, 0, At, B0); PG8_MMA(0, 1, At, B1); PG8_BAR; PG8_SCHED;
            PG8_LDA(At, 0, 1); PG8_STAGE(PG8_SB(0, 0), b2, voffB); PG8_STAGE(PG8_SB(0, 1), b2 + hstep, voffB); PG8_STAGE(PG8_SA(0, 0), a2, voffA);
            PG8_WAIT_V(8); PG8_WAIT_L(0); PG8_BAR; PG8_MMA(1, 0, At, B0); PG8_MMA(1, 1, At, B1); PG8_BAR; PG8_SCHED;
            PG8_LDB(B0, 1, 0); PG8_LDB(B1, 1, 1); PG8_SCHED; PG8_LDA(At, 1, 0); PG8_STAGE(PG8_SA(0, 1), a2 + hstep, voffA);
            PG8_WAIT_V(8); PG8_WAIT_L(0); PG8_BAR; PG8_MMA(0, 0, At, B0); PG8_MMA(0, 1, At, B1); PG8_BAR; PG8_SCHED;
            PG8_LDA(At, 1, 1); PG8_STAGE(PG8_SB(1, 0), b3, voffB); PG8_STAGE(PG8_SB(1, 1), b3 + hstep, voffB); PG8_STAGE(PG8_SA(1, 0), a3, voffA);
            PG8_WAIT_V(8); PG8_WAIT_L(0); PG8_BAR; PG8_MMA(1, 0, At, B0); PG8_MMA(1, 1, At, B1); PG8_BAR; PG8_SCHED;
            } else {
            PG8_LDB(B0, 0, 0); PG8_SCHED; PG8_LDA(At, 0, 0); PG8_STAGE(PG8_SA(1, 1), a1 + hstep, voffA);
            PG8_WAIT_L(8); PG8_BAR; PG8_WAIT_L(0); PG8_MMA(0, 0, At, B0); PG8_BAR; PG8_SCHED;
            PG8_LDB(B1, 0, 1); PG8_STAGE(PG8_SB(0, 0), b2, voffB);
            PG8_BAR; PG8_WAIT_L(0); PG8_MMA(0, 1, At, B1); PG8_BAR;
            PG8_LDA(At, 0, 1); PG8_STAGE(PG8_SA(0, 0), a2, voffA);
            PG8_BAR; PG8_WAIT_L(0); PG8_MMA(1, 0, At, B0); PG8_BAR; PG8_SCHED;
            PG8_STAGE(PG8_SB(0, 1), b2 + hstep, voffB);
            PG8_WAIT_V(6); PG8_BAR; PG8_MMA(1, 1, At, B1); PG8_BAR;
            PG8_LDB(B0, 1, 0); PG8_SCHED; PG8_LDA(At, 1, 0); PG8_STAGE(PG8_SA(0, 1), a2 + hstep, voffA);
            PG8_WAIT_L(8); PG8_BAR; PG8_WAIT_L(0); PG8_MMA(0, 0, At, B0); PG8_BAR; PG8_SCHED;
            PG8_LDB(B1, 1, 1); PG8_STAGE(PG8_SB(1, 0), b3, voffB);
            PG8_BAR; PG8_WAIT_L(0); PG8_MMA(0, 1, At, B1); PG8_BAR;
            PG8_LDA(At, 1, 1); PG8_STAGE(PG8_SA(1, 0), a3, voffA);
            PG8_BAR; PG8_WAIT_L(0); PG8_MMA(1, 0, At, B0); PG8_BAR; PG8_SCHED;
            PG8_STAGE(PG8_SB(1, 1), b3 + hstep, voffB);
            PG8_WAIT_V(6); PG8_BAR; PG8_MMA(1, 1, At, B1); PG8_BAR;
            }
        }
        if constexpr (ALIGN_EPI) { if (wr == 0) PG8_BAR; }
        if constexpr (!Epi::AFTER_DRAIN) { E(acc, cur, wr, wc, fr, fq); S.done(cur); }
        if (!has_next) break;
#pragma unroll
        for (int a = 0; a < 2; ++a)
#pragma unroll
            for (int b = 0; b < 2; ++b)
#pragma unroll
                for (int m = 0; m < 4; ++m)
#pragma unroll
                    for (int n = 0; n < 2; ++n) acc[a][b][m][n] = (f32x4){0.f, 0.f, 0.f, 0.f};
        cur = nxt; cA = nA; cB = nB; ++ui;
        if constexpr (ALIGN_EPI) { if (wr == 1) PG8_BAR; }
    }
    PG8_WAIT_V(0);
    if constexpr (!ALIGN_EPI) { if (wr == 0) PG8_BAR; }
    PG8_BAR;
    if constexpr (Epi::AFTER_DRAIN) { E.fused(acc, cur, wr, wc, fr, fq, lds, wid, lane); S.done(cur); }
#undef PG8_SA
#undef PG8_SB
#undef PG8_STAGE
#undef PG8_LDA
#undef PG8_LDB
#undef PG8_MMA
#undef PG8_WAIT_V
#undef PG8_WAIT_L
#undef PG8_BAR
#undef PG8_SCHED
}
}

DEVI void sincos_pos(float ang, float& cs, float& sn) {
    const double TWO_PI = 6.283185307179586476925286766559; const double a = (double)ang; const double k = __builtin_rint(a * (1.0 / TWO_PI));
    const float r = (float)(a - k * TWO_PI);
    cs = cosf(r); sn = sinf(r);
}

namespace afast {
#ifndef ATT_PRIO
#define ATT_PRIO 2
#endif
#ifndef ATT_DUP
#define ATT_DUP 0
#endif
constexpr int NW = 8, KVBLK = 64, SLOTK = 12288, SLOTV = 8192, KROFF = 8192;
constexpr int LDS_K = 0, LDS_V = 3 * SLOTK, LDS_WS = LDS_V + 3 * SLOTV, LDS_OST = LDS_WS + NW * 256, LDS_BYTES = LDS_OST + NW * 4096;
#define SBAR() __builtin_amdgcn_sched_barrier(0)
#define PIN(x) asm volatile("" : "+v"(x))
#define MFMA(a, b, c) __builtin_amdgcn_mfma_f32_32x32x16_bf16(a, b, c, 0, 0, 0)
#ifndef ATT_AGPR_O
#define ATT_AGPR_O 0
#endif
#if ATT_AGPR_O
#define PVMFMA(acc, a, b) asm volatile("s_nop 1\n\tv_mfma_f32_32x32x16_bf16 %0, %1, %2, %0" : "+a"(acc) : "v"(a), "v"(b))
#else
#define PVMFMA(acc, a, b) acc = __builtin_amdgcn_mfma_f32_32x32x16_bf16(a, b, acc, 0, 0, 0)
#endif
#define WAIT_BAR_(N) asm volatile("s_waitcnt vmcnt(" #N ") lgkmcnt(0)\n\ts_barrier" ::: "memory")
#define WAIT_BAR_0() WAIT_BAR_(0)
#define WAIT_BAR_1() do { if (ATT_DUP & 1) WAIT_BAR_(2); else WAIT_BAR_(1); } while (0)
#define WAIT_BAR_2() do { if (ATT_DUP & 1) WAIT_BAR_(4); else WAIT_BAR_(2); } while (0)
#define WAIT_BAR_3() do { if (ATT_DUP & 1) WAIT_BAR_(6); else WAIT_BAR_(3); } while (0)
#define WAIT_BAR(N) do { WAIT_BAR_##N(); if (ATT_DUP & 2) asm volatile("s_barrier" ::: "memory"); } while (0)
DEVI int crow(int r, int hi) { return (r & 3) + 8 * (r >> 2) + 4 * hi; }
DEVI unsigned cvtpk(float lo, float hi) { unsigned r; asm("v_cvt_pk_bf16_f32 %0, %1, %2" : "=v"(r) : "v"(lo), "v"(hi)); return r; }
DEVI void glds16(const void* g, unsigned lds_base) {
    unsigned sv; asm volatile("s_mov_b32 %0, m0\n\ts_mov_b32 m0, %2\n\ts_nop 0\n\tglobal_load_lds_dwordx4 %1, off\n\ts_mov_b32 m0, %0" : "=&s"(sv) : "v"(g), "s"(lds_base) : "memory"); }
typedef __attribute__((address_space(3))) const char* lds_cptr;
typedef short v4i16_t __attribute__((ext_vector_type(4)));
DEVI bf16x8 ldsb128(lds_cptr p) { return *(const __attribute__((address_space(3))) bf16x8*)p; }
DEVI s16x4 vtr(lds_cptr p) { return __builtin_bit_cast(s16x4, __builtin_amdgcn_ds_read_tr16_b64_v4i16((__attribute__((address_space(3))) v4i16_t*)p)); }
DEVI bf16x8 scale8(bf16x8 v, float s) {
    u32x4 w = __builtin_bit_cast(u32x4, v); u32x4 o;
#pragma unroll
    for (int i = 0; i < 4; ++i) { const float lo = __uint_as_float(w[i] << 16) * s, hi = __uint_as_float(w[i] & 0xffff0000u) * s; o[i] = cvtpk(lo, hi); }
    return __builtin_bit_cast(bf16x8, o);
}

template <int ROPE>
DEVI void attn_unit(const bf16_t* Qn, int ldq, const bf16_t* Qr, const float* ssh, const bf16_t* __restrict__ Kn, int ldk, const bf16_t* __restrict__ Kr,
                    const bf16_t* __restrict__ V, int ldv, int NT, bf16_t* O, const bf16_t* G, int ldo, char* lds) {
    const int tid = threadIdx.x, lane = tid & 63, r32 = lane & 31, hi = lane >> 5; const int wid = __builtin_amdgcn_readfirstlane(tid >> 6);
    const unsigned lds0 = (unsigned)(uintptr_t)lds; float* wsf = (float*)(lds + LDS_WS) + wid * 64;
    const bf16_t* ksrc = Kn + (size_t)lane * ldk + wid * 8;
    const bf16_t* vsrc = V + (size_t)(16 * (wid & 3) + (lane >> 2)) * ldv + (wid >> 2) * 32 + (lane & 3) * 8;
    const bf16_t* krsrc = ROPE ? Kr + (size_t)(32 * (wid & 1) + r32) * 32 + 8 * (2 * ((wid >> 1) & 1) + hi) : nullptr;
    const unsigned kdst = lds0 + LDS_K + wid * 1024, vdst = lds0 + LDS_V + wid * 1024, krdst = lds0 + LDS_K + KROFF + (wid & 3) * 1024;
    const bool rwave = ROPE && wid < 4;
#define DMA_K(t, slot) do { DMA_K1(t, slot); if (ATT_DUP & 1) DMA_K1(t, slot); } while (0)
#define DMA_K1(t, slot) do { if (ROPE) { if (rwave) glds16(krsrc + (size_t)(t) * KVBLK * 32, (unsigned)__builtin_amdgcn_readfirstlane(krdst + (slot))); } \
        glds16(ksrc + (size_t)(t) * KVBLK * ldk, (unsigned)__builtin_amdgcn_readfirstlane(kdst + (slot))); } while (0)
#define DMA_V1(t, slot) glds16(vsrc + (size_t)(t) * KVBLK * ldv, (unsigned)__builtin_amdgcn_readfirstlane(vdst + (slot)))
#define DMA_V(t, slot) do { DMA_V1(t, slot); if (ATT_DUP & 1) DMA_V1(t, slot); } while (0)
    const lds_cptr vp0 = (lds_cptr)lds + LDS_V + ((lane >> 4) & 1) * 32 + (lane & 3) * 8 + (4 * hi + ((lane & 15) >> 2)) * 64;
    const lds_cptr kp0 = (lds_cptr)lds + LDS_K + hi * 1024 + r32 * 16;
    const lds_cptr krp0 = (lds_cptr)lds + LDS_K + KROFF + hi * 512 + r32 * 16;
    DMA_K(0, 0); DMA_V(0, 0); DMA_K(1, SLOTK);
    bf16x8 qr[4]; bf16x8 qrr[2];
    { const bf16_t* Qw = Qn + (size_t)(wid * 32 + r32) * ldq + hi * 8;
#pragma unroll
      for (int d0 = 0; d0 < 4; ++d0) qr[d0] = *reinterpret_cast<const bf16x8*>(Qw + d0 * 16);
      if (ROPE) { const bf16_t* Qrw = Qr + (size_t)(wid * 32 + r32) * 512 + hi * 8;
#pragma unroll
          for (int d0 = 0; d0 < 2; ++d0) qrr[d0] = *reinterpret_cast<const bf16x8*>(Qrw + d0 * 16);
          const f32x2 s2 = *(const f32x2*)(ssh + (size_t)(wid * 32 + r32) * 32); const float sc = rsqrtf((s2[0] + s2[1]) * (1.f / 96.f) + EPS) * C2_MLA;
#pragma unroll
          for (int d0 = 0; d0 < 4; ++d0) qr[d0] = scale8(qr[d0], sc);
#pragma unroll
          for (int d0 = 0; d0 < 2; ++d0) qrr[d0] = scale8(qrr[d0], sc); } }
    float l_reg = 0.f; f32x16 o[2]; o[0] = f32x16{}; o[1] = f32x16{};
    const f32x16 zero16 = f32x16{};
    f32x16 dacc = f32x16{}; f32x16 pA0, pA1, pB0, pB1; bf16x8 kf[8]; bf16x8 kfr[4]; s16x4 vlo[8], vhi[8]; u32x4 pw0, pw1, pw2, pw3;
    int sl_prev = 0, sl_cur = 0, sl_next = SLOTK;
#define VSL(s) (((s) / (SLOTK / 1024)) * (SLOTV / 1024))
#define ROT() do { sl_prev = sl_cur; sl_cur = sl_next; sl_next = (sl_next == 2 * SLOTK) ? 0 : sl_next + SLOTK; } while (0)
#define EX(v) __builtin_amdgcn_exp2f(v)
#define KLOADALL(slot) do { _Pragma("unroll") for (int d0 = 0; d0 < 4; ++d0) { kf[2 * d0] = ldsb128(kp0 + (slot) + d0 * 2048); kf[2 * d0 + 1] = ldsb128(kp0 + (slot) + d0 * 2048 + 512); } \
        if (ROPE) { _Pragma("unroll") for (int q = 0; q < 4; ++q) kfr[q] = ldsb128(krp0 + (slot) + q * 1024); } } while (0)
    DMA_K(2, 2 * SLOTK);
    WAIT_BAR(3);
    KLOADALL(0);
    pA0 = MFMA(kf[0], qr[0], zero16); pA1 = MFMA(kf[1], qr[0], zero16); pA0 = MFMA(kf[2], qr[1], pA0); pA1 = MFMA(kf[3], qr[1], pA1);
    pA0 = MFMA(kf[4], qr[2], pA0); pA1 = MFMA(kf[5], qr[2], pA1); pA0 = MFMA(kf[6], qr[3], pA0); pA1 = MFMA(kf[7], qr[3], pA1);
    if (ROPE) { pA0 = MFMA(kfr[0], qrr[0], pA0); pA1 = MFMA(kfr[1], qrr[0], pA1); pA0 = MFMA(kfr[2], qrr[1], pA0); pA1 = MFMA(kfr[3], qrr[1], pA1); }
#pragma unroll
    for (int r = 0; r < 16; ++r) { pA0[r] = EX(pA0[r]); pA1[r] = EX(pA1[r]); }
    WAIT_BAR(0);
    DMA_K(3, 0); DMA_V(1, SLOTV); ROT();
    KLOADALL(sl_cur);
    WAIT_BAR(2);
#define PKW(P, i) cvtpk(P[i], P[i + 1])
#define PAF(k) __builtin_bit_cast(bf16x8, pw##k)
#define VFR(i) (bf16x8){vlo[i][0], vlo[i][1], vlo[i][2], vlo[i][3], vhi[i][0], vhi[i][1], vhi[i][2], vhi[i][3]}
#define VRD(i) do { vlo[i] = vtr(vp_ + (((i) >> 2) * 4096 + ((i) & 3) * 1024)); vhi[i] = vtr(vp_ + (((i) >> 2) * 4096 + ((i) & 3) * 1024 + 512)); } while (0)
#define KRD(G, d0) do { if (G) { kf[2 * (d0)] = ldsb128(kp0 + sl_next + (d0) * 2048); kf[2 * (d0) + 1] = ldsb128(kp0 + sl_next + (d0) * 2048 + 512); \
        if (ATT_DUP & 16) { bf16x8 d0_, d1_; asm volatile("ds_read_b128 %0, %2 offset:0\n\tds_read_b128 %1, %2 offset:512\n\ts_waitcnt lgkmcnt(0)" : "=&v"(d0_), "=&v"(d1_) : "v"((unsigned)(uintptr_t)(kp0 + sl_next + (d0) * 2048)) : "memory"); } SBAR(); } } while (0)
#define KRR(G, q) do { if (ROPE) { if (G) { kfr[2 * (q)] = ldsb128(krp0 + sl_next + (2 * (q)) * 1024); kfr[2 * (q) + 1] = ldsb128(krp0 + sl_next + (2 * (q) + 1) * 1024); SBAR(); } } } while (0)
#define GAPA4(CX, MF, a0, a1, a2, a3, W0, W1, PW) do { MF; sacc += a0; sacc += a1; sacc += a2; sacc += a3; W0; W1; PIN(PW); PIN(sacc); PIN(CX); if ((ATT_DUP & 8) && !ROPE) { dacc = MFMA(kf[0], qr[0], dacc); PIN(dacc); } SBAR(); } while (0)
#define GAPA3(CX, MF, a0, a1, a2, W0, W1, PW) do { MF; sacc += a0; sacc += a1; sacc += a2; W0; W1; PIN(PW); PIN(sacc); PIN(CX); if ((ATT_DUP & 8) && !ROPE) { dacc = MFMA(kf[0], qr[0], dacc); PIN(dacc); } SBAR(); } while (0)
#define GAPA31(CX, MF, a0, a1, a2, W0, PW) do { MF; sacc += a0; sacc += a1; sacc += a2; W0; PIN(PW); PIN(sacc); PIN(CX); if ((ATT_DUP & 8) && !ROPE) { dacc = MFMA(kf[0], qr[0], dacc); PIN(dacc); } SBAR(); } while (0)
#define GAPA21(CX, MF, a0, a1, W0, PW) do { MF; sacc += a0; sacc += a1; W0; PIN(PW); PIN(sacc); PIN(CX); if ((ATT_DUP & 8) && !ROPE) { dacc = MFMA(kf[0], qr[0], dacc); PIN(dacc); } SBAR(); } while (0)
#define XEXP(v) do { if (ATT_DUP & 4) { float d_; asm volatile("v_exp_f32 %0, %1" : "=v"(d_) : "v"(v)); } } while (0)
#define GAPB(MF, X, i) do { MF; X[i] = EX(X[i]); X[i + 1] = EX(X[i + 1]); X[i + 2] = EX(X[i + 2]); X[i + 3] = EX(X[i + 3]); XEXP(X[i]); XEXP(X[i + 1]); XEXP(X[i + 2]); XEXP(X[i + 3]); PIN(X); SBAR(); } while (0)
#define STEP(C0, C1, P0, P1, t, GK, GV, GL) do { SBAR(); if (ATT_PRIO == 2) __builtin_amdgcn_s_setprio(1); if (ATT_PRIO == 3) __builtin_amdgcn_s_setprio(0); \
    const lds_cptr vp_ = vp0 + VSL(sl_prev); \
    VRD(0); SBAR(); float sacc = P0[0] + P0[1]; \
    if (!ROPE) { \
                        GAPA4(C0, C0 = MFMA(kf[0], qr[0], zero16), P0[2], P0[3], P0[4], P0[5],     pw0[0] = PKW(P0, 0),  pw0[1] = PKW(P0, 2),  pw0); \
        VRD(4); SBAR(); GAPA4(C1, C1 = MFMA(kf[1], qr[0], zero16), P0[6], P0[7], P0[8], P0[9],     pw0[2] = PKW(P0, 4),  pw0[3] = PKW(P0, 6),  pw0); \
        VRD(1); SBAR(); GAPA4(C0, C0 = MFMA(kf[2], qr[1], C0),    P0[10], P0[11], P0[12], P0[13], pw1[0] = PKW(P0, 8),  pw1[1] = PKW(P0, 10), pw1); \
        VRD(5); SBAR(); GAPA4(C1, C1 = MFMA(kf[3], qr[1], C1),    P0[14], P0[15], P1[0], P1[1],   pw1[2] = PKW(P0, 12), pw1[3] = PKW(P0, 14), pw1); \
        VRD(2); SBAR(); GAPA4(C0, C0 = MFMA(kf[4], qr[2], C0),    P1[2], P1[3], P1[4], P1[5],     pw2[0] = PKW(P1, 0),  pw2[1] = PKW(P1, 2),  pw2); \
        VRD(6); SBAR(); GAPA4(C1, C1 = MFMA(kf[5], qr[2], C1),    P1[6], P1[7], P1[8], P1[9],     pw2[2] = PKW(P1, 4),  pw2[3] = PKW(P1, 6),  pw2); \
        VRD(3); SBAR(); GAPA4(C0, C0 = MFMA(kf[6], qr[3], C0),    P1[10], P1[11], P1[12], P1[13], pw3[0] = PKW(P1, 8),  pw3[1] = PKW(P1, 10), pw3); \
        VRD(7); SBAR(); GAPA4(C1, C1 = MFMA(kf[7], qr[3], C1),    P1[14], P1[15], 0.f, 0.f,       pw3[2] = PKW(P1, 12), pw3[3] = PKW(P1, 14), pw3); \
    } else { \
                        GAPA3(C0, C0 = MFMA(kf[0], qr[0], zero16), P0[2], P0[3], P0[4],    pw0[0] = PKW(P0, 0),  pw0[1] = PKW(P0, 2),  pw0); \
        VRD(4); SBAR(); GAPA3(C1, C1 = MFMA(kf[1], qr[0], zero16), P0[5], P0[6], P0[7],    pw0[2] = PKW(P0, 4),  pw0[3] = PKW(P0, 6),  pw0); \
        VRD(1); SBAR(); GAPA3(C0, C0 = MFMA(kf[2], qr[1], C0),    P0[8], P0[9], P0[10],   pw1[0] = PKW(P0, 8),  pw1[1] = PKW(P0, 10), pw1); \
        VRD(5); SBAR(); GAPA3(C1, C1 = MFMA(kf[3], qr[1], C1),    P0[11], P0[12], P0[13], pw1[2] = PKW(P0, 12), pw1[3] = PKW(P0, 14), pw1); \
        VRD(2); SBAR(); GAPA31(C0, C0 = MFMA(kf[4], qr[2], C0),   P0[14], P0[15], P1[0],  pw2[0] = PKW(P1, 0),  pw2); \
        VRD(6); SBAR(); GAPA31(C1, C1 = MFMA(kf[5], qr[2], C1),   P1[1], P1[2], P1[3],    pw2[1] = PKW(P1, 2),  pw2); \
        VRD(3); SBAR(); GAPA21(C0, C0 = MFMA(kf[6], qr[3], C0),   P1[4], P1[5],           pw2[2] = PKW(P1, 4),  pw2); \
        VRD(7); SBAR(); GAPA21(C1, C1 = MFMA(kf[7], qr[3], C1),   P1[6], P1[7],           pw2[3] = PKW(P1, 6),  pw2); \
                        GAPA21(C0, C0 = MFMA(kfr[0], qrr[0], C0), P1[8], P1[9],           pw3[0] = PKW(P1, 8),  pw3); \
                        GAPA21(C1, C1 = MFMA(kfr[1], qrr[0], C1), P1[10], P1[11],         pw3[1] = PKW(P1, 10), pw3); \
                        GAPA21(C0, C0 = MFMA(kfr[2], qrr[1], C0), P1[12], P1[13],         pw3[2] = PKW(P1, 12), pw3); \
                        GAPA21(C1, C1 = MFMA(kfr[3], qrr[1], C1), P1[14], P1[15],         pw3[3] = PKW(P1, 14), pw3); \
    } \
    l_reg += sacc; \
    if (GK) DMA_K((t) + 3, sl_cur); if (GV) DMA_V((t) + 1, VSL(sl_next)); \
    SBAR(); if (ATT_PRIO == 2) __builtin_amdgcn_s_setprio(0); if (ATT_PRIO == 3) __builtin_amdgcn_s_setprio(1); \
    GAPB(PVMFMA(o[0], PAF(0), VFR(0)), C0, 0); \
    KRD(GL, 0); GAPB(PVMFMA(o[1], PAF(0), VFR(4)), C0, 4); \
    KRD(GL, 1); GAPB(PVMFMA(o[0], PAF(1), VFR(1)), C0, 8); \
    KRD(GL, 2); GAPB(PVMFMA(o[1], PAF(1), VFR(5)), C0, 12); \
    KRD(GL, 3); GAPB(PVMFMA(o[0], PAF(2), VFR(2)), C1, 0); \
    KRR(GL, 0); GAPB(PVMFMA(o[1], PAF(2), VFR(6)), C1, 4); \
    KRR(GL, 1); GAPB(PVMFMA(o[0], PAF(3), VFR(3)), C1, 8); \
    GAPB(PVMFMA(o[1], PAF(3), VFR(7)), C1, 12); \
    } while (0)
    if (ATT_PRIO == 1) { if (wid >= 4) __builtin_amdgcn_s_setprio(1); }
    int t = 1;
    for (; t + 5 < NT; t += 2) {
        STEP(pB0, pB1, pA0, pA1, t, true, true, true);     WAIT_BAR(2); ROT();
        STEP(pA0, pA1, pB0, pB1, t + 1, true, true, true); WAIT_BAR(2); ROT();
    }
#define ENDW(tt) do { if ((tt) + 3 < NT) { WAIT_BAR(2); } else if ((tt) + 2 < NT) { WAIT_BAR(1); } else { WAIT_BAR(0); } } while (0)
    for (; t + 1 < NT; t += 2) {
        STEP(pB0, pB1, pA0, pA1, t, (t + 3 < NT), (t + 1 < NT), (t + 1 < NT));         ENDW(t);     ROT();
        STEP(pA0, pA1, pB0, pB1, t + 1, (t + 4 < NT), (t + 2 < NT), (t + 2 < NT));     ENDW(t + 1); ROT();
    }
    STEP(pB0, pB1, pA0, pA1, NT - 1, false, false, false);
    if (ATT_PRIO != 0) __builtin_amdgcn_s_setprio(0);
    { float sacc = pB0[0] + pB0[1];
#pragma unroll
      for (int r = 2; r < 16; ++r) sacc += pB0[r];
#pragma unroll
      for (int r = 0; r < 16; ++r) sacc += pB1[r];
      l_reg += sacc;
      pw0 = (u32x4){PKW(pB0, 0), PKW(pB0, 2), PKW(pB0, 4), PKW(pB0, 6)}; pw1 = (u32x4){PKW(pB0, 8), PKW(pB0, 10), PKW(pB0, 12), PKW(pB0, 14)};
      pw2 = (u32x4){PKW(pB1, 0), PKW(pB1, 2), PKW(pB1, 4), PKW(pB1, 6)}; pw3 = (u32x4){PKW(pB1, 8), PKW(pB1, 10), PKW(pB1, 12), PKW(pB1, 14)};
      const lds_cptr vp_ = vp0 + VSL(sl_cur); _Pragma("unroll") for (int i = 0; i < 8; ++i) VRD(i);
      PVMFMA(o[0], PAF(0), VFR(0)); PVMFMA(o[1], PAF(0), VFR(4)); PVMFMA(o[0], PAF(1), VFR(1)); PVMFMA(o[1], PAF(1), VFR(5));
      PVMFMA(o[0], PAF(2), VFR(2)); PVMFMA(o[1], PAF(2), VFR(6)); PVMFMA(o[0], PAF(3), VFR(3)); PVMFMA(o[1], PAF(3), VFR(7)); }
#if ATT_AGPR_O
    asm volatile("s_nop 15\n\ts_nop 7" : "+a"(o[0]), "+a"(o[1]));
#endif
    { auto rr = __builtin_amdgcn_permlane32_swap(__float_as_uint(l_reg), __float_as_uint(l_reg), false, false); l_reg = __uint_as_float(rr[0]) + __uint_as_float(rr[1]); }
    if (hi == 0) wsf[32 + r32] = l_reg; asm volatile("s_waitcnt lgkmcnt(0)" ::: "memory");
    float rli[16];
#pragma unroll
    for (int r = 0; r < 16; ++r) rli[r] = __builtin_amdgcn_rcpf(wsf[32 + crow(r, hi)]);
    bf16_t* stg = (bf16_t*)(lds + LDS_OST) + wid * 2048;
#pragma unroll
    for (int r = 0; r < 16; ++r) { const int orow = crow(r, hi);
#pragma unroll
        for (int d0 = 0; d0 < 2; ++d0) stg[orow * 64 + d0 * 32 + r32] = (bf16_t)f2bf(o[d0][r] * rli[r]); }
    asm volatile("s_waitcnt lgkmcnt(0)" ::: "memory");
#pragma unroll
    for (int i = 0; i < 4; ++i) { const int row = i * 8 + (lane >> 3), ch = lane & 7; const size_t goff = (size_t)(wid * 32 + row) * ldo + ch * 8;
        const u32x4 ov = *(const u32x4*)(stg + row * 64 + ch * 8); const u32x4 gv = *(const u32x4*)(G + goff); u32x4 w;
#pragma unroll
        for (int q = 0; q < 4; ++q) { const float lo = __uint_as_float(ov[q] << 16) * __uint_as_float(gv[q] << 16), hh = __uint_as_float(ov[q] & 0xffff0000u) * __uint_as_float(gv[q] & 0xffff0000u); w[q] = cvtpk(lo, hh); }
        *(u32x4*)(O + goff) = w; }
    asm volatile("s_waitcnt lgkmcnt(0)\n\ts_barrier" ::: "memory");
#undef DMA_K
#undef DMA_K1
#undef DMA_V1
#undef XEXP
#undef DMA_V
#undef VSL
#undef ROT
#undef EX
#undef KLOADALL
#undef PKW
#undef PAF
#undef VFR
#undef VRD
#undef KRD
#undef KRR
#undef GAPA4
#undef GAPA3
#undef GAPA31
#undef GAPA21
#undef GAPB
#undef STEP
#undef ENDW
}
#undef SBAR
#undef PIN
#undef MFMA
#undef PVMFMA
#undef WAIT_BAR
#undef WAIT_BAR_
#undef WAIT_BAR_0
#undef WAIT_BAR_1
#undef WAIT_BAR_2
#undef WAIT_BAR_3
}

namespace af8 {
#ifndef F8_DUP
#define F8_DUP 0
#endif
typedef int v8i __attribute__((ext_vector_type(8)));
typedef int v4i __attribute__((ext_vector_type(4)));
typedef int v2i __attribute__((ext_vector_type(2)));
constexpr int NW = 8, KVBLK = 64, SLOT = 4096, KSLOT = 2048;
constexpr int KRSLOT = 1024 + 64;
constexpr int NSL = 4;
constexpr int LDS_K = 0, LDS_V = NSL * KSLOT, LDS_KR = LDS_V + NSL * SLOT, LDS_WS = LDS_KR + NSL * KRSLOT, LDS_OST = LDS_WS + NW * 256, LDS_BYTES = LDS_OST + NW * 4096;
constexpr float YOFF = 56.0f;
#define SBAR() __builtin_amdgcn_sched_barrier(0)
#define PIN(x) asm volatile("" : "+v"(x))
#define WAIT_BAR0() asm volatile("s_waitcnt vmcnt(0) lgkmcnt(0)\n\ts_barrier" ::: "memory")
#define WAIT_BAR1() asm volatile("s_waitcnt vmcnt(2) lgkmcnt(0)\n\ts_barrier" ::: "memory")
#define V8(x) ((v8i){(x)[0], (x)[1], (x)[2], (x)[3], 0, 0, 0, 0})
#define V6(x) ((v8i){(int)(x)[0], (int)(x)[1], (int)(x)[2], (int)(x)[3], (int)(x)[4], (int)(x)[5], 0, 0})
#define QKMFMA(a, b, c) __builtin_amdgcn_mfma_scale_f32_32x32x64_f8f6f4(V8(a), V6(b), c, 4, 2, 0, 126, 0, 126)
#define PVMFMA8(a, b, c) __builtin_amdgcn_mfma_scale_f32_32x32x64_f8f6f4(a, b, c, 1, 0, 0, 127, 0, 127)
DEVI int crow(int r, int hi) { return (r & 3) + 8 * (r >> 2) + 4 * hi; }
DEVI unsigned cvtpk(float lo, float hi) { unsigned r; asm("v_cvt_pk_bf16_f32 %0, %1, %2" : "=v"(r) : "v"(lo), "v"(hi)); return r; }
DEVI void glds16(const void* g, unsigned lds_base) {
    unsigned sv; asm volatile("s_mov_b32 %0, m0\n\ts_mov_b32 m0, %2\n\ts_nop 0\n\tglobal_load_lds_dwordx4 %1, off\n\ts_mov_b32 m0, %0" : "=&s"(sv) : "v"(g), "s"(lds_base) : "memory"); }
typedef __attribute__((address_space(3))) const char* lds_cptr;
DEVI v4i lds128(lds_cptr p) { return *(const __attribute__((address_space(3))) v4i*)p; }
DEVI v2i vtr8(lds_cptr p) { return __builtin_amdgcn_ds_read_tr8_b64_v2i32((__attribute__((address_space(3))) v2i*)p); }
#define PK16U8(P, PF, B) do { unsigned a_, b_, c_, d_; asm volatile("" : "=v"(a_), "=v"(b_), "=v"(c_), "=v"(d_)); \
    _Pragma("unroll") for (int k_ = 0; k_ < 4; ++k_) { a_ = __builtin_amdgcn_cvt_pk_u8_f32(P[k_], k_, a_); b_ = __builtin_amdgcn_cvt_pk_u8_f32(P[4 + k_], k_, b_); \
        c_ = __builtin_amdgcn_cvt_pk_u8_f32(P[8 + k_], k_, c_); d_ = __builtin_amdgcn_cvt_pk_u8_f32(P[12 + k_], k_, d_); } \
    PF[B] = (int)a_; PF[(B) + 1] = (int)b_; PF[(B) + 2] = (int)c_; PF[(B) + 3] = (int)d_; } while (0)
DEVI int pk4bf8(float a, float b, float c, float d) { unsigned w; asm volatile("" : "=v"(w)); w = __builtin_amdgcn_cvt_pk_u8_f32(a, 0, w); w = __builtin_amdgcn_cvt_pk_u8_f32(b, 1, w); w = __builtin_amdgcn_cvt_pk_u8_f32(c, 2, w); w = __builtin_amdgcn_cvt_pk_u8_f32(d, 3, w); return (int)w; }

DEVI int pk4fp8(float a, float b, float c, float d) { int w; asm volatile("" : "=v"(w)); w = __builtin_amdgcn_cvt_pk_fp8_f32(a, b, w, false); w = __builtin_amdgcn_cvt_pk_fp8_f32(c, d, w, true); return w; }
#ifndef F6_INTERLEAVED
#define F6_INTERLEAVED 1
#endif
typedef float v16f __attribute__((ext_vector_type(16)));
typedef unsigned v6u __attribute__((ext_vector_type(6)));
DEVI v6u q32_to_fp6(const bf16_t* p, float sc) { v16f a, b;
#pragma unroll
    for (int c = 0; c < 4; ++c) { const u32x4 w = *(const u32x4*)(p + 8 * c);
#pragma unroll
        for (int k = 0; k < 4; ++k) { const float lo = __uint_as_float(w[k] << 16) * sc, hi = __uint_as_float(w[k] & 0xffff0000u) * sc; const int i = 4 * c + k;
            if (F6_INTERLEAVED) { a[i] = lo; b[i] = hi; } else if (i < 8) { a[2 * i] = lo; a[2 * i + 1] = hi; } else { b[2 * i - 16] = lo; b[2 * i - 15] = hi; } } }
    return __builtin_amdgcn_cvt_scalef32_2xpk16_fp6_f32(a, b, 1.0f); }
template <int ROPE>
DEVI void attn_unit(const void* Qv, int ldq, const bf16_t* Qr, const float* ssh, const unsigned char* __restrict__ K, int ldk, const unsigned char* __restrict__ Kr,
                    const unsigned char* __restrict__ V, int ldv, int NT, bf16_t* O, const bf16_t* G, int ldo, char* lds) {
    int tid_ = threadIdx.x; asm volatile("" : "+v"(tid_));
    const int tid = tid_, lane = tid & 63, r32 = lane & 31, hi = lane >> 5; const int wid = __builtin_amdgcn_readfirstlane(tid >> 6);
    const unsigned lds0 = (unsigned)(uintptr_t)lds; float* wsf = (float*)(lds + LDS_WS) + wid * 64;
    const int role = wid < 2 ? 0 : (wid >= 4 ? 1 : ((ROPE && wid == 2) ? 2 : 3)); const bool kwave = role != 1; const int dlead = kwave ? 4 : 2;
    const int kkey = 32 * (wid & 1) + (lane >> 1), vkey = 16 * (wid & 3) + (lane >> 2);
    const unsigned char* dsrc = role == 0 ? K + (size_t)kkey * ldk + 16 * ((lane & 1) ^ ((kkey >> 3) & 1))
                              : role == 1 ? V + (size_t)vkey * ldv + 16 * ((lane & 3) ^ (2 * ((vkey >> 3) & 1)))
                              : (ROPE ? Kr + (size_t)lane * 16 : K);
    const size_t dstep = (size_t)KVBLK * (role == 0 ? ldk : (role == 1 ? ldv : 16));
    const unsigned ddst = lds0 + (role == 0 ? LDS_K + (wid & 1) * 1024 : (role == 1 ? LDS_V + (wid & 3) * 1024 : LDS_KR));
    const int dslot = role == 0 ? KSLOT : (role == 1 ? SLOT : KRSLOT); const bool dma_on = role != 3;
#define DMA(t, si) glds16(dsrc + (size_t)(t) * dstep, (unsigned)__builtin_amdgcn_readfirstlane(ddst + (si) * dslot))
    const lds_cptr kpa = (lds_cptr)lds + LDS_K + r32 * 32 + ((hi ^ ((r32 >> 3) & 1)) * 16);
    const int vg = (lane >> 4) & 1, vq = (lane & 15) >> 1, vp = lane & 1, vfk = (vq >> 2) & 1;
    const int vrow = (8 * (vq >> 2) + 4 * hi + (vq & 3)) * 64 + 8 * vp + 16 * vg;
    const lds_cptr vp0 = (lds_cptr)lds + LDS_V + vrow + 32 * vfk, vp1 = (lds_cptr)lds + LDS_V + vrow + 32 * (1 - vfk);
    const lds_cptr ra0 = (lds_cptr)lds + LDS_KR + (hi ? 1024 : r32 * 16), ra1 = (lds_cptr)lds + LDS_KR + (hi ? 1024 : 512 + r32 * 16);
    if (ROPE) { if (tid < 16) *(int*)(lds + LDS_KR + (tid >> 2) * KRSLOT + 1024 + (tid & 3) * 4) = 0; }
    if (dma_on) { if (kwave) { DMA(0, 0); DMA(1, 1); DMA(2, 2); DMA(3, 3); } else { DMA(0, 0); DMA(1, 1); } }
    v6u qf, qrf;
    if (!ROPE) { qf = q32_to_fp6((const bf16_t*)Qv + (size_t)(wid * 32 + r32) * ldq + hi * 32, 1.0f); qrf = qf; }
    else { const f32x2 s2 = *(const f32x2*)(ssh + (size_t)(wid * 32 + r32) * 32); const float sc = rsqrtf((s2[0] + s2[1]) * (1.f / 96.f) + EPS) * (C2_MLA * 8.f);
        qf = q32_to_fp6((const bf16_t*)Qv + (size_t)(wid * 32 + r32) * ldq + hi * 32, sc);
        qrf = q32_to_fp6(Qr + (size_t)(wid * 32 + r32) * 512, hi ? 0.f : sc); }
    f32x16 o[2]; o[0] = f32x16{}; o[1] = f32x16{}; f32x16 lacc = f32x16{};
    v8i ones;
#pragma unroll
    for (int i = 0; i < 8; ++i) ones[i] = 0x38383838;
    PIN(ones);
    f32x16 m4;
    { float y_ = YOFF; asm volatile("" : "+v"(y_));
#pragma unroll
      for (int r = 0; r < 16; ++r) m4[r] = y_; }
    PIN(m4);
    v4i kf0, kf1, krf0, krf1; v8i vf0, vf1, pfA, pfB;
#define ROT() do { } while (0)
#define EX(v) __builtin_amdgcn_exp2f(v)
#define KLOAD(si) do { kf0 = lds128(kpa + (si) * KSLOT); kf1 = lds128(kpa + (si) * KSLOT + 1024); if (ROPE) { krf0 = lds128(ra0 + (si) * KRSLOT); krf1 = lds128(ra1 + (si) * KRSLOT); } } while (0)
    WAIT_BAR0();
    KLOAD(0);
    { f32x16 c0 = QKMFMA(kf0, qf, m4), c1 = QKMFMA(kf1, qf, m4);
      if (ROPE) { c0 = QKMFMA(krf0, qrf, c0); c1 = QKMFMA(krf1, qrf, c1); }
      PK16U8(c0, pfA, 0); PK16U8(c1, pfA, 4); }
    WAIT_BAR0();
    if (dma_on) { if (kwave) { if (4 < NT) DMA(4, 0); } else DMA(2, 2); }
    KLOAD(1);
    WAIT_BAR1();
#define VRD2(m) do { const v2i a_ = vtr8(vp0 + vsl_ * SLOT + (m) * 1024), b_ = vtr8(vp1 + vsl_ * SLOT + (m) * 1024); vf0[2 * (m)] = a_[0]; vf0[2 * (m) + 1] = a_[1]; vf1[2 * (m)] = b_[0]; vf1[2 * (m) + 1] = b_[1]; } while (0)
#define STEP(t, PFP, PFN, GK, GV, GL) do { SBAR(); \
    const int vsl_ = ((t) - 1) & 3; f32x16 C0, C1; \
    VRD2(0); VRD2(1); SBAR(); \
    C0 = QKMFMA(kf0, qf, m4); if (ROPE) C0 = QKMFMA(krf0, qrf, C0); PIN(C0); SBAR(); \
    VRD2(2); VRD2(3); SBAR(); \
    C1 = QKMFMA(kf1, qf, m4); if (ROPE) C1 = QKMFMA(krf1, qrf, C1); PIN(C1); SBAR(); \
    if (GL) { KLOAD(((t) + 1) & 3); } \
    { const bool mine_ = dma_on && (kwave ? (GK) : (GV)); if (mine_) DMA((t) + dlead, kwave ? ((t) & 3) : (((t) + 2) & 3)); } \
    SBAR(); \
    lacc = PVMFMA8(PFP, ones, lacc); PIN(lacc); SBAR(); \
    PK16U8(C0, PFN, 0); PIN(PFN); SBAR(); \
    o[0] = PVMFMA8(PFP, vf0, o[0]); PIN(o[0]); SBAR(); \
    PK16U8(C1, PFN, 4); PIN(PFN); SBAR(); \
    o[1] = PVMFMA8(PFP, vf1, o[1]); PIN(o[1]); SBAR(); \
    { const bool mine_ = dma_on && (kwave ? (GK) : (GV)); if (mine_) WAIT_BAR1(); else WAIT_BAR0(); } \
    } while (0)
    int t = 1;
    for (; t + 5 < NT; t += 2) {
        STEP(t, pfA, pfB, true, true, true);     ROT();
        STEP(t + 1, pfB, pfA, true, true, true); ROT();
    }
    for (; t + 1 < NT; t += 2) {
        STEP(t, pfA, pfB, (t + 4 < NT), (t + 2 < NT), (t + 1 < NT));         ROT();
        STEP(t + 1, pfB, pfA, (t + 5 < NT), (t + 3 < NT), (t + 2 < NT));     ROT();
    }
    STEP(NT - 1, pfA, pfB, false, false, false);
    { const int vsl_ = (NT - 1) & 3; VRD2(0); VRD2(1); VRD2(2); VRD2(3);
      lacc = PVMFMA8(pfB, ones, lacc); o[0] = PVMFMA8(pfB, vf0, o[0]); o[1] = PVMFMA8(pfB, vf1, o[1]); }
    float rli[16];
#pragma unroll
    for (int r = 0; r < 16; ++r) rli[r] = __builtin_amdgcn_rcpf(lacc[r]);
    bf16_t* stg = (bf16_t*)(lds + LDS_OST) + wid * 2048;
#pragma unroll
    for (int r = 0; r < 16; ++r) { const int orow = crow(r, hi);
#pragma unroll
        for (int d0 = 0; d0 < 2; ++d0) stg[orow * 64 + d0 * 32 + r32] = (bf16_t)f2bf(o[d0][r] * rli[r]); }
    asm volatile("s_waitcnt lgkmcnt(0)" ::: "memory");
#pragma unroll
    for (int i = 0; i < 4; ++i) { const int row = i * 8 + (lane >> 3), ch = lane & 7; const size_t goff = (size_t)(wid * 32 + row) * ldo + ch * 8;
        const u32x4 ov = *(const u32x4*)(stg + row * 64 + ch * 8); const u32x4 gv = *(const u32x4*)(G + goff); u32x4 w;
#pragma unroll
        for (int q = 0; q < 4; ++q) { const float lo = __uint_as_float(ov[q] << 16) * __uint_as_float(gv[q] << 16), hh = __uint_as_float(ov[q] & 0xffff0000u) * __uint_as_float(gv[q] & 0xffff0000u); w[q] = cvtpk(lo, hh); }
        *(u32x4*)(O + goff) = w; }
    asm volatile("s_waitcnt lgkmcnt(0)\n\ts_barrier" ::: "memory");
#undef DMA
#undef ROT
#undef EX
#undef KLOAD
#undef VRD2
#undef STEP
}
#undef SBAR
#undef PIN
#undef WAIT_BAR0
#undef WAIT_BAR1
#undef QKMFMA
#undef V8
#undef V6
#undef PVMFMA8
}

#define RLX_AGENT __ATOMIC_RELAXED, __HIP_MEMORY_SCOPE_AGENT
#define XB_TMO      128
#define XB_XCNT(j)  (256  + 64 * (j))
#define XB_XSUB(j)  (1280 + 64 * (j))
#define XB_XGEN(j)  (2304 + 64 * (j))
#define XB_TOP      3328
#define XB_TOPGEN   3392
#define XCD_BAR_WORDS 3456
#define XB_SPIN_CAP (1u << 18)

__device__ __forceinline__ unsigned xb_ld(unsigned* p)              { return __hip_atomic_load(p, __ATOMIC_RELAXED, __HIP_MEMORY_SCOPE_AGENT); }
__device__ __forceinline__ unsigned xb_add(unsigned* p, unsigned v) { return __hip_atomic_fetch_add(p, v, __ATOMIC_RELAXED, __HIP_MEMORY_SCOPE_AGENT); }
__device__ __forceinline__ unsigned xb_xcc_id() { return (unsigned)__builtin_amdgcn_s_getreg((3 << 11) | 20) & 0xFu; }
#define XB_SPIN(cond, bar) do { unsigned _sp = 0; while (cond) { __builtin_amdgcn_s_sleep(1); \
    if ((++_sp & 255u) == 0u) { if (xb_ld(&(bar)[XB_TMO])) break; if (_sp > XB_SPIN_CAP) { atomicAdd(&(bar)[XB_TMO], 1u); break; } } } } while (0)

struct XcdBarrier {
    unsigned* bar; unsigned x;
    volatile LAS unsigned* st;
};

__device__ __forceinline__ XcdBarrier xcd_barrier_post(unsigned* bar, volatile LAS unsigned* st) {
    XcdBarrier b; b.bar = bar; b.x = xb_xcc_id(); b.st = st;
    if (threadIdx.x == 0) (void)xb_add(&bar[XB_XCNT(b.x)], 1u);
    return b;
}
__device__ __forceinline__ void xcd_barrier_complete(unsigned* bar, unsigned x, unsigned& nloc, unsigned& nx) {
    const unsigned G = gridDim.x * gridDim.y * gridDim.z;
    unsigned sum, cnt, mine, sp = 0u;
    for (;;) {
        sum = 0u; cnt = 0u; mine = 0u;
#pragma unroll
        for (unsigned j = 0; j < 16; ++j) { const unsigned c = xb_ld(&bar[XB_XCNT(j)]); sum += c; cnt += (c > 0u) ? 1u : 0u; mine = (j == x) ? c : mine; }
        if (sum == G) break;
        __builtin_amdgcn_s_sleep(1);
        if ((++sp & 255u) == 0u) { if (xb_ld(&bar[XB_TMO])) break; if (sp > XB_SPIN_CAP) { atomicAdd(&bar[XB_TMO], 1u); break; } }
    }
    nloc = mine > 0u ? mine : 1u; nx = cnt > 0u ? cnt : 1u;
}

__device__ __forceinline__ void xcd_barrier(const XcdBarrier& b) {
    asm volatile("s_waitcnt vmcnt(0)" ::: "memory");
    __syncthreads();
    if (threadIdx.x == 0) {
        unsigned* bar = b.bar;
        __builtin_amdgcn_s_waitcnt(0);
        unsigned nloc = b.st[0], nx = b.st[1];
        if (nloc == 0u) { xcd_barrier_complete(bar, b.x, nloc, nx); b.st[0] = nloc; b.st[1] = nx; }
        const unsigned old = xb_add(&bar[XB_XSUB(b.x)], 1u);
        const unsigned gen = old / nloc;
        if (old + 1u == (gen + 1u) * nloc) {
            __builtin_amdgcn_fence(__ATOMIC_RELEASE, "agent");
            asm volatile("s_waitcnt vmcnt(0)" ::: "memory");
            const unsigned og = xb_add(&bar[XB_TOP], 1u);
            const unsigned tg = og / nx;
            if (og + 1u == (tg + 1u) * nx) xb_add(&bar[XB_TOPGEN], 1u);
            else XB_SPIN(xb_ld(&bar[XB_TOPGEN]) == tg, bar);
            __builtin_amdgcn_fence(__ATOMIC_ACQUIRE, "agent");
            xb_add(&bar[XB_XGEN(b.x)], 1u);
            asm volatile("s_waitcnt vmcnt(0)" ::: "memory");
        } else {
            XB_SPIN(xb_ld(&bar[XB_XGEN(b.x)]) == gen, bar);
            __builtin_amdgcn_fence(__ATOMIC_ACQUIRE, "agent");
            asm volatile("s_waitcnt vmcnt(0)" ::: "memory");
        }
    }
    __syncthreads();
}


#include <hip/hip_cooperative_groups.h>
namespace cg = cooperative_groups;
constexpr int NWAVES = 8, NTHREADS = 512, LDS_BYTES = 147456, RING_BYTES = 131072;
constexpr size_t MiB = 1u << 20;
constexpr size_t WS_MOD = 1 * MiB;
constexpr size_t WS_TABA = WS_MOD + 128 * 1024;
constexpr size_t WS_TABB = WS_TABA + 32 * 1024;
constexpr size_t WS_WIN0 = 2 * MiB;
constexpr size_t WS_WOUT0 = 7 * MiB;
constexpr size_t WS_WIN1 = 9 * MiB;
constexpr size_t WS_WKVB = 13 * MiB;
constexpr size_t WS_WQB = 14 * MiB;
constexpr size_t WS_WOUT1 = 16 * MiB;
constexpr size_t WS_X1C = 18 * MiB;
constexpr size_t WS_H = 20 * MiB;
constexpr size_t WS_Q = 53 * MiB;
constexpr size_t WS_K = 86 * MiB;
constexpr size_t WS_V0 = 95 * MiB;
constexpr size_t WS_G = 120 * MiB;
constexpr size_t WS_V1 = 153 * MiB;
constexpr size_t WS_KVA = 186 * MiB;
constexpr size_t WS_QA = 195 * MiB;
constexpr size_t WS_Q1R = 207 * MiB;
constexpr size_t WS_KR = 223 * MiB;
constexpr size_t WS_SSKV = 225 * MiB;
constexpr size_t WS_SSQ = 226 * MiB;
constexpr size_t WS_SSH = 227 * MiB;
constexpr size_t WS_SSX = 229 * MiB;
constexpr size_t WS_BIAS1 = WS_MOD + 80 * 1024;
constexpr size_t WS_NWM1 = WS_MOD + 104 * 1024;
constexpr size_t WS_RINV = 230 * MiB + 512 * 1024;
constexpr size_t WS_SLAB = 231 * MiB;
constexpr size_t WS_END = 256 * MiB;
static_assert(WS_K + (size_t)NB * TK * DM * 2 <= WS_G && WS_G + (size_t)MT * DM * 2 <= WS_V1 && WS_V1 + (size_t)NB * TK * DM * 2 <= WS_KVA && WS_SSH + (size_t)ML * 32 * 4 <= WS_END, "ws map");

#ifndef ATT1_F8
#define ATT1_F8 1
#endif
#ifndef ATT0_F8
#define ATT0_F8 1
#endif
struct Args { const float* in[23]; float* out; unsigned char* ws; int ph_lo, ph_hi, coop, pad; };

DEVI void phase0(const Args& a, unsigned char* ws, LAS unsigned char* lds, int vb, int G) {
    const int tid = threadIdx.x, wave = tid >> 6, lane = tid & 63;
    float* mod = (float*)(ws + WS_MOD);
    if (vb < 96) {
        LAS float* sc = (LAS float*)lds; LAS float* red = sc + 3 * 1024;
        const int layer = vb / 48, cs = vb % 48; const float* w = a.in[layer ? 11 : 4]; const float* bb = a.in[layer ? 12 : 5];
        for (int i = tid; i < 3072; i += NTHREADS) { const int r = i >> 10, k = i & 1023; const float v = r < 2 ? a.in[1][r * 1024 + k] : a.in[3][k]; sc[i] = v / (1.f + expf(-v)); }
        __syncthreads();
        const int col = cs * 64 + lane; float a0 = 0.f, a1 = 0.f, a2 = 0.f;
#pragma unroll 8
        for (int k = wave * 128; k < wave * 128 + 128; ++k) { const float wv = w[(size_t)k * 3072 + col]; a0 += sc[k] * wv; a1 += sc[1024 + k] * wv; a2 += sc[2048 + k] * wv; }
        red[(wave * 3 + 0) * 64 + lane] = a0; red[(wave * 3 + 1) * 64 + lane] = a1; red[(wave * 3 + 2) * 64 + lane] = a2;
        __syncthreads();
        if (tid < 192) { const int r = tid >> 6; float s = 0.f;
#pragma unroll
            for (int q = 0; q < 8; ++q) s += red[(q * 3 + r) * 64 + lane];
            mod[(size_t)(layer * 3 + r) * 3072 + col] = s + bb[col]; }
        __syncthreads();
    } else if (vb < 102) {
        f32x2* tabA = (f32x2*)(ws + WS_TABA); f32x2* tabB = (f32x2*)(ws + WS_TABB);
        const int i = (vb - 96) * NTHREADS + tid;
        if (i < 128 * 16) { const int pos = i >> 4, f = i & 15; const float invf = powf(10000.f, -(float)f / 16.f); float cs_, sn_; sincos_pos((float)pos * invf, cs_, sn_); tabA[i] = (f32x2){cs_, sn_}; }
        else if (i < 128 * 24) { const int j = i - 128 * 16, pos = j >> 3, f = j & 7; const float invf = powf(10000.f, -(float)f / 8.f); float cs_, sn_; sincos_pos((float)pos * invf, cs_, sn_); tabB[j] = (f32x2){cs_, sn_}; }
    }
    if (vb < 102 || G <= 102) { if (G > 102) return; }
    struct WD { int src, K, Nsrc, Np, mode, ks; size_t dst; };
    const WD wd[6] = {{7, 1024, N_IN0, 2560, 1, -1, WS_WIN0}, {10, 1024, 1024, 1024, 0, -1, WS_WOUT0}, {14, 1024, N_IN1, N_IN1P, 2, -1, WS_WIN1},
                      {16, 256, 2048, 2048, 3, 15, WS_WKVB}, {18, 384, 1536, 2048, 4, 17, WS_WQB}, {22, 1024, 1024, 1024, 0, -1, WS_WOUT1}};
    LAS float* tl = (LAS float*)lds; int tbase = 0;
#pragma unroll
    for (int m = 0; m < 6; ++m) {
        const float* W = a.in[wd[m].src]; const float* ks = wd[m].ks >= 0 ? a.in[wd[m].ks] : nullptr; bf16_t* Bt = (bf16_t*)(ws + wd[m].dst);
        const int K = wd[m].K, Nsrc = wd[m].Nsrc, Np = wd[m].Np, npb = Np / 256, ntile = (K / 64) * npb;
        for (int it = ((vb - 102) - tbase % (G - 102) + (G - 102)) % (G - 102); it < ntile; it += (G - 102)) {
            const int kb = it / npb, pb = it % npb, k0 = 64 * kb, p0 = 256 * pb;
            const int pl = tid & 255, kh = tid >> 8; int cc = pg8::wmap(wd[m].mode, p0 + pl); if (cc >= Nsrc) cc = -1;
            float v[32];
#pragma unroll
            for (int i = 0; i < 32; ++i) { const int k = k0 + 2 * i + kh; v[i] = cc >= 0 ? W[(size_t)k * Nsrc + cc] * (ks ? ks[k] : 1.f) : 0.f; }
#pragma unroll
            for (int i = 0; i < 32; ++i) tl[pl * 65 + 2 * i + kh] = v[i];
            __syncthreads();
#pragma unroll
            for (int j = 0; j < 4; ++j) { const int q = tid + 512 * j, pr = q >> 3, c = q & 7; const LAS float* sp = tl + pr * 65 + 8 * c;
                u32x4 o; o.x = pk2(sp[0], sp[1]); o.y = pk2(sp[2], sp[3]); o.z = pk2(sp[4], sp[5]); o.w = pk2(sp[6], sp[7]);
                *(u32x4*)(Bt + (size_t)(p0 + pr) * K + k0 + 8 * c) = o; }
            __syncthreads();
        }
        tbase += ntile;
    }
}

DEVI void phase_prep(const float* xa, const float* xb, const float* nw, const float* mod, bf16_t* H, int gw, int NGW, int lane) {
    for (int row0 = gw; row0 < MT; row0 += 4 * NGW) {
        f32x4 v[4][4]; float ss[4];
#pragma unroll
        for (int q = 0; q < 4; ++q) { const int row = row0 + q * NGW; ss[q] = 0.f;
            if (row < MT) { const float* src = row < ML ? xa + (size_t)row * DM : xb + (size_t)(row - ML) * DM;
#pragma unroll
                for (int j = 0; j < 4; ++j) v[q][j] = *(const f32x4*)(src + 4 * lane + 256 * j); } }
#pragma unroll
        for (int q = 0; q < 4; ++q) { const int row = row0 + q * NGW;
            if (row < MT) {
#pragma unroll
                for (int j = 0; j < 4; ++j) ss[q] += (v[q][j].x * v[q][j].x + v[q][j].y * v[q][j].y) + (v[q][j].z * v[q][j].z + v[q][j].w * v[q][j].w); } }
#pragma unroll
        for (int o = 1; o < 64; o <<= 1) {
#pragma unroll
            for (int q = 0; q < 4; ++q) ss[q] += __shfl_xor(ss[q], o); }
#pragma unroll
        for (int q = 0; q < 4; ++q) { const int row = row0 + q * NGW;
            if (row < MT) { const int r = row < SEQ ? 0 : (row < ML ? 1 : 2); const float rinv = rsqrtf(ss[q] * (1.f / DM) + EPS);
#pragma unroll
                for (int j = 0; j < 4; ++j) { const int cidx = 4 * lane + 256 * j; const f32x4 w = *(const f32x4*)(nw + cidx);
                    const f32x4 sh = *(const f32x4*)(mod + (size_t)r * 3072 + cidx), scl = *(const f32x4*)(mod + (size_t)r * 3072 + 1024 + cidx);
                    const f32x4 h = (v[q][j] * rinv) * w * (scl + 1.f) + sh;
                    u32x2 o; o.x = pk2(h.x, h.y); o.y = pk2(h.z, h.w); *(u32x2*)(H + (size_t)row * DM + cidx) = o; } } }
    }
}

DEVI float sq4f(const f32x4 v) { return (v[0] * v[0] + v[1] * v[1]) + (v[2] * v[2] + v[3] * v[3]); }
DEVI void phase1_extras(const float* nw1, const float* mod1, const bf16_t* Win1t, float* nwm1, float* bias1, const float* ctx, float* X1c, int gw, int NGW, int lane) {
    for (int p = gw; p < N_IN1P; p += NGW) {
        const u32x4 w0 = *(const u32x4*)(Win1t + (size_t)p * DM + lane * 16), w1 = *(const u32x4*)(Win1t + (size_t)p * DM + lane * 16 + 8); float acc3[3];
#pragma unroll
        for (int r = 0; r < 3; ++r) { const float* mp = mod1 + (size_t)r * 3072 + lane * 16; const f32x4 m0 = *(const f32x4*)mp, m1 = *(const f32x4*)(mp + 4), m2 = *(const f32x4*)(mp + 8), m3 = *(const f32x4*)(mp + 12);
            const float mm[16] = {m0[0], m0[1], m0[2], m0[3], m1[0], m1[1], m1[2], m1[3], m2[0], m2[1], m2[2], m2[3], m3[0], m3[1], m3[2], m3[3]}; float a = 0.f;
#pragma unroll
            for (int i = 0; i < 8; ++i) { const unsigned ww = i < 4 ? w0[i] : w1[i - 4]; a += mm[2 * i] * __uint_as_float(ww << 16) + mm[2 * i + 1] * __uint_as_float(ww & 0xffff0000u); }
            acc3[r] = wave_sum(a); }
        if (lane == 0) { bias1[p] = acc3[0]; bias1[N_IN1P + p] = acc3[1]; bias1[2 * N_IN1P + p] = acc3[2]; }
    }
    for (int i = gw * 64 + lane; i < 3 * DM; i += NGW * 64) { const int r = i >> 10, c = i & 1023; nwm1[i] = nw1[c] * (1.f + mod1[(size_t)r * 3072 + 1024 + c]); }
}
DEVI void phase_ctxprep(const float* ctx, const float* slab, const float* gatec, float* X1c, const float* nwm1, bf16_t* H, const float* SSX, float* RINV, int gw, int NGW, int lane) {
    for (int rr = gw; rr < MC; rr += NGW) { const int R = ML + rr; float ss = 0.f;
#pragma unroll
        for (int j = 0; j < 4; ++j) { const int c = 4 * lane + 256 * j; f32x4 y = *(const f32x4*)(slab + (size_t)rr * DM + c);
#pragma unroll
            for (int ks = 1; ks < 8; ++ks) y = y + *(const f32x4*)(slab + ((size_t)ks * MC + rr) * DM + c);
            const f32x4 v = *(const f32x4*)(ctx + (size_t)rr * DM + c) + *(const f32x4*)(gatec + c) * y; *(f32x4*)(X1c + (size_t)rr * DM + c) = v;
            ss += sq4f(v); const f32x4 h = v * *(const f32x4*)(nwm1 + 2 * DM + c);
            u32x2 o; o.x = pk2(h.x, h.y); o.y = pk2(h.z, h.w); *(u32x2*)(H + (size_t)R * DM + c) = o; }
        ss = wave_sum(ss); if (lane == 0) RINV[R] = rsqrtf(ss * (1.f / DM) + EPS); }
    for (int R = gw * 64 + lane; R < ML; R += NGW * 64) { const f32x4 s0 = *(const f32x4*)(SSX + (size_t)R * 16), s1 = *(const f32x4*)(SSX + (size_t)R * 16 + 4), s2 = *(const f32x4*)(SSX + (size_t)R * 16 + 8), s3 = *(const f32x4*)(SSX + (size_t)R * 16 + 12);
        const f32x4 st = (s0 + s1) + (s2 + s3); RINV[R] = rsqrtf(((st[0] + st[1]) + (st[2] + st[3])) * (1.f / DM) + EPS); }
}

#ifdef MK_UBENCH
DEVI void ubench(int wave) {
    typedef int v8i __attribute__((ext_vector_type(8)));
    if ((MK_UBENCH & 4) && wave >= 4) return;
    v8i a, b; f32x16 acc = f32x16{}; float e[8]; float d = 0.f;
#pragma unroll
    for (int i = 0; i < 8; ++i) { a[i] = 0x38383838; b[i] = 0x38383838; e[i] = 0.001f * (float)(i + 1); }
    asm volatile("" : "+v"(a), "+v"(b));
    bf16x8 ha, hb; asm volatile("" : "=v"(ha), "=v"(hb));
    for (int it = 0; it < 1500; ++it) {
        if (MK_UBENCH & 1) { if (MK_UBENCH & 16) { acc = __builtin_amdgcn_mfma_f32_32x32x16_bf16(ha, hb, acc, 0, 0, 0); acc = __builtin_amdgcn_mfma_f32_32x32x16_bf16(ha, hb, acc, 0, 0, 0); }
                             else acc = __builtin_amdgcn_mfma_scale_f32_32x32x64_f8f6f4(a, b, acc, 0, 0, 0, 127, 0, 127); }
        if (MK_UBENCH & 2) {
#pragma unroll
            for (int i = 0; i < 8; ++i) e[i] = __builtin_amdgcn_exp2f(e[i]) * 0.5f; }
        if (MK_UBENCH & 8) {
#pragma unroll
            for (int i = 0; i < 16; ++i) asm volatile("v_add_f32 %0, %0, %1" : "+v"(e[i & 7]) : "v"(d)); }
        asm volatile("" : "+v"(acc)); __builtin_amdgcn_sched_barrier(0);
    }
#pragma unroll
    for (int i = 0; i < 8; ++i) asm volatile("" :: "v"(e[i]));
    asm volatile("" :: "v"(acc));
}
#endif
__global__ void __launch_bounds__(NTHREADS, 2) mega(Args a) {
    extern __shared__ __attribute__((aligned(16))) unsigned char lds[];
    const int tid = threadIdx.x, lane = tid & 63; const int wave = __builtin_amdgcn_readfirstlane(tid >> 6);
    const int G = gridDim.x, bx = blockIdx.x; const int vcu = (G % 8 == 0) ? (bx % 8) * (G / 8) + bx / 8 : bx;
    unsigned char* ws = a.ws; float* out = a.out;
    const float* x = a.in[0]; const float* ctx = a.in[2];
    float* mod = (float*)(ws + WS_MOD); const f32x4* tabA = (const f32x4*)(ws + WS_TABA); const f32x4* tabB = (const f32x4*)(ws + WS_TABB);
    bf16_t* H = (bf16_t*)(ws + WS_H); bf16_t* Qb = (bf16_t*)(ws + WS_Q); bf16_t* K0 = (bf16_t*)(ws + WS_K); bf16_t* V0 = (bf16_t*)(ws + WS_V0); bf16_t* K1 = (bf16_t*)(ws + WS_K);
    bf16_t* Gb = (bf16_t*)(ws + WS_G); bf16_t* V1 = (bf16_t*)(ws + WS_V1); bf16_t* KVA = (bf16_t*)(ws + WS_KVA); bf16_t* QA = (bf16_t*)(ws + WS_QA); bf16_t* Q1R = (bf16_t*)(ws + WS_Q1R);
    bf16_t* O0 = (bf16_t*)(ws + WS_V1); bf16_t* O1 = (bf16_t*)(ws + WS_H); bf16_t* KR = (bf16_t*)(ws + WS_KR); float* SSKV = (float*)(ws + WS_SSKV); float* SSQ = (float*)(ws + WS_SSQ); float* SSH = (float*)(ws + WS_SSH); float* X1c = (float*)(ws + WS_X1C); float* SSX = (float*)(ws + WS_SSX); float* BIAS1 = (float*)(ws + WS_BIAS1); float* NWM1 = (float*)(ws + WS_NWM1);
#ifdef MK_TS
#define MK_TS_SEAM (MK_TS >= 100 ? (MK_TS % 100) : MK_TS / 2)
#define MK_TS_WHAT (MK_TS % 2)
#endif
#ifdef MK_TS_SEAM
    const unsigned long long ts0 = __builtin_amdgcn_s_memrealtime(); unsigned long long ts1 = ts0, ts2 = ts0;
#endif
    const int lo = a.ph_lo, hi_ = a.ph_hi;
#ifndef ONLY_PHASE
#define ONLY_PHASE -1
#endif
#define IN(k) ((ONLY_PHASE < 0 || ONLY_PHASE == (k)) && lo <= (k) && (k) < hi_)
#ifndef MK_REP_MASK
#define MK_REP_MASK 0
#endif
#define REPS(k) (((MK_REP_MASK >> (k)) & 1) ? 2 : 1)
#ifdef MK_TS_SEAM
#define SEAM(k) do { if (IN(k) && IN((k) + 1)) { if ((k) == MK_TS_SEAM) { ts1 = __builtin_amdgcn_s_memrealtime(); if (tid == 0) { atomicMax((unsigned*)ws + 4000, (unsigned)(ts1 - ts0)); atomicMax((unsigned*)ws + 4001, ((unsigned)(ts1 - ts0) << 10) | (unsigned)bx); } } xcd_barrier(xbar); if ((k) == MK_TS_SEAM) ts2 = __builtin_amdgcn_s_memrealtime(); } } while (0)
#else
#define SEAM(k) do { if (IN(k) && IN((k) + 1)) { xcd_barrier(xbar); } } while (0)
#endif
    PG8_LAS unsigned char* ring = (PG8_LAS unsigned char*)lds;
    volatile LAS unsigned* xst = (volatile LAS unsigned*)((LAS unsigned char*)lds + RING_BYTES + 512);
    if (tid < 4) xst[tid] = 0u;
    __syncthreads();
    XcdBarrier xbar; xbar.bar = (unsigned*)ws; xbar.x = 0; xbar.st = xst;
    if (a.coop) xbar = xcd_barrier_post((unsigned*)ws, xst);
    if (a.coop == 0x7fffffff) cg::this_grid().sync();

    if (IN(0)) for (int rep_ = 0; rep_ < REPS(0); ++rep_) { phase0(a, ws, (LAS unsigned char*)lds, bx, G); } SEAM(0);
    if (IN(1)) for (int rep_ = 0; rep_ < REPS(1); ++rep_) { phase1_extras(a.in[13], mod + 3 * 3072, (const bf16_t*)(ws + WS_WIN1), NWM1, BIAS1, ctx, X1c, vcu * NWAVES + wave, G * NWAVES, lane);
        phase_prep(x, ctx, a.in[6], mod, H, vcu * NWAVES + wave, G * NWAVES, lane); } SEAM(1);
    if (IN(2)) { pg8::Gemm g{H, (const bf16_t*)(ws + WS_WIN0), MT, N_IN0, 1024}; pg8::ROrder S; S.init(0, MT / 256, N_IN0, G, bx, REPS(2));
        pg8::EpiIn0<ATT0_F8> E{a.in[8], a.in[9], tabA, K0, V0, Qb, Gb};
        pg8::gemm_phase<pg8::EpiIn0<ATT0_F8>, pg8::ROrder, true, true>(ring, g, S, E); } SEAM(2);
#ifdef MK_CLOCK_PROBE
    unsigned long long pc0 = 0, pr0 = 0, pc1 = 0, pr1 = 0;
    if (IN(3)) { pc0 = __builtin_readcyclecounter(); pr0 = __builtin_amdgcn_s_memrealtime(); }
#endif
    if (IN(3)) for (int rep_ = 0; rep_ < REPS(3); ++rep_) {
        const int xg = vcu >> 5, c = vcu & 31, b = xg >> 2, kvh = xg & 3; const size_t kbase = (size_t)b * TK * 256 + kvh * 64;
#if ATT0_F8
        const unsigned char* K8 = (const unsigned char*)K0 + (size_t)b * TK * 128 + kvh * 32; const unsigned char* V8 = (const unsigned char*)V0 + kbase;
        for (int i = 0; i < 4; ++i) { const int h = kvh * 4 + i; const size_t q0 = ((size_t)b * SEQ + c * 256) * DM + h * 64;
            af8::attn_unit<0>(Qb + q0, DM, nullptr, nullptr, K8, 128, nullptr, V8, 256, TK / 64, O0 + q0, Gb + q0, DM, (char*)lds); }
        if (c < 4) { const int h = kvh * 4 + c; const size_t q0 = ((size_t)ML + b * CTXL) * DM + h * 64;
            af8::attn_unit<0>(Qb + q0, DM, nullptr, nullptr, K8, 128, nullptr, V8, 256, CTXL / 64, O0 + q0, Gb + q0, DM, (char*)lds); }
#else
        for (int i = 0; i < 4; ++i) { const int h = kvh * 4 + i; const size_t q0 = ((size_t)b * SEQ + c * 256) * DM + h * 64;
            afast::attn_unit<0>(Qb + q0, DM, nullptr, nullptr, K0 + kbase, 256, nullptr, V0 + kbase, 256, TK / 64, O0 + q0, Gb + q0, DM, (char*)lds); }
        if (c < 4) { const int h = kvh * 4 + c; const size_t q0 = ((size_t)ML + b * CTXL) * DM + h * 64;
            afast::attn_unit<0>(Qb + q0, DM, nullptr, nullptr, K0 + kbase, 256, nullptr, V0 + kbase, 256, CTXL / 64, O0 + q0, Gb + q0, DM, (char*)lds); }
#endif
    } SEAM(3);
#ifdef MK_CLOCK_PROBE
    if (IN(3)) { pc1 = __builtin_readcyclecounter(); pr1 = __builtin_amdgcn_s_memrealtime(); }
#endif
    if (IN(4)) {
        { pg8::Gemm g{O0, (const bf16_t*)(ws + WS_WOUT0), ML, 1024, 1024, 0}; pg8::ROrder S; S.init(0, ML / 256, 1024, G, bx, REPS(4));
          pg8::EpiOutF E{x, out, mod + 2048, NWM1, H, SSX};
          pg8::gemm_phase<pg8::EpiOutF, pg8::ROrder, true, true>(ring, g, S, E); }
        { pg8::Gemm g{O0, (const bf16_t*)(ws + WS_WOUT0), MT, 1024, 1024, 128}; pg8::CtxSplitOrder S; S.init(bx, 8, 128);
          pg8::EpiOutSlab E{(float*)(ws + WS_SLAB), 128};
          pg8::gemm_phase<pg8::EpiOutSlab, pg8::CtxSplitOrder, true, true>(ring, g, S, E); }
    } SEAM(4);
    if (IN(5)) { phase_ctxprep(ctx, (const float*)(ws + WS_SLAB), mod + 2048 + 2 * 3072, X1c, NWM1, H, SSX, (float*)(ws + WS_RINV), vcu * NWAVES + wave, G * NWAVES, lane); } SEAM(5);
    if (IN(6)) { pg8::Gemm g{H, (const bf16_t*)(ws + WS_WIN1), MT, N_IN1P, 1024}; pg8::In1Order S; S.init(G, bx);
        pg8::EpiIn1<ATT1_F8> E{a.in[21], tabB, KVA, SSKV, QA, SSQ, KR, Gb, (const float*)(ws + WS_RINV), BIAS1};
        pg8::gemm_phase<pg8::EpiIn1<ATT1_F8>, pg8::In1Order, true, true>(ring, g, S, E); } SEAM(6);
    if (IN(7)) {
        { pg8::Gemm g{KVA, (const bf16_t*)(ws + WS_WKVB), MT, 2048, 256}; pg8::ROrder S; S.init(0, MT / 256, 2048, G, bx, REPS(7));
          pg8::EpiKvb<ATT1_F8> E{SSKV, a.in[20], K1, V1};
          pg8::gemm_phase<pg8::EpiKvb<ATT1_F8>, pg8::ROrder, true, true>(ring, g, S, E); }
        { pg8::Gemm g{QA, (const bf16_t*)(ws + WS_WQB), ML, 2048, 384}; pg8::ROrder S; S.init(0, ML / 256, 2048, G, bx, REPS(7));
          pg8::EpiQb E{SSQ, a.in[19], tabB, Qb, Q1R, SSH};
          pg8::gemm_phase<pg8::EpiQb, pg8::ROrder, true, true>(ring, g, S, E); }
    } SEAM(7);
    if (IN(8)) for (int rep_ = 0; rep_ < REPS(8); ++rep_) {
        const int xg = vcu >> 5, c = vcu & 31;
        for (int i = 0; i < 4; ++i) { const int s = xg + 8 * i, b = s >> 4, h = s & 15; const size_t row0 = (size_t)b * SEQ + c * 256, q0 = row0 * DM + h * 64;
#if ATT1_F8
            af8::attn_unit<1>(Qb + q0, DM, Q1R + row0 * 512 + h * 32, SSH + (row0 * 16 + h) * 2, (const unsigned char*)K1 + (size_t)b * TK * 512 + h * 32, 512, (const unsigned char*)KR + (size_t)b * TK * 16,
                              (const unsigned char*)V1 + (size_t)b * TK * DM + h * 64, DM, TK / 64, O1 + q0, Gb + q0, DM, (char*)lds); }
#else
            afast::attn_unit<1>(Qb + q0, DM, Q1R + row0 * 512 + h * 32, SSH + (row0 * 16 + h) * 2, K1 + (size_t)b * TK * DM + h * 64, DM, KR + (size_t)b * TK * 32,
                                V1 + (size_t)b * TK * DM + h * 64, DM, TK / 64, O1 + q0, Gb + q0, DM, (char*)lds); }
#endif
    } SEAM(8);
    if (IN(9)) { pg8::Gemm g{O1, (const bf16_t*)(ws + WS_WOUT1), ML, 1024, 1024}; pg8::ROrder S; S.init(0, ML / 256, 1024, G, bx);
        pg8::EpiOut E{out, nullptr, out, nullptr, mod + 3 * 3072 + 2048};
        pg8::gemm_phase<pg8::EpiOut, pg8::ROrder, true, true>(ring, g, S, E); }
#ifdef MK_TS_SEAM
    if (bx == 0 && wave == 0) { const unsigned long long tend_ = __builtin_amdgcn_s_memrealtime(); const unsigned long long w = MK_TS == 99 ? (tend_ - ts0) : MK_TS >= 100 ? (MK_TS >= 200 ? (unsigned long long)(((unsigned*)ws)[4001] & 1023u) * 100ull : (unsigned long long)((unsigned*)ws)[4000]) : (MK_TS_WHAT ? (ts2 - ts1) * 10ull : (ts1 - ts0)); const unsigned long long t0 = __builtin_amdgcn_s_memrealtime(); while (__builtin_amdgcn_s_memrealtime() - t0 < w) __builtin_amdgcn_s_sleep(8); }
#endif
#ifdef MK_UBENCH
    ubench(wave);
#endif
#ifdef MK_CLOCK_PROBE
    if (bx == 0 && wave == 0) { const unsigned long long dc = pc1 - pc0, dr = pr1 - pr0;
        const unsigned long long mhz = dr ? (dc * 100ull) / dr : 0ull;
        const unsigned long long t0 = __builtin_amdgcn_s_memrealtime(); const unsigned long long wait_ticks = mhz * 10ull;
        while (__builtin_amdgcn_s_memrealtime() - t0 < wait_ticks) __builtin_amdgcn_s_sleep(8); }
#endif
#undef IN
#undef SEAM
}

constexpr int NPHASE = 10;
#ifndef MK_ONE_LAUNCH
#define MK_ONE_LAUNCH 1
#endif
extern "C" void kernel_launch(void* const* d_in, const int* in_sizes, int n_in, void* d_out, int out_size, void* d_ws, size_t ws_size, hipStream_t stream) {
    static int grid = 0;
    if (grid == 0) {
        if (n_in != 23 || out_size != ML * DM || ws_size < WS_END) { fprintf(stderr, "kernel_launch: unexpected shapes n_in %d out %d ws %zu\n", n_in, out_size, ws_size); grid = -1; return; }
        int dev = 0, cus = 0, per_cu = 0;
        if (hipGetDevice(&dev) != hipSuccess || hipDeviceGetAttribute(&cus, hipDeviceAttributeMultiprocessorCount, dev) != hipSuccess) { grid = -1; return; }
        if (hipFuncSetAttribute((const void*)mega, hipFuncAttributeMaxDynamicSharedMemorySize, LDS_BYTES) != hipSuccess) { fprintf(stderr, "kernel_launch: hipFuncSetAttribute failed\n"); grid = -1; return; }
        if (hipOccupancyMaxActiveBlocksPerMultiprocessor(&per_cu, (const void*)mega, NTHREADS, LDS_BYTES) != hipSuccess || per_cu < 1) { fprintf(stderr, "kernel_launch: occupancy query says %d\n", per_cu); grid = -1; return; }
        grid = cus;
        if (grid != 256) fprintf(stderr, "kernel_launch: %d CUs (built for 256)\n", grid);
    }
    if (grid < 0) return;
    if (hipMemsetAsync(d_ws, 0, 16384, stream) != hipSuccess) { fprintf(stderr, "kernel_launch: memset failed\n"); return; }
    Args a{};
    for (int i = 0; i < 23; ++i) a.in[i] = (const float*)d_in[i];
    a.out = (float*)d_out; a.ws = (unsigned char*)d_ws;
#if MK_ONE_LAUNCH
    a.ph_lo = 0; a.ph_hi = NPHASE; a.coop = 1;
    void* args[] = {&a};
#ifdef MK_PLAIN_LAUNCH
    (void)args; hipLaunchKernelGGL(mega, dim3(grid), dim3(NTHREADS), LDS_BYTES, stream, a);
#else
    const hipError_t e = hipLaunchCooperativeKernel((const void*)mega, dim3(grid), dim3(NTHREADS), args, LDS_BYTES, stream);
    if (e != hipSuccess) fprintf(stderr, "kernel_launch: cooperative launch failed: %s (grid %d)\n", hipGetErrorString(e), grid);
#endif
#else
    for (int p = 0; p < NPHASE; ++p) { a.ph_lo = p; a.ph_hi = p + 1; a.coop = 0; hipLaunchKernelGGL(mega, dim3(grid), dim3(NTHREADS), LDS_BYTES, stream, a); }
    const hipError_t le = hipPeekAtLastError();
    if (le != hipSuccess) fprintf(stderr, "kernel_launch: launch failed: %s\n", hipGetErrorName(le));
#endif
}
```

```cpp
#include <hip/hip_runtime.h>
#include <hip/hip_bf16.h>
#include <cstdio>
#include <cstdint>

#define DEVI __device__ __forceinline__
#define LAS __attribute__((address_space(3)))
#define GAS __attribute__((address_space(1)))

constexpr int NB = 2, SEQ = 8192, DM = 1024, CTXL = 256, TK = SEQ + CTXL;
constexpr int ML = NB * SEQ, MC = NB * CTXL, MT = ML + MC;
constexpr int GRIDW = 64;
constexpr float EPS = 1e-6f;
constexpr float LOG2E = 1.4426950408889634f;
constexpr int N_IN0 = 2560, N_IN1 = 1696, N_IN1P = 1792;
constexpr float C2_GQA = 0.125f * LOG2E;
constexpr float C2_MLA = 0.10206207261596575f * LOG2E;

typedef unsigned short bf16_t;
typedef short bf16x8 __attribute__((ext_vector_type(8)));
typedef short s16x4 __attribute__((ext_vector_type(4)));
typedef float f32x4 __attribute__((ext_vector_type(4)));
typedef float f32x2 __attribute__((ext_vector_type(2)));
typedef float f32x16 __attribute__((ext_vector_type(16)));
typedef unsigned u32x4 __attribute__((ext_vector_type(4)));
typedef unsigned u32x2 __attribute__((ext_vector_type(2)));

DEVI float bf2f(bf16_t v) { return __uint_as_float((unsigned)v << 16); }
DEVI unsigned f2bf(float f) { unsigned u = __float_as_uint(f); return (u + 0x7fffu + ((u >> 16) & 1u)) >> 16; }
DEVI unsigned pk2(float lo, float hi) { return f2bf(lo) | (f2bf(hi) << 16); }
DEVI float wave_sum(float v) {
#pragma unroll
    for (int o = 1; o < 64; o <<= 1) v += __shfl_xor(v, o);
    return v;
}
DEVI float silu_f(float v) { return v / (1.f + __expf(-v)); }
namespace pg8 {
#define PG8_LAS __attribute__((address_space(3)))
typedef unsigned short bf16_t;
typedef short bf16x8 __attribute__((ext_vector_type(8)));
typedef float f32x4 __attribute__((ext_vector_type(4)));
typedef unsigned u32x4 __attribute__((ext_vector_type(4)));
constexpr int BM = 256, BK = 64, HALF = 128, HTB = HALF * BK * 2  , STAGE_BYTES = 8 * HTB, NXCD = 8, WGM = 8;

__host__ __device__ __forceinline__ int lds_byte(int r, int c) { const int st = (r >> 4) * 2 + (c >> 5), rr = r & 15, cc = c & 31, ob = rr * 64 + cc * 2; return st * 1024 + (ob ^ (((ob >> 9) & 1) << 5)); }
__host__ __device__ __forceinline__ void stage_rc(int b, int& R, int& C) { const int st = b / 1024, sb = b % 1024, swz = sb ^ (((sb >> 9) & 1) << 5); R = (st >> 1) * 16 + swz / 64; C = (st & 1) * 32 + (swz % 64) / 2; }
__host__ __device__ __forceinline__ int perm32(int rho) { const int n = rho >> 4, i = rho & 15; return 8 * (i >> 2) + 4 * n + (i & 3); }

struct Unit { int pm, pn, ko; };
struct Gemm { const bf16_t* A; const bf16_t* Bt; int M, N, K, Kloop; };

struct StaticOrder {
    int nM, nN, nwg, G, c;
    __host__ __device__ void init(int M, int N, int G_, int c_) { nM = M / BM; nN = N / BM; nwg = nM * nN; G = G_; c = c_; }
    __host__ __device__ bool next(int i, Unit& u) const {
        const long L = (long)i * G + c; if (L >= nwg) return false;
        int wgid = (int)L; { const int q = nwg / NXCD, r = nwg % NXCD, xcd = wgid % NXCD, off = wgid / NXCD; wgid = (xcd < r ? xcd * (q + 1) : r * (q + 1) + (xcd - r) * q) + off; }
        const int nig = WGM * nN, gid = wgid / nig, fm = gid * WGM, gsz = (nM - fm) < WGM ? (nM - fm) : WGM;
        u.pm = fm + ((wgid % nig) % gsz); u.pn = (wgid % nig) / gsz; u.ko = 0; return true;
    }
    __device__ __forceinline__ void a_ready(const Unit&) const {}
    __device__ __forceinline__ void done(const Unit&) const {}
};


struct ROrder {
    int pm0, nM, nN, nwg, G, c, rep;
    __host__ __device__ void init(int pm0_, int npm, int N, int G_, int c_, int rep_ = 1) { pm0 = pm0_; nM = npm; nN = N / BM; nwg = nM * nN; G = G_; c = c_; rep = rep_; }
    __host__ __device__ bool next(int i, Unit& u) const {
        const long L = (long)i * G + c; if (L >= (long)nwg * rep) return false;
        int wgid = (int)(L % nwg); { const int q = nwg / NXCD, r = nwg % NXCD, xcd = wgid % NXCD, off = wgid / NXCD; wgid = (xcd < r ? xcd * (q + 1) : r * (q + 1) + (xcd - r) * q) + off; }
        const int nig = WGM * nN, gid = wgid / nig, fm = gid * WGM, gsz = (nM - fm) < WGM ? (nM - fm) : WGM;
        u.pm = pm0 + fm + ((wgid % nig) % gsz); u.pn = (wgid % nig) / gsz; u.ko = 0; return true;
    }
    __device__ __forceinline__ void a_ready(const Unit&) const {}
    __device__ __forceinline__ void done(const Unit&) const {}
};

struct EpiF32 {
    static constexpr bool PERM = true, AFTER_DRAIN = false;
    float* O; int ldc; int pmbase;
    __device__ __forceinline__ void operator()(const f32x4 (&acc)[2][2][4][2], const Unit& u, int wr, int wc, int fr, int fq) const {
        const int row0 = (u.pm - pmbase) * BM + wr * 64 + fr, col0 = u.pn * BM + wc * 32 + 8 * fq;
#pragma unroll
        for (int ai = 0; ai < 2; ++ai)
#pragma unroll
            for (int m = 0; m < 4; ++m) { float* rowp = O + (size_t)(row0 + ai * HALF + m * 16) * ldc + col0;
#pragma unroll
                for (int bj = 0; bj < 2; ++bj) { *(f32x4*)(rowp + bj * HALF) = acc[ai][bj][m][0]; *(f32x4*)(rowp + bj * HALF + 4) = acc[ai][bj][m][1]; } }
    }
};

DEVI unsigned cvt_pk_bf16(float lo, float hi) { unsigned r; asm volatile("v_cvt_pk_bf16_f32 %0, %1, %2" : "=v"(r) : "v"(lo), "v"(hi)); return r; }
DEVI u32x4 pack8(const f32x4 a, const f32x4 b) { u32x4 w; w.x = cvt_pk_bf16(a[0], a[1]); w.y = cvt_pk_bf16(a[2], a[3]); w.z = cvt_pk_bf16(b[0], b[1]); w.w = cvt_pk_bf16(b[2], b[3]); return w; }
DEVI u32x2 pack8_fp8(const f32x4 a, const f32x4 b) { int w0 = 0, w1 = 0; w0 = __builtin_amdgcn_cvt_pk_fp8_f32(a[0], a[1], w0, false); w0 = __builtin_amdgcn_cvt_pk_fp8_f32(a[2], a[3], w0, true);
    w1 = __builtin_amdgcn_cvt_pk_fp8_f32(b[0], b[1], w1, false); w1 = __builtin_amdgcn_cvt_pk_fp8_f32(b[2], b[3], w1, true); return (u32x2){(unsigned)w0, (unsigned)w1}; }
DEVI unsigned pack8_fp4(const f32x4 a, const f32x4 b) { unsigned w; asm volatile("" : "=v"(w)); w = __builtin_amdgcn_cvt_scalef32_pk_fp4_f32(w, a[0], a[1], 1.0f, 0); w = __builtin_amdgcn_cvt_scalef32_pk_fp4_f32(w, a[2], a[3], 1.0f, 1);
    w = __builtin_amdgcn_cvt_scalef32_pk_fp4_f32(w, b[0], b[1], 1.0f, 2); w = __builtin_amdgcn_cvt_scalef32_pk_fp4_f32(w, b[2], b[3], 1.0f, 3); return w; }
DEVI float quad_sum(float s) { s += __shfl_xor(s, 16); s += __shfl_xor(s, 32); return s; }
DEVI float sq4(const f32x4 v) { return (v[0] * v[0] + v[1] * v[1]) + (v[2] * v[2] + v[3] * v[3]); }
DEVI f32x4 silu4(const f32x4 v) { f32x4 o; o[0] = silu_f(v[0]); o[1] = silu_f(v[1]); o[2] = silu_f(v[2]); o[3] = silu_f(v[3]); return o; }
DEVI int key_slot(int R) { return R < ML ? (R >> 13) * TK + CTXL + (R & (SEQ - 1)) : ((R - ML) >> 8) * TK + ((R - ML) & 255); }
DEVI void rot4(f32x4& x1, f32x4& x2, const f32x4 cs01, const f32x4 cs23) {
    const f32x4 c = {cs01[0], cs01[2], cs23[0], cs23[2]}, s = {cs01[1], cs01[3], cs23[1], cs23[3]};
    const f32x4 a = x1 * c - x2 * s, b = x2 * c + x1 * s; x1 = a; x2 = b;
}

DEVI int drope32(int i) { const int fq = i >> 3, n = (i >> 2) & 1, j = i & 3; return 16 * (fq >> 1) + 8 * n + 4 * (fq & 1) + j; }
DEVI int wmap(int mode, int p) {
    const int pn = p >> 8, q = p & 255, bj = q >> 7, wc = (q >> 5) & 3, i = q & 31;
    switch (mode) {
    case 1: {
        if (pn == 0 || (pn >= 2 && pn <= 5)) { const int fq = i >> 3, n = (i >> 2) & 1, j = i & 3; return 256 * pn + 64 * wc + 32 * bj + 16 * n + 4 * fq + j; }
        return p; }
    case 2: {
        if (pn == 0) return q;
        if (pn == 1) return 288 + q;
        if (pn == 2) { if (wc < 2) return 288 + 256 + 64 * wc + 32 * bj + i; if (wc == 2 && bj == 0) return 256 + drope32(i); return -1; }
        return 672 + 256 * (pn - 3) + q; }
    case 3: { const int head = 2 * pn + (wc >> 1), type = wc & 1; return 128 * head + 64 * type + 32 * bj + i; }
    case 4: { const int head = 2 * pn + (wc >> 1), type = wc & 1; if (type == 0) return 96 * head + 32 * bj + i; return bj == 0 ? 96 * head + 64 + drope32(i) : -1; }
    default: return p;
    }
}

template <bool F8> struct EpiIn0 {
    static constexpr bool PERM = true, AFTER_DRAIN = false;
    const float* qn; const float* kn; const f32x4* tabA; bf16_t* K0; bf16_t* V0; bf16_t* Q0; bf16_t* G0;
    __device__ __forceinline__ void operator()(const f32x4 (&acc)[2][2][4][2], const Unit& u, int wr, int wc, int fr_, int fq_) const {
        int fr = fr_, fq = fq_; asm volatile("" : "+v"(fr), "+v"(fq));
        const int pn = u.pn; const bool lat = u.pm < ML / BM;
        if (pn == 0 || (pn >= 2 && pn <= 5)) {
            const float* wsrc = pn == 0 ? kn : qn; const float outs = pn == 0 ? (F8 ? 2.f : 1.f) : (F8 ? C2_GQA * 8.f : C2_GQA);
            f32x4 wv[2][2];
#pragma unroll
            for (int bj = 0; bj < 2; ++bj)
#pragma unroll
                for (int n = 0; n < 2; ++n) wv[bj][n] = *(const f32x4*)(wsrc + 32 * bj + 16 * n + 4 * fq) * outs;
#pragma unroll
            for (int ai = 0; ai < 2; ++ai)
#pragma unroll
                for (int m = 0; m < 4; ++m) {
                    const int R = u.pm * BM + ai * HALF + wr * 64 + m * 16 + fr;
                    f32x4 x[2][2]; float ss = 0.f;
#pragma unroll
                    for (int bj = 0; bj < 2; ++bj)
#pragma unroll
                        for (int n = 0; n < 2; ++n) { x[bj][n] = acc[ai][bj][m][n]; ss += sq4(x[bj][n]); }
                    const float rinv = rsqrtf(quad_sum(ss) * (1.f / 64.f) + EPS);
#pragma unroll
                    for (int bj = 0; bj < 2; ++bj)
#pragma unroll
                        for (int n = 0; n < 2; ++n) x[bj][n] = x[bj][n] * rinv * wv[bj][n];
                    if (lat) { const int t = R & (SEQ - 1), trow = t >> 6, tcol = t & 63;
                        const f32x4* tr = tabA + (trow * 16 + 4 * fq) / 2; const f32x4* tc = tabA + (tcol * 16 + 4 * fq) / 2;
                        rot4(x[0][0], x[0][1], tr[0], tr[1]); rot4(x[1][0], x[1][1], tc[0], tc[1]); }
                    if (F8 && pn == 0) { unsigned char* dst = (unsigned char*)K0 + (size_t)key_slot(R) * 128 + wc * 32 + 4 * fq;
                        *(unsigned*)dst = pack8_fp4(x[0][0], x[0][1]); *(unsigned*)(dst + 16) = pack8_fp4(x[1][0], x[1][1]); }
                    else if (pn == 0) { bf16_t* dst = K0 + (size_t)key_slot(R) * 256 + wc * 64 + 8 * fq;
                        *(u32x4*)dst = pack8(x[0][0], x[0][1]); *(u32x4*)(dst + 32) = pack8(x[1][0], x[1][1]); }
                    else { bf16_t* dst = Q0 + (size_t)R * DM + ((pn - 2) * 4 + wc) * 64 + 8 * fq;
                        *(u32x4*)dst = pack8(x[0][0], x[0][1]); *(u32x4*)(dst + 32) = pack8(x[1][0], x[1][1]); }
                }
        } else if (pn == 1) {
#pragma unroll
            for (int ai = 0; ai < 2; ++ai)
#pragma unroll
                for (int m = 0; m < 4; ++m) { const int R = u.pm * BM + ai * HALF + wr * 64 + m * 16 + fr;
                    if (F8) { unsigned char* dst = (unsigned char*)V0 + (size_t)key_slot(R) * 256 + wc * 32 + 8 * fq;
#pragma unroll
                        for (int bj = 0; bj < 2; ++bj) *(u32x2*)(dst + bj * HALF) = pack8_fp8(acc[ai][bj][m][0], acc[ai][bj][m][1]); }
                    else { bf16_t* dst = V0 + (size_t)key_slot(R) * 256 + wc * 32 + 8 * fq;
#pragma unroll
                        for (int bj = 0; bj < 2; ++bj) *(u32x4*)(dst + bj * HALF) = pack8(acc[ai][bj][m][0], acc[ai][bj][m][1]); } }
        } else {
#pragma unroll
            for (int ai = 0; ai < 2; ++ai)
#pragma unroll
                for (int m = 0; m < 4; ++m) { const int R = u.pm * BM + ai * HALF + wr * 64 + m * 16 + fr; bf16_t* dst = G0 + (size_t)R * DM + (pn - 6) * BM + wc * 32 + 8 * fq;
#pragma unroll
                    for (int bj = 0; bj < 2; ++bj) *(u32x4*)(dst + bj * HALF) = pack8(silu4(acc[ai][bj][m][0]), silu4(acc[ai][bj][m][1])); }
        }
    }
};

struct EpiOut {
    static constexpr bool PERM = true, AFTER_DRAIN = false;
    const float* baseL; const float* baseC; float* dstL; float* dstC; const float* gate;
    __device__ __forceinline__ void operator()(const f32x4 (&acc)[2][2][4][2], const Unit& u, int wr, int wc, int fr_, int fq_) const {
        int fr = fr_, fq = fq_; asm volatile("" : "+v"(fr), "+v"(fq));
        const int col0 = u.pn * BM + wc * 32 + 8 * fq;
#pragma unroll
        for (int ai = 0; ai < 2; ++ai)
#pragma unroll
            for (int m = 0; m < 4; ++m) { const int R = u.pm * BM + ai * HALF + wr * 64 + m * 16 + fr; const int r = R < SEQ ? 0 : (R < ML ? 1 : 2);
                const float* b = R < ML ? baseL + (size_t)R * DM : baseC + (size_t)(R - ML) * DM; float* d = R < ML ? dstL + (size_t)R * DM : dstC + (size_t)(R - ML) * DM;
                const float* g = gate + (size_t)r * 3072;
#pragma unroll
                for (int bj = 0; bj < 2; ++bj)
#pragma unroll
                    for (int n = 0; n < 2; ++n) { const int c = col0 + bj * HALF + 4 * n; *(f32x4*)(d + c) = *(const f32x4*)(b + c) + *(const f32x4*)(g + c) * acc[ai][bj][m][n]; } }
    }
};

struct EpiOutF {
    static constexpr bool PERM = true, AFTER_DRAIN = false;
    const float* base; float* dst; const float* gate; const float* nwm; bf16_t* Hn; float* SSX;
    __device__ __forceinline__ void operator()(const f32x4 (&acc)[2][2][4][2], const Unit& u, int wr, int wc, int fr_, int fq_) const {
        int fr = fr_, fq = fq_; asm volatile("" : "+v"(fr), "+v"(fq));
        const int col0 = u.pn * BM + wc * 32 + 8 * fq;
#pragma unroll
        for (int ai = 0; ai < 2; ++ai)
#pragma unroll
            for (int m = 0; m < 4; ++m) { const int R = u.pm * BM + ai * HALF + wr * 64 + m * 16 + fr; const int r = R < SEQ ? 0 : 1;
                asm volatile("" ::: "memory");
                const float* b = base + (size_t)R * DM; float* d = dst + (size_t)R * DM; const float* g = gate + (size_t)r * 3072; const float* nw = nwm + (size_t)r * 1024; float ss = 0.f;
#pragma unroll
                for (int bj = 0; bj < 2; ++bj) { const int c = col0 + bj * HALF;
                    const f32x4 x0 = *(const f32x4*)(b + c) + *(const f32x4*)(g + c) * acc[ai][bj][m][0], x1 = *(const f32x4*)(b + c + 4) + *(const f32x4*)(g + c + 4) * acc[ai][bj][m][1];
                    *(f32x4*)(d + c) = x0; *(f32x4*)(d + c + 4) = x1; ss += sq4(x0) + sq4(x1);
                    *(u32x4*)(Hn + (size_t)R * DM + c) = pack8(x0 * *(const f32x4*)(nw + c), x1 * *(const f32x4*)(nw + c + 4)); }
                ss = quad_sum(ss); if (fq == 0) SSX[(size_t)R * 16 + u.pn * 4 + wc] = ss; }
    }
};
struct EpiOutSlab {
    static constexpr bool PERM = true, AFTER_DRAIN = false;
    float* slab; int klen;
    __device__ __forceinline__ void operator()(const f32x4 (&acc)[2][2][4][2], const Unit& u, int wr, int wc, int fr_, int fq_) const {
        int fr = fr_, fq = fq_; asm volatile("" : "+v"(fr), "+v"(fq));
        const int col0 = u.pn * BM + wc * 32 + 8 * fq; float* sb = slab + (size_t)(u.ko / klen) * MC * DM;
#pragma unroll
        for (int ai = 0; ai < 2; ++ai)
#pragma unroll
            for (int m = 0; m < 4; ++m) { const int R = u.pm * BM + ai * HALF + wr * 64 + m * 16 + fr; float* d = sb + (size_t)(R - ML) * DM + col0;
#pragma unroll
                for (int bj = 0; bj < 2; ++bj) { *(f32x4*)(d + bj * HALF) = acc[ai][bj][m][0]; *(f32x4*)(d + bj * HALF + 4) = acc[ai][bj][m][1]; } }
    }
};
struct CtxSplitOrder {
    int c, KS, klen;
    __host__ __device__ void init(int c_, int KS_, int klen_) { c = c_; KS = KS_; klen = klen_; }
    __host__ __device__ bool next(int i, Unit& u) const { if (i > 0 || c >= 8 * KS) return false; const int t = c / KS; u.pm = ML / BM + (t >> 2); u.pn = t & 3; u.ko = (c % KS) * klen; return true; }
    __device__ __forceinline__ void a_ready(const Unit&) const {}
    __device__ __forceinline__ void done(const Unit&) const {}
};

template <bool F8> struct EpiIn1 {
    static constexpr bool PERM = true, AFTER_DRAIN = false;
    const float* krn; const f32x4* tabB; bf16_t* KVA; float* SSKV; bf16_t* QA; float* SSQ; bf16_t* KR; bf16_t* G1; const float* SSX; const float* bias;
    __device__ __forceinline__ void xrow(const f32x4 (&acc)[2][2][4][2], int ai, int m, int R, int pcol0, f32x4 (&x)[2][2]) const {
        const float rinv = SSX[R];
        const float* bp = bias + (size_t)(R < SEQ ? 0 : (R < ML ? 1 : 2)) * N_IN1P + pcol0;
#pragma unroll
        for (int bj = 0; bj < 2; ++bj)
#pragma unroll
            for (int n = 0; n < 2; ++n) x[bj][n] = acc[ai][bj][m][n] * rinv + *(const f32x4*)(bp + bj * HALF + 4 * n);
    }
    __device__ __forceinline__ void operator()(const f32x4 (&acc)[2][2][4][2], const Unit& u, int wr, int wc, int fr_, int fq_) const {
        int fr = fr_, fq = fq_; asm volatile("" : "+v"(fr), "+v"(fq));
        const int pn = u.pn; const bool lat = u.pm < ML / BM; const int pcol0 = pn * BM + wc * 32 + 8 * fq;
        if (pn >= 3) {
#pragma unroll
            for (int ai = 0; ai < 2; ++ai)
#pragma unroll
                for (int m = 0; m < 4; ++m) { const int R = u.pm * BM + ai * HALF + wr * 64 + m * 16 + fr; bf16_t* dst = G1 + (size_t)R * DM + (pn - 3) * BM + wc * 32 + 8 * fq;
                    asm volatile("" ::: "memory"); f32x4 x[2][2]; xrow(acc, ai, m, R, pcol0, x);
#pragma unroll
                    for (int bj = 0; bj < 2; ++bj) *(u32x4*)(dst + bj * HALF) = pack8(silu4(x[bj][0]), silu4(x[bj][1])); }
        } else if (pn == 2 && wc == 2) {
            f32x4 wv[2];
#pragma unroll
            for (int n = 0; n < 2; ++n) wv[n] = *(const f32x4*)(krn + 16 * (fq >> 1) + 8 * n + 4 * (fq & 1));
#pragma unroll
            for (int ai = 0; ai < 2; ++ai)
#pragma unroll
                for (int m = 0; m < 4; ++m) { const int R = u.pm * BM + ai * HALF + wr * 64 + m * 16 + fr;
                    asm volatile("" ::: "memory"); f32x4 xx[2][2]; xrow(acc, ai, m, R, pcol0, xx); f32x4 x0 = xx[0][0], x1 = xx[0][1];
                    const float rinv = rsqrtf(quad_sum(sq4(x0) + sq4(x1)) * (1.f / 32.f) + EPS);
                    x0 = x0 * rinv * wv[0]; x1 = x1 * rinv * wv[1];
                    if (lat) { const int t = R & (SEQ - 1); const int pos = (fq >> 1) ? (t & 63) : (t >> 6); const f32x4* tp = tabB + (pos * 8 + 4 * (fq & 1)) / 2; rot4(x0, x1, tp[0], tp[1]); }
                    if (F8) *(unsigned*)((unsigned char*)KR + (size_t)key_slot(R) * 16 + 4 * fq) = pack8_fp4(x0 * 2.f, x1 * 2.f); else *(u32x4*)(KR + (size_t)key_slot(R) * 32 + 8 * fq) = pack8(x0, x1); }
        } else if (pn == 2 && wc == 3) {
        } else if (pn == 0 || lat) {
            bf16_t* base; float* ssb; int ld, cbase, nss, iss;
            if (pn == 0) { base = KVA; ld = 256; cbase = wc * 32; ssb = SSKV; nss = 4; iss = wc; }
            else if (pn == 1) { base = QA; ld = 384; cbase = wc * 32; ssb = SSQ; nss = 6; iss = wc; }
            else { base = QA; ld = 384; cbase = 256 + wc * 64; ssb = SSQ; nss = 6; iss = 4 + wc; }
            const int bjs = pn == 2 ? 32 : HALF;
#pragma unroll
            for (int ai = 0; ai < 2; ++ai)
#pragma unroll
                for (int m = 0; m < 4; ++m) { const int R = u.pm * BM + ai * HALF + wr * 64 + m * 16 + fr; bf16_t* dst = base + (size_t)R * ld + cbase + 8 * fq; float ss = 0.f;
                    asm volatile("" ::: "memory"); f32x4 x[2][2]; xrow(acc, ai, m, R, pcol0, x);
#pragma unroll
                    for (int bj = 0; bj < 2; ++bj) { ss += sq4(x[bj][0]) + sq4(x[bj][1]); *(u32x4*)(dst + bj * bjs) = pack8(x[bj][0], x[bj][1]); }
                    ss = quad_sum(ss); if (fq == 0) ssb[(size_t)R * nss + iss] = ss; }
        }
    }
};

template <bool F8> struct EpiKvb {
    static constexpr bool PERM = true, AFTER_DRAIN = false;
    const float* SSKV; const float* knn; bf16_t* K1; bf16_t* V1;
    __device__ __forceinline__ void operator()(const f32x4 (&acc)[2][2][4][2], const Unit& u, int wr, int wc, int fr_, int fq_) const {
        int fr = fr_, fq = fq_; asm volatile("" : "+v"(fr), "+v"(fq));
        const int head = 2 * u.pn + (wc >> 1), type = wc & 1;
#pragma unroll
        for (int ai = 0; ai < 2; ++ai)
#pragma unroll
            for (int m = 0; m < 4; ++m) { const int R = u.pm * BM + ai * HALF + wr * 64 + m * 16 + fr;
                asm volatile("" ::: "memory");
                const f32x4 s4 = *(const f32x4*)(SSKV + (size_t)R * 4); const float rkv = rsqrtf(((s4[0] + s4[1]) + (s4[2] + s4[3])) * (1.f / 256.f) + EPS);
                f32x4 x[2][2]; float ss = 0.f;
#pragma unroll
                for (int bj = 0; bj < 2; ++bj)
#pragma unroll
                    for (int n = 0; n < 2; ++n) { x[bj][n] = acc[ai][bj][m][n] * rkv; ss += sq4(x[bj][n]); }
                if (type == 0) { const float rinv = rsqrtf(quad_sum(ss) * (1.f / 64.f) + EPS);
#pragma unroll
                    for (int bj = 0; bj < 2; ++bj)
#pragma unroll
                        for (int n = 0; n < 2; ++n) x[bj][n] = x[bj][n] * rinv * *(const f32x4*)(knn + 32 * bj + 8 * fq + 4 * n); }
                const size_t eo = (size_t)key_slot(R) * DM + head * 64 + 8 * fq;
                if (F8) { if (type == 0) { unsigned char* dst = (unsigned char*)K1 + (size_t)key_slot(R) * 512 + head * 32 + 4 * fq; *(unsigned*)dst = pack8_fp4(x[0][0] * 2.f, x[0][1] * 2.f); *(unsigned*)(dst + 16) = pack8_fp4(x[1][0] * 2.f, x[1][1] * 2.f); }
                          else { unsigned char* dst = (unsigned char*)V1 + eo; *(u32x2*)dst = pack8_fp8(x[0][0], x[0][1]); *(u32x2*)(dst + 32) = pack8_fp8(x[1][0], x[1][1]); } }
                else { bf16_t* dst = (type == 0 ? K1 : V1) + eo; *(u32x4*)dst = pack8(x[0][0], x[0][1]); *(u32x4*)(dst + 32) = pack8(x[1][0], x[1][1]); } }
    }
};

struct EpiQb {
    static constexpr bool PERM = true, AFTER_DRAIN = false;
    const float* SSQ; const float* qnw; const f32x4* tabB; bf16_t* Q1N; bf16_t* Q1R; float* SSH;
    __device__ __forceinline__ float rqa_of(int R) const { const float* sp = SSQ + (size_t)R * 6; const f32x2 sa = *(const f32x2*)sp, sb = *(const f32x2*)(sp + 2), sc = *(const f32x2*)(sp + 4);
        return rsqrtf(((sa[0] + sa[1]) + (sb[0] + sb[1]) + (sc[0] + sc[1])) * (1.f / 384.f) + EPS); }
    __device__ __forceinline__ void operator()(const f32x4 (&acc)[2][2][4][2], const Unit& u, int wr, int wc, int fr_, int fq_) const {
        int fr = fr_, fq = fq_; asm volatile("" : "+v"(fr), "+v"(fq));
        const int head = 2 * u.pn + (wc >> 1);
        if ((wc & 1) == 0) {
#pragma unroll
            for (int ai = 0; ai < 2; ++ai)
#pragma unroll
                for (int m = 0; m < 4; ++m) { const int R = u.pm * BM + ai * HALF + wr * 64 + m * 16 + fr;
                    asm volatile("" ::: "memory");
                    const float rqa = rqa_of(R); float ss = 0.f; bf16_t* dst = Q1N + (size_t)R * DM + head * 64 + 8 * fq;
#pragma unroll
                    for (int bj = 0; bj < 2; ++bj) { f32x4 x0 = acc[ai][bj][m][0] * rqa, x1 = acc[ai][bj][m][1] * rqa; ss += sq4(x0) + sq4(x1);
                        x0 = x0 * *(const f32x4*)(qnw + 32 * bj + 8 * fq); x1 = x1 * *(const f32x4*)(qnw + 32 * bj + 8 * fq + 4); *(u32x4*)(dst + 32 * bj) = pack8(x0, x1); }
                    ss = quad_sum(ss); if (fq == 0) SSH[((size_t)R * 16 + head) * 2] = ss; }
        } else {
#pragma unroll
            for (int ai = 0; ai < 2; ++ai)
#pragma unroll
                for (int m = 0; m < 4; ++m) { const int R = u.pm * BM + ai * HALF + wr * 64 + m * 16 + fr;
                    asm volatile("" ::: "memory");
                    const float rqa = rqa_of(R);
                    f32x4 x0 = acc[ai][0][m][0] * rqa, x1 = acc[ai][0][m][1] * rqa; const float ss = quad_sum(sq4(x0) + sq4(x1)); if (fq == 0) SSH[((size_t)R * 16 + head) * 2 + 1] = ss;
                    const float* wp = qnw + 64 + 16 * (fq >> 1) + 4 * (fq & 1); x0 = x0 * *(const f32x4*)wp; x1 = x1 * *(const f32x4*)(wp + 8);
                    const int t = R & (SEQ - 1); const int pos = (fq >> 1) ? (t & 63) : (t >> 6); const f32x4* tp = tabB + (pos * 8 + 4 * (fq & 1)) / 2; rot4(x0, x1, tp[0], tp[1]);
                    *(u32x4*)(Q1R + (size_t)R * 512 + head * 32 + 8 * fq) = pack8(x0, x1); }
        }
    }
};

struct In1Order {
    int G, c; ROrder lat;
    __host__ __device__ void init(int G_, int c_) { G = G_; c = c_; lat.init(0, ML / BM, N_IN1P, G_, c_); }
    __host__ __device__ bool next(int i, Unit& u) const {
        const long L = (long)i * G + c; if (L < lat.nwg) return lat.next(i, u);
        const int e = (int)(L - lat.nwg); if (e >= 4) return false; u.pm = ML / BM + (e >> 1); u.pn = (e & 1) * 2; u.ko = 0; return true;
    }
    __device__ __forceinline__ void a_ready(const Unit&) const {}
    __device__ __forceinline__ void done(const Unit&) const {}
};
template <class Epi, class Sched, bool ALIGN_EPI = false, bool SP2 = false>
__device__ __forceinline__ void gemm_phase(PG8_LAS unsigned char* lds, const Gemm g, const Sched& S, const Epi& E) {
    const int tid = threadIdx.x, wid = __builtin_amdgcn_readfirstlane(tid >> 6), lane = tid & 63, wr = wid >> 2, wc = wid & 3, fr = lane & 15, fq = lane >> 4;
    const int K = g.K, nt = (g.Kloop ? g.Kloop : K) / BK;
    unsigned voffA[2], voffB[2];
#pragma unroll
    for (int i = 0; i < 2; ++i) { int R, C; stage_rc(tid * 16 + i * 8192, R, C); const int Rb = Epi::PERM ? ((R & ~31) + perm32(R & 31)) : R;
        voffA[i] = (unsigned)(R * K + C) * 2u; voffB[i] = (unsigned)(Rb * K + C) * 2u; }
    const size_t kstep = (size_t)(BK * 2);
    const size_t hstep = (size_t)HALF * K * 2;
    const size_t tstep = 2 * hstep;
    const unsigned ldsw = (unsigned)wid * 1024u;
    const int aoff = lds_byte(wr * 64 + fr, fq * 8), boff = lds_byte(wc * 32 + fr, fq * 8);
#define PG8_SA(b, h) (((b) * 2 + (h)) * HTB)
#define PG8_SB(b, h) ((4 + (b) * 2 + (h)) * HTB)
#define PG8_STAGE(bufoff, gbase, voff) do { _Pragma("unroll") for (int _i = 0; _i < 2; ++_i) \
        __builtin_amdgcn_global_load_lds((const unsigned*)((const char*)(gbase) + (voff)[_i]), (PG8_LAS unsigned*)(lds + (bufoff) + ldsw + _i * 8192), 16, 0, 0); } while (0)
#define PG8_LDA(dst, b, h) do { _Pragma("unroll") for (int m = 0; m < 4; ++m) _Pragma("unroll") for (int k = 0; k < 2; ++k) dst[m][k] = *(const PG8_LAS bf16x8*)(lds + PG8_SA(b, h) + aoff + m * 2048 + k * 1024); } while (0)
#define PG8_LDB(dst, b, h) do { _Pragma("unroll") for (int n = 0; n < 2; ++n) _Pragma("unroll") for (int k = 0; k < 2; ++k) dst[n][k] = *(const PG8_LAS bf16x8*)(lds + PG8_SB(b, h) + boff + n * 2048 + k * 1024); } while (0)
#define PG8_MMA(ai, bj, At, Bt) do { __builtin_amdgcn_s_setprio(1); _Pragma("unroll") for (int m = 0; m < 4; ++m) _Pragma("unroll") for (int n = 0; n < 2; ++n) _Pragma("unroll") for (int k = 0; k < 2; ++k) \
        acc[ai][bj][m][n] = __builtin_amdgcn_mfma_f32_16x16x32_bf16(Bt[n][k], At[m][k], acc[ai][bj][m][n], 0, 0, 0); __builtin_amdgcn_s_setprio(0); } while (0)
#define PG8_WAIT_V(n) asm volatile("s_waitcnt vmcnt(" #n ")" ::: "memory")
#define PG8_WAIT_L(n) asm volatile("s_waitcnt lgkmcnt(" #n ")" ::: "memory")
#define PG8_BAR __builtin_amdgcn_s_barrier()
#define PG8_SCHED __builtin_amdgcn_sched_barrier(0)
    Unit cur, nxt; int ui = 0;
    if (!S.next(0, cur)) return;
    f32x4 acc[2][2][4][2];
#pragma unroll
    for (int a = 0; a < 2; ++a)
#pragma unroll
        for (int b = 0; b < 2; ++b)
#pragma unroll
            for (int m = 0; m < 4; ++m)
#pragma unroll
                for (int n = 0; n < 2; ++n) acc[a][b][m][n] = (f32x4){0.f, 0.f, 0.f, 0.f};
    bf16x8 At[4][2], B0[2][2], B1[2][2];
    const char* cA = (const char*)g.A + (size_t)cur.pm * tstep + (size_t)cur.ko * 2; const char* cB = (const char*)g.Bt + (size_t)cur.pn * tstep + (size_t)cur.ko * 2;
    S.a_ready(cur);
    if constexpr (SP2) {
        PG8_STAGE(PG8_SB(0, 0), cB, voffB); PG8_STAGE(PG8_SB(0, 1), cB + hstep, voffB); PG8_STAGE(PG8_SA(0, 0), cA, voffA); PG8_STAGE(PG8_SA(0, 1), cA + hstep, voffA);
        if (wr == 1) PG8_BAR;
        PG8_WAIT_V(2); PG8_BAR;
        PG8_STAGE(PG8_SB(1, 0), cB + kstep, voffB); PG8_STAGE(PG8_SA(1, 0), cA + kstep, voffA); PG8_STAGE(PG8_SB(1, 1), cB + hstep + kstep, voffB);
        PG8_WAIT_V(6); PG8_BAR;
    } else {
        PG8_STAGE(PG8_SB(0, 0), cB, voffB); PG8_STAGE(PG8_SA(0, 0), cA, voffA); PG8_STAGE(PG8_SB(0, 1), cB + hstep, voffB); PG8_STAGE(PG8_SA(0, 1), cA + hstep, voffA);
        if (wr == 1) PG8_BAR;
        PG8_WAIT_V(4); PG8_BAR;
        PG8_STAGE(PG8_SB(1, 0), cB + kstep, voffB); PG8_STAGE(PG8_SA(1, 0), cA + kstep, voffA); PG8_STAGE(PG8_SB(1, 1), cB + hstep + kstep, voffB);
        PG8_WAIT_V(6); PG8_BAR;
    }
    for (;;) {
        const bool has_next = S.next(ui + 1, nxt);
        const char* nA = has_next ? (const char*)g.A + (size_t)nxt.pm * tstep + (size_t)nxt.ko * 2 : cA; const char* nB = has_next ? (const char*)g.Bt + (size_t)nxt.pn * tstep + (size_t)nxt.ko * 2 : cB;
        _Pragma("nounroll") for (int t = 0; t < nt; t += 2) {
            const bool last = (t == nt - 2);
            const char* a1 = cA + (size_t)(t + 1) * kstep;
            const char* a2 = last ? nA : cA + (size_t)(t + 2) * kstep; const char* b2 = last ? nB : cB + (size_t)(t + 2) * kstep;
            const char* a3 = a2 + kstep; const char* b3 = b2 + kstep;
            if (last && has_next) S.a_ready(nxt);
            if constexpr (SP2) {
            PG8_LDB(B0, 0, 0); PG8_LDB(B1, 0, 1); PG8_SCHED; PG8_LDA(At, 0, 0); PG8_STAGE(PG8_SA(1, 1), a1 + hstep, voffA);
            PG8_WAIT_V(8); PG8_WAIT_L(0); PG8_BAR; PG8_MMA(0, 0, At, B0); PG8_MMA(0, 1, At, B1); PG8_BAR; PG8_SCHED;
            PG8_LDA(At, 0, 1); PG8_STAGE(PG8_SB(0, 0), b2, voffB); PG8_STAGE(PG8_SB(0, 1), b2 + hstep, voffB); PG8_STAGE(PG8_SA(0, 0), a2, voffA);
            PG8_WAIT_V(8); PG8_WAIT_L(0); PG8_BAR; PG8_MMA(1, 0, At, B0); PG8_MMA(1, 1, At, B1); PG8_BAR; PG8_SCHED;
            PG8_LDB(B0, 1, 0); PG8_LDB(B1, 1, 1); PG8_SCHED; PG8_LDA(At, 1, 0); PG8_STAGE(PG8_SA(0, 1), a2 + hstep, voffA);
            PG8_WAIT_V(8); PG8_WAIT_L(0); PG8_BAR; PG8_MMA(0, 0, At, B0); PG8_MMA(0, 1, At, B1); PG8_BAR; PG8_SCHED;
            PG8_LDA(At, 1, 1); PG8_STAGE(PG8_SB(1, 0), b3, voffB); PG8_STAGE(PG8_SB(1, 1), b3 + hstep, voffB); PG8_STAGE(PG8_SA(1, 0), a3, voffA);
            PG8_WAIT_V(8); PG8_WAIT_L(0); PG8_BAR; PG8_MMA(1, 0, At, B0); PG8_MMA(1, 1, At, B1); PG8_BAR; PG8_SCHED;
            } else {
            PG8_LDB(B0, 0, 0); PG8_SCHED; PG8_LDA(At, 0, 0); PG8_STAGE(PG8_SA(1, 1), a1 + hstep, voffA);
            PG8_WAIT_L(8); PG8_BAR; PG8_WAIT_L(0); PG8_MMA(0, 0, At, B0); PG8_BAR; PG8_SCHED;
            PG8_LDB(B1, 0, 1); PG8_STAGE(PG8_SB(0, 0), b2, voffB);
            PG8_BAR; PG8_WAIT_L(0); PG8_MMA(0, 1, At, B1); PG8_BAR;
            PG8_LDA(At, 0, 1); PG8_STAGE(PG8_SA(0, 0), a2, voffA);
            PG8_BAR; PG8_WAIT_L(0); PG8_MMA(1, 0, At, B0); PG8_BAR; PG8_SCHED;
            PG8_STAGE(PG8_SB(0, 1), b2 + hstep, voffB);
            PG8_WAIT_V(6); PG8_BAR; PG8_MMA(1, 1, At, B1); PG8_BAR;
            PG8_LDB(B0, 1, 0); PG8_SCHED; PG8_LDA(At, 1, 0); PG8_STAGE(PG8_SA(0, 1), a2 + hstep, voffA);
            PG8_WAIT_L(8); PG8_BAR; PG8_WAIT_L(0); PG8_MMA(0, 0, At, B0); PG8_BAR; PG8_SCHED;
            PG8_LDB(B1, 1, 1); PG8_STAGE(PG8_SB(1, 0), b3, voffB);
            PG8_BAR; PG8_WAIT_L(0); PG8_MMA(0, 1, At, B1); PG8_BAR;
            PG8_LDA(At, 1, 1); PG8_STAGE(PG8_SA(1, 0), a3, voffA);
            PG8_BAR; PG8_WAIT_L(0); PG8_MMA(1, 0, At, B0); PG8_BAR; PG8_SCHED;
            PG8_STAGE(PG8_SB(1, 1), b3 + hstep, voffB);
            PG8_WAIT_V(6); PG8_BAR; PG8_MMA(1, 1, At, B1); PG8_BAR;
            }
        }
        if constexpr (ALIGN_EPI) { if (wr == 0) PG8_BAR; }
        if constexpr (!Epi::AFTER_DRAIN) { E(acc, cur, wr, wc, fr, fq); S.done(cur); }
        if (!has_next) break;
#pragma unroll
        for (int a = 0; a < 2; ++a)
#pragma unroll
            for (int b = 0; b < 2; ++b)
#pragma unroll
                for (int m = 0; m < 4; ++m)
#pragma unroll
                    for (int n = 0; n < 2; ++n) acc[a][b][m][n] = (f32x4){0.f, 0.f, 0.f, 0.f};
        cur = nxt; cA = nA; cB = nB; ++ui;
        if constexpr (ALIGN_EPI) { if (wr == 1) PG8_BAR; }
    }
    PG8_WAIT_V(0);
    if constexpr (!ALIGN_EPI) { if (wr == 0) PG8_BAR; }
    PG8_BAR;
    if constexpr (Epi::AFTER_DRAIN) { E.fused(acc, cur, wr, wc, fr, fq, lds, wid, lane); S.done(cur); }
#undef PG8_SA
#undef PG8_SB
#undef PG8_STAGE
#undef PG8_LDA
#undef PG8_LDB
#undef PG8_MMA
#undef PG8_WAIT_V
#undef PG8_WAIT_L
#undef PG8_BAR
#undef PG8_SCHED
}
}

DEVI void sincos_pos(float ang, float& cs, float& sn) {
    const double TWO_PI = 6.283185307179586476925286766559; const double a = (double)ang; const double k = __builtin_rint(a * (1.0 / TWO_PI));
    const float r = (float)(a - k * TWO_PI);
    cs = cosf(r); sn = sinf(r);
}

namespace afast {
#ifndef ATT_PRIO
#define ATT_PRIO 2
#endif
#ifndef ATT_DUP
#define ATT_DUP 0
#endif
constexpr int NW = 8, KVBLK = 64, SLOTK = 12288, SLOTV = 8192, KROFF = 8192;
constexpr int LDS_K = 0, LDS_V = 3 * SLOTK, LDS_WS = LDS_V + 3 * SLOTV, LDS_OST = LDS_WS + NW * 256, LDS_BYTES = LDS_OST + NW * 4096;
#define SBAR() __builtin_amdgcn_sched_barrier(0)
#define PIN(x) asm volatile("" : "+v"(x))
#define MFMA(a, b, c) __builtin_amdgcn_mfma_f32_32x32x16_bf16(a, b, c, 0, 0, 0)
#ifndef ATT_AGPR_O
#define ATT_AGPR_O 0
#endif
#if ATT_AGPR_O
#define PVMFMA(acc, a, b) asm volatile("s_nop 1\n\tv_mfma_f32_32x32x16_bf16 %0, %1, %2, %0" : "+a"(acc) : "v"(a), "v"(b))
#else
#define PVMFMA(acc, a, b) acc = __builtin_amdgcn_mfma_f32_32x32x16_bf16(a, b, acc, 0, 0, 0)
#endif
#define WAIT_BAR_(N) asm volatile("s_waitcnt vmcnt(" #N ") lgkmcnt(0)\n\ts_barrier" ::: "memory")
#define WAIT_BAR_0() WAIT_BAR_(0)
#define WAIT_BAR_1() do { if (ATT_DUP & 1) WAIT_BAR_(2); else WAIT_BAR_(1); } while (0)
#define WAIT_BAR_2() do { if (ATT_DUP & 1) WAIT_BAR_(4); else WAIT_BAR_(2); } while (0)
#define WAIT_BAR_3() do { if (ATT_DUP & 1) WAIT_BAR_(6); else WAIT_BAR_(3); } while (0)
#define WAIT_BAR(N) do { WAIT_BAR_##N(); if (ATT_DUP & 2) asm volatile("s_barrier" ::: "memory"); } while (0)
DEVI int crow(int r, int hi) { return (r & 3) + 8 * (r >> 2) + 4 * hi; }
DEVI unsigned cvtpk(float lo, float hi) { unsigned r; asm("v_cvt_pk_bf16_f32 %0, %1, %2" : "=v"(r) : "v"(lo), "v"(hi)); return r; }
DEVI void glds16(const void* g, unsigned lds_base) {
    unsigned sv; asm volatile("s_mov_b32 %0, m0\n\ts_mov_b32 m0, %2\n\ts_nop 0\n\tglobal_load_lds_dwordx4 %1, off\n\ts_mov_b32 m0, %0" : "=&s"(sv) : "v"(g), "s"(lds_base) : "memory"); }
typedef __attribute__((address_space(3))) const char* lds_cptr;
typedef short v4i16_t __attribute__((ext_vector_type(4)));
DEVI bf16x8 ldsb128(lds_cptr p) { return *(const __attribute__((address_space(3))) bf16x8*)p; }
DEVI s16x4 vtr(lds_cptr p) { return __builtin_bit_cast(s16x4, __builtin_amdgcn_ds_read_tr16_b64_v4i16((__attribute__((address_space(3))) v4i16_t*)p)); }
DEVI bf16x8 scale8(bf16x8 v, float s) {
    u32x4 w = __builtin_bit_cast(u32x4, v); u32x4 o;
#pragma unroll
    for (int i = 0; i < 4; ++i) { const float lo = __uint_as_float(w[i] << 16) * s, hi = __uint_as_float(w[i] & 0xffff0000u) * s; o[i] = cvtpk(lo, hi); }
    return __builtin_bit_cast(bf16x8, o);
}

template <int ROPE>
DEVI void attn_unit(const bf16_t* Qn, int ldq, const bf16_t* Qr, const float* ssh, const bf16_t* __restrict__ Kn, int ldk, const bf16_t* __restrict__ Kr,
                    const bf16_t* __restrict__ V, int ldv, int NT, bf16_t* O, const bf16_t* G, int ldo, char* lds) {
    const int tid = threadIdx.x, lane = tid & 63, r32 = lane & 31, hi = lane >> 5; const int wid = __builtin_amdgcn_readfirstlane(tid >> 6);
    const unsigned lds0 = (unsigned)(uintptr_t)lds; float* wsf = (float*)(lds + LDS_WS) + wid * 64;
    const bf16_t* ksrc = Kn + (size_t)lane * ldk + wid * 8;
    const bf16_t* vsrc = V + (size_t)(16 * (wid & 3) + (lane >> 2)) * ldv + (wid >> 2) * 32 + (lane & 3) * 8;
    const bf16_t* krsrc = ROPE ? Kr + (size_t)(32 * (wid & 1) + r32) * 32 + 8 * (2 * ((wid >> 1) & 1) + hi) : nullptr;
    const unsigned kdst = lds0 + LDS_K + wid * 1024, vdst = lds0 + LDS_V + wid * 1024, krdst = lds0 + LDS_K + KROFF + (wid & 3) * 1024;
    const bool rwave = ROPE && wid < 4;
#define DMA_K(t, slot) do { DMA_K1(t, slot); if (ATT_DUP & 1) DMA_K1(t, slot); } while (0)
#define DMA_K1(t, slot) do { if (ROPE) { if (rwave) glds16(krsrc + (size_t)(t) * KVBLK * 32, (unsigned)__builtin_amdgcn_readfirstlane(krdst + (slot))); } \
        glds16(ksrc + (size_t)(t) * KVBLK * ldk, (unsigned)__builtin_amdgcn_readfirstlane(kdst + (slot))); } while (0)
#define DMA_V1(t, slot) glds16(vsrc + (size_t)(t) * KVBLK * ldv, (unsigned)__builtin_amdgcn_readfirstlane(vdst + (slot)))
#define DMA_V(t, slot) do { DMA_V1(t, slot); if (ATT_DUP & 1) DMA_V1(t, slot); } while (0)
    const lds_cptr vp0 = (lds_cptr)lds + LDS_V + ((lane >> 4) & 1) * 32 + (lane & 3) * 8 + (4 * hi + ((lane & 15) >> 2)) * 64;
    const lds_cptr kp0 = (lds_cptr)lds + LDS_K + hi * 1024 + r32 * 16;
    const lds_cptr krp0 = (lds_cptr)lds + LDS_K + KROFF + hi * 512 + r32 * 16;
    DMA_K(0, 0); DMA_V(0, 0); DMA_K(1, SLOTK);
    bf16x8 qr[4]; bf16x8 qrr[2];
    { const bf16_t* Qw = Qn + (size_t)(wid * 32 + r32) * ldq + hi * 8;
#pragma unroll
      for (int d0 = 0; d0 < 4; ++d0) qr[d0] = *reinterpret_cast<const bf16x8*>(Qw + d0 * 16);
      if (ROPE) { const bf16_t* Qrw = Qr + (size_t)(wid * 32 + r32) * 512 + hi * 8;
#pragma unroll
          for (int d0 = 0; d0 < 2; ++d0) qrr[d0] = *reinterpret_cast<const bf16x8*>(Qrw + d0 * 16);
          const f32x2 s2 = *(const f32x2*)(ssh + (size_t)(wid * 32 + r32) * 32); const float sc = rsqrtf((s2[0] + s2[1]) * (1.f / 96.f) + EPS) * C2_MLA;
#pragma unroll
          for (int d0 = 0; d0 < 4; ++d0) qr[d0] = scale8(qr[d0], sc);
#pragma unroll
          for (int d0 = 0; d0 < 2; ++d0) qrr[d0] = scale8(qrr[d0], sc); } }
    float l_reg = 0.f; f32x16 o[2]; o[0] = f32x16{}; o[1] = f32x16{};
    const f32x16 zero16 = f32x16{};
    f32x16 dacc = f32x16{}; f32x16 pA0, pA1, pB0, pB1; bf16x8 kf[8]; bf16x8 kfr[4]; s16x4 vlo[8], vhi[8]; u32x4 pw0, pw1, pw2, pw3;
    int sl_prev = 0, sl_cur = 0, sl_next = SLOTK;
#define VSL(s) (((s) / (SLOTK / 1024)) * (SLOTV / 1024))
#define ROT() do { sl_prev = sl_cur; sl_cur = sl_next; sl_next = (sl_next == 2 * SLOTK) ? 0 : sl_next + SLOTK; } while (0)
#define EX(v) __builtin_amdgcn_exp2f(v)
#define KLOADALL(slot) do { _Pragma("unroll") for (int d0 = 0; d0 < 4; ++d0) { kf[2 * d0] = ldsb128(kp0 + (slot) + d0 * 2048); kf[2 * d0 + 1] = ldsb128(kp0 + (slot) + d0 * 2048 + 512); } \
        if (ROPE) { _Pragma("unroll") for (int q = 0; q < 4; ++q) kfr[q] = ldsb128(krp0 + (slot) + q * 1024); } } while (0)
    DMA_K(2, 2 * SLOTK);
    WAIT_BAR(3);
    KLOADALL(0);
    pA0 = MFMA(kf[0], qr[0], zero16); pA1 = MFMA(kf[1], qr[0], zero16); pA0 = MFMA(kf[2], qr[1], pA0); pA1 = MFMA(kf[3], qr[1], pA1);
    pA0 = MFMA(kf[4], qr[2], pA0); pA1 = MFMA(kf[5], qr[2], pA1); pA0 = MFMA(kf[6], qr[3], pA0); pA1 = MFMA(kf[7], qr[3], pA1);
    if (ROPE) { pA0 = MFMA(kfr[0], qrr[0], pA0); pA1 = MFMA(kfr[1], qrr[0], pA1); pA0 = MFMA(kfr[2], qrr[1], pA0); pA1 = MFMA(kfr[3], qrr[1], pA1); }
#pragma unroll
    for (int r = 0; r < 16; ++r) { pA0[r] = EX(pA0[r]); pA1[r] = EX(pA1[r]); }
    WAIT_BAR(0);
    DMA_K(3, 0); DMA_V(1, SLOTV); ROT();
    KLOADALL(sl_cur);
    WAIT_BAR(2);
#define PKW(P, i) cvtpk(P[i], P[i + 1])
#define PAF(k) __builtin_bit_cast(bf16x8, pw##k)
#define VFR(i) (bf16x8){vlo[i][0], vlo[i][1], vlo[i][2], vlo[i][3], vhi[i][0], vhi[i][1], vhi[i][2], vhi[i][3]}
#define VRD(i) do { vlo[i] = vtr(vp_ + (((i) >> 2) * 4096 + ((i) & 3) * 1024)); vhi[i] = vtr(vp_ + (((i) >> 2) * 4096 + ((i) & 3) * 1024 + 512)); } while (0)
#define KRD(G, d0) do { if (G) { kf[2 * (d0)] = ldsb128(kp0 + sl_next + (d0) * 2048); kf[2 * (d0) + 1] = ldsb128(kp0 + sl_next + (d0) * 2048 + 512); \
        if (ATT_DUP & 16) { bf16x8 d0_, d1_; asm volatile("ds_read_b128 %0, %2 offset:0\n\tds_read_b128 %1, %2 offset:512\n\ts_waitcnt lgkmcnt(0)" : "=&v"(d0_), "=&v"(d1_) : "v"((unsigned)(uintptr_t)(kp0 + sl_next + (d0) * 2048)) : "memory"); } SBAR(); } } while (0)
#define KRR(G, q) do { if (ROPE) { if (G) { kfr[2 * (q)] = ldsb128(krp0 + sl_next + (2 * (q)) * 1024); kfr[2 * (q) + 1] = ldsb128(krp0 + sl_next + (2 * (q) + 1) * 1024); SBAR(); } } } while (0)
#define GAPA4(CX, MF, a0, a1, a2, a3, W0, W1, PW) do { MF; sacc += a0; sacc += a1; sacc += a2; sacc += a3; W0; W1; PIN(PW); PIN(sacc); PIN(CX); if ((ATT_DUP & 8) && !ROPE) { dacc = MFMA(kf[0], qr[0], dacc); PIN(dacc); } SBAR(); } while (0)
#define GAPA3(CX, MF, a0, a1, a2, W0, W1, PW) do { MF; sacc += a0; sacc += a1; sacc += a2; W0; W1; PIN(PW); PIN(sacc); PIN(CX); if ((ATT_DUP & 8) && !ROPE) { dacc = MFMA(kf[0], qr[0], dacc); PIN(dacc); } SBAR(); } while (0)
#define GAPA31(CX, MF, a0, a1, a2, W0, PW) do { MF; sacc += a0; sacc += a1; sacc += a2; W0; PIN(PW); PIN(sacc); PIN(CX); if ((ATT_DUP & 8) && !ROPE) { dacc = MFMA(kf[0], qr[0], dacc); PIN(dacc); } SBAR(); } while (0)
#define GAPA21(CX, MF, a0, a1, W0, PW) do { MF; sacc += a0; sacc += a1; W0; PIN(PW); PIN(sacc); PIN(CX); if ((ATT_DUP & 8) && !ROPE) { dacc = MFMA(kf[0], qr[0], dacc); PIN(dacc); } SBAR(); } while (0)
#define XEXP(v) do { if (ATT_DUP & 4) { float d_; asm volatile("v_exp_f32 %0, %1" : "=v"(d_) : "v"(v)); } } while (0)
#define GAPB(MF, X, i) do { MF; X[i] = EX(X[i]); X[i + 1] = EX(X[i + 1]); X[i + 2] = EX(X[i + 2]); X[i + 3] = EX(X[i + 3]); XEXP(X[i]); XEXP(X[i + 1]); XEXP(X[i + 2]); XEXP(X[i + 3]); PIN(X); SBAR(); } while (0)
#define STEP(C0, C1, P0, P1, t, GK, GV, GL) do { SBAR(); if (ATT_PRIO == 2) __builtin_amdgcn_s_setprio(1); if (ATT_PRIO == 3) __builtin_amdgcn_s_setprio(0); \
    const lds_cptr vp_ = vp0 + VSL(sl_prev); \
    VRD(0); SBAR(); float sacc = P0[0] + P0[1]; \
    if (!ROPE) { \
                        GAPA4(C0, C0 = MFMA(kf[0], qr[0], zero16), P0[2], P0[3], P0[4], P0[5],     pw0[0] = PKW(P0, 0),  pw0[1] = PKW(P0, 2),  pw0); \
        VRD(4); SBAR(); GAPA4(C1, C1 = MFMA(kf[1], qr[0], zero16), P0[6], P0[7], P0[8], P0[9],     pw0[2] = PKW(P0, 4),  pw0[3] = PKW(P0, 6),  pw0); \
        VRD(1); SBAR(); GAPA4(C0, C0 = MFMA(kf[2], qr[1], C0),    P0[10], P0[11], P0[12], P0[13], pw1[0] = PKW(P0, 8),  pw1[1] = PKW(P0, 10), pw1); \
        VRD(5); SBAR(); GAPA4(C1, C1 = MFMA(kf[3], qr[1], C1),    P0[14], P0[15], P1[0], P1[1],   pw1[2] = PKW(P0, 12), pw1[3] = PKW(P0, 14), pw1); \
        VRD(2); SBAR(); GAPA4(C0, C0 = MFMA(kf[4], qr[2], C0),    P1[2], P1[3], P1[4], P1[5],     pw2[0] = PKW(P1, 0),  pw2[1] = PKW(P1, 2),  pw2); \
        VRD(6); SBAR(); GAPA4(C1, C1 = MFMA(kf[5], qr[2], C1),    P1[6], P1[7], P1[8], P1[9],     pw2[2] = PKW(P1, 4),  pw2[3] = PKW(P1, 6),  pw2); \
        VRD(3); SBAR(); GAPA4(C0, C0 = MFMA(kf[6], qr[3], C0),    P1[10], P1[11], P1[12], P1[13], pw3[0] = PKW(P1, 8),  pw3[1] = PKW(P1, 10), pw3); \
        VRD(7); SBAR(); GAPA4(C1, C1 = MFMA(kf[7], qr[3], C1),    P1[14], P1[15], 0.f, 0.f,       pw3[2] = PKW(P1, 12), pw3[3] = PKW(P1, 14), pw3); \
    } else { \
                        GAPA3(C0, C0 = MFMA(kf[0], qr[0], zero16), P0[2], P0[3], P0[4],    pw0[0] = PKW(P0, 0),  pw0[1] = PKW(P0, 2),  pw0); \
        VRD(4); SBAR(); GAPA3(C1, C1 = MFMA(kf[1], qr[0], zero16), P0[5], P0[6], P0[7],    pw0[2] = PKW(P0, 4),  pw0[3] = PKW(P0, 6),  pw0); \
        VRD(1); SBAR(); GAPA3(C0, C0 = MFMA(kf[2], qr[1], C0),    P0[8], P0[9], P0[10],   pw1[0] = PKW(P0, 8),  pw1[1] = PKW(P0, 10), pw1); \
        VRD(5); SBAR(); GAPA3(C1, C1 = MFMA(kf[3], qr[1], C1),    P0[11], P0[12], P0[13], pw1[2] = PKW(P0, 12), pw1[3] = PKW(P0, 14), pw1); \
        VRD(2); SBAR(); GAPA31(C0, C0 = MFMA(kf[4], qr[2], C0),   P0[14], P0[15], P1[0],  pw2[0] = PKW(P1, 0),  pw2); \
        VRD(6); SBAR(); GAPA31(C1, C1 = MFMA(kf[5], qr[2], C1),   P1[1], P1[2], P1[3],    pw2[1] = PKW(P1, 2),  pw2); \
        VRD(3); SBAR(); GAPA21(C0, C0 = MFMA(kf[6], qr[3], C0),   P1[4], P1[5],           pw2[2] = PKW(P1, 4),  pw2); \
        VRD(7); SBAR(); GAPA21(C1, C1 = MFMA(kf[7], qr[3], C1),   P1[6], P1[7],           pw2[3] = PKW(P1, 6),  pw2); \
                        GAPA21(C0, C0 = MFMA(kfr[0], qrr[0], C0), P1[8], P1[9],           pw3[0] = PKW(P1, 8),  pw3); \
                        GAPA21(C1, C1 = MFMA(kfr[1], qrr[0], C1), P1[10], P1[11],         pw3[1] = PKW(P1, 10), pw3); \
                        GAPA21(C0, C0 = MFMA(kfr[2], qrr[1], C0), P1[12], P1[13],         pw3[2] = PKW(P1, 12), pw3); \
                        GAPA21(C1, C1 = MFMA(kfr[3], qrr[1], C1), P1[14], P1[15],         pw3[3] = PKW(P1, 14), pw3); \
    } \
    l_reg += sacc; \
    if (GK) DMA_K((t) + 3, sl_cur); if (GV) DMA_V((t) + 1, VSL(sl_next)); \
    SBAR(); if (ATT_PRIO == 2) __builtin_amdgcn_s_setprio(0); if (ATT_PRIO == 3) __builtin_amdgcn_s_setprio(1); \
    GAPB(PVMFMA(o[0], PAF(0), VFR(0)), C0, 0); \
    KRD(GL, 0); GAPB(PVMFMA(o[1], PAF(0), VFR(4)), C0, 4); \
    KRD(GL, 1); GAPB(PVMFMA(o[0], PAF(1), VFR(1)), C0, 8); \
    KRD(GL, 2); GAPB(PVMFMA(o[1], PAF(1), VFR(5)), C0, 12); \
    KRD(GL, 3); GAPB(PVMFMA(o[0], PAF(2), VFR(2)), C1, 0); \
    KRR(GL, 0); GAPB(PVMFMA(o[1], PAF(2), VFR(6)), C1, 4); \
    KRR(GL, 1); GAPB(PVMFMA(o[0], PAF(3), VFR(3)), C1, 8); \
    GAPB(PVMFMA(o[1], PAF(3), VFR(7)), C1, 12); \
    } while (0)
    if (ATT_PRIO == 1) { if (wid >= 4) __builtin_amdgcn_s_setprio(1); }
    int t = 1;
    for (; t + 5 < NT; t += 2) {
        STEP(pB0, pB1, pA0, pA1, t, true, true, true);     WAIT_BAR(2); ROT();
        STEP(pA0, pA1, pB0, pB1, t + 1, true, true, true); WAIT_BAR(2); ROT();
    }
#define ENDW(tt) do { if ((tt) + 3 < NT) { WAIT_BAR(2); } else if ((tt) + 2 < NT) { WAIT_BAR(1); } else { WAIT_BAR(0); } } while (0)
    for (; t + 1 < NT; t += 2) {
        STEP(pB0, pB1, pA0, pA1, t, (t + 3 < NT), (t + 1 < NT), (t + 1 < NT));         ENDW(t);     ROT();
        STEP(pA0, pA1, pB0, pB1, t + 1, (t + 4 < NT), (t + 2 < NT), (t + 2 < NT));     ENDW(t + 1); ROT();
    }
    STEP(pB0, pB1, pA0, pA1, NT - 1, false, false, false);
    if (ATT_PRIO != 0) __builtin_amdgcn_s_setprio(0);
    { float sacc = pB0[0] + pB0[1];
#pragma unroll
      for (int r = 2; r < 16; ++r) sacc += pB0[r];
#pragma unroll
      for (int r = 0; r < 16; ++r) sacc += pB1[r];
      l_reg += sacc;
      pw0 = (u32x4){PKW(pB0, 0), PKW(pB0, 2), PKW(pB0, 4), PKW(pB0, 6)}; pw1 = (u32x4){PKW(pB0, 8), PKW(pB0, 10), PKW(pB0, 12), PKW(pB0, 14)};
      pw2 = (u32x4){PKW(pB1, 0), PKW(pB1, 2), PKW(pB1, 4), PKW(pB1, 6)}; pw3 = (u32x4){PKW(pB1, 8), PKW(pB1, 10), PKW(pB1, 12), PKW(pB1, 14)};
      const lds_cptr vp_ = vp0 + VSL(sl_cur); _Pragma("unroll") for (int i = 0; i < 8; ++i) VRD(i);
      PVMFMA(o[0], PAF(0), VFR(0)); PVMFMA(o[1], PAF(0), VFR(4)); PVMFMA(o[0], PAF(1), VFR(1)); PVMFMA(o[1], PAF(1), VFR(5));
      PVMFMA(o[0], PAF(2), VFR(2)); PVMFMA(o[1], PAF(2), VFR(6)); PVMFMA(o[0], PAF(3), VFR(3)); PVMFMA(o[1], PAF(3), VFR(7)); }
#if ATT_AGPR_O
    asm volatile("s_nop 15\n\ts_nop 7" : "+a"(o[0]), "+a"(o[1]));
#endif
    { auto rr = __builtin_amdgcn_permlane32_swap(__float_as_uint(l_reg), __float_as_uint(l_reg), false, false); l_reg = __uint_as_float(rr[0]) + __uint_as_float(rr[1]); }
    if (hi == 0) wsf[32 + r32] = l_reg; asm volatile("s_waitcnt lgkmcnt(0)" ::: "memory");
    float rli[16];
#pragma unroll
    for (int r = 0; r < 16; ++r) rli[r] = __builtin_amdgcn_rcpf(wsf[32 + crow(r, hi)]);
    bf16_t* stg = (bf16_t*)(lds + LDS_OST) + wid * 2048;
#pragma unroll
    for (int r = 0; r < 16; ++r) { const int orow = crow(r, hi);
#pragma unroll
        for (int d0 = 0; d0 < 2; ++d0) stg[orow * 64 + d0 * 32 + r32] = (bf16_t)f2bf(o[d0][r] * rli[r]); }
    asm volatile("s_waitcnt lgkmcnt(0)" ::: "memory");
#pragma unroll
    for (int i = 0; i < 4; ++i) { const int row = i * 8 + (lane >> 3), ch = lane & 7; const size_t goff = (size_t)(wid * 32 + row) * ldo + ch * 8;
        const u32x4 ov = *(const u32x4*)(stg + row * 64 + ch * 8); const u32x4 gv = *(const u32x4*)(G + goff); u32x4 w;
#pragma unroll
        for (int q = 0; q < 4; ++q) { const float lo = __uint_as_float(ov[q] << 16) * __uint_as_float(gv[q] << 16), hh = __uint_as_float(ov[q] & 0xffff0000u) * __uint_as_float(gv[q] & 0xffff0000u); w[q] = cvtpk(lo, hh); }
        *(u32x4*)(O + goff) = w; }
    asm volatile("s_waitcnt lgkmcnt(0)\n\ts_barrier" ::: "memory");
#undef DMA_K
#undef DMA_K1
#undef DMA_V1
#undef XEXP
#undef DMA_V
#undef VSL
#undef ROT
#undef EX
#undef KLOADALL
#undef PKW
#undef PAF
#undef VFR
#undef VRD
#undef KRD
#undef KRR
#undef GAPA4
#undef GAPA3
#undef GAPA31
#undef GAPA21
#undef GAPB
#undef STEP
#undef ENDW
}
#undef SBAR
#undef PIN
#undef MFMA
#undef PVMFMA
#undef WAIT_BAR
#undef WAIT_BAR_
#undef WAIT_BAR_0
#undef WAIT_BAR_1
#undef WAIT_BAR_2
#undef WAIT_BAR_3
}

namespace af8 {
#ifdef MK_UNIT_PROBE
#define UPROBE_PARAM , unsigned long long& upacc
#define UPROBE_ARG , upacc
#else
#define UPROBE_PARAM
#define UPROBE_ARG
#endif
#ifndef F8_DUP
#define F8_DUP 0
#endif
typedef int v8i __attribute__((ext_vector_type(8)));
typedef int v4i __attribute__((ext_vector_type(4)));
typedef int v2i __attribute__((ext_vector_type(2)));
constexpr int NW = 8, KVBLK = 64, SLOT = 4096, KSLOT = 2048;
constexpr int KRSLOT = 1024 + 64;
constexpr int NSL = 4;
constexpr int LDS_K = 0, LDS_V = NSL * KSLOT, LDS_KR = LDS_V + NSL * SLOT, LDS_WS = LDS_KR + NSL * KRSLOT, LDS_OST = LDS_WS + NW * 256, LDS_BYTES = LDS_OST + NW * 4096;
constexpr float YOFF = 56.0f;
#define SBAR() __builtin_amdgcn_sched_barrier(0)
#define PIN(x) asm volatile("" : "+v"(x))
#define WAIT_BAR0() asm volatile("s_waitcnt vmcnt(0) lgkmcnt(0)\n\ts_barrier" ::: "memory")
#define WAIT_BAR1() asm volatile("s_waitcnt vmcnt(2) lgkmcnt(0)\n\ts_barrier" ::: "memory")
#define V8(x) ((v8i){(x)[0], (x)[1], (x)[2], (x)[3], 0, 0, 0, 0})
#define V6(x) ((v8i){(int)(x)[0], (int)(x)[1], (int)(x)[2], (int)(x)[3], (int)(x)[4], (int)(x)[5], 0, 0})
#define QKMFMA(a, b, c) __builtin_amdgcn_mfma_scale_f32_32x32x64_f8f6f4(V8(a), V6(b), c, 4, 2, 0, 126, 0, 126)
#define PVMFMA8(a, b, c) __builtin_amdgcn_mfma_scale_f32_32x32x64_f8f6f4(a, b, c, 1, 0, 0, 127, 0, 127)
#define SUMMFMA(a, b, c) __builtin_amdgcn_mfma_scale_f32_16x16x128_f8f6f4(a, b, c, 1, 0, 0, 127, 0, 127)
DEVI int crow(int r, int hi) { return (r & 3) + 8 * (r >> 2) + 4 * hi; }
DEVI unsigned cvtpk(float lo, float hi) { unsigned r; asm("v_cvt_pk_bf16_f32 %0, %1, %2" : "=v"(r) : "v"(lo), "v"(hi)); return r; }
DEVI void glds16(const void* g, unsigned lds_base) {
    unsigned sv; asm volatile("s_mov_b32 %0, m0\n\ts_mov_b32 m0, %2\n\ts_nop 0\n\tglobal_load_lds_dwordx4 %1, off\n\ts_mov_b32 m0, %0" : "=&s"(sv) : "v"(g), "s"(lds_base) : "memory"); }
typedef __attribute__((address_space(3))) const char* lds_cptr;
DEVI v4i lds128(lds_cptr p) { return *(const __attribute__((address_space(3))) v4i*)p; }
DEVI v2i vtr8(lds_cptr p) { return __builtin_amdgcn_ds_read_tr8_b64_v2i32((__attribute__((address_space(3))) v2i*)p); }
#define PK16U8(P, PF, B) do { unsigned a_, b_, c_, d_; asm volatile("" : "=v"(a_), "=v"(b_), "=v"(c_), "=v"(d_)); \
    _Pragma("unroll") for (int k_ = 0; k_ < 4; ++k_) { a_ = __builtin_amdgcn_cvt_pk_u8_f32(P[k_], k_, a_); b_ = __builtin_amdgcn_cvt_pk_u8_f32(P[4 + k_], k_, b_); \
        c_ = __builtin_amdgcn_cvt_pk_u8_f32(P[8 + k_], k_, c_); d_ = __builtin_amdgcn_cvt_pk_u8_f32(P[12 + k_], k_, d_); } \
    PF[B] = (int)a_; PF[(B) + 1] = (int)b_; PF[(B) + 2] = (int)c_; PF[(B) + 3] = (int)d_; } while (0)
DEVI int pk4bf8(float a, float b, float c, float d) { unsigned w; asm volatile("" : "=v"(w)); w = __builtin_amdgcn_cvt_pk_u8_f32(a, 0, w); w = __builtin_amdgcn_cvt_pk_u8_f32(b, 1, w); w = __builtin_amdgcn_cvt_pk_u8_f32(c, 2, w); w = __builtin_amdgcn_cvt_pk_u8_f32(d, 3, w); return (int)w; }

DEVI int pk4fp8(float a, float b, float c, float d) { int w; asm volatile("" : "=v"(w)); w = __builtin_amdgcn_cvt_pk_fp8_f32(a, b, w, false); w = __builtin_amdgcn_cvt_pk_fp8_f32(c, d, w, true); return w; }
#ifndef F6_INTERLEAVED
#define F6_INTERLEAVED 1
#endif
typedef float v16f __attribute__((ext_vector_type(16)));
typedef unsigned v6u __attribute__((ext_vector_type(6)));
DEVI v6u q32_to_fp6(const bf16_t* p, float sc) { v16f a, b;
#pragma unroll
    for (int c = 0; c < 4; ++c) { const u32x4 w = *(const u32x4*)(p + 8 * c);
#pragma unroll
        for (int k = 0; k < 4; ++k) { const float lo = __uint_as_float(w[k] << 16) * sc, hi = __uint_as_float(w[k] & 0xffff0000u) * sc; const int i = 4 * c + k;
            if (F6_INTERLEAVED) { a[i] = lo; b[i] = hi; } else if (i < 8) { a[2 * i] = lo; a[2 * i + 1] = hi; } else { b[2 * i - 16] = lo; b[2 * i - 15] = hi; } } }
    return __builtin_amdgcn_cvt_scalef32_2xpk16_fp6_f32(a, b, 1.0f); }
template <int ROPE>
DEVI void attn_unit(const void* Qv, int ldq, const bf16_t* Qr, const float* ssh, const unsigned char* __restrict__ K, int ldk, const unsigned char* __restrict__ Kr,
                    const unsigned char* __restrict__ V, int ldv, int NT, bf16_t* O, const bf16_t* G, int ldo, char* lds UPROBE_PARAM) {
#ifdef MK_UNIT_PROBE
    const unsigned long long upT0 = __builtin_amdgcn_s_memrealtime();
#endif
    int tid_ = threadIdx.x; asm volatile("" : "+v"(tid_));
    const int tid = tid_, lane = tid & 63, r32 = lane & 31, hi = lane >> 5; const int wid = __builtin_amdgcn_readfirstlane(tid >> 6);
    const unsigned lds0 = (unsigned)(uintptr_t)lds; float* wsf = (float*)(lds + LDS_WS) + wid * 64;
    const int role = wid < 2 ? 0 : (wid >= 4 ? 1 : ((ROPE && wid == 2) ? 2 : 3)); const bool kwave = role != 1; const int dlead = kwave ? 4 : 2;
    const int kkey = 32 * (wid & 1) + (lane >> 1), vkey = 16 * (wid & 3) + (lane >> 2);
    const unsigned char* dsrc = role == 0 ? K + (size_t)kkey * ldk + 16 * ((lane & 1) ^ ((kkey >> 3) & 1))
                              : role == 1 ? V + (size_t)vkey * ldv + 16 * ((lane & 3) ^ (2 * ((vkey >> 3) & 1)))
                              : (ROPE ? Kr + (size_t)lane * 16 : K);
    const size_t dstep = (size_t)KVBLK * (role == 0 ? ldk : (role == 1 ? ldv : 16));
    const unsigned ddst = lds0 + (role == 0 ? LDS_K + (wid & 1) * 1024 : (role == 1 ? LDS_V + (wid & 3) * 1024 : LDS_KR));
    const int dslot = role == 0 ? KSLOT : (role == 1 ? SLOT : KRSLOT); const bool dma_on = role != 3;
#define DMA(t, si) glds16(dsrc + (size_t)(t) * dstep, (unsigned)__builtin_amdgcn_readfirstlane(ddst + (si) * dslot))
    const lds_cptr kpa = (lds_cptr)lds + LDS_K + r32 * 32 + ((hi ^ ((r32 >> 3) & 1)) * 16);
    const int vg = (lane >> 4) & 1, vq = (lane & 15) >> 1, vp = lane & 1, vfk = (vq >> 2) & 1;
    const int vrow = (8 * (vq >> 2) + 4 * hi + (vq & 3)) * 64 + 8 * vp + 16 * vg;
    const lds_cptr vp0 = (lds_cptr)lds + LDS_V + vrow + 32 * vfk, vp1 = (lds_cptr)lds + LDS_V + vrow + 32 * (1 - vfk);
    const lds_cptr ra0 = (lds_cptr)lds + LDS_KR + (hi ? 1024 : r32 * 16), ra1 = (lds_cptr)lds + LDS_KR + (hi ? 1024 : 512 + r32 * 16);
    if (ROPE) { if (tid < 16) *(int*)(lds + LDS_KR + (tid >> 2) * KRSLOT + 1024 + (tid & 3) * 4) = 0; }
    if (dma_on) { if (kwave) { DMA(0, 0); DMA(1, 1); DMA(2, 2); DMA(3, 3); } else { DMA(0, 0); DMA(1, 1); } }
    v6u qf, qrf;
    if (!ROPE) { qf = q32_to_fp6((const bf16_t*)Qv + (size_t)(wid * 32 + r32) * ldq + hi * 32, 1.0f); qrf = qf; }
    else { const f32x2 s2 = *(const f32x2*)(ssh + (size_t)(wid * 32 + r32) * 32); const float sc = rsqrtf((s2[0] + s2[1]) * (1.f / 96.f) + EPS) * (C2_MLA * 8.f);
        qf = q32_to_fp6((const bf16_t*)Qv + (size_t)(wid * 32 + r32) * ldq + hi * 32, sc);
        qrf = q32_to_fp6(Qr + (size_t)(wid * 32 + r32) * 512, hi ? 0.f : sc); }
    f32x16 o[2]; o[0] = f32x16{}; o[1] = f32x16{}; f32x4 lacc = f32x4{};
    v8i ones;
#pragma unroll
    for (int i = 0; i < 8; ++i) ones[i] = ((lane & 15) == ((lane >> 4) & 1)) ? 0x38383838 : 0;
    PIN(ones);
    f32x16 m4;
    { float y_ = YOFF; asm volatile("" : "+v"(y_));
#pragma unroll
      for (int r = 0; r < 16; ++r) m4[r] = y_; }
    PIN(m4);
    v4i kf0, kf1, krf0, krf1; v8i vf0, vf1, pfA, pfB;
#define ROT() do { } while (0)
#define EX(v) __builtin_amdgcn_exp2f(v)
#define KLOAD(si) do { kf0 = lds128(kpa + (si) * KSLOT); kf1 = lds128(kpa + (si) * KSLOT + 1024); if (ROPE) { krf0 = lds128(ra0 + (si) * KRSLOT); krf1 = lds128(ra1 + (si) * KRSLOT); } } while (0)
    WAIT_BAR0();
    KLOAD(0);
    { f32x16 c0 = QKMFMA(kf0, qf, m4), c1 = QKMFMA(kf1, qf, m4);
      if (ROPE) { c0 = QKMFMA(krf0, qrf, c0); c1 = QKMFMA(krf1, qrf, c1); }
      PK16U8(c0, pfA, 0); PK16U8(c1, pfA, 4); }
    WAIT_BAR0();
    if (dma_on) { if (kwave) { if (4 < NT) DMA(4, 0); } else DMA(2, 2); }
    KLOAD(1);
    WAIT_BAR1();
#define VRD2(m) do { const v2i a_ = vtr8(vp0 + vsl_ * SLOT + (m) * 1024), b_ = vtr8(vp1 + vsl_ * SLOT + (m) * 1024); vf0[2 * (m)] = a_[0]; vf0[2 * (m) + 1] = a_[1]; vf1[2 * (m)] = b_[0]; vf1[2 * (m) + 1] = b_[1]; } while (0)
#define STEP(t, PFP, PFN, GK, GV, GL) do { SBAR(); \
    const int vsl_ = ((t) - 1) & 3; f32x16 C0, C1; \
    VRD2(0); VRD2(1); SBAR(); \
    C0 = QKMFMA(kf0, qf, m4); if (ROPE) C0 = QKMFMA(krf0, qrf, C0); PIN(C0); SBAR(); \
    VRD2(2); VRD2(3); SBAR(); \
    C1 = QKMFMA(kf1, qf, m4); if (ROPE) C1 = QKMFMA(krf1, qrf, C1); PIN(C1); SBAR(); \
    if (GL) { KLOAD(((t) + 1) & 3); } \
    { const bool mine_ = dma_on && (kwave ? (GK) : (GV)); if (mine_) DMA((t) + dlead, kwave ? ((t) & 3) : (((t) + 2) & 3)); } \
    SBAR(); \
    lacc = SUMMFMA(PFP, ones, lacc); PIN(lacc); SBAR(); \
    PK16U8(C0, PFN, 0); PIN(PFN); SBAR(); \
    o[0] = PVMFMA8(PFP, vf0, o[0]); PIN(o[0]); SBAR(); \
    PK16U8(C1, PFN, 4); PIN(PFN); SBAR(); \
    o[1] = PVMFMA8(PFP, vf1, o[1]); PIN(o[1]); SBAR(); \
    { const bool mine_ = dma_on && (kwave ? (GK) : (GV)); if (mine_) WAIT_BAR1(); else WAIT_BAR0(); } \
    } while (0)
#ifdef MK_UNIT_PROBE
    const unsigned long long upT1 = __builtin_amdgcn_s_memrealtime();
#endif
    int t = 1;
    for (; t + 5 < NT; t += 2) {
        STEP(t, pfA, pfB, true, true, true);     ROT();
        STEP(t + 1, pfB, pfA, true, true, true); ROT();
    }
    for (; t + 1 < NT; t += 2) {
        STEP(t, pfA, pfB, (t + 4 < NT), (t + 2 < NT), (t + 1 < NT));         ROT();
        STEP(t + 1, pfB, pfA, (t + 5 < NT), (t + 3 < NT), (t + 2 < NT));     ROT();
    }
    STEP(NT - 1, pfA, pfB, false, false, false);
#ifdef MK_UNIT_PROBE
    const unsigned long long upT2 = __builtin_amdgcn_s_memrealtime();
#endif
    { const int vsl_ = (NT - 1) & 3; VRD2(0); VRD2(1); VRD2(2); VRD2(3);
      lacc = SUMMFMA(pfB, ones, lacc); o[0] = PVMFMA8(pfB, vf0, o[0]); o[1] = PVMFMA8(pfB, vf1, o[1]); }
    float rli[16];
#pragma unroll
    for (int r = 0; r < 16; ++r) rli[r] = 0.f;
    if ((lane & 15) < 2) *(f32x4*)(wsf + (lane & 15) * 16 + 4 * (lane >> 4)) = lacc;
    asm volatile("s_waitcnt lgkmcnt(0)" ::: "memory");
#pragma unroll
    for (int r = 0; r < 16; ++r) rli[r] = __builtin_amdgcn_rcpf(wsf[crow(r, hi)]);
    bf16_t* stg = (bf16_t*)(lds + LDS_OST) + wid * 2048;
#pragma unroll
    for (int r = 0; r < 16; ++r) { const int orow = crow(r, hi);
#pragma unroll
        for (int d0 = 0; d0 < 2; ++d0) stg[orow * 64 + d0 * 32 + r32] = (bf16_t)f2bf(o[d0][r] * rli[r]); }
    asm volatile("s_waitcnt lgkmcnt(0)" ::: "memory");
#pragma unroll
    for (int i = 0; i < 4; ++i) { const int row = i * 8 + (lane >> 3), ch = lane & 7; const size_t goff = (size_t)(wid * 32 + row) * ldo + ch * 8;
        const u32x4 ov = *(const u32x4*)(stg + row * 64 + ch * 8); const u32x4 gv = *(const u32x4*)(G + goff); u32x4 w;
#pragma unroll
        for (int q = 0; q < 4; ++q) { const float lo = __uint_as_float(ov[q] << 16) * __uint_as_float(gv[q] << 16), hh = __uint_as_float(ov[q] & 0xffff0000u) * __uint_as_float(gv[q] & 0xffff0000u); w[q] = cvtpk(lo, hh); }
        *(u32x4*)(O + goff) = w; }
    asm volatile("s_waitcnt lgkmcnt(0)\n\ts_barrier" ::: "memory");
#ifdef MK_UNIT_PROBE
    { const unsigned long long upT3 = __builtin_amdgcn_s_memrealtime(); const int w_ = MK_UNIT_PROBE & 3; upacc += w_ == 1 ? (upT1 - upT0) : (w_ == 2 ? (upT3 - upT2) : (upT2 - upT1)); }
#endif
#undef DMA
#undef ROT
#undef EX
#undef KLOAD
#undef VRD2
#undef STEP
}
#undef SBAR
#undef PIN
#undef WAIT_BAR0
#undef WAIT_BAR1
#undef QKMFMA
#undef SUMMFMA
#undef V8
#undef V6
#undef PVMFMA8
}

#define RLX_AGENT __ATOMIC_RELAXED, __HIP_MEMORY_SCOPE_AGENT
#define XB_TMO      128
#define XB_XCNT(j)  (256  + 64 * (j))
#define XB_XSUB(j)  (1280 + 64 * (j))
#define XB_XGEN(j)  (2304 + 64 * (j))
#define XB_TOP      3328
#define XB_TOPGEN   3392
#define XCD_BAR_WORDS 3456
#define XB_SPIN_CAP (1u << 18)

__device__ __forceinline__ unsigned xb_ld(unsigned* p)              { return __hip_atomic_load(p, __ATOMIC_RELAXED, __HIP_MEMORY_SCOPE_AGENT); }
__device__ __forceinline__ unsigned xb_add(unsigned* p, unsigned v) { return __hip_atomic_fetch_add(p, v, __ATOMIC_RELAXED, __HIP_MEMORY_SCOPE_AGENT); }
__device__ __forceinline__ unsigned xb_xcc_id() { return (unsigned)__builtin_amdgcn_s_getreg((3 << 11) | 20) & 0xFu; }
#define XB_SPIN(cond, bar) do { unsigned _sp = 0; while (cond) { __builtin_amdgcn_s_sleep(1); \
    if ((++_sp & 255u) == 0u) { if (xb_ld(&(bar)[XB_TMO])) break; if (_sp > XB_SPIN_CAP) { atomicAdd(&(bar)[XB_TMO], 1u); break; } } } } while (0)

struct XcdBarrier {
    unsigned* bar; unsigned x;
    volatile LAS unsigned* st;
};

__device__ __forceinline__ XcdBarrier xcd_barrier_post(unsigned* bar, volatile LAS unsigned* st) {
    XcdBarrier b; b.bar = bar; b.x = xb_xcc_id(); b.st = st;
    if (threadIdx.x == 0) (void)xb_add(&bar[XB_XCNT(b.x)], 1u);
    return b;
}
__device__ __forceinline__ void xcd_barrier_complete(unsigned* bar, unsigned x, unsigned& nloc, unsigned& nx) {
    const unsigned G = gridDim.x * gridDim.y * gridDim.z;
    unsigned sum, cnt, mine, sp = 0u;
    for (;;) {
        sum = 0u; cnt = 0u; mine = 0u;
#pragma unroll
        for (unsigned j = 0; j < 16; ++j) { const unsigned c = xb_ld(&bar[XB_XCNT(j)]); sum += c; cnt += (c > 0u) ? 1u : 0u; mine = (j == x) ? c : mine; }
        if (sum == G) break;
        __builtin_amdgcn_s_sleep(1);
        if ((++sp & 255u) == 0u) { if (xb_ld(&bar[XB_TMO])) break; if (sp > XB_SPIN_CAP) { atomicAdd(&bar[XB_TMO], 1u); break; } }
    }
    nloc = mine > 0u ? mine : 1u; nx = cnt > 0u ? cnt : 1u;
}

__device__ __forceinline__ void xcd_barrier(const XcdBarrier& b) {
    asm volatile("s_waitcnt vmcnt(0)" ::: "memory");
    __syncthreads();
    if (threadIdx.x == 0) {
        unsigned* bar = b.bar;
        __builtin_amdgcn_s_waitcnt(0);
        unsigned nloc = b.st[0], nx = b.st[1];
        if (nloc == 0u) { xcd_barrier_complete(bar, b.x, nloc, nx); b.st[0] = nloc; b.st[1] = nx; }
        const unsigned old = xb_add(&bar[XB_XSUB(b.x)], 1u);
        const unsigned gen = old / nloc;
        if (old + 1u == (gen + 1u) * nloc) {
            __builtin_amdgcn_fence(__ATOMIC_RELEASE, "agent");
            asm volatile("s_waitcnt vmcnt(0)" ::: "memory");
            const unsigned og = xb_add(&bar[XB_TOP], 1u);
            const unsigned tg = og / nx;
            if (og + 1u == (tg + 1u) * nx) xb_add(&bar[XB_TOPGEN], 1u);
            else XB_SPIN(xb_ld(&bar[XB_TOPGEN]) == tg, bar);
            __builtin_amdgcn_fence(__ATOMIC_ACQUIRE, "agent");
            xb_add(&bar[XB_XGEN(b.x)], 1u);
            asm volatile("s_waitcnt vmcnt(0)" ::: "memory");
        } else {
            XB_SPIN(xb_ld(&bar[XB_XGEN(b.x)]) == gen, bar);
            __builtin_amdgcn_fence(__ATOMIC_ACQUIRE, "agent");
            asm volatile("s_waitcnt vmcnt(0)" ::: "memory");
        }
    }
    __syncthreads();
}


#include <hip/hip_cooperative_groups.h>
namespace cg = cooperative_groups;
constexpr int NWAVES = 8, NTHREADS = 512, LDS_BYTES = 147456, RING_BYTES = 131072;
constexpr size_t MiB = 1u << 20;
constexpr size_t WS_MOD = 1 * MiB;
constexpr size_t WS_TABA = WS_MOD + 128 * 1024;
constexpr size_t WS_TABB = WS_TABA + 32 * 1024;
constexpr size_t WS_WIN0 = 2 * MiB;
constexpr size_t WS_WOUT0 = 7 * MiB;
constexpr size_t WS_WIN1 = 9 * MiB;
constexpr size_t WS_WKVB = 13 * MiB;
constexpr size_t WS_WQB = 14 * MiB;
constexpr size_t WS_WOUT1 = 16 * MiB;
constexpr size_t WS_X1C = 18 * MiB;
constexpr size_t WS_H = 20 * MiB;
constexpr size_t WS_Q = 53 * MiB;
constexpr size_t WS_K = 86 * MiB;
constexpr size_t WS_V0 = 95 * MiB;
constexpr size_t WS_G = 120 * MiB;
constexpr size_t WS_V1 = 153 * MiB;
constexpr size_t WS_KVA = 186 * MiB;
constexpr size_t WS_QA = 195 * MiB;
constexpr size_t WS_Q1R = 207 * MiB;
constexpr size_t WS_KR = 223 * MiB;
constexpr size_t WS_SSKV = 225 * MiB;
constexpr size_t WS_SSQ = 226 * MiB;
constexpr size_t WS_SSH = 227 * MiB;
constexpr size_t WS_SSX = 229 * MiB;
constexpr size_t WS_BIAS1 = WS_MOD + 80 * 1024;
constexpr size_t WS_NWM1 = WS_MOD + 104 * 1024;
constexpr size_t WS_RINV = 230 * MiB + 512 * 1024;
constexpr size_t WS_SLAB = 231 * MiB;
constexpr size_t WS_END = 256 * MiB;
static_assert(WS_K + (size_t)NB * TK * DM * 2 <= WS_G && WS_G + (size_t)MT * DM * 2 <= WS_V1 && WS_V1 + (size_t)NB * TK * DM * 2 <= WS_KVA && WS_SSH + (size_t)ML * 32 * 4 <= WS_END, "ws map");

#ifndef ATT1_F8
#define ATT1_F8 1
#endif
#ifndef ATT0_F8
#define ATT0_F8 1
#endif
struct Args { const float* in[23]; float* out; unsigned char* ws; int ph_lo, ph_hi, coop, pad; };

DEVI void phase0(const Args& a, unsigned char* ws, LAS unsigned char* lds, int vb, int G) {
    const int tid = threadIdx.x, wave = tid >> 6, lane = tid & 63;
    float* mod = (float*)(ws + WS_MOD);
    if (vb < 96) {
        LAS float* sc = (LAS float*)lds; LAS float* red = sc + 3 * 1024;
        const int layer = vb / 48, cs = vb % 48; const float* w = a.in[layer ? 11 : 4]; const float* bb = a.in[layer ? 12 : 5];
        for (int i = tid; i < 3072; i += NTHREADS) { const int r = i >> 10, k = i & 1023; const float v = r < 2 ? a.in[1][r * 1024 + k] : a.in[3][k]; sc[i] = v / (1.f + expf(-v)); }
        __syncthreads();
        const int col = cs * 64 + lane; float a0 = 0.f, a1 = 0.f, a2 = 0.f;
#pragma unroll 8
        for (int k = wave * 128; k < wave * 128 + 128; ++k) { const float wv = w[(size_t)k * 3072 + col]; a0 += sc[k] * wv; a1 += sc[1024 + k] * wv; a2 += sc[2048 + k] * wv; }
        red[(wave * 3 + 0) * 64 + lane] = a0; red[(wave * 3 + 1) * 64 + lane] = a1; red[(wave * 3 + 2) * 64 + lane] = a2;
        __syncthreads();
        if (tid < 192) { const int r = tid >> 6; float s = 0.f;
#pragma unroll
            for (int q = 0; q < 8; ++q) s += red[(q * 3 + r) * 64 + lane];
            mod[(size_t)(layer * 3 + r) * 3072 + col] = s + bb[col]; }
        __syncthreads();
    } else if (vb < 102) {
        f32x2* tabA = (f32x2*)(ws + WS_TABA); f32x2* tabB = (f32x2*)(ws + WS_TABB);
        const int i = (vb - 96) * NTHREADS + tid;
        if (i < 128 * 16) { const int pos = i >> 4, f = i & 15; const float invf = powf(10000.f, -(float)f / 16.f); float cs_, sn_; sincos_pos((float)pos * invf, cs_, sn_); tabA[i] = (f32x2){cs_, sn_}; }
        else if (i < 128 * 24) { const int j = i - 128 * 16, pos = j >> 3, f = j & 7; const float invf = powf(10000.f, -(float)f / 8.f); float cs_, sn_; sincos_pos((float)pos * invf, cs_, sn_); tabB[j] = (f32x2){cs_, sn_}; }
    }
    if (vb < 102 || G <= 102) { if (G > 102) return; }
    struct WD { int src, K, Nsrc, Np, mode, ks; size_t dst; };
    const WD wd[6] = {{7, 1024, N_IN0, 2560, 1, -1, WS_WIN0}, {10, 1024, 1024, 1024, 0, -1, WS_WOUT0}, {14, 1024, N_IN1, N_IN1P, 2, -1, WS_WIN1},
                      {16, 256, 2048, 2048, 3, 15, WS_WKVB}, {18, 384, 1536, 2048, 4, 17, WS_WQB}, {22, 1024, 1024, 1024, 0, -1, WS_WOUT1}};
    LAS float* tl = (LAS float*)lds; int tbase = 0;
#pragma unroll
    for (int m = 0; m < 6; ++m) {
        const float* W = a.in[wd[m].src]; const float* ks = wd[m].ks >= 0 ? a.in[wd[m].ks] : nullptr; bf16_t* Bt = (bf16_t*)(ws + wd[m].dst);
        const int K = wd[m].K, Nsrc = wd[m].Nsrc, Np = wd[m].Np, npb = Np / 256, ntile = (K / 64) * npb;
        for (int it = ((vb - 102) - tbase % (G - 102) + (G - 102)) % (G - 102); it < ntile; it += (G - 102)) {
            const int kb = it / npb, pb = it % npb, k0 = 64 * kb, p0 = 256 * pb;
            const int pl = tid & 255, kh = tid >> 8; int cc = pg8::wmap(wd[m].mode, p0 + pl); if (cc >= Nsrc) cc = -1;
            float v[32];
#pragma unroll
            for (int i = 0; i < 32; ++i) { const int k = k0 + 2 * i + kh; v[i] = cc >= 0 ? W[(size_t)k * Nsrc + cc] * (ks ? ks[k] : 1.f) : 0.f; }
#pragma unroll
            for (int i = 0; i < 32; ++i) tl[pl * 65 + 2 * i + kh] = v[i];
            __syncthreads();
#pragma unroll
            for (int j = 0; j < 4; ++j) { const int q = tid + 512 * j, pr = q >> 3, c = q & 7; const LAS float* sp = tl + pr * 65 + 8 * c;
                u32x4 o; o.x = pk2(sp[0], sp[1]); o.y = pk2(sp[2], sp[3]); o.z = pk2(sp[4], sp[5]); o.w = pk2(sp[6], sp[7]);
                *(u32x4*)(Bt + (size_t)(p0 + pr) * K + k0 + 8 * c) = o; }
            __syncthreads();
        }
        tbase += ntile;
    }
}

DEVI void phase_prep(const float* xa, const float* xb, const float* nw, const float* mod, bf16_t* H, int gw, int NGW, int lane) {
    for (int row0 = gw; row0 < MT; row0 += 4 * NGW) {
        f32x4 v[4][4]; float ss[4];
#pragma unroll
        for (int q = 0; q < 4; ++q) { const int row = row0 + q * NGW; ss[q] = 0.f;
            if (row < MT) { const float* src = row < ML ? xa + (size_t)row * DM : xb + (size_t)(row - ML) * DM;
#pragma unroll
                for (int j = 0; j < 4; ++j) v[q][j] = *(const f32x4*)(src + 4 * lane + 256 * j); } }
#pragma unroll
        for (int q = 0; q < 4; ++q) { const int row = row0 + q * NGW;
            if (row < MT) {
#pragma unroll
                for (int j = 0; j < 4; ++j) ss[q] += (v[q][j].x * v[q][j].x + v[q][j].y * v[q][j].y) + (v[q][j].z * v[q][j].z + v[q][j].w * v[q][j].w); } }
#pragma unroll
        for (int o = 1; o < 64; o <<= 1) {
#pragma unroll
            for (int q = 0; q < 4; ++q) ss[q] += __shfl_xor(ss[q], o); }
#pragma unroll
        for (int q = 0; q < 4; ++q) { const int row = row0 + q * NGW;
            if (row < MT) { const int r = row < SEQ ? 0 : (row < ML ? 1 : 2); const float rinv = rsqrtf(ss[q] * (1.f / DM) + EPS);
#pragma unroll
                for (int j = 0; j < 4; ++j) { const int cidx = 4 * lane + 256 * j; const f32x4 w = *(const f32x4*)(nw + cidx);
                    const f32x4 sh = *(const f32x4*)(mod + (size_t)r * 3072 + cidx), scl = *(const f32x4*)(mod + (size_t)r * 3072 + 1024 + cidx);
                    const f32x4 h = (v[q][j] * rinv) * w * (scl + 1.f) + sh;
                    u32x2 o; o.x = pk2(h.x, h.y); o.y = pk2(h.z, h.w); *(u32x2*)(H + (size_t)row * DM + cidx) = o; } } }
    }
}

DEVI float sq4f(const f32x4 v) { return (v[0] * v[0] + v[1] * v[1]) + (v[2] * v[2] + v[3] * v[3]); }
DEVI void phase1_extras(const float* nw1, const float* mod1, const bf16_t* Win1t, float* nwm1, float* bias1, const float* ctx, float* X1c, int gw, int NGW, int lane) {
    for (int p = gw; p < N_IN1P; p += NGW) {
        const u32x4 w0 = *(const u32x4*)(Win1t + (size_t)p * DM + lane * 16), w1 = *(const u32x4*)(Win1t + (size_t)p * DM + lane * 16 + 8); float acc3[3];
#pragma unroll
        for (int r = 0; r < 3; ++r) { const float* mp = mod1 + (size_t)r * 3072 + lane * 16; const f32x4 m0 = *(const f32x4*)mp, m1 = *(const f32x4*)(mp + 4), m2 = *(const f32x4*)(mp + 8), m3 = *(const f32x4*)(mp + 12);
            const float mm[16] = {m0[0], m0[1], m0[2], m0[3], m1[0], m1[1], m1[2], m1[3], m2[0], m2[1], m2[2], m2[3], m3[0], m3[1], m3[2], m3[3]}; float a = 0.f;
#pragma unroll
            for (int i = 0; i < 8; ++i) { const unsigned ww = i < 4 ? w0[i] : w1[i - 4]; a += mm[2 * i] * __uint_as_float(ww << 16) + mm[2 * i + 1] * __uint_as_float(ww & 0xffff0000u); }
            acc3[r] = wave_sum(a); }
        if (lane == 0) { bias1[p] = acc3[0]; bias1[N_IN1P + p] = acc3[1]; bias1[2 * N_IN1P + p] = acc3[2]; }
    }
    for (int i = gw * 64 + lane; i < 3 * DM; i += NGW * 64) { const int r = i >> 10, c = i & 1023; nwm1[i] = nw1[c] * (1.f + mod1[(size_t)r * 3072 + 1024 + c]); }
}
DEVI void phase_ctxprep(const float* ctx, const float* slab, const float* gatec, float* X1c, const float* nwm1, bf16_t* H, const float* SSX, float* RINV, int gw, int NGW, int lane) {
    for (int rr = gw; rr < MC; rr += NGW) { const int R = ML + rr; float ss = 0.f;
#pragma unroll
        for (int j = 0; j < 4; ++j) { const int c = 4 * lane + 256 * j; f32x4 y = *(const f32x4*)(slab + (size_t)rr * DM + c);
#pragma unroll
            for (int ks = 1; ks < 8; ++ks) y = y + *(const f32x4*)(slab + ((size_t)ks * MC + rr) * DM + c);
            const f32x4 v = *(const f32x4*)(ctx + (size_t)rr * DM + c) + *(const f32x4*)(gatec + c) * y; *(f32x4*)(X1c + (size_t)rr * DM + c) = v;
            ss += sq4f(v); const f32x4 h = v * *(const f32x4*)(nwm1 + 2 * DM + c);
            u32x2 o; o.x = pk2(h.x, h.y); o.y = pk2(h.z, h.w); *(u32x2*)(H + (size_t)R * DM + c) = o; }
        ss = wave_sum(ss); if (lane == 0) RINV[R] = rsqrtf(ss * (1.f / DM) + EPS); }
    for (int R = gw * 64 + lane; R < ML; R += NGW * 64) { const f32x4 s0 = *(const f32x4*)(SSX + (size_t)R * 16), s1 = *(const f32x4*)(SSX + (size_t)R * 16 + 4), s2 = *(const f32x4*)(SSX + (size_t)R * 16 + 8), s3 = *(const f32x4*)(SSX + (size_t)R * 16 + 12);
        const f32x4 st = (s0 + s1) + (s2 + s3); RINV[R] = rsqrtf(((st[0] + st[1]) + (st[2] + st[3])) * (1.f / DM) + EPS); }
}

#ifdef MK_UBENCH
DEVI void ubench(int wave) {
    typedef int v8i __attribute__((ext_vector_type(8)));
    if ((MK_UBENCH & 4) && wave >= 4) return;
    v8i a, b; f32x16 acc = f32x16{}; float e[8]; float d = 0.f;
#pragma unroll
    for (int i = 0; i < 8; ++i) { a[i] = 0x38383838; b[i] = 0x38383838; e[i] = 0.001f * (float)(i + 1); }
    asm volatile("" : "+v"(a), "+v"(b));
    bf16x8 ha, hb; asm volatile("" : "=v"(ha), "=v"(hb));
    for (int it = 0; it < 1500; ++it) {
        if (MK_UBENCH & 1) { if (MK_UBENCH & 16) { acc = __builtin_amdgcn_mfma_f32_32x32x16_bf16(ha, hb, acc, 0, 0, 0); acc = __builtin_amdgcn_mfma_f32_32x32x16_bf16(ha, hb, acc, 0, 0, 0); }
                             else if (MK_UBENCH & 32) acc = __builtin_amdgcn_mfma_scale_f32_32x32x64_f8f6f4(a, b, acc, 4, 2, 0, 127, 0, 127);
                             else if (MK_UBENCH & 64) acc = __builtin_amdgcn_mfma_scale_f32_32x32x64_f8f6f4(a, b, acc, 4, 4, 0, 127, 0, 127);
                             else acc = __builtin_amdgcn_mfma_scale_f32_32x32x64_f8f6f4(a, b, acc, 0, 0, 0, 127, 0, 127); }
        if (MK_UBENCH & 2) {
#pragma unroll
            for (int i = 0; i < 8; ++i) e[i] = __builtin_amdgcn_exp2f(e[i]) * 0.5f; }
        if (MK_UBENCH & 8) {
#pragma unroll
            for (int i = 0; i < 16; ++i) asm volatile("v_add_f32 %0, %0, %1" : "+v"(e[i & 7]) : "v"(d)); }
        asm volatile("" : "+v"(acc)); __builtin_amdgcn_sched_barrier(0);
    }
#pragma unroll
    for (int i = 0; i < 8; ++i) asm volatile("" :: "v"(e[i]));
    asm volatile("" :: "v"(acc));
}
#endif
__global__ void __launch_bounds__(NTHREADS, 2) mega(Args a) {
    extern __shared__ __attribute__((aligned(16))) unsigned char lds[];
    const int tid = threadIdx.x, lane = tid & 63; const int wave = __builtin_amdgcn_readfirstlane(tid >> 6);
    const int G = gridDim.x, bx = blockIdx.x; const int vcu = (G % 8 == 0) ? (bx % 8) * (G / 8) + bx / 8 : bx;
    unsigned char* ws = a.ws; float* out = a.out;
    const float* x = a.in[0]; const float* ctx = a.in[2];
    float* mod = (float*)(ws + WS_MOD); const f32x4* tabA = (const f32x4*)(ws + WS_TABA); const f32x4* tabB = (const f32x4*)(ws + WS_TABB);
    bf16_t* H = (bf16_t*)(ws + WS_H); bf16_t* Qb = (bf16_t*)(ws + WS_Q); bf16_t* K0 = (bf16_t*)(ws + WS_K); bf16_t* V0 = (bf16_t*)(ws + WS_V0); bf16_t* K1 = (bf16_t*)(ws + WS_K);
    bf16_t* Gb = (bf16_t*)(ws + WS_G); bf16_t* V1 = (bf16_t*)(ws + WS_V1); bf16_t* KVA = (bf16_t*)(ws + WS_KVA); bf16_t* QA = (bf16_t*)(ws + WS_QA); bf16_t* Q1R = (bf16_t*)(ws + WS_Q1R);
    bf16_t* O0 = (bf16_t*)(ws + WS_V1); bf16_t* O1 = (bf16_t*)(ws + WS_H); bf16_t* KR = (bf16_t*)(ws + WS_KR); float* SSKV = (float*)(ws + WS_SSKV); float* SSQ = (float*)(ws + WS_SSQ); float* SSH = (float*)(ws + WS_SSH); float* X1c = (float*)(ws + WS_X1C); float* SSX = (float*)(ws + WS_SSX); float* BIAS1 = (float*)(ws + WS_BIAS1); float* NWM1 = (float*)(ws + WS_NWM1);
#ifdef MK_TS
#define MK_TS_SEAM (MK_TS >= 100 ? (MK_TS % 100) : MK_TS / 2)
#define MK_TS_WHAT (MK_TS % 2)
#endif
#ifdef MK_TS_SEAM
    const unsigned long long ts0 = __builtin_amdgcn_s_memrealtime(); unsigned long long ts1 = ts0, ts2 = ts0;
#endif
    const int lo = a.ph_lo, hi_ = a.ph_hi;
#ifndef ONLY_PHASE
#define ONLY_PHASE -1
#endif
#define IN(k) ((ONLY_PHASE < 0 || ONLY_PHASE == (k)) && lo <= (k) && (k) < hi_)
#ifndef MK_REP_MASK
#define MK_REP_MASK 0
#endif
#define REPS(k) (((MK_REP_MASK >> (k)) & 1) ? 2 : 1)
#ifdef MK_TS_SEAM
#define SEAM(k) do { if (IN(k) && IN((k) + 1)) { if ((k) == MK_TS_SEAM) { ts1 = __builtin_amdgcn_s_memrealtime(); if (tid == 0) { atomicMax((unsigned*)ws + 4000, (unsigned)(ts1 - ts0)); atomicMax((unsigned*)ws + 4001, ((unsigned)(ts1 - ts0) << 10) | (unsigned)bx); } } xcd_barrier(xbar); if ((k) == MK_TS_SEAM) ts2 = __builtin_amdgcn_s_memrealtime(); } } while (0)
#else
#define SEAM(k) do { if (IN(k) && IN((k) + 1)) { xcd_barrier(xbar); } } while (0)
#endif
    PG8_LAS unsigned char* ring = (PG8_LAS unsigned char*)lds;
    volatile LAS unsigned* xst = (volatile LAS unsigned*)((LAS unsigned char*)lds + RING_BYTES + 512);
    if (tid < 4) xst[tid] = 0u;
    __syncthreads();
    XcdBarrier xbar; xbar.bar = (unsigned*)ws; xbar.x = 0; xbar.st = xst;
    if (a.coop) xbar = xcd_barrier_post((unsigned*)ws, xst);
    if (a.coop == 0x7fffffff) cg::this_grid().sync();

    if (IN(0)) for (int rep_ = 0; rep_ < REPS(0); ++rep_) { phase0(a, ws, (LAS unsigned char*)lds, bx, G); } SEAM(0);
    if (IN(1)) for (int rep_ = 0; rep_ < REPS(1); ++rep_) { phase1_extras(a.in[13], mod + 3 * 3072, (const bf16_t*)(ws + WS_WIN1), NWM1, BIAS1, ctx, X1c, vcu * NWAVES + wave, G * NWAVES, lane);
        phase_prep(x, ctx, a.in[6], mod, H, vcu * NWAVES + wave, G * NWAVES, lane); } SEAM(1);
    if (IN(2)) { pg8::Gemm g{H, (const bf16_t*)(ws + WS_WIN0), MT, N_IN0, 1024}; pg8::ROrder S; S.init(0, MT / 256, N_IN0, G, bx, REPS(2));
        pg8::EpiIn0<ATT0_F8> E{a.in[8], a.in[9], tabA, K0, V0, Qb, Gb};
        pg8::gemm_phase<pg8::EpiIn0<ATT0_F8>, pg8::ROrder, true, true>(ring, g, S, E); } SEAM(2);
#ifdef MK_UNIT_PROBE
    unsigned long long upacc = 0, updummy = 0;
#define UPROBE_ARG3 , *((MK_UNIT_PROBE & 48) == 0 ? &upacc : &updummy)
#define UPROBE_ARGC , *((MK_UNIT_PROBE & 48) == 32 ? &upacc : &updummy)
#define UPROBE_ARG8 , *((MK_UNIT_PROBE & 48) == 16 ? &upacc : &updummy)
#else
#define UPROBE_ARG3
#define UPROBE_ARGC
#define UPROBE_ARG8
#endif
#ifdef MK_CLOCK_PROBE
    unsigned long long pc0 = 0, pr0 = 0, pc1 = 0, pr1 = 0;
    if (IN(3)) { pc0 = __builtin_readcyclecounter(); pr0 = __builtin_amdgcn_s_memrealtime(); }
#endif
    if (IN(3)) for (int rep_ = 0; rep_ < REPS(3); ++rep_) {
        const int xg = vcu >> 5, c = vcu & 31, b = xg >> 2, kvh = xg & 3; const size_t kbase = (size_t)b * TK * 256 + kvh * 64;
#ifdef MK_PROBE_NT
        const int NT3 = (rep_ + 1 < REPS(3)) ? MK_PROBE_NT : TK / 64;
#else
        const int NT3 = TK / 64;
#endif
#if ATT0_F8
        const unsigned char* K8 = (const unsigned char*)K0 + (size_t)b * TK * 128 + kvh * 32; const unsigned char* V8 = (const unsigned char*)V0 + kbase;
        for (int i = 0; i < 4; ++i) { const int h = kvh * 4 + i; const size_t q0 = ((size_t)b * SEQ + c * 256) * DM + h * 64;
            af8::attn_unit<0>(Qb + q0, DM, nullptr, nullptr, K8, 128, nullptr, V8, 256, NT3, O0 + q0, Gb + q0, DM, (char*)lds UPROBE_ARG3); }
        if (c < 4) { const int h = kvh * 4 + c; const size_t q0 = ((size_t)ML + b * CTXL) * DM + h * 64;
            af8::attn_unit<0>(Qb + q0, DM, nullptr, nullptr, K8, 128, nullptr, V8, 256, CTXL / 64, O0 + q0, Gb + q0, DM, (char*)lds UPROBE_ARGC); }
#else
        for (int i = 0; i < 4; ++i) { const int h = kvh * 4 + i; const size_t q0 = ((size_t)b * SEQ + c * 256) * DM + h * 64;
            afast::attn_unit<0>(Qb + q0, DM, nullptr, nullptr, K0 + kbase, 256, nullptr, V0 + kbase, 256, TK / 64, O0 + q0, Gb + q0, DM, (char*)lds); }
        if (c < 4) { const int h = kvh * 4 + c; const size_t q0 = ((size_t)ML + b * CTXL) * DM + h * 64;
            afast::attn_unit<0>(Qb + q0, DM, nullptr, nullptr, K0 + kbase, 256, nullptr, V0 + kbase, 256, CTXL / 64, O0 + q0, Gb + q0, DM, (char*)lds); }
#endif
    } SEAM(3);
#ifdef MK_CLOCK_PROBE
    if (IN(3)) { pc1 = __builtin_readcyclecounter(); pr1 = __builtin_amdgcn_s_memrealtime(); }
#endif
    if (IN(4)) {
        { pg8::Gemm g{O0, (const bf16_t*)(ws + WS_WOUT0), ML, 1024, 1024, 0}; pg8::ROrder S; S.init(0, ML / 256, 1024, G, bx, REPS(4));
          pg8::EpiOutF E{x, out, mod + 2048, NWM1, H, SSX};
          pg8::gemm_phase<pg8::EpiOutF, pg8::ROrder, true, true>(ring, g, S, E); }
        { pg8::Gemm g{O0, (const bf16_t*)(ws + WS_WOUT0), MT, 1024, 1024, 128}; pg8::CtxSplitOrder S; S.init(bx, 8, 128);
          pg8::EpiOutSlab E{(float*)(ws + WS_SLAB), 128};
          pg8::gemm_phase<pg8::EpiOutSlab, pg8::CtxSplitOrder, true, true>(ring, g, S, E); }
    } SEAM(4);
    if (IN(5)) { phase_ctxprep(ctx, (const float*)(ws + WS_SLAB), mod + 2048 + 2 * 3072, X1c, NWM1, H, SSX, (float*)(ws + WS_RINV), vcu * NWAVES + wave, G * NWAVES, lane); } SEAM(5);
    if (IN(6)) { pg8::Gemm g{H, (const bf16_t*)(ws + WS_WIN1), MT, N_IN1P, 1024}; pg8::In1Order S; S.init(G, bx);
        pg8::EpiIn1<ATT1_F8> E{a.in[21], tabB, KVA, SSKV, QA, SSQ, KR, Gb, (const float*)(ws + WS_RINV), BIAS1};
        pg8::gemm_phase<pg8::EpiIn1<ATT1_F8>, pg8::In1Order, true, true>(ring, g, S, E); } SEAM(6);
    if (IN(7)) {
        { pg8::Gemm g{KVA, (const bf16_t*)(ws + WS_WKVB), MT, 2048, 256}; pg8::ROrder S; S.init(0, MT / 256, 2048, G, bx, REPS(7));
          pg8::EpiKvb<ATT1_F8> E{SSKV, a.in[20], K1, V1};
          pg8::gemm_phase<pg8::EpiKvb<ATT1_F8>, pg8::ROrder, true, true>(ring, g, S, E); }
        { pg8::Gemm g{QA, (const bf16_t*)(ws + WS_WQB), ML, 2048, 384}; pg8::ROrder S; S.init(0, ML / 256, 2048, G, bx, REPS(7));
          pg8::EpiQb E{SSQ, a.in[19], tabB, Qb, Q1R, SSH};
          pg8::gemm_phase<pg8::EpiQb, pg8::ROrder, true, true>(ring, g, S, E); }
    } SEAM(7);
    if (IN(8)) for (int rep_ = 0; rep_ < REPS(8); ++rep_) {
        const int xg = vcu >> 5, c = vcu & 31;
        for (int i = 0; i < 4; ++i) { const int s = xg + 8 * i, b = s >> 4, h = s & 15; const size_t row0 = (size_t)b * SEQ + c * 256, q0 = row0 * DM + h * 64;
#if ATT1_F8
            af8::attn_unit<1>(Qb + q0, DM, Q1R + row0 * 512 + h * 32, SSH + (row0 * 16 + h) * 2, (const unsigned char*)K1 + (size_t)b * TK * 512 + h * 32, 512, (const unsigned char*)KR + (size_t)b * TK * 16,
                              (const unsigned char*)V1 + (size_t)b * TK * DM + h * 64, DM, TK / 64, O1 + q0, Gb + q0, DM, (char*)lds UPROBE_ARG8); }
#else
            afast::attn_unit<1>(Qb + q0, DM, Q1R + row0 * 512 + h * 32, SSH + (row0 * 16 + h) * 2, K1 + (size_t)b * TK * DM + h * 64, DM, KR + (size_t)b * TK * 32,
                                V1 + (size_t)b * TK * DM + h * 64, DM, TK / 64, O1 + q0, Gb + q0, DM, (char*)lds); }
#endif
    } SEAM(8);
    if (IN(9)) { pg8::Gemm g{O1, (const bf16_t*)(ws + WS_WOUT1), ML, 1024, 1024}; pg8::ROrder S; S.init(0, ML / 256, 1024, G, bx);
        pg8::EpiOut E{out, nullptr, out, nullptr, mod + 3 * 3072 + 2048};
        pg8::gemm_phase<pg8::EpiOut, pg8::ROrder, true, true>(ring, g, S, E); }
#ifdef MK_TS_SEAM
    if (bx == 0 && wave == 0) { const unsigned long long tend_ = __builtin_amdgcn_s_memrealtime(); const unsigned long long w = MK_TS == 99 ? (tend_ - ts0) : MK_TS >= 100 ? (MK_TS >= 200 ? (unsigned long long)(((unsigned*)ws)[4001] & 1023u) * 100ull : (unsigned long long)((unsigned*)ws)[4000]) : (MK_TS_WHAT ? (ts2 - ts1) * 10ull : (ts1 - ts0)); const unsigned long long t0 = __builtin_amdgcn_s_memrealtime(); while (__builtin_amdgcn_s_memrealtime() - t0 < w) __builtin_amdgcn_s_sleep(8); }
#endif
#ifdef MK_UBENCH
    ubench(wave);
#endif
#ifdef MK_UNIT_PROBE
    if (bx == 0 && wave == 0) { const unsigned long long t0 = __builtin_amdgcn_s_memrealtime(); const unsigned long long w = upacc * 10ull; (void)updummy; while (__builtin_amdgcn_s_memrealtime() - t0 < w) __builtin_amdgcn_s_sleep(8); }
#endif
#ifdef MK_CLOCK_PROBE
    if (bx == 0 && wave == 0) { const unsigned long long dc = pc1 - pc0, dr = pr1 - pr0;
        const unsigned long long mhz = dr ? (dc * 100ull) / dr : 0ull;
        const unsigned long long t0 = __builtin_amdgcn_s_memrealtime(); const unsigned long long wait_ticks = mhz * 10ull;
        while (__builtin_amdgcn_s_memrealtime() - t0 < wait_ticks) __builtin_amdgcn_s_sleep(8); }
#endif
#undef IN
#undef SEAM
}

constexpr int NPHASE = 10;
#ifndef MK_ONE_LAUNCH
#define MK_ONE_LAUNCH 1
#endif
extern "C" void kernel_launch(void* const* d_in, const int* in_sizes, int n_in, void* d_out, int out_size, void* d_ws, size_t ws_size, hipStream_t stream) {
    static int grid = 0;
    if (grid == 0) {
        if (n_in != 23 || out_size != ML * DM || ws_size < WS_END) { fprintf(stderr, "kernel_launch: unexpected shapes n_in %d out %d ws %zu\n", n_in, out_size, ws_size); grid = -1; return; }
        int dev = 0, cus = 0, per_cu = 0;
        if (hipGetDevice(&dev) != hipSuccess || hipDeviceGetAttribute(&cus, hipDeviceAttributeMultiprocessorCount, dev) != hipSuccess) { grid = -1; return; }
        if (hipFuncSetAttribute((const void*)mega, hipFuncAttributeMaxDynamicSharedMemorySize, LDS_BYTES) != hipSuccess) { fprintf(stderr, "kernel_launch: hipFuncSetAttribute failed\n"); grid = -1; return; }
        if (hipOccupancyMaxActiveBlocksPerMultiprocessor(&per_cu, (const void*)mega, NTHREADS, LDS_BYTES) != hipSuccess || per_cu < 1) { fprintf(stderr, "kernel_launch: occupancy query says %d\n", per_cu); grid = -1; return; }
        grid = cus;
        if (grid != 256) fprintf(stderr, "kernel_launch: %d CUs (built for 256)\n", grid);
    }
    if (grid < 0) return;
    if (hipMemsetAsync(d_ws, 0, 16384, stream) != hipSuccess) { fprintf(stderr, "kernel_launch: memset failed\n"); return; }
    Args a{};
    for (int i = 0; i < 23; ++i) a.in[i] = (const float*)d_in[i];
    a.out = (float*)d_out; a.ws = (unsigned char*)d_ws;
#if MK_ONE_LAUNCH
    a.ph_lo = 0; a.ph_hi = NPHASE; a.coop = 1;
    void* args[] = {&a};
#ifdef MK_PLAIN_LAUNCH
    (void)args; hipLaunchKernelGGL(mega, dim3(grid), dim3(NTHREADS), LDS_BYTES, stream, a);
#else
    const hipError_t e = hipLaunchCooperativeKernel((const void*)mega, dim3(grid), dim3(NTHREADS), args, LDS_BYTES, stream);
    if (e != hipSuccess) fprintf(stderr, "kernel_launch: cooperative launch failed: %s (grid %d)\n", hipGetErrorString(e), grid);
#endif
#else
    for (int p = 0; p < NPHASE; ++p) { a.ph_lo = p; a.ph_hi = p + 1; a.coop = 0; hipLaunchKernelGGL(mega, dim3(grid), dim3(NTHREADS), LDS_BYTES, stream, a); }
    const hipError_t le = hipPeekAtLastError();
    if (le != hipSuccess) fprintf(stderr, "kernel_launch: launch failed: %s\n", hipGetErrorName(le));
#endif
}
```

```cpp
#include <hip/hip_runtime.h>
#include <hip/hip_bf16.h>
#include <cstdio>
#include <cstdint>

#define DEVI __device__ __forceinline__
#define LAS __attribute__((address_space(3)))
#define GAS __attribute__((address_space(1)))

constexpr int NB = 2, SEQ = 8192, DM = 1024, CTXL = 256, TK = SEQ + CTXL;
constexpr int ML = NB * SEQ, MC = NB * CTXL, MT = ML + MC;
constexpr int GRIDW = 64;
constexpr float EPS = 1e-6f;
constexpr float LOG2E = 1.4426950408889634f;
constexpr int N_IN0 = 2560, N_IN1 = 1696, N_IN1P = 1792;
constexpr float C2_GQA = 0.125f * LOG2E;
constexpr float C2_MLA = 0.10206207261596575f * LOG2E;

typedef unsigned short bf16_t;
typedef short bf16x8 __attribute__((ext_vector_type(8)));
typedef short s16x4 __attribute__((ext_vector_type(4)));
typedef float f32x4 __attribute__((ext_vector_type(4)));
typedef float f32x2 __attribute__((ext_vector_type(2)));
typedef float f32x16 __attribute__((ext_vector_type(16)));
typedef unsigned u32x4 __attribute__((ext_vector_type(4)));
typedef unsigned u32x2 __attribute__((ext_vector_type(2)));

DEVI float bf2f(bf16_t v) { return __uint_as_float((unsigned)v << 16); }
DEVI unsigned f2bf(float f) { unsigned u = __float_as_uint(f); return (u + 0x7fffu + ((u >> 16) & 1u)) >> 16; }
DEVI unsigned pk2(float lo, float hi) { return f2bf(lo) | (f2bf(hi) << 16); }
DEVI float wave_sum(float v) {
#pragma unroll
    for (int o = 1; o < 64; o <<= 1) v += __shfl_xor(v, o);
    return v;
}
DEVI float silu_f(float v) { return v / (1.f + __expf(-v)); }
namespace pg8 {
#define PG8_LAS __attribute__((address_space(3)))
typedef unsigned short bf16_t;
typedef short bf16x8 __attribute__((ext_vector_type(8)));
typedef float f32x4 __attribute__((ext_vector_type(4)));
typedef unsigned u32x4 __attribute__((ext_vector_type(4)));
constexpr int BM = 256, BK = 64, HALF = 128, HTB = HALF * BK * 2  , STAGE_BYTES = 8 * HTB, NXCD = 8, WGM = 8;

__host__ __device__ __forceinline__ int lds_byte(int r, int c) { const int st = (r >> 4) * 2 + (c >> 5), rr = r & 15, cc = c & 31, ob = rr * 64 + cc * 2; return st * 1024 + (ob ^ (((ob >> 9) & 1) << 5)); }
__host__ __device__ __forceinline__ void stage_rc(int b, int& R, int& C) { const int st = b / 1024, sb = b % 1024, swz = sb ^ (((sb >> 9) & 1) << 5); R = (st >> 1) * 16 + swz / 64; C = (st & 1) * 32 + (swz % 64) / 2; }
__host__ __device__ __forceinline__ int perm32(int rho) { const int n = rho >> 4, i = rho & 15; return 8 * (i >> 2) + 4 * n + (i & 3); }

struct Unit { int pm, pn, ko; };
struct Gemm { const bf16_t* A; const bf16_t* Bt; int M, N, K, Kloop; };

struct StaticOrder {
    int nM, nN, nwg, G, c;
    __host__ __device__ void init(int M, int N, int G_, int c_) { nM = M / BM; nN = N / BM; nwg = nM * nN; G = G_; c = c_; }
    __host__ __device__ bool next(int i, Unit& u) const {
        const long L = (long)i * G + c; if (L >= nwg) return false;
        int wgid = (int)L; { const int q = nwg / NXCD, r = nwg % NXCD, xcd = wgid % NXCD, off = wgid / NXCD; wgid = (xcd < r ? xcd * (q + 1) : r * (q + 1) + (xcd - r) * q) + off; }
        const int nig = WGM * nN, gid = wgid / nig, fm = gid * WGM, gsz = (nM - fm) < WGM ? (nM - fm) : WGM;
        u.pm = fm + ((wgid % nig) % gsz); u.pn = (wgid % nig) / gsz; u.ko = 0; return true;
    }
    __device__ __forceinline__ void a_ready(const Unit&) const {}
    __device__ __forceinline__ void done(const Unit&) const {}
};


struct ROrder {
    int pm0, nM, nN, nwg, G, c, rep;
    __host__ __device__ void init(int pm0_, int npm, int N, int G_, int c_, int rep_ = 1) { pm0 = pm0_; nM = npm; nN = N / BM; nwg = nM * nN; G = G_; c = c_; rep = rep_; }
    __host__ __device__ bool next(int i, Unit& u) const {
        const long L = (long)i * G + c; if (L >= (long)nwg * rep) return false;
        int wgid = (int)(L % nwg); { const int q = nwg / NXCD, r = nwg % NXCD, xcd = wgid % NXCD, off = wgid / NXCD; wgid = (xcd < r ? xcd * (q + 1) : r * (q + 1) + (xcd - r) * q) + off; }
        const int nig = WGM * nN, gid = wgid / nig, fm = gid * WGM, gsz = (nM - fm) < WGM ? (nM - fm) : WGM;
        u.pm = pm0 + fm + ((wgid % nig) % gsz); u.pn = (wgid % nig) / gsz; u.ko = 0; return true;
    }
    __device__ __forceinline__ void a_ready(const Unit&) const {}
    __device__ __forceinline__ void done(const Unit&) const {}
};

struct EpiF32 {
    static constexpr bool PERM = true, AFTER_DRAIN = false;
    float* O; int ldc; int pmbase;
    __device__ __forceinline__ void operator()(const f32x4 (&acc)[2][2][4][2], const Unit& u, int wr, int wc, int fr, int fq) const {
        const int row0 = (u.pm - pmbase) * BM + wr * 64 + fr, col0 = u.pn * BM + wc * 32 + 8 * fq;
#pragma unroll
        for (int ai = 0; ai < 2; ++ai)
#pragma unroll
            for (int m = 0; m < 4; ++m) { float* rowp = O + (size_t)(row0 + ai * HALF + m * 16) * ldc + col0;
#pragma unroll
                for (int bj = 0; bj < 2; ++bj) { *(f32x4*)(rowp + bj * HALF) = acc[ai][bj][m][0]; *(f32x4*)(rowp + bj * HALF + 4) = acc[ai][bj][m][1]; } }
    }
};

DEVI unsigned cvt_pk_bf16(float lo, float hi) { unsigned r; asm volatile("v_cvt_pk_bf16_f32 %0, %1, %2" : "=v"(r) : "v"(lo), "v"(hi)); return r; }
DEVI u32x4 pack8(const f32x4 a, const f32x4 b) { u32x4 w; w.x = cvt_pk_bf16(a[0], a[1]); w.y = cvt_pk_bf16(a[2], a[3]); w.z = cvt_pk_bf16(b[0], b[1]); w.w = cvt_pk_bf16(b[2], b[3]); return w; }
DEVI u32x2 pack8_fp8(const f32x4 a, const f32x4 b) { int w0 = 0, w1 = 0; w0 = __builtin_amdgcn_cvt_pk_fp8_f32(a[0], a[1], w0, false); w0 = __builtin_amdgcn_cvt_pk_fp8_f32(a[2], a[3], w0, true);
    w1 = __builtin_amdgcn_cvt_pk_fp8_f32(b[0], b[1], w1, false); w1 = __builtin_amdgcn_cvt_pk_fp8_f32(b[2], b[3], w1, true); return (u32x2){(unsigned)w0, (unsigned)w1}; }
DEVI unsigned pack8_fp4(const f32x4 a, const f32x4 b) { unsigned w; asm volatile("" : "=v"(w)); w = __builtin_amdgcn_cvt_scalef32_pk_fp4_f32(w, a[0], a[1], 1.0f, 0); w = __builtin_amdgcn_cvt_scalef32_pk_fp4_f32(w, a[2], a[3], 1.0f, 1);
    w = __builtin_amdgcn_cvt_scalef32_pk_fp4_f32(w, b[0], b[1], 1.0f, 2); w = __builtin_amdgcn_cvt_scalef32_pk_fp4_f32(w, b[2], b[3], 1.0f, 3); return w; }
DEVI float quad_sum(float s) { s += __shfl_xor(s, 16); s += __shfl_xor(s, 32); return s; }
DEVI float sq4(const f32x4 v) { return (v[0] * v[0] + v[1] * v[1]) + (v[2] * v[2] + v[3] * v[3]); }
DEVI f32x4 silu4(const f32x4 v) { f32x4 o; o[0] = silu_f(v[0]); o[1] = silu_f(v[1]); o[2] = silu_f(v[2]); o[3] = silu_f(v[3]); return o; }
DEVI int key_slot(int R) { return R < ML ? (R >> 13) * TK + CTXL + (R & (SEQ - 1)) : ((R - ML) >> 8) * TK + ((R - ML) & 255); }
DEVI void rot4(f32x4& x1, f32x4& x2, const f32x4 cs01, const f32x4 cs23) {
    const f32x4 c = {cs01[0], cs01[2], cs23[0], cs23[2]}, s = {cs01[1], cs01[3], cs23[1], cs23[3]};
    const f32x4 a = x1 * c - x2 * s, b = x2 * c + x1 * s; x1 = a; x2 = b;
}

DEVI int drope32(int i) { const int fq = i >> 3, n = (i >> 2) & 1, j = i & 3; return 16 * (fq >> 1) + 8 * n + 4 * (fq & 1) + j; }
DEVI int wmap(int mode, int p) {
    const int pn = p >> 8, q = p & 255, bj = q >> 7, wc = (q >> 5) & 3, i = q & 31;
    switch (mode) {
    case 1: {
        if (pn == 0 || (pn >= 2 && pn <= 5)) { const int fq = i >> 3, n = (i >> 2) & 1, j = i & 3; return 256 * pn + 64 * wc + 32 * bj + 16 * n + 4 * fq + j; }
        return p; }
    case 2: {
        if (pn == 0) return q;
        if (pn == 1) return 288 + q;
        if (pn == 2) { if (wc < 2) return 288 + 256 + 64 * wc + 32 * bj + i; if (wc == 2 && bj == 0) return 256 + drope32(i); return -1; }
        return 672 + 256 * (pn - 3) + q; }
    case 3: { const int head = 2 * pn + (wc >> 1), type = wc & 1; return 128 * head + 64 * type + 32 * bj + i; }
    case 4: { const int head = 2 * pn + (wc >> 1), type = wc & 1; if (type == 0) return 96 * head + 32 * bj + i; return bj == 0 ? 96 * head + 64 + drope32(i) : -1; }
    default: return p;
    }
}

template <bool F8> struct EpiIn0 {
    static constexpr bool PERM = true, AFTER_DRAIN = false;
    const float* qn; const float* kn; const f32x4* tabA; bf16_t* K0; bf16_t* V0; bf16_t* Q0; bf16_t* G0;
    __device__ __forceinline__ void operator()(const f32x4 (&acc)[2][2][4][2], const Unit& u, int wr, int wc, int fr_, int fq_) const {
        int fr = fr_, fq = fq_; asm volatile("" : "+v"(fr), "+v"(fq));
        const int pn = u.pn; const bool lat = u.pm < ML / BM;
        if (pn == 0 || (pn >= 2 && pn <= 5)) {
            const float* wsrc = pn == 0 ? kn : qn; const float outs = pn == 0 ? (F8 ? 2.f : 1.f) : (F8 ? C2_GQA * 8.f : C2_GQA);
            f32x4 wv[2][2];
#pragma unroll
            for (int bj = 0; bj < 2; ++bj)
#pragma unroll
                for (int n = 0; n < 2; ++n) wv[bj][n] = *(const f32x4*)(wsrc + 32 * bj + 16 * n + 4 * fq) * outs;
#pragma unroll
            for (int ai = 0; ai < 2; ++ai)
#pragma unroll
                for (int m = 0; m < 4; ++m) {
                    const int R = u.pm * BM + ai * HALF + wr * 64 + m * 16 + fr;
                    f32x4 x[2][2]; float ss = 0.f;
#pragma unroll
                    for (int bj = 0; bj < 2; ++bj)
#pragma unroll
                        for (int n = 0; n < 2; ++n) { x[bj][n] = acc[ai][bj][m][n]; ss += sq4(x[bj][n]); }
                    const float rinv = rsqrtf(quad_sum(ss) * (1.f / 64.f) + EPS);
#pragma unroll
                    for (int bj = 0; bj < 2; ++bj)
#pragma unroll
                        for (int n = 0; n < 2; ++n) x[bj][n] = x[bj][n] * rinv * wv[bj][n];
                    if (lat) { const int t = R & (SEQ - 1), trow = t >> 6, tcol = t & 63;
                        const f32x4* tr = tabA + (trow * 16 + 4 * fq) / 2; const f32x4* tc = tabA + (tcol * 16 + 4 * fq) / 2;
                        rot4(x[0][0], x[0][1], tr[0], tr[1]); rot4(x[1][0], x[1][1], tc[0], tc[1]); }
                    if (F8 && pn == 0) { unsigned char* dst = (unsigned char*)K0 + (size_t)key_slot(R) * 128 + wc * 32 + 4 * fq;
                        *(unsigned*)dst = pack8_fp4(x[0][0], x[0][1]); *(unsigned*)(dst + 16) = pack8_fp4(x[1][0], x[1][1]); }
                    else if (pn == 0) { bf16_t* dst = K0 + (size_t)key_slot(R) * 256 + wc * 64 + 8 * fq;
                        *(u32x4*)dst = pack8(x[0][0], x[0][1]); *(u32x4*)(dst + 32) = pack8(x[1][0], x[1][1]); }
                    else { bf16_t* dst = Q0 + (size_t)R * DM + ((pn - 2) * 4 + wc) * 64 + 8 * fq;
                        *(u32x4*)dst = pack8(x[0][0], x[0][1]); *(u32x4*)(dst + 32) = pack8(x[1][0], x[1][1]); }
                }
        } else if (pn == 1) {
#pragma unroll
            for (int ai = 0; ai < 2; ++ai)
#pragma unroll
                for (int m = 0; m < 4; ++m) { const int R = u.pm * BM + ai * HALF + wr * 64 + m * 16 + fr;
                    if (F8) { unsigned char* dst = (unsigned char*)V0 + (size_t)key_slot(R) * 256 + wc * 32 + 8 * fq;
#pragma unroll
                        for (int bj = 0; bj < 2; ++bj) *(u32x2*)(dst + bj * HALF) = pack8_fp8(acc[ai][bj][m][0], acc[ai][bj][m][1]); }
                    else { bf16_t* dst = V0 + (size_t)key_slot(R) * 256 + wc * 32 + 8 * fq;
#pragma unroll
                        for (int bj = 0; bj < 2; ++bj) *(u32x4*)(dst + bj * HALF) = pack8(acc[ai][bj][m][0], acc[ai][bj][m][1]); } }
        } else {
#pragma unroll
            for (int ai = 0; ai < 2; ++ai)
#pragma unroll
                for (int m = 0; m < 4; ++m) { const int R = u.pm * BM + ai * HALF + wr * 64 + m * 16 + fr; bf16_t* dst = G0 + (size_t)R * DM + (pn - 6) * BM + wc * 32 + 8 * fq;
#pragma unroll
                    for (int bj = 0; bj < 2; ++bj) *(u32x4*)(dst + bj * HALF) = pack8(silu4(acc[ai][bj][m][0]), silu4(acc[ai][bj][m][1])); }
        }
    }
};

struct EpiOut {
    static constexpr bool PERM = true, AFTER_DRAIN = false;
    const float* baseL; const float* baseC; float* dstL; float* dstC; const float* gate;
    __device__ __forceinline__ void operator()(const f32x4 (&acc)[2][2][4][2], const Unit& u, int wr, int wc, int fr_, int fq_) const {
        int fr = fr_, fq = fq_; asm volatile("" : "+v"(fr), "+v"(fq));
        const int col0 = u.pn * BM + wc * 32 + 8 * fq;
#pragma unroll
        for (int ai = 0; ai < 2; ++ai)
#pragma unroll
            for (int m = 0; m < 4; ++m) { const int R = u.pm * BM + ai * HALF + wr * 64 + m * 16 + fr; const int r = R < SEQ ? 0 : (R < ML ? 1 : 2);
                const float* b = R < ML ? baseL + (size_t)R * DM : baseC + (size_t)(R - ML) * DM; float* d = R < ML ? dstL + (size_t)R * DM : dstC + (size_t)(R - ML) * DM;
                const float* g = gate + (size_t)r * 3072;
#pragma unroll
                for (int bj = 0; bj < 2; ++bj)
#pragma unroll
                    for (int n = 0; n < 2; ++n) { const int c = col0 + bj * HALF + 4 * n; *(f32x4*)(d + c) = *(const f32x4*)(b + c) + *(const f32x4*)(g + c) * acc[ai][bj][m][n]; } }
    }
};

struct EpiOutF {
    static constexpr bool PERM = true, AFTER_DRAIN = false;
    const float* base; float* dst; const float* gate; const float* nwm; bf16_t* Hn; float* SSX;
    __device__ __forceinline__ void operator()(const f32x4 (&acc)[2][2][4][2], const Unit& u, int wr, int wc, int fr_, int fq_) const {
        int fr = fr_, fq = fq_; asm volatile("" : "+v"(fr), "+v"(fq));
        const int col0 = u.pn * BM + wc * 32 + 8 * fq;
#pragma unroll
        for (int ai = 0; ai < 2; ++ai)
#pragma unroll
            for (int m = 0; m < 4; ++m) { const int R = u.pm * BM + ai * HALF + wr * 64 + m * 16 + fr; const int r = R < SEQ ? 0 : 1;
                asm volatile("" ::: "memory");
                const float* b = base + (size_t)R * DM; float* d = dst + (size_t)R * DM; const float* g = gate + (size_t)r * 3072; const float* nw = nwm + (size_t)r * 1024; float ss = 0.f;
#pragma unroll
                for (int bj = 0; bj < 2; ++bj) { const int c = col0 + bj * HALF;
                    const f32x4 x0 = *(const f32x4*)(b + c) + *(const f32x4*)(g + c) * acc[ai][bj][m][0], x1 = *(const f32x4*)(b + c + 4) + *(const f32x4*)(g + c + 4) * acc[ai][bj][m][1];
                    *(f32x4*)(d + c) = x0; *(f32x4*)(d + c + 4) = x1; ss += sq4(x0) + sq4(x1);
                    *(u32x4*)(Hn + (size_t)R * DM + c) = pack8(x0 * *(const f32x4*)(nw + c), x1 * *(const f32x4*)(nw + c + 4)); }
                ss = quad_sum(ss); if (fq == 0) SSX[(size_t)R * 16 + u.pn * 4 + wc] = ss; }
    }
};
struct EpiOutSlab {
    static constexpr bool PERM = true, AFTER_DRAIN = false;
    float* slab; int klen;
    __device__ __forceinline__ void operator()(const f32x4 (&acc)[2][2][4][2], const Unit& u, int wr, int wc, int fr_, int fq_) const {
        int fr = fr_, fq = fq_; asm volatile("" : "+v"(fr), "+v"(fq));
        const int col0 = u.pn * BM + wc * 32 + 8 * fq; float* sb = slab + (size_t)(u.ko / klen) * MC * DM;
#pragma unroll
        for (int ai = 0; ai < 2; ++ai)
#pragma unroll
            for (int m = 0; m < 4; ++m) { const int R = u.pm * BM + ai * HALF + wr * 64 + m * 16 + fr; float* d = sb + (size_t)(R - ML) * DM + col0;
#pragma unroll
                for (int bj = 0; bj < 2; ++bj) { *(f32x4*)(d + bj * HALF) = acc[ai][bj][m][0]; *(f32x4*)(d + bj * HALF + 4) = acc[ai][bj][m][1]; } }
    }
};
struct CtxSplitOrder {
    int c, KS, klen;
    __host__ __device__ void init(int c_, int KS_, int klen_) { c = c_; KS = KS_; klen = klen_; }
    __host__ __device__ bool next(int i, Unit& u) const { if (i > 0 || c >= 8 * KS) return false; const int t = c / KS; u.pm = ML / BM + (t >> 2); u.pn = t & 3; u.ko = (c % KS) * klen; return true; }
    __device__ __forceinline__ void a_ready(const Unit&) const {}
    __device__ __forceinline__ void done(const Unit&) const {}
};

template <bool F8> struct EpiIn1 {
    static constexpr bool PERM = true, AFTER_DRAIN = false;
    const float* krn; const f32x4* tabB; bf16_t* KVA; float* SSKV; bf16_t* QA; float* SSQ; bf16_t* KR; bf16_t* G1; const float* SSX; const float* bias;
    __device__ __forceinline__ void xrow(const f32x4 (&acc)[2][2][4][2], int ai, int m, int R, int pcol0, f32x4 (&x)[2][2]) const {
        const float rinv = SSX[R];
        const float* bp = bias + (size_t)(R < SEQ ? 0 : (R < ML ? 1 : 2)) * N_IN1P + pcol0;
#pragma unroll
        for (int bj = 0; bj < 2; ++bj)
#pragma unroll
            for (int n = 0; n < 2; ++n) x[bj][n] = acc[ai][bj][m][n] * rinv + *(const f32x4*)(bp + bj * HALF + 4 * n);
    }
    __device__ __forceinline__ void operator()(const f32x4 (&acc)[2][2][4][2], const Unit& u, int wr, int wc, int fr_, int fq_) const {
        int fr = fr_, fq = fq_; asm volatile("" : "+v"(fr), "+v"(fq));
        const int pn = u.pn; const bool lat = u.pm < ML / BM; const int pcol0 = pn * BM + wc * 32 + 8 * fq;
        if (pn >= 3) {
#pragma unroll
            for (int ai = 0; ai < 2; ++ai)
#pragma unroll
                for (int m = 0; m < 4; ++m) { const int R = u.pm * BM + ai * HALF + wr * 64 + m * 16 + fr; bf16_t* dst = G1 + (size_t)R * DM + (pn - 3) * BM + wc * 32 + 8 * fq;
                    asm volatile("" ::: "memory"); f32x4 x[2][2]; xrow(acc, ai, m, R, pcol0, x);
#pragma unroll
                    for (int bj = 0; bj < 2; ++bj) *(u32x4*)(dst + bj * HALF) = pack8(silu4(x[bj][0]), silu4(x[bj][1])); }
        } else if (pn == 2 && wc == 2) {
            f32x4 wv[2];
#pragma unroll
            for (int n = 0; n < 2; ++n) wv[n] = *(const f32x4*)(krn + 16 * (fq >> 1) + 8 * n + 4 * (fq & 1));
#pragma unroll
            for (int ai = 0; ai < 2; ++ai)
#pragma unroll
                for (int m = 0; m < 4; ++m) { const int R = u.pm * BM + ai * HALF + wr * 64 + m * 16 + fr;
                    asm volatile("" ::: "memory"); f32x4 xx[2][2]; xrow(acc, ai, m, R, pcol0, xx); f32x4 x0 = xx[0][0], x1 = xx[0][1];
                    const float rinv = rsqrtf(quad_sum(sq4(x0) + sq4(x1)) * (1.f / 32.f) + EPS);
                    x0 = x0 * rinv * wv[0]; x1 = x1 * rinv * wv[1];
                    if (lat) { const int t = R & (SEQ - 1); const int pos = (fq >> 1) ? (t & 63) : (t >> 6); const f32x4* tp = tabB + (pos * 8 + 4 * (fq & 1)) / 2; rot4(x0, x1, tp[0], tp[1]); }
                    if (F8) *(unsigned*)((unsigned char*)KR + (size_t)key_slot(R) * 16 + 4 * fq) = pack8_fp4(x0 * 2.f, x1 * 2.f); else *(u32x4*)(KR + (size_t)key_slot(R) * 32 + 8 * fq) = pack8(x0, x1); }
        } else if (pn == 2 && wc == 3) {
        } else if (pn == 0 || lat) {
            bf16_t* base; float* ssb; int ld, cbase, nss, iss;
            if (pn == 0) { base = KVA; ld = 256; cbase = wc * 32; ssb = SSKV; nss = 4; iss = wc; }
            else if (pn == 1) { base = QA; ld = 384; cbase = wc * 32; ssb = SSQ; nss = 6; iss = wc; }
            else { base = QA; ld = 384; cbase = 256 + wc * 64; ssb = SSQ; nss = 6; iss = 4 + wc; }
            const int bjs = pn == 2 ? 32 : HALF;
#pragma unroll
            for (int ai = 0; ai < 2; ++ai)
#pragma unroll
                for (int m = 0; m < 4; ++m) { const int R = u.pm * BM + ai * HALF + wr * 64 + m * 16 + fr; bf16_t* dst = base + (size_t)R * ld + cbase + 8 * fq; float ss = 0.f;
                    asm volatile("" ::: "memory"); f32x4 x[2][2]; xrow(acc, ai, m, R, pcol0, x);
#pragma unroll
                    for (int bj = 0; bj < 2; ++bj) { ss += sq4(x[bj][0]) + sq4(x[bj][1]); *(u32x4*)(dst + bj * bjs) = pack8(x[bj][0], x[bj][1]); }
                    ss = quad_sum(ss); if (fq == 0) ssb[(size_t)R * nss + iss] = ss; }
        }
    }
};

template <bool F8> struct EpiKvb {
    static constexpr bool PERM = true, AFTER_DRAIN = false;
    const float* SSKV; const float* knn; bf16_t* K1; bf16_t* V1;
    __device__ __forceinline__ void operator()(const f32x4 (&acc)[2][2][4][2], const Unit& u, int wr, int wc, int fr_, int fq_) const {
        int fr = fr_, fq = fq_; asm volatile("" : "+v"(fr), "+v"(fq));
        const int head = 2 * u.pn + (wc >> 1), type = wc & 1;
#pragma unroll
        for (int ai = 0; ai < 2; ++ai)
#pragma unroll
            for (int m = 0; m < 4; ++m) { const int R = u.pm * BM + ai * HALF + wr * 64 + m * 16 + fr;
                asm volatile("" ::: "memory");
                const f32x4 s4 = *(const f32x4*)(SSKV + (size_t)R * 4); const float rkv = rsqrtf(((s4[0] + s4[1]) + (s4[2] + s4[3])) * (1.f / 256.f) + EPS);
                f32x4 x[2][2]; float ss = 0.f;
#pragma unroll
                for (int bj = 0; bj < 2; ++bj)
#pragma unroll
                    for (int n = 0; n < 2; ++n) { x[bj][n] = acc[ai][bj][m][n] * rkv; ss += sq4(x[bj][n]); }
                if (type == 0) { const float rinv = rsqrtf(quad_sum(ss) * (1.f / 64.f) + EPS);
#pragma unroll
                    for (int bj = 0; bj < 2; ++bj)
#pragma unroll
                        for (int n = 0; n < 2; ++n) x[bj][n] = x[bj][n] * rinv * *(const f32x4*)(knn + 32 * bj + 8 * fq + 4 * n); }
                const size_t eo = (size_t)key_slot(R) * DM + head * 64 + 8 * fq;
                if (F8) { if (type == 0) { unsigned char* dst = (unsigned char*)K1 + (size_t)key_slot(R) * 512 + head * 32 + 4 * fq; *(unsigned*)dst = pack8_fp4(x[0][0] * 2.f, x[0][1] * 2.f); *(unsigned*)(dst + 16) = pack8_fp4(x[1][0] * 2.f, x[1][1] * 2.f); }
                          else { unsigned char* dst = (unsigned char*)V1 + eo; *(u32x2*)dst = pack8_fp8(x[0][0], x[0][1]); *(u32x2*)(dst + 32) = pack8_fp8(x[1][0], x[1][1]); } }
                else { bf16_t* dst = (type == 0 ? K1 : V1) + eo; *(u32x4*)dst = pack8(x[0][0], x[0][1]); *(u32x4*)(dst + 32) = pack8(x[1][0], x[1][1]); } }
    }
};

struct EpiQb {
    static constexpr bool PERM = true, AFTER_DRAIN = false;
    const float* SSQ; const float* qnw; const f32x4* tabB; bf16_t* Q1N; bf16_t* Q1R; float* SSH;
    __device__ __forceinline__ float rqa_of(int R) const { const float* sp = SSQ + (size_t)R * 6; const f32x2 sa = *(const f32x2*)sp, sb = *(const f32x2*)(sp + 2), sc = *(const f32x2*)(sp + 4);
        return rsqrtf(((sa[0] + sa[1]) + (sb[0] + sb[1]) + (sc[0] + sc[1])) * (1.f / 384.f) + EPS); }
    __device__ __forceinline__ void operator()(const f32x4 (&acc)[2][2][4][2], const Unit& u, int wr, int wc, int fr_, int fq_) const {
        int fr = fr_, fq = fq_; asm volatile("" : "+v"(fr), "+v"(fq));
        const int head = 2 * u.pn + (wc >> 1);
        if ((wc & 1) == 0) {
#pragma unroll
            for (int ai = 0; ai < 2; ++ai)
#pragma unroll
                for (int m = 0; m < 4; ++m) { const int R = u.pm * BM + ai * HALF + wr * 64 + m * 16 + fr;
                    asm volatile("" ::: "memory");
                    const float rqa = rqa_of(R); float ss = 0.f; bf16_t* dst = Q1N + (size_t)R * DM + head * 64 + 8 * fq;
#pragma unroll
                    for (int bj = 0; bj < 2; ++bj) { f32x4 x0 = acc[ai][bj][m][0] * rqa, x1 = acc[ai][bj][m][1] * rqa; ss += sq4(x0) + sq4(x1);
                        x0 = x0 * *(const f32x4*)(qnw + 32 * bj + 8 * fq); x1 = x1 * *(const f32x4*)(qnw + 32 * bj + 8 * fq + 4); *(u32x4*)(dst + 32 * bj) = pack8(x0, x1); }
                    ss = quad_sum(ss); if (fq == 0) SSH[((size_t)R * 16 + head) * 2] = ss; }
        } else {
#pragma unroll
            for (int ai = 0; ai < 2; ++ai)
#pragma unroll
                for (int m = 0; m < 4; ++m) { const int R = u.pm * BM + ai * HALF + wr * 64 + m * 16 + fr;
                    asm volatile("" ::: "memory");
                    const float rqa = rqa_of(R);
                    f32x4 x0 = acc[ai][0][m][0] * rqa, x1 = acc[ai][0][m][1] * rqa; const float ss = quad_sum(sq4(x0) + sq4(x1)); if (fq == 0) SSH[((size_t)R * 16 + head) * 2 + 1] = ss;
                    const float* wp = qnw + 64 + 16 * (fq >> 1) + 4 * (fq & 1); x0 = x0 * *(const f32x4*)wp; x1 = x1 * *(const f32x4*)(wp + 8);
                    const int t = R & (SEQ - 1); const int pos = (fq >> 1) ? (t & 63) : (t >> 6); const f32x4* tp = tabB + (pos * 8 + 4 * (fq & 1)) / 2; rot4(x0, x1, tp[0], tp[1]);
                    *(u32x4*)(Q1R + (size_t)R * 512 + head * 32 + 8 * fq) = pack8(x0, x1); }
        }
    }
};

struct In1Order {
    int G, c; ROrder lat;
    __host__ __device__ void init(int G_, int c_) { G = G_; c = c_; lat.init(0, ML / BM, N_IN1P, G_, c_); }
    __host__ __device__ bool next(int i, Unit& u) const {
        const long L = (long)i * G + c; if (L < lat.nwg) return lat.next(i, u);
        const int e = (int)(L - lat.nwg); if (e >= 4) return false; u.pm = ML / BM + (e >> 1); u.pn = (e & 1) * 2; u.ko = 0; return true;
    }
    __device__ __forceinline__ void a_ready(const Unit&) const {}
    __device__ __forceinline__ void done(const Unit&) const {}
};
template <class Epi, class Sched, bool ALIGN_EPI = false, bool SP2 = false>
__device__ __forceinline__ void gemm_phase(PG8_LAS unsigned char* lds, const Gemm g, const Sched& S, const Epi& E) {
    const int tid = threadIdx.x, wid = __builtin_amdgcn_readfirstlane(tid >> 6), lane = tid & 63, wr = wid >> 2, wc = wid & 3, fr = lane & 15, fq = lane >> 4;
    const int K = g.K, nt = (g.Kloop ? g.Kloop : K) / BK;
    unsigned voffA[2], voffB[2];
#pragma unroll
    for (int i = 0; i < 2; ++i) { int R, C; stage_rc(tid * 16 + i * 8192, R, C); const int Rb = Epi::PERM ? ((R & ~31) + perm32(R & 31)) : R;
        voffA[i] = (unsigned)(R * K + C) * 2u; voffB[i] = (unsigned)(Rb * K + C) * 2u; }
    const size_t kstep = (size_t)(BK * 2);
    const size_t hstep = (size_t)HALF * K * 2;
    const size_t tstep = 2 * hstep;
    const unsigned ldsw = (unsigned)wid * 1024u;
    const int aoff = lds_byte(wr * 64 + fr, fq * 8), boff = lds_byte(wc * 32 + fr, fq * 8);
#define PG8_SA(b, h) (((b) * 2 + (h)) * HTB)
#define PG8_SB(b, h) ((4 + (b) * 2 + (h)) * HTB)
#define PG8_STAGE(bufoff, gbase, voff) do { _Pragma("unroll") for (int _i = 0; _i < 2; ++_i) \
        __builtin_amdgcn_global_load_lds((const unsigned*)((const char*)(gbase) + (voff)[_i]), (PG8_LAS unsigned*)(lds + (bufoff) + ldsw + _i * 8192), 16, 0, 0); } while (0)
#define PG8_LDA(dst, b, h) do { _Pragma("unroll") for (int m = 0; m < 4; ++m) _Pragma("unroll") for (int k = 0; k < 2; ++k) dst[m][k] = *(const PG8_LAS bf16x8*)(lds + PG8_SA(b, h) + aoff + m * 2048 + k * 1024); } while (0)
#define PG8_LDB(dst, b, h) do { _Pragma("unroll") for (int n = 0; n < 2; ++n) _Pragma("unroll") for (int k = 0; k < 2; ++k) dst[n][k] = *(const PG8_LAS bf16x8*)(lds + PG8_SB(b, h) + boff + n * 2048 + k * 1024); } while (0)
#define PG8_MMA(ai, bj, At, Bt) do { __builtin_amdgcn_s_setprio(1); _Pragma("unroll") for (int m = 0; m < 4; ++m) _Pragma("unroll") for (int n = 0; n < 2; ++n) _Pragma("unroll") for (int k = 0; k < 2; ++k) \
        acc[ai][bj][m][n] = __builtin_amdgcn_mfma_f32_16x16x32_bf16(Bt[n][k], At[m][k], acc[ai][bj][m][n], 0, 0, 0); __builtin_amdgcn_s_setprio(0); } while (0)
#define PG8_WAIT_V(n) asm volatile("s_waitcnt vmcnt(" #n ")" ::: "memory")
#define PG8_WAIT_L(n) asm volatile("s_waitcnt lgkmcnt(" #n ")" ::: "memory")
#define PG8_BAR __builtin_amdgcn_s_barrier()
#define PG8_SCHED __builtin_amdgcn_sched_barrier(0)
    Unit cur, nxt; int ui = 0;
    if (!S.next(0, cur)) return;
    f32x4 acc[2][2][4][2];
#pragma unroll
    for (int a = 0; a < 2; ++a)
#pragma unroll
        for (int b = 0; b < 2; ++b)
#pragma unroll
            for (int m = 0; m < 4; ++m)
#pragma unroll
                for (int n = 0; n < 2; ++n) acc[a][b][m][n] = (f32x4){0.f, 0.f, 0.f, 0.f};
    bf16x8 At[4][2], B0[2][2], B1[2][2];
    const char* cA = (const char*)g.A + (size_t)cur.pm * tstep + (size_t)cur.ko * 2; const char* cB = (const char*)g.Bt + (size_t)cur.pn * tstep + (size_t)cur.ko * 2;
    S.a_ready(cur);
    if constexpr (SP2) {
        PG8_STAGE(PG8_SB(0, 0), cB, voffB); PG8_STAGE(PG8_SB(0, 1), cB + hstep, voffB); PG8_STAGE(PG8_SA(0, 0), cA, voffA); PG8_STAGE(PG8_SA(0, 1), cA + hstep, voffA);
        if (wr == 1) PG8_BAR;
        PG8_WAIT_V(2); PG8_BAR;
        PG8_STAGE(PG8_SB(1, 0), cB + kstep, voffB); PG8_STAGE(PG8_SA(1, 0), cA + kstep, voffA); PG8_STAGE(PG8_SB(1, 1), cB + hstep + kstep, voffB);
        PG8_WAIT_V(6); PG8_BAR;
    } else {
        PG8_STAGE(PG8_SB(0, 0), cB, voffB); PG8_STAGE(PG8_SA(0, 0), cA, voffA); PG8_STAGE(PG8_SB(0, 1), cB + hstep, voffB); PG8_STAGE(PG8_SA(0, 1), cA + hstep, voffA);
        if (wr == 1) PG8_BAR;
        PG8_WAIT_V(4); PG8_BAR;
        PG8_STAGE(PG8_SB(1, 0), cB + kstep, voffB); PG8_STAGE(PG8_SA(1, 0), cA + kstep, voffA); PG8_STAGE(PG8_SB(1, 1), cB + hstep + kstep, voffB);
        PG8_WAIT_V(6); PG8_BAR;
    }
    for (;;) {
        const bool has_next = S.next(ui + 1, nxt);
        const char* nA = has_next ? (const char*)g.A + (size_t)nxt.pm * tstep + (size_t)nxt.ko * 2 : cA; const char* nB = has_next ? (const char*)g.Bt + (size_t)nxt.pn * tstep + (size_t)nxt.ko * 2 : cB;
        _Pragma("nounroll") for (int t = 0; t < nt; t += 2) {
            const bool last = (t == nt - 2);
            const char* a1 = cA + (size_t)(t + 1) * kstep;
            const char* a2 = last ? nA : cA + (size_t)(t + 2) * kstep; const char* b2 = last ? nB : cB + (size_t)(t + 2) * kstep;
            const char* a3 = a2 + kstep; const char* b3 = b2 + kstep;
            if (last && has_next) S.a_ready(nxt);
            if constexpr (SP2) {
            PG8_LDB(B0, 0, 0); PG8_LDB(B1, 0, 1); PG8_SCHED; PG8_LDA(At, 0, 0); PG8_STAGE(PG8_SA(1, 1), a1 + hstep, voffA);
            PG8_WAIT_V(8); PG8_WAIT_L(0); PG8_BAR; PG8_MMA(0, 0, At, B0); PG8_MMA(0, 1, At, B1); PG8_BAR; PG8_SCHED;
            PG8_LDA(At, 0, 1); PG8_STAGE(PG8_SB(0, 0), b2, voffB); PG8_STAGE(PG8_SB(0, 1), b2 + hstep, voffB); PG8_STAGE(PG8_SA(0, 0), a2, voffA);
            PG8_WAIT_V(8); PG8_WAIT_L(0); PG8_BAR; PG8_MMA(1, 0, At, B0); PG8_MMA(1, 1, At, B1); PG8_BAR; PG8_SCHED;
            PG8_LDB(B0, 1, 0); PG8_LDB(B1, 1, 1); PG8_SCHED; PG8_LDA(At, 1, 0); PG8_STAGE(PG8_SA(0, 1), a2 + hstep, voffA);
            PG8_WAIT_V(8); PG8_WAIT_L(0); PG8_BAR; PG8_MMA(0, 0, At, B0); PG8_MMA(0, 1, At, B1); PG8_BAR; PG8_SCHED;
            PG8_LDA(At, 1, 1); PG8_STAGE(PG8_SB(1, 0), b3, voffB); PG8_STAGE(PG8_SB(1, 1), b3 + hstep, voffB); PG8_STAGE(PG8_SA(1, 0), a3, voffA);
            PG8_WAIT_V(8); PG8_WAIT_L(0); PG8_BAR; PG8_MMA(1, 0, At, B0); PG8_MMA(1, 1, At, B1); PG8_BAR; PG8_SCHED;
            } else {
            PG8_LDB(B0, 0, 0); PG8_SCHED; PG8_LDA(At, 0, 0); PG8_STAGE(PG8_SA(1, 1), a1 + hstep, voffA);
            PG8_WAIT_L(8); PG8_BAR; PG8_WAIT_L(0); PG8_MMA(0, 0, At, B0); PG8_BAR; PG8_SCHED;
            PG8_LDB(B1, 0, 1); PG8_STAGE(PG8_SB(0, 0), b2, voffB);
            PG8_BAR; PG8_WAIT_L(0); PG8_MMA(0, 1, At, B1); PG8_BAR;
            PG8_LDA(At, 0, 1); PG8_STAGE(PG8_SA(0, 0), a2, voffA);
            PG8_BAR; PG8_WAIT_L(0); PG8_MMA(1, 0, At, B0); PG8_BAR; PG8_SCHED;
            PG8_STAGE(PG8_SB(0, 1), b2 + hstep, voffB);
            PG8_WAIT_V(6); PG8_BAR; PG8_MMA(1, 1, At, B1); PG8_BAR;
            PG8_LDB(B0, 1, 0); PG8_SCHED; PG8_LDA(At, 1, 0); PG8_STAGE(PG8_SA(0, 1), a2 + hstep, voffA);
            PG8_WAIT_L(8); PG8_BAR; PG8_WAIT_L(0); PG8_MMA(0, 0, At, B0); PG8_BAR; PG8_SCHED;
            PG8_LDB(B1, 1, 1); PG8_STAGE(PG8_SB(1, 0), b3, voffB);
            PG8_BAR; PG8_WAIT_L(0); PG8_MMA(0, 1, At, B1); PG8_BAR;
            PG8_LDA(At, 1, 1); PG8_STAGE(PG8_SA(1, 0), a3, voffA);
            PG8_BAR; PG8_WAIT_L(0); PG8_MMA(1, 0, At, B0); PG8_BAR; PG8_SCHED;
            PG8_STAGE(PG8_SB(1, 1), b3 + hstep, voffB);
            PG8_WAIT_V(6); PG8_BAR; PG8_MMA(1, 1, At, B1); PG8_BAR;
            }
        }
        if constexpr (ALIGN_EPI) { if (wr == 0) PG8_BAR; }
        if constexpr (!Epi::AFTER_DRAIN) { E(acc, cur, wr, wc, fr, fq); S.done(cur); }
        if (!has_next) break;
#pragma unroll
        for (int a = 0; a < 2; ++a)
#pragma unroll
            for (int b = 0; b < 2; ++b)
#pragma unroll
                for (int m = 0; m < 4; ++m)
#pragma unroll
                    for (int n = 0; n < 2; ++n) acc[a][b][m][n] = (f32x4){0.f, 0.f, 0.f, 0.f};
        cur = nxt; cA = nA; cB = nB; ++ui;
        if constexpr (ALIGN_EPI) { if (wr == 1) PG8_BAR; }
    }
    PG8_WAIT_V(0);
    if constexpr (!ALIGN_EPI) { if (wr == 0) PG8_BAR; }
    PG8_BAR;
    if constexpr (Epi::AFTER_DRAIN) { E.fused(acc, cur, wr, wc, fr, fq, lds, wid, lane); S.done(cur); }
#undef PG8_SA
#undef PG8_SB
#undef PG8_STAGE
#undef PG8_LDA
#undef PG8_LDB
#undef PG8_MMA
#undef PG8_WAIT_V
#undef PG8_WAIT_L
#undef PG8_BAR
#undef PG8_SCHED
}
}

DEVI void sincos_pos(float ang, float& cs, float& sn) {
    const double TWO_PI = 6.283185307179586476925286766559; const double a = (double)ang; const double k = __builtin_rint(a * (1.0 / TWO_PI));
    const float r = (float)(a - k * TWO_PI);
    cs = cosf(r); sn = sinf(r);
}

namespace afast {
#ifndef ATT_PRIO
#define ATT_PRIO 2
#endif
#ifndef ATT_DUP
#define ATT_DUP 0
#endif
constexpr int NW = 8, KVBLK = 64, SLOTK = 12288, SLOTV = 8192, KROFF = 8192;
constexpr int LDS_K = 0, LDS_V = 3 * SLOTK, LDS_WS = LDS_V + 3 * SLOTV, LDS_OST = LDS_WS + NW * 256, LDS_BYTES = LDS_OST + NW * 4096;
#define SBAR() __builtin_amdgcn_sched_barrier(0)
#define PIN(x) asm volatile("" : "+v"(x))
#define MFMA(a, b, c) __builtin_amdgcn_mfma_f32_32x32x16_bf16(a, b, c, 0, 0, 0)
#ifndef ATT_AGPR_O
#define ATT_AGPR_O 0
#endif
#if ATT_AGPR_O
#define PVMFMA(acc, a, b) asm volatile("s_nop 1\n\tv_mfma_f32_32x32x16_bf16 %0, %1, %2, %0" : "+a"(acc) : "v"(a), "v"(b))
#else
#define PVMFMA(acc, a, b) acc = __builtin_amdgcn_mfma_f32_32x32x16_bf16(a, b, acc, 0, 0, 0)
#endif
#define WAIT_BAR_(N) asm volatile("s_waitcnt vmcnt(" #N ") lgkmcnt(0)\n\ts_barrier" ::: "memory")
#define WAIT_BAR_0() WAIT_BAR_(0)
#define WAIT_BAR_1() do { if (ATT_DUP & 1) WAIT_BAR_(2); else WAIT_BAR_(1); } while (0)
#define WAIT_BAR_2() do { if (ATT_DUP & 1) WAIT_BAR_(4); else WAIT_BAR_(2); } while (0)
#define WAIT_BAR_3() do { if (ATT_DUP & 1) WAIT_BAR_(6); else WAIT_BAR_(3); } while (0)
#define WAIT_BAR(N) do { WAIT_BAR_##N(); if (ATT_DUP & 2) asm volatile("s_barrier" ::: "memory"); } while (0)
DEVI int crow(int r, int hi) { return (r & 3) + 8 * (r >> 2) + 4 * hi; }
DEVI unsigned cvtpk(float lo, float hi) { unsigned r; asm("v_cvt_pk_bf16_f32 %0, %1, %2" : "=v"(r) : "v"(lo), "v"(hi)); return r; }
DEVI void glds16(const void* g, unsigned lds_base) {
    unsigned sv; asm volatile("s_mov_b32 %0, m0\n\ts_mov_b32 m0, %2\n\ts_nop 0\n\tglobal_load_lds_dwordx4 %1, off\n\ts_mov_b32 m0, %0" : "=&s"(sv) : "v"(g), "s"(lds_base) : "memory"); }
typedef __attribute__((address_space(3))) const char* lds_cptr;
typedef short v4i16_t __attribute__((ext_vector_type(4)));
DEVI bf16x8 ldsb128(lds_cptr p) { return *(const __attribute__((address_space(3))) bf16x8*)p; }
DEVI s16x4 vtr(lds_cptr p) { return __builtin_bit_cast(s16x4, __builtin_amdgcn_ds_read_tr16_b64_v4i16((__attribute__((address_space(3))) v4i16_t*)p)); }
DEVI bf16x8 scale8(bf16x8 v, float s) {
    u32x4 w = __builtin_bit_cast(u32x4, v); u32x4 o;
#pragma unroll
    for (int i = 0; i < 4; ++i) { const float lo = __uint_as_float(w[i] << 16) * s, hi = __uint_as_float(w[i] & 0xffff0000u) * s; o[i] = cvtpk(lo, hi); }
    return __builtin_bit_cast(bf16x8, o);
}

template <int ROPE>
DEVI void attn_unit(const bf16_t* Qn, int ldq, const bf16_t* Qr, const float* ssh, const bf16_t* __restrict__ Kn, int ldk, const bf16_t* __restrict__ Kr,
                    const bf16_t* __restrict__ V, int ldv, int NT, bf16_t* O, const bf16_t* G, int ldo, char* lds) {
    const int tid = threadIdx.x, lane = tid & 63, r32 = lane & 31, hi = lane >> 5; const int wid = __builtin_amdgcn_readfirstlane(tid >> 6);
    const unsigned lds0 = (unsigned)(uintptr_t)lds; float* wsf = (float*)(lds + LDS_WS) + wid * 64;
    const bf16_t* ksrc = Kn + (size_t)lane * ldk + wid * 8;
    const bf16_t* vsrc = V + (size_t)(16 * (wid & 3) + (lane >> 2)) * ldv + (wid >> 2) * 32 + (lane & 3) * 8;
    const bf16_t* krsrc = ROPE ? Kr + (size_t)(32 * (wid & 1) + r32) * 32 + 8 * (2 * ((wid >> 1) & 1) + hi) : nullptr;
    const unsigned kdst = lds0 + LDS_K + wid * 1024, vdst = lds0 + LDS_V + wid * 1024, krdst = lds0 + LDS_K + KROFF + (wid & 3) * 1024;
    const bool rwave = ROPE && wid < 4;
#define DMA_K(t, slot) do { DMA_K1(t, slot); if (ATT_DUP & 1) DMA_K1(t, slot); } while (0)
#define DMA_K1(t, slot) do { if (ROPE) { if (rwave) glds16(krsrc + (size_t)(t) * KVBLK * 32, (unsigned)__builtin_amdgcn_readfirstlane(krdst + (slot))); } \
        glds16(ksrc + (size_t)(t) * KVBLK * ldk, (unsigned)__builtin_amdgcn_readfirstlane(kdst + (slot))); } while (0)
#define DMA_V1(t, slot) glds16(vsrc + (size_t)(t) * KVBLK * ldv, (unsigned)__builtin_amdgcn_readfirstlane(vdst + (slot)))
#define DMA_V(t, slot) do { DMA_V1(t, slot); if (ATT_DUP & 1) DMA_V1(t, slot); } while (0)
    const lds_cptr vp0 = (lds_cptr)lds + LDS_V + ((lane >> 4) & 1) * 32 + (lane & 3) * 8 + (4 * hi + ((lane & 15) >> 2)) * 64;
    const lds_cptr kp0 = (lds_cptr)lds + LDS_K + hi * 1024 + r32 * 16;
    const lds_cptr krp0 = (lds_cptr)lds + LDS_K + KROFF + hi * 512 + r32 * 16;
    DMA_K(0, 0); DMA_V(0, 0); DMA_K(1, SLOTK);
    bf16x8 qr[4]; bf16x8 qrr[2];
    { const bf16_t* Qw = Qn + (size_t)(wid * 32 + r32) * ldq + hi * 8;
#pragma unroll
      for (int d0 = 0; d0 < 4; ++d0) qr[d0] = *reinterpret_cast<const bf16x8*>(Qw + d0 * 16);
      if (ROPE) { const bf16_t* Qrw = Qr + (size_t)(wid * 32 + r32) * 512 + hi * 8;
#pragma unroll
          for (int d0 = 0; d0 < 2; ++d0) qrr[d0] = *reinterpret_cast<const bf16x8*>(Qrw + d0 * 16);
          const f32x2 s2 = *(const f32x2*)(ssh + (size_t)(wid * 32 + r32) * 32); const float sc = rsqrtf((s2[0] + s2[1]) * (1.f / 96.f) + EPS) * C2_MLA;
#pragma unroll
          for (int d0 = 0; d0 < 4; ++d0) qr[d0] = scale8(qr[d0], sc);
#pragma unroll
          for (int d0 = 0; d0 < 2; ++d0) qrr[d0] = scale8(qrr[d0], sc); } }
    float l_reg = 0.f; f32x16 o[2]; o[0] = f32x16{}; o[1] = f32x16{};
    const f32x16 zero16 = f32x16{};
    f32x16 dacc = f32x16{}; f32x16 pA0, pA1, pB0, pB1; bf16x8 kf[8]; bf16x8 kfr[4]; s16x4 vlo[8], vhi[8]; u32x4 pw0, pw1, pw2, pw3;
    int sl_prev = 0, sl_cur = 0, sl_next = SLOTK;
#define VSL(s) (((s) / (SLOTK / 1024)) * (SLOTV / 1024))
#define ROT() do { sl_prev = sl_cur; sl_cur = sl_next; sl_next = (sl_next == 2 * SLOTK) ? 0 : sl_next + SLOTK; } while (0)
#define EX(v) __builtin_amdgcn_exp2f(v)
#define KLOADALL(slot) do { _Pragma("unroll") for (int d0 = 0; d0 < 4; ++d0) { kf[2 * d0] = ldsb128(kp0 + (slot) + d0 * 2048); kf[2 * d0 + 1] = ldsb128(kp0 + (slot) + d0 * 2048 + 512); } \
        if (ROPE) { _Pragma("unroll") for (int q = 0; q < 4; ++q) kfr[q] = ldsb128(krp0 + (slot) + q * 1024); } } while (0)
    DMA_K(2, 2 * SLOTK);
    WAIT_BAR(3);
    KLOADALL(0);
    pA0 = MFMA(kf[0], qr[0], zero16); pA1 = MFMA(kf[1], qr[0], zero16); pA0 = MFMA(kf[2], qr[1], pA0); pA1 = MFMA(kf[3], qr[1], pA1);
    pA0 = MFMA(kf[4], qr[2], pA0); pA1 = MFMA(kf[5], qr[2], pA1); pA0 = MFMA(kf[6], qr[3], pA0); pA1 = MFMA(kf[7], qr[3], pA1);
    if (ROPE) { pA0 = MFMA(kfr[0], qrr[0], pA0); pA1 = MFMA(kfr[1], qrr[0], pA1); pA0 = MFMA(kfr[2], qrr[1], pA0); pA1 = MFMA(kfr[3], qrr[1], pA1); }
#pragma unroll
    for (int r = 0; r < 16; ++r) { pA0[r] = EX(pA0[r]); pA1[r] = EX(pA1[r]); }
    WAIT_BAR(0);
    DMA_K(3, 0); DMA_V(1, SLOTV); ROT();
    KLOADALL(sl_cur);
    WAIT_BAR(2);
#define PKW(P, i) cvtpk(P[i], P[i + 1])
#define PAF(k) __builtin_bit_cast(bf16x8, pw##k)
#define VFR(i) (bf16x8){vlo[i][0], vlo[i][1], vlo[i][2], vlo[i][3], vhi[i][0], vhi[i][1], vhi[i][2], vhi[i][3]}
#define VRD(i) do { vlo[i] = vtr(vp_ + (((i) >> 2) * 4096 + ((i) & 3) * 1024)); vhi[i] = vtr(vp_ + (((i) >> 2) * 4096 + ((i) & 3) * 1024 + 512)); } while (0)
#define KRD(G, d0) do { if (G) { kf[2 * (d0)] = ldsb128(kp0 + sl_next + (d0) * 2048); kf[2 * (d0) + 1] = ldsb128(kp0 + sl_next + (d0) * 2048 + 512); \
        if (ATT_DUP & 16) { bf16x8 d0_, d1_; asm volatile("ds_read_b128 %0, %2 offset:0\n\tds_read_b128 %1, %2 offset:512\n\ts_waitcnt lgkmcnt(0)" : "=&v"(d0_), "=&v"(d1_) : "v"((unsigned)(uintptr_t)(kp0 + sl_next + (d0) * 2048)) : "memory"); } SBAR(); } } while (0)
#define KRR(G, q) do { if (ROPE) { if (G) { kfr[2 * (q)] = ldsb128(krp0 + sl_next + (2 * (q)) * 1024); kfr[2 * (q) + 1] = ldsb128(krp0 + sl_next + (2 * (q) + 1) * 1024); SBAR(); } } } while (0)
#define GAPA4(CX, MF, a0, a1, a2, a3, W0, W1, PW) do { MF; sacc += a0; sacc += a1; sacc += a2; sacc += a3; W0; W1; PIN(PW); PIN(sacc); PIN(CX); if ((ATT_DUP & 8) && !ROPE) { dacc = MFMA(kf[0], qr[0], dacc); PIN(dacc); } SBAR(); } while (0)
#define GAPA3(CX, MF, a0, a1, a2, W0, W1, PW) do { MF; sacc += a0; sacc += a1; sacc += a2; W0; W1; PIN(PW); PIN(sacc); PIN(CX); if ((ATT_DUP & 8) && !ROPE) { dacc = MFMA(kf[0], qr[0], dacc); PIN(dacc); } SBAR(); } while (0)
#define GAPA31(CX, MF, a0, a1, a2, W0, PW) do { MF; sacc += a0; sacc += a1; sacc += a2; W0; PIN(PW); PIN(sacc); PIN(CX); if ((ATT_DUP & 8) && !ROPE) { dacc = MFMA(kf[0], qr[0], dacc); PIN(dacc); } SBAR(); } while (0)
#define GAPA21(CX, MF, a0, a1, W0, PW) do { MF; sacc += a0; sacc += a1; W0; PIN(PW); PIN(sacc); PIN(CX); if ((ATT_DUP & 8) && !ROPE) { dacc = MFMA(kf[0], qr[0], dacc); PIN(dacc); } SBAR(); } while (0)
#define XEXP(v) do { if (ATT_DUP & 4) { float d_; asm volatile("v_exp_f32 %0, %1" : "=v"(d_) : "v"(v)); } } while (0)
#define GAPB(MF, X, i) do { MF; X[i] = EX(X[i]); X[i + 1] = EX(X[i + 1]); X[i + 2] = EX(X[i + 2]); X[i + 3] = EX(X[i + 3]); XEXP(X[i]); XEXP(X[i + 1]); XEXP(X[i + 2]); XEXP(X[i + 3]); PIN(X); SBAR(); } while (0)
#define STEP(C0, C1, P0, P1, t, GK, GV, GL) do { SBAR(); if (ATT_PRIO == 2) __builtin_amdgcn_s_setprio(1); if (ATT_PRIO == 3) __builtin_amdgcn_s_setprio(0); \
    const lds_cptr vp_ = vp0 + VSL(sl_prev); \
    VRD(0); SBAR(); float sacc = P0[0] + P0[1]; \
    if (!ROPE) { \
                        GAPA4(C0, C0 = MFMA(kf[0], qr[0], zero16), P0[2], P0[3], P0[4], P0[5],     pw0[0] = PKW(P0, 0),  pw0[1] = PKW(P0, 2),  pw0); \
        VRD(4); SBAR(); GAPA4(C1, C1 = MFMA(kf[1], qr[0], zero16), P0[6], P0[7], P0[8], P0[9],     pw0[2] = PKW(P0, 4),  pw0[3] = PKW(P0, 6),  pw0); \
        VRD(1); SBAR(); GAPA4(C0, C0 = MFMA(kf[2], qr[1], C0),    P0[10], P0[11], P0[12], P0[13], pw1[0] = PKW(P0, 8),  pw1[1] = PKW(P0, 10), pw1); \
        VRD(5); SBAR(); GAPA4(C1, C1 = MFMA(kf[3], qr[1], C1),    P0[14], P0[15], P1[0], P1[1],   pw1[2] = PKW(P0, 12), pw1[3] = PKW(P0, 14), pw1); \
        VRD(2); SBAR(); GAPA4(C0, C0 = MFMA(kf[4], qr[2], C0),    P1[2], P1[3], P1[4], P1[5],     pw2[0] = PKW(P1, 0),  pw2[1] = PKW(P1, 2),  pw2); \
        VRD(6); SBAR(); GAPA4(C1, C1 = MFMA(kf[5], qr[2], C1),    P1[6], P1[7], P1[8], P1[9],     pw2[2] = PKW(P1, 4),  pw2[3] = PKW(P1, 6),  pw2); \
        VRD(3); SBAR(); GAPA4(C0, C0 = MFMA(kf[6], qr[3], C0),    P1[10], P1[11], P1[12], P1[13], pw3[0] = PKW(P1, 8),  pw3[1] = PKW(P1, 10), pw3); \
        VRD(7); SBAR(); GAPA4(C1, C1 = MFMA(kf[7], qr[3], C1),    P1[14], P1[15], 0.f, 0.f,       pw3[2] = PKW(P1, 12), pw3[3] = PKW(P1, 14), pw3); \
    } else { \
                        GAPA3(C0, C0 = MFMA(kf[0], qr[0], zero16), P0[2], P0[3], P0[4],    pw0[0] = PKW(P0, 0),  pw0[1] = PKW(P0, 2),  pw0); \
        VRD(4); SBAR(); GAPA3(C1, C1 = MFMA(kf[1], qr[0], zero16), P0[5], P0[6], P0[7],    pw0[2] = PKW(P0, 4),  pw0[3] = PKW(P0, 6),  pw0); \
        VRD(1); SBAR(); GAPA3(C0, C0 = MFMA(kf[2], qr[1], C0),    P0[8], P0[9], P0[10],   pw1[0] = PKW(P0, 8),  pw1[1] = PKW(P0, 10), pw1); \
        VRD(5); SBAR(); GAPA3(C1, C1 = MFMA(kf[3], qr[1], C1),    P0[11], P0[12], P0[13], pw1[2] = PKW(P0, 12), pw1[3] = PKW(P0, 14), pw1); \
        VRD(2); SBAR(); GAPA31(C0, C0 = MFMA(kf[4], qr[2], C0),   P0[14], P0[15], P1[0],  pw2[0] = PKW(P1, 0),  pw2); \
        VRD(6); SBAR(); GAPA31(C1, C1 = MFMA(kf[5], qr[2], C1),   P1[1], P1[2], P1[3],    pw2[1] = PKW(P1, 2),  pw2); \
        VRD(3); SBAR(); GAPA21(C0, C0 = MFMA(kf[6], qr[3], C0),   P1[4], P1[5],           pw2[2] = PKW(P1, 4),  pw2); \
        VRD(7); SBAR(); GAPA21(C1, C1 = MFMA(kf[7], qr[3], C1),   P1[6], P1[7],           pw2[3] = PKW(P1, 6),  pw2); \
                        GAPA21(C0, C0 = MFMA(kfr[0], qrr[0], C0), P1[8], P1[9],           pw3[0] = PKW(P1, 8),  pw3); \
                        GAPA21(C1, C1 = MFMA(kfr[1], qrr[0], C1), P1[10], P1[11],         pw3[1] = PKW(P1, 10), pw3); \
                        GAPA21(C0, C0 = MFMA(kfr[2], qrr[1], C0), P1[12], P1[13],         pw3[2] = PKW(P1, 12), pw3); \
                        GAPA21(C1, C1 = MFMA(kfr[3], qrr[1], C1), P1[14], P1[15],         pw3[3] = PKW(P1, 14), pw3); \
    } \
    l_reg += sacc; \
    if (GK) DMA_K((t) + 3, sl_cur); if (GV) DMA_V((t) + 1, VSL(sl_next)); \
    SBAR(); if (ATT_PRIO == 2) __builtin_amdgcn_s_setprio(0); if (ATT_PRIO == 3) __builtin_amdgcn_s_setprio(1); \
    GAPB(PVMFMA(o[0], PAF(0), VFR(0)), C0, 0); \
    KRD(GL, 0); GAPB(PVMFMA(o[1], PAF(0), VFR(4)), C0, 4); \
    KRD(GL, 1); GAPB(PVMFMA(o[0], PAF(1), VFR(1)), C0, 8); \
    KRD(GL, 2); GAPB(PVMFMA(o[1], PAF(1), VFR(5)), C0, 12); \
    KRD(GL, 3); GAPB(PVMFMA(o[0], PAF(2), VFR(2)), C1, 0); \
    KRR(GL, 0); GAPB(PVMFMA(o[1], PAF(2), VFR(6)), C1, 4); \
    KRR(GL, 1); GAPB(PVMFMA(o[0], PAF(3), VFR(3)), C1, 8); \
    GAPB(PVMFMA(o[1], PAF(3), VFR(7)), C1, 12); \
    } while (0)
    if (ATT_PRIO == 1) { if (wid >= 4) __builtin_amdgcn_s_setprio(1); }
    int t = 1;
    for (; t + 5 < NT; t += 2) {
        STEP(pB0, pB1, pA0, pA1, t, true, true, true);     WAIT_BAR(2); ROT();
        STEP(pA0, pA1, pB0, pB1, t + 1, true, true, true); WAIT_BAR(2); ROT();
    }
#define ENDW(tt) do { if ((tt) + 3 < NT) { WAIT_BAR(2); } else if ((tt) + 2 < NT) { WAIT_BAR(1); } else { WAIT_BAR(0); } } while (0)
    for (; t + 1 < NT; t += 2) {
        STEP(pB0, pB1, pA0, pA1, t, (t + 3 < NT), (t + 1 < NT), (t + 1 < NT));         ENDW(t);     ROT();
        STEP(pA0, pA1, pB0, pB1, t + 1, (t + 4 < NT), (t + 2 < NT), (t + 2 < NT));     ENDW(t + 1); ROT();
    }
    STEP(pB0, pB1, pA0, pA1, NT - 1, false, false, false);
    if (ATT_PRIO != 0) __builtin_amdgcn_s_setprio(0);
    { float sacc = pB0[0] + pB0[1];
#pragma unroll
      for (int r = 2; r < 16; ++r) sacc += pB0[r];
#pragma unroll
      for (int r = 0; r < 16; ++r) sacc += pB1[r];
      l_reg += sacc;
      pw0 = (u32x4){PKW(pB0, 0), PKW(pB0, 2), PKW(pB0, 4), PKW(pB0, 6)}; pw1 = (u32x4){PKW(pB0, 8), PKW(pB0, 10), PKW(pB0, 12), PKW(pB0, 14)};
      pw2 = (u32x4){PKW(pB1, 0), PKW(pB1, 2), PKW(pB1, 4), PKW(pB1, 6)}; pw3 = (u32x4){PKW(pB1, 8), PKW(pB1, 10), PKW(pB1, 12), PKW(pB1, 14)};
      const lds_cptr vp_ = vp0 + VSL(sl_cur); _Pragma("unroll") for (int i = 0; i < 8; ++i) VRD(i);
      PVMFMA(o[0], PAF(0), VFR(0)); PVMFMA(o[1], PAF(0), VFR(4)); PVMFMA(o[0], PAF(1), VFR(1)); PVMFMA(o[1], PAF(1), VFR(5));
      PVMFMA(o[0], PAF(2), VFR(2)); PVMFMA(o[1], PAF(2), VFR(6)); PVMFMA(o[0], PAF(3), VFR(3)); PVMFMA(o[1], PAF(3), VFR(7)); }
#if ATT_AGPR_O
    asm volatile("s_nop 15\n\ts_nop 7" : "+a"(o[0]), "+a"(o[1]));
#endif
    { auto rr = __builtin_amdgcn_permlane32_swap(__float_as_uint(l_reg), __float_as_uint(l_reg), false, false); l_reg = __uint_as_float(rr[0]) + __uint_as_float(rr[1]); }
    if (hi == 0) wsf[32 + r32] = l_reg; asm volatile("s_waitcnt lgkmcnt(0)" ::: "memory");
    float rli[16];
#pragma unroll
    for (int r = 0; r < 16; ++r) rli[r] = __builtin_amdgcn_rcpf(wsf[32 + crow(r, hi)]);
    bf16_t* stg = (bf16_t*)(lds + LDS_OST) + wid * 2048;
#pragma unroll
    for (int r = 0; r < 16; ++r) { const int orow = crow(r, hi);
#pragma unroll
        for (int d0 = 0; d0 < 2; ++d0) stg[orow * 64 + d0 * 32 + r32] = (bf16_t)f2bf(o[d0][r] * rli[r]); }
    asm volatile("s_waitcnt lgkmcnt(0)" ::: "memory");
#pragma unroll
    for (int i = 0; i < 4; ++i) { const int row = i * 8 + (lane >> 3), ch = lane & 7; const size_t goff = (size_t)(wid * 32 + row) * ldo + ch * 8;
        const u32x4 ov = *(const u32x4*)(stg + row * 64 + ch * 8); const u32x4 gv = *(const u32x4*)(G + goff); u32x4 w;
#pragma unroll
        for (int q = 0; q < 4; ++q) { const float lo = __uint_as_float(ov[q] << 16) * __uint_as_float(gv[q] << 16), hh = __uint_as_float(ov[q] & 0xffff0000u) * __uint_as_float(gv[q] & 0xffff0000u); w[q] = cvtpk(lo, hh); }
        *(u32x4*)(O + goff) = w; }
    asm volatile("s_waitcnt lgkmcnt(0)\n\ts_barrier" ::: "memory");
#undef DMA_K
#undef DMA_K1
#undef DMA_V1
#undef XEXP
#undef DMA_V
#undef VSL
#undef ROT
#undef EX
#undef KLOADALL
#undef PKW
#undef PAF
#undef VFR
#undef VRD
#undef KRD
#undef KRR
#undef GAPA4
#undef GAPA3
#undef GAPA31
#undef GAPA21
#undef GAPB
#undef STEP
#undef ENDW
}
#undef SBAR
#undef PIN
#undef MFMA
#undef PVMFMA
#undef WAIT_BAR
#undef WAIT_BAR_
#undef WAIT_BAR_0
#undef WAIT_BAR_1
#undef WAIT_BAR_2
#undef WAIT_BAR_3
}

namespace af8 {
#ifdef MK_UNIT_PROBE
#define UPROBE_PARAM , unsigned long long& upacc
#define UPROBE_ARG , upacc
#else
#define UPROBE_PARAM
#define UPROBE_ARG
#endif
#ifndef F8_DUP
#define F8_DUP 0
#endif
typedef int v8i __attribute__((ext_vector_type(8)));
typedef int v4i __attribute__((ext_vector_type(4)));
typedef int v2i __attribute__((ext_vector_type(2)));
constexpr int NW = 8, KVBLK = 64, SLOT = 4096, KSLOT = 2048;
constexpr int KRSLOT = 1024 + 64;
constexpr int NSL = 4;
constexpr int LDS_K = 0, LDS_V = NSL * KSLOT, LDS_KR = LDS_V + NSL * SLOT, LDS_WS = LDS_KR + NSL * KRSLOT, LDS_OST = LDS_WS + NW * 256, LDS_BYTES = LDS_OST + NW * 4096;
constexpr float YOFF = (56.0f + 0.5f) / 256.f;
#define SBAR() __builtin_amdgcn_sched_barrier(0)
#define PIN(x) asm volatile("" : "+v"(x))
#define WAIT_BAR0() asm volatile("s_waitcnt vmcnt(0) lgkmcnt(0)\n\ts_barrier" ::: "memory")
#define WAIT_BAR1() asm volatile("s_waitcnt vmcnt(2) lgkmcnt(0)\n\ts_barrier" ::: "memory")
#define V8(x) ((v8i){(x)[0], (x)[1], (x)[2], (x)[3], 0, 0, 0, 0})
#define V6(x) ((v8i){(int)(x)[0], (int)(x)[1], (int)(x)[2], (int)(x)[3], (int)(x)[4], (int)(x)[5], 0, 0})
#define QKMFMA(a, b, c) __builtin_amdgcn_mfma_scale_f32_32x32x64_f8f6f4(V8(a), V6(b), c, 4, 2, 0, 122, 0, 122)
#define PVMFMA8(a, b, c) __builtin_amdgcn_mfma_scale_f32_32x32x64_f8f6f4(a, b, c, 1, 0, 0, 127, 0, 127)
#define SUMMFMA(a, b, c) __builtin_amdgcn_mfma_scale_f32_16x16x128_f8f6f4(a, b, c, 1, 0, 0, 127, 0, 127)
DEVI int crow(int r, int hi) { return (r & 3) + 8 * (r >> 2) + 4 * hi; }
DEVI unsigned cvtpk(float lo, float hi) { unsigned r; asm("v_cvt_pk_bf16_f32 %0, %1, %2" : "=v"(r) : "v"(lo), "v"(hi)); return r; }
DEVI void glds16(const void* g, unsigned lds_base) {
    unsigned sv; asm volatile("s_mov_b32 %0, m0\n\ts_mov_b32 m0, %2\n\ts_nop 0\n\tglobal_load_lds_dwordx4 %1, off\n\ts_mov_b32 m0, %0" : "=&s"(sv) : "v"(g), "s"(lds_base) : "memory"); }
typedef __attribute__((address_space(3))) const char* lds_cptr;
DEVI v4i lds128(lds_cptr p) { return *(const __attribute__((address_space(3))) v4i*)p; }
DEVI v2i vtr8(lds_cptr p) { return __builtin_amdgcn_ds_read_tr8_b64_v2i32((__attribute__((address_space(3))) v2i*)p); }
typedef unsigned short us2 __attribute__((ext_vector_type(2)));
#define PK16U8(P, PF, B) do { _Pragma("unroll") for (int g_ = 0; g_ < 4; ++g_) { \
        const us2 lo_ = __builtin_amdgcn_cvt_pknorm_u16(P[4 * g_], P[4 * g_ + 1]), hi_ = __builtin_amdgcn_cvt_pknorm_u16(P[4 * g_ + 2], P[4 * g_ + 3]); \
        PF[(B) + g_] = (int)__builtin_amdgcn_perm(__builtin_bit_cast(unsigned, hi_), __builtin_bit_cast(unsigned, lo_), 0x07050301u); } } while (0)
DEVI int pk4bf8(float a, float b, float c, float d) { unsigned w; asm volatile("" : "=v"(w)); w = __builtin_amdgcn_cvt_pk_u8_f32(a, 0, w); w = __builtin_amdgcn_cvt_pk_u8_f32(b, 1, w); w = __builtin_amdgcn_cvt_pk_u8_f32(c, 2, w); w = __builtin_amdgcn_cvt_pk_u8_f32(d, 3, w); return (int)w; }

DEVI int pk4fp8(float a, float b, float c, float d) { int w; asm volatile("" : "=v"(w)); w = __builtin_amdgcn_cvt_pk_fp8_f32(a, b, w, false); w = __builtin_amdgcn_cvt_pk_fp8_f32(c, d, w, true); return w; }
#ifndef F6_INTERLEAVED
#define F6_INTERLEAVED 1
#endif
typedef float v16f __attribute__((ext_vector_type(16)));
typedef unsigned v6u __attribute__((ext_vector_type(6)));
DEVI v6u q32_to_fp6(const bf16_t* p, float sc) { v16f a, b;
#pragma unroll
    for (int c = 0; c < 4; ++c) { const u32x4 w = *(const u32x4*)(p + 8 * c);
#pragma unroll
        for (int k = 0; k < 4; ++k) { const float lo = __uint_as_float(w[k] << 16) * sc, hi = __uint_as_float(w[k] & 0xffff0000u) * sc; const int i = 4 * c + k;
            if (F6_INTERLEAVED) { a[i] = lo; b[i] = hi; } else if (i < 8) { a[2 * i] = lo; a[2 * i + 1] = hi; } else { b[2 * i - 16] = lo; b[2 * i - 15] = hi; } } }
    return __builtin_amdgcn_cvt_scalef32_2xpk16_fp6_f32(a, b, 1.0f); }
template <int ROPE>
DEVI void attn_unit(const void* Qv, int ldq, const bf16_t* Qr, const float* ssh, const unsigned char* __restrict__ K, int ldk, const unsigned char* __restrict__ Kr,
                    const unsigned char* __restrict__ V, int ldv, int NT, bf16_t* O, const bf16_t* G, int ldo, char* lds UPROBE_PARAM) {
#ifdef MK_UNIT_PROBE
    const unsigned long long upT0 = __builtin_amdgcn_s_memrealtime();
#endif
    int tid_ = threadIdx.x; asm volatile("" : "+v"(tid_));
    const int tid = tid_, lane = tid & 63, r32 = lane & 31, hi = lane >> 5; const int wid = __builtin_amdgcn_readfirstlane(tid >> 6);
    const unsigned lds0 = (unsigned)(uintptr_t)lds; float* wsf = (float*)(lds + LDS_WS) + wid * 64;
    const int role = wid < 2 ? 0 : (wid >= 4 ? 1 : ((ROPE && wid == 2) ? 2 : 3)); const bool kwave = role != 1; const int dlead = kwave ? 4 : 2;
    const int kkey = 32 * (wid & 1) + (lane >> 1), vkey = 16 * (wid & 3) + (lane >> 2);
    const unsigned char* dsrc = role == 0 ? K + (size_t)kkey * ldk + 16 * ((lane & 1) ^ ((kkey >> 3) & 1))
                              : role == 1 ? V + (size_t)vkey * ldv + 16 * ((lane & 3) ^ (2 * ((vkey >> 3) & 1)))
                              : (ROPE ? Kr + (size_t)lane * 16 : K);
    const size_t dstep = (size_t)KVBLK * (role == 0 ? ldk : (role == 1 ? ldv : 16));
    const unsigned ddst = lds0 + (role == 0 ? LDS_K + (wid & 1) * 1024 : (role == 1 ? LDS_V + (wid & 3) * 1024 : LDS_KR));
    const int dslot = role == 0 ? KSLOT : (role == 1 ? SLOT : KRSLOT); const bool dma_on = role != 3;
#define DMA(t, si) glds16(dsrc + (size_t)(t) * dstep, (unsigned)__builtin_amdgcn_readfirstlane(ddst + (si) * dslot))
    const lds_cptr kpa = (lds_cptr)lds + LDS_K + r32 * 32 + ((hi ^ ((r32 >> 3) & 1)) * 16);
    const int vg = (lane >> 4) & 1, vq = (lane & 15) >> 1, vp = lane & 1, vfk = (vq >> 2) & 1;
    const int vrow = (8 * (vq >> 2) + 4 * hi + (vq & 3)) * 64 + 8 * vp + 16 * vg;
    const lds_cptr vp0 = (lds_cptr)lds + LDS_V + vrow + 32 * vfk, vp1 = (lds_cptr)lds + LDS_V + vrow + 32 * (1 - vfk);
    const lds_cptr ra0 = (lds_cptr)lds + LDS_KR + (hi ? 1024 : r32 * 16), ra1 = (lds_cptr)lds + LDS_KR + (hi ? 1024 : 512 + r32 * 16);
    if (ROPE) { if (tid < 16) *(int*)(lds + LDS_KR + (tid >> 2) * KRSLOT + 1024 + (tid & 3) * 4) = 0; }
    if (dma_on) { if (kwave) { DMA(0, 0); DMA(1, 1); DMA(2, 2); DMA(3, 3); } else { DMA(0, 0); DMA(1, 1); } }
    v6u qf, qrf;
    if (!ROPE) { qf = q32_to_fp6((const bf16_t*)Qv + (size_t)(wid * 32 + r32) * ldq + hi * 32, 1.0f); qrf = qf; }
    else { const f32x2 s2 = *(const f32x2*)(ssh + (size_t)(wid * 32 + r32) * 32); const float sc = rsqrtf((s2[0] + s2[1]) * (1.f / 96.f) + EPS) * (C2_MLA * 8.f);
        qf = q32_to_fp6((const bf16_t*)Qv + (size_t)(wid * 32 + r32) * ldq + hi * 32, sc);
        qrf = q32_to_fp6(Qr + (size_t)(wid * 32 + r32) * 512, hi ? 0.f : sc); }
    f32x16 o[2]; o[0] = f32x16{}; o[1] = f32x16{}; f32x4 lacc = f32x4{};
    v8i ones;
#pragma unroll
    for (int i = 0; i < 8; ++i) ones[i] = ((lane & 15) == ((lane >> 4) & 1)) ? 0x38383838 : 0;
    PIN(ones);
    f32x16 m4;
    { float y_ = YOFF; asm volatile("" : "+v"(y_));
#pragma unroll
      for (int r = 0; r < 16; ++r) m4[r] = y_; }
    PIN(m4);
    v4i kf0, kf1, krf0, krf1; v8i vf0, vf1, pfA, pfB;
#define ROT() do { } while (0)
#define EX(v) __builtin_amdgcn_exp2f(v)
#define KLOAD(si) do { kf0 = lds128(kpa + (si) * KSLOT); kf1 = lds128(kpa + (si) * KSLOT + 1024); if (ROPE) { krf0 = lds128(ra0 + (si) * KRSLOT); krf1 = lds128(ra1 + (si) * KRSLOT); } } while (0)
    WAIT_BAR0();
    KLOAD(0);
    { f32x16 c0 = QKMFMA(kf0, qf, m4), c1 = QKMFMA(kf1, qf, m4);
      if (ROPE) { c0 = QKMFMA(krf0, qrf, c0); c1 = QKMFMA(krf1, qrf, c1); }
      PK16U8(c0, pfA, 0); PK16U8(c1, pfA, 4); }
    WAIT_BAR0();
    if (dma_on) { if (kwave) { if (4 < NT) DMA(4, 0); } else DMA(2, 2); }
    KLOAD(1);
    WAIT_BAR1();
#define VRD2(m) do { const v2i a_ = vtr8(vp0 + vsl_ * SLOT + (m) * 1024), b_ = vtr8(vp1 + vsl_ * SLOT + (m) * 1024); vf0[2 * (m)] = a_[0]; vf0[2 * (m) + 1] = a_[1]; vf1[2 * (m)] = b_[0]; vf1[2 * (m) + 1] = b_[1]; } while (0)
#define STEP(t, PFP, PFN, GK, GV, GL) do { SBAR(); \
    const int vsl_ = ((t) - 1) & 3; f32x16 C0, C1; \
    VRD2(0); VRD2(1); SBAR(); \
    C0 = QKMFMA(kf0, qf, m4); if (ROPE) C0 = QKMFMA(krf0, qrf, C0); PIN(C0); SBAR(); \
    VRD2(2); VRD2(3); SBAR(); \
    C1 = QKMFMA(kf1, qf, m4); if (ROPE) C1 = QKMFMA(krf1, qrf, C1); PIN(C1); SBAR(); \
    if (GL) { KLOAD(((t) + 1) & 3); } \
    { const bool mine_ = dma_on && (kwave ? (GK) : (GV)); if (mine_) DMA((t) + dlead, kwave ? ((t) & 3) : (((t) + 2) & 3)); } \
    SBAR(); \
    lacc = SUMMFMA(PFP, ones, lacc); PIN(lacc); SBAR(); \
    PK16U8(C0, PFN, 0); PIN(PFN); SBAR(); \
    o[0] = PVMFMA8(PFP, vf0, o[0]); PIN(o[0]); SBAR(); \
    PK16U8(C1, PFN, 4); PIN(PFN); SBAR(); \
    o[1] = PVMFMA8(PFP, vf1, o[1]); PIN(o[1]); SBAR(); \
    { const bool mine_ = dma_on && (kwave ? (GK) : (GV)); if (mine_) WAIT_BAR1(); else WAIT_BAR0(); } \
    } while (0)
#ifdef MK_UNIT_PROBE
    const unsigned long long upT1 = __builtin_amdgcn_s_memrealtime();
#endif
    int t = 1;
    for (; t + 5 < NT; t += 2) {
        STEP(t, pfA, pfB, true, true, true);     ROT();
        STEP(t + 1, pfB, pfA, true, true, true); ROT();
    }
    for (; t + 1 < NT; t += 2) {
        STEP(t, pfA, pfB, (t + 4 < NT), (t + 2 < NT), (t + 1 < NT));         ROT();
        STEP(t + 1, pfB, pfA, (t + 5 < NT), (t + 3 < NT), (t + 2 < NT));     ROT();
    }
    STEP(NT - 1, pfA, pfB, false, false, false);
#ifdef MK_UNIT_PROBE
    const unsigned long long upT2 = __builtin_amdgcn_s_memrealtime();
#endif
    { const int vsl_ = (NT - 1) & 3; VRD2(0); VRD2(1); VRD2(2); VRD2(3);
      lacc = SUMMFMA(pfB, ones, lacc); o[0] = PVMFMA8(pfB, vf0, o[0]); o[1] = PVMFMA8(pfB, vf1, o[1]); }
    float rli[16];
#pragma unroll
    for (int r = 0; r < 16; ++r) rli[r] = 0.f;
    if ((lane & 15) < 2) *(f32x4*)(wsf + (lane & 15) * 16 + 4 * (lane >> 4)) = lacc;
    asm volatile("s_waitcnt lgkmcnt(0)" ::: "memory");
#pragma unroll
    for (int r = 0; r < 16; ++r) rli[r] = __builtin_amdgcn_rcpf(wsf[crow(r, hi)]);
    bf16_t* stg = (bf16_t*)(lds + LDS_OST) + wid * 2048;
#pragma unroll
    for (int r = 0; r < 16; ++r) { const int orow = crow(r, hi);
#pragma unroll
        for (int d0 = 0; d0 < 2; ++d0) stg[orow * 64 + d0 * 32 + r32] = (bf16_t)f2bf(o[d0][r] * rli[r]); }
    asm volatile("s_waitcnt lgkmcnt(0)" ::: "memory");
#pragma unroll
    for (int i = 0; i < 4; ++i) { const int row = i * 8 + (lane >> 3), ch = lane & 7; const size_t goff = (size_t)(wid * 32 + row) * ldo + ch * 8;
        const u32x4 ov = *(const u32x4*)(stg + row * 64 + ch * 8); const u32x4 gv = *(const u32x4*)(G + goff); u32x4 w;
#pragma unroll
        for (int q = 0; q < 4; ++q) { const float lo = __uint_as_float(ov[q] << 16) * __uint_as_float(gv[q] << 16), hh = __uint_as_float(ov[q] & 0xffff0000u) * __uint_as_float(gv[q] & 0xffff0000u); w[q] = cvtpk(lo, hh); }
        *(u32x4*)(O + goff) = w; }
    asm volatile("s_waitcnt lgkmcnt(0)\n\ts_barrier" ::: "memory");
#ifdef MK_UNIT_PROBE
    { const unsigned long long upT3 = __builtin_amdgcn_s_memrealtime(); const int w_ = MK_UNIT_PROBE & 3; upacc += w_ == 1 ? (upT1 - upT0) : (w_ == 2 ? (upT3 - upT2) : (upT2 - upT1)); }
#endif
#undef DMA
#undef ROT
#undef EX
#undef KLOAD
#undef VRD2
#undef STEP
}
#undef SBAR
#undef PIN
#undef WAIT_BAR0
#undef WAIT_BAR1
#undef QKMFMA
#undef SUMMFMA
#undef V8
#undef V6
#undef PVMFMA8
}

#define RLX_AGENT __ATOMIC_RELAXED, __HIP_MEMORY_SCOPE_AGENT
#define XB_TMO      128
#define XB_XCNT(j)  (256  + 64 * (j))
#define XB_XSUB(j)  (1280 + 64 * (j))
#define XB_XGEN(j)  (2304 + 64 * (j))
#define XB_TOP      3328
#define XB_TOPGEN   3392
#define XCD_BAR_WORDS 3456
#define XB_SPIN_CAP (1u << 18)

__device__ __forceinline__ unsigned xb_ld(unsigned* p)              { return __hip_atomic_load(p, __ATOMIC_RELAXED, __HIP_MEMORY_SCOPE_AGENT); }
__device__ __forceinline__ unsigned xb_add(unsigned* p, unsigned v) { return __hip_atomic_fetch_add(p, v, __ATOMIC_RELAXED, __HIP_MEMORY_SCOPE_AGENT); }
__device__ __forceinline__ unsigned xb_xcc_id() { return (unsigned)__builtin_amdgcn_s_getreg((3 << 11) | 20) & 0xFu; }
#define XB_SPIN(cond, bar) do { unsigned _sp = 0; while (cond) { __builtin_amdgcn_s_sleep(1); \
    if ((++_sp & 255u) == 0u) { if (xb_ld(&(bar)[XB_TMO])) break; if (_sp > XB_SPIN_CAP) { atomicAdd(&(bar)[XB_TMO], 1u); break; } } } } while (0)

struct XcdBarrier {
    unsigned* bar; unsigned x;
    volatile LAS unsigned* st;
};

__device__ __forceinline__ XcdBarrier xcd_barrier_post(unsigned* bar, volatile LAS unsigned* st) {
    XcdBarrier b; b.bar = bar; b.x = xb_xcc_id(); b.st = st;
    if (threadIdx.x == 0) (void)xb_add(&bar[XB_XCNT(b.x)], 1u);
    return b;
}
__device__ __forceinline__ void xcd_barrier_complete(unsigned* bar, unsigned x, unsigned& nloc, unsigned& nx) {
    const unsigned G = gridDim.x * gridDim.y * gridDim.z;
    unsigned sum, cnt, mine, sp = 0u;
    for (;;) {
        sum = 0u; cnt = 0u; mine = 0u;
#pragma unroll
        for (unsigned j = 0; j < 16; ++j) { const unsigned c = xb_ld(&bar[XB_XCNT(j)]); sum += c; cnt += (c > 0u) ? 1u : 0u; mine = (j == x) ? c : mine; }
        if (sum == G) break;
        __builtin_amdgcn_s_sleep(1);
        if ((++sp & 255u) == 0u) { if (xb_ld(&bar[XB_TMO])) break; if (sp > XB_SPIN_CAP) { atomicAdd(&bar[XB_TMO], 1u); break; } }
    }
    nloc = mine > 0u ? mine : 1u; nx = cnt > 0u ? cnt : 1u;
}

__device__ __forceinline__ void xcd_barrier(const XcdBarrier& b) {
    asm volatile("s_waitcnt vmcnt(0)" ::: "memory");
    __syncthreads();
    if (threadIdx.x == 0) {
        unsigned* bar = b.bar;
        __builtin_amdgcn_s_waitcnt(0);
        unsigned nloc = b.st[0], nx = b.st[1];
        if (nloc == 0u) { xcd_barrier_complete(bar, b.x, nloc, nx); b.st[0] = nloc; b.st[1] = nx; }
        const unsigned old = xb_add(&bar[XB_XSUB(b.x)], 1u);
        const unsigned gen = old / nloc;
        if (old + 1u == (gen + 1u) * nloc) {
            __builtin_amdgcn_fence(__ATOMIC_RELEASE, "agent");
            asm volatile("s_waitcnt vmcnt(0)" ::: "memory");
            const unsigned og = xb_add(&bar[XB_TOP], 1u);
            const unsigned tg = og / nx;
            if (og + 1u == (tg + 1u) * nx) xb_add(&bar[XB_TOPGEN], 1u);
            else XB_SPIN(xb_ld(&bar[XB_TOPGEN]) == tg, bar);
            __builtin_amdgcn_fence(__ATOMIC_ACQUIRE, "agent");
            xb_add(&bar[XB_XGEN(b.x)], 1u);
            asm volatile("s_waitcnt vmcnt(0)" ::: "memory");
        } else {
            XB_SPIN(xb_ld(&bar[XB_XGEN(b.x)]) == gen, bar);
            __builtin_amdgcn_fence(__ATOMIC_ACQUIRE, "agent");
            asm volatile("s_waitcnt vmcnt(0)" ::: "memory");
        }
    }
    __syncthreads();
}


#include <hip/hip_cooperative_groups.h>
namespace cg = cooperative_groups;
constexpr int NWAVES = 8, NTHREADS = 512, LDS_BYTES = 147456, RING_BYTES = 131072;
constexpr size_t MiB = 1u << 20;
constexpr size_t WS_MOD = 1 * MiB;
constexpr size_t WS_TABA = WS_MOD + 128 * 1024;
constexpr size_t WS_TABB = WS_TABA + 32 * 1024;
constexpr size_t WS_WIN0 = 2 * MiB;
constexpr size_t WS_WOUT0 = 7 * MiB;
constexpr size_t WS_WIN1 = 9 * MiB;
constexpr size_t WS_WKVB = 13 * MiB;
constexpr size_t WS_WQB = 14 * MiB;
constexpr size_t WS_WOUT1 = 16 * MiB;
constexpr size_t WS_X1C = 18 * MiB;
constexpr size_t WS_H = 20 * MiB;
constexpr size_t WS_Q = 53 * MiB;
constexpr size_t WS_K = 86 * MiB;
constexpr size_t WS_V0 = 95 * MiB;
constexpr size_t WS_G = 120 * MiB;
constexpr size_t WS_V1 = 153 * MiB;
constexpr size_t WS_KVA = 186 * MiB;
constexpr size_t WS_QA = 195 * MiB;
constexpr size_t WS_Q1R = 207 * MiB;
constexpr size_t WS_KR = 223 * MiB;
constexpr size_t WS_SSKV = 225 * MiB;
constexpr size_t WS_SSQ = 226 * MiB;
constexpr size_t WS_SSH = 227 * MiB;
constexpr size_t WS_SSX = 229 * MiB;
constexpr size_t WS_BIAS1 = WS_MOD + 80 * 1024;
constexpr size_t WS_NWM1 = WS_MOD + 104 * 1024;
constexpr size_t WS_RINV = 230 * MiB + 512 * 1024;
constexpr size_t WS_SLAB = 231 * MiB;
constexpr size_t WS_END = 256 * MiB;
static_assert(WS_K + (size_t)NB * TK * DM * 2 <= WS_G && WS_G + (size_t)MT * DM * 2 <= WS_V1 && WS_V1 + (size_t)NB * TK * DM * 2 <= WS_KVA && WS_SSH + (size_t)ML * 32 * 4 <= WS_END, "ws map");

#ifndef ATT1_F8
#define ATT1_F8 1
#endif
#ifndef ATT0_F8
#define ATT0_F8 1
#endif
struct Args { const float* in[23]; float* out; unsigned char* ws; int ph_lo, ph_hi, coop, pad; };

DEVI void phase0(const Args& a, unsigned char* ws, LAS unsigned char* lds, int vb, int G) {
    const int tid = threadIdx.x, wave = tid >> 6, lane = tid & 63;
    float* mod = (float*)(ws + WS_MOD);
    if (vb < 96) {
        LAS float* sc = (LAS float*)lds; LAS float* red = sc + 3 * 1024;
        const int layer = vb / 48, cs = vb % 48; const float* w = a.in[layer ? 11 : 4]; const float* bb = a.in[layer ? 12 : 5];
        for (int i = tid; i < 3072; i += NTHREADS) { const int r = i >> 10, k = i & 1023; const float v = r < 2 ? a.in[1][r * 1024 + k] : a.in[3][k]; sc[i] = v / (1.f + expf(-v)); }
        __syncthreads();
        const int col = cs * 64 + lane; float a0 = 0.f, a1 = 0.f, a2 = 0.f;
#pragma unroll 8
        for (int k = wave * 128; k < wave * 128 + 128; ++k) { const float wv = w[(size_t)k * 3072 + col]; a0 += sc[k] * wv; a1 += sc[1024 + k] * wv; a2 += sc[2048 + k] * wv; }
        red[(wave * 3 + 0) * 64 + lane] = a0; red[(wave * 3 + 1) * 64 + lane] = a1; red[(wave * 3 + 2) * 64 + lane] = a2;
        __syncthreads();
        if (tid < 192) { const int r = tid >> 6; float s = 0.f;
#pragma unroll
            for (int q = 0; q < 8; ++q) s += red[(q * 3 + r) * 64 + lane];
            mod[(size_t)(layer * 3 + r) * 3072 + col] = s + bb[col]; }
        __syncthreads();
    } else if (vb < 102) {
        f32x2* tabA = (f32x2*)(ws + WS_TABA); f32x2* tabB = (f32x2*)(ws + WS_TABB);
        const int i = (vb - 96) * NTHREADS + tid;
        if (i < 128 * 16) { const int pos = i >> 4, f = i & 15; const float invf = powf(10000.f, -(float)f / 16.f); float cs_, sn_; sincos_pos((float)pos * invf, cs_, sn_); tabA[i] = (f32x2){cs_, sn_}; }
        else if (i < 128 * 24) { const int j = i - 128 * 16, pos = j >> 3, f = j & 7; const float invf = powf(10000.f, -(float)f / 8.f); float cs_, sn_; sincos_pos((float)pos * invf, cs_, sn_); tabB[j] = (f32x2){cs_, sn_}; }
    }
    if (vb < 102 || G <= 102) { if (G > 102) return; }
    struct WD { int src, K, Nsrc, Np, mode, ks; size_t dst; };
    const WD wd[6] = {{7, 1024, N_IN0, 2560, 1, -1, WS_WIN0}, {10, 1024, 1024, 1024, 0, -1, WS_WOUT0}, {14, 1024, N_IN1, N_IN1P, 2, -1, WS_WIN1},
                      {16, 256, 2048, 2048, 3, 15, WS_WKVB}, {18, 384, 1536, 2048, 4, 17, WS_WQB}, {22, 1024, 1024, 1024, 0, -1, WS_WOUT1}};
    LAS float* tl = (LAS float*)lds; int tbase = 0;
#pragma unroll
    for (int m = 0; m < 6; ++m) {
        const float* W = a.in[wd[m].src]; const float* ks = wd[m].ks >= 0 ? a.in[wd[m].ks] : nullptr; bf16_t* Bt = (bf16_t*)(ws + wd[m].dst);
        const int K = wd[m].K, Nsrc = wd[m].Nsrc, Np = wd[m].Np, npb = Np / 256, ntile = (K / 64) * npb;
        for (int it = ((vb - 102) - tbase % (G - 102) + (G - 102)) % (G - 102); it < ntile; it += (G - 102)) {
            const int kb = it / npb, pb = it % npb, k0 = 64 * kb, p0 = 256 * pb;
            const int pl = tid & 255, kh = tid >> 8; int cc = pg8::wmap(wd[m].mode, p0 + pl); if (cc >= Nsrc) cc = -1;
            float v[32];
#pragma unroll
            for (int i = 0; i < 32; ++i) { const int k = k0 + 2 * i + kh; v[i] = cc >= 0 ? W[(size_t)k * Nsrc + cc] * (ks ? ks[k] : 1.f) : 0.f; }
#pragma unroll
            for (int i = 0; i < 32; ++i) tl[pl * 65 + 2 * i + kh] = v[i];
            __syncthreads();
#pragma unroll
            for (int j = 0; j < 4; ++j) { const int q = tid + 512 * j, pr = q >> 3, c = q & 7; const LAS float* sp = tl + pr * 65 + 8 * c;
                u32x4 o; o.x = pk2(sp[0], sp[1]); o.y = pk2(sp[2], sp[3]); o.z = pk2(sp[4], sp[5]); o.w = pk2(sp[6], sp[7]);
                *(u32x4*)(Bt + (size_t)(p0 + pr) * K + k0 + 8 * c) = o; }
            __syncthreads();
        }
        tbase += ntile;
    }
}

DEVI void phase_prep(const float* xa, const float* xb, const float* nw, const float* mod, bf16_t* H, int gw, int NGW, int lane) {
    for (int row0 = gw; row0 < MT; row0 += 4 * NGW) {
        f32x4 v[4][4]; float ss[4];
#pragma unroll
        for (int q = 0; q < 4; ++q) { const int row = row0 + q * NGW; ss[q] = 0.f;
            if (row < MT) { const float* src = row < ML ? xa + (size_t)row * DM : xb + (size_t)(row - ML) * DM;
#pragma unroll
                for (int j = 0; j < 4; ++j) v[q][j] = *(const f32x4*)(src + 4 * lane + 256 * j); } }
#pragma unroll
        for (int q = 0; q < 4; ++q) { const int row = row0 + q * NGW;
            if (row < MT) {
#pragma unroll
                for (int j = 0; j < 4; ++j) ss[q] += (v[q][j].x * v[q][j].x + v[q][j].y * v[q][j].y) + (v[q][j].z * v[q][j].z + v[q][j].w * v[q][j].w); } }
#pragma unroll
        for (int o = 1; o < 64; o <<= 1) {
#pragma unroll
            for (int q = 0; q < 4; ++q) ss[q] += __shfl_xor(ss[q], o); }
#pragma unroll
        for (int q = 0; q < 4; ++q) { const int row = row0 + q * NGW;
            if (row < MT) { const int r = row < SEQ ? 0 : (row < ML ? 1 : 2); const float rinv = rsqrtf(ss[q] * (1.f / DM) + EPS);
#pragma unroll
                for (int j = 0; j < 4; ++j) { const int cidx = 4 * lane + 256 * j; const f32x4 w = *(const f32x4*)(nw + cidx);
                    const f32x4 sh = *(const f32x4*)(mod + (size_t)r * 3072 + cidx), scl = *(const f32x4*)(mod + (size_t)r * 3072 + 1024 + cidx);
                    const f32x4 h = (v[q][j] * rinv) * w * (scl + 1.f) + sh;
                    u32x2 o; o.x = pk2(h.x, h.y); o.y = pk2(h.z, h.w); *(u32x2*)(H + (size_t)row * DM + cidx) = o; } } }
    }
}

DEVI float sq4f(const f32x4 v) { return (v[0] * v[0] + v[1] * v[1]) + (v[2] * v[2] + v[3] * v[3]); }
DEVI void phase1_extras(const float* nw1, const float* mod1, const bf16_t* Win1t, float* nwm1, float* bias1, const float* ctx, float* X1c, int gw, int NGW, int lane) {
    for (int p = gw; p < N_IN1P; p += NGW) {
        const u32x4 w0 = *(const u32x4*)(Win1t + (size_t)p * DM + lane * 16), w1 = *(const u32x4*)(Win1t + (size_t)p * DM + lane * 16 + 8); float acc3[3];
#pragma unroll
        for (int r = 0; r < 3; ++r) { const float* mp = mod1 + (size_t)r * 3072 + lane * 16; const f32x4 m0 = *(const f32x4*)mp, m1 = *(const f32x4*)(mp + 4), m2 = *(const f32x4*)(mp + 8), m3 = *(const f32x4*)(mp + 12);
            const float mm[16] = {m0[0], m0[1], m0[2], m0[3], m1[0], m1[1], m1[2], m1[3], m2[0], m2[1], m2[2], m2[3], m3[0], m3[1], m3[2], m3[3]}; float a = 0.f;
#pragma unroll
            for (int i = 0; i < 8; ++i) { const unsigned ww = i < 4 ? w0[i] : w1[i - 4]; a += mm[2 * i] * __uint_as_float(ww << 16) + mm[2 * i + 1] * __uint_as_float(ww & 0xffff0000u); }
            acc3[r] = wave_sum(a); }
        if (lane == 0) { bias1[p] = acc3[0]; bias1[N_IN1P + p] = acc3[1]; bias1[2 * N_IN1P + p] = acc3[2]; }
    }
    for (int i = gw * 64 + lane; i < 3 * DM; i += NGW * 64) { const int r = i >> 10, c = i & 1023; nwm1[i] = nw1[c] * (1.f + mod1[(size_t)r * 3072 + 1024 + c]); }
}
DEVI void phase_ctxprep(const float* ctx, const float* slab, const float* gatec, float* X1c, const float* nwm1, bf16_t* H, const float* SSX, float* RINV, int gw, int NGW, int lane) {
    for (int rr = gw; rr < MC; rr += NGW) { const int R = ML + rr; float ss = 0.f;
#pragma unroll
        for (int j = 0; j < 4; ++j) { const int c = 4 * lane + 256 * j; f32x4 y = *(const f32x4*)(slab + (size_t)rr * DM + c);
#pragma unroll
            for (int ks = 1; ks < 8; ++ks) y = y + *(const f32x4*)(slab + ((size_t)ks * MC + rr) * DM + c);
            const f32x4 v = *(const f32x4*)(ctx + (size_t)rr * DM + c) + *(const f32x4*)(gatec + c) * y; *(f32x4*)(X1c + (size_t)rr * DM + c) = v;
            ss += sq4f(v); const f32x4 h = v * *(const f32x4*)(nwm1 + 2 * DM + c);
            u32x2 o; o.x = pk2(h.x, h.y); o.y = pk2(h.z, h.w); *(u32x2*)(H + (size_t)R * DM + c) = o; }
        ss = wave_sum(ss); if (lane == 0) RINV[R] = rsqrtf(ss * (1.f / DM) + EPS); }
    for (int R = gw * 64 + lane; R < ML; R += NGW * 64) { const f32x4 s0 = *(const f32x4*)(SSX + (size_t)R * 16), s1 = *(const f32x4*)(SSX + (size_t)R * 16 + 4), s2 = *(const f32x4*)(SSX + (size_t)R * 16 + 8), s3 = *(const f32x4*)(SSX + (size_t)R * 16 + 12);
        const f32x4 st = (s0 + s1) + (s2 + s3); RINV[R] = rsqrtf(((st[0] + st[1]) + (st[2] + st[3])) * (1.f / DM) + EPS); }
}

#ifdef MK_UBENCH
DEVI void ubench(int wave) {
    typedef int v8i __attribute__((ext_vector_type(8)));
    if ((MK_UBENCH & 4) && wave >= 4) return;
    v8i a, b; f32x16 acc = f32x16{}; float e[8]; float d = 0.f;
#pragma unroll
    for (int i = 0; i < 8; ++i) { a[i] = 0x38383838; b[i] = 0x38383838; e[i] = 0.001f * (float)(i + 1); }
    asm volatile("" : "+v"(a), "+v"(b));
    bf16x8 ha, hb; asm volatile("" : "=v"(ha), "=v"(hb));
    for (int it = 0; it < 1500; ++it) {
        if (MK_UBENCH & 1) { if (MK_UBENCH & 16) { acc = __builtin_amdgcn_mfma_f32_32x32x16_bf16(ha, hb, acc, 0, 0, 0); acc = __builtin_amdgcn_mfma_f32_32x32x16_bf16(ha, hb, acc, 0, 0, 0); }
                             else if (MK_UBENCH & 32) acc = __builtin_amdgcn_mfma_scale_f32_32x32x64_f8f6f4(a, b, acc, 4, 2, 0, 127, 0, 127);
                             else if (MK_UBENCH & 64) acc = __builtin_amdgcn_mfma_scale_f32_32x32x64_f8f6f4(a, b, acc, 4, 4, 0, 127, 0, 127);
                             else acc = __builtin_amdgcn_mfma_scale_f32_32x32x64_f8f6f4(a, b, acc, 0, 0, 0, 127, 0, 127); }
        if (MK_UBENCH & 2) {
#pragma unroll
            for (int i = 0; i < 8; ++i) e[i] = __builtin_amdgcn_exp2f(e[i]) * 0.5f; }
        if (MK_UBENCH & 8) {
#pragma unroll
            for (int i = 0; i < 16; ++i) asm volatile("v_add_f32 %0, %0, %1" : "+v"(e[i & 7]) : "v"(d)); }
        asm volatile("" : "+v"(acc)); __builtin_amdgcn_sched_barrier(0);
    }
#pragma unroll
    for (int i = 0; i < 8; ++i) asm volatile("" :: "v"(e[i]));
    asm volatile("" :: "v"(acc));
}
#endif
__global__ void __launch_bounds__(NTHREADS, 2) mega(Args a) {
    extern __shared__ __attribute__((aligned(16))) unsigned char lds[];
    const int tid = threadIdx.x, lane = tid & 63; const int wave = __builtin_amdgcn_readfirstlane(tid >> 6);
    const int G = gridDim.x, bx = blockIdx.x; const int vcu = (G % 8 == 0) ? (bx % 8) * (G / 8) + bx / 8 : bx;
    unsigned char* ws = a.ws; float* out = a.out;
    const float* x = a.in[0]; const float* ctx = a.in[2];
    float* mod = (float*)(ws + WS_MOD); const f32x4* tabA = (const f32x4*)(ws + WS_TABA); const f32x4* tabB = (const f32x4*)(ws + WS_TABB);
    bf16_t* H = (bf16_t*)(ws + WS_H); bf16_t* Qb = (bf16_t*)(ws + WS_Q); bf16_t* K0 = (bf16_t*)(ws + WS_K); bf16_t* V0 = (bf16_t*)(ws + WS_V0); bf16_t* K1 = (bf16_t*)(ws + WS_K);
    bf16_t* Gb = (bf16_t*)(ws + WS_G); bf16_t* V1 = (bf16_t*)(ws + WS_V1); bf16_t* KVA = (bf16_t*)(ws + WS_KVA); bf16_t* QA = (bf16_t*)(ws + WS_QA); bf16_t* Q1R = (bf16_t*)(ws + WS_Q1R);
    bf16_t* O0 = (bf16_t*)(ws + WS_V1); bf16_t* O1 = (bf16_t*)(ws + WS_H); bf16_t* KR = (bf16_t*)(ws + WS_KR); float* SSKV = (float*)(ws + WS_SSKV); float* SSQ = (float*)(ws + WS_SSQ); float* SSH = (float*)(ws + WS_SSH); float* X1c = (float*)(ws + WS_X1C); float* SSX = (float*)(ws + WS_SSX); float* BIAS1 = (float*)(ws + WS_BIAS1); float* NWM1 = (float*)(ws + WS_NWM1);
#ifdef MK_TS
#define MK_TS_SEAM (MK_TS >= 100 ? (MK_TS % 100) : MK_TS / 2)
#define MK_TS_WHAT (MK_TS % 2)
#endif
#ifdef MK_TS_SEAM
    const unsigned long long ts0 = __builtin_amdgcn_s_memrealtime(); unsigned long long ts1 = ts0, ts2 = ts0;
#endif
    const int lo = a.ph_lo, hi_ = a.ph_hi;
#ifndef ONLY_PHASE
#define ONLY_PHASE -1
#endif
#define IN(k) ((ONLY_PHASE < 0 || ONLY_PHASE == (k)) && lo <= (k) && (k) < hi_)
#ifndef MK_REP_MASK
#define MK_REP_MASK 0
#endif
#define REPS(k) (((MK_REP_MASK >> (k)) & 1) ? 2 : 1)
#ifdef MK_TS_SEAM
#define SEAM(k) do { if (IN(k) && IN((k) + 1)) { if ((k) == MK_TS_SEAM) { ts1 = __builtin_amdgcn_s_memrealtime(); if (tid == 0) { atomicMax((unsigned*)ws + 4000, (unsigned)(ts1 - ts0)); atomicMax((unsigned*)ws + 4001, ((unsigned)(ts1 - ts0) << 10) | (unsigned)bx); } } xcd_barrier(xbar); if ((k) == MK_TS_SEAM) ts2 = __builtin_amdgcn_s_memrealtime(); } } while (0)
#else
#define SEAM(k) do { if (IN(k) && IN((k) + 1)) { xcd_barrier(xbar); } } while (0)
#endif
    PG8_LAS unsigned char* ring = (PG8_LAS unsigned char*)lds;
    volatile LAS unsigned* xst = (volatile LAS unsigned*)((LAS unsigned char*)lds + RING_BYTES + 512);
    if (tid < 4) xst[tid] = 0u;
    __syncthreads();
    XcdBarrier xbar; xbar.bar = (unsigned*)ws; xbar.x = 0; xbar.st = xst;
    if (a.coop) xbar = xcd_barrier_post((unsigned*)ws, xst);
    if (a.coop == 0x7fffffff) cg::this_grid().sync();

    if (IN(0)) for (int rep_ = 0; rep_ < REPS(0); ++rep_) { phase0(a, ws, (LAS unsigned char*)lds, bx, G); } SEAM(0);
    if (IN(1)) for (int rep_ = 0; rep_ < REPS(1); ++rep_) { phase1_extras(a.in[13], mod + 3 * 3072, (const bf16_t*)(ws + WS_WIN1), NWM1, BIAS1, ctx, X1c, vcu * NWAVES + wave, G * NWAVES, lane);
        phase_prep(x, ctx, a.in[6], mod, H, vcu * NWAVES + wave, G * NWAVES, lane); } SEAM(1);
    if (IN(2)) { pg8::Gemm g{H, (const bf16_t*)(ws + WS_WIN0), MT, N_IN0, 1024}; pg8::ROrder S; S.init(0, MT / 256, N_IN0, G, bx, REPS(2));
        pg8::EpiIn0<ATT0_F8> E{a.in[8], a.in[9], tabA, K0, V0, Qb, Gb};
        pg8::gemm_phase<pg8::EpiIn0<ATT0_F8>, pg8::ROrder, true, true>(ring, g, S, E); } SEAM(2);
#ifdef MK_UNIT_PROBE
    unsigned long long upacc = 0, updummy = 0;
#define UPROBE_ARG3 , *((MK_UNIT_PROBE & 48) == 0 ? &upacc : &updummy)
#define UPROBE_ARGC , *((MK_UNIT_PROBE & 48) == 32 ? &upacc : &updummy)
#define UPROBE_ARG8 , *((MK_UNIT_PROBE & 48) == 16 ? &upacc : &updummy)
#else
#define UPROBE_ARG3
#define UPROBE_ARGC
#define UPROBE_ARG8
#endif
#ifdef MK_CLOCK_PROBE
    unsigned long long pc0 = 0, pr0 = 0, pc1 = 0, pr1 = 0;
    if (IN(3)) { pc0 = __builtin_readcyclecounter(); pr0 = __builtin_amdgcn_s_memrealtime(); }
#endif
    if (IN(3)) for (int rep_ = 0; rep_ < REPS(3); ++rep_) {
        const int xg = vcu >> 5, c = vcu & 31, b = xg >> 2, kvh = xg & 3; const size_t kbase = (size_t)b * TK * 256 + kvh * 64;
#ifdef MK_PROBE_NT
        const int NT3 = (rep_ + 1 < REPS(3)) ? MK_PROBE_NT : TK / 64;
#else
        const int NT3 = TK / 64;
#endif
#if ATT0_F8
        const unsigned char* K8 = (const unsigned char*)K0 + (size_t)b * TK * 128 + kvh * 32; const unsigned char* V8 = (const unsigned char*)V0 + kbase;
        for (int i = 0; i < 4; ++i) { const int h = kvh * 4 + i; const size_t q0 = ((size_t)b * SEQ + c * 256) * DM + h * 64;
            af8::attn_unit<0>(Qb + q0, DM, nullptr, nullptr, K8, 128, nullptr, V8, 256, NT3, O0 + q0, Gb + q0, DM, (char*)lds UPROBE_ARG3); }
        if (c < 4) { const int h = kvh * 4 + c; const size_t q0 = ((size_t)ML + b * CTXL) * DM + h * 64;
            af8::attn_unit<0>(Qb + q0, DM, nullptr, nullptr, K8, 128, nullptr, V8, 256, CTXL / 64, O0 + q0, Gb + q0, DM, (char*)lds UPROBE_ARGC); }
#else
        for (int i = 0; i < 4; ++i) { const int h = kvh * 4 + i; const size_t q0 = ((size_t)b * SEQ + c * 256) * DM + h * 64;
            afast::attn_unit<0>(Qb + q0, DM, nullptr, nullptr, K0 + kbase, 256, nullptr, V0 + kbase, 256, TK / 64, O0 + q0, Gb + q0, DM, (char*)lds); }
        if (c < 4) { const int h = kvh * 4 + c; const size_t q0 = ((size_t)ML + b * CTXL) * DM + h * 64;
            afast::attn_unit<0>(Qb + q0, DM, nullptr, nullptr, K0 + kbase, 256, nullptr, V0 + kbase, 256, CTXL / 64, O0 + q0, Gb + q0, DM, (char*)lds); }
#endif
    } SEAM(3);
#ifdef MK_CLOCK_PROBE
    if (IN(3)) { pc1 = __builtin_readcyclecounter(); pr1 = __builtin_amdgcn_s_memrealtime(); }
#endif
    if (IN(4)) {
        { pg8::Gemm g{O0, (const bf16_t*)(ws + WS_WOUT0), ML, 1024, 1024, 0}; pg8::ROrder S; S.init(0, ML / 256, 1024, G, bx, REPS(4));
          pg8::EpiOutF E{x, out, mod + 2048, NWM1, H, SSX};
          pg8::gemm_phase<pg8::EpiOutF, pg8::ROrder, true, true>(ring, g, S, E); }
        { pg8::Gemm g{O0, (const bf16_t*)(ws + WS_WOUT0), MT, 1024, 1024, 128}; pg8::CtxSplitOrder S; S.init(bx, 8, 128);
          pg8::EpiOutSlab E{(float*)(ws + WS_SLAB), 128};
          pg8::gemm_phase<pg8::EpiOutSlab, pg8::CtxSplitOrder, true, true>(ring, g, S, E); }
    } SEAM(4);
    if (IN(5)) { phase_ctxprep(ctx, (const float*)(ws + WS_SLAB), mod + 2048 + 2 * 3072, X1c, NWM1, H, SSX, (float*)(ws + WS_RINV), vcu * NWAVES + wave, G * NWAVES, lane); } SEAM(5);
    if (IN(6)) { pg8::Gemm g{H, (const bf16_t*)(ws + WS_WIN1), MT, N_IN1P, 1024}; pg8::In1Order S; S.init(G, bx);
        pg8::EpiIn1<ATT1_F8> E{a.in[21], tabB, KVA, SSKV, QA, SSQ, KR, Gb, (const float*)(ws + WS_RINV), BIAS1};
        pg8::gemm_phase<pg8::EpiIn1<ATT1_F8>, pg8::In1Order, true, true>(ring, g, S, E); } SEAM(6);
    if (IN(7)) {
        { pg8::Gemm g{KVA, (const bf16_t*)(ws + WS_WKVB), MT, 2048, 256}; pg8::ROrder S; S.init(0, MT / 256, 2048, G, bx, REPS(7));
          pg8::EpiKvb<ATT1_F8> E{SSKV, a.in[20], K1, V1};
          pg8::gemm_phase<pg8::EpiKvb<ATT1_F8>, pg8::ROrder, true, true>(ring, g, S, E); }
        { pg8::Gemm g{QA, (const bf16_t*)(ws + WS_WQB), ML, 2048, 384}; pg8::ROrder S; S.init(0, ML / 256, 2048, G, bx, REPS(7));
          pg8::EpiQb E{SSQ, a.in[19], tabB, Qb, Q1R, SSH};
          pg8::gemm_phase<pg8::EpiQb, pg8::ROrder, true, true>(ring, g, S, E); }
    } SEAM(7);
    if (IN(8)) for (int rep_ = 0; rep_ < REPS(8); ++rep_) {
        const int xg = vcu >> 5, c = vcu & 31;
        for (int i = 0; i < 4; ++i) { const int s = xg + 8 * i, b = s >> 4, h = s & 15; const size_t row0 = (size_t)b * SEQ + c * 256, q0 = row0 * DM + h * 64;
#if ATT1_F8
            af8::attn_unit<1>(Qb + q0, DM, Q1R + row0 * 512 + h * 32, SSH + (row0 * 16 + h) * 2, (const unsigned char*)K1 + (size_t)b * TK * 512 + h * 32, 512, (const unsigned char*)KR + (size_t)b * TK * 16,
                              (const unsigned char*)V1 + (size_t)b * TK * DM + h * 64, DM, TK / 64, O1 + q0, Gb + q0, DM, (char*)lds UPROBE_ARG8); }
#else
            afast::attn_unit<1>(Qb + q0, DM, Q1R + row0 * 512 + h * 32, SSH + (row0 * 16 + h) * 2, K1 + (size_t)b * TK * DM + h * 64, DM, KR + (size_t)b * TK * 32,
                                V1 + (size_t)b * TK * DM + h * 64, DM, TK / 64, O1 + q0, Gb + q0, DM, (char*)lds); }
#endif
    } SEAM(8);
    if (IN(9)) { pg8::Gemm g{O1, (const bf16_t*)(ws + WS_WOUT1), ML, 1024, 1024}; pg8::ROrder S; S.init(0, ML / 256, 1024, G, bx);
        pg8::EpiOut E{out, nullptr, out, nullptr, mod + 3 * 3072 + 2048};
        pg8::gemm_phase<pg8::EpiOut, pg8::ROrder, true, true>(ring, g, S, E); }
#ifdef MK_TS_SEAM
    if (bx == 0 && wave == 0) { const unsigned long long tend_ = __builtin_amdgcn_s_memrealtime(); const unsigned long long w = MK_TS == 99 ? (tend_ - ts0) : MK_TS >= 100 ? (MK_TS >= 200 ? (unsigned long long)(((unsigned*)ws)[4001] & 1023u) * 100ull : (unsigned long long)((unsigned*)ws)[4000]) : (MK_TS_WHAT ? (ts2 - ts1) * 10ull : (ts1 - ts0)); const unsigned long long t0 = __builtin_amdgcn_s_memrealtime(); while (__builtin_amdgcn_s_memrealtime() - t0 < w) __builtin_amdgcn_s_sleep(8); }
#endif
#ifdef MK_UBENCH
    ubench(wave);
#endif
#ifdef MK_UNIT_PROBE
    if (bx == 0 && wave == 0) { const unsigned long long t0 = __builtin_amdgcn_s_memrealtime(); const unsigned long long w = upacc * 10ull; (void)updummy; while (__builtin_amdgcn_s_memrealtime() - t0 < w) __builtin_amdgcn_s_sleep(8); }
#endif
#ifdef MK_CLOCK_PROBE
    if (bx == 0 && wave == 0) { const unsigned long long dc = pc1 - pc0, dr = pr1 - pr0;
        const unsigned long long mhz = dr ? (dc * 100ull) / dr : 0ull;
        const unsigned long long t0 = __builtin_amdgcn_s_memrealtime(); const unsigned long long wait_ticks = mhz * 10ull;
        while (__builtin_amdgcn_s_memrealtime() - t0 < wait_ticks) __builtin_amdgcn_s_sleep(8); }
#endif
#undef IN
#undef SEAM
}

constexpr int NPHASE = 10;
#ifndef MK_ONE_LAUNCH
#define MK_ONE_LAUNCH 1
#endif
extern "C" void kernel_launch(void* const* d_in, const int* in_sizes, int n_in, void* d_out, int out_size, void* d_ws, size_t ws_size, hipStream_t stream) {
    static int grid = 0;
    if (grid == 0) {
        if (n_in != 23 || out_size != ML * DM || ws_size < WS_END) { fprintf(stderr, "kernel_launch: unexpected shapes n_in %d out %d ws %zu\n", n_in, out_size, ws_size); grid = -1; return; }
        int dev = 0, cus = 0, per_cu = 0;
        if (hipGetDevice(&dev) != hipSuccess || hipDeviceGetAttribute(&cus, hipDeviceAttributeMultiprocessorCount, dev) != hipSuccess) { grid = -1; return; }
        if (hipFuncSetAttribute((const void*)mega, hipFuncAttributeMaxDynamicSharedMemorySize, LDS_BYTES) != hipSuccess) { fprintf(stderr, "kernel_launch: hipFuncSetAttribute failed\n"); grid = -1; return; }
        if (hipOccupancyMaxActiveBlocksPerMultiprocessor(&per_cu, (const void*)mega, NTHREADS, LDS_BYTES) != hipSuccess || per_cu < 1) { fprintf(stderr, "kernel_launch: occupancy query says %d\n", per_cu); grid = -1; return; }
        grid = cus;
        if (grid != 256) fprintf(stderr, "kernel_launch: %d CUs (built for 256)\n", grid);
    }
    if (grid < 0) return;
    if (hipMemsetAsync(d_ws, 0, 16384, stream) != hipSuccess) { fprintf(stderr, "kernel_launch: memset failed\n"); return; }
    Args a{};
    for (int i = 0; i < 23; ++i) a.in[i] = (const float*)d_in[i];
    a.out = (float*)d_out; a.ws = (unsigned char*)d_ws;
#if MK_ONE_LAUNCH
    a.ph_lo = 0; a.ph_hi = NPHASE; a.coop = 1;
    void* args[] = {&a};
#ifdef MK_PLAIN_LAUNCH
    (void)args; hipLaunchKernelGGL(mega, dim3(grid), dim3(NTHREADS), LDS_BYTES, stream, a);
#else
    const hipError_t e = hipLaunchCooperativeKernel((const void*)mega, dim3(grid), dim3(NTHREADS), args, LDS_BYTES, stream);
    if (e != hipSuccess) fprintf(stderr, "kernel_launch: cooperative launch failed: %s (grid %d)\n", hipGetErrorString(e), grid);
#endif
#else
    for (int p = 0; p < NPHASE; ++p) { a.ph_lo = p; a.ph_hi = p + 1; a.coop = 0; hipLaunchKernelGGL(mega, dim3(grid), dim3(NTHREADS), LDS_BYTES, stream, a); }
    const hipError_t le = hipPeekAtLastError();
    if (le != hipSuccess) fprintf(stderr, "kernel_launch: launch failed: %s\n", hipGetErrorName(le));
#endif
}
```

```cpp
#include <hip/hip_runtime.h>
#include <hip/hip_bf16.h>
#include <cstdio>
#include <cstdint>

#define DEVI __device__ __forceinline__
#define LAS __attribute__((address_space(3)))
#define GAS __attribute__((address_space(1)))

constexpr int NB = 2, SEQ = 8192, DM = 1024, CTXL = 256, TK = SEQ + CTXL;
constexpr int ML = NB * SEQ, MC = NB * CTXL, MT = ML + MC;
constexpr int GRIDW = 64;
constexpr float EPS = 1e-6f;
constexpr float LOG2E = 1.4426950408889634f;
constexpr int N_IN0 = 2560, N_IN1 = 1696, N_IN1P = 1792;
constexpr float C2_GQA = 0.125f * LOG2E;
constexpr float C2_MLA = 0.10206207261596575f * LOG2E;

typedef unsigned short bf16_t;
typedef short bf16x8 __attribute__((ext_vector_type(8)));
typedef short s16x4 __attribute__((ext_vector_type(4)));
typedef float f32x4 __attribute__((ext_vector_type(4)));
typedef float f32x2 __attribute__((ext_vector_type(2)));
typedef float f32x16 __attribute__((ext_vector_type(16)));
typedef unsigned u32x4 __attribute__((ext_vector_type(4)));
typedef unsigned u32x2 __attribute__((ext_vector_type(2)));

DEVI float bf2f(bf16_t v) { return __uint_as_float((unsigned)v << 16); }
DEVI unsigned f2bf(float f) { unsigned u = __float_as_uint(f); return (u + 0x7fffu + ((u >> 16) & 1u)) >> 16; }
DEVI unsigned pk2(float lo, float hi) { return f2bf(lo) | (f2bf(hi) << 16); }
DEVI float wave_sum(float v) {
#pragma unroll
    for (int o = 1; o < 64; o <<= 1) v += __shfl_xor(v, o);
    return v;
}
DEVI float silu_f(float v) { return v / (1.f + __expf(-v)); }
namespace pg8 {
#define PG8_LAS __attribute__((address_space(3)))
typedef unsigned short bf16_t;
typedef short bf16x8 __attribute__((ext_vector_type(8)));
typedef float f32x4 __attribute__((ext_vector_type(4)));
typedef unsigned u32x4 __attribute__((ext_vector_type(4)));
constexpr int BM = 256, BK = 64, HALF = 128, HTB = HALF * BK * 2  , STAGE_BYTES = 8 * HTB, NXCD = 8, WGM = 8;

__host__ __device__ __forceinline__ int lds_byte(int r, int c) { const int st = (r >> 4) * 2 + (c >> 5), rr = r & 15, cc = c & 31, ob = rr * 64 + cc * 2; return st * 1024 + (ob ^ (((ob >> 9) & 1) << 5)); }
__host__ __device__ __forceinline__ void stage_rc(int b, int& R, int& C) { const int st = b / 1024, sb = b % 1024, swz = sb ^ (((sb >> 9) & 1) << 5); R = (st >> 1) * 16 + swz / 64; C = (st & 1) * 32 + (swz % 64) / 2; }
__host__ __device__ __forceinline__ int perm32(int rho) { const int n = rho >> 4, i = rho & 15; return 8 * (i >> 2) + 4 * n + (i & 3); }

struct Unit { int pm, pn, ko; };
struct Gemm { const bf16_t* A; const bf16_t* Bt; int M, N, K, Kloop; };

struct StaticOrder {
    int nM, nN, nwg, G, c;
    __host__ __device__ void init(int M, int N, int G_, int c_) { nM = M / BM; nN = N / BM; nwg = nM * nN; G = G_; c = c_; }
    __host__ __device__ bool next(int i, Unit& u) const {
        const long L = (long)i * G + c; if (L >= nwg) return false;
        int wgid = (int)L; { const int q = nwg / NXCD, r = nwg % NXCD, xcd = wgid % NXCD, off = wgid / NXCD; wgid = (xcd < r ? xcd * (q + 1) : r * (q + 1) + (xcd - r) * q) + off; }
        const int nig = WGM * nN, gid = wgid / nig, fm = gid * WGM, gsz = (nM - fm) < WGM ? (nM - fm) : WGM;
        u.pm = fm + ((wgid % nig) % gsz); u.pn = (wgid % nig) / gsz; u.ko = 0; return true;
    }
    __device__ __forceinline__ void a_ready(const Unit&) const {}
    __device__ __forceinline__ void done(const Unit&) const {}
};


struct ROrder {
    int pm0, nM, nN, nwg, G, c, rep;
    __host__ __device__ void init(int pm0_, int npm, int N, int G_, int c_, int rep_ = 1) { pm0 = pm0_; nM = npm; nN = N / BM; nwg = nM * nN; G = G_; c = c_; rep = rep_; }
    __host__ __device__ bool next(int i, Unit& u) const {
        const long L = (long)i * G + c; if (L >= (long)nwg * rep) return false;
        int wgid = (int)(L % nwg); { const int q = nwg / NXCD, r = nwg % NXCD, xcd = wgid % NXCD, off = wgid / NXCD; wgid = (xcd < r ? xcd * (q + 1) : r * (q + 1) + (xcd - r) * q) + off; }
        const int nig = WGM * nN, gid = wgid / nig, fm = gid * WGM, gsz = (nM - fm) < WGM ? (nM - fm) : WGM;
        u.pm = pm0 + fm + ((wgid % nig) % gsz); u.pn = (wgid % nig) / gsz; u.ko = 0; return true;
    }
    __device__ __forceinline__ void a_ready(const Unit&) const {}
    __device__ __forceinline__ void done(const Unit&) const {}
};

struct EpiF32 {
    static constexpr bool PERM = true, AFTER_DRAIN = false;
    float* O; int ldc; int pmbase;
    __device__ __forceinline__ void operator()(const f32x4 (&acc)[2][2][4][2], const Unit& u, int wr, int wc, int fr, int fq) const {
        const int row0 = (u.pm - pmbase) * BM + wr * 64 + fr, col0 = u.pn * BM + wc * 32 + 8 * fq;
#pragma unroll
        for (int ai = 0; ai < 2; ++ai)
#pragma unroll
            for (int m = 0; m < 4; ++m) { float* rowp = O + (size_t)(row0 + ai * HALF + m * 16) * ldc + col0;
#pragma unroll
                for (int bj = 0; bj < 2; ++bj) { *(f32x4*)(rowp + bj * HALF) = acc[ai][bj][m][0]; *(f32x4*)(rowp + bj * HALF + 4) = acc[ai][bj][m][1]; } }
    }
};

DEVI unsigned cvt_pk_bf16(float lo, float hi) { unsigned r; asm volatile("v_cvt_pk_bf16_f32 %0, %1, %2" : "=v"(r) : "v"(lo), "v"(hi)); return r; }
DEVI u32x4 pack8(const f32x4 a, const f32x4 b) { u32x4 w; w.x = cvt_pk_bf16(a[0], a[1]); w.y = cvt_pk_bf16(a[2], a[3]); w.z = cvt_pk_bf16(b[0], b[1]); w.w = cvt_pk_bf16(b[2], b[3]); return w; }
DEVI u32x2 pack8_fp8(const f32x4 a, const f32x4 b) { int w0 = 0, w1 = 0; w0 = __builtin_amdgcn_cvt_pk_fp8_f32(a[0], a[1], w0, false); w0 = __builtin_amdgcn_cvt_pk_fp8_f32(a[2], a[3], w0, true);
    w1 = __builtin_amdgcn_cvt_pk_fp8_f32(b[0], b[1], w1, false); w1 = __builtin_amdgcn_cvt_pk_fp8_f32(b[2], b[3], w1, true); return (u32x2){(unsigned)w0, (unsigned)w1}; }
DEVI unsigned pack8_fp4(const f32x4 a, const f32x4 b) { unsigned w; asm volatile("" : "=v"(w)); w = __builtin_amdgcn_cvt_scalef32_pk_fp4_f32(w, a[0], a[1], 1.0f, 0); w = __builtin_amdgcn_cvt_scalef32_pk_fp4_f32(w, a[2], a[3], 1.0f, 1);
    w = __builtin_amdgcn_cvt_scalef32_pk_fp4_f32(w, b[0], b[1], 1.0f, 2); w = __builtin_amdgcn_cvt_scalef32_pk_fp4_f32(w, b[2], b[3], 1.0f, 3); return w; }
DEVI float quad_sum(float s) { s += __shfl_xor(s, 16); s += __shfl_xor(s, 32); return s; }
DEVI float sq4(const f32x4 v) { return (v[0] * v[0] + v[1] * v[1]) + (v[2] * v[2] + v[3] * v[3]); }
DEVI f32x4 silu4(const f32x4 v) { f32x4 o; o[0] = silu_f(v[0]); o[1] = silu_f(v[1]); o[2] = silu_f(v[2]); o[3] = silu_f(v[3]); return o; }
DEVI int key_slot(int R) { return R < ML ? (R >> 13) * TK + CTXL + (R & (SEQ - 1)) : ((R - ML) >> 8) * TK + ((R - ML) & 255); }
DEVI void rot4(f32x4& x1, f32x4& x2, const f32x4 cs01, const f32x4 cs23) {
    const f32x4 c = {cs01[0], cs01[2], cs23[0], cs23[2]}, s = {cs01[1], cs01[3], cs23[1], cs23[3]};
    const f32x4 a = x1 * c - x2 * s, b = x2 * c + x1 * s; x1 = a; x2 = b;
}

DEVI int drope32(int i) { const int fq = i >> 3, n = (i >> 2) & 1, j = i & 3; return 16 * (fq >> 1) + 8 * n + 4 * (fq & 1) + j; }
DEVI int wmap(int mode, int p) {
    const int pn = p >> 8, q = p & 255, bj = q >> 7, wc = (q >> 5) & 3, i = q & 31;
    switch (mode) {
    case 1: {
        if (pn == 0 || (pn >= 2 && pn <= 5)) { const int fq = i >> 3, n = (i >> 2) & 1, j = i & 3; return 256 * pn + 64 * wc + 32 * bj + 16 * n + 4 * fq + j; }
        return p; }
    case 2: {
        if (pn == 0) return q;
        if (pn == 1) return 288 + q;
        if (pn == 2) { if (wc < 2) return 288 + 256 + 64 * wc + 32 * bj + i; if (wc == 2 && bj == 0) return 256 + drope32(i); return -1; }
        return 672 + 256 * (pn - 3) + q; }
    case 3: { const int head = 2 * pn + (wc >> 1), type = wc & 1; return 128 * head + 64 * type + 32 * bj + i; }
    case 4: { const int head = 2 * pn + (wc >> 1), type = wc & 1; if (type == 0) return 96 * head + 32 * bj + i; return bj == 0 ? 96 * head + 64 + drope32(i) : -1; }
    default: return p;
    }
}

template <bool F8> struct EpiIn0 {
    static constexpr bool PERM = true, AFTER_DRAIN = false;
    const float* qn; const float* kn; const f32x4* tabA; bf16_t* K0; bf16_t* V0; bf16_t* Q0; bf16_t* G0;
    __device__ __forceinline__ void operator()(const f32x4 (&acc)[2][2][4][2], const Unit& u, int wr, int wc, int fr_, int fq_) const {
        int fr = fr_, fq = fq_; asm volatile("" : "+v"(fr), "+v"(fq));
        const int pn = u.pn; const bool lat = u.pm < ML / BM;
        if (pn == 0 || (pn >= 2 && pn <= 5)) {
            const float* wsrc = pn == 0 ? kn : qn; const float outs = pn == 0 ? (F8 ? 2.f : 1.f) : (F8 ? C2_GQA * 8.f : C2_GQA);
            f32x4 wv[2][2];
#pragma unroll
            for (int bj = 0; bj < 2; ++bj)
#pragma unroll
                for (int n = 0; n < 2; ++n) wv[bj][n] = *(const f32x4*)(wsrc + 32 * bj + 16 * n + 4 * fq) * outs;
#pragma unroll
            for (int ai = 0; ai < 2; ++ai)
#pragma unroll
                for (int m = 0; m < 4; ++m) {
                    const int R = u.pm * BM + ai * HALF + wr * 64 + m * 16 + fr;
                    f32x4 x[2][2]; float ss = 0.f;
#pragma unroll
                    for (int bj = 0; bj < 2; ++bj)
#pragma unroll
                        for (int n = 0; n < 2; ++n) { x[bj][n] = acc[ai][bj][m][n]; ss += sq4(x[bj][n]); }
                    const float rinv = rsqrtf(quad_sum(ss) * (1.f / 64.f) + EPS);
#pragma unroll
                    for (int bj = 0; bj < 2; ++bj)
#pragma unroll
                        for (int n = 0; n < 2; ++n) x[bj][n] = x[bj][n] * rinv * wv[bj][n];
                    if (lat) { const int t = R & (SEQ - 1), trow = t >> 6, tcol = t & 63;
                        const f32x4* tr = tabA + (trow * 16 + 4 * fq) / 2; const f32x4* tc = tabA + (tcol * 16 + 4 * fq) / 2;
                        rot4(x[0][0], x[0][1], tr[0], tr[1]); rot4(x[1][0], x[1][1], tc[0], tc[1]); }
                    if (F8 && pn == 0) { unsigned char* dst = (unsigned char*)K0 + (size_t)key_slot(R) * 128 + wc * 32 + 4 * fq;
                        *(unsigned*)dst = pack8_fp4(x[0][0], x[0][1]); *(unsigned*)(dst + 16) = pack8_fp4(x[1][0], x[1][1]); }
                    else if (pn == 0) { bf16_t* dst = K0 + (size_t)key_slot(R) * 256 + wc * 64 + 8 * fq;
                        *(u32x4*)dst = pack8(x[0][0], x[0][1]); *(u32x4*)(dst + 32) = pack8(x[1][0], x[1][1]); }
                    else { bf16_t* dst = Q0 + (size_t)R * DM + ((pn - 2) * 4 + wc) * 64 + 8 * fq;
                        *(u32x4*)dst = pack8(x[0][0], x[0][1]); *(u32x4*)(dst + 32) = pack8(x[1][0], x[1][1]); }
                }
        } else if (pn == 1) {
#pragma unroll
            for (int ai = 0; ai < 2; ++ai)
#pragma unroll
                for (int m = 0; m < 4; ++m) { const int R = u.pm * BM + ai * HALF + wr * 64 + m * 16 + fr;
                    if (F8) { unsigned char* dst = (unsigned char*)V0 + (size_t)key_slot(R) * 256 + wc * 32 + 8 * fq;
#pragma unroll
                        for (int bj = 0; bj < 2; ++bj) *(u32x2*)(dst + bj * HALF) = pack8_fp8(acc[ai][bj][m][0], acc[ai][bj][m][1]); }
                    else { bf16_t* dst = V0 + (size_t)key_slot(R) * 256 + wc * 32 + 8 * fq;
#pragma unroll
                        for (int bj = 0; bj < 2; ++bj) *(u32x4*)(dst + bj * HALF) = pack8(acc[ai][bj][m][0], acc[ai][bj][m][1]); } }
        } else {
#pragma unroll
            for (int ai = 0; ai < 2; ++ai)
#pragma unroll
                for (int m = 0; m < 4; ++m) { const int R = u.pm * BM + ai * HALF + wr * 64 + m * 16 + fr; bf16_t* dst = G0 + (size_t)R * DM + (pn - 6) * BM + wc * 32 + 8 * fq;
#pragma unroll
                    for (int bj = 0; bj < 2; ++bj) *(u32x4*)(dst + bj * HALF) = pack8(silu4(acc[ai][bj][m][0]), silu4(acc[ai][bj][m][1])); }
        }
    }
};

struct EpiOut {
    static constexpr bool PERM = true, AFTER_DRAIN = false;
    const float* baseL; const float* baseC; float* dstL; float* dstC; const float* gate;
    __device__ __forceinline__ void operator()(const f32x4 (&acc)[2][2][4][2], const Unit& u, int wr, int wc, int fr_, int fq_) const {
        int fr = fr_, fq = fq_; asm volatile("" : "+v"(fr), "+v"(fq));
        const int col0 = u.pn * BM + wc * 32 + 8 * fq;
#pragma unroll
        for (int ai = 0; ai < 2; ++ai)
#pragma unroll
            for (int m = 0; m < 4; ++m) { const int R = u.pm * BM + ai * HALF + wr * 64 + m * 16 + fr; const int r = R < SEQ ? 0 : (R < ML ? 1 : 2);
                const float* b = R < ML ? baseL + (size_t)R * DM : baseC + (size_t)(R - ML) * DM; float* d = R < ML ? dstL + (size_t)R * DM : dstC + (size_t)(R - ML) * DM;
                const float* g = gate + (size_t)r * 3072;
#pragma unroll
                for (int bj = 0; bj < 2; ++bj)
#pragma unroll
                    for (int n = 0; n < 2; ++n) { const int c = col0 + bj * HALF + 4 * n; *(f32x4*)(d + c) = *(const f32x4*)(b + c) + *(const f32x4*)(g + c) * acc[ai][bj][m][n]; } }
    }
};

struct EpiOutF {
    static constexpr bool PERM = true, AFTER_DRAIN = false;
    const float* base; float* dst; const float* gate; const float* nwm; bf16_t* Hn; float* SSX;
    __device__ __forceinline__ void operator()(const f32x4 (&acc)[2][2][4][2], const Unit& u, int wr, int wc, int fr_, int fq_) const {
        int fr = fr_, fq = fq_; asm volatile("" : "+v"(fr), "+v"(fq));
        const int col0 = u.pn * BM + wc * 32 + 8 * fq;
#pragma unroll
        for (int ai = 0; ai < 2; ++ai)
#pragma unroll
            for (int m = 0; m < 4; ++m) { const int R = u.pm * BM + ai * HALF + wr * 64 + m * 16 + fr; const int r = R < SEQ ? 0 : 1;
                asm volatile("" ::: "memory");
                const float* b = base + (size_t)R * DM; float* d = dst + (size_t)R * DM; const float* g = gate + (size_t)r * 3072; const float* nw = nwm + (size_t)r * 1024; float ss = 0.f;
#pragma unroll
                for (int bj = 0; bj < 2; ++bj) { const int c = col0 + bj * HALF;
                    const f32x4 x0 = *(const f32x4*)(b + c) + *(const f32x4*)(g + c) * acc[ai][bj][m][0], x1 = *(const f32x4*)(b + c + 4) + *(const f32x4*)(g + c + 4) * acc[ai][bj][m][1];
                    *(f32x4*)(d + c) = x0; *(f32x4*)(d + c + 4) = x1; ss += sq4(x0) + sq4(x1);
                    *(u32x4*)(Hn + (size_t)R * DM + c) = pack8(x0 * *(const f32x4*)(nw + c), x1 * *(const f32x4*)(nw + c + 4)); }
                ss = quad_sum(ss); if (fq == 0) SSX[(size_t)R * 16 + u.pn * 4 + wc] = ss; }
    }
};
struct EpiOutSlab {
    static constexpr bool PERM = true, AFTER_DRAIN = false;
    float* slab; int klen;
    __device__ __forceinline__ void operator()(const f32x4 (&acc)[2][2][4][2], const Unit& u, int wr, int wc, int fr_, int fq_) const {
        int fr = fr_, fq = fq_; asm volatile("" : "+v"(fr), "+v"(fq));
        const int col0 = u.pn * BM + wc * 32 + 8 * fq; float* sb = slab + (size_t)(u.ko / klen) * MC * DM;
#pragma unroll
        for (int ai = 0; ai < 2; ++ai)
#pragma unroll
            for (int m = 0; m < 4; ++m) { const int R = u.pm * BM + ai * HALF + wr * 64 + m * 16 + fr; float* d = sb + (size_t)(R - ML) * DM + col0;
#pragma unroll
                for (int bj = 0; bj < 2; ++bj) { *(f32x4*)(d + bj * HALF) = acc[ai][bj][m][0]; *(f32x4*)(d + bj * HALF + 4) = acc[ai][bj][m][1]; } }
    }
};
struct CtxSplitOrder {
    int c, KS, klen;
    __host__ __device__ void init(int c_, int KS_, int klen_) { c = c_; KS = KS_; klen = klen_; }
    __host__ __device__ bool next(int i, Unit& u) const { if (i > 0 || c >= 8 * KS) return false; const int t = c / KS; u.pm = ML / BM + (t >> 2); u.pn = t & 3; u.ko = (c % KS) * klen; return true; }
    __device__ __forceinline__ void a_ready(const Unit&) const {}
    __device__ __forceinline__ void done(const Unit&) const {}
};

template <bool F8> struct EpiIn1 {
    static constexpr bool PERM = true, AFTER_DRAIN = false;
    const float* krn; const f32x4* tabB; bf16_t* KVA; float* SSKV; bf16_t* QA; float* SSQ; bf16_t* KR; bf16_t* G1; const float* SSX; const float* bias;
    __device__ __forceinline__ void xrow(const f32x4 (&acc)[2][2][4][2], int ai, int m, int R, int pcol0, f32x4 (&x)[2][2]) const {
        const float rinv = SSX[R];
        const float* bp = bias + (size_t)(R < SEQ ? 0 : (R < ML ? 1 : 2)) * N_IN1P + pcol0;
#pragma unroll
        for (int bj = 0; bj < 2; ++bj)
#pragma unroll
            for (int n = 0; n < 2; ++n) x[bj][n] = acc[ai][bj][m][n] * rinv + *(const f32x4*)(bp + bj * HALF + 4 * n);
    }
    __device__ __forceinline__ void operator()(const f32x4 (&acc)[2][2][4][2], const Unit& u, int wr, int wc, int fr_, int fq_) const {
        int fr = fr_, fq = fq_; asm volatile("" : "+v"(fr), "+v"(fq));
        const int pn = u.pn; const bool lat = u.pm < ML / BM; const int pcol0 = pn * BM + wc * 32 + 8 * fq;
        if (pn >= 3) {
#pragma unroll
            for (int ai = 0; ai < 2; ++ai)
#pragma unroll
                for (int m = 0; m < 4; ++m) { const int R = u.pm * BM + ai * HALF + wr * 64 + m * 16 + fr; bf16_t* dst = G1 + (size_t)R * DM + (pn - 3) * BM + wc * 32 + 8 * fq;
                    asm volatile("" ::: "memory"); f32x4 x[2][2]; xrow(acc, ai, m, R, pcol0, x);
#pragma unroll
                    for (int bj = 0; bj < 2; ++bj) *(u32x4*)(dst + bj * HALF) = pack8(silu4(x[bj][0]), silu4(x[bj][1])); }
        } else if (pn == 2 && wc == 2) {
            f32x4 wv[2];
#pragma unroll
            for (int n = 0; n < 2; ++n) wv[n] = *(const f32x4*)(krn + 16 * (fq >> 1) + 8 * n + 4 * (fq & 1));
#pragma unroll
            for (int ai = 0; ai < 2; ++ai)
#pragma unroll
                for (int m = 0; m < 4; ++m) { const int R = u.pm * BM + ai * HALF + wr * 64 + m * 16 + fr;
                    asm volatile("" ::: "memory"); f32x4 xx[2][2]; xrow(acc, ai, m, R, pcol0, xx); f32x4 x0 = xx[0][0], x1 = xx[0][1];
                    const float rinv = rsqrtf(quad_sum(sq4(x0) + sq4(x1)) * (1.f / 32.f) + EPS);
                    x0 = x0 * rinv * wv[0]; x1 = x1 * rinv * wv[1];
                    if (lat) { const int t = R & (SEQ - 1); const int pos = (fq >> 1) ? (t & 63) : (t >> 6); const f32x4* tp = tabB + (pos * 8 + 4 * (fq & 1)) / 2; rot4(x0, x1, tp[0], tp[1]); }
                    if (F8) *(unsigned*)((unsigned char*)KR + (size_t)key_slot(R) * 16 + 4 * fq) = pack8_fp4(x0 * 2.f, x1 * 2.f); else *(u32x4*)(KR + (size_t)key_slot(R) * 32 + 8 * fq) = pack8(x0, x1); }
        } else if (pn == 2 && wc == 3) {
        } else if (pn == 0 || lat) {
            bf16_t* base; float* ssb; int ld, cbase, nss, iss;
            if (pn == 0) { base = KVA; ld = 256; cbase = wc * 32; ssb = SSKV; nss = 4; iss = wc; }
            else if (pn == 1) { base = QA; ld = 384; cbase = wc * 32; ssb = SSQ; nss = 6; iss = wc; }
            else { base = QA; ld = 384; cbase = 256 + wc * 64; ssb = SSQ; nss = 6; iss = 4 + wc; }
            const int bjs = pn == 2 ? 32 : HALF;
#pragma unroll
            for (int ai = 0; ai < 2; ++ai)
#pragma unroll
                for (int m = 0; m < 4; ++m) { const int R = u.pm * BM + ai * HALF + wr * 64 + m * 16 + fr; bf16_t* dst = base + (size_t)R * ld + cbase + 8 * fq; float ss = 0.f;
                    asm volatile("" ::: "memory"); f32x4 x[2][2]; xrow(acc, ai, m, R, pcol0, x);
#pragma unroll
                    for (int bj = 0; bj < 2; ++bj) { ss += sq4(x[bj][0]) + sq4(x[bj][1]); *(u32x4*)(dst + bj * bjs) = pack8(x[bj][0], x[bj][1]); }
                    ss = quad_sum(ss); if (fq == 0) ssb[(size_t)R * nss + iss] = ss; }
        }
    }
};

template <bool F8> struct EpiKvb {
    static constexpr bool PERM = true, AFTER_DRAIN = false;
    const float* SSKV; const float* knn; bf16_t* K1; bf16_t* V1;
    __device__ __forceinline__ void operator()(const f32x4 (&acc)[2][2][4][2], const Unit& u, int wr, int wc, int fr_, int fq_) const {
        int fr = fr_, fq = fq_; asm volatile("" : "+v"(fr), "+v"(fq));
        const int head = 2 * u.pn + (wc >> 1), type = wc & 1;
#pragma unroll
        for (int ai = 0; ai < 2; ++ai)
#pragma unroll
            for (int m = 0; m < 4; ++m) { const int R = u.pm * BM + ai * HALF + wr * 64 + m * 16 + fr;
                asm volatile("" ::: "memory");
                const f32x4 s4 = *(const f32x4*)(SSKV + (size_t)R * 4); const float rkv = rsqrtf(((s4[0] + s4[1]) + (s4[2] + s4[3])) * (1.f / 256.f) + EPS);
                f32x4 x[2][2]; float ss = 0.f;
#pragma unroll
                for (int bj = 0; bj < 2; ++bj)
#pragma unroll
                    for (int n = 0; n < 2; ++n) { x[bj][n] = acc[ai][bj][m][n] * rkv; ss += sq4(x[bj][n]); }
                if (type == 0) { const float rinv = rsqrtf(quad_sum(ss) * (1.f / 64.f) + EPS);
#pragma unroll
                    for (int bj = 0; bj < 2; ++bj)
#pragma unroll
                        for (int n = 0; n < 2; ++n) x[bj][n] = x[bj][n] * rinv * *(const f32x4*)(knn + 32 * bj + 8 * fq + 4 * n); }
                const size_t eo = (size_t)key_slot(R) * DM + head * 64 + 8 * fq;
                if (F8) { if (type == 0) { unsigned char* dst = (unsigned char*)K1 + (size_t)key_slot(R) * 512 + head * 32 + 4 * fq; *(unsigned*)dst = pack8_fp4(x[0][0] * 2.f, x[0][1] * 2.f); *(unsigned*)(dst + 16) = pack8_fp4(x[1][0] * 2.f, x[1][1] * 2.f); }
                          else { unsigned char* dst = (unsigned char*)V1 + eo; *(u32x2*)dst = pack8_fp8(x[0][0], x[0][1]); *(u32x2*)(dst + 32) = pack8_fp8(x[1][0], x[1][1]); } }
                else { bf16_t* dst = (type == 0 ? K1 : V1) + eo; *(u32x4*)dst = pack8(x[0][0], x[0][1]); *(u32x4*)(dst + 32) = pack8(x[1][0], x[1][1]); } }
    }
};

struct EpiQb {
    static constexpr bool PERM = true, AFTER_DRAIN = false;
    const float* SSQ; const float* qnw; const f32x4* tabB; bf16_t* Q1N; bf16_t* Q1R; float* SSH;
    __device__ __forceinline__ float rqa_of(int R) const { const float* sp = SSQ + (size_t)R * 6; const f32x2 sa = *(const f32x2*)sp, sb = *(const f32x2*)(sp + 2), sc = *(const f32x2*)(sp + 4);
        return rsqrtf(((sa[0] + sa[1]) + (sb[0] + sb[1]) + (sc[0] + sc[1])) * (1.f / 384.f) + EPS); }
    __device__ __forceinline__ void operator()(const f32x4 (&acc)[2][2][4][2], const Unit& u, int wr, int wc, int fr_, int fq_) const {
        int fr = fr_, fq = fq_; asm volatile("" : "+v"(fr), "+v"(fq));
        const int head = 2 * u.pn + (wc >> 1);
        if ((wc & 1) == 0) {
#pragma unroll
            for (int ai = 0; ai < 2; ++ai)
#pragma unroll
                for (int m = 0; m < 4; ++m) { const int R = u.pm * BM + ai * HALF + wr * 64 + m * 16 + fr;
                    asm volatile("" ::: "memory");
                    const float rqa = rqa_of(R); float ss = 0.f; bf16_t* dst = Q1N + (size_t)R * DM + head * 64 + 8 * fq;
#pragma unroll
                    for (int bj = 0; bj < 2; ++bj) { f32x4 x0 = acc[ai][bj][m][0] * rqa, x1 = acc[ai][bj][m][1] * rqa; ss += sq4(x0) + sq4(x1);
                        x0 = x0 * *(const f32x4*)(qnw + 32 * bj + 8 * fq); x1 = x1 * *(const f32x4*)(qnw + 32 * bj + 8 * fq + 4); *(u32x4*)(dst + 32 * bj) = pack8(x0, x1); }
                    ss = quad_sum(ss); if (fq == 0) SSH[((size_t)R * 16 + head) * 2] = ss; }
        } else {
#pragma unroll
            for (int ai = 0; ai < 2; ++ai)
#pragma unroll
                for (int m = 0; m < 4; ++m) { const int R = u.pm * BM + ai * HALF + wr * 64 + m * 16 + fr;
                    asm volatile("" ::: "memory");
                    const float rqa = rqa_of(R);
                    f32x4 x0 = acc[ai][0][m][0] * rqa, x1 = acc[ai][0][m][1] * rqa; const float ss = quad_sum(sq4(x0) + sq4(x1)); if (fq == 0) SSH[((size_t)R * 16 + head) * 2 + 1] = ss;
                    const float* wp = qnw + 64 + 16 * (fq >> 1) + 4 * (fq & 1); x0 = x0 * *(const f32x4*)wp; x1 = x1 * *(const f32x4*)(wp + 8);
                    const int t = R & (SEQ - 1); const int pos = (fq >> 1) ? (t & 63) : (t >> 6); const f32x4* tp = tabB + (pos * 8 + 4 * (fq & 1)) / 2; rot4(x0, x1, tp[0], tp[1]);
                    *(u32x4*)(Q1R + (size_t)R * 512 + head * 32 + 8 * fq) = pack8(x0, x1); }
        }
    }
};

struct In1Order {
    int G, c; ROrder lat;
    __host__ __device__ void init(int G_, int c_) { G = G_; c = c_; lat.init(0, ML / BM, N_IN1P, G_, c_); }
    __host__ __device__ bool next(int i, Unit& u) const {
        const long L = (long)i * G + c; if (L < lat.nwg) return lat.next(i, u);
        const int e = (int)(L - lat.nwg); if (e >= 4) return false; u.pm = ML / BM + (e >> 1); u.pn = (e & 1) * 2; u.ko = 0; return true;
    }
    __device__ __forceinline__ void a_ready(const Unit&) const {}
    __device__ __forceinline__ void done(const Unit&) const {}
};
template <class Epi, class Sched, bool ALIGN_EPI = false, bool SP2 = false>
__device__ __forceinline__ void gemm_phase(PG8_LAS unsigned char* lds, const Gemm g, const Sched& S, const Epi& E) {
    const int tid = threadIdx.x, wid = __builtin_amdgcn_readfirstlane(tid >> 6), lane = tid & 63, wr = wid >> 2, wc = wid & 3, fr = lane & 15, fq = lane >> 4;
    const int K = g.K, nt = (g.Kloop ? g.Kloop : K) / BK;
    unsigned voffA[2], voffB[2];
#pragma unroll
    for (int i = 0; i < 2; ++i) { int R, C; stage_rc(tid * 16 + i * 8192, R, C); const int Rb = Epi::PERM ? ((R & ~31) + perm32(R & 31)) : R;
        voffA[i] = (unsigned)(R * K + C) * 2u; voffB[i] = (unsigned)(Rb * K + C) * 2u; }
    const size_t kstep = (size_t)(BK * 2);
    const size_t hstep = (size_t)HALF * K * 2;
    const size_t tstep = 2 * hstep;
    const unsigned ldsw = (unsigned)wid * 1024u;
    const int aoff = lds_byte(wr * 64 + fr, fq * 8), boff = lds_byte(wc * 32 + fr, fq * 8);
#define PG8_SA(b, h) (((b) * 2 + (h)) * HTB)
#define PG8_SB(b, h) ((4 + (b) * 2 + (h)) * HTB)
#define PG8_STAGE(bufoff, gbase, voff) do { _Pragma("unroll") for (int _i = 0; _i < 2; ++_i) \
        __builtin_amdgcn_global_load_lds((const unsigned*)((const char*)(gbase) + (voff)[_i]), (PG8_LAS unsigned*)(lds + (bufoff) + ldsw + _i * 8192), 16, 0, 0); } while (0)
#define PG8_LDA(dst, b, h) do { _Pragma("unroll") for (int m = 0; m < 4; ++m) _Pragma("unroll") for (int k = 0; k < 2; ++k) dst[m][k] = *(const PG8_LAS bf16x8*)(lds + PG8_SA(b, h) + aoff + m * 2048 + k * 1024); } while (0)
#define PG8_LDB(dst, b, h) do { _Pragma("unroll") for (int n = 0; n < 2; ++n) _Pragma("unroll") for (int k = 0; k < 2; ++k) dst[n][k] = *(const PG8_LAS bf16x8*)(lds + PG8_SB(b, h) + boff + n * 2048 + k * 1024); } while (0)
#define PG8_MMA(ai, bj, At, Bt) do { __builtin_amdgcn_s_setprio(1); _Pragma("unroll") for (int m = 0; m < 4; ++m) _Pragma("unroll") for (int n = 0; n < 2; ++n) _Pragma("unroll") for (int k = 0; k < 2; ++k) \
        acc[ai][bj][m][n] = __builtin_amdgcn_mfma_f32_16x16x32_bf16(Bt[n][k], At[m][k], acc[ai][bj][m][n], 0, 0, 0); __builtin_amdgcn_s_setprio(0); } while (0)
#define PG8_WAIT_V(n) asm volatile("s_waitcnt vmcnt(" #n ")" ::: "memory")
#define PG8_WAIT_L(n) asm volatile("s_waitcnt lgkmcnt(" #n ")" ::: "memory")
#define PG8_BAR __builtin_amdgcn_s_barrier()
#define PG8_SCHED __builtin_amdgcn_sched_barrier(0)
    Unit cur, nxt; int ui = 0;
    if (!S.next(0, cur)) return;
    f32x4 acc[2][2][4][2];
#pragma unroll
    for (int a = 0; a < 2; ++a)
#pragma unroll
        for (int b = 0; b < 2; ++b)
#pragma unroll
            for (int m = 0; m < 4; ++m)
#pragma unroll
                for (int n = 0; n < 2; ++n) acc[a][b][m][n] = (f32x4){0.f, 0.f, 0.f, 0.f};
    bf16x8 At[4][2], B0[2][2], B1[2][2];
    const char* cA = (const char*)g.A + (size_t)cur.pm * tstep + (size_t)cur.ko * 2; const char* cB = (const char*)g.Bt + (size_t)cur.pn * tstep + (size_t)cur.ko * 2;
    S.a_ready(cur);
    if constexpr (SP2) {
        PG8_STAGE(PG8_SB(0, 0), cB, voffB); PG8_STAGE(PG8_SB(0, 1), cB + hstep, voffB); PG8_STAGE(PG8_SA(0, 0), cA, voffA); PG8_STAGE(PG8_SA(0, 1), cA + hstep, voffA);
        if (wr == 1) PG8_BAR;
        PG8_WAIT_V(2); PG8_BAR;
        PG8_STAGE(PG8_SB(1, 0), cB + kstep, voffB); PG8_STAGE(PG8_SA(1, 0), cA + kstep, voffA); PG8_STAGE(PG8_SB(1, 1), cB + hstep + kstep, voffB);
        PG8_WAIT_V(6); PG8_BAR;
    } else {
        PG8_STAGE(PG8_SB(0, 0), cB, voffB); PG8_STAGE(PG8_SA(0, 0), cA, voffA); PG8_STAGE(PG8_SB(0, 1), cB + hstep, voffB); PG8_STAGE(PG8_SA(0, 1), cA + hstep, voffA);
        if (wr == 1) PG8_BAR;
        PG8_WAIT_V(4); PG8_BAR;
        PG8_STAGE(PG8_SB(1, 0), cB + kstep, voffB); PG8_STAGE(PG8_SA(1, 0), cA + kstep, voffA); PG8_STAGE(PG8_SB(1, 1), cB + hstep + kstep, voffB);
        PG8_WAIT_V(6); PG8_BAR;
    }
    for (;;) {
        const bool has_next = S.next(ui + 1, nxt);
        const char* nA = has_next ? (const char*)g.A + (size_t)nxt.pm * tstep + (size_t)nxt.ko * 2 : cA; const char* nB = has_next ? (const char*)g.Bt + (size_t)nxt.pn * tstep + (size_t)nxt.ko * 2 : cB;
        _Pragma("nounroll") for (int t = 0; t < nt; t += 2) {
            const bool last = (t == nt - 2);
            const char* a1 = cA + (size_t)(t + 1) * kstep;
            const char* a2 = last ? nA : cA + (size_t)(t + 2) * kstep; const char* b2 = last ? nB : cB + (size_t)(t + 2) * kstep;
            const char* a3 = a2 + kstep; const char* b3 = b2 + kstep;
            if (last && has_next) S.a_ready(nxt);
            if constexpr (SP2) {
            PG8_LDB(B0, 0, 0); PG8_LDB(B1, 0, 1); PG8_SCHED; PG8_LDA(At, 0, 0); PG8_STAGE(PG8_SA(1, 1), a1 + hstep, voffA);
            PG8_WAIT_V(8); PG8_WAIT_L(0); PG8_BAR; PG8_MMA(0, 0, At, B0); PG8_MMA(0, 1, At, B1); PG8_BAR; PG8_SCHED;
            PG8_LDA(At, 0, 1); PG8_STAGE(PG8_SB(0, 0), b2, voffB); PG8_STAGE(PG8_SB(0, 1), b2 + hstep, voffB); PG8_STAGE(PG8_SA(0, 0), a2, voffA);
            PG8_WAIT_V(8); PG8_WAIT_L(0); PG8_BAR; PG8_MMA(1, 0, At, B0); PG8_MMA(1, 1, At, B1); PG8_BAR; PG8_SCHED;
            PG8_LDB(B0, 1, 0); PG8_LDB(B1, 1, 1); PG8_SCHED; PG8_LDA(At, 1, 0); PG8_STAGE(PG8_SA(0, 1), a2 + hstep, voffA);
            PG8_WAIT_V(8); PG8_WAIT_L(0); PG8_BAR; PG8_MMA(0, 0, At, B0); PG8_MMA(0, 1, At, B1); PG8_BAR; PG8_SCHED;
            PG8_LDA(At, 1, 1); PG8_STAGE(PG8_SB(1, 0), b3, voffB); PG8_STAGE(PG8_SB(1, 1), b3 + hstep, voffB); PG8_STAGE(PG8_SA(1, 0), a3, voffA);
            PG8_WAIT_V(8); PG8_WAIT_L(0); PG8_BAR; PG8_MMA(1, 0, At, B0); PG8_MMA(1, 1, At, B1); PG8_BAR; PG8_SCHED;
            } else {
            PG8_LDB(B0, 0, 0); PG8_SCHED; PG8_LDA(At, 0, 0); PG8_STAGE(PG8_SA(1, 1), a1 + hstep, voffA);
            PG8_WAIT_L(8); PG8_BAR; PG8_WAIT_L(0); PG8_MMA(0, 0, At, B0); PG8_BAR; PG8_SCHED;
            PG8_LDB(B1, 0, 1); PG8_STAGE(PG8_SB(0, 0), b2, voffB);
            PG8_BAR; PG8_WAIT_L(0); PG8_MMA(0, 1, At, B1); PG8_BAR;
            PG8_LDA(At, 0, 1); PG8_STAGE(PG8_SA(0, 0), a2, voffA);
            PG8_BAR; PG8_WAIT_L(0); PG8_MMA(1, 0, At, B0); PG8_BAR; PG8_SCHED;
            PG8_STAGE(PG8_SB(0, 1), b2 + hstep, voffB);
            PG8_WAIT_V(6); PG8_BAR; PG8_MMA(1, 1, At, B1); PG8_BAR;
            PG8_LDB(B0, 1, 0); PG8_SCHED; PG8_LDA(At, 1, 0); PG8_STAGE(PG8_SA(0, 1), a2 + hstep, voffA);
            PG8_WAIT_L(8); PG8_BAR; PG8_WAIT_L(0); PG8_MMA(0, 0, At, B0); PG8_BAR; PG8_SCHED;
            PG8_LDB(B1, 1, 1); PG8_STAGE(PG8_SB(1, 0), b3, voffB);
            PG8_BAR; PG8_WAIT_L(0); PG8_MMA(0, 1, At, B1); PG8_BAR;
            PG8_LDA(At, 1, 1); PG8_STAGE(PG8_SA(1, 0), a3, voffA);
            PG8_BAR; PG8_WAIT_L(0); PG8_MMA(1, 0, At, B0); PG8_BAR; PG8_SCHED;
            PG8_STAGE(PG8_SB(1, 1), b3 + hstep, voffB);
            PG8_WAIT_V(6); PG8_BAR; PG8_MMA(1, 1, At, B1); PG8_BAR;
            }
        }
        if constexpr (ALIGN_EPI) { if (wr == 0) PG8_BAR; }
        if constexpr (!Epi::AFTER_DRAIN) { E(acc, cur, wr, wc, fr, fq); S.done(cur); }
        if (!has_next) break;
#pragma unroll
        for (int a = 0; a < 2; ++a)
#pragma unroll
            for (int b = 0; b < 2; ++b)
#pragma unroll
                for (int m = 0; m < 4; ++m)
#pragma unroll
                    for (int n = 0; n < 2; ++n) acc[a][b][m][n] = (f32x4){0.f, 0.f, 0.f, 0.f};
        cur = nxt; cA = nA; cB = nB; ++ui;
        if constexpr (ALIGN_EPI) { if (wr == 1) PG8_BAR; }
    }
    PG8_WAIT_V(0);
    if constexpr (!ALIGN_EPI) { if (wr == 0) PG8_BAR; }
    PG8_BAR;
    if constexpr (Epi::AFTER_DRAIN) { E.fused(acc, cur, wr, wc, fr, fq, lds, wid, lane); S.done(cur); }
#undef PG8_SA
#undef PG8_SB
#undef PG8_STAGE
#undef PG8_LDA
#undef PG8_LDB
#undef PG8_MMA
#undef PG8_WAIT_V
#undef PG8_WAIT_L
#undef PG8_BAR
#undef PG8_SCHED
}
}

DEVI void sincos_pos(float ang, float& cs, float& sn) {
    const double TWO_PI = 6.283185307179586476925286766559; const double a = (double)ang; const double k = __builtin_rint(a * (1.0 / TWO_PI));
    const float r = (float)(a - k * TWO_PI);
    cs = cosf(r); sn = sinf(r);
}

namespace afast {
#ifndef ATT_PRIO
#define ATT_PRIO 2
#endif
#ifndef ATT_DUP
#define ATT_DUP 0
#endif
constexpr int NW = 8, KVBLK = 64, SLOTK = 12288, SLOTV = 8192, KROFF = 8192;
constexpr int LDS_K = 0, LDS_V = 3 * SLOTK, LDS_WS = LDS_V + 3 * SLOTV, LDS_OST = LDS_WS + NW * 256, LDS_BYTES = LDS_OST + NW * 4096;
#define SBAR() __builtin_amdgcn_sched_barrier(0)
#define PIN(x) asm volatile("" : "+v"(x))
#define MFMA(a, b, c) __builtin_amdgcn_mfma_f32_32x32x16_bf16(a, b, c, 0, 0, 0)
#ifndef ATT_AGPR_O
#define ATT_AGPR_O 0
#endif
#if ATT_AGPR_O
#define PVMFMA(acc, a, b) asm volatile("s_nop 1\n\tv_mfma_f32_32x32x16_bf16 %0, %1, %2, %0" : "+a"(acc) : "v"(a), "v"(b))
#else
#define PVMFMA(acc, a, b) acc = __builtin_amdgcn_mfma_f32_32x32x16_bf16(a, b, acc, 0, 0, 0)
#endif
#define WAIT_BAR_(N) asm volatile("s_waitcnt vmcnt(" #N ") lgkmcnt(0)\n\ts_barrier" ::: "memory")
#define WAIT_BAR_0() WAIT_BAR_(0)
#define WAIT_BAR_1() do { if (ATT_DUP & 1) WAIT_BAR_(2); else WAIT_BAR_(1); } while (0)
#define WAIT_BAR_2() do { if (ATT_DUP & 1) WAIT_BAR_(4); else WAIT_BAR_(2); } while (0)
#define WAIT_BAR_3() do { if (ATT_DUP & 1) WAIT_BAR_(6); else WAIT_BAR_(3); } while (0)
#define WAIT_BAR(N) do { WAIT_BAR_##N(); if (ATT_DUP & 2) asm volatile("s_barrier" ::: "memory"); } while (0)
DEVI int crow(int r, int hi) { return (r & 3) + 8 * (r >> 2) + 4 * hi; }
DEVI unsigned cvtpk(float lo, float hi) { unsigned r; asm("v_cvt_pk_bf16_f32 %0, %1, %2" : "=v"(r) : "v"(lo), "v"(hi)); return r; }
DEVI void glds16(const void* g, unsigned lds_base) {
    unsigned sv; asm volatile("s_mov_b32 %0, m0\n\ts_mov_b32 m0, %2\n\ts_nop 0\n\tglobal_load_lds_dwordx4 %1, off\n\ts_mov_b32 m0, %0" : "=&s"(sv) : "v"(g), "s"(lds_base) : "memory"); }
typedef __attribute__((address_space(3))) const char* lds_cptr;
typedef short v4i16_t __attribute__((ext_vector_type(4)));
DEVI bf16x8 ldsb128(lds_cptr p) { return *(const __attribute__((address_space(3))) bf16x8*)p; }
DEVI s16x4 vtr(lds_cptr p) { return __builtin_bit_cast(s16x4, __builtin_amdgcn_ds_read_tr16_b64_v4i16((__attribute__((address_space(3))) v4i16_t*)p)); }
DEVI bf16x8 scale8(bf16x8 v, float s) {
    u32x4 w = __builtin_bit_cast(u32x4, v); u32x4 o;
#pragma unroll
    for (int i = 0; i < 4; ++i) { const float lo = __uint_as_float(w[i] << 16) * s, hi = __uint_as_float(w[i] & 0xffff0000u) * s; o[i] = cvtpk(lo, hi); }
    return __builtin_bit_cast(bf16x8, o);
}

template <int ROPE>
DEVI void attn_unit(const bf16_t* Qn, int ldq, const bf16_t* Qr, const float* ssh, const bf16_t* __restrict__ Kn, int ldk, const bf16_t* __restrict__ Kr,
                    const bf16_t* __restrict__ V, int ldv, int NT, bf16_t* O, const bf16_t* G, int ldo, char* lds) {
    const int tid = threadIdx.x, lane = tid & 63, r32 = lane & 31, hi = lane >> 5; const int wid = __builtin_amdgcn_readfirstlane(tid >> 6);
    const unsigned lds0 = (unsigned)(uintptr_t)lds; float* wsf = (float*)(lds + LDS_WS) + wid * 64;
    const bf16_t* ksrc = Kn + (size_t)lane * ldk + wid * 8;
    const bf16_t* vsrc = V + (size_t)(16 * (wid & 3) + (lane >> 2)) * ldv + (wid >> 2) * 32 + (lane & 3) * 8;
    const bf16_t* krsrc = ROPE ? Kr + (size_t)(32 * (wid & 1) + r32) * 32 + 8 * (2 * ((wid >> 1) & 1) + hi) : nullptr;
    const unsigned kdst = lds0 + LDS_K + wid * 1024, vdst = lds0 + LDS_V + wid * 1024, krdst = lds0 + LDS_K + KROFF + (wid & 3) * 1024;
    const bool rwave = ROPE && wid < 4;
#define DMA_K(t, slot) do { DMA_K1(t, slot); if (ATT_DUP & 1) DMA_K1(t, slot); } while (0)
#define DMA_K1(t, slot) do { if (ROPE) { if (rwave) glds16(krsrc + (size_t)(t) * KVBLK * 32, (unsigned)__builtin_amdgcn_readfirstlane(krdst + (slot))); } \
        glds16(ksrc + (size_t)(t) * KVBLK * ldk, (unsigned)__builtin_amdgcn_readfirstlane(kdst + (slot))); } while (0)
#define DMA_V1(t, slot) glds16(vsrc + (size_t)(t) * KVBLK * ldv, (unsigned)__builtin_amdgcn_readfirstlane(vdst + (slot)))
#define DMA_V(t, slot) do { DMA_V1(t, slot); if (ATT_DUP & 1) DMA_V1(t, slot); } while (0)
    const lds_cptr vp0 = (lds_cptr)lds + LDS_V + ((lane >> 4) & 1) * 32 + (lane & 3) * 8 + (4 * hi + ((lane & 15) >> 2)) * 64;
    const lds_cptr kp0 = (lds_cptr)lds + LDS_K + hi * 1024 + r32 * 16;
    const lds_cptr krp0 = (lds_cptr)lds + LDS_K + KROFF + hi * 512 + r32 * 16;
    DMA_K(0, 0); DMA_V(0, 0); DMA_K(1, SLOTK);
    bf16x8 qr[4]; bf16x8 qrr[2];
    { const bf16_t* Qw = Qn + (size_t)(wid * 32 + r32) * ldq + hi * 8;
#pragma unroll
      for (int d0 = 0; d0 < 4; ++d0) qr[d0] = *reinterpret_cast<const bf16x8*>(Qw + d0 * 16);
      if (ROPE) { const bf16_t* Qrw = Qr + (size_t)(wid * 32 + r32) * 512 + hi * 8;
#pragma unroll
          for (int d0 = 0; d0 < 2; ++d0) qrr[d0] = *reinterpret_cast<const bf16x8*>(Qrw + d0 * 16);
          const f32x2 s2 = *(const f32x2*)(ssh + (size_t)(wid * 32 + r32) * 32); const float sc = rsqrtf((s2[0] + s2[1]) * (1.f / 96.f) + EPS) * C2_MLA;
#pragma unroll
          for (int d0 = 0; d0 < 4; ++d0) qr[d0] = scale8(qr[d0], sc);
#pragma unroll
          for (int d0 = 0; d0 < 2; ++d0) qrr[d0] = scale8(qrr[d0], sc); } }
    float l_reg = 0.f; f32x16 o[2]; o[0] = f32x16{}; o[1] = f32x16{};
    const f32x16 zero16 = f32x16{};
    f32x16 dacc = f32x16{}; f32x16 pA0, pA1, pB0, pB1; bf16x8 kf[8]; bf16x8 kfr[4]; s16x4 vlo[8], vhi[8]; u32x4 pw0, pw1, pw2, pw3;
    int sl_prev = 0, sl_cur = 0, sl_next = SLOTK;
#define VSL(s) (((s) / (SLOTK / 1024)) * (SLOTV / 1024))
#define ROT() do { sl_prev = sl_cur; sl_cur = sl_next; sl_next = (sl_next == 2 * SLOTK) ? 0 : sl_next + SLOTK; } while (0)
#define EX(v) __builtin_amdgcn_exp2f(v)
#define KLOADALL(slot) do { _Pragma("unroll") for (int d0 = 0; d0 < 4; ++d0) { kf[2 * d0] = ldsb128(kp0 + (slot) + d0 * 2048); kf[2 * d0 + 1] = ldsb128(kp0 + (slot) + d0 * 2048 + 512); } \
        if (ROPE) { _Pragma("unroll") for (int q = 0; q < 4; ++q) kfr[q] = ldsb128(krp0 + (slot) + q * 1024); } } while (0)
    DMA_K(2, 2 * SLOTK);
    WAIT_BAR(3);
    KLOADALL(0);
    pA0 = MFMA(kf[0], qr[0], zero16); pA1 = MFMA(kf[1], qr[0], zero16); pA0 = MFMA(kf[2], qr[1], pA0); pA1 = MFMA(kf[3], qr[1], pA1);
    pA0 = MFMA(kf[4], qr[2], pA0); pA1 = MFMA(kf[5], qr[2], pA1); pA0 = MFMA(kf[6], qr[3], pA0); pA1 = MFMA(kf[7], qr[3], pA1);
    if (ROPE) { pA0 = MFMA(kfr[0], qrr[0], pA0); pA1 = MFMA(kfr[1], qrr[0], pA1); pA0 = MFMA(kfr[2], qrr[1], pA0); pA1 = MFMA(kfr[3], qrr[1], pA1); }
#pragma unroll
    for (int r = 0; r < 16; ++r) { pA0[r] = EX(pA0[r]); pA1[r] = EX(pA1[r]); }
    WAIT_BAR(0);
    DMA_K(3, 0); DMA_V(1, SLOTV); ROT();
    KLOADALL(sl_cur);
    WAIT_BAR(2);
#define PKW(P, i) cvtpk(P[i], P[i + 1])
#define PAF(k) __builtin_bit_cast(bf16x8, pw##k)
#define VFR(i) (bf16x8){vlo[i][0], vlo[i][1], vlo[i][2], vlo[i][3], vhi[i][0], vhi[i][1], vhi[i][2], vhi[i][3]}
#define VRD(i) do { vlo[i] = vtr(vp_ + (((i) >> 2) * 4096 + ((i) & 3) * 1024)); vhi[i] = vtr(vp_ + (((i) >> 2) * 4096 + ((i) & 3) * 1024 + 512)); } while (0)
#define KRD(G, d0) do { if (G) { kf[2 * (d0)] = ldsb128(kp0 + sl_next + (d0) * 2048); kf[2 * (d0) + 1] = ldsb128(kp0 + sl_next + (d0) * 2048 + 512); \
        if (ATT_DUP & 16) { bf16x8 d0_, d1_; asm volatile("ds_read_b128 %0, %2 offset:0\n\tds_read_b128 %1, %2 offset:512\n\ts_waitcnt lgkmcnt(0)" : "=&v"(d0_), "=&v"(d1_) : "v"((unsigned)(uintptr_t)(kp0 + sl_next + (d0) * 2048)) : "memory"); } SBAR(); } } while (0)
#define KRR(G, q) do { if (ROPE) { if (G) { kfr[2 * (q)] = ldsb128(krp0 + sl_next + (2 * (q)) * 1024); kfr[2 * (q) + 1] = ldsb128(krp0 + sl_next + (2 * (q) + 1) * 1024); SBAR(); } } } while (0)
#define GAPA4(CX, MF, a0, a1, a2, a3, W0, W1, PW) do { MF; sacc += a0; sacc += a1; sacc += a2; sacc += a3; W0; W1; PIN(PW); PIN(sacc); PIN(CX); if ((ATT_DUP & 8) && !ROPE) { dacc = MFMA(kf[0], qr[0], dacc); PIN(dacc); } SBAR(); } while (0)
#define GAPA3(CX, MF, a0, a1, a2, W0, W1, PW) do { MF; sacc += a0; sacc += a1; sacc += a2; W0; W1; PIN(PW); PIN(sacc); PIN(CX); if ((ATT_DUP & 8) && !ROPE) { dacc = MFMA(kf[0], qr[0], dacc); PIN(dacc); } SBAR(); } while (0)
#define GAPA31(CX, MF, a0, a1, a2, W0, PW) do { MF; sacc += a0; sacc += a1; sacc += a2; W0; PIN(PW); PIN(sacc); PIN(CX); if ((ATT_DUP & 8) && !ROPE) { dacc = MFMA(kf[0], qr[0], dacc); PIN(dacc); } SBAR(); } while (0)
#define GAPA21(CX, MF, a0, a1, W0, PW) do { MF; sacc += a0; sacc += a1; W0; PIN(PW); PIN(sacc); PIN(CX); if ((ATT_DUP & 8) && !ROPE) { dacc = MFMA(kf[0], qr[0], dacc); PIN(dacc); } SBAR(); } while (0)
#define XEXP(v) do { if (ATT_DUP & 4) { float d_; asm volatile("v_exp_f32 %0, %1" : "=v"(d_) : "v"(v)); } } while (0)
#define GAPB(MF, X, i) do { MF; X[i] = EX(X[i]); X[i + 1] = EX(X[i + 1]); X[i + 2] = EX(X[i + 2]); X[i + 3] = EX(X[i + 3]); XEXP(X[i]); XEXP(X[i + 1]); XEXP(X[i + 2]); XEXP(X[i + 3]); PIN(X); SBAR(); } while (0)
#define STEP(C0, C1, P0, P1, t, GK, GV, GL) do { SBAR(); if (ATT_PRIO == 2) __builtin_amdgcn_s_setprio(1); if (ATT_PRIO == 3) __builtin_amdgcn_s_setprio(0); \
    const lds_cptr vp_ = vp0 + VSL(sl_prev); \
    VRD(0); SBAR(); float sacc = P0[0] + P0[1]; \
    if (!ROPE) { \
                        GAPA4(C0, C0 = MFMA(kf[0], qr[0], zero16), P0[2], P0[3], P0[4], P0[5],     pw0[0] = PKW(P0, 0),  pw0[1] = PKW(P0, 2),  pw0); \
        VRD(4); SBAR(); GAPA4(C1, C1 = MFMA(kf[1], qr[0], zero16), P0[6], P0[7], P0[8], P0[9],     pw0[2] = PKW(P0, 4),  pw0[3] = PKW(P0, 6),  pw0); \
        VRD(1); SBAR(); GAPA4(C0, C0 = MFMA(kf[2], qr[1], C0),    P0[10], P0[11], P0[12], P0[13], pw1[0] = PKW(P0, 8),  pw1[1] = PKW(P0, 10), pw1); \
        VRD(5); SBAR(); GAPA4(C1, C1 = MFMA(kf[3], qr[1], C1),    P0[14], P0[15], P1[0], P1[1],   pw1[2] = PKW(P0, 12), pw1[3] = PKW(P0, 14), pw1); \
        VRD(2); SBAR(); GAPA4(C0, C0 = MFMA(kf[4], qr[2], C0),    P1[2], P1[3], P1[4], P1[5],     pw2[0] = PKW(P1, 0),  pw2[1] = PKW(P1, 2),  pw2); \
        VRD(6); SBAR(); GAPA4(C1, C1 = MFMA(kf[5], qr[2], C1),    P1[6], P1[7], P1[8], P1[9],     pw2[2] = PKW(P1, 4),  pw2[3] = PKW(P1, 6),  pw2); \
        VRD(3); SBAR(); GAPA4(C0, C0 = MFMA(kf[6], qr[3], C0),    P1[10], P1[11], P1[12], P1[13], pw3[0] = PKW(P1, 8),  pw3[1] = PKW(P1, 10), pw3); \
        VRD(7); SBAR(); GAPA4(C1, C1 = MFMA(kf[7], qr[3], C1),    P1[14], P1[15], 0.f, 0.f,       pw3[2] = PKW(P1, 12), pw3[3] = PKW(P1, 14), pw3); \
    } else { \
                        GAPA3(C0, C0 = MFMA(kf[0], qr[0], zero16), P0[2], P0[3], P0[4],    pw0[0] = PKW(P0, 0),  pw0[1] = PKW(P0, 2),  pw0); \
        VRD(4); SBAR(); GAPA3(C1, C1 = MFMA(kf[1], qr[0], zero16), P0[5], P0[6], P0[7],    pw0[2] = PKW(P0, 4),  pw0[3] = PKW(P0, 6),  pw0); \
        VRD(1); SBAR(); GAPA3(C0, C0 = MFMA(kf[2], qr[1], C0),    P0[8], P0[9], P0[10],   pw1[0] = PKW(P0, 8),  pw1[1] = PKW(P0, 10), pw1); \
        VRD(5); SBAR(); GAPA3(C1, C1 = MFMA(kf[3], qr[1], C1),    P0[11], P0[12], P0[13], pw1[2] = PKW(P0, 12), pw1[3] = PKW(P0, 14), pw1); \
        VRD(2); SBAR(); GAPA31(C0, C0 = MFMA(kf[4], qr[2], C0),   P0[14], P0[15], P1[0],  pw2[0] = PKW(P1, 0),  pw2); \
        VRD(6); SBAR(); GAPA31(C1, C1 = MFMA(kf[5], qr[2], C1),   P1[1], P1[2], P1[3],    pw2[1] = PKW(P1, 2),  pw2); \
        VRD(3); SBAR(); GAPA21(C0, C0 = MFMA(kf[6], qr[3], C0),   P1[4], P1[5],           pw2[2] = PKW(P1, 4),  pw2); \
        VRD(7); SBAR(); GAPA21(C1, C1 = MFMA(kf[7], qr[3], C1),   P1[6], P1[7],           pw2[3] = PKW(P1, 6),  pw2); \
                        GAPA21(C0, C0 = MFMA(kfr[0], qrr[0], C0), P1[8], P1[9],           pw3[0] = PKW(P1, 8),  pw3); \
                        GAPA21(C1, C1 = MFMA(kfr[1], qrr[0], C1), P1[10], P1[11],         pw3[1] = PKW(P1, 10), pw3); \
                        GAPA21(C0, C0 = MFMA(kfr[2], qrr[1], C0), P1[12], P1[13],         pw3[2] = PKW(P1, 12), pw3); \
                        GAPA21(C1, C1 = MFMA(kfr[3], qrr[1], C1), P1[14], P1[15],         pw3[3] = PKW(P1, 14), pw3); \
    } \
    l_reg += sacc; \
    if (GK) DMA_K((t) + 3, sl_cur); if (GV) DMA_V((t) + 1, VSL(sl_next)); \
    SBAR(); if (ATT_PRIO == 2) __builtin_amdgcn_s_setprio(0); if (ATT_PRIO == 3) __builtin_amdgcn_s_setprio(1); \
    GAPB(PVMFMA(o[0], PAF(0), VFR(0)), C0, 0); \
    KRD(GL, 0); GAPB(PVMFMA(o[1], PAF(0), VFR(4)), C0, 4); \
    KRD(GL, 1); GAPB(PVMFMA(o[0], PAF(1), VFR(1)), C0, 8); \
    KRD(GL, 2); GAPB(PVMFMA(o[1], PAF(1), VFR(5)), C0, 12); \
    KRD(GL, 3); GAPB(PVMFMA(o[0], PAF(2), VFR(2)), C1, 0); \
    KRR(GL, 0); GAPB(PVMFMA(o[1], PAF(2), VFR(6)), C1, 4); \
    KRR(GL, 1); GAPB(PVMFMA(o[0], PAF(3), VFR(3)), C1, 8); \
    GAPB(PVMFMA(o[1], PAF(3), VFR(7)), C1, 12); \
    } while (0)
    if (ATT_PRIO == 1) { if (wid >= 4) __builtin_amdgcn_s_setprio(1); }
    int t = 1;
    for (; t + 5 < NT; t += 2) {
        STEP(pB0, pB1, pA0, pA1, t, true, true, true);     WAIT_BAR(2); ROT();
        STEP(pA0, pA1, pB0, pB1, t + 1, true, true, true); WAIT_BAR(2); ROT();
    }
#define ENDW(tt) do { if ((tt) + 3 < NT) { WAIT_BAR(2); } else if ((tt) + 2 < NT) { WAIT_BAR(1); } else { WAIT_BAR(0); } } while (0)
    for (; t + 1 < NT; t += 2) {
        STEP(pB0, pB1, pA0, pA1, t, (t + 3 < NT), (t + 1 < NT), (t + 1 < NT));         ENDW(t);     ROT();
        STEP(pA0, pA1, pB0, pB1, t + 1, (t + 4 < NT), (t + 2 < NT), (t + 2 < NT));     ENDW(t + 1); ROT();
    }
    STEP(pB0, pB1, pA0, pA1, NT - 1, false, false, false);
    if (ATT_PRIO != 0) __builtin_amdgcn_s_setprio(0);
    { float sacc = pB0[0] + pB0[1];
#pragma unroll
      for (int r = 2; r < 16; ++r) sacc += pB0[r];
#pragma unroll
      for (int r = 0; r < 16; ++r) sacc += pB1[r];
      l_reg += sacc;
      pw0 = (u32x4){PKW(pB0, 0), PKW(pB0, 2), PKW(pB0, 4), PKW(pB0, 6)}; pw1 = (u32x4){PKW(pB0, 8), PKW(pB0, 10), PKW(pB0, 12), PKW(pB0, 14)};
      pw2 = (u32x4){PKW(pB1, 0), PKW(pB1, 2), PKW(pB1, 4), PKW(pB1, 6)}; pw3 = (u32x4){PKW(pB1, 8), PKW(pB1, 10), PKW(pB1, 12), PKW(pB1, 14)};
      const lds_cptr vp_ = vp0 + VSL(sl_cur); _Pragma("unroll") for (int i = 0; i < 8; ++i) VRD(i);
      PVMFMA(o[0], PAF(0), VFR(0)); PVMFMA(o[1], PAF(0), VFR(4)); PVMFMA(o[0], PAF(1), VFR(1)); PVMFMA(o[1], PAF(1), VFR(5));
      PVMFMA(o[0], PAF(2), VFR(2)); PVMFMA(o[1], PAF(2), VFR(6)); PVMFMA(o[0], PAF(3), VFR(3)); PVMFMA(o[1], PAF(3), VFR(7)); }
#if ATT_AGPR_O
    asm volatile("s_nop 15\n\ts_nop 7" : "+a"(o[0]), "+a"(o[1]));
#endif
    { auto rr = __builtin_amdgcn_permlane32_swap(__float_as_uint(l_reg), __float_as_uint(l_reg), false, false); l_reg = __uint_as_float(rr[0]) + __uint_as_float(rr[1]); }
    if (hi == 0) wsf[32 + r32] = l_reg; asm volatile("s_waitcnt lgkmcnt(0)" ::: "memory");
    float rli[16];
#pragma unroll
    for (int r = 0; r < 16; ++r) rli[r] = __builtin_amdgcn_rcpf(wsf[32 + crow(r, hi)]);
    bf16_t* stg = (bf16_t*)(lds + LDS_OST) + wid * 2048;
#pragma unroll
    for (int r = 0; r < 16; ++r) { const int orow = crow(r, hi);
#pragma unroll
        for (int d0 = 0; d0 < 2; ++d0) stg[orow * 64 + d0 * 32 + r32] = (bf16_t)f2bf(o[d0][r] * rli[r]); }
    asm volatile("s_waitcnt lgkmcnt(0)" ::: "memory");
#pragma unroll
    for (int i = 0; i < 4; ++i) { const int row = i * 8 + (lane >> 3), ch = lane & 7; const size_t goff = (size_t)(wid * 32 + row) * ldo + ch * 8;
        const u32x4 ov = *(const u32x4*)(stg + row * 64 + ch * 8); const u32x4 gv = *(const u32x4*)(G + goff); u32x4 w;
#pragma unroll
        for (int q = 0; q < 4; ++q) { const float lo = __uint_as_float(ov[q] << 16) * __uint_as_float(gv[q] << 16), hh = __uint_as_float(ov[q] & 0xffff0000u) * __uint_as_float(gv[q] & 0xffff0000u); w[q] = cvtpk(lo, hh); }
        *(u32x4*)(O + goff) = w; }
    asm volatile("s_waitcnt lgkmcnt(0)\n\ts_barrier" ::: "memory");
#undef DMA_K
#undef DMA_K1
#undef DMA_V1
#undef XEXP
#undef DMA_V
#undef VSL
#undef ROT
#undef EX
#undef KLOADALL
#undef PKW
#undef PAF
#undef VFR
#undef VRD
#undef KRD
#undef KRR
#undef GAPA4
#undef GAPA3
#undef GAPA31
#undef GAPA21
#undef GAPB
#undef STEP
#undef ENDW
}
#undef SBAR
#undef PIN
#undef MFMA
#undef PVMFMA
#undef WAIT_BAR
#undef WAIT_BAR_
#undef WAIT_BAR_0
#undef WAIT_BAR_1
#undef WAIT_BAR_2
#undef WAIT_BAR_3
}

namespace af8 {
#ifdef MK_UNIT_PROBE
#define UPROBE_PARAM , unsigned long long& upacc
#define UPROBE_ARG , upacc
#else
#define UPROBE_PARAM
#define UPROBE_ARG
#endif
#ifndef F8_DUP
#define F8_DUP 0
#endif
typedef int v8i __attribute__((ext_vector_type(8)));
typedef int v4i __attribute__((ext_vector_type(4)));
typedef int v2i __attribute__((ext_vector_type(2)));
constexpr int NW = 8, KVBLK = 64, SLOT = 4096, KSLOT = 2048;
constexpr int KRSLOT = 1024 + 64;
constexpr int NSL = 4;
constexpr int LDS_K = 0, LDS_V = NSL * KSLOT, LDS_KR = LDS_V + NSL * SLOT, LDS_WS = LDS_KR + NSL * KRSLOT, LDS_OST = LDS_WS + NW * 256, LDS_BYTES = LDS_OST + NW * 4096;
constexpr float YOFF = (56.0f + 0.5f) / 256.f;
#define SBAR() __builtin_amdgcn_sched_barrier(0)
#define PIN(x) asm volatile("" : "+v"(x))
#define WAIT_BAR0() asm volatile("s_waitcnt vmcnt(0) lgkmcnt(0)\n\ts_barrier" ::: "memory")
#define WAIT_BAR1() asm volatile("s_waitcnt vmcnt(2) lgkmcnt(0)\n\ts_barrier" ::: "memory")
#define V8(x) ((v8i){(x)[0], (x)[1], (x)[2], (x)[3], 0, 0, 0, 0})
#define V6(x) ((v8i){(int)(x)[0], (int)(x)[1], (int)(x)[2], (int)(x)[3], (int)(x)[4], (int)(x)[5], 0, 0})
#define QKMFMA(a, b, c) __builtin_amdgcn_mfma_scale_f32_32x32x64_f8f6f4(V8(a), V6(b), c, 4, 2, 0, 122, 0, 122)
#define PVMFMA8(a, b, c) __builtin_amdgcn_mfma_scale_f32_32x32x64_f8f6f4(a, b, c, 1, 0, 0, 127, 0, 127)
#define SUMMFMA(a, b, c) __builtin_amdgcn_mfma_scale_f32_16x16x128_f8f6f4(a, b, c, 1, 0, 0, 127, 0, 127)
DEVI int crow(int r, int hi) { return (r & 3) + 8 * (r >> 2) + 4 * hi; }
DEVI unsigned cvtpk(float lo, float hi) { unsigned r; asm("v_cvt_pk_bf16_f32 %0, %1, %2" : "=v"(r) : "v"(lo), "v"(hi)); return r; }
DEVI void glds16(const void* g, unsigned lds_base) {
    unsigned sv; asm volatile("s_mov_b32 %0, m0\n\ts_mov_b32 m0, %2\n\ts_nop 0\n\tglobal_load_lds_dwordx4 %1, off\n\ts_mov_b32 m0, %0" : "=&s"(sv) : "v"(g), "s"(lds_base) : "memory"); }
typedef __attribute__((address_space(3))) const char* lds_cptr;
DEVI v4i lds128(lds_cptr p) { return *(const __attribute__((address_space(3))) v4i*)p; }
DEVI v2i vtr8(lds_cptr p) { return __builtin_amdgcn_ds_read_tr8_b64_v2i32((__attribute__((address_space(3))) v2i*)p); }
typedef unsigned short us2 __attribute__((ext_vector_type(2)));
#define PK16U8(P, PF, B) do { _Pragma("unroll") for (int g_ = 0; g_ < 4; ++g_) { \
        const us2 lo_ = __builtin_amdgcn_cvt_pknorm_u16(P[4 * g_], P[4 * g_ + 1]), hi_ = __builtin_amdgcn_cvt_pknorm_u16(P[4 * g_ + 2], P[4 * g_ + 3]); \
        PF[(B) + g_] = (int)__builtin_amdgcn_perm(__builtin_bit_cast(unsigned, hi_), __builtin_bit_cast(unsigned, lo_), 0x07050301u); } } while (0)
DEVI int pk4bf8(float a, float b, float c, float d) { unsigned w; asm volatile("" : "=v"(w)); w = __builtin_amdgcn_cvt_pk_u8_f32(a, 0, w); w = __builtin_amdgcn_cvt_pk_u8_f32(b, 1, w); w = __builtin_amdgcn_cvt_pk_u8_f32(c, 2, w); w = __builtin_amdgcn_cvt_pk_u8_f32(d, 3, w); return (int)w; }

DEVI int pk4fp8(float a, float b, float c, float d) { int w; asm volatile("" : "=v"(w)); w = __builtin_amdgcn_cvt_pk_fp8_f32(a, b, w, false); w = __builtin_amdgcn_cvt_pk_fp8_f32(c, d, w, true); return w; }
#ifndef F6_INTERLEAVED
#define F6_INTERLEAVED 1
#endif
typedef float v16f __attribute__((ext_vector_type(16)));
typedef unsigned v6u __attribute__((ext_vector_type(6)));
DEVI v6u q_cvt(const u32x4 (&wv)[4], float sc) { v16f a, b;
#pragma unroll
    for (int c = 0; c < 4; ++c) { const u32x4 w = wv[c];
#pragma unroll
        for (int k = 0; k < 4; ++k) { const float lo = __uint_as_float(w[k] << 16) * sc, hi = __uint_as_float(w[k] & 0xffff0000u) * sc; const int i = 4 * c + k;
            if (F6_INTERLEAVED) { a[i] = lo; b[i] = hi; } else if (i < 8) { a[2 * i] = lo; a[2 * i + 1] = hi; } else { b[2 * i - 16] = lo; b[2 * i - 15] = hi; } } }
    return __builtin_amdgcn_cvt_scalef32_2xpk16_fp6_f32(a, b, 1.0f); }
struct QRaw { u32x4 a[4], b[4]; f32x2 s2; };
template <int ROPE> DEVI void q_issue(QRaw& r, const void* Qv, int ldq, const bf16_t* Qr, const float* ssh, int wid, int r32, int hi) {
    const bf16_t* p = (const bf16_t*)Qv + (size_t)(wid * 32 + r32) * ldq + hi * 32;
#pragma unroll
    for (int c = 0; c < 4; ++c) r.a[c] = *(const u32x4*)(p + 8 * c);
    if (ROPE) { const bf16_t* pr = Qr + (size_t)(wid * 32 + r32) * 512;
#pragma unroll
        for (int c = 0; c < 4; ++c) r.b[c] = *(const u32x4*)(pr + 8 * c);
        r.s2 = *(const f32x2*)(ssh + (size_t)(wid * 32 + r32) * 32); } }
template <int ROPE> DEVI void q_convert(const QRaw& r, int hi, v6u& qf, v6u& qrf) {
    if (!ROPE) { qf = q_cvt(r.a, 1.0f); qrf = qf; }
    else { const float sc = rsqrtf((r.s2[0] + r.s2[1]) * (1.f / 96.f) + EPS) * (C2_MLA * 8.f); qf = q_cvt(r.a, sc); qrf = q_cvt(r.b, hi ? 0.f : sc); } }
struct Dma { const unsigned char* dsrc; size_t dstep; unsigned ddst; int dslot, dlead; bool kwave, dma_on; };
template <int ROPE> DEVI Dma dma_setup(const unsigned char* K, int ldk, const unsigned char* Kr, const unsigned char* V, int ldv, unsigned lds0, int wid, int lane) { Dma d;
    const int role = wid < 2 ? 0 : (wid >= 4 ? 1 : ((ROPE && wid == 2) ? 2 : 3)); d.kwave = role != 1; d.dlead = d.kwave ? 4 : 2;
    const int kkey = 32 * (wid & 1) + (lane >> 1), vkey = 16 * (wid & 3) + (lane >> 2);
    d.dsrc = role == 0 ? K + (size_t)kkey * ldk + 16 * ((lane & 1) ^ ((kkey >> 3) & 1))
           : role == 1 ? V + (size_t)vkey * ldv + 16 * ((lane & 3) ^ (2 * ((vkey >> 3) & 1)))
           : (ROPE ? Kr + (size_t)lane * 16 : K);
    d.dstep = (size_t)KVBLK * (role == 0 ? ldk : (role == 1 ? ldv : 16));
    d.ddst = lds0 + (role == 0 ? LDS_K + (wid & 1) * 1024 : (role == 1 ? LDS_V + (wid & 3) * 1024 : LDS_KR));
    d.dslot = role == 0 ? KSLOT : (role == 1 ? SLOT : KRSLOT); d.dma_on = role != 3; return d; }
#define DMAX(d, t, si) glds16((d).dsrc + (size_t)(t) * (d).dstep, (unsigned)__builtin_amdgcn_readfirstlane((d).ddst + (si) * (d).dslot))
DEVI void dma_head(const Dma& d) { if (d.dma_on) { if (d.kwave) { DMAX(d, 0, 0); DMAX(d, 1, 1); DMAX(d, 2, 2); DMAX(d, 3, 3); } else { DMAX(d, 0, 0); DMAX(d, 1, 1); } } }
template <int ROPE>
DEVI void attn_prefetch(const void* Qv, int ldq, const bf16_t* Qr, const float* ssh, const unsigned char* K, int ldk, const unsigned char* Kr, const unsigned char* V, int ldv, char* lds, v6u& qf, v6u& qrf) {
    int tid_ = threadIdx.x; asm volatile("" : "+v"(tid_));
    const int tid = tid_, lane = tid & 63, r32 = lane & 31, hi = lane >> 5; const int wid = __builtin_amdgcn_readfirstlane(tid >> 6);
    if (ROPE) { if (tid < 16) *(int*)(lds + LDS_KR + (tid >> 2) * KRSLOT + 1024 + (tid & 3) * 4) = 0; }
    const Dma d = dma_setup<ROPE>(K, ldk, Kr, V, ldv, (unsigned)(uintptr_t)lds, wid, lane); dma_head(d);
    QRaw qr; q_issue<ROPE>(qr, Qv, ldq, Qr, ssh, wid, r32, hi); q_convert<ROPE>(qr, hi, qf, qrf); }
template <int ROPE>
DEVI void attn_unit(const unsigned char* __restrict__ K, int ldk, const unsigned char* __restrict__ Kr, const unsigned char* __restrict__ V, int ldv, int NT, bf16_t* O, const bf16_t* G, int ldo, char* lds, v6u& qf_io, v6u& qrf_io,
                    bool has_next, const void* Qv_n, int ldq, const bf16_t* Qr_n, const float* ssh_n, const unsigned char* K_n, const unsigned char* Kr_n, const unsigned char* V_n UPROBE_PARAM) {
#ifdef MK_UNIT_PROBE
    const unsigned long long upT0 = __builtin_amdgcn_s_memrealtime();
#endif
    int tid_ = threadIdx.x; asm volatile("" : "+v"(tid_));
    const int tid = tid_, lane = tid & 63, r32 = lane & 31, hi = lane >> 5; const int wid = __builtin_amdgcn_readfirstlane(tid >> 6);
    const unsigned lds0 = (unsigned)(uintptr_t)lds; float* wsf = (float*)(lds + LDS_WS) + wid * 64;
    const Dma dd = dma_setup<ROPE>(K, ldk, Kr, V, ldv, lds0, wid, lane);
    const bool kwave = dd.kwave, dma_on = dd.dma_on; const int dlead = dd.dlead;
#define DMA(t, si) DMAX(dd, t, si)
    const lds_cptr kpa = (lds_cptr)lds + LDS_K + r32 * 32 + ((hi ^ ((r32 >> 3) & 1)) * 16);
    const int vg = (lane >> 4) & 1, vq = (lane & 15) >> 1, vp = lane & 1, vfk = (vq >> 2) & 1;
    const int vrow = (8 * (vq >> 2) + 4 * hi + (vq & 3)) * 64 + 8 * vp + 16 * vg;
    const lds_cptr vp0 = (lds_cptr)lds + LDS_V + vrow + 32 * vfk, vp1 = (lds_cptr)lds + LDS_V + vrow + 32 * (1 - vfk);
    const lds_cptr ra0 = (lds_cptr)lds + LDS_KR + (hi ? 1024 : r32 * 16), ra1 = (lds_cptr)lds + LDS_KR + (hi ? 1024 : 512 + r32 * 16);
    const v6u qf = qf_io, qrf = qrf_io;
    f32x16 o[2]; o[0] = f32x16{}; o[1] = f32x16{}; f32x4 lacc = f32x4{};
    v8i ones;
#pragma unroll
    for (int i = 0; i < 8; ++i) ones[i] = ((lane & 15) == ((lane >> 4) & 1)) ? 0x38383838 : 0;
    PIN(ones);
    f32x16 m4;
    { float y_ = YOFF; asm volatile("" : "+v"(y_));
#pragma unroll
      for (int r = 0; r < 16; ++r) m4[r] = y_; }
    PIN(m4);
    v4i kf0, kf1, krf0, krf1; v8i vf0, vf1, pfA, pfB;
#define ROT() do { } while (0)
#define EX(v) __builtin_amdgcn_exp2f(v)
#define KLOAD(si) do { kf0 = lds128(kpa + (si) * KSLOT); kf1 = lds128(kpa + (si) * KSLOT + 1024); if (ROPE) { krf0 = lds128(ra0 + (si) * KRSLOT); krf1 = lds128(ra1 + (si) * KRSLOT); } } while (0)
    WAIT_BAR0();
    KLOAD(0);
    { f32x16 c0 = QKMFMA(kf0, qf, m4), c1 = QKMFMA(kf1, qf, m4);
      if (ROPE) { c0 = QKMFMA(krf0, qrf, c0); c1 = QKMFMA(krf1, qrf, c1); }
      PK16U8(c0, pfA, 0); PK16U8(c1, pfA, 4); }
    WAIT_BAR0();
    if (dma_on) { if (kwave) { if (4 < NT) DMA(4, 0); } else DMA(2, 2); }
    KLOAD(1);
    WAIT_BAR1();
#define VRD2(m) do { const v2i a_ = vtr8(vp0 + vsl_ * SLOT + (m) * 1024), b_ = vtr8(vp1 + vsl_ * SLOT + (m) * 1024); vf0[2 * (m)] = a_[0]; vf0[2 * (m) + 1] = a_[1]; vf1[2 * (m)] = b_[0]; vf1[2 * (m) + 1] = b_[1]; } while (0)
#define STEP(t, PFP, PFN, GK, GV, GL) do { SBAR(); \
    const int vsl_ = ((t) - 1) & 3; f32x16 C0, C1; \
    VRD2(0); VRD2(1); SBAR(); \
    C0 = QKMFMA(kf0, qf, m4); if (ROPE) C0 = QKMFMA(krf0, qrf, C0); PIN(C0); SBAR(); \
    VRD2(2); VRD2(3); SBAR(); \
    C1 = QKMFMA(kf1, qf, m4); if (ROPE) C1 = QKMFMA(krf1, qrf, C1); PIN(C1); SBAR(); \
    if (GL) { KLOAD(((t) + 1) & 3); } \
    { const bool mine_ = dma_on && (kwave ? (GK) : (GV)); if (mine_) DMA((t) + dlead, kwave ? ((t) & 3) : (((t) + 2) & 3)); } \
    SBAR(); \
    lacc = SUMMFMA(PFP, ones, lacc); PIN(lacc); SBAR(); \
    PK16U8(C0, PFN, 0); PIN(PFN); SBAR(); \
    o[0] = PVMFMA8(PFP, vf0, o[0]); PIN(o[0]); SBAR(); \
    PK16U8(C1, PFN, 4); PIN(PFN); SBAR(); \
    o[1] = PVMFMA8(PFP, vf1, o[1]); PIN(o[1]); SBAR(); \
    { const bool mine_ = dma_on && (kwave ? (GK) : (GV)); if (mine_) WAIT_BAR1(); else WAIT_BAR0(); } \
    } while (0)
#ifdef MK_UNIT_PROBE
    const unsigned long long upT1 = __builtin_amdgcn_s_memrealtime();
#endif
    int t = 1;
    for (; t + 5 < NT; t += 2) {
        STEP(t, pfA, pfB, true, true, true);     ROT();
        STEP(t + 1, pfB, pfA, true, true, true); ROT();
    }
    for (; t + 1 < NT; t += 2) {
        STEP(t, pfA, pfB, (t + 4 < NT), (t + 2 < NT), (t + 1 < NT));         ROT();
        STEP(t + 1, pfB, pfA, (t + 5 < NT), (t + 3 < NT), (t + 2 < NT));     ROT();
    }
    STEP(NT - 1, pfA, pfB, false, false, false);
#ifdef MK_UNIT_PROBE
    const unsigned long long upT2 = __builtin_amdgcn_s_memrealtime();
#endif
    if (has_next) { const Dma dn = dma_setup<ROPE>(K_n, ldk, Kr_n, V_n, ldv, lds0, wid, lane); dma_head(dn); }
    u32x4 gv[4];
#pragma unroll
    for (int i = 0; i < 4; ++i) gv[i] = *(const u32x4*)(G + (size_t)(wid * 32 + i * 8 + (lane >> 3)) * ldo + (lane & 7) * 8);
    QRaw qn;
    if (has_next) q_issue<ROPE>(qn, Qv_n, ldq, Qr_n, ssh_n, wid, r32, hi);
    { const int vsl_ = (NT - 1) & 3; VRD2(0); VRD2(1); VRD2(2); VRD2(3);
      lacc = SUMMFMA(pfB, ones, lacc); o[0] = PVMFMA8(pfB, vf0, o[0]); o[1] = PVMFMA8(pfB, vf1, o[1]); }
    float rli[16];
#pragma unroll
    for (int r = 0; r < 16; ++r) rli[r] = 0.f;
    if ((lane & 15) < 2) *(f32x4*)(wsf + (lane & 15) * 16 + 4 * (lane >> 4)) = lacc;
    asm volatile("s_waitcnt lgkmcnt(0)" ::: "memory");
#pragma unroll
    for (int r = 0; r < 16; ++r) rli[r] = __builtin_amdgcn_rcpf(wsf[crow(r, hi)]);
    bf16_t* stg = (bf16_t*)(lds + LDS_OST) + wid * 2048;
#pragma unroll
    for (int r = 0; r < 16; ++r) { const int orow = crow(r, hi);
#pragma unroll
        for (int d0 = 0; d0 < 2; ++d0) stg[orow * 64 + d0 * 32 + r32] = (bf16_t)f2bf(o[d0][r] * rli[r]); }
    asm volatile("s_waitcnt lgkmcnt(0)" ::: "memory");
#pragma unroll
    for (int i = 0; i < 4; ++i) { const int row = i * 8 + (lane >> 3), ch = lane & 7; const size_t goff = (size_t)(wid * 32 + row) * ldo + ch * 8;
        const u32x4 ov = *(const u32x4*)(stg + row * 64 + ch * 8); u32x4 w;
#pragma unroll
        for (int q = 0; q < 4; ++q) { const float lo = __uint_as_float(ov[q] << 16) * __uint_as_float(gv[i][q] << 16), hh = __uint_as_float(ov[q] & 0xffff0000u) * __uint_as_float(gv[i][q] & 0xffff0000u); w[q] = cvtpk(lo, hh); }
        *(u32x4*)(O + goff) = w; }
    if (has_next) q_convert<ROPE>(qn, hi, qf_io, qrf_io);
    asm volatile("s_waitcnt lgkmcnt(0)\n\ts_barrier" ::: "memory");
#ifdef MK_UNIT_PROBE
    { const unsigned long long upT3 = __builtin_amdgcn_s_memrealtime(); const int w_ = MK_UNIT_PROBE & 3; upacc += w_ == 1 ? (upT1 - upT0) : (w_ == 2 ? (upT3 - upT2) : (upT2 - upT1)); }
#endif
#undef DMA
#undef ROT
#undef EX
#undef KLOAD
#undef VRD2
#undef STEP
}
#undef SBAR
#undef PIN
#undef WAIT_BAR0
#undef WAIT_BAR1
#undef QKMFMA
#undef DMAX
#undef SUMMFMA
#undef V8
#undef V6
#undef PVMFMA8
}

#define RLX_AGENT __ATOMIC_RELAXED, __HIP_MEMORY_SCOPE_AGENT
#define XB_TMO      128
#define XB_XCNT(j)  (256  + 64 * (j))
#define XB_XSUB(j)  (1280 + 64 * (j))
#define XB_XGEN(j)  (2304 + 64 * (j))
#define XB_TOP      3328
#define XB_TOPGEN   3392
#define XCD_BAR_WORDS 3456
#define XB_SPIN_CAP (1u << 18)

__device__ __forceinline__ unsigned xb_ld(unsigned* p)              { return __hip_atomic_load(p, __ATOMIC_RELAXED, __HIP_MEMORY_SCOPE_AGENT); }
__device__ __forceinline__ unsigned xb_add(unsigned* p, unsigned v) { return __hip_atomic_fetch_add(p, v, __ATOMIC_RELAXED, __HIP_MEMORY_SCOPE_AGENT); }
__device__ __forceinline__ unsigned xb_xcc_id() { return (unsigned)__builtin_amdgcn_s_getreg((3 << 11) | 20) & 0xFu; }
#define XB_SPIN(cond, bar) do { unsigned _sp = 0; while (cond) { __builtin_amdgcn_s_sleep(1); \
    if ((++_sp & 255u) == 0u) { if (xb_ld(&(bar)[XB_TMO])) break; if (_sp > XB_SPIN_CAP) { atomicAdd(&(bar)[XB_TMO], 1u); break; } } } } while (0)

struct XcdBarrier {
    unsigned* bar; unsigned x;
    volatile LAS unsigned* st;
};

__device__ __forceinline__ XcdBarrier xcd_barrier_post(unsigned* bar, volatile LAS unsigned* st) {
    XcdBarrier b; b.bar = bar; b.x = xb_xcc_id(); b.st = st;
    if (threadIdx.x == 0) (void)xb_add(&bar[XB_XCNT(b.x)], 1u);
    return b;
}
__device__ __forceinline__ void xcd_barrier_complete(unsigned* bar, unsigned x, unsigned& nloc, unsigned& nx) {
    const unsigned G = gridDim.x * gridDim.y * gridDim.z;
    unsigned sum, cnt, mine, sp = 0u;
    for (;;) {
        sum = 0u; cnt = 0u; mine = 0u;
#pragma unroll
        for (unsigned j = 0; j < 16; ++j) { const unsigned c = xb_ld(&bar[XB_XCNT(j)]); sum += c; cnt += (c > 0u) ? 1u : 0u; mine = (j == x) ? c : mine; }
        if (sum == G) break;
        __builtin_amdgcn_s_sleep(1);
        if ((++sp & 255u) == 0u) { if (xb_ld(&bar[XB_TMO])) break; if (sp > XB_SPIN_CAP) { atomicAdd(&bar[XB_TMO], 1u); break; } }
    }
    nloc = mine > 0u ? mine : 1u; nx = cnt > 0u ? cnt : 1u;
}

__device__ __forceinline__ void xcd_barrier(const XcdBarrier& b) {
    asm volatile("s_waitcnt vmcnt(0)" ::: "memory");
    __syncthreads();
    if (threadIdx.x == 0) {
        unsigned* bar = b.bar;
        __builtin_amdgcn_s_waitcnt(0);
        unsigned nloc = b.st[0], nx = b.st[1];
        if (nloc == 0u) { xcd_barrier_complete(bar, b.x, nloc, nx); b.st[0] = nloc; b.st[1] = nx; }
        const unsigned old = xb_add(&bar[XB_XSUB(b.x)], 1u);
        const unsigned gen = old / nloc;
        if (old + 1u == (gen + 1u) * nloc) {
            __builtin_amdgcn_fence(__ATOMIC_RELEASE, "agent");
            asm volatile("s_waitcnt vmcnt(0)" ::: "memory");
            const unsigned og = xb_add(&bar[XB_TOP], 1u);
            const unsigned tg = og / nx;
            if (og + 1u == (tg + 1u) * nx) xb_add(&bar[XB_TOPGEN], 1u);
            else XB_SPIN(xb_ld(&bar[XB_TOPGEN]) == tg, bar);
            __builtin_amdgcn_fence(__ATOMIC_ACQUIRE, "agent");
            xb_add(&bar[XB_XGEN(b.x)], 1u);
            asm volatile("s_waitcnt vmcnt(0)" ::: "memory");
        } else {
            XB_SPIN(xb_ld(&bar[XB_XGEN(b.x)]) == gen, bar);
            __builtin_amdgcn_fence(__ATOMIC_ACQUIRE, "agent");
            asm volatile("s_waitcnt vmcnt(0)" ::: "memory");
        }
    }
    __syncthreads();
}


#include <hip/hip_cooperative_groups.h>
namespace cg = cooperative_groups;
constexpr int NWAVES = 8, NTHREADS = 512, LDS_BYTES = 147456, RING_BYTES = 131072;
constexpr size_t MiB = 1u << 20;
constexpr size_t WS_MOD = 1 * MiB;
constexpr size_t WS_TABA = WS_MOD + 128 * 1024;
constexpr size_t WS_TABB = WS_TABA + 32 * 1024;
constexpr size_t WS_WIN0 = 2 * MiB;
constexpr size_t WS_WOUT0 = 7 * MiB;
constexpr size_t WS_WIN1 = 9 * MiB;
constexpr size_t WS_WKVB = 13 * MiB;
constexpr size_t WS_WQB = 14 * MiB;
constexpr size_t WS_WOUT1 = 16 * MiB;
constexpr size_t WS_X1C = 18 * MiB;
constexpr size_t WS_H = 20 * MiB;
constexpr size_t WS_Q = 53 * MiB;
constexpr size_t WS_K = 86 * MiB;
constexpr size_t WS_V0 = 95 * MiB;
constexpr size_t WS_G = 120 * MiB;
constexpr size_t WS_V1 = 153 * MiB;
constexpr size_t WS_KVA = 186 * MiB;
constexpr size_t WS_QA = 195 * MiB;
constexpr size_t WS_Q1R = 207 * MiB;
constexpr size_t WS_KR = 223 * MiB;
constexpr size_t WS_SSKV = 225 * MiB;
constexpr size_t WS_SSQ = 226 * MiB;
constexpr size_t WS_SSH = 227 * MiB;
constexpr size_t WS_SSX = 229 * MiB;
constexpr size_t WS_BIAS1 = WS_MOD + 80 * 1024;
constexpr size_t WS_NWM1 = WS_MOD + 104 * 1024;
constexpr size_t WS_RINV = 230 * MiB + 512 * 1024;
constexpr size_t WS_SLAB = 231 * MiB;
constexpr size_t WS_END = 256 * MiB;
static_assert(WS_K + (size_t)NB * TK * DM * 2 <= WS_G && WS_G + (size_t)MT * DM * 2 <= WS_V1 && WS_V1 + (size_t)NB * TK * DM * 2 <= WS_KVA && WS_SSH + (size_t)ML * 32 * 4 <= WS_END, "ws map");

#ifndef ATT1_F8
#define ATT1_F8 1
#endif
#ifndef ATT0_F8
#define ATT0_F8 1
#endif
struct Args { const float* in[23]; float* out; unsigned char* ws; int ph_lo, ph_hi, coop, pad; };

DEVI void phase0(const Args& a, unsigned char* ws, LAS unsigned char* lds, int vb, int G) {
    const int tid = threadIdx.x, wave = tid >> 6, lane = tid & 63;
    float* mod = (float*)(ws + WS_MOD);
    if (vb < 96) {
        LAS float* sc = (LAS float*)lds; LAS float* red = sc + 3 * 1024;
        const int layer = vb / 48, cs = vb % 48; const float* w = a.in[layer ? 11 : 4]; const float* bb = a.in[layer ? 12 : 5];
        for (int i = tid; i < 3072; i += NTHREADS) { const int r = i >> 10, k = i & 1023; const float v = r < 2 ? a.in[1][r * 1024 + k] : a.in[3][k]; sc[i] = v / (1.f + expf(-v)); }
        __syncthreads();
        const int col = cs * 64 + lane; float a0 = 0.f, a1 = 0.f, a2 = 0.f;
#pragma unroll 8
        for (int k = wave * 128; k < wave * 128 + 128; ++k) { const float wv = w[(size_t)k * 3072 + col]; a0 += sc[k] * wv; a1 += sc[1024 + k] * wv; a2 += sc[2048 + k] * wv; }
        red[(wave * 3 + 0) * 64 + lane] = a0; red[(wave * 3 + 1) * 64 + lane] = a1; red[(wave * 3 + 2) * 64 + lane] = a2;
        __syncthreads();
        if (tid < 192) { const int r = tid >> 6; float s = 0.f;
#pragma unroll
            for (int q = 0; q < 8; ++q) s += red[(q * 3 + r) * 64 + lane];
            mod[(size_t)(layer * 3 + r) * 3072 + col] = s + bb[col]; }
        __syncthreads();
    } else if (vb < 102) {
        f32x2* tabA = (f32x2*)(ws + WS_TABA); f32x2* tabB = (f32x2*)(ws + WS_TABB);
        const int i = (vb - 96) * NTHREADS + tid;
        if (i < 128 * 16) { const int pos = i >> 4, f = i & 15; const float invf = powf(10000.f, -(float)f / 16.f); float cs_, sn_; sincos_pos((float)pos * invf, cs_, sn_); tabA[i] = (f32x2){cs_, sn_}; }
        else if (i < 128 * 24) { const int j = i - 128 * 16, pos = j >> 3, f = j & 7; const float invf = powf(10000.f, -(float)f / 8.f); float cs_, sn_; sincos_pos((float)pos * invf, cs_, sn_); tabB[j] = (f32x2){cs_, sn_}; }
    }
    if (vb < 102 || G <= 102) { if (G > 102) return; }
    struct WD { int src, K, Nsrc, Np, mode, ks; size_t dst; };
    const WD wd[6] = {{7, 1024, N_IN0, 2560, 1, -1, WS_WIN0}, {10, 1024, 1024, 1024, 0, -1, WS_WOUT0}, {14, 1024, N_IN1, N_IN1P, 2, -1, WS_WIN1},
                      {16, 256, 2048, 2048, 3, 15, WS_WKVB}, {18, 384, 1536, 2048, 4, 17, WS_WQB}, {22, 1024, 1024, 1024, 0, -1, WS_WOUT1}};
    LAS float* tl = (LAS float*)lds; int tbase = 0;
#pragma unroll
    for (int m = 0; m < 6; ++m) {
        const float* W = a.in[wd[m].src]; const float* ks = wd[m].ks >= 0 ? a.in[wd[m].ks] : nullptr; bf16_t* Bt = (bf16_t*)(ws + wd[m].dst);
        const int K = wd[m].K, Nsrc = wd[m].Nsrc, Np = wd[m].Np, npb = Np / 256, ntile = (K / 64) * npb;
        for (int it = ((vb - 102) - tbase % (G - 102) + (G - 102)) % (G - 102); it < ntile; it += (G - 102)) {
            const int kb = it / npb, pb = it % npb, k0 = 64 * kb, p0 = 256 * pb;
            const int pl = tid & 255, kh = tid >> 8; int cc = pg8::wmap(wd[m].mode, p0 + pl); if (cc >= Nsrc) cc = -1;
            float v[32];
#pragma unroll
            for (int i = 0; i < 32; ++i) { const int k = k0 + 2 * i + kh; v[i] = cc >= 0 ? W[(size_t)k * Nsrc + cc] * (ks ? ks[k] : 1.f) : 0.f; }
#pragma unroll
            for (int i = 0; i < 32; ++i) tl[pl * 65 + 2 * i + kh] = v[i];
            __syncthreads();
#pragma unroll
            for (int j = 0; j < 4; ++j) { const int q = tid + 512 * j, pr = q >> 3, c = q & 7; const LAS float* sp = tl + pr * 65 + 8 * c;
                u32x4 o; o.x = pk2(sp[0], sp[1]); o.y = pk2(sp[2], sp[3]); o.z = pk2(sp[4], sp[5]); o.w = pk2(sp[6], sp[7]);
                *(u32x4*)(Bt + (size_t)(p0 + pr) * K + k0 + 8 * c) = o; }
            __syncthreads();
        }
        tbase += ntile;
    }
}

DEVI void phase_prep(const float* xa, const float* xb, const float* nw, const float* mod, bf16_t* H, int gw, int NGW, int lane) {
    for (int row0 = gw; row0 < MT; row0 += 4 * NGW) {
        f32x4 v[4][4]; float ss[4];
#pragma unroll
        for (int q = 0; q < 4; ++q) { const int row = row0 + q * NGW; ss[q] = 0.f;
            if (row < MT) { const float* src = row < ML ? xa + (size_t)row * DM : xb + (size_t)(row - ML) * DM;
#pragma unroll
                for (int j = 0; j < 4; ++j) v[q][j] = *(const f32x4*)(src + 4 * lane + 256 * j); } }
#pragma unroll
        for (int q = 0; q < 4; ++q) { const int row = row0 + q * NGW;
            if (row < MT) {
#pragma unroll
                for (int j = 0; j < 4; ++j) ss[q] += (v[q][j].x * v[q][j].x + v[q][j].y * v[q][j].y) + (v[q][j].z * v[q][j].z + v[q][j].w * v[q][j].w); } }
#pragma unroll
        for (int o = 1; o < 64; o <<= 1) {
#pragma unroll
            for (int q = 0; q < 4; ++q) ss[q] += __shfl_xor(ss[q], o); }
#pragma unroll
        for (int q = 0; q < 4; ++q) { const int row = row0 + q * NGW;
            if (row < MT) { const int r = row < SEQ ? 0 : (row < ML ? 1 : 2); const float rinv = rsqrtf(ss[q] * (1.f / DM) + EPS);
#pragma unroll
                for (int j = 0; j < 4; ++j) { const int cidx = 4 * lane + 256 * j; const f32x4 w = *(const f32x4*)(nw + cidx);
                    const f32x4 sh = *(const f32x4*)(mod + (size_t)r * 3072 + cidx), scl = *(const f32x4*)(mod + (size_t)r * 3072 + 1024 + cidx);
                    const f32x4 h = (v[q][j] * rinv) * w * (scl + 1.f) + sh;
                    u32x2 o; o.x = pk2(h.x, h.y); o.y = pk2(h.z, h.w); *(u32x2*)(H + (size_t)row * DM + cidx) = o; } } }
    }
}

DEVI float sq4f(const f32x4 v) { return (v[0] * v[0] + v[1] * v[1]) + (v[2] * v[2] + v[3] * v[3]); }
DEVI void phase1_extras(const float* nw1, const float* mod1, const bf16_t* Win1t, float* nwm1, float* bias1, const float* ctx, float* X1c, int gw, int NGW, int lane) {
    for (int p = gw; p < N_IN1P; p += NGW) {
        const u32x4 w0 = *(const u32x4*)(Win1t + (size_t)p * DM + lane * 16), w1 = *(const u32x4*)(Win1t + (size_t)p * DM + lane * 16 + 8); float acc3[3];
#pragma unroll
        for (int r = 0; r < 3; ++r) { const float* mp = mod1 + (size_t)r * 3072 + lane * 16; const f32x4 m0 = *(const f32x4*)mp, m1 = *(const f32x4*)(mp + 4), m2 = *(const f32x4*)(mp + 8), m3 = *(const f32x4*)(mp + 12);
            const float mm[16] = {m0[0], m0[1], m0[2], m0[3], m1[0], m1[1], m1[2], m1[3], m2[0], m2[1], m2[2], m2[3], m3[0], m3[1], m3[2], m3[3]}; float a = 0.f;
#pragma unroll
            for (int i = 0; i < 8; ++i) { const unsigned ww = i < 4 ? w0[i] : w1[i - 4]; a += mm[2 * i] * __uint_as_float(ww << 16) + mm[2 * i + 1] * __uint_as_float(ww & 0xffff0000u); }
            acc3[r] = wave_sum(a); }
        if (lane == 0) { bias1[p] = acc3[0]; bias1[N_IN1P + p] = acc3[1]; bias1[2 * N_IN1P + p] = acc3[2]; }
    }
    for (int i = gw * 64 + lane; i < 3 * DM; i += NGW * 64) { const int r = i >> 10, c = i & 1023; nwm1[i] = nw1[c] * (1.f + mod1[(size_t)r * 3072 + 1024 + c]); }
}
DEVI void phase_ctxprep(const float* ctx, const float* slab, const float* gatec, float* X1c, const float* nwm1, bf16_t* H, const float* SSX, float* RINV, int gw, int NGW, int lane) {
    for (int rr = gw; rr < MC; rr += NGW) { const int R = ML + rr; float ss = 0.f;
#pragma unroll
        for (int j = 0; j < 4; ++j) { const int c = 4 * lane + 256 * j; f32x4 y = *(const f32x4*)(slab + (size_t)rr * DM + c);
#pragma unroll
            for (int ks = 1; ks < 8; ++ks) y = y + *(const f32x4*)(slab + ((size_t)ks * MC + rr) * DM + c);
            const f32x4 v = *(const f32x4*)(ctx + (size_t)rr * DM + c) + *(const f32x4*)(gatec + c) * y; *(f32x4*)(X1c + (size_t)rr * DM + c) = v;
            ss += sq4f(v); const f32x4 h = v * *(const f32x4*)(nwm1 + 2 * DM + c);
            u32x2 o; o.x = pk2(h.x, h.y); o.y = pk2(h.z, h.w); *(u32x2*)(H + (size_t)R * DM + c) = o; }
        ss = wave_sum(ss); if (lane == 0) RINV[R] = rsqrtf(ss * (1.f / DM) + EPS); }
    for (int R = gw * 64 + lane; R < ML; R += NGW * 64) { const f32x4 s0 = *(const f32x4*)(SSX + (size_t)R * 16), s1 = *(const f32x4*)(SSX + (size_t)R * 16 + 4), s2 = *(const f32x4*)(SSX + (size_t)R * 16 + 8), s3 = *(const f32x4*)(SSX + (size_t)R * 16 + 12);
        const f32x4 st = (s0 + s1) + (s2 + s3); RINV[R] = rsqrtf(((st[0] + st[1]) + (st[2] + st[3])) * (1.f / DM) + EPS); }
}

#ifdef MK_UBENCH
DEVI void ubench(int wave) {
    typedef int v8i __attribute__((ext_vector_type(8)));
    if ((MK_UBENCH & 4) && wave >= 4) return;
    v8i a, b; f32x16 acc = f32x16{}; float e[8]; float d = 0.f;
#pragma unroll
    for (int i = 0; i < 8; ++i) { a[i] = 0x38383838; b[i] = 0x38383838; e[i] = 0.001f * (float)(i + 1); }
    asm volatile("" : "+v"(a), "+v"(b));
    bf16x8 ha, hb; asm volatile("" : "=v"(ha), "=v"(hb));
    for (int it = 0; it < 1500; ++it) {
        if (MK_UBENCH & 1) { if (MK_UBENCH & 16) { acc = __builtin_amdgcn_mfma_f32_32x32x16_bf16(ha, hb, acc, 0, 0, 0); acc = __builtin_amdgcn_mfma_f32_32x32x16_bf16(ha, hb, acc, 0, 0, 0); }
                             else if (MK_UBENCH & 32) acc = __builtin_amdgcn_mfma_scale_f32_32x32x64_f8f6f4(a, b, acc, 4, 2, 0, 127, 0, 127);
                             else if (MK_UBENCH & 64) acc = __builtin_amdgcn_mfma_scale_f32_32x32x64_f8f6f4(a, b, acc, 4, 4, 0, 127, 0, 127);
                             else acc = __builtin_amdgcn_mfma_scale_f32_32x32x64_f8f6f4(a, b, acc, 0, 0, 0, 127, 0, 127); }
        if (MK_UBENCH & 2) {
#pragma unroll
            for (int i = 0; i < 8; ++i) e[i] = __builtin_amdgcn_exp2f(e[i]) * 0.5f; }
        if (MK_UBENCH & 8) {
#pragma unroll
            for (int i = 0; i < 16; ++i) asm volatile("v_add_f32 %0, %0, %1" : "+v"(e[i & 7]) : "v"(d)); }
        asm volatile("" : "+v"(acc)); __builtin_amdgcn_sched_barrier(0);
    }
#pragma unroll
    for (int i = 0; i < 8; ++i) asm volatile("" :: "v"(e[i]));
    asm volatile("" :: "v"(acc));
}
#endif
__global__ void __launch_bounds__(NTHREADS, 2) mega(Args a) {
    extern __shared__ __attribute__((aligned(16))) unsigned char lds[];
    const int tid = threadIdx.x, lane = tid & 63; const int wave = __builtin_amdgcn_readfirstlane(tid >> 6);
    const int G = gridDim.x, bx = blockIdx.x; const int vcu = (G % 8 == 0) ? (bx % 8) * (G / 8) + bx / 8 : bx;
    unsigned char* ws = a.ws; float* out = a.out;
    const float* x = a.in[0]; const float* ctx = a.in[2];
    float* mod = (float*)(ws + WS_MOD); const f32x4* tabA = (const f32x4*)(ws + WS_TABA); const f32x4* tabB = (const f32x4*)(ws + WS_TABB);
    bf16_t* H = (bf16_t*)(ws + WS_H); bf16_t* Qb = (bf16_t*)(ws + WS_Q); bf16_t* K0 = (bf16_t*)(ws + WS_K); bf16_t* V0 = (bf16_t*)(ws + WS_V0); bf16_t* K1 = (bf16_t*)(ws + WS_K);
    bf16_t* Gb = (bf16_t*)(ws + WS_G); bf16_t* V1 = (bf16_t*)(ws + WS_V1); bf16_t* KVA = (bf16_t*)(ws + WS_KVA); bf16_t* QA = (bf16_t*)(ws + WS_QA); bf16_t* Q1R = (bf16_t*)(ws + WS_Q1R);
    bf16_t* O0 = (bf16_t*)(ws + WS_V1); bf16_t* O1 = (bf16_t*)(ws + WS_H); bf16_t* KR = (bf16_t*)(ws + WS_KR); float* SSKV = (float*)(ws + WS_SSKV); float* SSQ = (float*)(ws + WS_SSQ); float* SSH = (float*)(ws + WS_SSH); float* X1c = (float*)(ws + WS_X1C); float* SSX = (float*)(ws + WS_SSX); float* BIAS1 = (float*)(ws + WS_BIAS1); float* NWM1 = (float*)(ws + WS_NWM1);
#ifdef MK_TS
#define MK_TS_SEAM (MK_TS >= 100 ? (MK_TS % 100) : MK_TS / 2)
#define MK_TS_WHAT (MK_TS % 2)
#endif
#ifdef MK_TS_SEAM
    const unsigned long long ts0 = __builtin_amdgcn_s_memrealtime(); unsigned long long ts1 = ts0, ts2 = ts0;
#endif
    const int lo = a.ph_lo, hi_ = a.ph_hi;
#ifndef ONLY_PHASE
#define ONLY_PHASE -1
#endif
#define IN(k) ((ONLY_PHASE < 0 || ONLY_PHASE == (k)) && lo <= (k) && (k) < hi_)
#ifndef MK_REP_MASK
#define MK_REP_MASK 0
#endif
#define REPS(k) (((MK_REP_MASK >> (k)) & 1) ? 2 : 1)
#ifdef MK_TS_SEAM
#define SEAM(k) do { if (IN(k) && IN((k) + 1)) { if ((k) == MK_TS_SEAM) { ts1 = __builtin_amdgcn_s_memrealtime(); if (tid == 0) { atomicMax((unsigned*)ws + 4000, (unsigned)(ts1 - ts0)); atomicMax((unsigned*)ws + 4001, ((unsigned)(ts1 - ts0) << 10) | (unsigned)bx); } } xcd_barrier(xbar); if ((k) == MK_TS_SEAM) ts2 = __builtin_amdgcn_s_memrealtime(); } } while (0)
#else
#define SEAM(k) do { if (IN(k) && IN((k) + 1)) { xcd_barrier(xbar); } } while (0)
#endif
    PG8_LAS unsigned char* ring = (PG8_LAS unsigned char*)lds;
    volatile LAS unsigned* xst = (volatile LAS unsigned*)((LAS unsigned char*)lds + RING_BYTES + 512);
    if (tid < 4) xst[tid] = 0u;
    __syncthreads();
    XcdBarrier xbar; xbar.bar = (unsigned*)ws; xbar.x = 0; xbar.st = xst;
    if (a.coop) xbar = xcd_barrier_post((unsigned*)ws, xst);
    if (a.coop == 0x7fffffff) cg::this_grid().sync();

    if (IN(0)) for (int rep_ = 0; rep_ < REPS(0); ++rep_) { phase0(a, ws, (LAS unsigned char*)lds, bx, G); } SEAM(0);
    if (IN(1)) for (int rep_ = 0; rep_ < REPS(1); ++rep_) { phase1_extras(a.in[13], mod + 3 * 3072, (const bf16_t*)(ws + WS_WIN1), NWM1, BIAS1, ctx, X1c, vcu * NWAVES + wave, G * NWAVES, lane);
        phase_prep(x, ctx, a.in[6], mod, H, vcu * NWAVES + wave, G * NWAVES, lane); } SEAM(1);
    if (IN(2)) { pg8::Gemm g{H, (const bf16_t*)(ws + WS_WIN0), MT, N_IN0, 1024}; pg8::ROrder S; S.init(0, MT / 256, N_IN0, G, bx, REPS(2));
        pg8::EpiIn0<ATT0_F8> E{a.in[8], a.in[9], tabA, K0, V0, Qb, Gb};
        pg8::gemm_phase<pg8::EpiIn0<ATT0_F8>, pg8::ROrder, true, true>(ring, g, S, E); } SEAM(2);
#ifdef MK_UNIT_PROBE
    unsigned long long upacc = 0, updummy = 0;
#define UPROBE_ARG3 , *((MK_UNIT_PROBE & 48) == 0 ? &upacc : &updummy)
#define UPROBE_ARGC , *((MK_UNIT_PROBE & 48) == 32 ? &upacc : &updummy)
#define UPROBE_ARG8 , *((MK_UNIT_PROBE & 48) == 16 ? &upacc : &updummy)
#else
#define UPROBE_ARG3
#define UPROBE_ARGC
#define UPROBE_ARG8
#endif
#ifdef MK_CLOCK_PROBE
    unsigned long long pc0 = 0, pr0 = 0, pc1 = 0, pr1 = 0;
    if (IN(3)) { pc0 = __builtin_readcyclecounter(); pr0 = __builtin_amdgcn_s_memrealtime(); }
#endif
    if (IN(3)) for (int rep_ = 0; rep_ < REPS(3); ++rep_) {
        const int xg = vcu >> 5, c = vcu & 31, b = xg >> 2, kvh = xg & 3; const size_t kbase = (size_t)b * TK * 256 + kvh * 64;
#ifdef MK_PROBE_NT
        const int NT3 = (rep_ + 1 < REPS(3)) ? MK_PROBE_NT : TK / 64;
#else
        const int NT3 = TK / 64;
#endif
#if ATT0_F8
        const unsigned char* K8 = (const unsigned char*)K0 + (size_t)b * TK * 128 + kvh * 32; const unsigned char* V8 = (const unsigned char*)V0 + kbase;
        const size_t qc0 = ((size_t)ML + b * CTXL) * DM + (kvh * 4 + c) * 64;
        af8::v6u qf, qrf;
        af8::attn_prefetch<0>(Qb + ((size_t)b * SEQ + c * 256) * DM + kvh * 4 * 64, DM, nullptr, nullptr, K8, 128, nullptr, V8, 256, (char*)lds, qf, qrf);
        for (int i = 0; i < 4; ++i) { const int h = kvh * 4 + i; const size_t q0 = ((size_t)b * SEQ + c * 256) * DM + h * 64; const bool nx = i < 3 || c < 4; const size_t q0n = i < 3 ? q0 + 64 : qc0;
            af8::attn_unit<0>(K8, 128, nullptr, V8, 256, NT3, O0 + q0, Gb + q0, DM, (char*)lds, qf, qrf, nx, Qb + q0n, DM, nullptr, nullptr, K8, nullptr, V8 UPROBE_ARG3); }
        if (c < 4) af8::attn_unit<0>(K8, 128, nullptr, V8, 256, CTXL / 64, O0 + qc0, Gb + qc0, DM, (char*)lds, qf, qrf, false, nullptr, DM, nullptr, nullptr, K8, nullptr, V8 UPROBE_ARGC);
#else
        for (int i = 0; i < 4; ++i) { const int h = kvh * 4 + i; const size_t q0 = ((size_t)b * SEQ + c * 256) * DM + h * 64;
            afast::attn_unit<0>(Qb + q0, DM, nullptr, nullptr, K0 + kbase, 256, nullptr, V0 + kbase, 256, TK / 64, O0 + q0, Gb + q0, DM, (char*)lds); }
        if (c < 4) { const int h = kvh * 4 + c; const size_t q0 = ((size_t)ML + b * CTXL) * DM + h * 64;
            afast::attn_unit<0>(Qb + q0, DM, nullptr, nullptr, K0 + kbase, 256, nullptr, V0 + kbase, 256, CTXL / 64, O0 + q0, Gb + q0, DM, (char*)lds); }
#endif
    } SEAM(3);
#ifdef MK_CLOCK_PROBE
    if (IN(3)) { pc1 = __builtin_readcyclecounter(); pr1 = __builtin_amdgcn_s_memrealtime(); }
#endif
    if (IN(4)) {
        { pg8::Gemm g{O0, (const bf16_t*)(ws + WS_WOUT0), ML, 1024, 1024, 0}; pg8::ROrder S; S.init(0, ML / 256, 1024, G, bx, REPS(4));
          pg8::EpiOutF E{x, out, mod + 2048, NWM1, H, SSX};
          pg8::gemm_phase<pg8::EpiOutF, pg8::ROrder, true, true>(ring, g, S, E); }
        { pg8::Gemm g{O0, (const bf16_t*)(ws + WS_WOUT0), MT, 1024, 1024, 128}; pg8::CtxSplitOrder S; S.init(bx, 8, 128);
          pg8::EpiOutSlab E{(float*)(ws + WS_SLAB), 128};
          pg8::gemm_phase<pg8::EpiOutSlab, pg8::CtxSplitOrder, true, true>(ring, g, S, E); }
    } SEAM(4);
    if (IN(5)) { phase_ctxprep(ctx, (const float*)(ws + WS_SLAB), mod + 2048 + 2 * 3072, X1c, NWM1, H, SSX, (float*)(ws + WS_RINV), vcu * NWAVES + wave, G * NWAVES, lane); } SEAM(5);
    if (IN(6)) { pg8::Gemm g{H, (const bf16_t*)(ws + WS_WIN1), MT, N_IN1P, 1024}; pg8::In1Order S; S.init(G, bx);
        pg8::EpiIn1<ATT1_F8> E{a.in[21], tabB, KVA, SSKV, QA, SSQ, KR, Gb, (const float*)(ws + WS_RINV), BIAS1};
        pg8::gemm_phase<pg8::EpiIn1<ATT1_F8>, pg8::In1Order, true, true>(ring, g, S, E); } SEAM(6);
    if (IN(7)) {
        { pg8::Gemm g{KVA, (const bf16_t*)(ws + WS_WKVB), MT, 2048, 256}; pg8::ROrder S; S.init(0, MT / 256, 2048, G, bx, REPS(7));
          pg8::EpiKvb<ATT1_F8> E{SSKV, a.in[20], K1, V1};
          pg8::gemm_phase<pg8::EpiKvb<ATT1_F8>, pg8::ROrder, true, true>(ring, g, S, E); }
        { pg8::Gemm g{QA, (const bf16_t*)(ws + WS_WQB), ML, 2048, 384}; pg8::ROrder S; S.init(0, ML / 256, 2048, G, bx, REPS(7));
          pg8::EpiQb E{SSQ, a.in[19], tabB, Qb, Q1R, SSH};
          pg8::gemm_phase<pg8::EpiQb, pg8::ROrder, true, true>(ring, g, S, E); }
    } SEAM(7);
    if (IN(8)) for (int rep_ = 0; rep_ < REPS(8); ++rep_) {
        const int xg = vcu >> 5, c = vcu & 31;
#if ATT1_F8
        af8::v6u qf, qrf;
        { const int s0 = xg, b = s0 >> 4, h = s0 & 15; const size_t row0 = (size_t)b * SEQ + c * 256;
          af8::attn_prefetch<1>(Qb + row0 * DM + h * 64, DM, Q1R + row0 * 512 + h * 32, SSH + (row0 * 16 + h) * 2, (const unsigned char*)K1 + (size_t)b * TK * 512 + h * 32, 512, (const unsigned char*)KR + (size_t)b * TK * 16,
                                (const unsigned char*)V1 + (size_t)b * TK * DM + h * 64, DM, (char*)lds, qf, qrf); }
#endif
        for (int i = 0; i < 4; ++i) { const int s = xg + 8 * i, b = s >> 4, h = s & 15; const size_t row0 = (size_t)b * SEQ + c * 256, q0 = row0 * DM + h * 64;
#if ATT1_F8
            const int sn = xg + 8 * (i < 3 ? i + 1 : i), bn = sn >> 4, hn = sn & 15; const size_t row0n = (size_t)bn * SEQ + c * 256;
            af8::attn_unit<1>((const unsigned char*)K1 + (size_t)b * TK * 512 + h * 32, 512, (const unsigned char*)KR + (size_t)b * TK * 16, (const unsigned char*)V1 + (size_t)b * TK * DM + h * 64, DM, TK / 64, O1 + q0, Gb + q0, DM, (char*)lds, qf, qrf,
                              i < 3, Qb + row0n * DM + hn * 64, DM, Q1R + row0n * 512 + hn * 32, SSH + (row0n * 16 + hn) * 2, (const unsigned char*)K1 + (size_t)bn * TK * 512 + hn * 32, (const unsigned char*)KR + (size_t)bn * TK * 16,
                              (const unsigned char*)V1 + (size_t)bn * TK * DM + hn * 64 UPROBE_ARG8); }
#else
            afast::attn_unit<1>(Qb + q0, DM, Q1R + row0 * 512 + h * 32, SSH + (row0 * 16 + h) * 2, K1 + (size_t)b * TK * DM + h * 64, DM, KR + (size_t)b * TK * 32,
                                V1 + (size_t)b * TK * DM + h * 64, DM, TK / 64, O1 + q0, Gb + q0, DM, (char*)lds); }
#endif
    } SEAM(8);
    if (IN(9)) { pg8::Gemm g{O1, (const bf16_t*)(ws + WS_WOUT1), ML, 1024, 1024}; pg8::ROrder S; S.init(0, ML / 256, 1024, G, bx);
        pg8::EpiOut E{out, nullptr, out, nullptr, mod + 3 * 3072 + 2048};
        pg8::gemm_phase<pg8::EpiOut, pg8::ROrder, true, true>(ring, g, S, E); }
#ifdef MK_TS_SEAM
    if (bx == 0 && wave == 0) { const unsigned long long tend_ = __builtin_amdgcn_s_memrealtime(); const unsigned long long w = MK_TS == 99 ? (tend_ - ts0) : MK_TS >= 100 ? (MK_TS >= 200 ? (unsigned long long)(((unsigned*)ws)[4001] & 1023u) * 100ull : (unsigned long long)((unsigned*)ws)[4000]) : (MK_TS_WHAT ? (ts2 - ts1) * 10ull : (ts1 - ts0)); const unsigned long long t0 = __builtin_amdgcn_s_memrealtime(); while (__builtin_amdgcn_s_memrealtime() - t0 < w) __builtin_amdgcn_s_sleep(8); }
#endif
#ifdef MK_UBENCH
    ubench(wave);
#endif
#ifdef MK_UNIT_PROBE
    if (bx == 0 && wave == 0) { const unsigned long long t0 = __builtin_amdgcn_s_memrealtime(); const unsigned long long w = upacc * 10ull; (void)updummy; while (__builtin_amdgcn_s_memrealtime() - t0 < w) __builtin_amdgcn_s_sleep(8); }
#endif
#ifdef MK_CLOCK_PROBE
    if (bx == 0 && wave == 0) { const unsigned long long dc = pc1 - pc0, dr = pr1 - pr0;
        const unsigned long long mhz = dr ? (dc * 100ull) / dr : 0ull;
        const unsigned long long t0 = __builtin_amdgcn_s_memrealtime(); const unsigned long long wait_ticks = mhz * 10ull;
        while (__builtin_amdgcn_s_memrealtime() - t0 < wait_ticks) __builtin_amdgcn_s_sleep(8); }
#endif
#undef IN
#undef SEAM
}

constexpr int NPHASE = 10;
#ifndef MK_ONE_LAUNCH
#define MK_ONE_LAUNCH 1
#endif
extern "C" void kernel_launch(void* const* d_in, const int* in_sizes, int n_in, void* d_out, int out_size, void* d_ws, size_t ws_size, hipStream_t stream) {
    static int grid = 0;
    if (grid == 0) {
        if (n_in != 23 || out_size != ML * DM || ws_size < WS_END) { fprintf(stderr, "kernel_launch: unexpected shapes n_in %d out %d ws %zu\n", n_in, out_size, ws_size); grid = -1; return; }
        int dev = 0, cus = 0, per_cu = 0;
        if (hipGetDevice(&dev) != hipSuccess || hipDeviceGetAttribute(&cus, hipDeviceAttributeMultiprocessorCount, dev) != hipSuccess) { grid = -1; return; }
        if (hipFuncSetAttribute((const void*)mega, hipFuncAttributeMaxDynamicSharedMemorySize, LDS_BYTES) != hipSuccess) { fprintf(stderr, "kernel_launch: hipFuncSetAttribute failed\n"); grid = -1; return; }
        if (hipOccupancyMaxActiveBlocksPerMultiprocessor(&per_cu, (const void*)mega, NTHREADS, LDS_BYTES) != hipSuccess || per_cu < 1) { fprintf(stderr, "kernel_launch: occupancy query says %d\n", per_cu); grid = -1; return; }
        grid = cus;
        if (grid != 256) fprintf(stderr, "kernel_launch: %d CUs (built for 256)\n", grid);
    }
    if (grid < 0) return;
    if (hipMemsetAsync(d_ws, 0, 16384, stream) != hipSuccess) { fprintf(stderr, "kernel_launch: memset failed\n"); return; }
    Args a{};
    for (int i = 0; i < 23; ++i) a.in[i] = (const float*)d_in[i];
    a.out = (float*)d_out; a.ws = (unsigned char*)d_ws;
#if MK_ONE_LAUNCH
    a.ph_lo = 0; a.ph_hi = NPHASE; a.coop = 1;
    void* args[] = {&a};
#ifdef MK_PLAIN_LAUNCH
    (void)args; hipLaunchKernelGGL(mega, dim3(grid), dim3(NTHREADS), LDS_BYTES, stream, a);
#else
    const hipError_t e = hipLaunchCooperativeKernel((const void*)mega, dim3(grid), dim3(NTHREADS), args, LDS_BYTES, stream);
    if (e != hipSuccess) fprintf(stderr, "kernel_launch: cooperative launch failed: %s (grid %d)\n", hipGetErrorString(e), grid);
#endif
#else
    for (int p = 0; p < NPHASE; ++p) { a.ph_lo = p; a.ph_hi = p + 1; a.coop = 0; hipLaunchKernelGGL(mega, dim3(grid), dim3(NTHREADS), LDS_BYTES, stream, a); }
    const hipError_t le = hipPeekAtLastError();
    if (le != hipSuccess) fprintf(stderr, "kernel_launch: launch failed: %s\n", hipGetErrorName(le));
#endif
}
```

```cpp
#include <hip/hip_runtime.h>
#include <hip/hip_bf16.h>
#include <cstdio>
#include <cstdint>

#define DEVI __device__ __forceinline__
#define LAS __attribute__((address_space(3)))
#define GAS __attribute__((address_space(1)))

constexpr int NB = 2, SEQ = 8192, DM = 1024, CTXL = 256, TK = SEQ + CTXL;
constexpr int ML = NB * SEQ, MC = NB * CTXL, MT = ML + MC;
constexpr int GRIDW = 64;
constexpr float EPS = 1e-6f;
constexpr float LOG2E = 1.4426950408889634f;
constexpr int N_IN0 = 2560, N_IN1 = 1696, N_IN1P = 1792;
constexpr float C2_GQA = 0.125f * LOG2E;
constexpr float C2_MLA = 0.10206207261596575f * LOG2E;

typedef unsigned short bf16_t;
typedef short bf16x8 __attribute__((ext_vector_type(8)));
typedef short s16x4 __attribute__((ext_vector_type(4)));
typedef float f32x4 __attribute__((ext_vector_type(4)));
typedef float f32x2 __attribute__((ext_vector_type(2)));
typedef float f32x16 __attribute__((ext_vector_type(16)));
typedef unsigned u32x4 __attribute__((ext_vector_type(4)));
typedef unsigned u32x2 __attribute__((ext_vector_type(2)));

DEVI float bf2f(bf16_t v) { return __uint_as_float((unsigned)v << 16); }
DEVI unsigned f2bf(float f) { unsigned u = __float_as_uint(f); return (u + 0x7fffu + ((u >> 16) & 1u)) >> 16; }
DEVI unsigned pk2(float lo, float hi) { return f2bf(lo) | (f2bf(hi) << 16); }
DEVI float wave_sum(float v) {
#pragma unroll
    for (int o = 1; o < 64; o <<= 1) v += __shfl_xor(v, o);
    return v;
}
DEVI float silu_f(float v) { return v / (1.f + __expf(-v)); }
namespace pg8 {
#define PG8_LAS __attribute__((address_space(3)))
typedef unsigned short bf16_t;
typedef short bf16x8 __attribute__((ext_vector_type(8)));
typedef float f32x4 __attribute__((ext_vector_type(4)));
typedef unsigned u32x4 __attribute__((ext_vector_type(4)));
constexpr int BM = 256, BK = 64, HALF = 128, HTB = HALF * BK * 2  , STAGE_BYTES = 8 * HTB, NXCD = 8, WGM = 8;

__host__ __device__ __forceinline__ int lds_byte(int r, int c) { const int st = (r >> 4) * 2 + (c >> 5), rr = r & 15, cc = c & 31, ob = rr * 64 + cc * 2; return st * 1024 + (ob ^ (((ob >> 9) & 1) << 5)); }
__host__ __device__ __forceinline__ void stage_rc(int b, int& R, int& C) { const int st = b / 1024, sb = b % 1024, swz = sb ^ (((sb >> 9) & 1) << 5); R = (st >> 1) * 16 + swz / 64; C = (st & 1) * 32 + (swz % 64) / 2; }
__host__ __device__ __forceinline__ int perm32(int rho) { const int n = rho >> 4, i = rho & 15; return 8 * (i >> 2) + 4 * n + (i & 3); }

struct Unit { int pm, pn, ko; };
struct Gemm { const bf16_t* A; const bf16_t* Bt; int M, N, K, Kloop; };

struct StaticOrder {
    int nM, nN, nwg, G, c;
    __host__ __device__ void init(int M, int N, int G_, int c_) { nM = M / BM; nN = N / BM; nwg = nM * nN; G = G_; c = c_; }
    __host__ __device__ bool next(int i, Unit& u) const {
        const long L = (long)i * G + c; if (L >= nwg) return false;
        int wgid = (int)L; { const int q = nwg / NXCD, r = nwg % NXCD, xcd = wgid % NXCD, off = wgid / NXCD; wgid = (xcd < r ? xcd * (q + 1) : r * (q + 1) + (xcd - r) * q) + off; }
        const int nig = WGM * nN, gid = wgid / nig, fm = gid * WGM, gsz = (nM - fm) < WGM ? (nM - fm) : WGM;
        u.pm = fm + ((wgid % nig) % gsz); u.pn = (wgid % nig) / gsz; u.ko = 0; return true;
    }
    __device__ __forceinline__ void a_ready(const Unit&) const {}
    __device__ __forceinline__ void done(const Unit&) const {}
};


struct ROrder {
    int pm0, nM, nN, nwg, G, c, rep;
    __host__ __device__ void init(int pm0_, int npm, int N, int G_, int c_, int rep_ = 1) { pm0 = pm0_; nM = npm; nN = N / BM; nwg = nM * nN; G = G_; c = c_; rep = rep_; }
    __host__ __device__ bool next(int i, Unit& u) const {
        const long L = (long)i * G + c; if (L >= (long)nwg * rep) return false;
        int wgid = (int)(L % nwg); { const int q = nwg / NXCD, r = nwg % NXCD, xcd = wgid % NXCD, off = wgid / NXCD; wgid = (xcd < r ? xcd * (q + 1) : r * (q + 1) + (xcd - r) * q) + off; }
        const int nig = WGM * nN, gid = wgid / nig, fm = gid * WGM, gsz = (nM - fm) < WGM ? (nM - fm) : WGM;
        u.pm = pm0 + fm + ((wgid % nig) % gsz); u.pn = (wgid % nig) / gsz; u.ko = 0; return true;
    }
    __device__ __forceinline__ void a_ready(const Unit&) const {}
    __device__ __forceinline__ void done(const Unit&) const {}
};

struct EpiF32 {
    static constexpr bool PERM = true, AFTER_DRAIN = false;
    float* O; int ldc; int pmbase;
    __device__ __forceinline__ void operator()(const f32x4 (&acc)[2][2][4][2], const Unit& u, int wr, int wc, int fr, int fq) const {
        const int row0 = (u.pm - pmbase) * BM + wr * 64 + fr, col0 = u.pn * BM + wc * 32 + 8 * fq;
#pragma unroll
        for (int ai = 0; ai < 2; ++ai)
#pragma unroll
            for (int m = 0; m < 4; ++m) { float* rowp = O + (size_t)(row0 + ai * HALF + m * 16) * ldc + col0;
#pragma unroll
                for (int bj = 0; bj < 2; ++bj) { *(f32x4*)(rowp + bj * HALF) = acc[ai][bj][m][0]; *(f32x4*)(rowp + bj * HALF + 4) = acc[ai][bj][m][1]; } }
    }
};

DEVI unsigned cvt_pk_bf16(float lo, float hi) { unsigned r; asm volatile("v_cvt_pk_bf16_f32 %0, %1, %2" : "=v"(r) : "v"(lo), "v"(hi)); return r; }
DEVI u32x4 pack8(const f32x4 a, const f32x4 b) { u32x4 w; w.x = cvt_pk_bf16(a[0], a[1]); w.y = cvt_pk_bf16(a[2], a[3]); w.z = cvt_pk_bf16(b[0], b[1]); w.w = cvt_pk_bf16(b[2], b[3]); return w; }
DEVI u32x2 pack8_fp8(const f32x4 a, const f32x4 b) { int w0 = 0, w1 = 0; w0 = __builtin_amdgcn_cvt_pk_fp8_f32(a[0], a[1], w0, false); w0 = __builtin_amdgcn_cvt_pk_fp8_f32(a[2], a[3], w0, true);
    w1 = __builtin_amdgcn_cvt_pk_fp8_f32(b[0], b[1], w1, false); w1 = __builtin_amdgcn_cvt_pk_fp8_f32(b[2], b[3], w1, true); return (u32x2){(unsigned)w0, (unsigned)w1}; }
DEVI unsigned pack8_fp4(const f32x4 a, const f32x4 b) { unsigned w; asm volatile("" : "=v"(w)); w = __builtin_amdgcn_cvt_scalef32_pk_fp4_f32(w, a[0], a[1], 1.0f, 0); w = __builtin_amdgcn_cvt_scalef32_pk_fp4_f32(w, a[2], a[3], 1.0f, 1);
    w = __builtin_amdgcn_cvt_scalef32_pk_fp4_f32(w, b[0], b[1], 1.0f, 2); w = __builtin_amdgcn_cvt_scalef32_pk_fp4_f32(w, b[2], b[3], 1.0f, 3); return w; }
DEVI float quad_sum(float s) { s += __shfl_xor(s, 16); s += __shfl_xor(s, 32); return s; }
DEVI float sq4(const f32x4 v) { return (v[0] * v[0] + v[1] * v[1]) + (v[2] * v[2] + v[3] * v[3]); }
DEVI f32x4 silu4(const f32x4 v) { f32x4 o; o[0] = silu_f(v[0]); o[1] = silu_f(v[1]); o[2] = silu_f(v[2]); o[3] = silu_f(v[3]); return o; }
DEVI int key_slot(int R) { return R < ML ? (R >> 13) * TK + CTXL + (R & (SEQ - 1)) : ((R - ML) >> 8) * TK + ((R - ML) & 255); }
DEVI void rot4(f32x4& x1, f32x4& x2, const f32x4 cs01, const f32x4 cs23) {
    const f32x4 c = {cs01[0], cs01[2], cs23[0], cs23[2]}, s = {cs01[1], cs01[3], cs23[1], cs23[3]};
    const f32x4 a = x1 * c - x2 * s, b = x2 * c + x1 * s; x1 = a; x2 = b;
}

DEVI int drope32(int i) { const int fq = i >> 3, n = (i >> 2) & 1, j = i & 3; return 16 * (fq >> 1) + 8 * n + 4 * (fq & 1) + j; }
DEVI int wmap(int mode, int p) {
    const int pn = p >> 8, q = p & 255, bj = q >> 7, wc = (q >> 5) & 3, i = q & 31;
    switch (mode) {
    case 1: {
        if (pn == 0 || (pn >= 2 && pn <= 5)) { const int fq = i >> 3, n = (i >> 2) & 1, j = i & 3; return 256 * pn + 64 * wc + 32 * bj + 16 * n + 4 * fq + j; }
        return p; }
    case 2: {
        if (pn == 0) return q;
        if (pn == 1) return 288 + q;
        if (pn == 2) { if (wc < 2) return 288 + 256 + 64 * wc + 32 * bj + i; if (wc == 2 && bj == 0) return 256 + drope32(i); return -1; }
        return 672 + 256 * (pn - 3) + q; }
    case 3: { const int head = 2 * pn + (wc >> 1), type = wc & 1; return 128 * head + 64 * type + 32 * bj + i; }
    case 4: { const int head = 2 * pn + (wc >> 1), type = wc & 1; if (type == 0) return 96 * head + 32 * bj + i; return bj == 0 ? 96 * head + 64 + drope32(i) : -1; }
    default: return p;
    }
}

template <bool F8> struct EpiIn0 {
    static constexpr bool PERM = true, AFTER_DRAIN = false;
    const float* qn; const float* kn; const f32x4* tabA; bf16_t* K0; bf16_t* V0; bf16_t* Q0; bf16_t* G0;
    __device__ __forceinline__ void operator()(const f32x4 (&acc)[2][2][4][2], const Unit& u, int wr, int wc, int fr_, int fq_) const {
        int fr = fr_, fq = fq_; asm volatile("" : "+v"(fr), "+v"(fq));
        const int pn = u.pn; const bool lat = u.pm < ML / BM;
        if (pn == 0 || (pn >= 2 && pn <= 5)) {
            const float* wsrc = pn == 0 ? kn : qn; const float outs = pn == 0 ? (F8 ? 2.f : 1.f) : (F8 ? C2_GQA * 8.f : C2_GQA);
            f32x4 wv[2][2];
#pragma unroll
            for (int bj = 0; bj < 2; ++bj)
#pragma unroll
                for (int n = 0; n < 2; ++n) wv[bj][n] = *(const f32x4*)(wsrc + 32 * bj + 16 * n + 4 * fq) * outs;
#pragma unroll
            for (int ai = 0; ai < 2; ++ai)
#pragma unroll
                for (int m = 0; m < 4; ++m) {
                    const int R = u.pm * BM + ai * HALF + wr * 64 + m * 16 + fr;
                    f32x4 x[2][2]; float ss = 0.f;
#pragma unroll
                    for (int bj = 0; bj < 2; ++bj)
#pragma unroll
                        for (int n = 0; n < 2; ++n) { x[bj][n] = acc[ai][bj][m][n]; ss += sq4(x[bj][n]); }
                    const float rinv = rsqrtf(quad_sum(ss) * (1.f / 64.f) + EPS);
#pragma unroll
                    for (int bj = 0; bj < 2; ++bj)
#pragma unroll
                        for (int n = 0; n < 2; ++n) x[bj][n] = x[bj][n] * rinv * wv[bj][n];
                    if (lat) { const int t = R & (SEQ - 1), trow = t >> 6, tcol = t & 63;
                        const f32x4* tr = tabA + (trow * 16 + 4 * fq) / 2; const f32x4* tc = tabA + (tcol * 16 + 4 * fq) / 2;
                        rot4(x[0][0], x[0][1], tr[0], tr[1]); rot4(x[1][0], x[1][1], tc[0], tc[1]); }
                    if (F8 && pn == 0) { unsigned char* dst = (unsigned char*)K0 + (size_t)key_slot(R) * 128 + wc * 32 + 4 * fq;
                        *(unsigned*)dst = pack8_fp4(x[0][0], x[0][1]); *(unsigned*)(dst + 16) = pack8_fp4(x[1][0], x[1][1]); }
                    else if (pn == 0) { bf16_t* dst = K0 + (size_t)key_slot(R) * 256 + wc * 64 + 8 * fq;
                        *(u32x4*)dst = pack8(x[0][0], x[0][1]); *(u32x4*)(dst + 32) = pack8(x[1][0], x[1][1]); }
                    else { bf16_t* dst = Q0 + (size_t)R * DM + ((pn - 2) * 4 + wc) * 64 + 8 * fq;
                        *(u32x4*)dst = pack8(x[0][0], x[0][1]); *(u32x4*)(dst + 32) = pack8(x[1][0], x[1][1]); }
                }
        } else if (pn == 1) {
#pragma unroll
            for (int ai = 0; ai < 2; ++ai)
#pragma unroll
                for (int m = 0; m < 4; ++m) { const int R = u.pm * BM + ai * HALF + wr * 64 + m * 16 + fr;
                    if (F8) { unsigned char* dst = (unsigned char*)V0 + (size_t)key_slot(R) * 256 + wc * 32 + 8 * fq;
#pragma unroll
                        for (int bj = 0; bj < 2; ++bj) *(u32x2*)(dst + bj * HALF) = pack8_fp8(acc[ai][bj][m][0], acc[ai][bj][m][1]); }
                    else { bf16_t* dst = V0 + (size_t)key_slot(R) * 256 + wc * 32 + 8 * fq;
#pragma unroll
                        for (int bj = 0; bj < 2; ++bj) *(u32x4*)(dst + bj * HALF) = pack8(acc[ai][bj][m][0], acc[ai][bj][m][1]); } }
        } else {
#pragma unroll
            for (int ai = 0; ai < 2; ++ai)
#pragma unroll
                for (int m = 0; m < 4; ++m) { const int R = u.pm * BM + ai * HALF + wr * 64 + m * 16 + fr; bf16_t* dst = G0 + (size_t)R * DM + (pn - 6) * BM + wc * 32 + 8 * fq;
#pragma unroll
                    for (int bj = 0; bj < 2; ++bj) *(u32x4*)(dst + bj * HALF) = pack8(silu4(acc[ai][bj][m][0]), silu4(acc[ai][bj][m][1])); }
        }
    }
};

struct EpiOut {
    static constexpr bool PERM = true, AFTER_DRAIN = false;
    const float* baseL; const float* baseC; float* dstL; float* dstC; const float* gate;
    __device__ __forceinline__ void operator()(const f32x4 (&acc)[2][2][4][2], const Unit& u, int wr, int wc, int fr_, int fq_) const {
        int fr = fr_, fq = fq_; asm volatile("" : "+v"(fr), "+v"(fq));
        const int col0 = u.pn * BM + wc * 32 + 8 * fq;
#pragma unroll
        for (int ai = 0; ai < 2; ++ai)
#pragma unroll
            for (int m = 0; m < 4; ++m) { const int R = u.pm * BM + ai * HALF + wr * 64 + m * 16 + fr; const int r = R < SEQ ? 0 : (R < ML ? 1 : 2);
                const float* b = R < ML ? baseL + (size_t)R * DM : baseC + (size_t)(R - ML) * DM; float* d = R < ML ? dstL + (size_t)R * DM : dstC + (size_t)(R - ML) * DM;
                const float* g = gate + (size_t)r * 3072;
#pragma unroll
                for (int bj = 0; bj < 2; ++bj)
#pragma unroll
                    for (int n = 0; n < 2; ++n) { const int c = col0 + bj * HALF + 4 * n; *(f32x4*)(d + c) = *(const f32x4*)(b + c) + *(const f32x4*)(g + c) * acc[ai][bj][m][n]; } }
    }
};

struct EpiOutF {
    static constexpr bool PERM = true, AFTER_DRAIN = false;
    const float* base; float* dst; const float* gate; const float* nwm; bf16_t* Hn; float* SSX;
    __device__ __forceinline__ void operator()(const f32x4 (&acc)[2][2][4][2], const Unit& u, int wr, int wc, int fr_, int fq_) const {
        int fr = fr_, fq = fq_; asm volatile("" : "+v"(fr), "+v"(fq));
        const int col0 = u.pn * BM + wc * 32 + 8 * fq;
#pragma unroll
        for (int ai = 0; ai < 2; ++ai)
#pragma unroll
            for (int m = 0; m < 4; ++m) { const int R = u.pm * BM + ai * HALF + wr * 64 + m * 16 + fr; const int r = R < SEQ ? 0 : 1;
                asm volatile("" ::: "memory");
                const float* b = base + (size_t)R * DM; float* d = dst + (size_t)R * DM; const float* g = gate + (size_t)r * 3072; const float* nw = nwm + (size_t)r * 1024; float ss = 0.f;
#pragma unroll
                for (int bj = 0; bj < 2; ++bj) { const int c = col0 + bj * HALF;
                    const f32x4 x0 = *(const f32x4*)(b + c) + *(const f32x4*)(g + c) * acc[ai][bj][m][0], x1 = *(const f32x4*)(b + c + 4) + *(const f32x4*)(g + c + 4) * acc[ai][bj][m][1];
                    *(f32x4*)(d + c) = x0; *(f32x4*)(d + c + 4) = x1; ss += sq4(x0) + sq4(x1);
                    *(u32x4*)(Hn + (size_t)R * DM + c) = pack8(x0 * *(const f32x4*)(nw + c), x1 * *(const f32x4*)(nw + c + 4)); }
                ss = quad_sum(ss); if (fq == 0) SSX[(size_t)R * 16 + u.pn * 4 + wc] = ss; }
    }
};
struct EpiOutSlab {
    static constexpr bool PERM = true, AFTER_DRAIN = false;
    float* slab; int klen;
    __device__ __forceinline__ void operator()(const f32x4 (&acc)[2][2][4][2], const Unit& u, int wr, int wc, int fr_, int fq_) const {
        int fr = fr_, fq = fq_; asm volatile("" : "+v"(fr), "+v"(fq));
        const int col0 = u.pn * BM + wc * 32 + 8 * fq; float* sb = slab + (size_t)(u.ko / klen) * MC * DM;
#pragma unroll
        for (int ai = 0; ai < 2; ++ai)
#pragma unroll
            for (int m = 0; m < 4; ++m) { const int R = u.pm * BM + ai * HALF + wr * 64 + m * 16 + fr; float* d = sb + (size_t)(R - ML) * DM + col0;
#pragma unroll
                for (int bj = 0; bj < 2; ++bj) { *(f32x4*)(d + bj * HALF) = acc[ai][bj][m][0]; *(f32x4*)(d + bj * HALF + 4) = acc[ai][bj][m][1]; } }
    }
};
struct CtxSplitOrder {
    int c, KS, klen;
    __host__ __device__ void init(int c_, int KS_, int klen_) { c = c_; KS = KS_; klen = klen_; }
    __host__ __device__ bool next(int i, Unit& u) const { if (i > 0 || c >= 8 * KS) return false; const int t = c / KS; u.pm = ML / BM + (t >> 2); u.pn = t & 3; u.ko = (c % KS) * klen; return true; }
    __device__ __forceinline__ void a_ready(const Unit&) const {}
    __device__ __forceinline__ void done(const Unit&) const {}
};

template <bool F8> struct EpiIn1 {
    static constexpr bool PERM = true, AFTER_DRAIN = false;
    const float* krn; const f32x4* tabB; bf16_t* KVA; float* SSKV; bf16_t* QA; float* SSQ; bf16_t* KR; bf16_t* G1; const float* SSX; const float* bias;
    __device__ __forceinline__ void xrow(const f32x4 (&acc)[2][2][4][2], int ai, int m, int R, int pcol0, f32x4 (&x)[2][2]) const {
        const float rinv = SSX[R];
        const float* bp = bias + (size_t)(R < SEQ ? 0 : (R < ML ? 1 : 2)) * N_IN1P + pcol0;
#pragma unroll
        for (int bj = 0; bj < 2; ++bj)
#pragma unroll
            for (int n = 0; n < 2; ++n) x[bj][n] = acc[ai][bj][m][n] * rinv + *(const f32x4*)(bp + bj * HALF + 4 * n);
    }
    __device__ __forceinline__ void operator()(const f32x4 (&acc)[2][2][4][2], const Unit& u, int wr, int wc, int fr_, int fq_) const {
        int fr = fr_, fq = fq_; asm volatile("" : "+v"(fr), "+v"(fq));
        const int pn = u.pn; const bool lat = u.pm < ML / BM; const int pcol0 = pn * BM + wc * 32 + 8 * fq;
        if (pn >= 3) {
#pragma unroll
            for (int ai = 0; ai < 2; ++ai)
#pragma unroll
                for (int m = 0; m < 4; ++m) { const int R = u.pm * BM + ai * HALF + wr * 64 + m * 16 + fr; bf16_t* dst = G1 + (size_t)R * DM + (pn - 3) * BM + wc * 32 + 8 * fq;
                    asm volatile("" ::: "memory"); f32x4 x[2][2]; xrow(acc, ai, m, R, pcol0, x);
#pragma unroll
                    for (int bj = 0; bj < 2; ++bj) *(u32x4*)(dst + bj * HALF) = pack8(silu4(x[bj][0]), silu4(x[bj][1])); }
        } else if (pn == 2 && wc == 2) {
            f32x4 wv[2];
#pragma unroll
            for (int n = 0; n < 2; ++n) wv[n] = *(const f32x4*)(krn + 16 * (fq >> 1) + 8 * n + 4 * (fq & 1));
#pragma unroll
            for (int ai = 0; ai < 2; ++ai)
#pragma unroll
                for (int m = 0; m < 4; ++m) { const int R = u.pm * BM + ai * HALF + wr * 64 + m * 16 + fr;
                    asm volatile("" ::: "memory"); f32x4 xx[2][2]; xrow(acc, ai, m, R, pcol0, xx); f32x4 x0 = xx[0][0], x1 = xx[0][1];
                    const float rinv = rsqrtf(quad_sum(sq4(x0) + sq4(x1)) * (1.f / 32.f) + EPS);
                    x0 = x0 * rinv * wv[0]; x1 = x1 * rinv * wv[1];
                    if (lat) { const int t = R & (SEQ - 1); const int pos = (fq >> 1) ? (t & 63) : (t >> 6); const f32x4* tp = tabB + (pos * 8 + 4 * (fq & 1)) / 2; rot4(x0, x1, tp[0], tp[1]); }
                    if (F8) *(unsigned*)((unsigned char*)KR + (size_t)key_slot(R) * 16 + 4 * fq) = pack8_fp4(x0 * 2.f, x1 * 2.f); else *(u32x4*)(KR + (size_t)key_slot(R) * 32 + 8 * fq) = pack8(x0, x1); }
        } else if (pn == 2 && wc == 3) {
        } else if (pn == 0 || lat) {
            bf16_t* base; float* ssb; int ld, cbase, nss, iss;
            if (pn == 0) { base = KVA; ld = 256; cbase = wc * 32; ssb = SSKV; nss = 4; iss = wc; }
            else if (pn == 1) { base = QA; ld = 384; cbase = wc * 32; ssb = SSQ; nss = 6; iss = wc; }
            else { base = QA; ld = 384; cbase = 256 + wc * 64; ssb = SSQ; nss = 6; iss = 4 + wc; }
            const int bjs = pn == 2 ? 32 : HALF;
#pragma unroll
            for (int ai = 0; ai < 2; ++ai)
#pragma unroll
                for (int m = 0; m < 4; ++m) { const int R = u.pm * BM + ai * HALF + wr * 64 + m * 16 + fr; bf16_t* dst = base + (size_t)R * ld + cbase + 8 * fq; float ss = 0.f;
                    asm volatile("" ::: "memory"); f32x4 x[2][2]; xrow(acc, ai, m, R, pcol0, x);
#pragma unroll
                    for (int bj = 0; bj < 2; ++bj) { ss += sq4(x[bj][0]) + sq4(x[bj][1]); *(u32x4*)(dst + bj * bjs) = pack8(x[bj][0], x[bj][1]); }
                    ss = quad_sum(ss); if (fq == 0) ssb[(size_t)R * nss + iss] = ss; }
        }
    }
};

template <bool F8> struct EpiKvb {
    static constexpr bool PERM = true, AFTER_DRAIN = false;
    const float* SSKV; const float* knn; bf16_t* K1; bf16_t* V1;
    __device__ __forceinline__ void operator()(const f32x4 (&acc)[2][2][4][2], const Unit& u, int wr, int wc, int fr_, int fq_) const {
        int fr = fr_, fq = fq_; asm volatile("" : "+v"(fr), "+v"(fq));
        const int head = 2 * u.pn + (wc >> 1), type = wc & 1; const int R0 = u.pm * BM + wr * 64 + fr;
        float rkv[2][4];
        { f32x4 s4[2][4];
#pragma unroll
          for (int ai = 0; ai < 2; ++ai)
#pragma unroll
            for (int m = 0; m < 4; ++m) s4[ai][m] = *(const f32x4*)(SSKV + (size_t)(R0 + ai * HALF + m * 16) * 4);
#pragma unroll
          for (int ai = 0; ai < 2; ++ai)
#pragma unroll
            for (int m = 0; m < 4; ++m) rkv[ai][m] = rsqrtf(((s4[ai][m][0] + s4[ai][m][1]) + (s4[ai][m][2] + s4[ai][m][3])) * (1.f / 256.f) + EPS); }
        f32x4 kw[2][2];
#pragma unroll
        for (int bj = 0; bj < 2; ++bj)
#pragma unroll
            for (int n = 0; n < 2; ++n) kw[bj][n] = *(const f32x4*)(knn + 32 * bj + 8 * fq + 4 * n);
#pragma unroll
        for (int ai = 0; ai < 2; ++ai)
#pragma unroll
            for (int m = 0; m < 4; ++m) { const int R = R0 + ai * HALF + m * 16;
                asm volatile("" ::: "memory");
                f32x4 x[2][2]; float ss = 0.f;
#pragma unroll
                for (int bj = 0; bj < 2; ++bj)
#pragma unroll
                    for (int n = 0; n < 2; ++n) { x[bj][n] = acc[ai][bj][m][n] * rkv[ai][m]; ss += sq4(x[bj][n]); }
                if (type == 0) { const float rinv = rsqrtf(quad_sum(ss) * (1.f / 64.f) + EPS);
#pragma unroll
                    for (int bj = 0; bj < 2; ++bj)
#pragma unroll
                        for (int n = 0; n < 2; ++n) x[bj][n] = x[bj][n] * rinv * kw[bj][n]; }
                const size_t eo = (size_t)key_slot(R) * DM + head * 64 + 8 * fq;
                if (F8) { if (type == 0) { unsigned char* dst = (unsigned char*)K1 + (size_t)key_slot(R) * 512 + head * 32 + 4 * fq; *(unsigned*)dst = pack8_fp4(x[0][0] * 2.f, x[0][1] * 2.f); *(unsigned*)(dst + 16) = pack8_fp4(x[1][0] * 2.f, x[1][1] * 2.f); }
                          else { unsigned char* dst = (unsigned char*)V1 + eo; *(u32x2*)dst = pack8_fp8(x[0][0], x[0][1]); *(u32x2*)(dst + 32) = pack8_fp8(x[1][0], x[1][1]); } }
                else { bf16_t* dst = (type == 0 ? K1 : V1) + eo; *(u32x4*)dst = pack8(x[0][0], x[0][1]); *(u32x4*)(dst + 32) = pack8(x[1][0], x[1][1]); } }
    }
};

struct EpiQb {
    static constexpr bool PERM = true, AFTER_DRAIN = false;
    const float* SSQ; const float* qnw; const f32x4* tabB; bf16_t* Q1N; bf16_t* Q1R; float* SSH;
    __device__ __forceinline__ void operator()(const f32x4 (&acc)[2][2][4][2], const Unit& u, int wr, int wc, int fr_, int fq_) const {
        int fr = fr_, fq = fq_; asm volatile("" : "+v"(fr), "+v"(fq));
        const int head = 2 * u.pn + (wc >> 1); const int R0 = u.pm * BM + wr * 64 + fr;
        float rqa[2][4];
        { f32x2 sv[2][4][3];
#pragma unroll
          for (int ai = 0; ai < 2; ++ai)
#pragma unroll
            for (int m = 0; m < 4; ++m) { const float* sp = SSQ + (size_t)(R0 + ai * HALF + m * 16) * 6; sv[ai][m][0] = *(const f32x2*)sp; sv[ai][m][1] = *(const f32x2*)(sp + 2); sv[ai][m][2] = *(const f32x2*)(sp + 4); }
#pragma unroll
          for (int ai = 0; ai < 2; ++ai)
#pragma unroll
            for (int m = 0; m < 4; ++m) rqa[ai][m] = rsqrtf(((sv[ai][m][0][0] + sv[ai][m][0][1]) + (sv[ai][m][1][0] + sv[ai][m][1][1]) + (sv[ai][m][2][0] + sv[ai][m][2][1])) * (1.f / 384.f) + EPS); }
        if ((wc & 1) == 0) {
            f32x4 qw[2][2];
#pragma unroll
            for (int bj = 0; bj < 2; ++bj) { qw[bj][0] = *(const f32x4*)(qnw + 32 * bj + 8 * fq); qw[bj][1] = *(const f32x4*)(qnw + 32 * bj + 8 * fq + 4); }
#pragma unroll
            for (int ai = 0; ai < 2; ++ai)
#pragma unroll
                for (int m = 0; m < 4; ++m) { const int R = R0 + ai * HALF + m * 16;
                    asm volatile("" ::: "memory");
                    float ss = 0.f; bf16_t* dst = Q1N + (size_t)R * DM + head * 64 + 8 * fq;
#pragma unroll
                    for (int bj = 0; bj < 2; ++bj) { f32x4 x0 = acc[ai][bj][m][0] * rqa[ai][m], x1 = acc[ai][bj][m][1] * rqa[ai][m]; ss += sq4(x0) + sq4(x1);
                        x0 = x0 * qw[bj][0]; x1 = x1 * qw[bj][1]; *(u32x4*)(dst + 32 * bj) = pack8(x0, x1); }
                    ss = quad_sum(ss); if (fq == 0) SSH[((size_t)R * 16 + head) * 2] = ss; }
        } else {
            const float* wp = qnw + 64 + 16 * (fq >> 1) + 4 * (fq & 1); const f32x4 w0 = *(const f32x4*)wp, w1 = *(const f32x4*)(wp + 8);
            f32x4 tn0, tn1;
            { const int t = R0 & (SEQ - 1); const int pos = (fq >> 1) ? (t & 63) : (t >> 6); const f32x4* tp = tabB + (pos * 8 + 4 * (fq & 1)) / 2; tn0 = tp[0]; tn1 = tp[1]; }
#pragma unroll
            for (int ai = 0; ai < 2; ++ai)
#pragma unroll
                for (int m = 0; m < 4; ++m) { const int R = R0 + ai * HALF + m * 16; const f32x4 t0 = tn0, t1 = tn1;
                    if (ai * 4 + m < 7) { const int Rn = R0 + ((ai * 4 + m + 1) >> 2) * HALF + ((ai * 4 + m + 1) & 3) * 16; const int t = Rn & (SEQ - 1); const int pos = (fq >> 1) ? (t & 63) : (t >> 6);
                        const f32x4* tp = tabB + (pos * 8 + 4 * (fq & 1)) / 2; tn0 = tp[0]; tn1 = tp[1]; }
                    asm volatile("" ::: "memory");
                    f32x4 x0 = acc[ai][0][m][0] * rqa[ai][m], x1 = acc[ai][0][m][1] * rqa[ai][m]; const float ss = quad_sum(sq4(x0) + sq4(x1)); if (fq == 0) SSH[((size_t)R * 16 + head) * 2 + 1] = ss;
                    x0 = x0 * w0; x1 = x1 * w1; rot4(x0, x1, t0, t1);
                    *(u32x4*)(Q1R + (size_t)R * 512 + head * 32 + 8 * fq) = pack8(x0, x1); }
        }
    }
};

struct In1Order {
    int G, c; ROrder lat;
    __host__ __device__ void init(int G_, int c_) { G = G_; c = c_; lat.init(0, ML / BM, N_IN1P, G_, c_); }
    __host__ __device__ bool next(int i, Unit& u) const {
        const long L = (long)i * G + c; if (L < lat.nwg) return lat.next(i, u);
        const int e = (int)(L - lat.nwg); if (e >= 4) return false; u.pm = ML / BM + (e >> 1); u.pn = (e & 1) * 2; u.ko = 0; return true;
    }
    __device__ __forceinline__ void a_ready(const Unit&) const {}
    __device__ __forceinline__ void done(const Unit&) const {}
};
template <class Epi, class Sched, bool ALIGN_EPI = false, bool SP2 = false>
__device__ __forceinline__ void gemm_phase(PG8_LAS unsigned char* lds, const Gemm g, const Sched& S, const Epi& E) {
    const int tid = threadIdx.x, wid = __builtin_amdgcn_readfirstlane(tid >> 6), lane = tid & 63, wr = wid >> 2, wc = wid & 3, fr = lane & 15, fq = lane >> 4;
    const int K = g.K, nt = (g.Kloop ? g.Kloop : K) / BK;
    unsigned voffA[2], voffB[2];
#pragma unroll
    for (int i = 0; i < 2; ++i) { int R, C; stage_rc(tid * 16 + i * 8192, R, C); const int Rb = Epi::PERM ? ((R & ~31) + perm32(R & 31)) : R;
        voffA[i] = (unsigned)(R * K + C) * 2u; voffB[i] = (unsigned)(Rb * K + C) * 2u; }
    const size_t kstep = (size_t)(BK * 2);
    const size_t hstep = (size_t)HALF * K * 2;
    const size_t tstep = 2 * hstep;
    const unsigned ldsw = (unsigned)wid * 1024u;
    const int aoff = lds_byte(wr * 64 + fr, fq * 8), boff = lds_byte(wc * 32 + fr, fq * 8);
#define PG8_SA(b, h) (((b) * 2 + (h)) * HTB)
#define PG8_SB(b, h) ((4 + (b) * 2 + (h)) * HTB)
#define PG8_STAGE(bufoff, gbase, voff) do { _Pragma("unroll") for (int _i = 0; _i < 2; ++_i) \
        __builtin_amdgcn_global_load_lds((const unsigned*)((const char*)(gbase) + (voff)[_i]), (PG8_LAS unsigned*)(lds + (bufoff) + ldsw + _i * 8192), 16, 0, 0); } while (0)
#define PG8_LDA(dst, b, h) do { _Pragma("unroll") for (int m = 0; m < 4; ++m) _Pragma("unroll") for (int k = 0; k < 2; ++k) dst[m][k] = *(const PG8_LAS bf16x8*)(lds + PG8_SA(b, h) + aoff + m * 2048 + k * 1024); } while (0)
#define PG8_LDB(dst, b, h) do { _Pragma("unroll") for (int n = 0; n < 2; ++n) _Pragma("unroll") for (int k = 0; k < 2; ++k) dst[n][k] = *(const PG8_LAS bf16x8*)(lds + PG8_SB(b, h) + boff + n * 2048 + k * 1024); } while (0)
#define PG8_MMA(ai, bj, At, Bt) do { __builtin_amdgcn_s_setprio(1); _Pragma("unroll") for (int m = 0; m < 4; ++m) _Pragma("unroll") for (int n = 0; n < 2; ++n) _Pragma("unroll") for (int k = 0; k < 2; ++k) \
        acc[ai][bj][m][n] = __builtin_amdgcn_mfma_f32_16x16x32_bf16(Bt[n][k], At[m][k], acc[ai][bj][m][n], 0, 0, 0); __builtin_amdgcn_s_setprio(0); } while (0)
#define PG8_WAIT_V(n) asm volatile("s_waitcnt vmcnt(" #n ")" ::: "memory")
#define PG8_WAIT_L(n) asm volatile("s_waitcnt lgkmcnt(" #n ")" ::: "memory")
#define PG8_BAR __builtin_amdgcn_s_barrier()
#define PG8_SCHED __builtin_amdgcn_sched_barrier(0)
    Unit cur, nxt; int ui = 0;
    if (!S.next(0, cur)) return;
    f32x4 acc[2][2][4][2];
#pragma unroll
    for (int a = 0; a < 2; ++a)
#pragma unroll
        for (int b = 0; b < 2; ++b)
#pragma unroll
            for (int m = 0; m < 4; ++m)
#pragma unroll
                for (int n = 0; n < 2; ++n) acc[a][b][m][n] = (f32x4){0.f, 0.f, 0.f, 0.f};
    bf16x8 At[4][2], B0[2][2], B1[2][2];
    const char* cA = (const char*)g.A + (size_t)cur.pm * tstep + (size_t)cur.ko * 2; const char* cB = (const char*)g.Bt + (size_t)cur.pn * tstep + (size_t)cur.ko * 2;
    S.a_ready(cur);
    if constexpr (SP2) {
        PG8_STAGE(PG8_SB(0, 0), cB, voffB); PG8_STAGE(PG8_SB(0, 1), cB + hstep, voffB); PG8_STAGE(PG8_SA(0, 0), cA, voffA); PG8_STAGE(PG8_SA(0, 1), cA + hstep, voffA);
        if (wr == 1) PG8_BAR;
        PG8_WAIT_V(2); PG8_BAR;
        PG8_STAGE(PG8_SB(1, 0), cB + kstep, voffB); PG8_STAGE(PG8_SA(1, 0), cA + kstep, voffA); PG8_STAGE(PG8_SB(1, 1), cB + hstep + kstep, voffB);
        PG8_WAIT_V(6); PG8_BAR;
    } else {
        PG8_STAGE(PG8_SB(0, 0), cB, voffB); PG8_STAGE(PG8_SA(0, 0), cA, voffA); PG8_STAGE(PG8_SB(0, 1), cB + hstep, voffB); PG8_STAGE(PG8_SA(0, 1), cA + hstep, voffA);
        if (wr == 1) PG8_BAR;
        PG8_WAIT_V(4); PG8_BAR;
        PG8_STAGE(PG8_SB(1, 0), cB + kstep, voffB); PG8_STAGE(PG8_SA(1, 0), cA + kstep, voffA); PG8_STAGE(PG8_SB(1, 1), cB + hstep + kstep, voffB);
        PG8_WAIT_V(6); PG8_BAR;
    }
    for (;;) {
        const bool has_next = S.next(ui + 1, nxt);
        const char* nA = has_next ? (const char*)g.A + (size_t)nxt.pm * tstep + (size_t)nxt.ko * 2 : cA; const char* nB = has_next ? (const char*)g.Bt + (size_t)nxt.pn * tstep + (size_t)nxt.ko * 2 : cB;
        _Pragma("nounroll") for (int t = 0; t < nt; t += 2) {
            const bool last = (t == nt - 2);
            const char* a1 = cA + (size_t)(t + 1) * kstep;
            const char* a2 = last ? nA : cA + (size_t)(t + 2) * kstep; const char* b2 = last ? nB : cB + (size_t)(t + 2) * kstep;
            const char* a3 = a2 + kstep; const char* b3 = b2 + kstep;
            if (last && has_next) S.a_ready(nxt);
            if constexpr (SP2) {
            PG8_LDB(B0, 0, 0); PG8_LDB(B1, 0, 1); PG8_SCHED; PG8_LDA(At, 0, 0); PG8_STAGE(PG8_SA(1, 1), a1 + hstep, voffA);
            PG8_WAIT_V(8); PG8_WAIT_L(0); PG8_BAR; PG8_MMA(0, 0, At, B0); PG8_MMA(0, 1, At, B1); PG8_BAR; PG8_SCHED;
            PG8_LDA(At, 0, 1); PG8_STAGE(PG8_SB(0, 0), b2, voffB); PG8_STAGE(PG8_SB(0, 1), b2 + hstep, voffB); PG8_STAGE(PG8_SA(0, 0), a2, voffA);
            PG8_WAIT_V(8); PG8_WAIT_L(0); PG8_BAR; PG8_MMA(1, 0, At, B0); PG8_MMA(1, 1, At, B1); PG8_BAR; PG8_SCHED;
            PG8_LDB(B0, 1, 0); PG8_LDB(B1, 1, 1); PG8_SCHED; PG8_LDA(At, 1, 0); PG8_STAGE(PG8_SA(0, 1), a2 + hstep, voffA);
            PG8_WAIT_V(8); PG8_WAIT_L(0); PG8_BAR; PG8_MMA(0, 0, At, B0); PG8_MMA(0, 1, At, B1); PG8_BAR; PG8_SCHED;
            PG8_LDA(At, 1, 1); PG8_STAGE(PG8_SB(1, 0), b3, voffB); PG8_STAGE(PG8_SB(1, 1), b3 + hstep, voffB); PG8_STAGE(PG8_SA(1, 0), a3, voffA);
            PG8_WAIT_V(8); PG8_WAIT_L(0); PG8_BAR; PG8_MMA(1, 0, At, B0); PG8_MMA(1, 1, At, B1); PG8_BAR; PG8_SCHED;
            } else {
            PG8_LDB(B0, 0, 0); PG8_SCHED; PG8_LDA(At, 0, 0); PG8_STAGE(PG8_SA(1, 1), a1 + hstep, voffA);
            PG8_WAIT_L(8); PG8_BAR; PG8_WAIT_L(0); PG8_MMA(0, 0, At, B0); PG8_BAR; PG8_SCHED;
            PG8_LDB(B1, 0, 1); PG8_STAGE(PG8_SB(0, 0), b2, voffB);
            PG8_BAR; PG8_WAIT_L(0); PG8_MMA(0, 1, At, B1); PG8_BAR;
            PG8_LDA(At, 0, 1); PG8_STAGE(PG8_SA(0, 0), a2, voffA);
            PG8_BAR; PG8_WAIT_L(0); PG8_MMA(1, 0, At, B0); PG8_BAR; PG8_SCHED;
            PG8_STAGE(PG8_SB(0, 1), b2 + hstep, voffB);
            PG8_WAIT_V(6); PG8_BAR; PG8_MMA(1, 1, At, B1); PG8_BAR;
            PG8_LDB(B0, 1, 0); PG8_SCHED; PG8_LDA(At, 1, 0); PG8_STAGE(PG8_SA(0, 1), a2 + hstep, voffA);
            PG8_WAIT_L(8); PG8_BAR; PG8_WAIT_L(0); PG8_MMA(0, 0, At, B0); PG8_BAR; PG8_SCHED;
            PG8_LDB(B1, 1, 1); PG8_STAGE(PG8_SB(1, 0), b3, voffB);
            PG8_BAR; PG8_WAIT_L(0); PG8_MMA(0, 1, At, B1); PG8_BAR;
            PG8_LDA(At, 1, 1); PG8_STAGE(PG8_SA(1, 0), a3, voffA);
            PG8_BAR; PG8_WAIT_L(0); PG8_MMA(1, 0, At, B0); PG8_BAR; PG8_SCHED;
            PG8_STAGE(PG8_SB(1, 1), b3 + hstep, voffB);
            PG8_WAIT_V(6); PG8_BAR; PG8_MMA(1, 1, At, B1); PG8_BAR;
            }
        }
        if constexpr (ALIGN_EPI) { if (wr == 0) PG8_BAR; }
        if constexpr (!Epi::AFTER_DRAIN) { E(acc, cur, wr, wc, fr, fq); S.done(cur); }
        if (!has_next) break;
#pragma unroll
        for (int a = 0; a < 2; ++a)
#pragma unroll
            for (int b = 0; b < 2; ++b)
#pragma unroll
                for (int m = 0; m < 4; ++m)
#pragma unroll
                    for (int n = 0; n < 2; ++n) acc[a][b][m][n] = (f32x4){0.f, 0.f, 0.f, 0.f};
        cur = nxt; cA = nA; cB = nB; ++ui;
        if constexpr (ALIGN_EPI) { if (wr == 1) PG8_BAR; }
    }
    PG8_WAIT_V(0);
    if constexpr (!ALIGN_EPI) { if (wr == 0) PG8_BAR; }
    PG8_BAR;
    if constexpr (Epi::AFTER_DRAIN) { E.fused(acc, cur, wr, wc, fr, fq, lds, wid, lane); S.done(cur); }
#undef PG8_SA
#undef PG8_SB
#undef PG8_STAGE
#undef PG8_LDA
#undef PG8_LDB
#undef PG8_MMA
#undef PG8_WAIT_V
#undef PG8_WAIT_L
#undef PG8_BAR
#undef PG8_SCHED
}
}

DEVI void sincos_pos(float ang, float& cs, float& sn) {
    const double TWO_PI = 6.283185307179586476925286766559; const double a = (double)ang; const double k = __builtin_rint(a * (1.0 / TWO_PI));
    const float r = (float)(a - k * TWO_PI);
    cs = cosf(r); sn = sinf(r);
}

namespace afast {
#ifndef ATT_PRIO
#define ATT_PRIO 2
#endif
#ifndef ATT_DUP
#define ATT_DUP 0
#endif
constexpr int NW = 8, KVBLK = 64, SLOTK = 12288, SLOTV = 8192, KROFF = 8192;
constexpr int LDS_K = 0, LDS_V = 3 * SLOTK, LDS_WS = LDS_V + 3 * SLOTV, LDS_OST = LDS_WS + NW * 256, LDS_BYTES = LDS_OST + NW * 4096;
#define SBAR() __builtin_amdgcn_sched_barrier(0)
#define PIN(x) asm volatile("" : "+v"(x))
#define MFMA(a, b, c) __builtin_amdgcn_mfma_f32_32x32x16_bf16(a, b, c, 0, 0, 0)
#ifndef ATT_AGPR_O
#define ATT_AGPR_O 0
#endif
#if ATT_AGPR_O
#define PVMFMA(acc, a, b) asm volatile("s_nop 1\n\tv_mfma_f32_32x32x16_bf16 %0, %1, %2, %0" : "+a"(acc) : "v"(a), "v"(b))
#else
#define PVMFMA(acc, a, b) acc = __builtin_amdgcn_mfma_f32_32x32x16_bf16(a, b, acc, 0, 0, 0)
#endif
#define WAIT_BAR_(N) asm volatile("s_waitcnt vmcnt(" #N ") lgkmcnt(0)\n\ts_barrier" ::: "memory")
#define WAIT_BAR_0() WAIT_BAR_(0)
#define WAIT_BAR_1() do { if (ATT_DUP & 1) WAIT_BAR_(2); else WAIT_BAR_(1); } while (0)
#define WAIT_BAR_2() do { if (ATT_DUP & 1) WAIT_BAR_(4); else WAIT_BAR_(2); } while (0)
#define WAIT_BAR_3() do { if (ATT_DUP & 1) WAIT_BAR_(6); else WAIT_BAR_(3); } while (0)
#define WAIT_BAR(N) do { WAIT_BAR_##N(); if (ATT_DUP & 2) asm volatile("s_barrier" ::: "memory"); } while (0)
DEVI int crow(int r, int hi) { return (r & 3) + 8 * (r >> 2) + 4 * hi; }
DEVI unsigned cvtpk(float lo, float hi) { unsigned r; asm("v_cvt_pk_bf16_f32 %0, %1, %2" : "=v"(r) : "v"(lo), "v"(hi)); return r; }
DEVI void glds16(const void* g, unsigned lds_base) {
    unsigned sv; asm volatile("s_mov_b32 %0, m0\n\ts_mov_b32 m0, %2\n\ts_nop 0\n\tglobal_load_lds_dwordx4 %1, off\n\ts_mov_b32 m0, %0" : "=&s"(sv) : "v"(g), "s"(lds_base) : "memory"); }
typedef __attribute__((address_space(3))) const char* lds_cptr;
typedef short v4i16_t __attribute__((ext_vector_type(4)));
DEVI bf16x8 ldsb128(lds_cptr p) { return *(const __attribute__((address_space(3))) bf16x8*)p; }
DEVI s16x4 vtr(lds_cptr p) { return __builtin_bit_cast(s16x4, __builtin_amdgcn_ds_read_tr16_b64_v4i16((__attribute__((address_space(3))) v4i16_t*)p)); }
DEVI bf16x8 scale8(bf16x8 v, float s) {
    u32x4 w = __builtin_bit_cast(u32x4, v); u32x4 o;
#pragma unroll
    for (int i = 0; i < 4; ++i) { const float lo = __uint_as_float(w[i] << 16) * s, hi = __uint_as_float(w[i] & 0xffff0000u) * s; o[i] = cvtpk(lo, hi); }
    return __builtin_bit_cast(bf16x8, o);
}

template <int ROPE>
DEVI void attn_unit(const bf16_t* Qn, int ldq, const bf16_t* Qr, const float* ssh, const bf16_t* __restrict__ Kn, int ldk, const bf16_t* __restrict__ Kr,
                    const bf16_t* __restrict__ V, int ldv, int NT, bf16_t* O, const bf16_t* G, int ldo, char* lds) {
    const int tid = threadIdx.x, lane = tid & 63, r32 = lane & 31, hi = lane >> 5; const int wid = __builtin_amdgcn_readfirstlane(tid >> 6);
    const unsigned lds0 = (unsigned)(uintptr_t)lds; float* wsf = (float*)(lds + LDS_WS) + wid * 64;
    const bf16_t* ksrc = Kn + (size_t)lane * ldk + wid * 8;
    const bf16_t* vsrc = V + (size_t)(16 * (wid & 3) + (lane >> 2)) * ldv + (wid >> 2) * 32 + (lane & 3) * 8;
    const bf16_t* krsrc = ROPE ? Kr + (size_t)(32 * (wid & 1) + r32) * 32 + 8 * (2 * ((wid >> 1) & 1) + hi) : nullptr;
    const unsigned kdst = lds0 + LDS_K + wid * 1024, vdst = lds0 + LDS_V + wid * 1024, krdst = lds0 + LDS_K + KROFF + (wid & 3) * 1024;
    const bool rwave = ROPE && wid < 4;
#define DMA_K(t, slot) do { DMA_K1(t, slot); if (ATT_DUP & 1) DMA_K1(t, slot); } while (0)
#define DMA_K1(t, slot) do { if (ROPE) { if (rwave) glds16(krsrc + (size_t)(t) * KVBLK * 32, (unsigned)__builtin_amdgcn_readfirstlane(krdst + (slot))); } \
        glds16(ksrc + (size_t)(t) * KVBLK * ldk, (unsigned)__builtin_amdgcn_readfirstlane(kdst + (slot))); } while (0)
#define DMA_V1(t, slot) glds16(vsrc + (size_t)(t) * KVBLK * ldv, (unsigned)__builtin_amdgcn_readfirstlane(vdst + (slot)))
#define DMA_V(t, slot) do { DMA_V1(t, slot); if (ATT_DUP & 1) DMA_V1(t, slot); } while (0)
    const lds_cptr vp0 = (lds_cptr)lds + LDS_V + ((lane >> 4) & 1) * 32 + (lane & 3) * 8 + (4 * hi + ((lane & 15) >> 2)) * 64;
    const lds_cptr kp0 = (lds_cptr)lds + LDS_K + hi * 1024 + r32 * 16;
    const lds_cptr krp0 = (lds_cptr)lds + LDS_K + KROFF + hi * 512 + r32 * 16;
    DMA_K(0, 0); DMA_V(0, 0); DMA_K(1, SLOTK);
    bf16x8 qr[4]; bf16x8 qrr[2];
    { const bf16_t* Qw = Qn + (size_t)(wid * 32 + r32) * ldq + hi * 8;
#pragma unroll
      for (int d0 = 0; d0 < 4; ++d0) qr[d0] = *reinterpret_cast<const bf16x8*>(Qw + d0 * 16);
      if (ROPE) { const bf16_t* Qrw = Qr + (size_t)(wid * 32 + r32) * 512 + hi * 8;
#pragma unroll
          for (int d0 = 0; d0 < 2; ++d0) qrr[d0] = *reinterpret_cast<const bf16x8*>(Qrw + d0 * 16);
          const f32x2 s2 = *(const f32x2*)(ssh + (size_t)(wid * 32 + r32) * 32); const float sc = rsqrtf((s2[0] + s2[1]) * (1.f / 96.f) + EPS) * C2_MLA;
#pragma unroll
          for (int d0 = 0; d0 < 4; ++d0) qr[d0] = scale8(qr[d0], sc);
#pragma unroll
          for (int d0 = 0; d0 < 2; ++d0) qrr[d0] = scale8(qrr[d0], sc); } }
    float l_reg = 0.f; f32x16 o[2]; o[0] = f32x16{}; o[1] = f32x16{};
    const f32x16 zero16 = f32x16{};
    f32x16 dacc = f32x16{}; f32x16 pA0, pA1, pB0, pB1; bf16x8 kf[8]; bf16x8 kfr[4]; s16x4 vlo[8], vhi[8]; u32x4 pw0, pw1, pw2, pw3;
    int sl_prev = 0, sl_cur = 0, sl_next = SLOTK;
#define VSL(s) (((s) / (SLOTK / 1024)) * (SLOTV / 1024))
#define ROT() do { sl_prev = sl_cur; sl_cur = sl_next; sl_next = (sl_next == 2 * SLOTK) ? 0 : sl_next + SLOTK; } while (0)
#define EX(v) __builtin_amdgcn_exp2f(v)
#define KLOADALL(slot) do { _Pragma("unroll") for (int d0 = 0; d0 < 4; ++d0) { kf[2 * d0] = ldsb128(kp0 + (slot) + d0 * 2048); kf[2 * d0 + 1] = ldsb128(kp0 + (slot) + d0 * 2048 + 512); } \
        if (ROPE) { _Pragma("unroll") for (int q = 0; q < 4; ++q) kfr[q] = ldsb128(krp0 + (slot) + q * 1024); } } while (0)
    DMA_K(2, 2 * SLOTK);
    WAIT_BAR(3);
    KLOADALL(0);
    pA0 = MFMA(kf[0], qr[0], zero16); pA1 = MFMA(kf[1], qr[0], zero16); pA0 = MFMA(kf[2], qr[1], pA0); pA1 = MFMA(kf[3], qr[1], pA1);
    pA0 = MFMA(kf[4], qr[2], pA0); pA1 = MFMA(kf[5], qr[2], pA1); pA0 = MFMA(kf[6], qr[3], pA0); pA1 = MFMA(kf[7], qr[3], pA1);
    if (ROPE) { pA0 = MFMA(kfr[0], qrr[0], pA0); pA1 = MFMA(kfr[1], qrr[0], pA1); pA0 = MFMA(kfr[2], qrr[1], pA0); pA1 = MFMA(kfr[3], qrr[1], pA1); }
#pragma unroll
    for (int r = 0; r < 16; ++r) { pA0[r] = EX(pA0[r]); pA1[r] = EX(pA1[r]); }
    WAIT_BAR(0);
    DMA_K(3, 0); DMA_V(1, SLOTV); ROT();
    KLOADALL(sl_cur);
    WAIT_BAR(2);
#define PKW(P, i) cvtpk(P[i], P[i + 1])
#define PAF(k) __builtin_bit_cast(bf16x8, pw##k)
#define VFR(i) (bf16x8){vlo[i][0], vlo[i][1], vlo[i][2], vlo[i][3], vhi[i][0], vhi[i][1], vhi[i][2], vhi[i][3]}
#define VRD(i) do { vlo[i] = vtr(vp_ + (((i) >> 2) * 4096 + ((i) & 3) * 1024)); vhi[i] = vtr(vp_ + (((i) >> 2) * 4096 + ((i) & 3) * 1024 + 512)); } while (0)
#define KRD(G, d0) do { if (G) { kf[2 * (d0)] = ldsb128(kp0 + sl_next + (d0) * 2048); kf[2 * (d0) + 1] = ldsb128(kp0 + sl_next + (d0) * 2048 + 512); \
        if (ATT_DUP & 16) { bf16x8 d0_, d1_; asm volatile("ds_read_b128 %0, %2 offset:0\n\tds_read_b128 %1, %2 offset:512\n\ts_waitcnt lgkmcnt(0)" : "=&v"(d0_), "=&v"(d1_) : "v"((unsigned)(uintptr_t)(kp0 + sl_next + (d0) * 2048)) : "memory"); } SBAR(); } } while (0)
#define KRR(G, q) do { if (ROPE) { if (G) { kfr[2 * (q)] = ldsb128(krp0 + sl_next + (2 * (q)) * 1024); kfr[2 * (q) + 1] = ldsb128(krp0 + sl_next + (2 * (q) + 1) * 1024); SBAR(); } } } while (0)
#define GAPA4(CX, MF, a0, a1, a2, a3, W0, W1, PW) do { MF; sacc += a0; sacc += a1; sacc += a2; sacc += a3; W0; W1; PIN(PW); PIN(sacc); PIN(CX); if ((ATT_DUP & 8) && !ROPE) { dacc = MFMA(kf[0], qr[0], dacc); PIN(dacc); } SBAR(); } while (0)
#define GAPA3(CX, MF, a0, a1, a2, W0, W1, PW) do { MF; sacc += a0; sacc += a1; sacc += a2; W0; W1; PIN(PW); PIN(sacc); PIN(CX); if ((ATT_DUP & 8) && !ROPE) { dacc = MFMA(kf[0], qr[0], dacc); PIN(dacc); } SBAR(); } while (0)
#define GAPA31(CX, MF, a0, a1, a2, W0, PW) do { MF; sacc += a0; sacc += a1; sacc += a2; W0; PIN(PW); PIN(sacc); PIN(CX); if ((ATT_DUP & 8) && !ROPE) { dacc = MFMA(kf[0], qr[0], dacc); PIN(dacc); } SBAR(); } while (0)
#define GAPA21(CX, MF, a0, a1, W0, PW) do { MF; sacc += a0; sacc += a1; W0; PIN(PW); PIN(sacc); PIN(CX); if ((ATT_DUP & 8) && !ROPE) { dacc = MFMA(kf[0], qr[0], dacc); PIN(dacc); } SBAR(); } while (0)
#define XEXP(v) do { if (ATT_DUP & 4) { float d_; asm volatile("v_exp_f32 %0, %1" : "=v"(d_) : "v"(v)); } } while (0)
#define GAPB(MF, X, i) do { MF; X[i] = EX(X[i]); X[i + 1] = EX(X[i + 1]); X[i + 2] = EX(X[i + 2]); X[i + 3] = EX(X[i + 3]); XEXP(X[i]); XEXP(X[i + 1]); XEXP(X[i + 2]); XEXP(X[i + 3]); PIN(X); SBAR(); } while (0)
#define STEP(C0, C1, P0, P1, t, GK, GV, GL) do { SBAR(); if (ATT_PRIO == 2) __builtin_amdgcn_s_setprio(1); if (ATT_PRIO == 3) __builtin_amdgcn_s_setprio(0); \
    const lds_cptr vp_ = vp0 + VSL(sl_prev); \
    VRD(0); SBAR(); float sacc = P0[0] + P0[1]; \
    if (!ROPE) { \
                        GAPA4(C0, C0 = MFMA(kf[0], qr[0], zero16), P0[2], P0[3], P0[4], P0[5],     pw0[0] = PKW(P0, 0),  pw0[1] = PKW(P0, 2),  pw0); \
        VRD(4); SBAR(); GAPA4(C1, C1 = MFMA(kf[1], qr[0], zero16), P0[6], P0[7], P0[8], P0[9],     pw0[2] = PKW(P0, 4),  pw0[3] = PKW(P0, 6),  pw0); \
        VRD(1); SBAR(); GAPA4(C0, C0 = MFMA(kf[2], qr[1], C0),    P0[10], P0[11], P0[12], P0[13], pw1[0] = PKW(P0, 8),  pw1[1] = PKW(P0, 10), pw1); \
        VRD(5); SBAR(); GAPA4(C1, C1 = MFMA(kf[3], qr[1], C1),    P0[14], P0[15], P1[0], P1[1],   pw1[2] = PKW(P0, 12), pw1[3] = PKW(P0, 14), pw1); \
        VRD(2); SBAR(); GAPA4(C0, C0 = MFMA(kf[4], qr[2], C0),    P1[2], P1[3], P1[4], P1[5],     pw2[0] = PKW(P1, 0),  pw2[1] = PKW(P1, 2),  pw2); \
        VRD(6); SBAR(); GAPA4(C1, C1 = MFMA(kf[5], qr[2], C1),    P1[6], P1[7], P1[8], P1[9],     pw2[2] = PKW(P1, 4),  pw2[3] = PKW(P1, 6),  pw2); \
        VRD(3); SBAR(); GAPA4(C0, C0 = MFMA(kf[6], qr[3], C0),    P1[10], P1[11], P1[12], P1[13], pw3[0] = PKW(P1, 8),  pw3[1] = PKW(P1, 10), pw3); \
        VRD(7); SBAR(); GAPA4(C1, C1 = MFMA(kf[7], qr[3], C1),    P1[14], P1[15], 0.f, 0.f,       pw3[2] = PKW(P1, 12), pw3[3] = PKW(P1, 14), pw3); \
    } else { \
                        GAPA3(C0, C0 = MFMA(kf[0], qr[0], zero16), P0[2], P0[3], P0[4],    pw0[0] = PKW(P0, 0),  pw0[1] = PKW(P0, 2),  pw0); \
        VRD(4); SBAR(); GAPA3(C1, C1 = MFMA(kf[1], qr[0], zero16), P0[5], P0[6], P0[7],    pw0[2] = PKW(P0, 4),  pw0[3] = PKW(P0, 6),  pw0); \
        VRD(1); SBAR(); GAPA3(C0, C0 = MFMA(kf[2], qr[1], C0),    P0[8], P0[9], P0[10],   pw1[0] = PKW(P0, 8),  pw1[1] = PKW(P0, 10), pw1); \
        VRD(5); SBAR(); GAPA3(C1, C1 = MFMA(kf[3], qr[1], C1),    P0[11], P0[12], P0[13], pw1[2] = PKW(P0, 12), pw1[3] = PKW(P0, 14), pw1); \
        VRD(2); SBAR(); GAPA31(C0, C0 = MFMA(kf[4], qr[2], C0),   P0[14], P0[15], P1[0],  pw2[0] = PKW(P1, 0),  pw2); \
        VRD(6); SBAR(); GAPA31(C1, C1 = MFMA(kf[5], qr[2], C1),   P1[1], P1[2], P1[3],    pw2[1] = PKW(P1, 2),  pw2); \
        VRD(3); SBAR(); GAPA21(C0, C0 = MFMA(kf[6], qr[3], C0),   P1[4], P1[5],           pw2[2] = PKW(P1, 4),  pw2); \
        VRD(7); SBAR(); GAPA21(C1, C1 = MFMA(kf[7], qr[3], C1),   P1[6], P1[7],           pw2[3] = PKW(P1, 6),  pw2); \
                        GAPA21(C0, C0 = MFMA(kfr[0], qrr[0], C0), P1[8], P1[9],           pw3[0] = PKW(P1, 8),  pw3); \
                        GAPA21(C1, C1 = MFMA(kfr[1], qrr[0], C1), P1[10], P1[11],         pw3[1] = PKW(P1, 10), pw3); \
                        GAPA21(C0, C0 = MFMA(kfr[2], qrr[1], C0), P1[12], P1[13],         pw3[2] = PKW(P1, 12), pw3); \
                        GAPA21(C1, C1 = MFMA(kfr[3], qrr[1], C1), P1[14], P1[15],         pw3[3] = PKW(P1, 14), pw3); \
    } \
    l_reg += sacc; \
    if (GK) DMA_K((t) + 3, sl_cur); if (GV) DMA_V((t) + 1, VSL(sl_next)); \
    SBAR(); if (ATT_PRIO == 2) __builtin_amdgcn_s_setprio(0); if (ATT_PRIO == 3) __builtin_amdgcn_s_setprio(1); \
    GAPB(PVMFMA(o[0], PAF(0), VFR(0)), C0, 0); \
    KRD(GL, 0); GAPB(PVMFMA(o[1], PAF(0), VFR(4)), C0, 4); \
    KRD(GL, 1); GAPB(PVMFMA(o[0], PAF(1), VFR(1)), C0, 8); \
    KRD(GL, 2); GAPB(PVMFMA(o[1], PAF(1), VFR(5)), C0, 12); \
    KRD(GL, 3); GAPB(PVMFMA(o[0], PAF(2), VFR(2)), C1, 0); \
    KRR(GL, 0); GAPB(PVMFMA(o[1], PAF(2), VFR(6)), C1, 4); \
    KRR(GL, 1); GAPB(PVMFMA(o[0], PAF(3), VFR(3)), C1, 8); \
    GAPB(PVMFMA(o[1], PAF(3), VFR(7)), C1, 12); \
    } while (0)
    if (ATT_PRIO == 1) { if (wid >= 4) __builtin_amdgcn_s_setprio(1); }
    int t = 1;
    for (; t + 5 < NT; t += 2) {
        STEP(pB0, pB1, pA0, pA1, t, true, true, true);     WAIT_BAR(2); ROT();
        STEP(pA0, pA1, pB0, pB1, t + 1, true, true, true); WAIT_BAR(2); ROT();
    }
#define ENDW(tt) do { if ((tt) + 3 < NT) { WAIT_BAR(2); } else if ((tt) + 2 < NT) { WAIT_BAR(1); } else { WAIT_BAR(0); } } while (0)
    for (; t + 1 < NT; t += 2) {
        STEP(pB0, pB1, pA0, pA1, t, (t + 3 < NT), (t + 1 < NT), (t + 1 < NT));         ENDW(t);     ROT();
        STEP(pA0, pA1, pB0, pB1, t + 1, (t + 4 < NT), (t + 2 < NT), (t + 2 < NT));     ENDW(t + 1); ROT();
    }
    STEP(pB0, pB1, pA0, pA1, NT - 1, false, false, false);
    if (ATT_PRIO != 0) __builtin_amdgcn_s_setprio(0);
    { float sacc = pB0[0] + pB0[1];
#pragma unroll
      for (int r = 2; r < 16; ++r) sacc += pB0[r];
#pragma unroll
      for (int r = 0; r < 16; ++r) sacc += pB1[r];
      l_reg += sacc;
      pw0 = (u32x4){PKW(pB0, 0), PKW(pB0, 2), PKW(pB0, 4), PKW(pB0, 6)}; pw1 = (u32x4){PKW(pB0, 8), PKW(pB0, 10), PKW(pB0, 12), PKW(pB0, 14)};
      pw2 = (u32x4){PKW(pB1, 0), PKW(pB1, 2), PKW(pB1, 4), PKW(pB1, 6)}; pw3 = (u32x4){PKW(pB1, 8), PKW(pB1, 10), PKW(pB1, 12), PKW(pB1, 14)};
      const lds_cptr vp_ = vp0 + VSL(sl_cur); _Pragma("unroll") for (int i = 0; i < 8; ++i) VRD(i);
      PVMFMA(o[0], PAF(0), VFR(0)); PVMFMA(o[1], PAF(0), VFR(4)); PVMFMA(o[0], PAF(1), VFR(1)); PVMFMA(o[1], PAF(1), VFR(5));
      PVMFMA(o[0], PAF(2), VFR(2)); PVMFMA(o[1], PAF(2), VFR(6)); PVMFMA(o[0], PAF(3), VFR(3)); PVMFMA(o[1], PAF(3), VFR(7)); }
#if ATT_AGPR_O
    asm volatile("s_nop 15\n\ts_nop 7" : "+a"(o[0]), "+a"(o[1]));
#endif
    { auto rr = __builtin_amdgcn_permlane32_swap(__float_as_uint(l_reg), __float_as_uint(l_reg), false, false); l_reg = __uint_as_float(rr[0]) + __uint_as_float(rr[1]); }
    if (hi == 0) wsf[32 + r32] = l_reg; asm volatile("s_waitcnt lgkmcnt(0)" ::: "memory");
    float rli[16];
#pragma unroll
    for (int r = 0; r < 16; ++r) rli[r] = __builtin_amdgcn_rcpf(wsf[32 + crow(r, hi)]);
    bf16_t* stg = (bf16_t*)(lds + LDS_OST) + wid * 2048;
#pragma unroll
    for (int r = 0; r < 16; ++r) { const int orow = crow(r, hi);
#pragma unroll
        for (int d0 = 0; d0 < 2; ++d0) stg[orow * 64 + d0 * 32 + r32] = (bf16_t)f2bf(o[d0][r] * rli[r]); }
    asm volatile("s_waitcnt lgkmcnt(0)" ::: "memory");
#pragma unroll
    for (int i = 0; i < 4; ++i) { const int row = i * 8 + (lane >> 3), ch = lane & 7; const size_t goff = (size_t)(wid * 32 + row) * ldo + ch * 8;
        const u32x4 ov = *(const u32x4*)(stg + row * 64 + ch * 8); const u32x4 gv = *(const u32x4*)(G + goff); u32x4 w;
#pragma unroll
        for (int q = 0; q < 4; ++q) { const float lo = __uint_as_float(ov[q] << 16) * __uint_as_float(gv[q] << 16), hh = __uint_as_float(ov[q] & 0xffff0000u) * __uint_as_float(gv[q] & 0xffff0000u); w[q] = cvtpk(lo, hh); }
        *(u32x4*)(O + goff) = w; }
    asm volatile("s_waitcnt lgkmcnt(0)\n\ts_barrier" ::: "memory");
#undef DMA_K
#undef DMA_K1
#undef DMA_V1
#undef XEXP
#undef DMA_V
#undef VSL
#undef ROT
#undef EX
#undef KLOADALL
#undef PKW
#undef PAF
#undef VFR
#undef VRD
#undef KRD
#undef KRR
#undef GAPA4
#undef GAPA3
#undef GAPA31
#undef GAPA21
#undef GAPB
#undef STEP
#undef ENDW
}
#undef SBAR
#undef PIN
#undef MFMA
#undef PVMFMA
#undef WAIT_BAR
#undef WAIT_BAR_
#undef WAIT_BAR_0
#undef WAIT_BAR_1
#undef WAIT_BAR_2
#undef WAIT_BAR_3
}

namespace af8 {
#ifdef MK_UNIT_PROBE
#define UPROBE_PARAM , unsigned long long& upacc
#define UPROBE_ARG , upacc
#else
#define UPROBE_PARAM
#define UPROBE_ARG
#endif
#ifndef F8_DUP
#define F8_DUP 0
#endif
typedef int v8i __attribute__((ext_vector_type(8)));
typedef int v4i __attribute__((ext_vector_type(4)));
typedef int v2i __attribute__((ext_vector_type(2)));
constexpr int NW = 8, KVBLK = 64, SLOT = 4096, KSLOT = 2048;
constexpr int KRSLOT = 1024 + 64;
constexpr int NSL = 4;
constexpr int LDS_K = 0, LDS_V = NSL * KSLOT, LDS_KR = LDS_V + NSL * SLOT, LDS_WS = LDS_KR + NSL * KRSLOT, LDS_OST = LDS_WS + NW * 256, LDS_BYTES = LDS_OST + NW * 4096;
constexpr float YOFF = (56.0f + 0.5f) / 256.f;
#define SBAR() __builtin_amdgcn_sched_barrier(0)
#define PIN(x) asm volatile("" : "+v"(x))
#define WAIT_BAR0() asm volatile("s_waitcnt vmcnt(0) lgkmcnt(0)\n\ts_barrier" ::: "memory")
#define WAIT_BAR1() asm volatile("s_waitcnt vmcnt(2) lgkmcnt(0)\n\ts_barrier" ::: "memory")
#define V8(x) ((v8i){(x)[0], (x)[1], (x)[2], (x)[3], 0, 0, 0, 0})
#define V6(x) ((v8i){(int)(x)[0], (int)(x)[1], (int)(x)[2], (int)(x)[3], (int)(x)[4], (int)(x)[5], 0, 0})
#define QKMFMA(a, b, c) __builtin_amdgcn_mfma_scale_f32_32x32x64_f8f6f4(V8(a), V6(b), c, 4, 2, 0, 122, 0, 122)
#define PVMFMA8(a, b, c) __builtin_amdgcn_mfma_scale_f32_32x32x64_f8f6f4(a, b, c, 1, 0, 0, 127, 0, 127)
#define SUMMFMA(a, b, c) __builtin_amdgcn_mfma_scale_f32_16x16x128_f8f6f4(a, b, c, 1, 0, 0, 127, 0, 127)
DEVI int crow(int r, int hi) { return (r & 3) + 8 * (r >> 2) + 4 * hi; }
DEVI unsigned cvtpk(float lo, float hi) { unsigned r; asm("v_cvt_pk_bf16_f32 %0, %1, %2" : "=v"(r) : "v"(lo), "v"(hi)); return r; }
DEVI void glds16(const void* g, unsigned lds_base) {
    unsigned sv; asm volatile("s_mov_b32 %0, m0\n\ts_mov_b32 m0, %2\n\ts_nop 0\n\tglobal_load_lds_dwordx4 %1, off\n\ts_mov_b32 m0, %0" : "=&s"(sv) : "v"(g), "s"(lds_base) : "memory"); }
typedef __attribute__((address_space(3))) const char* lds_cptr;
DEVI v4i lds128(lds_cptr p) { return *(const __attribute__((address_space(3))) v4i*)p; }
DEVI v2i vtr8(lds_cptr p) { return __builtin_amdgcn_ds_read_tr8_b64_v2i32((__attribute__((address_space(3))) v2i*)p); }
typedef unsigned short us2 __attribute__((ext_vector_type(2)));
#define PK16U8(P, PF, B) do { _Pragma("unroll") for (int g_ = 0; g_ < 4; ++g_) { \
        const us2 lo_ = __builtin_amdgcn_cvt_pknorm_u16(P[4 * g_], P[4 * g_ + 1]), hi_ = __builtin_amdgcn_cvt_pknorm_u16(P[4 * g_ + 2], P[4 * g_ + 3]); \
        PF[(B) + g_] = (int)__builtin_amdgcn_perm(__builtin_bit_cast(unsigned, hi_), __builtin_bit_cast(unsigned, lo_), 0x07050301u); } } while (0)
DEVI int pk4bf8(float a, float b, float c, float d) { unsigned w; asm volatile("" : "=v"(w)); w = __builtin_amdgcn_cvt_pk_u8_f32(a, 0, w); w = __builtin_amdgcn_cvt_pk_u8_f32(b, 1, w); w = __builtin_amdgcn_cvt_pk_u8_f32(c, 2, w); w = __builtin_amdgcn_cvt_pk_u8_f32(d, 3, w); return (int)w; }

DEVI int pk4fp8(float a, float b, float c, float d) { int w; asm volatile("" : "=v"(w)); w = __builtin_amdgcn_cvt_pk_fp8_f32(a, b, w, false); w = __builtin_amdgcn_cvt_pk_fp8_f32(c, d, w, true); return w; }
#ifndef F6_INTERLEAVED
#define F6_INTERLEAVED 1
#endif
typedef float v16f __attribute__((ext_vector_type(16)));
typedef unsigned v6u __attribute__((ext_vector_type(6)));
DEVI v6u q_cvt(const u32x4 (&wv)[4], float sc) { v16f a, b;
#pragma unroll
    for (int c = 0; c < 4; ++c) { const u32x4 w = wv[c];
#pragma unroll
        for (int k = 0; k < 4; ++k) { const float lo = __uint_as_float(w[k] << 16) * sc, hi = __uint_as_float(w[k] & 0xffff0000u) * sc; const int i = 4 * c + k;
            if (F6_INTERLEAVED) { a[i] = lo; b[i] = hi; } else if (i < 8) { a[2 * i] = lo; a[2 * i + 1] = hi; } else { b[2 * i - 16] = lo; b[2 * i - 15] = hi; } } }
    return __builtin_amdgcn_cvt_scalef32_2xpk16_fp6_f32(a, b, 1.0f); }
struct QRaw { u32x4 a[4], b[4]; f32x2 s2; };
template <int ROPE> DEVI void q_issue(QRaw& r, const void* Qv, int ldq, const bf16_t* Qr, const float* ssh, int wid, int r32, int hi) {
    const bf16_t* p = (const bf16_t*)Qv + (size_t)(wid * 32 + r32) * ldq + hi * 32;
#pragma unroll
    for (int c = 0; c < 4; ++c) r.a[c] = *(const u32x4*)(p + 8 * c);
    if (ROPE) { const bf16_t* pr = Qr + (size_t)(wid * 32 + r32) * 512;
#pragma unroll
        for (int c = 0; c < 4; ++c) r.b[c] = *(const u32x4*)(pr + 8 * c);
        r.s2 = *(const f32x2*)(ssh + (size_t)(wid * 32 + r32) * 32); } }
template <int ROPE> DEVI void q_convert(const QRaw& r, int hi, v6u& qf, v6u& qrf) {
    if (!ROPE) { qf = q_cvt(r.a, 1.0f); qrf = qf; }
    else { const float sc = rsqrtf((r.s2[0] + r.s2[1]) * (1.f / 96.f) + EPS) * (C2_MLA * 8.f); qf = q_cvt(r.a, sc); qrf = q_cvt(r.b, hi ? 0.f : sc); } }
struct Dma { const unsigned char* dsrc; size_t dstep; unsigned ddst; int dslot, dlead; bool kwave, dma_on; };
template <int ROPE> DEVI Dma dma_setup(const unsigned char* K, int ldk, const unsigned char* Kr, const unsigned char* V, int ldv, unsigned lds0, int wid, int lane) { Dma d;
    const int role = wid < 2 ? 0 : (wid >= 4 ? 1 : ((ROPE && wid == 2) ? 2 : 3)); d.kwave = role != 1; d.dlead = d.kwave ? 4 : 2;
    const int kkey = 32 * (wid & 1) + (lane >> 1), vkey = 16 * (wid & 3) + (lane >> 2);
    d.dsrc = role == 0 ? K + (size_t)kkey * ldk + 16 * ((lane & 1) ^ ((kkey >> 3) & 1))
           : role == 1 ? V + (size_t)vkey * ldv + 16 * ((lane & 3) ^ (2 * ((vkey >> 3) & 1)))
           : (ROPE ? Kr + (size_t)lane * 16 : K);
    d.dstep = (size_t)KVBLK * (role == 0 ? ldk : (role == 1 ? ldv : 16));
    d.ddst = lds0 + (role == 0 ? LDS_K + (wid & 1) * 1024 : (role == 1 ? LDS_V + (wid & 3) * 1024 : LDS_KR));
    d.dslot = role == 0 ? KSLOT : (role == 1 ? SLOT : KRSLOT); d.dma_on = role != 3; return d; }
#define DMAX(d, t, si) glds16((d).dsrc + (size_t)(t) * (d).dstep, (unsigned)__builtin_amdgcn_readfirstlane((d).ddst + (si) * (d).dslot))
DEVI void dma_head(const Dma& d) { if (d.dma_on) { if (d.kwave) { DMAX(d, 0, 0); DMAX(d, 1, 1); DMAX(d, 2, 2); DMAX(d, 3, 3); } else { DMAX(d, 0, 0); DMAX(d, 1, 1); } } }
template <int ROPE>
DEVI void attn_prefetch(const void* Qv, int ldq, const bf16_t* Qr, const float* ssh, const unsigned char* K, int ldk, const unsigned char* Kr, const unsigned char* V, int ldv, char* lds, v6u& qf, v6u& qrf) {
    int tid_ = threadIdx.x; asm volatile("" : "+v"(tid_));
    const int tid = tid_, lane = tid & 63, r32 = lane & 31, hi = lane >> 5; const int wid = __builtin_amdgcn_readfirstlane(tid >> 6);
    if (ROPE) { if (tid < 16) *(int*)(lds + LDS_KR + (tid >> 2) * KRSLOT + 1024 + (tid & 3) * 4) = 0; }
    const Dma d = dma_setup<ROPE>(K, ldk, Kr, V, ldv, (unsigned)(uintptr_t)lds, wid, lane); dma_head(d);
    QRaw qr; q_issue<ROPE>(qr, Qv, ldq, Qr, ssh, wid, r32, hi); q_convert<ROPE>(qr, hi, qf, qrf); }
template <int ROPE>
DEVI void attn_unit(const unsigned char* __restrict__ K, int ldk, const unsigned char* __restrict__ Kr, const unsigned char* __restrict__ V, int ldv, int NT, bf16_t* O, const bf16_t* G, int ldo, char* lds, v6u& qf_io, v6u& qrf_io,
                    bool has_next, const void* Qv_n, int ldq, const bf16_t* Qr_n, const float* ssh_n, const unsigned char* K_n, const unsigned char* Kr_n, const unsigned char* V_n UPROBE_PARAM) {
#ifdef MK_UNIT_PROBE
    const unsigned long long upT0 = __builtin_amdgcn_s_memrealtime();
#endif
    int tid_ = threadIdx.x; asm volatile("" : "+v"(tid_));
    const int tid = tid_, lane = tid & 63, r32 = lane & 31, hi = lane >> 5; const int wid = __builtin_amdgcn_readfirstlane(tid >> 6);
    const unsigned lds0 = (unsigned)(uintptr_t)lds; float* wsf = (float*)(lds + LDS_WS) + wid * 64;
    const Dma dd = dma_setup<ROPE>(K, ldk, Kr, V, ldv, lds0, wid, lane);
    const bool kwave = dd.kwave, dma_on = dd.dma_on; const int dlead = dd.dlead;
#define DMA(t, si) DMAX(dd, t, si)
    const lds_cptr kpa = (lds_cptr)lds + LDS_K + r32 * 32 + ((hi ^ ((r32 >> 3) & 1)) * 16);
    const int vg = (lane >> 4) & 1, vq = (lane & 15) >> 1, vp = lane & 1, vfk = (vq >> 2) & 1;
    const int vrow = (8 * (vq >> 2) + 4 * hi + (vq & 3)) * 64 + 8 * vp + 16 * vg;
    const lds_cptr vp0 = (lds_cptr)lds + LDS_V + vrow + 32 * vfk, vp1 = (lds_cptr)lds + LDS_V + vrow + 32 * (1 - vfk);
    const lds_cptr ra0 = (lds_cptr)lds + LDS_KR + (hi ? 1024 : r32 * 16), ra1 = (lds_cptr)lds + LDS_KR + (hi ? 1024 : 512 + r32 * 16);
    const v6u qf = qf_io, qrf = qrf_io;
    f32x16 o[2]; o[0] = f32x16{}; o[1] = f32x16{}; f32x4 lacc = f32x4{};
    v8i ones;
#pragma unroll
    for (int i = 0; i < 8; ++i) ones[i] = ((lane & 15) == ((lane >> 4) & 1)) ? 0x38383838 : 0;
    PIN(ones);
    f32x16 m4;
    { float y_ = YOFF; asm volatile("" : "+v"(y_));
#pragma unroll
      for (int r = 0; r < 16; ++r) m4[r] = y_; }
    PIN(m4);
    v4i kf0, kf1, krf0, krf1; v8i vf0, vf1, pfA, pfB;
#define ROT() do { } while (0)
#define EX(v) __builtin_amdgcn_exp2f(v)
#define KLOAD(si) do { kf0 = lds128(kpa + (si) * KSLOT); kf1 = lds128(kpa + (si) * KSLOT + 1024); if (ROPE) { krf0 = lds128(ra0 + (si) * KRSLOT); krf1 = lds128(ra1 + (si) * KRSLOT); } } while (0)
    WAIT_BAR0();
    KLOAD(0);
    { f32x16 c0 = QKMFMA(kf0, qf, m4), c1 = QKMFMA(kf1, qf, m4);
      if (ROPE) { c0 = QKMFMA(krf0, qrf, c0); c1 = QKMFMA(krf1, qrf, c1); }
      PK16U8(c0, pfA, 0); PK16U8(c1, pfA, 4); }
    WAIT_BAR0();
    if (dma_on) { if (kwave) { if (4 < NT) DMA(4, 0); } else DMA(2, 2); }
    KLOAD(1);
    WAIT_BAR1();
#define VRD2(m) do { const v2i a_ = vtr8(vp0 + vsl_ * SLOT + (m) * 1024), b_ = vtr8(vp1 + vsl_ * SLOT + (m) * 1024); vf0[2 * (m)] = a_[0]; vf0[2 * (m) + 1] = a_[1]; vf1[2 * (m)] = b_[0]; vf1[2 * (m) + 1] = b_[1]; } while (0)
#define STEP(t, PFP, PFN, GK, GV, GL) do { SBAR(); \
    const int vsl_ = ((t) - 1) & 3; f32x16 C0, C1; \
    VRD2(0); VRD2(1); SBAR(); \
    C0 = QKMFMA(kf0, qf, m4); if (ROPE) C0 = QKMFMA(krf0, qrf, C0); PIN(C0); SBAR(); \
    VRD2(2); VRD2(3); SBAR(); \
    C1 = QKMFMA(kf1, qf, m4); if (ROPE) C1 = QKMFMA(krf1, qrf, C1); PIN(C1); SBAR(); \
    if (GL) { KLOAD(((t) + 1) & 3); } \
    { const bool mine_ = dma_on && (kwave ? (GK) : (GV)); if (mine_) DMA((t) + dlead, kwave ? ((t) & 3) : (((t) + 2) & 3)); } \
    SBAR(); \
    lacc = SUMMFMA(PFP, ones, lacc); PIN(lacc); SBAR(); \
    PK16U8(C0, PFN, 0); PIN(PFN); SBAR(); \
    o[0] = PVMFMA8(PFP, vf0, o[0]); PIN(o[0]); SBAR(); \
    PK16U8(C1, PFN, 4); PIN(PFN); SBAR(); \
    o[1] = PVMFMA8(PFP, vf1, o[1]); PIN(o[1]); SBAR(); \
    { const bool mine_ = dma_on && (kwave ? (GK) : (GV)); if (mine_) WAIT_BAR1(); else WAIT_BAR0(); } \
    } while (0)
#ifdef MK_UNIT_PROBE
    const unsigned long long upT1 = __builtin_amdgcn_s_memrealtime();
#endif
    int t = 1;
    for (; t + 5 < NT; t += 2) {
        STEP(t, pfA, pfB, true, true, true);     ROT();
        STEP(t + 1, pfB, pfA, true, true, true); ROT();
    }
    for (; t + 1 < NT; t += 2) {
        STEP(t, pfA, pfB, (t + 4 < NT), (t + 2 < NT), (t + 1 < NT));         ROT();
        STEP(t + 1, pfB, pfA, (t + 5 < NT), (t + 3 < NT), (t + 2 < NT));     ROT();
    }
    STEP(NT - 1, pfA, pfB, false, false, false);
#ifdef MK_UNIT_PROBE
    const unsigned long long upT2 = __builtin_amdgcn_s_memrealtime();
#endif
    if (has_next) { const Dma dn = dma_setup<ROPE>(K_n, ldk, Kr_n, V_n, ldv, lds0, wid, lane); dma_head(dn); }
    u32x4 gv[4];
#pragma unroll
    for (int i = 0; i < 4; ++i) gv[i] = *(const u32x4*)(G + (size_t)(wid * 32 + i * 8 + (lane >> 3)) * ldo + (lane & 7) * 8);
    QRaw qn;
    if (has_next) q_issue<ROPE>(qn, Qv_n, ldq, Qr_n, ssh_n, wid, r32, hi);
    { const int vsl_ = (NT - 1) & 3; VRD2(0); VRD2(1); VRD2(2); VRD2(3);
      lacc = SUMMFMA(pfB, ones, lacc); o[0] = PVMFMA8(pfB, vf0, o[0]); o[1] = PVMFMA8(pfB, vf1, o[1]); }
    float rli[16];
#pragma unroll
    for (int r = 0; r < 16; ++r) rli[r] = 0.f;
    if ((lane & 15) < 2) *(f32x4*)(wsf + (lane & 15) * 16 + 4 * (lane >> 4)) = lacc;
    asm volatile("s_waitcnt lgkmcnt(0)" ::: "memory");
#pragma unroll
    for (int r = 0; r < 16; ++r) rli[r] = __builtin_amdgcn_rcpf(wsf[crow(r, hi)]);
    bf16_t* stg = (bf16_t*)(lds + LDS_OST) + wid * 2048;
#pragma unroll
    for (int r = 0; r < 16; ++r) { const int orow = crow(r, hi);
#pragma unroll
        for (int d0 = 0; d0 < 2; ++d0) stg[orow * 64 + d0 * 32 + r32] = (bf16_t)f2bf(o[d0][r] * rli[r]); }
    asm volatile("s_waitcnt lgkmcnt(0)" ::: "memory");
#pragma unroll
    for (int i = 0; i < 4; ++i) { const int row = i * 8 + (lane >> 3), ch = lane & 7; const size_t goff = (size_t)(wid * 32 + row) * ldo + ch * 8;
        const u32x4 ov = *(const u32x4*)(stg + row * 64 + ch * 8); u32x4 w;
#pragma unroll
        for (int q = 0; q < 4; ++q) { const float lo = __uint_as_float(ov[q] << 16) * __uint_as_float(gv[i][q] << 16), hh = __uint_as_float(ov[q] & 0xffff0000u) * __uint_as_float(gv[i][q] & 0xffff0000u); w[q] = cvtpk(lo, hh); }
        *(u32x4*)(O + goff) = w; }
    if (has_next) q_convert<ROPE>(qn, hi, qf_io, qrf_io);
    asm volatile("s_waitcnt lgkmcnt(0)\n\ts_barrier" ::: "memory");
#ifdef MK_UNIT_PROBE
    { const unsigned long long upT3 = __builtin_amdgcn_s_memrealtime(); const int w_ = MK_UNIT_PROBE & 3; upacc += w_ == 1 ? (upT1 - upT0) : (w_ == 2 ? (upT3 - upT2) : (upT2 - upT1)); }
#endif
#undef DMA
#undef ROT
#undef EX
#undef KLOAD
#undef VRD2
#undef STEP
}
#undef SBAR
#undef PIN
#undef WAIT_BAR0
#undef WAIT_BAR1
#undef QKMFMA
#undef DMAX
#undef SUMMFMA
#undef V8
#undef V6
#undef PVMFMA8
}

#define RLX_AGENT __ATOMIC_RELAXED, __HIP_MEMORY_SCOPE_AGENT
#define XB_TMO      128
#define XB_XCNT(j)  (256  + 64 * (j))
#define XB_XSUB(j)  (1280 + 64 * (j))
#define XB_XGEN(j)  (2304 + 64 * (j))
#define XB_TOP      3328
#define XB_TOPGEN   3392
#define XCD_BAR_WORDS 3456
#define XB_SPIN_CAP (1u << 18)

__device__ __forceinline__ unsigned xb_ld(unsigned* p)              { return __hip_atomic_load(p, __ATOMIC_RELAXED, __HIP_MEMORY_SCOPE_AGENT); }
__device__ __forceinline__ unsigned xb_add(unsigned* p, unsigned v) { return __hip_atomic_fetch_add(p, v, __ATOMIC_RELAXED, __HIP_MEMORY_SCOPE_AGENT); }
__device__ __forceinline__ unsigned xb_xcc_id() { return (unsigned)__builtin_amdgcn_s_getreg((3 << 11) | 20) & 0xFu; }
#define XB_SPIN(cond, bar) do { unsigned _sp = 0; while (cond) { __builtin_amdgcn_s_sleep(1); \
    if ((++_sp & 255u) == 0u) { if (xb_ld(&(bar)[XB_TMO])) break; if (_sp > XB_SPIN_CAP) { atomicAdd(&(bar)[XB_TMO], 1u); break; } } } } while (0)

struct XcdBarrier {
    unsigned* bar; unsigned x;
    volatile LAS unsigned* st;
};

__device__ __forceinline__ XcdBarrier xcd_barrier_post(unsigned* bar, volatile LAS unsigned* st) {
    XcdBarrier b; b.bar = bar; b.x = xb_xcc_id(); b.st = st;
    if (threadIdx.x == 0) (void)xb_add(&bar[XB_XCNT(b.x)], 1u);
    return b;
}
__device__ __forceinline__ void xcd_barrier_complete(unsigned* bar, unsigned x, unsigned& nloc, unsigned& nx) {
    const unsigned G = gridDim.x * gridDim.y * gridDim.z;
    unsigned sum, cnt, mine, sp = 0u;
    for (;;) {
        sum = 0u; cnt = 0u; mine = 0u;
#pragma unroll
        for (unsigned j = 0; j < 16; ++j) { const unsigned c = xb_ld(&bar[XB_XCNT(j)]); sum += c; cnt += (c > 0u) ? 1u : 0u; mine = (j == x) ? c : mine; }
        if (sum == G) break;
        __builtin_amdgcn_s_sleep(1);
        if ((++sp & 255u) == 0u) { if (xb_ld(&bar[XB_TMO])) break; if (sp > XB_SPIN_CAP) { atomicAdd(&bar[XB_TMO], 1u); break; } }
    }
    nloc = mine > 0u ? mine : 1u; nx = cnt > 0u ? cnt : 1u;
}

__device__ __forceinline__ void xcd_barrier(const XcdBarrier& b) {
    asm volatile("s_waitcnt vmcnt(0)" ::: "memory");
    __syncthreads();
    if (threadIdx.x == 0) {
        unsigned* bar = b.bar;
        __builtin_amdgcn_s_waitcnt(0);
        unsigned nloc = b.st[0], nx = b.st[1];
        if (nloc == 0u) { xcd_barrier_complete(bar, b.x, nloc, nx); b.st[0] = nloc; b.st[1] = nx; }
        const unsigned old = xb_add(&bar[XB_XSUB(b.x)], 1u);
        const unsigned gen = old / nloc;
        if (old + 1u == (gen + 1u) * nloc) {
            __builtin_amdgcn_fence(__ATOMIC_RELEASE, "agent");
            asm volatile("s_waitcnt vmcnt(0)" ::: "memory");
            const unsigned og = xb_add(&bar[XB_TOP], 1u);
            const unsigned tg = og / nx;
            if (og + 1u == (tg + 1u) * nx) xb_add(&bar[XB_TOPGEN], 1u);
            else XB_SPIN(xb_ld(&bar[XB_TOPGEN]) == tg, bar);
            __builtin_amdgcn_fence(__ATOMIC_ACQUIRE, "agent");
            xb_add(&bar[XB_XGEN(b.x)], 1u);
            asm volatile("s_waitcnt vmcnt(0)" ::: "memory");
        } else {
            XB_SPIN(xb_ld(&bar[XB_XGEN(b.x)]) == gen, bar);
            __builtin_amdgcn_fence(__ATOMIC_ACQUIRE, "agent");
            asm volatile("s_waitcnt vmcnt(0)" ::: "memory");
        }
    }
    __syncthreads();
}


#include <hip/hip_cooperative_groups.h>
namespace cg = cooperative_groups;
constexpr int NWAVES = 8, NTHREADS = 512, LDS_BYTES = 147456, RING_BYTES = 131072;
constexpr size_t MiB = 1u << 20;
constexpr size_t WS_MOD = 1 * MiB;
constexpr size_t WS_TABA = WS_MOD + 128 * 1024;
constexpr size_t WS_TABB = WS_TABA + 32 * 1024;
constexpr size_t WS_WIN0 = 2 * MiB;
constexpr size_t WS_WOUT0 = 7 * MiB;
constexpr size_t WS_WIN1 = 9 * MiB;
constexpr size_t WS_WKVB = 13 * MiB;
constexpr size_t WS_WQB = 14 * MiB;
constexpr size_t WS_WOUT1 = 16 * MiB;
constexpr size_t WS_X1C = 18 * MiB;
constexpr size_t WS_H = 20 * MiB;
constexpr size_t WS_Q = 53 * MiB;
constexpr size_t WS_K = 86 * MiB;
constexpr size_t WS_V0 = 95 * MiB;
constexpr size_t WS_G = 120 * MiB;
constexpr size_t WS_V1 = 153 * MiB;
constexpr size_t WS_KVA = 186 * MiB;
constexpr size_t WS_QA = 195 * MiB;
constexpr size_t WS_Q1R = 207 * MiB;
constexpr size_t WS_KR = 223 * MiB;
constexpr size_t WS_SSKV = 225 * MiB;
constexpr size_t WS_SSQ = 226 * MiB;
constexpr size_t WS_SSH = 227 * MiB;
constexpr size_t WS_SSX = 229 * MiB;
constexpr size_t WS_BIAS1 = WS_MOD + 80 * 1024;
constexpr size_t WS_NWM1 = WS_MOD + 104 * 1024;
constexpr size_t WS_RINV = 230 * MiB + 512 * 1024;
constexpr size_t WS_SLAB = 231 * MiB;
constexpr size_t WS_END = 256 * MiB;
static_assert(WS_K + (size_t)NB * TK * DM * 2 <= WS_G && WS_G + (size_t)MT * DM * 2 <= WS_V1 && WS_V1 + (size_t)NB * TK * DM * 2 <= WS_KVA && WS_SSH + (size_t)ML * 32 * 4 <= WS_END, "ws map");

#ifndef ATT1_F8
#define ATT1_F8 1
#endif
#ifndef ATT0_F8
#define ATT0_F8 1
#endif
struct Args { const float* in[23]; float* out; unsigned char* ws; int ph_lo, ph_hi, coop, pad; };

DEVI void phase0(const Args& a, unsigned char* ws, LAS unsigned char* lds, int vb, int G) {
    const int tid = threadIdx.x, wave = tid >> 6, lane = tid & 63;
    float* mod = (float*)(ws + WS_MOD);
    if (vb < 96) {
        LAS float* sc = (LAS float*)lds; LAS float* red = sc + 3 * 1024;
        const int layer = vb / 48, cs = vb % 48; const float* w = a.in[layer ? 11 : 4]; const float* bb = a.in[layer ? 12 : 5];
        for (int i = tid; i < 3072; i += NTHREADS) { const int r = i >> 10, k = i & 1023; const float v = r < 2 ? a.in[1][r * 1024 + k] : a.in[3][k]; sc[i] = v / (1.f + expf(-v)); }
        __syncthreads();
        const int col = cs * 64 + lane; float a0 = 0.f, a1 = 0.f, a2 = 0.f;
#pragma unroll 8
        for (int k = wave * 128; k < wave * 128 + 128; ++k) { const float wv = w[(size_t)k * 3072 + col]; a0 += sc[k] * wv; a1 += sc[1024 + k] * wv; a2 += sc[2048 + k] * wv; }
        red[(wave * 3 + 0) * 64 + lane] = a0; red[(wave * 3 + 1) * 64 + lane] = a1; red[(wave * 3 + 2) * 64 + lane] = a2;
        __syncthreads();
        if (tid < 192) { const int r = tid >> 6; float s = 0.f;
#pragma unroll
            for (int q = 0; q < 8; ++q) s += red[(q * 3 + r) * 64 + lane];
            mod[(size_t)(layer * 3 + r) * 3072 + col] = s + bb[col]; }
        __syncthreads();
    } else if (vb < 102) {
        f32x2* tabA = (f32x2*)(ws + WS_TABA); f32x2* tabB = (f32x2*)(ws + WS_TABB);
        const int i = (vb - 96) * NTHREADS + tid;
        if (i < 128 * 16) { const int pos = i >> 4, f = i & 15; const float invf = powf(10000.f, -(float)f / 16.f); float cs_, sn_; sincos_pos((float)pos * invf, cs_, sn_); tabA[i] = (f32x2){cs_, sn_}; }
        else if (i < 128 * 24) { const int j = i - 128 * 16, pos = j >> 3, f = j & 7; const float invf = powf(10000.f, -(float)f / 8.f); float cs_, sn_; sincos_pos((float)pos * invf, cs_, sn_); tabB[j] = (f32x2){cs_, sn_}; }
    }
    if (vb < 102 || G <= 102) { if (G > 102) return; }
    struct WD { int src, K, Nsrc, Np, mode, ks; size_t dst; };
    const WD wd[6] = {{7, 1024, N_IN0, 2560, 1, -1, WS_WIN0}, {10, 1024, 1024, 1024, 0, -1, WS_WOUT0}, {14, 1024, N_IN1, N_IN1P, 2, -1, WS_WIN1},
                      {16, 256, 2048, 2048, 3, 15, WS_WKVB}, {18, 384, 1536, 2048, 4, 17, WS_WQB}, {22, 1024, 1024, 1024, 0, -1, WS_WOUT1}};
    LAS float* tl = (LAS float*)lds; int tbase = 0;
#pragma unroll
    for (int m = 0; m < 6; ++m) {
        const float* W = a.in[wd[m].src]; const float* ks = wd[m].ks >= 0 ? a.in[wd[m].ks] : nullptr; bf16_t* Bt = (bf16_t*)(ws + wd[m].dst);
        const int K = wd[m].K, Nsrc = wd[m].Nsrc, Np = wd[m].Np, npb = Np / 256, ntile = (K / 64) * npb;
        for (int it = ((vb - 102) - tbase % (G - 102) + (G - 102)) % (G - 102); it < ntile; it += (G - 102)) {
            const int kb = it / npb, pb = it % npb, k0 = 64 * kb, p0 = 256 * pb;
            const int pl = tid & 255, kh = tid >> 8; int cc = pg8::wmap(wd[m].mode, p0 + pl); if (cc >= Nsrc) cc = -1;
            float v[32];
#pragma unroll
            for (int i = 0; i < 32; ++i) { const int k = k0 + 2 * i + kh; v[i] = cc >= 0 ? W[(size_t)k * Nsrc + cc] * (ks ? ks[k] : 1.f) : 0.f; }
#pragma unroll
            for (int i = 0; i < 32; ++i) tl[pl * 65 + 2 * i + kh] = v[i];
            __syncthreads();
#pragma unroll
            for (int j = 0; j < 4; ++j) { const int q = tid + 512 * j, pr = q >> 3, c = q & 7; const LAS float* sp = tl + pr * 65 + 8 * c;
                u32x4 o; o.x = pk2(sp[0], sp[1]); o.y = pk2(sp[2], sp[3]); o.z = pk2(sp[4], sp[5]); o.w = pk2(sp[6], sp[7]);
                *(u32x4*)(Bt + (size_t)(p0 + pr) * K + k0 + 8 * c) = o; }
            __syncthreads();
        }
        tbase += ntile;
    }
}

DEVI void phase_prep(const float* xa, const float* xb, const float* nw, const float* mod, bf16_t* H, int gw, int NGW, int lane) {
    for (int row0 = gw; row0 < MT; row0 += 4 * NGW) {
        f32x4 v[4][4]; float ss[4];
#pragma unroll
        for (int q = 0; q < 4; ++q) { const int row = row0 + q * NGW; ss[q] = 0.f;
            if (row < MT) { const float* src = row < ML ? xa + (size_t)row * DM : xb + (size_t)(row - ML) * DM;
#pragma unroll
                for (int j = 0; j < 4; ++j) v[q][j] = *(const f32x4*)(src + 4 * lane + 256 * j); } }
#pragma unroll
        for (int q = 0; q < 4; ++q) { const int row = row0 + q * NGW;
            if (row < MT) {
#pragma unroll
                for (int j = 0; j < 4; ++j) ss[q] += (v[q][j].x * v[q][j].x + v[q][j].y * v[q][j].y) + (v[q][j].z * v[q][j].z + v[q][j].w * v[q][j].w); } }
#pragma unroll
        for (int o = 1; o < 64; o <<= 1) {
#pragma unroll
            for (int q = 0; q < 4; ++q) ss[q] += __shfl_xor(ss[q], o); }
#pragma unroll
        for (int q = 0; q < 4; ++q) { const int row = row0 + q * NGW;
            if (row < MT) { const int r = row < SEQ ? 0 : (row < ML ? 1 : 2); const float rinv = rsqrtf(ss[q] * (1.f / DM) + EPS);
#pragma unroll
                for (int j = 0; j < 4; ++j) { const int cidx = 4 * lane + 256 * j; const f32x4 w = *(const f32x4*)(nw + cidx);
                    const f32x4 sh = *(const f32x4*)(mod + (size_t)r * 3072 + cidx), scl = *(const f32x4*)(mod + (size_t)r * 3072 + 1024 + cidx);
                    const f32x4 h = (v[q][j] * rinv) * w * (scl + 1.f) + sh;
                    u32x2 o; o.x = pk2(h.x, h.y); o.y = pk2(h.z, h.w); *(u32x2*)(H + (size_t)row * DM + cidx) = o; } } }
    }
}

DEVI float sq4f(const f32x4 v) { return (v[0] * v[0] + v[1] * v[1]) + (v[2] * v[2] + v[3] * v[3]); }
DEVI void phase1_extras(const float* nw1, const float* mod1, const bf16_t* Win1t, float* nwm1, float* bias1, const float* ctx, float* X1c, int gw, int NGW, int lane) {
    for (int p = gw; p < N_IN1P; p += NGW) {
        const u32x4 w0 = *(const u32x4*)(Win1t + (size_t)p * DM + lane * 16), w1 = *(const u32x4*)(Win1t + (size_t)p * DM + lane * 16 + 8); float acc3[3];
#pragma unroll
        for (int r = 0; r < 3; ++r) { const float* mp = mod1 + (size_t)r * 3072 + lane * 16; const f32x4 m0 = *(const f32x4*)mp, m1 = *(const f32x4*)(mp + 4), m2 = *(const f32x4*)(mp + 8), m3 = *(const f32x4*)(mp + 12);
            const float mm[16] = {m0[0], m0[1], m0[2], m0[3], m1[0], m1[1], m1[2], m1[3], m2[0], m2[1], m2[2], m2[3], m3[0], m3[1], m3[2], m3[3]}; float a = 0.f;
#pragma unroll
            for (int i = 0; i < 8; ++i) { const unsigned ww = i < 4 ? w0[i] : w1[i - 4]; a += mm[2 * i] * __uint_as_float(ww << 16) + mm[2 * i + 1] * __uint_as_float(ww & 0xffff0000u); }
            acc3[r] = wave_sum(a); }
        if (lane == 0) { bias1[p] = acc3[0]; bias1[N_IN1P + p] = acc3[1]; bias1[2 * N_IN1P + p] = acc3[2]; }
    }
    for (int i = gw * 64 + lane; i < 3 * DM; i += NGW * 64) { const int r = i >> 10, c = i & 1023; nwm1[i] = nw1[c] * (1.f + mod1[(size_t)r * 3072 + 1024 + c]); }
}
DEVI void phase_ctxprep(const float* ctx, const float* slab, const float* gatec, float* X1c, const float* nwm1, bf16_t* H, const float* SSX, float* RINV, int gw, int NGW, int lane) {
    for (int rr = gw; rr < MC; rr += NGW) { const int R = ML + rr; float ss = 0.f;
#pragma unroll
        for (int j = 0; j < 4; ++j) { const int c = 4 * lane + 256 * j; f32x4 y = *(const f32x4*)(slab + (size_t)rr * DM + c);
#pragma unroll
            for (int ks = 1; ks < 8; ++ks) y = y + *(const f32x4*)(slab + ((size_t)ks * MC + rr) * DM + c);
            const f32x4 v = *(const f32x4*)(ctx + (size_t)rr * DM + c) + *(const f32x4*)(gatec + c) * y; *(f32x4*)(X1c + (size_t)rr * DM + c) = v;
            ss += sq4f(v); const f32x4 h = v * *(const f32x4*)(nwm1 + 2 * DM + c);
            u32x2 o; o.x = pk2(h.x, h.y); o.y = pk2(h.z, h.w); *(u32x2*)(H + (size_t)R * DM + c) = o; }
        ss = wave_sum(ss); if (lane == 0) RINV[R] = rsqrtf(ss * (1.f / DM) + EPS); }
    for (int R = gw * 64 + lane; R < ML; R += NGW * 64) { const f32x4 s0 = *(const f32x4*)(SSX + (size_t)R * 16), s1 = *(const f32x4*)(SSX + (size_t)R * 16 + 4), s2 = *(const f32x4*)(SSX + (size_t)R * 16 + 8), s3 = *(const f32x4*)(SSX + (size_t)R * 16 + 12);
        const f32x4 st = (s0 + s1) + (s2 + s3); RINV[R] = rsqrtf(((st[0] + st[1]) + (st[2] + st[3])) * (1.f / DM) + EPS); }
}

#ifdef MK_UBENCH
DEVI void ubench(int wave) {
    typedef int v8i __attribute__((ext_vector_type(8)));
    if ((MK_UBENCH & 4) && wave >= 4) return;
    v8i a, b; f32x16 acc = f32x16{}; float e[8]; float d = 0.f;
#pragma unroll
    for (int i = 0; i < 8; ++i) { a[i] = 0x38383838; b[i] = 0x38383838; e[i] = 0.001f * (float)(i + 1); }
    asm volatile("" : "+v"(a), "+v"(b));
    bf16x8 ha, hb; asm volatile("" : "=v"(ha), "=v"(hb));
    for (int it = 0; it < 1500; ++it) {
        if (MK_UBENCH & 1) { if (MK_UBENCH & 16) { acc = __builtin_amdgcn_mfma_f32_32x32x16_bf16(ha, hb, acc, 0, 0, 0); acc = __builtin_amdgcn_mfma_f32_32x32x16_bf16(ha, hb, acc, 0, 0, 0); }
                             else if (MK_UBENCH & 32) acc = __builtin_amdgcn_mfma_scale_f32_32x32x64_f8f6f4(a, b, acc, 4, 2, 0, 127, 0, 127);
                             else if (MK_UBENCH & 64) acc = __builtin_amdgcn_mfma_scale_f32_32x32x64_f8f6f4(a, b, acc, 4, 4, 0, 127, 0, 127);
                             else acc = __builtin_amdgcn_mfma_scale_f32_32x32x64_f8f6f4(a, b, acc, 0, 0, 0, 127, 0, 127); }
        if (MK_UBENCH & 2) {
#pragma unroll
            for (int i = 0; i < 8; ++i) e[i] = __builtin_amdgcn_exp2f(e[i]) * 0.5f; }
        if (MK_UBENCH & 8) {
#pragma unroll
            for (int i = 0; i < 16; ++i) asm volatile("v_add_f32 %0, %0, %1" : "+v"(e[i & 7]) : "v"(d)); }
        asm volatile("" : "+v"(acc)); __builtin_amdgcn_sched_barrier(0);
    }
#pragma unroll
    for (int i = 0; i < 8; ++i) asm volatile("" :: "v"(e[i]));
    asm volatile("" :: "v"(acc));
}
#endif
__global__ void __launch_bounds__(NTHREADS, 2) mega(Args a) {
    extern __shared__ __attribute__((aligned(16))) unsigned char lds[];
    const int tid = threadIdx.x, lane = tid & 63; const int wave = __builtin_amdgcn_readfirstlane(tid >> 6);
    const int G = gridDim.x, bx = blockIdx.x; const int vcu = (G % 8 == 0) ? (bx % 8) * (G / 8) + bx / 8 : bx;
    unsigned char* ws = a.ws; float* out = a.out;
    const float* x = a.in[0]; const float* ctx = a.in[2];
    float* mod = (float*)(ws + WS_MOD); const f32x4* tabA = (const f32x4*)(ws + WS_TABA); const f32x4* tabB = (const f32x4*)(ws + WS_TABB);
    bf16_t* H = (bf16_t*)(ws + WS_H); bf16_t* Qb = (bf16_t*)(ws + WS_Q); bf16_t* K0 = (bf16_t*)(ws + WS_K); bf16_t* V0 = (bf16_t*)(ws + WS_V0); bf16_t* K1 = (bf16_t*)(ws + WS_K);
    bf16_t* Gb = (bf16_t*)(ws + WS_G); bf16_t* V1 = (bf16_t*)(ws + WS_V1); bf16_t* KVA = (bf16_t*)(ws + WS_KVA); bf16_t* QA = (bf16_t*)(ws + WS_QA); bf16_t* Q1R = (bf16_t*)(ws + WS_Q1R);
    bf16_t* O0 = (bf16_t*)(ws + WS_V1); bf16_t* O1 = (bf16_t*)(ws + WS_H); bf16_t* KR = (bf16_t*)(ws + WS_KR); float* SSKV = (float*)(ws + WS_SSKV); float* SSQ = (float*)(ws + WS_SSQ); float* SSH = (float*)(ws + WS_SSH); float* X1c = (float*)(ws + WS_X1C); float* SSX = (float*)(ws + WS_SSX); float* BIAS1 = (float*)(ws + WS_BIAS1); float* NWM1 = (float*)(ws + WS_NWM1);
#ifdef MK_TS
#define MK_TS_SEAM (MK_TS >= 100 ? (MK_TS % 100) : MK_TS / 2)
#define MK_TS_WHAT (MK_TS % 2)
#endif
#ifdef MK_TS_SEAM
    const unsigned long long ts0 = __builtin_amdgcn_s_memrealtime(); unsigned long long ts1 = ts0, ts2 = ts0;
#endif
    const int lo = a.ph_lo, hi_ = a.ph_hi;
#ifndef ONLY_PHASE
#define ONLY_PHASE -1
#endif
#define IN(k) ((ONLY_PHASE < 0 || ONLY_PHASE == (k)) && lo <= (k) && (k) < hi_)
#ifndef MK_REP_MASK
#define MK_REP_MASK 0
#endif
#define REPS(k) (((MK_REP_MASK >> (k)) & 1) ? 2 : 1)
#ifdef MK_TS_SEAM
#define SEAM(k) do { if (IN(k) && IN((k) + 1)) { if ((k) == MK_TS_SEAM) { ts1 = __builtin_amdgcn_s_memrealtime(); if (tid == 0) { atomicMax((unsigned*)ws + 4000, (unsigned)(ts1 - ts0)); atomicMax((unsigned*)ws + 4001, ((unsigned)(ts1 - ts0) << 10) | (unsigned)bx); } } xcd_barrier(xbar); if ((k) == MK_TS_SEAM) ts2 = __builtin_amdgcn_s_memrealtime(); } } while (0)
#else
#define SEAM(k) do { if (IN(k) && IN((k) + 1)) { xcd_barrier(xbar); } } while (0)
#endif
    PG8_LAS unsigned char* ring = (PG8_LAS unsigned char*)lds;
    volatile LAS unsigned* xst = (volatile LAS unsigned*)((LAS unsigned char*)lds + RING_BYTES + 512);
    if (tid < 4) xst[tid] = 0u;
    __syncthreads();
    XcdBarrier xbar; xbar.bar = (unsigned*)ws; xbar.x = 0; xbar.st = xst;
    if (a.coop) xbar = xcd_barrier_post((unsigned*)ws, xst);
    if (a.coop == 0x7fffffff) cg::this_grid().sync();

    if (IN(0)) for (int rep_ = 0; rep_ < REPS(0); ++rep_) { phase0(a, ws, (LAS unsigned char*)lds, bx, G); } SEAM(0);
    if (IN(1)) for (int rep_ = 0; rep_ < REPS(1); ++rep_) { phase1_extras(a.in[13], mod + 3 * 3072, (const bf16_t*)(ws + WS_WIN1), NWM1, BIAS1, ctx, X1c, vcu * NWAVES + wave, G * NWAVES, lane);
        phase_prep(x, ctx, a.in[6], mod, H, vcu * NWAVES + wave, G * NWAVES, lane); } SEAM(1);
    if (IN(2)) { pg8::Gemm g{H, (const bf16_t*)(ws + WS_WIN0), MT, N_IN0, 1024}; pg8::ROrder S; S.init(0, MT / 256, N_IN0, G, bx, REPS(2));
        pg8::EpiIn0<ATT0_F8> E{a.in[8], a.in[9], tabA, K0, V0, Qb, Gb};
        pg8::gemm_phase<pg8::EpiIn0<ATT0_F8>, pg8::ROrder, true, true>(ring, g, S, E); } SEAM(2);
#ifdef MK_UNIT_PROBE
    unsigned long long upacc = 0, updummy = 0;
#define UPROBE_ARG3 , *((MK_UNIT_PROBE & 48) == 0 ? &upacc : &updummy)
#define UPROBE_ARGC , *((MK_UNIT_PROBE & 48) == 32 ? &upacc : &updummy)
#define UPROBE_ARG8 , *((MK_UNIT_PROBE & 48) == 16 ? &upacc : &updummy)
#else
#define UPROBE_ARG3
#define UPROBE_ARGC
#define UPROBE_ARG8
#endif
#ifdef MK_CLOCK_PROBE
    unsigned long long pc0 = 0, pr0 = 0, pc1 = 0, pr1 = 0;
    if (IN(3)) { pc0 = __builtin_readcyclecounter(); pr0 = __builtin_amdgcn_s_memrealtime(); }
#endif
    if (IN(3)) for (int rep_ = 0; rep_ < REPS(3); ++rep_) {
        const int xg = vcu >> 5, c = vcu & 31, b = xg >> 2, kvh = xg & 3; const size_t kbase = (size_t)b * TK * 256 + kvh * 64;
#ifdef MK_PROBE_NT
        const int NT3 = (rep_ + 1 < REPS(3)) ? MK_PROBE_NT : TK / 64;
#else
        const int NT3 = TK / 64;
#endif
#if ATT0_F8
        const unsigned char* K8 = (const unsigned char*)K0 + (size_t)b * TK * 128 + kvh * 32; const unsigned char* V8 = (const unsigned char*)V0 + kbase;
        const size_t qc0 = ((size_t)ML + b * CTXL) * DM + (kvh * 4 + c) * 64;
        af8::v6u qf, qrf;
        af8::attn_prefetch<0>(Qb + ((size_t)b * SEQ + c * 256) * DM + kvh * 4 * 64, DM, nullptr, nullptr, K8, 128, nullptr, V8, 256, (char*)lds, qf, qrf);
        for (int i = 0; i < 4; ++i) { const int h = kvh * 4 + i; const size_t q0 = ((size_t)b * SEQ + c * 256) * DM + h * 64; const bool nx = i < 3 || c < 4; const size_t q0n = i < 3 ? q0 + 64 : qc0;
            af8::attn_unit<0>(K8, 128, nullptr, V8, 256, NT3, O0 + q0, Gb + q0, DM, (char*)lds, qf, qrf, nx, Qb + q0n, DM, nullptr, nullptr, K8, nullptr, V8 UPROBE_ARG3); }
        if (c < 4) af8::attn_unit<0>(K8, 128, nullptr, V8, 256, CTXL / 64, O0 + qc0, Gb + qc0, DM, (char*)lds, qf, qrf, false, nullptr, DM, nullptr, nullptr, K8, nullptr, V8 UPROBE_ARGC);
#else
        for (int i = 0; i < 4; ++i) { const int h = kvh * 4 + i; const size_t q0 = ((size_t)b * SEQ + c * 256) * DM + h * 64;
            afast::attn_unit<0>(Qb + q0, DM, nullptr, nullptr, K0 + kbase, 256, nullptr, V0 + kbase, 256, TK / 64, O0 + q0, Gb + q0, DM, (char*)lds); }
        if (c < 4) { const int h = kvh * 4 + c; const size_t q0 = ((size_t)ML + b * CTXL) * DM + h * 64;
            afast::attn_unit<0>(Qb + q0, DM, nullptr, nullptr, K0 + kbase, 256, nullptr, V0 + kbase, 256, CTXL / 64, O0 + q0, Gb + q0, DM, (char*)lds); }
#endif
    } SEAM(3);
#ifdef MK_CLOCK_PROBE
    if (IN(3)) { pc1 = __builtin_readcyclecounter(); pr1 = __builtin_amdgcn_s_memrealtime(); }
#endif
    if (IN(4)) {
        { pg8::Gemm g{O0, (const bf16_t*)(ws + WS_WOUT0), ML, 1024, 1024, 0}; pg8::ROrder S; S.init(0, ML / 256, 1024, G, bx, REPS(4));
          pg8::EpiOutF E{x, out, mod + 2048, NWM1, H, SSX};
          pg8::gemm_phase<pg8::EpiOutF, pg8::ROrder, true, true>(ring, g, S, E); }
        { pg8::Gemm g{O0, (const bf16_t*)(ws + WS_WOUT0), MT, 1024, 1024, 128}; pg8::CtxSplitOrder S; S.init(bx, 8, 128);
          pg8::EpiOutSlab E{(float*)(ws + WS_SLAB), 128};
          pg8::gemm_phase<pg8::EpiOutSlab, pg8::CtxSplitOrder, true, true>(ring, g, S, E); }
    } SEAM(4);
    if (IN(5)) { phase_ctxprep(ctx, (const float*)(ws + WS_SLAB), mod + 2048 + 2 * 3072, X1c, NWM1, H, SSX, (float*)(ws + WS_RINV), vcu * NWAVES + wave, G * NWAVES, lane); } SEAM(5);
    if (IN(6)) { pg8::Gemm g{H, (const bf16_t*)(ws + WS_WIN1), MT, N_IN1P, 1024}; pg8::In1Order S; S.init(G, bx);
        pg8::EpiIn1<ATT1_F8> E{a.in[21], tabB, KVA, SSKV, QA, SSQ, KR, Gb, (const float*)(ws + WS_RINV), BIAS1};
        pg8::gemm_phase<pg8::EpiIn1<ATT1_F8>, pg8::In1Order, true, true>(ring, g, S, E); } SEAM(6);
    if (IN(7)) {
        { pg8::Gemm g{KVA, (const bf16_t*)(ws + WS_WKVB), MT, 2048, 256}; pg8::ROrder S; S.init(0, MT / 256, 2048, G, bx, REPS(7));
          pg8::EpiKvb<ATT1_F8> E{SSKV, a.in[20], K1, V1};
          pg8::gemm_phase<pg8::EpiKvb<ATT1_F8>, pg8::ROrder, true, true>(ring, g, S, E); }
        { pg8::Gemm g{QA, (const bf16_t*)(ws + WS_WQB), ML, 2048, 384}; pg8::ROrder S; S.init(0, ML / 256, 2048, G, bx, REPS(7));
          pg8::EpiQb E{SSQ, a.in[19], tabB, Qb, Q1R, SSH};
          pg8::gemm_phase<pg8::EpiQb, pg8::ROrder, true, true>(ring, g, S, E); }
    } SEAM(7);
    if (IN(8)) for (int rep_ = 0; rep_ < REPS(8); ++rep_) {
        const int xg = vcu >> 5, c = vcu & 31;
#if ATT1_F8
        af8::v6u qf, qrf;
        { const int s0 = xg, b = s0 >> 4, h = s0 & 15; const size_t row0 = (size_t)b * SEQ + c * 256;
          af8::attn_prefetch<1>(Qb + row0 * DM + h * 64, DM, Q1R + row0 * 512 + h * 32, SSH + (row0 * 16 + h) * 2, (const unsigned char*)K1 + (size_t)b * TK * 512 + h * 32, 512, (const unsigned char*)KR + (size_t)b * TK * 16,
                                (const unsigned char*)V1 + (size_t)b * TK * DM + h * 64, DM, (char*)lds, qf, qrf); }
#endif
        for (int i = 0; i < 4; ++i) { const int s = xg + 8 * i, b = s >> 4, h = s & 15; const size_t row0 = (size_t)b * SEQ + c * 256, q0 = row0 * DM + h * 64;
#if ATT1_F8
            const int sn = xg + 8 * (i < 3 ? i + 1 : i), bn = sn >> 4, hn = sn & 15; const size_t row0n = (size_t)bn * SEQ + c * 256;
            af8::attn_unit<1>((const unsigned char*)K1 + (size_t)b * TK * 512 + h * 32, 512, (const unsigned char*)KR + (size_t)b * TK * 16, (const unsigned char*)V1 + (size_t)b * TK * DM + h * 64, DM, TK / 64, O1 + q0, Gb + q0, DM, (char*)lds, qf, qrf,
                              i < 3, Qb + row0n * DM + hn * 64, DM, Q1R + row0n * 512 + hn * 32, SSH + (row0n * 16 + hn) * 2, (const unsigned char*)K1 + (size_t)bn * TK * 512 + hn * 32, (const unsigned char*)KR + (size_t)bn * TK * 16,
                              (const unsigned char*)V1 + (size_t)bn * TK * DM + hn * 64 UPROBE_ARG8); }
#else
            afast::attn_unit<1>(Qb + q0, DM, Q1R + row0 * 512 + h * 32, SSH + (row0 * 16 + h) * 2, K1 + (size_t)b * TK * DM + h * 64, DM, KR + (size_t)b * TK * 32,
                                V1 + (size_t)b * TK * DM + h * 64, DM, TK / 64, O1 + q0, Gb + q0, DM, (char*)lds); }
#endif
    } SEAM(8);
    if (IN(9)) { pg8::Gemm g{O1, (const bf16_t*)(ws + WS_WOUT1), ML, 1024, 1024}; pg8::ROrder S; S.init(0, ML / 256, 1024, G, bx);
        pg8::EpiOut E{out, nullptr, out, nullptr, mod + 3 * 3072 + 2048};
        pg8::gemm_phase<pg8::EpiOut, pg8::ROrder, true, true>(ring, g, S, E); }
#ifdef MK_TS_SEAM
    if (bx == 0 && wave == 0) { const unsigned long long tend_ = __builtin_amdgcn_s_memrealtime(); const unsigned long long w = MK_TS == 99 ? (tend_ - ts0) : MK_TS >= 100 ? (MK_TS >= 200 ? (unsigned long long)(((unsigned*)ws)[4001] & 1023u) * 100ull : (unsigned long long)((unsigned*)ws)[4000]) : (MK_TS_WHAT ? (ts2 - ts1) * 10ull : (ts1 - ts0)); const unsigned long long t0 = __builtin_amdgcn_s_memrealtime(); while (__builtin_amdgcn_s_memrealtime() - t0 < w) __builtin_amdgcn_s_sleep(8); }
#endif
#ifdef MK_UBENCH
    ubench(wave);
#endif
#ifdef MK_UNIT_PROBE
    if (bx == 0 && wave == 0) { const unsigned long long t0 = __builtin_amdgcn_s_memrealtime(); const unsigned long long w = upacc * 10ull; (void)updummy; while (__builtin_amdgcn_s_memrealtime() - t0 < w) __builtin_amdgcn_s_sleep(8); }
#endif
#ifdef MK_CLOCK_PROBE
    if (bx == 0 && wave == 0) { const unsigned long long dc = pc1 - pc0, dr = pr1 - pr0;
        const unsigned long long mhz = dr ? (dc * 100ull) / dr : 0ull;
        const unsigned long long t0 = __builtin_amdgcn_s_memrealtime(); const unsigned long long wait_ticks = mhz * 10ull;
        while (__builtin_amdgcn_s_memrealtime() - t0 < wait_ticks) __builtin_amdgcn_s_sleep(8); }
#endif
#undef IN
#undef SEAM
}

constexpr int NPHASE = 10;
#ifndef MK_ONE_LAUNCH
#define MK_ONE_LAUNCH 1
#endif
extern "C" void kernel_launch(void* const* d_in, const int* in_sizes, int n_in, void* d_out, int out_size, void* d_ws, size_t ws_size, hipStream_t stream) {
    static int grid = 0;
    if (grid == 0) {
        if (n_in != 23 || out_size != ML * DM || ws_size < WS_END) { fprintf(stderr, "kernel_launch: unexpected shapes n_in %d out %d ws %zu\n", n_in, out_size, ws_size); grid = -1; return; }
        int dev = 0, cus = 0, per_cu = 0;
        if (hipGetDevice(&dev) != hipSuccess || hipDeviceGetAttribute(&cus, hipDeviceAttributeMultiprocessorCount, dev) != hipSuccess) { grid = -1; return; }
        if (hipFuncSetAttribute((const void*)mega, hipFuncAttributeMaxDynamicSharedMemorySize, LDS_BYTES) != hipSuccess) { fprintf(stderr, "kernel_launch: hipFuncSetAttribute failed\n"); grid = -1; return; }
        if (hipOccupancyMaxActiveBlocksPerMultiprocessor(&per_cu, (const void*)mega, NTHREADS, LDS_BYTES) != hipSuccess || per_cu < 1) { fprintf(stderr, "kernel_launch: occupancy query says %d\n", per_cu); grid = -1; return; }
        grid = cus;
        if (grid != 256) fprintf(stderr, "kernel_launch: %d CUs (built for 256)\n", grid);
    }
    if (grid < 0) return;
    if (hipMemsetAsync(d_ws, 0, 16384, stream) != hipSuccess) { fprintf(stderr, "kernel_launch: memset failed\n"); return; }
    Args a{};
    for (int i = 0; i < 23; ++i) a.in[i] = (const float*)d_in[i];
    a.out = (float*)d_out; a.ws = (unsigned char*)d_ws;
#if MK_ONE_LAUNCH
    a.ph_lo = 0; a.ph_hi = NPHASE; a.coop = 1;
    void* args[] = {&a};
#ifdef MK_PLAIN_LAUNCH
    (void)args; hipLaunchKernelGGL(mega, dim3(grid), dim3(NTHREADS), LDS_BYTES, stream, a);
#else
    const hipError_t e = hipLaunchCooperativeKernel((const void*)mega, dim3(grid), dim3(NTHREADS), args, LDS_BYTES, stream);
    if (e != hipSuccess) fprintf(stderr, "kernel_launch: cooperative launch failed: %s (grid %d)\n", hipGetErrorString(e), grid);
#endif
#else
    for (int p = 0; p < NPHASE; ++p) { a.ph_lo = p; a.ph_hi = p + 1; a.coop = 0; hipLaunchKernelGGL(mega, dim3(grid), dim3(NTHREADS), LDS_BYTES, stream, a); }
    const hipError_t le = hipPeekAtLastError();
    if (le != hipSuccess) fprintf(stderr, "kernel_launch: launch failed: %s\n", hipGetErrorName(le));
#endif
}
```

```cpp
#include <hip/hip_runtime.h>
#include <hip/hip_bf16.h>
#include <cstdio>
#include <cstdint>

#define DEVI __device__ __forceinline__
#define LAS __attribute__((address_space(3)))
#define GAS __attribute__((address_space(1)))

constexpr int NB = 2, SEQ = 8192, DM = 1024, CTXL = 256, TK = SEQ + CTXL;
constexpr int ML = NB * SEQ, MC = NB * CTXL, MT = ML + MC;
constexpr int GRIDW = 64;
constexpr float EPS = 1e-6f;
constexpr float LOG2E = 1.4426950408889634f;
constexpr int N_IN0 = 2560, N_IN1 = 1696, N_IN1P = 1792;
constexpr float C2_GQA = 0.125f * LOG2E;
constexpr float C2_MLA = 0.10206207261596575f * LOG2E;

typedef unsigned short bf16_t;
typedef short bf16x8 __attribute__((ext_vector_type(8)));
typedef short s16x4 __attribute__((ext_vector_type(4)));
typedef float f32x4 __attribute__((ext_vector_type(4)));
typedef float f32x2 __attribute__((ext_vector_type(2)));
typedef float f32x16 __attribute__((ext_vector_type(16)));
typedef unsigned u32x4 __attribute__((ext_vector_type(4)));
typedef unsigned u32x2 __attribute__((ext_vector_type(2)));

DEVI float bf2f(bf16_t v) { return __uint_as_float((unsigned)v << 16); }
DEVI unsigned f2bf(float f) { unsigned u = __float_as_uint(f); return (u + 0x7fffu + ((u >> 16) & 1u)) >> 16; }
DEVI unsigned pk2(float lo, float hi) { return f2bf(lo) | (f2bf(hi) << 16); }
DEVI float wave_sum(float v) {
#pragma unroll
    for (int o = 1; o < 64; o <<= 1) v += __shfl_xor(v, o);
    return v;
}
DEVI float silu_f(float v) { return v / (1.f + __expf(-v)); }
namespace pg8 {
#define PG8_LAS __attribute__((address_space(3)))
typedef unsigned short bf16_t;
typedef short bf16x8 __attribute__((ext_vector_type(8)));
typedef float f32x4 __attribute__((ext_vector_type(4)));
typedef unsigned u32x4 __attribute__((ext_vector_type(4)));
constexpr int BM = 256, BK = 64, HALF = 128, HTB = HALF * BK * 2  , STAGE_BYTES = 8 * HTB, NXCD = 8, WGM = 8;

__host__ __device__ __forceinline__ int lds_byte(int r, int c) { const int st = (r >> 4) * 2 + (c >> 5), rr = r & 15, cc = c & 31, ob = rr * 64 + cc * 2; return st * 1024 + (ob ^ (((ob >> 9) & 1) << 5)); }
__host__ __device__ __forceinline__ void stage_rc(int b, int& R, int& C) { const int st = b / 1024, sb = b % 1024, swz = sb ^ (((sb >> 9) & 1) << 5); R = (st >> 1) * 16 + swz / 64; C = (st & 1) * 32 + (swz % 64) / 2; }
__host__ __device__ __forceinline__ int perm32(int rho) { const int n = rho >> 4, i = rho & 15; return 8 * (i >> 2) + 4 * n + (i & 3); }

struct Unit { int pm, pn, ko; };
struct Gemm { const bf16_t* A; const bf16_t* Bt; int M, N, K, Kloop; };

struct StaticOrder {
    int nM, nN, nwg, G, c;
    __host__ __device__ void init(int M, int N, int G_, int c_) { nM = M / BM; nN = N / BM; nwg = nM * nN; G = G_; c = c_; }
    __host__ __device__ bool next(int i, Unit& u) const {
        const long L = (long)i * G + c; if (L >= nwg) return false;
        int wgid = (int)L; { const int q = nwg / NXCD, r = nwg % NXCD, xcd = wgid % NXCD, off = wgid / NXCD; wgid = (xcd < r ? xcd * (q + 1) : r * (q + 1) + (xcd - r) * q) + off; }
        const int nig = WGM * nN, gid = wgid / nig, fm = gid * WGM, gsz = (nM - fm) < WGM ? (nM - fm) : WGM;
        u.pm = fm + ((wgid % nig) % gsz); u.pn = (wgid % nig) / gsz; u.ko = 0; return true;
    }
    __device__ __forceinline__ void a_ready(const Unit&) const {}
    __device__ __forceinline__ void done(const Unit&) const {}
};


struct ROrder {
    int pm0, nM, nN, nwg, G, c, rep;
    __host__ __device__ void init(int pm0_, int npm, int N, int G_, int c_, int rep_ = 1) { pm0 = pm0_; nM = npm; nN = N / BM; nwg = nM * nN; G = G_; c = c_; rep = rep_; }
    __host__ __device__ bool next(int i, Unit& u) const {
        const long L = (long)i * G + c; if (L >= (long)nwg * rep) return false;
        int wgid = (int)(L % nwg); { const int q = nwg / NXCD, r = nwg % NXCD, xcd = wgid % NXCD, off = wgid / NXCD; wgid = (xcd < r ? xcd * (q + 1) : r * (q + 1) + (xcd - r) * q) + off; }
        const int nig = WGM * nN, gid = wgid / nig, fm = gid * WGM, gsz = (nM - fm) < WGM ? (nM - fm) : WGM;
        u.pm = pm0 + fm + ((wgid % nig) % gsz); u.pn = (wgid % nig) / gsz; u.ko = 0; return true;
    }
    __device__ __forceinline__ void a_ready(const Unit&) const {}
    __device__ __forceinline__ void done(const Unit&) const {}
};

struct EpiF32 {
    static constexpr bool PERM = true, AFTER_DRAIN = false;
    float* O; int ldc; int pmbase;
    __device__ __forceinline__ void operator()(const f32x4 (&acc)[2][2][4][2], const Unit& u, int wr, int wc, int fr, int fq) const {
        const int row0 = (u.pm - pmbase) * BM + wr * 64 + fr, col0 = u.pn * BM + wc * 32 + 8 * fq;
#pragma unroll
        for (int ai = 0; ai < 2; ++ai)
#pragma unroll
            for (int m = 0; m < 4; ++m) { float* rowp = O + (size_t)(row0 + ai * HALF + m * 16) * ldc + col0;
#pragma unroll
                for (int bj = 0; bj < 2; ++bj) { *(f32x4*)(rowp + bj * HALF) = acc[ai][bj][m][0]; *(f32x4*)(rowp + bj * HALF + 4) = acc[ai][bj][m][1]; } }
    }
};

DEVI unsigned cvt_pk_bf16(float lo, float hi) { unsigned r; asm volatile("v_cvt_pk_bf16_f32 %0, %1, %2" : "=v"(r) : "v"(lo), "v"(hi)); return r; }
DEVI u32x4 pack8(const f32x4 a, const f32x4 b) { u32x4 w; w.x = cvt_pk_bf16(a[0], a[1]); w.y = cvt_pk_bf16(a[2], a[3]); w.z = cvt_pk_bf16(b[0], b[1]); w.w = cvt_pk_bf16(b[2], b[3]); return w; }
DEVI u32x2 pack8_fp8(const f32x4 a, const f32x4 b) { int w0 = 0, w1 = 0; w0 = __builtin_amdgcn_cvt_pk_fp8_f32(a[0], a[1], w0, false); w0 = __builtin_amdgcn_cvt_pk_fp8_f32(a[2], a[3], w0, true);
    w1 = __builtin_amdgcn_cvt_pk_fp8_f32(b[0], b[1], w1, false); w1 = __builtin_amdgcn_cvt_pk_fp8_f32(b[2], b[3], w1, true); return (u32x2){(unsigned)w0, (unsigned)w1}; }
DEVI unsigned pack8_fp4(const f32x4 a, const f32x4 b) { unsigned w; asm volatile("" : "=v"(w)); w = __builtin_amdgcn_cvt_scalef32_pk_fp4_f32(w, a[0], a[1], 1.0f, 0); w = __builtin_amdgcn_cvt_scalef32_pk_fp4_f32(w, a[2], a[3], 1.0f, 1);
    w = __builtin_amdgcn_cvt_scalef32_pk_fp4_f32(w, b[0], b[1], 1.0f, 2); w = __builtin_amdgcn_cvt_scalef32_pk_fp4_f32(w, b[2], b[3], 1.0f, 3); return w; }
DEVI float quad_sum(float s) { s += __shfl_xor(s, 16); s += __shfl_xor(s, 32); return s; }
DEVI float sq4(const f32x4 v) { return (v[0] * v[0] + v[1] * v[1]) + (v[2] * v[2] + v[3] * v[3]); }
DEVI f32x4 silu4(const f32x4 v) { f32x4 o; o[0] = silu_f(v[0]); o[1] = silu_f(v[1]); o[2] = silu_f(v[2]); o[3] = silu_f(v[3]); return o; }
DEVI int key_slot(int R) { return R < ML ? (R >> 13) * TK + CTXL + (R & (SEQ - 1)) : ((R - ML) >> 8) * TK + ((R - ML) & 255); }
DEVI void rot4(f32x4& x1, f32x4& x2, const f32x4 cs01, const f32x4 cs23) {
    const f32x4 c = {cs01[0], cs01[2], cs23[0], cs23[2]}, s = {cs01[1], cs01[3], cs23[1], cs23[3]};
    const f32x4 a = x1 * c - x2 * s, b = x2 * c + x1 * s; x1 = a; x2 = b;
}

DEVI int drope32(int i) { const int fq = i >> 3, n = (i >> 2) & 1, j = i & 3; return 16 * (fq >> 1) + 8 * n + 4 * (fq & 1) + j; }
DEVI int wmap(int mode, int p) {
    const int pn = p >> 8, q = p & 255, bj = q >> 7, wc = (q >> 5) & 3, i = q & 31;
    switch (mode) {
    case 1: {
        if (pn == 0 || (pn >= 2 && pn <= 5)) { const int fq = i >> 3, n = (i >> 2) & 1, j = i & 3; return 256 * pn + 64 * wc + 32 * bj + 16 * n + 4 * fq + j; }
        return p; }
    case 2: {
        if (pn == 0) return q;
        if (pn == 1) return 288 + q;
        if (pn == 2) { if (wc < 2) return 288 + 256 + 64 * wc + 32 * bj + i; if (wc == 2 && bj == 0) return 256 + drope32(i); return -1; }
        return 672 + 256 * (pn - 3) + q; }
    case 3: { const int head = 2 * pn + (wc >> 1), type = wc & 1; return 128 * head + 64 * type + 32 * bj + i; }
    case 4: { const int head = 2 * pn + (wc >> 1), type = wc & 1; if (type == 0) return 96 * head + 32 * bj + i; return bj == 0 ? 96 * head + 64 + drope32(i) : -1; }
    default: return p;
    }
}

template <bool F8> struct EpiIn0 {
    static constexpr bool PERM = true, AFTER_DRAIN = false;
    const float* qn; const float* kn; const f32x4* tabA; bf16_t* K0; bf16_t* V0; bf16_t* Q0; bf16_t* G0;
    __device__ __forceinline__ void operator()(const f32x4 (&acc)[2][2][4][2], const Unit& u, int wr, int wc, int fr_, int fq_) const {
        int fr = fr_, fq = fq_; asm volatile("" : "+v"(fr), "+v"(fq));
        const int pn = u.pn; const bool lat = u.pm < ML / BM;
        if (pn == 0 || (pn >= 2 && pn <= 5)) {
            const float* wsrc = pn == 0 ? kn : qn; const float outs = pn == 0 ? (F8 ? 2.f : 1.f) : (F8 ? C2_GQA * 8.f : C2_GQA);
            f32x4 wv[2][2];
#pragma unroll
            for (int bj = 0; bj < 2; ++bj)
#pragma unroll
                for (int n = 0; n < 2; ++n) wv[bj][n] = *(const f32x4*)(wsrc + 32 * bj + 16 * n + 4 * fq) * outs;
#pragma unroll
            for (int ai = 0; ai < 2; ++ai)
#pragma unroll
                for (int m = 0; m < 4; ++m) {
                    const int R = u.pm * BM + ai * HALF + wr * 64 + m * 16 + fr;
                    f32x4 x[2][2]; float ss = 0.f;
#pragma unroll
                    for (int bj = 0; bj < 2; ++bj)
#pragma unroll
                        for (int n = 0; n < 2; ++n) { x[bj][n] = acc[ai][bj][m][n]; ss += sq4(x[bj][n]); }
                    const float rinv = rsqrtf(quad_sum(ss) * (1.f / 64.f) + EPS);
#pragma unroll
                    for (int bj = 0; bj < 2; ++bj)
#pragma unroll
                        for (int n = 0; n < 2; ++n) x[bj][n] = x[bj][n] * rinv * wv[bj][n];
                    if (lat) { const int t = R & (SEQ - 1), trow = t >> 6, tcol = t & 63;
                        const f32x4* tr = tabA + (trow * 16 + 4 * fq) / 2; const f32x4* tc = tabA + (tcol * 16 + 4 * fq) / 2;
                        rot4(x[0][0], x[0][1], tr[0], tr[1]); rot4(x[1][0], x[1][1], tc[0], tc[1]); }
                    if (F8 && pn == 0) { unsigned char* dst = (unsigned char*)K0 + (size_t)key_slot(R) * 128 + wc * 32 + 4 * fq;
                        *(unsigned*)dst = pack8_fp4(x[0][0], x[0][1]); *(unsigned*)(dst + 16) = pack8_fp4(x[1][0], x[1][1]); }
                    else if (pn == 0) { bf16_t* dst = K0 + (size_t)key_slot(R) * 256 + wc * 64 + 8 * fq;
                        *(u32x4*)dst = pack8(x[0][0], x[0][1]); *(u32x4*)(dst + 32) = pack8(x[1][0], x[1][1]); }
                    else { bf16_t* dst = Q0 + (size_t)R * DM + ((pn - 2) * 4 + wc) * 64 + 8 * fq;
                        *(u32x4*)dst = pack8(x[0][0], x[0][1]); *(u32x4*)(dst + 32) = pack8(x[1][0], x[1][1]); }
                }
        } else if (pn == 1) {
#pragma unroll
            for (int ai = 0; ai < 2; ++ai)
#pragma unroll
                for (int m = 0; m < 4; ++m) { const int R = u.pm * BM + ai * HALF + wr * 64 + m * 16 + fr;
                    if (F8) { unsigned char* dst = (unsigned char*)V0 + (size_t)key_slot(R) * 256 + wc * 32 + 8 * fq;
#pragma unroll
                        for (int bj = 0; bj < 2; ++bj) *(u32x2*)(dst + bj * HALF) = pack8_fp8(acc[ai][bj][m][0], acc[ai][bj][m][1]); }
                    else { bf16_t* dst = V0 + (size_t)key_slot(R) * 256 + wc * 32 + 8 * fq;
#pragma unroll
                        for (int bj = 0; bj < 2; ++bj) *(u32x4*)(dst + bj * HALF) = pack8(acc[ai][bj][m][0], acc[ai][bj][m][1]); } }
        } else {
#pragma unroll
            for (int ai = 0; ai < 2; ++ai)
#pragma unroll
                for (int m = 0; m < 4; ++m) { const int R = u.pm * BM + ai * HALF + wr * 64 + m * 16 + fr; bf16_t* dst = G0 + (size_t)R * DM + (pn - 6) * BM + wc * 32 + 8 * fq;
#pragma unroll
                    for (int bj = 0; bj < 2; ++bj) *(u32x4*)(dst + bj * HALF) = pack8(silu4(acc[ai][bj][m][0]), silu4(acc[ai][bj][m][1])); }
        }
    }
};

struct EpiOut {
    static constexpr bool PERM = true, AFTER_DRAIN = false;
    const float* baseL; const float* baseC; float* dstL; float* dstC; const float* gate;
    __device__ __forceinline__ void operator()(const f32x4 (&acc)[2][2][4][2], const Unit& u, int wr, int wc, int fr_, int fq_) const {
        int fr = fr_, fq = fq_; asm volatile("" : "+v"(fr), "+v"(fq));
        const int col0 = u.pn * BM + wc * 32 + 8 * fq;
#pragma unroll
        for (int ai = 0; ai < 2; ++ai)
#pragma unroll
            for (int m = 0; m < 4; ++m) { const int R = u.pm * BM + ai * HALF + wr * 64 + m * 16 + fr; const int r = R < SEQ ? 0 : (R < ML ? 1 : 2);
                const float* b = R < ML ? baseL + (size_t)R * DM : baseC + (size_t)(R - ML) * DM; float* d = R < ML ? dstL + (size_t)R * DM : dstC + (size_t)(R - ML) * DM;
                const float* g = gate + (size_t)r * 3072;
#pragma unroll
                for (int bj = 0; bj < 2; ++bj)
#pragma unroll
                    for (int n = 0; n < 2; ++n) { const int c = col0 + bj * HALF + 4 * n; *(f32x4*)(d + c) = *(const f32x4*)(b + c) + *(const f32x4*)(g + c) * acc[ai][bj][m][n]; } }
    }
};

struct EpiOutF {
    static constexpr bool PERM = true, AFTER_DRAIN = false;
    const float* base; float* dst; const float* gate; const float* nwm; bf16_t* Hn; float* SSX;
    __device__ __forceinline__ void operator()(const f32x4 (&acc)[2][2][4][2], const Unit& u, int wr, int wc, int fr_, int fq_) const {
        int fr = fr_, fq = fq_; asm volatile("" : "+v"(fr), "+v"(fq));
        const int col0 = u.pn * BM + wc * 32 + 8 * fq;
#pragma unroll
        for (int ai = 0; ai < 2; ++ai)
#pragma unroll
            for (int m = 0; m < 4; ++m) { const int R = u.pm * BM + ai * HALF + wr * 64 + m * 16 + fr; const int r = R < SEQ ? 0 : 1;
                asm volatile("" ::: "memory");
                const float* b = base + (size_t)R * DM; float* d = dst + (size_t)R * DM; const float* g = gate + (size_t)r * 3072; const float* nw = nwm + (size_t)r * 1024; float ss = 0.f;
#pragma unroll
                for (int bj = 0; bj < 2; ++bj) { const int c = col0 + bj * HALF;
                    const f32x4 x0 = *(const f32x4*)(b + c) + *(const f32x4*)(g + c) * acc[ai][bj][m][0], x1 = *(const f32x4*)(b + c + 4) + *(const f32x4*)(g + c + 4) * acc[ai][bj][m][1];
                    *(f32x4*)(d + c) = x0; *(f32x4*)(d + c + 4) = x1; ss += sq4(x0) + sq4(x1);
                    *(u32x4*)(Hn + (size_t)R * DM + c) = pack8(x0 * *(const f32x4*)(nw + c), x1 * *(const f32x4*)(nw + c + 4)); }
                ss = quad_sum(ss); if (fq == 0) SSX[(size_t)R * 16 + u.pn * 4 + wc] = ss; }
    }
};
struct EpiOutSlab {
    static constexpr bool PERM = true, AFTER_DRAIN = false;
    float* slab; int klen;
    __device__ __forceinline__ void operator()(const f32x4 (&acc)[2][2][4][2], const Unit& u, int wr, int wc, int fr_, int fq_) const {
        int fr = fr_, fq = fq_; asm volatile("" : "+v"(fr), "+v"(fq));
        const int col0 = u.pn * BM + wc * 32 + 8 * fq; float* sb = slab + (size_t)(u.ko / klen) * MC * DM;
#pragma unroll
        for (int ai = 0; ai < 2; ++ai)
#pragma unroll
            for (int m = 0; m < 4; ++m) { const int R = u.pm * BM + ai * HALF + wr * 64 + m * 16 + fr; float* d = sb + (size_t)(R - ML) * DM + col0;
#pragma unroll
                for (int bj = 0; bj < 2; ++bj) { *(f32x4*)(d + bj * HALF) = acc[ai][bj][m][0]; *(f32x4*)(d + bj * HALF + 4) = acc[ai][bj][m][1]; } }
    }
};
struct CtxSplitOrder {
    int c, KS, klen;
    __host__ __device__ void init(int c_, int KS_, int klen_) { c = c_; KS = KS_; klen = klen_; }
    __host__ __device__ bool next(int i, Unit& u) const { if (i > 0 || c >= 8 * KS) return false; const int t = c / KS; u.pm = ML / BM + (t >> 2); u.pn = t & 3; u.ko = (c % KS) * klen; return true; }
    __device__ __forceinline__ void a_ready(const Unit&) const {}
    __device__ __forceinline__ void done(const Unit&) const {}
};

template <bool F8> struct EpiIn1 {
    static constexpr bool PERM = true, AFTER_DRAIN = false;
    const float* krn; const f32x4* tabB; bf16_t* KVA; float* SSKV; bf16_t* QA; float* SSQ; bf16_t* KR; bf16_t* G1; const float* SSX; const float* bias;
    __device__ __forceinline__ void xrow(const f32x4 (&acc)[2][2][4][2], int ai, int m, int R, int pcol0, f32x4 (&x)[2][2]) const {
        const float rinv = SSX[R];
        const float* bp = bias + (size_t)(R < SEQ ? 0 : (R < ML ? 1 : 2)) * N_IN1P + pcol0;
#pragma unroll
        for (int bj = 0; bj < 2; ++bj)
#pragma unroll
            for (int n = 0; n < 2; ++n) x[bj][n] = acc[ai][bj][m][n] * rinv + *(const f32x4*)(bp + bj * HALF + 4 * n);
    }
    __device__ __forceinline__ void operator()(const f32x4 (&acc)[2][2][4][2], const Unit& u, int wr, int wc, int fr_, int fq_) const {
        int fr = fr_, fq = fq_; asm volatile("" : "+v"(fr), "+v"(fq));
        const int pn = u.pn; const bool lat = u.pm < ML / BM; const int pcol0 = pn * BM + wc * 32 + 8 * fq;
        if (pn >= 3) {
#pragma unroll
            for (int ai = 0; ai < 2; ++ai)
#pragma unroll
                for (int m = 0; m < 4; ++m) { const int R = u.pm * BM + ai * HALF + wr * 64 + m * 16 + fr; bf16_t* dst = G1 + (size_t)R * DM + (pn - 3) * BM + wc * 32 + 8 * fq;
                    asm volatile("" ::: "memory"); f32x4 x[2][2]; xrow(acc, ai, m, R, pcol0, x);
#pragma unroll
                    for (int bj = 0; bj < 2; ++bj) *(u32x4*)(dst + bj * HALF) = pack8(silu4(x[bj][0]), silu4(x[bj][1])); }
        } else if (pn == 2 && wc == 2) {
            f32x4 wv[2];
#pragma unroll
            for (int n = 0; n < 2; ++n) wv[n] = *(const f32x4*)(krn + 16 * (fq >> 1) + 8 * n + 4 * (fq & 1));
#pragma unroll
            for (int ai = 0; ai < 2; ++ai)
#pragma unroll
                for (int m = 0; m < 4; ++m) { const int R = u.pm * BM + ai * HALF + wr * 64 + m * 16 + fr;
                    asm volatile("" ::: "memory"); f32x4 xx[2][2]; xrow(acc, ai, m, R, pcol0, xx); f32x4 x0 = xx[0][0], x1 = xx[0][1];
                    const float rinv = rsqrtf(quad_sum(sq4(x0) + sq4(x1)) * (1.f / 32.f) + EPS);
                    x0 = x0 * rinv * wv[0]; x1 = x1 * rinv * wv[1];
                    if (lat) { const int t = R & (SEQ - 1); const int pos = (fq >> 1) ? (t & 63) : (t >> 6); const f32x4* tp = tabB + (pos * 8 + 4 * (fq & 1)) / 2; rot4(x0, x1, tp[0], tp[1]); }
                    if (F8) *(unsigned*)((unsigned char*)KR + (size_t)key_slot(R) * 16 + 4 * fq) = pack8_fp4(x0 * 2.f, x1 * 2.f); else *(u32x4*)(KR + (size_t)key_slot(R) * 32 + 8 * fq) = pack8(x0, x1); }
        } else if (pn == 2 && wc == 3) {
        } else if (pn == 0 || lat) {
            bf16_t* base; float* ssb; int ld, cbase, nss, iss;
            if (pn == 0) { base = KVA; ld = 256; cbase = wc * 32; ssb = SSKV; nss = 4; iss = wc; }
            else if (pn == 1) { base = QA; ld = 384; cbase = wc * 32; ssb = SSQ; nss = 6; iss = wc; }
            else { base = QA; ld = 384; cbase = 256 + wc * 64; ssb = SSQ; nss = 6; iss = 4 + wc; }
            const int bjs = pn == 2 ? 32 : HALF;
#pragma unroll
            for (int ai = 0; ai < 2; ++ai)
#pragma unroll
                for (int m = 0; m < 4; ++m) { const int R = u.pm * BM + ai * HALF + wr * 64 + m * 16 + fr; bf16_t* dst = base + (size_t)R * ld + cbase + 8 * fq; float ss = 0.f;
                    asm volatile("" ::: "memory"); f32x4 x[2][2]; xrow(acc, ai, m, R, pcol0, x);
#pragma unroll
                    for (int bj = 0; bj < 2; ++bj) { ss += sq4(x[bj][0]) + sq4(x[bj][1]); *(u32x4*)(dst + bj * bjs) = pack8(x[bj][0], x[bj][1]); }
                    ss = quad_sum(ss); if (fq == 0) ssb[(size_t)R * nss + iss] = ss; }
        }
    }
};

template <bool F8> struct EpiKvb {
    static constexpr bool PERM = true, AFTER_DRAIN = false;
    const float* SSKV; const float* knn; bf16_t* K1; bf16_t* V1;
    __device__ __forceinline__ void operator()(const f32x4 (&acc)[2][2][4][2], const Unit& u, int wr, int wc, int fr_, int fq_) const {
        int fr = fr_, fq = fq_; asm volatile("" : "+v"(fr), "+v"(fq));
        const int head = 2 * u.pn + (wc >> 1), type = wc & 1; const int R0 = u.pm * BM + wr * 64 + fr;
        float rkv[2][4];
        { f32x4 s4[2][4];
#pragma unroll
          for (int ai = 0; ai < 2; ++ai)
#pragma unroll
            for (int m = 0; m < 4; ++m) s4[ai][m] = *(const f32x4*)(SSKV + (size_t)(R0 + ai * HALF + m * 16) * 4);
#pragma unroll
          for (int ai = 0; ai < 2; ++ai)
#pragma unroll
            for (int m = 0; m < 4; ++m) rkv[ai][m] = rsqrtf(((s4[ai][m][0] + s4[ai][m][1]) + (s4[ai][m][2] + s4[ai][m][3])) * (1.f / 256.f) + EPS); }
        f32x4 kw[2][2];
#pragma unroll
        for (int bj = 0; bj < 2; ++bj)
#pragma unroll
            for (int n = 0; n < 2; ++n) kw[bj][n] = *(const f32x4*)(knn + 32 * bj + 8 * fq + 4 * n);
#pragma unroll
        for (int ai = 0; ai < 2; ++ai)
#pragma unroll
            for (int m = 0; m < 4; ++m) { const int R = R0 + ai * HALF + m * 16;
                asm volatile("" ::: "memory");
                f32x4 x[2][2]; float ss = 0.f;
#pragma unroll
                for (int bj = 0; bj < 2; ++bj)
#pragma unroll
                    for (int n = 0; n < 2; ++n) { x[bj][n] = acc[ai][bj][m][n] * rkv[ai][m]; ss += sq4(x[bj][n]); }
                if (type == 0) { const float rinv = rsqrtf(quad_sum(ss) * (1.f / 64.f) + EPS);
#pragma unroll
                    for (int bj = 0; bj < 2; ++bj)
#pragma unroll
                        for (int n = 0; n < 2; ++n) x[bj][n] = x[bj][n] * rinv * kw[bj][n]; }
                const size_t eo = (size_t)key_slot(R) * DM + head * 64 + 8 * fq;
                if (F8) { if (type == 0) { unsigned char* dst = (unsigned char*)K1 + (size_t)key_slot(R) * 512 + head * 32 + 4 * fq; *(unsigned*)dst = pack8_fp4(x[0][0] * 2.f, x[0][1] * 2.f); *(unsigned*)(dst + 16) = pack8_fp4(x[1][0] * 2.f, x[1][1] * 2.f); }
                          else { unsigned char* dst = (unsigned char*)V1 + eo; *(u32x2*)dst = pack8_fp8(x[0][0], x[0][1]); *(u32x2*)(dst + 32) = pack8_fp8(x[1][0], x[1][1]); } }
                else { bf16_t* dst = (type == 0 ? K1 : V1) + eo; *(u32x4*)dst = pack8(x[0][0], x[0][1]); *(u32x4*)(dst + 32) = pack8(x[1][0], x[1][1]); } }
    }
};

struct EpiQb {
    static constexpr bool PERM = true, AFTER_DRAIN = false;
    const float* SSQ; const float* qnw; const f32x4* tabB; bf16_t* Q1N; bf16_t* Q1R; float* SSH;
    __device__ __forceinline__ void operator()(const f32x4 (&acc)[2][2][4][2], const Unit& u, int wr, int wc, int fr_, int fq_) const {
        int fr = fr_, fq = fq_; asm volatile("" : "+v"(fr), "+v"(fq));
        const int head = 2 * u.pn + (wc >> 1); const int R0 = u.pm * BM + wr * 64 + fr;
        float rqa[2][4];
        { f32x2 sv[2][4][3];
#pragma unroll
          for (int ai = 0; ai < 2; ++ai)
#pragma unroll
            for (int m = 0; m < 4; ++m) { const float* sp = SSQ + (size_t)(R0 + ai * HALF + m * 16) * 6; sv[ai][m][0] = *(const f32x2*)sp; sv[ai][m][1] = *(const f32x2*)(sp + 2); sv[ai][m][2] = *(const f32x2*)(sp + 4); }
#pragma unroll
          for (int ai = 0; ai < 2; ++ai)
#pragma unroll
            for (int m = 0; m < 4; ++m) rqa[ai][m] = rsqrtf(((sv[ai][m][0][0] + sv[ai][m][0][1]) + (sv[ai][m][1][0] + sv[ai][m][1][1]) + (sv[ai][m][2][0] + sv[ai][m][2][1])) * (1.f / 384.f) + EPS); }
        if ((wc & 1) == 0) {
            f32x4 qw[2][2];
#pragma unroll
            for (int bj = 0; bj < 2; ++bj) { qw[bj][0] = *(const f32x4*)(qnw + 32 * bj + 8 * fq); qw[bj][1] = *(const f32x4*)(qnw + 32 * bj + 8 * fq + 4); }
#pragma unroll
            for (int ai = 0; ai < 2; ++ai)
#pragma unroll
                for (int m = 0; m < 4; ++m) { const int R = R0 + ai * HALF + m * 16;
                    asm volatile("" ::: "memory");
                    float ss = 0.f; bf16_t* dst = Q1N + (size_t)R * DM + head * 64 + 8 * fq;
#pragma unroll
                    for (int bj = 0; bj < 2; ++bj) { f32x4 x0 = acc[ai][bj][m][0] * rqa[ai][m], x1 = acc[ai][bj][m][1] * rqa[ai][m]; ss += sq4(x0) + sq4(x1);
                        x0 = x0 * qw[bj][0]; x1 = x1 * qw[bj][1]; *(u32x4*)(dst + 32 * bj) = pack8(x0, x1); }
                    ss = quad_sum(ss); if (fq == 0) SSH[((size_t)R * 16 + head) * 2] = ss; }
        } else {
            const float* wp = qnw + 64 + 16 * (fq >> 1) + 4 * (fq & 1); const f32x4 w0 = *(const f32x4*)wp, w1 = *(const f32x4*)(wp + 8);
            f32x4 tn0, tn1;
            { const int t = R0 & (SEQ - 1); const int pos = (fq >> 1) ? (t & 63) : (t >> 6); const f32x4* tp = tabB + (pos * 8 + 4 * (fq & 1)) / 2; tn0 = tp[0]; tn1 = tp[1]; }
#pragma unroll
            for (int ai = 0; ai < 2; ++ai)
#pragma unroll
                for (int m = 0; m < 4; ++m) { const int R = R0 + ai * HALF + m * 16; const f32x4 t0 = tn0, t1 = tn1;
                    if (ai * 4 + m < 7) { const int Rn = R0 + ((ai * 4 + m + 1) >> 2) * HALF + ((ai * 4 + m + 1) & 3) * 16; const int t = Rn & (SEQ - 1); const int pos = (fq >> 1) ? (t & 63) : (t >> 6);
                        const f32x4* tp = tabB + (pos * 8 + 4 * (fq & 1)) / 2; tn0 = tp[0]; tn1 = tp[1]; }
                    asm volatile("" ::: "memory");
                    f32x4 x0 = acc[ai][0][m][0] * rqa[ai][m], x1 = acc[ai][0][m][1] * rqa[ai][m]; const float ss = quad_sum(sq4(x0) + sq4(x1)); if (fq == 0) SSH[((size_t)R * 16 + head) * 2 + 1] = ss;
                    x0 = x0 * w0; x1 = x1 * w1; rot4(x0, x1, t0, t1);
                    *(u32x4*)(Q1R + (size_t)R * 512 + head * 32 + 8 * fq) = pack8(x0, x1); }
        }
    }
};

struct In1Order {
    int G, c, rep; ROrder lat;
    __host__ __device__ void init(int G_, int c_, int rep_ = 1) { G = G_; c = c_; rep = rep_; lat.init(0, ML / BM, N_IN1P, 1, 0); }
    __host__ __device__ bool next(int i, Unit& u) const {
        const long L0 = (long)i * G + c; const long tot = lat.nwg + 4; if (L0 >= tot * rep) return false; const long L = L0 % tot; if (L < lat.nwg) return lat.next((int)L, u);
        const int e = (int)(L - lat.nwg); u.pm = ML / BM + (e >> 1); u.pn = (e & 1) * 2; u.ko = 0; return true;
    }
    __device__ __forceinline__ void a_ready(const Unit&) const {}
    __device__ __forceinline__ void done(const Unit&) const {}
};
template <class Epi, class Sched, bool ALIGN_EPI = false, bool SP2 = false>
__device__ __forceinline__ void gemm_phase(PG8_LAS unsigned char* lds, const Gemm g, const Sched& S, const Epi& E) {
    const int tid = threadIdx.x, wid = __builtin_amdgcn_readfirstlane(tid >> 6), lane = tid & 63, wr = wid >> 2, wc = wid & 3, fr = lane & 15, fq = lane >> 4;
    const int K = g.K, nt = (g.Kloop ? g.Kloop : K) / BK;
    unsigned voffA[2], voffB[2];
#pragma unroll
    for (int i = 0; i < 2; ++i) { int R, C; stage_rc(tid * 16 + i * 8192, R, C); const int Rb = Epi::PERM ? ((R & ~31) + perm32(R & 31)) : R;
        voffA[i] = (unsigned)(R * K + C) * 2u; voffB[i] = (unsigned)(Rb * K + C) * 2u; }
    const size_t kstep = (size_t)(BK * 2);
    const size_t hstep = (size_t)HALF * K * 2;
    const size_t tstep = 2 * hstep;
    const unsigned ldsw = (unsigned)wid * 1024u;
    const int aoff = lds_byte(wr * 64 + fr, fq * 8), boff = lds_byte(wc * 32 + fr, fq * 8);
#define PG8_SA(b, h) (((b) * 2 + (h)) * HTB)
#define PG8_SB(b, h) ((4 + (b) * 2 + (h)) * HTB)
#define PG8_STAGE(bufoff, gbase, voff) do { _Pragma("unroll") for (int _i = 0; _i < 2; ++_i) \
        __builtin_amdgcn_global_load_lds((const unsigned*)((const char*)(gbase) + (voff)[_i]), (PG8_LAS unsigned*)(lds + (bufoff) + ldsw + _i * 8192), 16, 0, 0); } while (0)
#define PG8_LDA(dst, b, h) do { _Pragma("unroll") for (int m = 0; m < 4; ++m) _Pragma("unroll") for (int k = 0; k < 2; ++k) dst[m][k] = *(const PG8_LAS bf16x8*)(lds + PG8_SA(b, h) + aoff + m * 2048 + k * 1024); } while (0)
#define PG8_LDB(dst, b, h) do { _Pragma("unroll") for (int n = 0; n < 2; ++n) _Pragma("unroll") for (int k = 0; k < 2; ++k) dst[n][k] = *(const PG8_LAS bf16x8*)(lds + PG8_SB(b, h) + boff + n * 2048 + k * 1024); } while (0)
#define PG8_MMA(ai, bj, At, Bt) do { __builtin_amdgcn_s_setprio(1); _Pragma("unroll") for (int m = 0; m < 4; ++m) _Pragma("unroll") for (int n = 0; n < 2; ++n) _Pragma("unroll") for (int k = 0; k < 2; ++k) \
        acc[ai][bj][m][n] = __builtin_amdgcn_mfma_f32_16x16x32_bf16(Bt[n][k], At[m][k], acc[ai][bj][m][n], 0, 0, 0); __builtin_amdgcn_s_setprio(0); } while (0)
#define PG8_WAIT_V(n) asm volatile("s_waitcnt vmcnt(" #n ")" ::: "memory")
#define PG8_WAIT_L(n) asm volatile("s_waitcnt lgkmcnt(" #n ")" ::: "memory")
#define PG8_BAR __builtin_amdgcn_s_barrier()
#define PG8_SCHED __builtin_amdgcn_sched_barrier(0)
    Unit cur, nxt; int ui = 0;
    if (!S.next(0, cur)) return;
    f32x4 acc[2][2][4][2];
#pragma unroll
    for (int a = 0; a < 2; ++a)
#pragma unroll
        for (int b = 0; b < 2; ++b)
#pragma unroll
            for (int m = 0; m < 4; ++m)
#pragma unroll
                for (int n = 0; n < 2; ++n) acc[a][b][m][n] = (f32x4){0.f, 0.f, 0.f, 0.f};
    bf16x8 At[4][2], B0[2][2], B1[2][2];
    const char* cA = (const char*)g.A + (size_t)cur.pm * tstep + (size_t)cur.ko * 2; const char* cB = (const char*)g.Bt + (size_t)cur.pn * tstep + (size_t)cur.ko * 2;
    S.a_ready(cur);
    if constexpr (SP2) {
        PG8_STAGE(PG8_SB(0, 0), cB, voffB); PG8_STAGE(PG8_SB(0, 1), cB + hstep, voffB); PG8_STAGE(PG8_SA(0, 0), cA, voffA); PG8_STAGE(PG8_SA(0, 1), cA + hstep, voffA);
        if (wr == 1) PG8_BAR;
        PG8_WAIT_V(2); PG8_BAR;
        PG8_STAGE(PG8_SB(1, 0), cB + kstep, voffB); PG8_STAGE(PG8_SA(1, 0), cA + kstep, voffA); PG8_STAGE(PG8_SB(1, 1), cB + hstep + kstep, voffB);
        PG8_WAIT_V(6); PG8_BAR;
    } else {
        PG8_STAGE(PG8_SB(0, 0), cB, voffB); PG8_STAGE(PG8_SA(0, 0), cA, voffA); PG8_STAGE(PG8_SB(0, 1), cB + hstep, voffB); PG8_STAGE(PG8_SA(0, 1), cA + hstep, voffA);
        if (wr == 1) PG8_BAR;
        PG8_WAIT_V(4); PG8_BAR;
        PG8_STAGE(PG8_SB(1, 0), cB + kstep, voffB); PG8_STAGE(PG8_SA(1, 0), cA + kstep, voffA); PG8_STAGE(PG8_SB(1, 1), cB + hstep + kstep, voffB);
        PG8_WAIT_V(6); PG8_BAR;
    }
    for (;;) {
        const bool has_next = S.next(ui + 1, nxt);
        const char* nA = has_next ? (const char*)g.A + (size_t)nxt.pm * tstep + (size_t)nxt.ko * 2 : cA; const char* nB = has_next ? (const char*)g.Bt + (size_t)nxt.pn * tstep + (size_t)nxt.ko * 2 : cB;
        _Pragma("nounroll") for (int t = 0; t < nt; t += 2) {
            const bool last = (t == nt - 2);
            const char* a1 = cA + (size_t)(t + 1) * kstep;
            const char* a2 = last ? nA : cA + (size_t)(t + 2) * kstep; const char* b2 = last ? nB : cB + (size_t)(t + 2) * kstep;
            const char* a3 = a2 + kstep; const char* b3 = b2 + kstep;
            if (last && has_next) S.a_ready(nxt);
            if constexpr (SP2) {
            PG8_LDB(B0, 0, 0); PG8_LDB(B1, 0, 1); PG8_SCHED; PG8_LDA(At, 0, 0); PG8_STAGE(PG8_SA(1, 1), a1 + hstep, voffA);
            PG8_WAIT_V(8); PG8_WAIT_L(0); PG8_BAR; PG8_MMA(0, 0, At, B0); PG8_MMA(0, 1, At, B1); PG8_BAR; PG8_SCHED;
            PG8_LDA(At, 0, 1); PG8_STAGE(PG8_SB(0, 0), b2, voffB); PG8_STAGE(PG8_SB(0, 1), b2 + hstep, voffB); PG8_STAGE(PG8_SA(0, 0), a2, voffA);
            PG8_WAIT_V(8); PG8_WAIT_L(0); PG8_BAR; PG8_MMA(1, 0, At, B0); PG8_MMA(1, 1, At, B1); PG8_BAR; PG8_SCHED;
            PG8_LDB(B0, 1, 0); PG8_LDB(B1, 1, 1); PG8_SCHED; PG8_LDA(At, 1, 0); PG8_STAGE(PG8_SA(0, 1), a2 + hstep, voffA);
            PG8_WAIT_V(8); PG8_WAIT_L(0); PG8_BAR; PG8_MMA(0, 0, At, B0); PG8_MMA(0, 1, At, B1); PG8_BAR; PG8_SCHED;
            PG8_LDA(At, 1, 1); PG8_STAGE(PG8_SB(1, 0), b3, voffB); PG8_STAGE(PG8_SB(1, 1), b3 + hstep, voffB); PG8_STAGE(PG8_SA(1, 0), a3, voffA);
            PG8_WAIT_V(8); PG8_WAIT_L(0); PG8_BAR; PG8_MMA(1, 0, At, B0); PG8_MMA(1, 1, At, B1); PG8_BAR; PG8_SCHED;
            } else {
            PG8_LDB(B0, 0, 0); PG8_SCHED; PG8_LDA(At, 0, 0); PG8_STAGE(PG8_SA(1, 1), a1 + hstep, voffA);
            PG8_WAIT_L(8); PG8_BAR; PG8_WAIT_L(0); PG8_MMA(0, 0, At, B0); PG8_BAR; PG8_SCHED;
            PG8_LDB(B1, 0, 1); PG8_STAGE(PG8_SB(0, 0), b2, voffB);
            PG8_BAR; PG8_WAIT_L(0); PG8_MMA(0, 1, At, B1); PG8_BAR;
            PG8_LDA(At, 0, 1); PG8_STAGE(PG8_SA(0, 0), a2, voffA);
            PG8_BAR; PG8_WAIT_L(0); PG8_MMA(1, 0, At, B0); PG8_BAR; PG8_SCHED;
            PG8_STAGE(PG8_SB(0, 1), b2 + hstep, voffB);
            PG8_WAIT_V(6); PG8_BAR; PG8_MMA(1, 1, At, B1); PG8_BAR;
            PG8_LDB(B0, 1, 0); PG8_SCHED; PG8_LDA(At, 1, 0); PG8_STAGE(PG8_SA(0, 1), a2 + hstep, voffA);
            PG8_WAIT_L(8); PG8_BAR; PG8_WAIT_L(0); PG8_MMA(0, 0, At, B0); PG8_BAR; PG8_SCHED;
            PG8_LDB(B1, 1, 1); PG8_STAGE(PG8_SB(1, 0), b3, voffB);
            PG8_BAR; PG8_WAIT_L(0); PG8_MMA(0, 1, At, B1); PG8_BAR;
            PG8_LDA(At, 1, 1); PG8_STAGE(PG8_SA(1, 0), a3, voffA);
            PG8_BAR; PG8_WAIT_L(0); PG8_MMA(1, 0, At, B0); PG8_BAR; PG8_SCHED;
            PG8_STAGE(PG8_SB(1, 1), b3 + hstep, voffB);
            PG8_WAIT_V(6); PG8_BAR; PG8_MMA(1, 1, At, B1); PG8_BAR;
            }
        }
        if constexpr (ALIGN_EPI) { if (wr == 0) PG8_BAR; }
        if constexpr (!Epi::AFTER_DRAIN) { E(acc, cur, wr, wc, fr, fq); S.done(cur); }
        if (!has_next) break;
#pragma unroll
        for (int a = 0; a < 2; ++a)
#pragma unroll
            for (int b = 0; b < 2; ++b)
#pragma unroll
                for (int m = 0; m < 4; ++m)
#pragma unroll
                    for (int n = 0; n < 2; ++n) acc[a][b][m][n] = (f32x4){0.f, 0.f, 0.f, 0.f};
        cur = nxt; cA = nA; cB = nB; ++ui;
        if constexpr (ALIGN_EPI) { if (wr == 1) PG8_BAR; }
    }
    PG8_WAIT_V(0);
    if constexpr (!ALIGN_EPI) { if (wr == 0) PG8_BAR; }
    PG8_BAR;
    if constexpr (Epi::AFTER_DRAIN) { E.fused(acc, cur, wr, wc, fr, fq, lds, wid, lane); S.done(cur); }
#undef PG8_SA
#undef PG8_SB
#undef PG8_STAGE
#undef PG8_LDA
#undef PG8_LDB
#undef PG8_MMA
#undef PG8_WAIT_V
#undef PG8_WAIT_L
#undef PG8_BAR
#undef PG8_SCHED
}
}

DEVI void sincos_pos(float ang, float& cs, float& sn) {
    const double TWO_PI = 6.283185307179586476925286766559; const double a = (double)ang; const double k = __builtin_rint(a * (1.0 / TWO_PI));
    const float r = (float)(a - k * TWO_PI);
    cs = cosf(r); sn = sinf(r);
}

namespace afast {
#ifndef ATT_PRIO
#define ATT_PRIO 2
#endif
#ifndef ATT_DUP
#define ATT_DUP 0
#endif
constexpr int NW = 8, KVBLK = 64, SLOTK = 12288, SLOTV = 8192, KROFF = 8192;
constexpr int LDS_K = 0, LDS_V = 3 * SLOTK, LDS_WS = LDS_V + 3 * SLOTV, LDS_OST = LDS_WS + NW * 256, LDS_BYTES = LDS_OST + NW * 4096;
#define SBAR() __builtin_amdgcn_sched_barrier(0)
#define PIN(x) asm volatile("" : "+v"(x))
#define MFMA(a, b, c) __builtin_amdgcn_mfma_f32_32x32x16_bf16(a, b, c, 0, 0, 0)
#ifndef ATT_AGPR_O
#define ATT_AGPR_O 0
#endif
#if ATT_AGPR_O
#define PVMFMA(acc, a, b) asm volatile("s_nop 1\n\tv_mfma_f32_32x32x16_bf16 %0, %1, %2, %0" : "+a"(acc) : "v"(a), "v"(b))
#else
#define PVMFMA(acc, a, b) acc = __builtin_amdgcn_mfma_f32_32x32x16_bf16(a, b, acc, 0, 0, 0)
#endif
#define WAIT_BAR_(N) asm volatile("s_waitcnt vmcnt(" #N ") lgkmcnt(0)\n\ts_barrier" ::: "memory")
#define WAIT_BAR_0() WAIT_BAR_(0)
#define WAIT_BAR_1() do { if (ATT_DUP & 1) WAIT_BAR_(2); else WAIT_BAR_(1); } while (0)
#define WAIT_BAR_2() do { if (ATT_DUP & 1) WAIT_BAR_(4); else WAIT_BAR_(2); } while (0)
#define WAIT_BAR_3() do { if (ATT_DUP & 1) WAIT_BAR_(6); else WAIT_BAR_(3); } while (0)
#define WAIT_BAR(N) do { WAIT_BAR_##N(); if (ATT_DUP & 2) asm volatile("s_barrier" ::: "memory"); } while (0)
DEVI int crow(int r, int hi) { return (r & 3) + 8 * (r >> 2) + 4 * hi; }
DEVI unsigned cvtpk(float lo, float hi) { unsigned r; asm("v_cvt_pk_bf16_f32 %0, %1, %2" : "=v"(r) : "v"(lo), "v"(hi)); return r; }
DEVI void glds16(const void* g, unsigned lds_base) {
    unsigned sv; asm volatile("s_mov_b32 %0, m0\n\ts_mov_b32 m0, %2\n\ts_nop 0\n\tglobal_load_lds_dwordx4 %1, off\n\ts_mov_b32 m0, %0" : "=&s"(sv) : "v"(g), "s"(lds_base) : "memory"); }
typedef __attribute__((address_space(3))) const char* lds_cptr;
typedef short v4i16_t __attribute__((ext_vector_type(4)));
DEVI bf16x8 ldsb128(lds_cptr p) { return *(const __attribute__((address_space(3))) bf16x8*)p; }
DEVI s16x4 vtr(lds_cptr p) { return __builtin_bit_cast(s16x4, __builtin_amdgcn_ds_read_tr16_b64_v4i16((__attribute__((address_space(3))) v4i16_t*)p)); }
DEVI bf16x8 scale8(bf16x8 v, float s) {
    u32x4 w = __builtin_bit_cast(u32x4, v); u32x4 o;
#pragma unroll
    for (int i = 0; i < 4; ++i) { const float lo = __uint_as_float(w[i] << 16) * s, hi = __uint_as_float(w[i] & 0xffff0000u) * s; o[i] = cvtpk(lo, hi); }
    return __builtin_bit_cast(bf16x8, o);
}

template <int ROPE>
DEVI void attn_unit(const bf16_t* Qn, int ldq, const bf16_t* Qr, const float* ssh, const bf16_t* __restrict__ Kn, int ldk, const bf16_t* __restrict__ Kr,
                    const bf16_t* __restrict__ V, int ldv, int NT, bf16_t* O, const bf16_t* G, int ldo, char* lds) {
    const int tid = threadIdx.x, lane = tid & 63, r32 = lane & 31, hi = lane >> 5; const int wid = __builtin_amdgcn_readfirstlane(tid >> 6);
    const unsigned lds0 = (unsigned)(uintptr_t)lds; float* wsf = (float*)(lds + LDS_WS) + wid * 64;
    const bf16_t* ksrc = Kn + (size_t)lane * ldk + wid * 8;
    const bf16_t* vsrc = V + (size_t)(16 * (wid & 3) + (lane >> 2)) * ldv + (wid >> 2) * 32 + (lane & 3) * 8;
    const bf16_t* krsrc = ROPE ? Kr + (size_t)(32 * (wid & 1) + r32) * 32 + 8 * (2 * ((wid >> 1) & 1) + hi) : nullptr;
    const unsigned kdst = lds0 + LDS_K + wid * 1024, vdst = lds0 + LDS_V + wid * 1024, krdst = lds0 + LDS_K + KROFF + (wid & 3) * 1024;
    const bool rwave = ROPE && wid < 4;
#define DMA_K(t, slot) do { DMA_K1(t, slot); if (ATT_DUP & 1) DMA_K1(t, slot); } while (0)
#define DMA_K1(t, slot) do { if (ROPE) { if (rwave) glds16(krsrc + (size_t)(t) * KVBLK * 32, (unsigned)__builtin_amdgcn_readfirstlane(krdst + (slot))); } \
        glds16(ksrc + (size_t)(t) * KVBLK * ldk, (unsigned)__builtin_amdgcn_readfirstlane(kdst + (slot))); } while (0)
#define DMA_V1(t, slot) glds16(vsrc + (size_t)(t) * KVBLK * ldv, (unsigned)__builtin_amdgcn_readfirstlane(vdst + (slot)))
#define DMA_V(t, slot) do { DMA_V1(t, slot); if (ATT_DUP & 1) DMA_V1(t, slot); } while (0)
    const lds_cptr vp0 = (lds_cptr)lds + LDS_V + ((lane >> 4) & 1) * 32 + (lane & 3) * 8 + (4 * hi + ((lane & 15) >> 2)) * 64;
    const lds_cptr kp0 = (lds_cptr)lds + LDS_K + hi * 1024 + r32 * 16;
    const lds_cptr krp0 = (lds_cptr)lds + LDS_K + KROFF + hi * 512 + r32 * 16;
    DMA_K(0, 0); DMA_V(0, 0); DMA_K(1, SLOTK);
    bf16x8 qr[4]; bf16x8 qrr[2];
    { const bf16_t* Qw = Qn + (size_t)(wid * 32 + r32) * ldq + hi * 8;
#pragma unroll
      for (int d0 = 0; d0 < 4; ++d0) qr[d0] = *reinterpret_cast<const bf16x8*>(Qw + d0 * 16);
      if (ROPE) { const bf16_t* Qrw = Qr + (size_t)(wid * 32 + r32) * 512 + hi * 8;
#pragma unroll
          for (int d0 = 0; d0 < 2; ++d0) qrr[d0] = *reinterpret_cast<const bf16x8*>(Qrw + d0 * 16);
          const f32x2 s2 = *(const f32x2*)(ssh + (size_t)(wid * 32 + r32) * 32); const float sc = rsqrtf((s2[0] + s2[1]) * (1.f / 96.f) + EPS) * C2_MLA;
#pragma unroll
          for (int d0 = 0; d0 < 4; ++d0) qr[d0] = scale8(qr[d0], sc);
#pragma unroll
          for (int d0 = 0; d0 < 2; ++d0) qrr[d0] = scale8(qrr[d0], sc); } }
    float l_reg = 0.f; f32x16 o[2]; o[0] = f32x16{}; o[1] = f32x16{};
    const f32x16 zero16 = f32x16{};
    f32x16 dacc = f32x16{}; f32x16 pA0, pA1, pB0, pB1; bf16x8 kf[8]; bf16x8 kfr[4]; s16x4 vlo[8], vhi[8]; u32x4 pw0, pw1, pw2, pw3;
    int sl_prev = 0, sl_cur = 0, sl_next = SLOTK;
#define VSL(s) (((s) / (SLOTK / 1024)) * (SLOTV / 1024))
#define ROT() do { sl_prev = sl_cur; sl_cur = sl_next; sl_next = (sl_next == 2 * SLOTK) ? 0 : sl_next + SLOTK; } while (0)
#define EX(v) __builtin_amdgcn_exp2f(v)
#define KLOADALL(slot) do { _Pragma("unroll") for (int d0 = 0; d0 < 4; ++d0) { kf[2 * d0] = ldsb128(kp0 + (slot) + d0 * 2048); kf[2 * d0 + 1] = ldsb128(kp0 + (slot) + d0 * 2048 + 512); } \
        if (ROPE) { _Pragma("unroll") for (int q = 0; q < 4; ++q) kfr[q] = ldsb128(krp0 + (slot) + q * 1024); } } while (0)
    DMA_K(2, 2 * SLOTK);
    WAIT_BAR(3);
    KLOADALL(0);
    pA0 = MFMA(kf[0], qr[0], zero16); pA1 = MFMA(kf[1], qr[0], zero16); pA0 = MFMA(kf[2], qr[1], pA0); pA1 = MFMA(kf[3], qr[1], pA1);
    pA0 = MFMA(kf[4], qr[2], pA0); pA1 = MFMA(kf[5], qr[2], pA1); pA0 = MFMA(kf[6], qr[3], pA0); pA1 = MFMA(kf[7], qr[3], pA1);
    if (ROPE) { pA0 = MFMA(kfr[0], qrr[0], pA0); pA1 = MFMA(kfr[1], qrr[0], pA1); pA0 = MFMA(kfr[2], qrr[1], pA0); pA1 = MFMA(kfr[3], qrr[1], pA1); }
#pragma unroll
    for (int r = 0; r < 16; ++r) { pA0[r] = EX(pA0[r]); pA1[r] = EX(pA1[r]); }
    WAIT_BAR(0);
    DMA_K(3, 0); DMA_V(1, SLOTV); ROT();
    KLOADALL(sl_cur);
    WAIT_BAR(2);
#define PKW(P, i) cvtpk(P[i], P[i + 1])
#define PAF(k) __builtin_bit_cast(bf16x8, pw##k)
#define VFR(i) (bf16x8){vlo[i][0], vlo[i][1], vlo[i][2], vlo[i][3], vhi[i][0], vhi[i][1], vhi[i][2], vhi[i][3]}
#define VRD(i) do { vlo[i] = vtr(vp_ + (((i) >> 2) * 4096 + ((i) & 3) * 1024)); vhi[i] = vtr(vp_ + (((i) >> 2) * 4096 + ((i) & 3) * 1024 + 512)); } while (0)
#define KRD(G, d0) do { if (G) { kf[2 * (d0)] = ldsb128(kp0 + sl_next + (d0) * 2048); kf[2 * (d0) + 1] = ldsb128(kp0 + sl_next + (d0) * 2048 + 512); \
        if (ATT_DUP & 16) { bf16x8 d0_, d1_; asm volatile("ds_read_b128 %0, %2 offset:0\n\tds_read_b128 %1, %2 offset:512\n\ts_waitcnt lgkmcnt(0)" : "=&v"(d0_), "=&v"(d1_) : "v"((unsigned)(uintptr_t)(kp0 + sl_next + (d0) * 2048)) : "memory"); } SBAR(); } } while (0)
#define KRR(G, q) do { if (ROPE) { if (G) { kfr[2 * (q)] = ldsb128(krp0 + sl_next + (2 * (q)) * 1024); kfr[2 * (q) + 1] = ldsb128(krp0 + sl_next + (2 * (q) + 1) * 1024); SBAR(); } } } while (0)
#define GAPA4(CX, MF, a0, a1, a2, a3, W0, W1, PW) do { MF; sacc += a0; sacc += a1; sacc += a2; sacc += a3; W0; W1; PIN(PW); PIN(sacc); PIN(CX); if ((ATT_DUP & 8) && !ROPE) { dacc = MFMA(kf[0], qr[0], dacc); PIN(dacc); } SBAR(); } while (0)
#define GAPA3(CX, MF, a0, a1, a2, W0, W1, PW) do { MF; sacc += a0; sacc += a1; sacc += a2; W0; W1; PIN(PW); PIN(sacc); PIN(CX); if ((ATT_DUP & 8) && !ROPE) { dacc = MFMA(kf[0], qr[0], dacc); PIN(dacc); } SBAR(); } while (0)
#define GAPA31(CX, MF, a0, a1, a2, W0, PW) do { MF; sacc += a0; sacc += a1; sacc += a2; W0; PIN(PW); PIN(sacc); PIN(CX); if ((ATT_DUP & 8) && !ROPE) { dacc = MFMA(kf[0], qr[0], dacc); PIN(dacc); } SBAR(); } while (0)
#define GAPA21(CX, MF, a0, a1, W0, PW) do { MF; sacc += a0; sacc += a1; W0; PIN(PW); PIN(sacc); PIN(CX); if ((ATT_DUP & 8) && !ROPE) { dacc = MFMA(kf[0], qr[0], dacc); PIN(dacc); } SBAR(); } while (0)
#define XEXP(v) do { if (ATT_DUP & 4) { float d_; asm volatile("v_exp_f32 %0, %1" : "=v"(d_) : "v"(v)); } } while (0)
#define GAPB(MF, X, i) do { MF; X[i] = EX(X[i]); X[i + 1] = EX(X[i + 1]); X[i + 2] = EX(X[i + 2]); X[i + 3] = EX(X[i + 3]); XEXP(X[i]); XEXP(X[i + 1]); XEXP(X[i + 2]); XEXP(X[i + 3]); PIN(X); SBAR(); } while (0)
#define STEP(C0, C1, P0, P1, t, GK, GV, GL) do { SBAR(); if (ATT_PRIO == 2) __builtin_amdgcn_s_setprio(1); if (ATT_PRIO == 3) __builtin_amdgcn_s_setprio(0); \
    const lds_cptr vp_ = vp0 + VSL(sl_prev); \
    VRD(0); SBAR(); float sacc = P0[0] + P0[1]; \
    if (!ROPE) { \
                        GAPA4(C0, C0 = MFMA(kf[0], qr[0], zero16), P0[2], P0[3], P0[4], P0[5],     pw0[0] = PKW(P0, 0),  pw0[1] = PKW(P0, 2),  pw0); \
        VRD(4); SBAR(); GAPA4(C1, C1 = MFMA(kf[1], qr[0], zero16), P0[6], P0[7], P0[8], P0[9],     pw0[2] = PKW(P0, 4),  pw0[3] = PKW(P0, 6),  pw0); \
        VRD(1); SBAR(); GAPA4(C0, C0 = MFMA(kf[2], qr[1], C0),    P0[10], P0[11], P0[12], P0[13], pw1[0] = PKW(P0, 8),  pw1[1] = PKW(P0, 10), pw1); \
        VRD(5); SBAR(); GAPA4(C1, C1 = MFMA(kf[3], qr[1], C1),    P0[14], P0[15], P1[0], P1[1],   pw1[2] = PKW(P0, 12), pw1[3] = PKW(P0, 14), pw1); \
        VRD(2); SBAR(); GAPA4(C0, C0 = MFMA(kf[4], qr[2], C0),    P1[2], P1[3], P1[4], P1[5],     pw2[0] = PKW(P1, 0),  pw2[1] = PKW(P1, 2),  pw2); \
        VRD(6); SBAR(); GAPA4(C1, C1 = MFMA(kf[5], qr[2], C1),    P1[6], P1[7], P1[8], P1[9],     pw2[2] = PKW(P1, 4),  pw2[3] = PKW(P1, 6),  pw2); \
        VRD(3); SBAR(); GAPA4(C0, C0 = MFMA(kf[6], qr[3], C0),    P1[10], P1[11], P1[12], P1[13], pw3[0] = PKW(P1, 8),  pw3[1] = PKW(P1, 10), pw3); \
        VRD(7); SBAR(); GAPA4(C1, C1 = MFMA(kf[7], qr[3], C1),    P1[14], P1[15], 0.f, 0.f,       pw3[2] = PKW(P1, 12), pw3[3] = PKW(P1, 14), pw3); \
    } else { \
                        GAPA3(C0, C0 = MFMA(kf[0], qr[0], zero16), P0[2], P0[3], P0[4],    pw0[0] = PKW(P0, 0),  pw0[1] = PKW(P0, 2),  pw0); \
        VRD(4); SBAR(); GAPA3(C1, C1 = MFMA(kf[1], qr[0], zero16), P0[5], P0[6], P0[7],    pw0[2] = PKW(P0, 4),  pw0[3] = PKW(P0, 6),  pw0); \
        VRD(1); SBAR(); GAPA3(C0, C0 = MFMA(kf[2], qr[1], C0),    P0[8], P0[9], P0[10],   pw1[0] = PKW(P0, 8),  pw1[1] = PKW(P0, 10), pw1); \
        VRD(5); SBAR(); GAPA3(C1, C1 = MFMA(kf[3], qr[1], C1),    P0[11], P0[12], P0[13], pw1[2] = PKW(P0, 12), pw1[3] = PKW(P0, 14), pw1); \
        VRD(2); SBAR(); GAPA31(C0, C0 = MFMA(kf[4], qr[2], C0),   P0[14], P0[15], P1[0],  pw2[0] = PKW(P1, 0),  pw2); \
        VRD(6); SBAR(); GAPA31(C1, C1 = MFMA(kf[5], qr[2], C1),   P1[1], P1[2], P1[3],    pw2[1] = PKW(P1, 2),  pw2); \
        VRD(3); SBAR(); GAPA21(C0, C0 = MFMA(kf[6], qr[3], C0),   P1[4], P1[5],           pw2[2] = PKW(P1, 4),  pw2); \
        VRD(7); SBAR(); GAPA21(C1, C1 = MFMA(kf[7], qr[3], C1),   P1[6], P1[7],           pw2[3] = PKW(P1, 6),  pw2); \
                        GAPA21(C0, C0 = MFMA(kfr[0], qrr[0], C0), P1[8], P1[9],           pw3[0] = PKW(P1, 8),  pw3); \
                        GAPA21(C1, C1 = MFMA(kfr[1], qrr[0], C1), P1[10], P1[11],         pw3[1] = PKW(P1, 10), pw3); \
                        GAPA21(C0, C0 = MFMA(kfr[2], qrr[1], C0), P1[12], P1[13],         pw3[2] = PKW(P1, 12), pw3); \
                        GAPA21(C1, C1 = MFMA(kfr[3], qrr[1], C1), P1[14], P1[15],         pw3[3] = PKW(P1, 14), pw3); \
    } \
    l_reg += sacc; \
    if (GK) DMA_K((t) + 3, sl_cur); if (GV) DMA_V((t) + 1, VSL(sl_next)); \
    SBAR(); if (ATT_PRIO == 2) __builtin_amdgcn_s_setprio(0); if (ATT_PRIO == 3) __builtin_amdgcn_s_setprio(1); \
    GAPB(PVMFMA(o[0], PAF(0), VFR(0)), C0, 0); \
    KRD(GL, 0); GAPB(PVMFMA(o[1], PAF(0), VFR(4)), C0, 4); \
    KRD(GL, 1); GAPB(PVMFMA(o[0], PAF(1), VFR(1)), C0, 8); \
    KRD(GL, 2); GAPB(PVMFMA(o[1], PAF(1), VFR(5)), C0, 12); \
    KRD(GL, 3); GAPB(PVMFMA(o[0], PAF(2), VFR(2)), C1, 0); \
    KRR(GL, 0); GAPB(PVMFMA(o[1], PAF(2), VFR(6)), C1, 4); \
    KRR(GL, 1); GAPB(PVMFMA(o[0], PAF(3), VFR(3)), C1, 8); \
    GAPB(PVMFMA(o[1], PAF(3), VFR(7)), C1, 12); \
    } while (0)
    if (ATT_PRIO == 1) { if (wid >= 4) __builtin_amdgcn_s_setprio(1); }
    int t = 1;
    for (; t + 5 < NT; t += 2) {
        STEP(pB0, pB1, pA0, pA1, t, true, true, true);     WAIT_BAR(2); ROT();
        STEP(pA0, pA1, pB0, pB1, t + 1, true, true, true); WAIT_BAR(2); ROT();
    }
#define ENDW(tt) do { if ((tt) + 3 < NT) { WAIT_BAR(2); } else if ((tt) + 2 < NT) { WAIT_BAR(1); } else { WAIT_BAR(0); } } while (0)
    for (; t + 1 < NT; t += 2) {
        STEP(pB0, pB1, pA0, pA1, t, (t + 3 < NT), (t + 1 < NT), (t + 1 < NT));         ENDW(t);     ROT();
        STEP(pA0, pA1, pB0, pB1, t + 1, (t + 4 < NT), (t + 2 < NT), (t + 2 < NT));     ENDW(t + 1); ROT();
    }
    STEP(pB0, pB1, pA0, pA1, NT - 1, false, false, false);
    if (ATT_PRIO != 0) __builtin_amdgcn_s_setprio(0);
    { float sacc = pB0[0] + pB0[1];
#pragma unroll
      for (int r = 2; r < 16; ++r) sacc += pB0[r];
#pragma unroll
      for (int r = 0; r < 16; ++r) sacc += pB1[r];
      l_reg += sacc;
      pw0 = (u32x4){PKW(pB0, 0), PKW(pB0, 2), PKW(pB0, 4), PKW(pB0, 6)}; pw1 = (u32x4){PKW(pB0, 8), PKW(pB0, 10), PKW(pB0, 12), PKW(pB0, 14)};
      pw2 = (u32x4){PKW(pB1, 0), PKW(pB1, 2), PKW(pB1, 4), PKW(pB1, 6)}; pw3 = (u32x4){PKW(pB1, 8), PKW(pB1, 10), PKW(pB1, 12), PKW(pB1, 14)};
      const lds_cptr vp_ = vp0 + VSL(sl_cur); _Pragma("unroll") for (int i = 0; i < 8; ++i) VRD(i);
      PVMFMA(o[0], PAF(0), VFR(0)); PVMFMA(o[1], PAF(0), VFR(4)); PVMFMA(o[0], PAF(1), VFR(1)); PVMFMA(o[1], PAF(1), VFR(5));
      PVMFMA(o[0], PAF(2), VFR(2)); PVMFMA(o[1], PAF(2), VFR(6)); PVMFMA(o[0], PAF(3), VFR(3)); PVMFMA(o[1], PAF(3), VFR(7)); }
#if ATT_AGPR_O
    asm volatile("s_nop 15\n\ts_nop 7" : "+a"(o[0]), "+a"(o[1]));
#endif
    { auto rr = __builtin_amdgcn_permlane32_swap(__float_as_uint(l_reg), __float_as_uint(l_reg), false, false); l_reg = __uint_as_float(rr[0]) + __uint_as_float(rr[1]); }
    if (hi == 0) wsf[32 + r32] = l_reg; asm volatile("s_waitcnt lgkmcnt(0)" ::: "memory");
    float rli[16];
#pragma unroll
    for (int r = 0; r < 16; ++r) rli[r] = __builtin_amdgcn_rcpf(wsf[32 + crow(r, hi)]);
    bf16_t* stg = (bf16_t*)(lds + LDS_OST) + wid * 2048;
#pragma unroll
    for (int r = 0; r < 16; ++r) { const int orow = crow(r, hi);
#pragma unroll
        for (int d0 = 0; d0 < 2; ++d0) stg[orow * 64 + d0 * 32 + r32] = (bf16_t)f2bf(o[d0][r] * rli[r]); }
    asm volatile("s_waitcnt lgkmcnt(0)" ::: "memory");
#pragma unroll
    for (int i = 0; i < 4; ++i) { const int row = i * 8 + (lane >> 3), ch = lane & 7; const size_t goff = (size_t)(wid * 32 + row) * ldo + ch * 8;
        const u32x4 ov = *(const u32x4*)(stg + row * 64 + ch * 8); const u32x4 gv = *(const u32x4*)(G + goff); u32x4 w;
#pragma unroll
        for (int q = 0; q < 4; ++q) { const float lo = __uint_as_float(ov[q] << 16) * __uint_as_float(gv[q] << 16), hh = __uint_as_float(ov[q] & 0xffff0000u) * __uint_as_float(gv[q] & 0xffff0000u); w[q] = cvtpk(lo, hh); }
        *(u32x4*)(O + goff) = w; }
    asm volatile("s_waitcnt lgkmcnt(0)\n\ts_barrier" ::: "memory");
#undef DMA_K
#undef DMA_K1
#undef DMA_V1
#undef XEXP
#undef DMA_V
#undef VSL
#undef ROT
#undef EX
#undef KLOADALL
#undef PKW
#undef PAF
#undef VFR
#undef VRD
#undef KRD
#undef KRR
#undef GAPA4
#undef GAPA3
#undef GAPA31
#undef GAPA21
#undef GAPB
#undef STEP
#undef ENDW
}
#undef SBAR
#undef PIN
#undef MFMA
#undef PVMFMA
#undef WAIT_BAR
#undef WAIT_BAR_
#undef WAIT_BAR_0
#undef WAIT_BAR_1
#undef WAIT_BAR_2
#undef WAIT_BAR_3
}

namespace af8 {
#ifdef MK_UNIT_PROBE
#define UPROBE_PARAM , unsigned long long& upacc
#define UPROBE_ARG , upacc
#else
#define UPROBE_PARAM
#define UPROBE_ARG
#endif
#ifndef F8_DUP
#define F8_DUP 0
#endif
typedef int v8i __attribute__((ext_vector_type(8)));
typedef int v4i __attribute__((ext_vector_type(4)));
typedef int v2i __attribute__((ext_vector_type(2)));
constexpr int NW = 8, KVBLK = 64, SLOT = 4096, KSLOT = 2048;
constexpr int KRSLOT = 1024 + 64;
constexpr int NSL = 4;
constexpr int LDS_K = 0, LDS_V = NSL * KSLOT, LDS_KR = LDS_V + NSL * SLOT, LDS_WS = LDS_KR + NSL * KRSLOT, LDS_OST = LDS_WS + NW * 256, LDS_BYTES = LDS_OST + NW * 4096;
constexpr float YOFF = (56.0f + 0.5f) / 256.f;
#define SBAR() __builtin_amdgcn_sched_barrier(0)
#define PIN(x) asm volatile("" : "+v"(x))
#define WAIT_BAR0() asm volatile("s_waitcnt vmcnt(0) lgkmcnt(0)\n\ts_barrier" ::: "memory")
#define WAIT_BAR1() asm volatile("s_waitcnt vmcnt(2) lgkmcnt(0)\n\ts_barrier" ::: "memory")
#define V8(x) ((v8i){(x)[0], (x)[1], (x)[2], (x)[3], 0, 0, 0, 0})
#define V6(x) ((v8i){(int)(x)[0], (int)(x)[1], (int)(x)[2], (int)(x)[3], (int)(x)[4], (int)(x)[5], 0, 0})
#define QKMFMA(a, b, c) __builtin_amdgcn_mfma_scale_f32_32x32x64_f8f6f4(V8(a), V6(b), c, 4, 2, 0, 122, 0, 122)
#define PVMFMA8(a, b, c) __builtin_amdgcn_mfma_scale_f32_32x32x64_f8f6f4(a, b, c, 1, 0, 0, 127, 0, 127)
#define SUMMFMA(a, b, c) __builtin_amdgcn_mfma_scale_f32_16x16x128_f8f6f4(a, b, c, 1, 0, 0, 127, 0, 127)
DEVI int crow(int r, int hi) { return (r & 3) + 8 * (r >> 2) + 4 * hi; }
DEVI unsigned cvtpk(float lo, float hi) { unsigned r; asm("v_cvt_pk_bf16_f32 %0, %1, %2" : "=v"(r) : "v"(lo), "v"(hi)); return r; }
DEVI void glds16(const void* g, unsigned lds_base) {
    unsigned sv; asm volatile("s_mov_b32 %0, m0\n\ts_mov_b32 m0, %2\n\ts_nop 0\n\tglobal_load_lds_dwordx4 %1, off\n\ts_mov_b32 m0, %0" : "=&s"(sv) : "v"(g), "s"(lds_base) : "memory"); }
typedef __attribute__((address_space(3))) const char* lds_cptr;
DEVI v4i lds128(lds_cptr p) { return *(const __attribute__((address_space(3))) v4i*)p; }
DEVI v2i vtr8(lds_cptr p) { return __builtin_amdgcn_ds_read_tr8_b64_v2i32((__attribute__((address_space(3))) v2i*)p); }
typedef unsigned short us2 __attribute__((ext_vector_type(2)));
#define PK16U8(P, PF, B) do { _Pragma("unroll") for (int g_ = 0; g_ < 4; ++g_) { \
        const us2 lo_ = __builtin_amdgcn_cvt_pknorm_u16(P[4 * g_], P[4 * g_ + 1]), hi_ = __builtin_amdgcn_cvt_pknorm_u16(P[4 * g_ + 2], P[4 * g_ + 3]); \
        PF[(B) + g_] = (int)__builtin_amdgcn_perm(__builtin_bit_cast(unsigned, hi_), __builtin_bit_cast(unsigned, lo_), 0x07050301u); } } while (0)
DEVI int pk4bf8(float a, float b, float c, float d) { unsigned w; asm volatile("" : "=v"(w)); w = __builtin_amdgcn_cvt_pk_u8_f32(a, 0, w); w = __builtin_amdgcn_cvt_pk_u8_f32(b, 1, w); w = __builtin_amdgcn_cvt_pk_u8_f32(c, 2, w); w = __builtin_amdgcn_cvt_pk_u8_f32(d, 3, w); return (int)w; }

DEVI int pk4fp8(float a, float b, float c, float d) { int w; asm volatile("" : "=v"(w)); w = __builtin_amdgcn_cvt_pk_fp8_f32(a, b, w, false); w = __builtin_amdgcn_cvt_pk_fp8_f32(c, d, w, true); return w; }
#ifndef F6_INTERLEAVED
#define F6_INTERLEAVED 1
#endif
typedef float v16f __attribute__((ext_vector_type(16)));
typedef unsigned v6u __attribute__((ext_vector_type(6)));
DEVI v6u q_cvt(const u32x4 (&wv)[4], float sc) { v16f a, b;
#pragma unroll
    for (int c = 0; c < 4; ++c) { const u32x4 w = wv[c];
#pragma unroll
        for (int k = 0; k < 4; ++k) { const float lo = __uint_as_float(w[k] << 16) * sc, hi = __uint_as_float(w[k] & 0xffff0000u) * sc; const int i = 4 * c + k;
            if (F6_INTERLEAVED) { a[i] = lo; b[i] = hi; } else if (i < 8) { a[2 * i] = lo; a[2 * i + 1] = hi; } else { b[2 * i - 16] = lo; b[2 * i - 15] = hi; } } }
    return __builtin_amdgcn_cvt_scalef32_2xpk16_fp6_f32(a, b, 1.0f); }
struct QRaw { u32x4 a[4], b[4]; f32x2 s2; };
template <int ROPE> DEVI void q_issue(QRaw& r, const void* Qv, int ldq, const bf16_t* Qr, const float* ssh, int wid, int r32, int hi) {
    const bf16_t* p = (const bf16_t*)Qv + (size_t)(wid * 32 + r32) * ldq + hi * 32;
#pragma unroll
    for (int c = 0; c < 4; ++c) r.a[c] = *(const u32x4*)(p + 8 * c);
    if (ROPE) { const bf16_t* pr = Qr + (size_t)(wid * 32 + r32) * 512;
#pragma unroll
        for (int c = 0; c < 4; ++c) r.b[c] = *(const u32x4*)(pr + 8 * c);
        r.s2 = *(const f32x2*)(ssh + (size_t)(wid * 32 + r32) * 32); } }
template <int ROPE> DEVI void q_convert(const QRaw& r, int hi, v6u& qf, v6u& qrf) {
    if (!ROPE) { qf = q_cvt(r.a, 1.0f); qrf = qf; }
    else { const float sc = rsqrtf((r.s2[0] + r.s2[1]) * (1.f / 96.f) + EPS) * (C2_MLA * 8.f); qf = q_cvt(r.a, sc); qrf = q_cvt(r.b, hi ? 0.f : sc); } }
struct Dma { const unsigned char* dsrc; size_t dstep; unsigned ddst; int dslot, dlead; bool kwave, dma_on; };
template <int ROPE> DEVI Dma dma_setup(const unsigned char* K, int ldk, const unsigned char* Kr, const unsigned char* V, int ldv, unsigned lds0, int wid, int lane) { Dma d;
    const int role = wid < 2 ? 0 : (wid >= 4 ? 1 : ((ROPE && wid == 2) ? 2 : 3)); d.kwave = role != 1; d.dlead = d.kwave ? 4 : 2;
    const int kkey = 32 * (wid & 1) + (lane >> 1), vkey = 16 * (wid & 3) + (lane >> 2);
    d.dsrc = role == 0 ? K + (size_t)kkey * ldk + 16 * ((lane & 1) ^ ((kkey >> 3) & 1))
           : role == 1 ? V + (size_t)vkey * ldv + 16 * ((lane & 3) ^ (2 * ((vkey >> 3) & 1)))
           : (ROPE ? Kr + (size_t)lane * 16 : K);
    d.dstep = (size_t)KVBLK * (role == 0 ? ldk : (role == 1 ? ldv : 16));
    d.ddst = lds0 + (role == 0 ? LDS_K + (wid & 1) * 1024 : (role == 1 ? LDS_V + (wid & 3) * 1024 : LDS_KR));
    d.dslot = role == 0 ? KSLOT : (role == 1 ? SLOT : KRSLOT); d.dma_on = role != 3; return d; }
#define DMAX(d, t, si) glds16((d).dsrc + (size_t)(t) * (d).dstep, (unsigned)__builtin_amdgcn_readfirstlane((d).ddst + (si) * (d).dslot))
DEVI void dma_head(const Dma& d) { if (d.dma_on) { if (d.kwave) { DMAX(d, 0, 0); DMAX(d, 1, 1); DMAX(d, 2, 2); DMAX(d, 3, 3); } else { DMAX(d, 0, 0); DMAX(d, 1, 1); } } }
template <int ROPE>
DEVI void attn_prefetch(const void* Qv, int ldq, const bf16_t* Qr, const float* ssh, const unsigned char* K, int ldk, const unsigned char* Kr, const unsigned char* V, int ldv, char* lds, v6u& qf, v6u& qrf) {
    int tid_ = threadIdx.x; asm volatile("" : "+v"(tid_));
    const int tid = tid_, lane = tid & 63, r32 = lane & 31, hi = lane >> 5; const int wid = __builtin_amdgcn_readfirstlane(tid >> 6);
    if (ROPE) { if (tid < 16) *(int*)(lds + LDS_KR + (tid >> 2) * KRSLOT + 1024 + (tid & 3) * 4) = 0; }
    const Dma d = dma_setup<ROPE>(K, ldk, Kr, V, ldv, (unsigned)(uintptr_t)lds, wid, lane); dma_head(d);
    QRaw qr; q_issue<ROPE>(qr, Qv, ldq, Qr, ssh, wid, r32, hi); q_convert<ROPE>(qr, hi, qf, qrf); }
template <int ROPE, int PRB = 0>
DEVI void attn_unit(const unsigned char* __restrict__ K, int ldk, const unsigned char* __restrict__ Kr, const unsigned char* __restrict__ V, int ldv, int NT, bf16_t* O, const bf16_t* G, int ldo, char* lds, v6u& qf_io, v6u& qrf_io,
                    bool has_next, const void* Qv_n, int ldq, const bf16_t* Qr_n, const float* ssh_n, const unsigned char* K_n, const unsigned char* Kr_n, const unsigned char* V_n UPROBE_PARAM) {
#ifdef MK_UNIT_PROBE
    const unsigned long long upT0 = __builtin_amdgcn_s_memrealtime();
#endif
    int tid_ = threadIdx.x; asm volatile("" : "+v"(tid_));
    const int tid = tid_, lane = tid & 63, r32 = lane & 31, hi = lane >> 5; const int wid = __builtin_amdgcn_readfirstlane(tid >> 6);
    const unsigned lds0 = (unsigned)(uintptr_t)lds; float* wsf = (float*)(lds + LDS_WS) + wid * 64;
    const Dma dd = dma_setup<ROPE>(K, ldk, Kr, V, ldv, lds0, wid, lane);
    const bool kwave = dd.kwave, dma_on = dd.dma_on; const int dlead = dd.dlead;
#define DMA(t, si) DMAX(dd, t, si)
    const lds_cptr kpa = (lds_cptr)lds + LDS_K + r32 * 32 + ((hi ^ ((r32 >> 3) & 1)) * 16);
    const int vg = (lane >> 4) & 1, vq = (lane & 15) >> 1, vp = lane & 1, vfk = (vq >> 2) & 1;
    const int vrow = (8 * (vq >> 2) + 4 * hi + (vq & 3)) * 64 + 8 * vp + 16 * vg;
    const lds_cptr vp0 = (lds_cptr)lds + LDS_V + vrow + 32 * vfk, vp1 = (lds_cptr)lds + LDS_V + vrow + 32 * (1 - vfk);
    const lds_cptr ra0 = (lds_cptr)lds + LDS_KR + (hi ? 1024 : r32 * 16), ra1 = (lds_cptr)lds + LDS_KR + (hi ? 1024 : 512 + r32 * 16);
    const v6u qf = qf_io, qrf = qrf_io;
    f32x16 o[2]; o[0] = f32x16{}; o[1] = f32x16{}; f32x4 lacc = f32x4{};
    v8i ones;
#pragma unroll
    for (int i = 0; i < 8; ++i) ones[i] = ((lane & 15) == ((lane >> 4) & 1)) ? 0x38383838 : 0;
    PIN(ones);
    f32x16 m4;
    { float y_ = YOFF; asm volatile("" : "+v"(y_));
#pragma unroll
      for (int r = 0; r < 16; ++r) m4[r] = y_; }
    PIN(m4);
    v4i kf0, kf1, krf0, krf1; v8i vf0, vf1, pfA, pfB;
#define ROT() do { } while (0)
#define EX(v) __builtin_amdgcn_exp2f(v)
#define KLOAD(si) do { kf0 = lds128(kpa + (si) * KSLOT); kf1 = lds128(kpa + (si) * KSLOT + 1024); if (ROPE) { krf0 = lds128(ra0 + (si) * KRSLOT); krf1 = lds128(ra1 + (si) * KRSLOT); } } while (0)
    WAIT_BAR0();
    KLOAD(0);
    { f32x16 c0 = QKMFMA(kf0, qf, m4), c1 = QKMFMA(kf1, qf, m4);
      if (ROPE) { c0 = QKMFMA(krf0, qrf, c0); c1 = QKMFMA(krf1, qrf, c1); }
      PK16U8(c0, pfA, 0); PK16U8(c1, pfA, 4); }
    WAIT_BAR0();
    if (dma_on) { if (kwave) { if (4 < NT) DMA(4, 0); } else DMA(2, 2); }
    KLOAD(1);
    WAIT_BAR1();
#define VRD2(m) do { const v2i a_ = vtr8(vp0 + vsl_ * SLOT + (m) * 1024), b_ = vtr8(vp1 + vsl_ * SLOT + (m) * 1024); vf0[2 * (m)] = a_[0]; vf0[2 * (m) + 1] = a_[1]; vf1[2 * (m)] = b_[0]; vf1[2 * (m) + 1] = b_[1]; } while (0)
#define STEP(t, PFP, PFN, GK, GV, GL) do { SBAR(); \
    const int vsl_ = ((t) - 1) & 3; f32x16 C0, C1; \
    if (!(PRB & 1)) { VRD2(0); VRD2(1); } SBAR(); \
    if (!(PRB & 64)) { C0 = QKMFMA(kf0, qf, m4); if (ROPE) C0 = QKMFMA(krf0, qrf, C0); } PIN(C0); SBAR(); \
    if (!(PRB & 1)) { VRD2(2); VRD2(3); } SBAR(); \
    if (!(PRB & 64)) { C1 = QKMFMA(kf1, qf, m4); if (ROPE) C1 = QKMFMA(krf1, qrf, C1); } PIN(C1); SBAR(); \
    if ((GL) && !(PRB & 2)) { KLOAD(((t) + 1) & 3); } \
    { const bool mine_ = dma_on && (kwave ? (GK) : (GV)); if (mine_ && !(PRB & 4)) DMA((t) + dlead, kwave ? ((t) & 3) : (((t) + 2) & 3)); } \
    SBAR(); \
    if (!(PRB & 32)) lacc = SUMMFMA(PFP, ones, lacc); PIN(lacc); SBAR(); \
    if (!(PRB & 16)) { PK16U8(C0, PFN, 0); } PIN(PFN); SBAR(); \
    if (!(PRB & 32)) o[0] = PVMFMA8(PFP, vf0, o[0]); PIN(o[0]); SBAR(); \
    if (!(PRB & 16)) { PK16U8(C1, PFN, 4); } PIN(PFN); SBAR(); \
    if (!(PRB & 32)) o[1] = PVMFMA8(PFP, vf1, o[1]); PIN(o[1]); SBAR(); \
    if (!(PRB & 8)) { const bool mine_ = dma_on && (kwave ? (GK) : (GV)); if (mine_) WAIT_BAR1(); else WAIT_BAR0(); } \
    } while (0)
#ifdef MK_UNIT_PROBE
    const unsigned long long upT1 = __builtin_amdgcn_s_memrealtime();
#endif
    int t = 1;
    for (; t + 5 < NT; t += 2) {
        STEP(t, pfA, pfB, true, true, true);     ROT();
        STEP(t + 1, pfB, pfA, true, true, true); ROT();
    }
    for (; t + 1 < NT; t += 2) {
        STEP(t, pfA, pfB, (t + 4 < NT), (t + 2 < NT), (t + 1 < NT));         ROT();
        STEP(t + 1, pfB, pfA, (t + 5 < NT), (t + 3 < NT), (t + 2 < NT));     ROT();
    }
    STEP(NT - 1, pfA, pfB, false, false, false);
#ifdef MK_UNIT_PROBE
    const unsigned long long upT2 = __builtin_amdgcn_s_memrealtime();
#endif
    if (has_next) { const Dma dn = dma_setup<ROPE>(K_n, ldk, Kr_n, V_n, ldv, lds0, wid, lane); dma_head(dn); }
    u32x4 gv[4];
#pragma unroll
    for (int i = 0; i < 4; ++i) gv[i] = *(const u32x4*)(G + (size_t)(wid * 32 + i * 8 + (lane >> 3)) * ldo + (lane & 7) * 8);
    QRaw qn;
    if (has_next) q_issue<ROPE>(qn, Qv_n, ldq, Qr_n, ssh_n, wid, r32, hi);
    { const int vsl_ = (NT - 1) & 3; VRD2(0); VRD2(1); VRD2(2); VRD2(3);
      lacc = SUMMFMA(pfB, ones, lacc); o[0] = PVMFMA8(pfB, vf0, o[0]); o[1] = PVMFMA8(pfB, vf1, o[1]); }
    float rli[16];
#pragma unroll
    for (int r = 0; r < 16; ++r) rli[r] = 0.f;
    if ((lane & 15) < 2) *(f32x4*)(wsf + (lane & 15) * 16 + 4 * (lane >> 4)) = lacc;
    asm volatile("s_waitcnt lgkmcnt(0)" ::: "memory");
#pragma unroll
    for (int r = 0; r < 16; ++r) rli[r] = __builtin_amdgcn_rcpf(wsf[crow(r, hi)]);
    bf16_t* stg = (bf16_t*)(lds + LDS_OST) + wid * 2048;
#pragma unroll
    for (int r = 0; r < 16; ++r) { const int orow = crow(r, hi);
#pragma unroll
        for (int d0 = 0; d0 < 2; ++d0) stg[orow * 64 + d0 * 32 + r32] = (bf16_t)f2bf(o[d0][r] * rli[r]); }
    asm volatile("s_waitcnt lgkmcnt(0)" ::: "memory");
#pragma unroll
    for (int i = 0; i < 4; ++i) { const int row = i * 8 + (lane >> 3), ch = lane & 7; const size_t goff = (size_t)(wid * 32 + row) * ldo + ch * 8;
        const u32x4 ov = *(const u32x4*)(stg + row * 64 + ch * 8); u32x4 w;
#pragma unroll
        for (int q = 0; q < 4; ++q) { const float lo = __uint_as_float(ov[q] << 16) * __uint_as_float(gv[i][q] << 16), hh = __uint_as_float(ov[q] & 0xffff0000u) * __uint_as_float(gv[i][q] & 0xffff0000u); w[q] = cvtpk(lo, hh); }
        *(u32x4*)(O + goff) = w; }
    if (has_next) q_convert<ROPE>(qn, hi, qf_io, qrf_io);
    asm volatile("s_waitcnt lgkmcnt(0)\n\ts_barrier" ::: "memory");
#ifdef MK_UNIT_PROBE
    { const unsigned long long upT3 = __builtin_amdgcn_s_memrealtime(); const int w_ = MK_UNIT_PROBE & 3; upacc += w_ == 1 ? (upT1 - upT0) : (w_ == 2 ? (upT3 - upT2) : (upT2 - upT1)); }
#endif
#undef DMA
#undef ROT
#undef EX
#undef KLOAD
#undef VRD2
#undef STEP
}

struct Half { const bf16_t* Q; const bf16_t* Qr; const float* ssh; bf16_t* O; const bf16_t* G; };
struct QF2 { v6u a, ra, b, rb; };
template <int ROPE>
DEVI void attn_prefetch2(const Half& lo, const Half& hi_, int ldq, const unsigned char* K, int ldk, const unsigned char* Kr, const unsigned char* V, int ldv, char* lds, QF2& q) {
    int tid_ = threadIdx.x; asm volatile("" : "+v"(tid_));
    const int tid = tid_, lane = tid & 63, r32 = lane & 31, hi = lane >> 5; const int wid = __builtin_amdgcn_readfirstlane(tid >> 6); const int w4 = wid & 3;
    if (ROPE) { if (tid < 16) *(int*)(lds + LDS_KR + (tid >> 2) * KRSLOT + 1024 + (tid & 3) * 4) = 0; }
    const Dma d = dma_setup<ROPE>(K, ldk, Kr, V, ldv, (unsigned)(uintptr_t)lds, wid, lane); dma_head(d);
    const bf16_t* Q = wid < 4 ? lo.Q : hi_.Q; const bf16_t* Qr = wid < 4 ? lo.Qr : hi_.Qr; const float* ssh = wid < 4 ? lo.ssh : hi_.ssh;
    { QRaw r; q_issue<ROPE>(r, Q, ldq, Qr, ssh, 2 * w4, r32, hi); q_convert<ROPE>(r, hi, q.a, q.ra); }
    { QRaw r; q_issue<ROPE>(r, Q, ldq, Qr, ssh, 2 * w4 + 1, r32, hi); q_convert<ROPE>(r, hi, q.b, q.rb); } }

template <int ROPE>
DEVI void attn_unit2(const unsigned char* __restrict__ K, int ldk, const unsigned char* __restrict__ Kr, const unsigned char* __restrict__ V, int ldv, int NT, const Half& lo, const Half& hi_, int ldo, char* lds, QF2& q,
                     bool has_next, const Half& lo_n, const Half& hi_n, int ldq, const unsigned char* K_n, const unsigned char* Kr_n, const unsigned char* V_n) {
    int tid_ = threadIdx.x; asm volatile("" : "+v"(tid_));
    const int tid = tid_, lane = tid & 63, r32 = lane & 31, hi = lane >> 5; const int wid = __builtin_amdgcn_readfirstlane(tid >> 6); const int w4 = wid & 3;
    const unsigned lds0 = (unsigned)(uintptr_t)lds; float* wsf = (float*)(lds + LDS_WS) + wid * 64;
    const Dma dd = dma_setup<ROPE>(K, ldk, Kr, V, ldv, lds0, wid, lane);
    const bool kwave = dd.kwave, dma_on = dd.dma_on; const int dlead = dd.dlead;
#define DMA(t, si) DMAX(dd, t, si)
    const lds_cptr kpa = (lds_cptr)lds + LDS_K + r32 * 32 + ((hi ^ ((r32 >> 3) & 1)) * 16);
    const int vg = (lane >> 4) & 1, vq = (lane & 15) >> 1, vp = lane & 1, vfk = (vq >> 2) & 1;
    const int vrow = (8 * (vq >> 2) + 4 * hi + (vq & 3)) * 64 + 8 * vp + 16 * vg;
    const lds_cptr vp0 = (lds_cptr)lds + LDS_V + vrow + 32 * vfk, vp1 = (lds_cptr)lds + LDS_V + vrow + 32 * (1 - vfk);
    const lds_cptr ra0 = (lds_cptr)lds + LDS_KR + (hi ? 1024 : r32 * 16), ra1 = (lds_cptr)lds + LDS_KR + (hi ? 1024 : 512 + r32 * 16);
    const v6u qfA = q.a, qrA = q.ra, qfB = q.b, qrB = q.rb;
    f32x16 oA[2], oB[2]; oA[0] = f32x16{}; oA[1] = f32x16{}; oB[0] = f32x16{}; oB[1] = f32x16{}; f32x4 laccA = f32x4{}, laccB = f32x4{};
    v8i ones;
#pragma unroll
    for (int i = 0; i < 8; ++i) ones[i] = ((lane & 15) == ((lane >> 4) & 1)) ? 0x38383838 : 0;
    PIN(ones);
    f32x16 m4;
    { float y_ = YOFF; asm volatile("" : "+v"(y_));
#pragma unroll
      for (int r = 0; r < 16; ++r) m4[r] = y_; }
    PIN(m4);
    v4i kf0, kf1, krf0, krf1; v8i vf0, vf1, PFA, PFB; f32x16 C0, C1;
#define KLOAD(si) do { kf0 = lds128(kpa + (si) * KSLOT); kf1 = lds128(kpa + (si) * KSLOT + 1024); if (ROPE) { krf0 = lds128(ra0 + (si) * KRSLOT); krf1 = lds128(ra1 + (si) * KRSLOT); } } while (0)
#define QK2(QF, QR) do { C0 = QKMFMA(kf0, QF, m4); if (ROPE) C0 = QKMFMA(krf0, QR, C0); PIN(C0); SBAR(); C1 = QKMFMA(kf1, QF, m4); if (ROPE) C1 = QKMFMA(krf1, QR, C1); PIN(C1); SBAR(); } while (0)
#define VRD2(m) do { const v2i a_ = vtr8(vp0 + vsl_ * SLOT + (m) * 1024), b_ = vtr8(vp1 + vsl_ * SLOT + (m) * 1024); vf0[2 * (m)] = a_[0]; vf0[2 * (m) + 1] = a_[1]; vf1[2 * (m)] = b_[0]; vf1[2 * (m) + 1] = b_[1]; } while (0)
#define PVB(PF, L, O) do { L = SUMMFMA(PF, ones, L); PIN(L); SBAR(); O[0] = PVMFMA8(PF, vf0, O[0]); PIN(O[0]); SBAR(); O[1] = PVMFMA8(PF, vf1, O[1]); PIN(O[1]); SBAR(); } while (0)
    WAIT_BAR0();
    KLOAD(0);
    QK2(qfA, qrA); PK16U8(C0, PFA, 0); PK16U8(C1, PFA, 4); PIN(PFA); SBAR();
    QK2(qfB, qrB); PK16U8(C0, PFB, 0); PK16U8(C1, PFB, 4); PIN(PFB); SBAR();
    WAIT_BAR0();
    if (dma_on) { if (kwave) { if (4 < NT) DMA(4, 0); } else DMA(2, 2); }
    KLOAD(1);
    WAIT_BAR1();
#define STEP2(t, GK, GV, GL) do { SBAR(); \
    const int vsl_ = ((t) - 1) & 3; \
    VRD2(0); VRD2(1); VRD2(2); VRD2(3); SBAR(); \
    QK2(qfA, qrA); \
    PVB(PFA, laccA, oA); \
    PK16U8(C0, PFA, 0); PK16U8(C1, PFA, 4); PIN(PFA); SBAR(); \
    QK2(qfB, qrB); \
    if (GL) { KLOAD(((t) + 1) & 3); } \
    { const bool mine_ = dma_on && (kwave ? (GK) : (GV)); if (mine_) DMA((t) + dlead, kwave ? ((t) & 3) : (((t) + 2) & 3)); } \
    SBAR(); \
    PVB(PFB, laccB, oB); \
    PK16U8(C0, PFB, 0); PK16U8(C1, PFB, 4); PIN(PFB); SBAR(); \
    { const bool mine_ = dma_on && (kwave ? (GK) : (GV)); if (mine_) WAIT_BAR1(); else WAIT_BAR0(); } \
    } while (0)
    int t = 1;
    for (; t + 4 < NT; ++t) STEP2(t, true, true, true);
    for (; t < NT; ++t) STEP2(t, (t + 4 < NT), (t + 2 < NT), (t + 1 < NT));
    if (has_next) { const Dma dn = dma_setup<ROPE>(K_n, ldk, Kr_n, V_n, ldv, lds0, wid, lane); dma_head(dn); }
    { const int vsl_ = (NT - 1) & 3; VRD2(0); VRD2(1); VRD2(2); VRD2(3); PVB(PFA, laccA, oA); PVB(PFB, laccB, oB); }
    const bf16_t* Gp = (wid < 4 ? lo.G : hi_.G) + (size_t)(w4 * 64) * ldo; bf16_t* Op = (wid < 4 ? lo.O : hi_.O) + (size_t)(w4 * 64) * ldo;
    u32x4 gv[2][4];
#pragma unroll
    for (int b = 0; b < 2; ++b)
#pragma unroll
        for (int i = 0; i < 4; ++i) gv[b][i] = *(const u32x4*)(Gp + (size_t)(b * 32 + i * 8 + (lane >> 3)) * ldo + (lane & 7) * 8);
    QRaw qnA, qnB;
    if (has_next) { const bf16_t* Q = wid < 4 ? lo_n.Q : hi_n.Q; const bf16_t* Qr = wid < 4 ? lo_n.Qr : hi_n.Qr; const float* ssh = wid < 4 ? lo_n.ssh : hi_n.ssh;
        q_issue<ROPE>(qnA, Q, ldq, Qr, ssh, 2 * w4, r32, hi); q_issue<ROPE>(qnB, Q, ldq, Qr, ssh, 2 * w4 + 1, r32, hi); }
    if ((lane & 15) < 2) { *(f32x4*)(wsf + (lane & 15) * 16 + 4 * (lane >> 4)) = laccA; *(f32x4*)(wsf + 32 + (lane & 15) * 16 + 4 * (lane >> 4)) = laccB; }
    asm volatile("s_waitcnt lgkmcnt(0)" ::: "memory");
    bf16_t* stg = (bf16_t*)(lds + LDS_OST) + wid * 2048;
#pragma unroll
    for (int b = 0; b < 2; ++b) {
#pragma unroll
        for (int r = 0; r < 16; ++r) { const int orow = crow(r, hi); const float rl = __builtin_amdgcn_rcpf(wsf[b * 32 + orow]);
#pragma unroll
            for (int d0 = 0; d0 < 2; ++d0) stg[orow * 64 + d0 * 32 + r32] = (bf16_t)f2bf((b ? oB[d0][r] : oA[d0][r]) * rl); }
        asm volatile("s_waitcnt lgkmcnt(0)" ::: "memory");
#pragma unroll
        for (int i = 0; i < 4; ++i) { const int row = i * 8 + (lane >> 3), ch = lane & 7; const size_t goff = (size_t)(b * 32 + row) * ldo + ch * 8;
            const u32x4 ov = *(const u32x4*)(stg + row * 64 + ch * 8); u32x4 w;
#pragma unroll
            for (int k = 0; k < 4; ++k) { const float l_ = __uint_as_float(ov[k] << 16) * __uint_as_float(gv[b][i][k] << 16), h_ = __uint_as_float(ov[k] & 0xffff0000u) * __uint_as_float(gv[b][i][k] & 0xffff0000u); w[k] = cvtpk(l_, h_); }
            *(u32x4*)(Op + goff) = w; }
        asm volatile("s_waitcnt lgkmcnt(0)" ::: "memory"); }
    if (has_next) { q_convert<ROPE>(qnA, hi, q.a, q.ra); q_convert<ROPE>(qnB, hi, q.b, q.rb); }
    asm volatile("s_waitcnt lgkmcnt(0)\n\ts_barrier" ::: "memory");
#undef DMA
#undef KLOAD
#undef QK2
#undef VRD2
#undef PVB
#undef STEP2
}
#undef SBAR
#undef PIN
#undef WAIT_BAR0
#undef WAIT_BAR1
#undef QKMFMA
#undef DMAX
#undef SUMMFMA
#undef V8
#undef V6
#undef PVMFMA8
}

#define RLX_AGENT __ATOMIC_RELAXED, __HIP_MEMORY_SCOPE_AGENT
#define XB_TMO      128
#define XB_XCNT(j)  (256  + 64 * (j))
#define XB_XSUB(j)  (1280 + 64 * (j))
#define XB_XGEN(j)  (2304 + 64 * (j))
#define XB_TOP      3328
#define XB_TOPGEN   3392
#define XCD_BAR_WORDS 3456
#define XB_SPIN_CAP (1u << 18)

__device__ __forceinline__ unsigned xb_ld(unsigned* p)              { return __hip_atomic_load(p, __ATOMIC_RELAXED, __HIP_MEMORY_SCOPE_AGENT); }
__device__ __forceinline__ unsigned xb_add(unsigned* p, unsigned v) { return __hip_atomic_fetch_add(p, v, __ATOMIC_RELAXED, __HIP_MEMORY_SCOPE_AGENT); }
__device__ __forceinline__ unsigned xb_xcc_id() { return (unsigned)__builtin_amdgcn_s_getreg((3 << 11) | 20) & 0xFu; }
#define XB_SPIN(cond, bar) do { unsigned _sp = 0; while (cond) { __builtin_amdgcn_s_sleep(1); \
    if ((++_sp & 255u) == 0u) { if (xb_ld(&(bar)[XB_TMO])) break; if (_sp > XB_SPIN_CAP) { atomicAdd(&(bar)[XB_TMO], 1u); break; } } } } while (0)

struct XcdBarrier {
    unsigned* bar; unsigned x;
    volatile LAS unsigned* st;
};

__device__ __forceinline__ XcdBarrier xcd_barrier_post(unsigned* bar, volatile LAS unsigned* st) {
    XcdBarrier b; b.bar = bar; b.x = xb_xcc_id(); b.st = st;
    if (threadIdx.x == 0) (void)xb_add(&bar[XB_XCNT(b.x)], 1u);
    return b;
}
__device__ __forceinline__ void xcd_barrier_complete(unsigned* bar, unsigned x, unsigned& nloc, unsigned& nx) {
    const unsigned G = gridDim.x * gridDim.y * gridDim.z;
    unsigned sum, cnt, mine, sp = 0u;
    for (;;) {
        sum = 0u; cnt = 0u; mine = 0u;
#pragma unroll
        for (unsigned j = 0; j < 16; ++j) { const unsigned c = xb_ld(&bar[XB_XCNT(j)]); sum += c; cnt += (c > 0u) ? 1u : 0u; mine = (j == x) ? c : mine; }
        if (sum == G) break;
        __builtin_amdgcn_s_sleep(1);
        if ((++sp & 255u) == 0u) { if (xb_ld(&bar[XB_TMO])) break; if (sp > XB_SPIN_CAP) { atomicAdd(&bar[XB_TMO], 1u); break; } }
    }
    nloc = mine > 0u ? mine : 1u; nx = cnt > 0u ? cnt : 1u;
}

__device__ __forceinline__ void xcd_barrier(const XcdBarrier& b) {
    asm volatile("s_waitcnt vmcnt(0)" ::: "memory");
    __syncthreads();
    if (threadIdx.x == 0) {
        unsigned* bar = b.bar;
        __builtin_amdgcn_s_waitcnt(0);
        unsigned nloc = b.st[0], nx = b.st[1];
        if (nloc == 0u) { xcd_barrier_complete(bar, b.x, nloc, nx); b.st[0] = nloc; b.st[1] = nx; }
        const unsigned old = xb_add(&bar[XB_XSUB(b.x)], 1u);
        const unsigned gen = old / nloc;
        if (old + 1u == (gen + 1u) * nloc) {
            __builtin_amdgcn_fence(__ATOMIC_RELEASE, "agent");
            asm volatile("s_waitcnt vmcnt(0)" ::: "memory");
            const unsigned og = xb_add(&bar[XB_TOP], 1u);
            const unsigned tg = og / nx;
            if (og + 1u == (tg + 1u) * nx) xb_add(&bar[XB_TOPGEN], 1u);
            else XB_SPIN(xb_ld(&bar[XB_TOPGEN]) == tg, bar);
            __builtin_amdgcn_fence(__ATOMIC_ACQUIRE, "agent");
            xb_add(&bar[XB_XGEN(b.x)], 1u);
            asm volatile("s_waitcnt vmcnt(0)" ::: "memory");
        } else {
            XB_SPIN(xb_ld(&bar[XB_XGEN(b.x)]) == gen, bar);
            __builtin_amdgcn_fence(__ATOMIC_ACQUIRE, "agent");
            asm volatile("s_waitcnt vmcnt(0)" ::: "memory");
        }
    }
    __syncthreads();
}


#include <hip/hip_cooperative_groups.h>
namespace cg = cooperative_groups;
constexpr int NWAVES = 8, NTHREADS = 512, LDS_BYTES = 147456, RING_BYTES = 131072;
constexpr size_t MiB = 1u << 20;
constexpr size_t WS_MOD = 1 * MiB;
constexpr size_t WS_TABA = WS_MOD + 128 * 1024;
constexpr size_t WS_TABB = WS_TABA + 32 * 1024;
constexpr size_t WS_WIN0 = 2 * MiB;
constexpr size_t WS_WOUT0 = 7 * MiB;
constexpr size_t WS_WIN1 = 9 * MiB;
constexpr size_t WS_WKVB = 13 * MiB;
constexpr size_t WS_WQB = 14 * MiB;
constexpr size_t WS_WOUT1 = 16 * MiB;
constexpr size_t WS_X1C = 18 * MiB;
constexpr size_t WS_H = 20 * MiB;
constexpr size_t WS_Q = 53 * MiB;
constexpr size_t WS_K = 86 * MiB;
constexpr size_t WS_V0 = 95 * MiB;
constexpr size_t WS_G = 120 * MiB;
constexpr size_t WS_V1 = 153 * MiB;
constexpr size_t WS_KVA = 186 * MiB;
constexpr size_t WS_QA = 195 * MiB;
constexpr size_t WS_Q1R = 207 * MiB;
constexpr size_t WS_KR = 223 * MiB;
constexpr size_t WS_SSKV = 225 * MiB;
constexpr size_t WS_SSQ = 226 * MiB;
constexpr size_t WS_SSH = 227 * MiB;
constexpr size_t WS_SSX = 229 * MiB;
constexpr size_t WS_BIAS1 = WS_MOD + 80 * 1024;
constexpr size_t WS_NWM1 = WS_MOD + 104 * 1024;
constexpr size_t WS_RINV = 230 * MiB + 512 * 1024;
constexpr size_t WS_SLAB = 231 * MiB;
constexpr size_t WS_END = 256 * MiB;
static_assert(WS_K + (size_t)NB * TK * DM * 2 <= WS_G && WS_G + (size_t)MT * DM * 2 <= WS_V1 && WS_V1 + (size_t)NB * TK * DM * 2 <= WS_KVA && WS_SSH + (size_t)ML * 32 * 4 <= WS_END, "ws map");

#ifndef ATT1_F8
#define ATT1_F8 1
#endif
#ifndef ATT_X2
#define ATT_X2 1
#endif
#ifndef ATT0_F8
#define ATT0_F8 1
#endif
struct Args { const float* in[23]; float* out; unsigned char* ws; int ph_lo, ph_hi, coop, pad; };

DEVI void phase0(const Args& a, unsigned char* ws, LAS unsigned char* lds, int vb, int G) {
    const int tid = threadIdx.x, wave = tid >> 6, lane = tid & 63;
    float* mod = (float*)(ws + WS_MOD);
    if (vb < 96) {
        LAS float* sc = (LAS float*)lds; LAS float* red = sc + 3 * 1024;
        const int layer = vb / 48, cs = vb % 48; const float* w = a.in[layer ? 11 : 4]; const float* bb = a.in[layer ? 12 : 5];
        for (int i = tid; i < 3072; i += NTHREADS) { const int r = i >> 10, k = i & 1023; const float v = r < 2 ? a.in[1][r * 1024 + k] : a.in[3][k]; sc[i] = v / (1.f + expf(-v)); }
        __syncthreads();
        const int col = cs * 64 + lane; float a0 = 0.f, a1 = 0.f, a2 = 0.f;
#pragma unroll 8
        for (int k = wave * 128; k < wave * 128 + 128; ++k) { const float wv = w[(size_t)k * 3072 + col]; a0 += sc[k] * wv; a1 += sc[1024 + k] * wv; a2 += sc[2048 + k] * wv; }
        red[(wave * 3 + 0) * 64 + lane] = a0; red[(wave * 3 + 1) * 64 + lane] = a1; red[(wave * 3 + 2) * 64 + lane] = a2;
        __syncthreads();
        if (tid < 192) { const int r = tid >> 6; float s = 0.f;
#pragma unroll
            for (int q = 0; q < 8; ++q) s += red[(q * 3 + r) * 64 + lane];
            mod[(size_t)(layer * 3 + r) * 3072 + col] = s + bb[col]; }
        __syncthreads();
    } else if (vb < 102) {
        f32x2* tabA = (f32x2*)(ws + WS_TABA); f32x2* tabB = (f32x2*)(ws + WS_TABB);
        const int i = (vb - 96) * NTHREADS + tid;
        if (i < 128 * 16) { const int pos = i >> 4, f = i & 15; const float invf = powf(10000.f, -(float)f / 16.f); float cs_, sn_; sincos_pos((float)pos * invf, cs_, sn_); tabA[i] = (f32x2){cs_, sn_}; }
        else if (i < 128 * 24) { const int j = i - 128 * 16, pos = j >> 3, f = j & 7; const float invf = powf(10000.f, -(float)f / 8.f); float cs_, sn_; sincos_pos((float)pos * invf, cs_, sn_); tabB[j] = (f32x2){cs_, sn_}; }
    }
    if (vb < 102 || G <= 102) { if (G > 102) return; }
    struct WD { int src, K, Nsrc, Np, mode, ks; size_t dst; };
    const WD wd[6] = {{7, 1024, N_IN0, 2560, 1, -1, WS_WIN0}, {10, 1024, 1024, 1024, 0, -1, WS_WOUT0}, {14, 1024, N_IN1, N_IN1P, 2, -1, WS_WIN1},
                      {16, 256, 2048, 2048, 3, 15, WS_WKVB}, {18, 384, 1536, 2048, 4, 17, WS_WQB}, {22, 1024, 1024, 1024, 0, -1, WS_WOUT1}};
    LAS float* tl = (LAS float*)lds; int tbase = 0;
#pragma unroll
    for (int m = 0; m < 6; ++m) {
        const float* W = a.in[wd[m].src]; const float* ks = wd[m].ks >= 0 ? a.in[wd[m].ks] : nullptr; bf16_t* Bt = (bf16_t*)(ws + wd[m].dst);
        const int K = wd[m].K, Nsrc = wd[m].Nsrc, Np = wd[m].Np, npb = Np / 256, ntile = (K / 64) * npb;
        for (int it = ((vb - 102) - tbase % (G - 102) + (G - 102)) % (G - 102); it < ntile; it += (G - 102)) {
            const int kb = it / npb, pb = it % npb, k0 = 64 * kb, p0 = 256 * pb;
            const int pl = tid & 255, kh = tid >> 8; int cc = pg8::wmap(wd[m].mode, p0 + pl); if (cc >= Nsrc) cc = -1;
            float v[32];
#pragma unroll
            for (int i = 0; i < 32; ++i) { const int k = k0 + 2 * i + kh; v[i] = cc >= 0 ? W[(size_t)k * Nsrc + cc] * (ks ? ks[k] : 1.f) : 0.f; }
#pragma unroll
            for (int i = 0; i < 32; ++i) tl[pl * 65 + 2 * i + kh] = v[i];
            __syncthreads();
#pragma unroll
            for (int j = 0; j < 4; ++j) { const int q = tid + 512 * j, pr = q >> 3, c = q & 7; const LAS float* sp = tl + pr * 65 + 8 * c;
                u32x4 o; o.x = pk2(sp[0], sp[1]); o.y = pk2(sp[2], sp[3]); o.z = pk2(sp[4], sp[5]); o.w = pk2(sp[6], sp[7]);
                *(u32x4*)(Bt + (size_t)(p0 + pr) * K + k0 + 8 * c) = o; }
            __syncthreads();
        }
        tbase += ntile;
    }
}

DEVI void phase_prep(const float* xa, const float* xb, const float* nw, const float* mod, bf16_t* H, int gw, int NGW, int lane) {
    for (int row0 = gw; row0 < MT; row0 += 4 * NGW) {
        f32x4 v[4][4]; float ss[4];
#pragma unroll
        for (int q = 0; q < 4; ++q) { const int row = row0 + q * NGW; ss[q] = 0.f;
            if (row < MT) { const float* src = row < ML ? xa + (size_t)row * DM : xb + (size_t)(row - ML) * DM;
#pragma unroll
                for (int j = 0; j < 4; ++j) v[q][j] = *(const f32x4*)(src + 4 * lane + 256 * j); } }
#pragma unroll
        for (int q = 0; q < 4; ++q) { const int row = row0 + q * NGW;
            if (row < MT) {
#pragma unroll
                for (int j = 0; j < 4; ++j) ss[q] += (v[q][j].x * v[q][j].x + v[q][j].y * v[q][j].y) + (v[q][j].z * v[q][j].z + v[q][j].w * v[q][j].w); } }
#pragma unroll
        for (int o = 1; o < 64; o <<= 1) {
#pragma unroll
            for (int q = 0; q < 4; ++q) ss[q] += __shfl_xor(ss[q], o); }
#pragma unroll
        for (int q = 0; q < 4; ++q) { const int row = row0 + q * NGW;
            if (row < MT) { const int r = row < SEQ ? 0 : (row < ML ? 1 : 2); const float rinv = rsqrtf(ss[q] * (1.f / DM) + EPS);
#pragma unroll
                for (int j = 0; j < 4; ++j) { const int cidx = 4 * lane + 256 * j; const f32x4 w = *(const f32x4*)(nw + cidx);
                    const f32x4 sh = *(const f32x4*)(mod + (size_t)r * 3072 + cidx), scl = *(const f32x4*)(mod + (size_t)r * 3072 + 1024 + cidx);
                    const f32x4 h = (v[q][j] * rinv) * w * (scl + 1.f) + sh;
                    u32x2 o; o.x = pk2(h.x, h.y); o.y = pk2(h.z, h.w); *(u32x2*)(H + (size_t)row * DM + cidx) = o; } } }
    }
}

DEVI float sq4f(const f32x4 v) { return (v[0] * v[0] + v[1] * v[1]) + (v[2] * v[2] + v[3] * v[3]); }
DEVI void phase1_extras(const float* nw1, const float* mod1, const bf16_t* Win1t, float* nwm1, float* bias1, const float* ctx, float* X1c, int gw, int NGW, int lane) {
    for (int p = gw; p < N_IN1P; p += NGW) {
        const u32x4 w0 = *(const u32x4*)(Win1t + (size_t)p * DM + lane * 16), w1 = *(const u32x4*)(Win1t + (size_t)p * DM + lane * 16 + 8); float acc3[3];
#pragma unroll
        for (int r = 0; r < 3; ++r) { const float* mp = mod1 + (size_t)r * 3072 + lane * 16; const f32x4 m0 = *(const f32x4*)mp, m1 = *(const f32x4*)(mp + 4), m2 = *(const f32x4*)(mp + 8), m3 = *(const f32x4*)(mp + 12);
            const float mm[16] = {m0[0], m0[1], m0[2], m0[3], m1[0], m1[1], m1[2], m1[3], m2[0], m2[1], m2[2], m2[3], m3[0], m3[1], m3[2], m3[3]}; float a = 0.f;
#pragma unroll
            for (int i = 0; i < 8; ++i) { const unsigned ww = i < 4 ? w0[i] : w1[i - 4]; a += mm[2 * i] * __uint_as_float(ww << 16) + mm[2 * i + 1] * __uint_as_float(ww & 0xffff0000u); }
            acc3[r] = wave_sum(a); }
        if (lane == 0) { bias1[p] = acc3[0]; bias1[N_IN1P + p] = acc3[1]; bias1[2 * N_IN1P + p] = acc3[2]; }
    }
    for (int i = gw * 64 + lane; i < 3 * DM; i += NGW * 64) { const int r = i >> 10, c = i & 1023; nwm1[i] = nw1[c] * (1.f + mod1[(size_t)r * 3072 + 1024 + c]); }
}
DEVI void phase_ctxprep(const float* ctx, const float* slab, const float* gatec, float* X1c, const float* nwm1, bf16_t* H, const float* SSX, float* RINV, int gw, int NGW, int lane) {
    for (int rr = gw; rr < MC; rr += NGW) { const int R = ML + rr; float ss = 0.f;
#pragma unroll
        for (int j = 0; j < 4; ++j) { const int c = 4 * lane + 256 * j; f32x4 y = *(const f32x4*)(slab + (size_t)rr * DM + c);
#pragma unroll
            for (int ks = 1; ks < 8; ++ks) y = y + *(const f32x4*)(slab + ((size_t)ks * MC + rr) * DM + c);
            const f32x4 v = *(const f32x4*)(ctx + (size_t)rr * DM + c) + *(const f32x4*)(gatec + c) * y; *(f32x4*)(X1c + (size_t)rr * DM + c) = v;
            ss += sq4f(v); const f32x4 h = v * *(const f32x4*)(nwm1 + 2 * DM + c);
            u32x2 o; o.x = pk2(h.x, h.y); o.y = pk2(h.z, h.w); *(u32x2*)(H + (size_t)R * DM + c) = o; }
        ss = wave_sum(ss); if (lane == 0) RINV[R] = rsqrtf(ss * (1.f / DM) + EPS); }
    for (int R = gw * 64 + lane; R < ML; R += NGW * 64) { const f32x4 s0 = *(const f32x4*)(SSX + (size_t)R * 16), s1 = *(const f32x4*)(SSX + (size_t)R * 16 + 4), s2 = *(const f32x4*)(SSX + (size_t)R * 16 + 8), s3 = *(const f32x4*)(SSX + (size_t)R * 16 + 12);
        const f32x4 st = (s0 + s1) + (s2 + s3); RINV[R] = rsqrtf(((st[0] + st[1]) + (st[2] + st[3])) * (1.f / DM) + EPS); }
}

#ifdef MK_UBENCH
DEVI void ubench(int wave) {
    typedef int v8i __attribute__((ext_vector_type(8)));
    if ((MK_UBENCH & 4) && wave >= 4) return;
    v8i a, b; f32x16 acc = f32x16{}; float e[8]; float d = 0.f;
#pragma unroll
    for (int i = 0; i < 8; ++i) { a[i] = 0x38383838; b[i] = 0x38383838; e[i] = 0.001f * (float)(i + 1); }
    asm volatile("" : "+v"(a), "+v"(b));
    bf16x8 ha, hb; asm volatile("" : "=v"(ha), "=v"(hb));
    for (int it = 0; it < 1500; ++it) {
        if (MK_UBENCH & 1) { if (MK_UBENCH & 16) { acc = __builtin_amdgcn_mfma_f32_32x32x16_bf16(ha, hb, acc, 0, 0, 0); acc = __builtin_amdgcn_mfma_f32_32x32x16_bf16(ha, hb, acc, 0, 0, 0); }
                             else if (MK_UBENCH & 32) acc = __builtin_amdgcn_mfma_scale_f32_32x32x64_f8f6f4(a, b, acc, 4, 2, 0, 127, 0, 127);
                             else if (MK_UBENCH & 64) acc = __builtin_amdgcn_mfma_scale_f32_32x32x64_f8f6f4(a, b, acc, 4, 4, 0, 127, 0, 127);
                             else acc = __builtin_amdgcn_mfma_scale_f32_32x32x64_f8f6f4(a, b, acc, 0, 0, 0, 127, 0, 127); }
        if (MK_UBENCH & 2) {
#pragma unroll
            for (int i = 0; i < 8; ++i) e[i] = __builtin_amdgcn_exp2f(e[i]) * 0.5f; }
        if (MK_UBENCH & 8) {
#pragma unroll
            for (int i = 0; i < 16; ++i) asm volatile("v_add_f32 %0, %0, %1" : "+v"(e[i & 7]) : "v"(d)); }
        asm volatile("" : "+v"(acc)); __builtin_amdgcn_sched_barrier(0);
    }
#pragma unroll
    for (int i = 0; i < 8; ++i) asm volatile("" :: "v"(e[i]));
    asm volatile("" :: "v"(acc));
}
#endif
__global__ void __launch_bounds__(NTHREADS, 2) mega(Args a) {
    extern __shared__ __attribute__((aligned(16))) unsigned char lds[];
    const int tid = threadIdx.x, lane = tid & 63; const int wave = __builtin_amdgcn_readfirstlane(tid >> 6);
    const int G = gridDim.x, bx = blockIdx.x; const int vcu = (G % 8 == 0) ? (bx % 8) * (G / 8) + bx / 8 : bx;
    unsigned char* ws = a.ws; float* out = a.out;
    const float* x = a.in[0]; const float* ctx = a.in[2];
    float* mod = (float*)(ws + WS_MOD); const f32x4* tabA = (const f32x4*)(ws + WS_TABA); const f32x4* tabB = (const f32x4*)(ws + WS_TABB);
    bf16_t* H = (bf16_t*)(ws + WS_H); bf16_t* Qb = (bf16_t*)(ws + WS_Q); bf16_t* K0 = (bf16_t*)(ws + WS_K); bf16_t* V0 = (bf16_t*)(ws + WS_V0); bf16_t* K1 = (bf16_t*)(ws + WS_K);
    bf16_t* Gb = (bf16_t*)(ws + WS_G); bf16_t* V1 = (bf16_t*)(ws + WS_V1); bf16_t* KVA = (bf16_t*)(ws + WS_KVA); bf16_t* QA = (bf16_t*)(ws + WS_QA); bf16_t* Q1R = (bf16_t*)(ws + WS_Q1R);
    bf16_t* O0 = (bf16_t*)(ws + WS_V1); bf16_t* O1 = (bf16_t*)(ws + WS_H); bf16_t* KR = (bf16_t*)(ws + WS_KR); float* SSKV = (float*)(ws + WS_SSKV); float* SSQ = (float*)(ws + WS_SSQ); float* SSH = (float*)(ws + WS_SSH); float* X1c = (float*)(ws + WS_X1C); float* SSX = (float*)(ws + WS_SSX); float* BIAS1 = (float*)(ws + WS_BIAS1); float* NWM1 = (float*)(ws + WS_NWM1);
#ifdef MK_TS
#define MK_TS_SEAM (MK_TS >= 100 ? (MK_TS % 100) : MK_TS / 2)
#define MK_TS_WHAT (MK_TS % 2)
#endif
#ifdef MK_TS_SEAM
    const unsigned long long ts0 = __builtin_amdgcn_s_memrealtime(); unsigned long long ts1 = ts0, ts2 = ts0;
#endif
    const int lo = a.ph_lo, hi_ = a.ph_hi;
#ifndef ONLY_PHASE
#define ONLY_PHASE -1
#endif
#define IN(k) ((ONLY_PHASE < 0 || ONLY_PHASE == (k)) && lo <= (k) && (k) < hi_)
#ifndef MK_REP_MASK
#define MK_REP_MASK 0
#endif
#define REPS(k) (((MK_REP_MASK >> (k)) & 1) ? 2 : 1)
#ifdef MK_TS_SEAM
#define SEAM(k) do { if (IN(k) && IN((k) + 1)) { if ((k) == MK_TS_SEAM) { ts1 = __builtin_amdgcn_s_memrealtime(); if (tid == 0) { atomicMax((unsigned*)ws + 4000, (unsigned)(ts1 - ts0)); atomicMax((unsigned*)ws + 4001, ((unsigned)(ts1 - ts0) << 10) | (unsigned)bx); } } xcd_barrier(xbar); if ((k) == MK_TS_SEAM) ts2 = __builtin_amdgcn_s_memrealtime(); } } while (0)
#else
#define SEAM(k) do { if (IN(k) && IN((k) + 1)) { xcd_barrier(xbar); } } while (0)
#endif
    PG8_LAS unsigned char* ring = (PG8_LAS unsigned char*)lds;
    volatile LAS unsigned* xst = (volatile LAS unsigned*)((LAS unsigned char*)lds + RING_BYTES + 512);
    if (tid < 4) xst[tid] = 0u;
    __syncthreads();
    XcdBarrier xbar; xbar.bar = (unsigned*)ws; xbar.x = 0; xbar.st = xst;
    if (a.coop) xbar = xcd_barrier_post((unsigned*)ws, xst);
    if (a.coop == 0x7fffffff) cg::this_grid().sync();

    if (IN(0)) for (int rep_ = 0; rep_ < REPS(0); ++rep_) { phase0(a, ws, (LAS unsigned char*)lds, bx, G); } SEAM(0);
    if (IN(1)) for (int rep_ = 0; rep_ < REPS(1); ++rep_) { phase1_extras(a.in[13], mod + 3 * 3072, (const bf16_t*)(ws + WS_WIN1), NWM1, BIAS1, ctx, X1c, vcu * NWAVES + wave, G * NWAVES, lane);
        phase_prep(x, ctx, a.in[6], mod, H, vcu * NWAVES + wave, G * NWAVES, lane); } SEAM(1);
    if (IN(2)) { pg8::Gemm g{H, (const bf16_t*)(ws + WS_WIN0), MT, N_IN0, 1024}; pg8::ROrder S; S.init(0, MT / 256, N_IN0, G, bx, REPS(2));
        pg8::EpiIn0<ATT0_F8> E{a.in[8], a.in[9], tabA, K0, V0, Qb, Gb};
        pg8::gemm_phase<pg8::EpiIn0<ATT0_F8>, pg8::ROrder, true, true>(ring, g, S, E); } SEAM(2);
#ifdef MK_UNIT_PROBE
    unsigned long long upacc = 0, updummy = 0;
#define UPROBE_ARG3 , *((MK_UNIT_PROBE & 48) == 0 ? &upacc : &updummy)
#define UPROBE_ARGC , *((MK_UNIT_PROBE & 48) == 32 ? &upacc : &updummy)
#define UPROBE_ARG8 , *((MK_UNIT_PROBE & 48) == 16 ? &upacc : &updummy)
#else
#define UPROBE_ARG3
#define UPROBE_ARGC
#define UPROBE_ARG8
#endif
#ifdef MK_CLOCK_PROBE
    unsigned long long pc0 = 0, pr0 = 0, pc1 = 0, pr1 = 0;
    if (IN(3)) { pc0 = __builtin_readcyclecounter(); pr0 = __builtin_amdgcn_s_memrealtime(); }
#endif
    if (IN(3)) for (int rep_ = 0; rep_ < REPS(3); ++rep_) {
        const int xg = vcu >> 5, c = vcu & 31, b = xg >> 2, kvh = xg & 3; const size_t kbase = (size_t)b * TK * 256 + kvh * 64;
#ifdef MK_PROBE_NT
        const int NT3 = (rep_ + 1 < REPS(3)) ? MK_PROBE_NT : TK / 64;
#else
        const int NT3 = TK / 64;
#endif
#if ATT0_F8
        const unsigned char* K8 = (const unsigned char*)K0 + (size_t)b * TK * 128 + kvh * 32; const unsigned char* V8 = (const unsigned char*)V0 + kbase;
#if ATT_X2
        { const int chunk = c & 15, hp = c >> 4;
          auto half = [&](size_t q0) { return af8::Half{Qb + q0, nullptr, nullptr, O0 + q0, Gb + q0}; };
          const size_t qa = ((size_t)b * SEQ + chunk * 512) * DM + (kvh * 4 + hp) * 64, qb2 = qa + 128, qc = ((size_t)ML + b * CTXL) * DM + (kvh * 4 + 2 * c) * 64;
          const af8::Half a0 = half(qa), a1 = half(qa + (size_t)256 * DM), b0 = half(qb2), b1 = half(qb2 + (size_t)256 * DM), c0 = half(qc), c1 = half(qc + 64);
          af8::QF2 q;
          af8::attn_prefetch2<0>(a0, a1, DM, K8, 128, nullptr, V8, 256, (char*)lds, q);
          af8::attn_unit2<0>(K8, 128, nullptr, V8, 256, NT3, a0, a1, DM, (char*)lds, q, true, b0, b1, DM, K8, nullptr, V8);
          af8::attn_unit2<0>(K8, 128, nullptr, V8, 256, NT3, b0, b1, DM, (char*)lds, q, c < 2, c0, c1, DM, K8, nullptr, V8);
          if (c < 2) af8::attn_unit2<0>(K8, 128, nullptr, V8, 256, CTXL / 64, c0, c1, DM, (char*)lds, q, false, c0, c1, DM, K8, nullptr, V8); }
#else
        const size_t qc0 = ((size_t)ML + b * CTXL) * DM + (kvh * 4 + c) * 64;
        af8::v6u qf, qrf;
        af8::attn_prefetch<0>(Qb + ((size_t)b * SEQ + c * 256) * DM + kvh * 4 * 64, DM, nullptr, nullptr, K8, 128, nullptr, V8, 256, (char*)lds, qf, qrf);
        for (int i = 0; i < 4; ++i) { const int h = kvh * 4 + i; const size_t q0 = ((size_t)b * SEQ + c * 256) * DM + h * 64; const bool nx = i < 3 || c < 4; const size_t q0n = i < 3 ? q0 + 64 : qc0;
#ifdef MK_PRB
            if (rep_ + 1 < REPS(3)) af8::attn_unit<0, MK_PRB>(K8, 128, nullptr, V8, 256, NT3, O0 + q0, Gb + q0, DM, (char*)lds, qf, qrf, nx, Qb + q0n, DM, nullptr, nullptr, K8, nullptr, V8 UPROBE_ARG3); else
#endif
            af8::attn_unit<0>(K8, 128, nullptr, V8, 256, NT3, O0 + q0, Gb + q0, DM, (char*)lds, qf, qrf, nx, Qb + q0n, DM, nullptr, nullptr, K8, nullptr, V8 UPROBE_ARG3); }
        if (c < 4) af8::attn_unit<0>(K8, 128, nullptr, V8, 256, CTXL / 64, O0 + qc0, Gb + qc0, DM, (char*)lds, qf, qrf, false, nullptr, DM, nullptr, nullptr, K8, nullptr, V8 UPROBE_ARGC);
#endif
#else
        for (int i = 0; i < 4; ++i) { const int h = kvh * 4 + i; const size_t q0 = ((size_t)b * SEQ + c * 256) * DM + h * 64;
            afast::attn_unit<0>(Qb + q0, DM, nullptr, nullptr, K0 + kbase, 256, nullptr, V0 + kbase, 256, TK / 64, O0 + q0, Gb + q0, DM, (char*)lds); }
        if (c < 4) { const int h = kvh * 4 + c; const size_t q0 = ((size_t)ML + b * CTXL) * DM + h * 64;
            afast::attn_unit<0>(Qb + q0, DM, nullptr, nullptr, K0 + kbase, 256, nullptr, V0 + kbase, 256, CTXL / 64, O0 + q0, Gb + q0, DM, (char*)lds); }
#endif
    } SEAM(3);
#ifdef MK_CLOCK_PROBE
    if (IN(3)) { pc1 = __builtin_readcyclecounter(); pr1 = __builtin_amdgcn_s_memrealtime(); }
#endif
    if (IN(4)) {
        { pg8::Gemm g{O0, (const bf16_t*)(ws + WS_WOUT0), ML, 1024, 1024, 0}; pg8::ROrder S; S.init(0, ML / 256, 1024, G, bx, REPS(4));
          pg8::EpiOutF E{x, out, mod + 2048, NWM1, H, SSX};
          pg8::gemm_phase<pg8::EpiOutF, pg8::ROrder, true, true>(ring, g, S, E); }
        { pg8::Gemm g{O0, (const bf16_t*)(ws + WS_WOUT0), MT, 1024, 1024, 128}; pg8::CtxSplitOrder S; S.init(bx, 8, 128);
          pg8::EpiOutSlab E{(float*)(ws + WS_SLAB), 128};
          pg8::gemm_phase<pg8::EpiOutSlab, pg8::CtxSplitOrder, true, true>(ring, g, S, E); }
    } SEAM(4);
    if (IN(5)) { phase_ctxprep(ctx, (const float*)(ws + WS_SLAB), mod + 2048 + 2 * 3072, X1c, NWM1, H, SSX, (float*)(ws + WS_RINV), vcu * NWAVES + wave, G * NWAVES, lane); } SEAM(5);
    if (IN(6)) { pg8::Gemm g{H, (const bf16_t*)(ws + WS_WIN1), MT, N_IN1P, 1024}; pg8::In1Order S; S.init(G, bx, REPS(6));
        pg8::EpiIn1<ATT1_F8> E{a.in[21], tabB, KVA, SSKV, QA, SSQ, KR, Gb, (const float*)(ws + WS_RINV), BIAS1};
        pg8::gemm_phase<pg8::EpiIn1<ATT1_F8>, pg8::In1Order, true, true>(ring, g, S, E); } SEAM(6);
    if (IN(7)) {
        { pg8::Gemm g{KVA, (const bf16_t*)(ws + WS_WKVB), MT, 2048, 256}; pg8::ROrder S; S.init(0, MT / 256, 2048, G, bx, REPS(7));
          pg8::EpiKvb<ATT1_F8> E{SSKV, a.in[20], K1, V1};
          pg8::gemm_phase<pg8::EpiKvb<ATT1_F8>, pg8::ROrder, true, true>(ring, g, S, E); }
        { pg8::Gemm g{QA, (const bf16_t*)(ws + WS_WQB), ML, 2048, 384}; pg8::ROrder S; S.init(0, ML / 256, 2048, G, bx, REPS(10));
          pg8::EpiQb E{SSQ, a.in[19], tabB, Qb, Q1R, SSH};
          pg8::gemm_phase<pg8::EpiQb, pg8::ROrder, true, true>(ring, g, S, E); }
    } SEAM(7);
    if (IN(8)) for (int rep_ = 0; rep_ < REPS(8); ++rep_) {
        const int xg = vcu >> 5, c = vcu & 31;
#if ATT_X2
        { const int chunk = c & 15, g2 = c >> 4;
          auto half = [&](int s, size_t row0) { const int h = s & 15; return af8::Half{Qb + row0 * DM + h * 64, Q1R + row0 * 512 + h * 32, SSH + (row0 * 16 + h) * 2, O1 + row0 * DM + h * 64, Gb + row0 * DM + h * 64}; };
          const int sa = xg + 8 * g2, sb = xg + 8 * (2 + g2); const size_t ra = (size_t)(sa >> 4) * SEQ + chunk * 512, rb = (size_t)(sb >> 4) * SEQ + chunk * 512;
          const af8::Half a0 = half(sa, ra), a1 = half(sa, ra + 256), b0 = half(sb, rb), b1 = half(sb, rb + 256);
          const unsigned char* Ka = (const unsigned char*)K1 + (size_t)(sa >> 4) * TK * 512 + (sa & 15) * 32; const unsigned char* Kra = (const unsigned char*)KR + (size_t)(sa >> 4) * TK * 16; const unsigned char* Va = (const unsigned char*)V1 + (size_t)(sa >> 4) * TK * DM + (sa & 15) * 64;
          const unsigned char* Kb = (const unsigned char*)K1 + (size_t)(sb >> 4) * TK * 512 + (sb & 15) * 32; const unsigned char* Krb = (const unsigned char*)KR + (size_t)(sb >> 4) * TK * 16; const unsigned char* Vb = (const unsigned char*)V1 + (size_t)(sb >> 4) * TK * DM + (sb & 15) * 64;
          af8::QF2 q;
          af8::attn_prefetch2<1>(a0, a1, DM, Ka, 512, Kra, Va, DM, (char*)lds, q);
          af8::attn_unit2<1>(Ka, 512, Kra, Va, DM, TK / 64, a0, a1, DM, (char*)lds, q, true, b0, b1, DM, Kb, Krb, Vb);
          af8::attn_unit2<1>(Kb, 512, Krb, Vb, DM, TK / 64, b0, b1, DM, (char*)lds, q, false, b0, b1, DM, Kb, Krb, Vb); }
#else
#if ATT1_F8
        af8::v6u qf, qrf;
        { const int s0 = xg, b = s0 >> 4, h = s0 & 15; const size_t row0 = (size_t)b * SEQ + c * 256;
          af8::attn_prefetch<1>(Qb + row0 * DM + h * 64, DM, Q1R + row0 * 512 + h * 32, SSH + (row0 * 16 + h) * 2, (const unsigned char*)K1 + (size_t)b * TK * 512 + h * 32, 512, (const unsigned char*)KR + (size_t)b * TK * 16,
                                (const unsigned char*)V1 + (size_t)b * TK * DM + h * 64, DM, (char*)lds, qf, qrf); }
#endif
        for (int i = 0; i < 4; ++i) { const int s = xg + 8 * i, b = s >> 4, h = s & 15; const size_t row0 = (size_t)b * SEQ + c * 256, q0 = row0 * DM + h * 64;
#if ATT1_F8
            const int sn = xg + 8 * (i < 3 ? i + 1 : i), bn = sn >> 4, hn = sn & 15; const size_t row0n = (size_t)bn * SEQ + c * 256;
            af8::attn_unit<1>((const unsigned char*)K1 + (size_t)b * TK * 512 + h * 32, 512, (const unsigned char*)KR + (size_t)b * TK * 16, (const unsigned char*)V1 + (size_t)b * TK * DM + h * 64, DM, TK / 64, O1 + q0, Gb + q0, DM, (char*)lds, qf, qrf,
                              i < 3, Qb + row0n * DM + hn * 64, DM, Q1R + row0n * 512 + hn * 32, SSH + (row0n * 16 + hn) * 2, (const unsigned char*)K1 + (size_t)bn * TK * 512 + hn * 32, (const unsigned char*)KR + (size_t)bn * TK * 16,
                              (const unsigned char*)V1 + (size_t)bn * TK * DM + hn * 64 UPROBE_ARG8); }
#else
            afast::attn_unit<1>(Qb + q0, DM, Q1R + row0 * 512 + h * 32, SSH + (row0 * 16 + h) * 2, K1 + (size_t)b * TK * DM + h * 64, DM, KR + (size_t)b * TK * 32,
                                V1 + (size_t)b * TK * DM + h * 64, DM, TK / 64, O1 + q0, Gb + q0, DM, (char*)lds); }
#endif
#endif
    } SEAM(8);
    if (IN(9)) { pg8::Gemm g{O1, (const bf16_t*)(ws + WS_WOUT1), ML, 1024, 1024}; pg8::ROrder S; S.init(0, ML / 256, 1024, G, bx, REPS(9));
        pg8::EpiOut E{out, nullptr, out, nullptr, mod + 3 * 3072 + 2048};
        pg8::gemm_phase<pg8::EpiOut, pg8::ROrder, true, true>(ring, g, S, E); }
#ifdef MK_TS_SEAM
    if (bx == 0 && wave == 0) { const unsigned long long tend_ = __builtin_amdgcn_s_memrealtime(); const unsigned long long w = MK_TS == 99 ? (tend_ - ts0) : MK_TS >= 100 ? (MK_TS >= 200 ? (unsigned long long)(((unsigned*)ws)[4001] & 1023u) * 100ull : (unsigned long long)((unsigned*)ws)[4000]) : (MK_TS_WHAT ? (ts2 - ts1) * 10ull : (ts1 - ts0)); const unsigned long long t0 = __builtin_amdgcn_s_memrealtime(); while (__builtin_amdgcn_s_memrealtime() - t0 < w) __builtin_amdgcn_s_sleep(8); }
#endif
#ifdef MK_UBENCH
    ubench(wave);
#endif
#ifdef MK_UNIT_PROBE
    if (bx == 0 && wave == 0) { const unsigned long long t0 = __builtin_amdgcn_s_memrealtime(); const unsigned long long w = upacc * 10ull; (void)updummy; while (__builtin_amdgcn_s_memrealtime() - t0 < w) __builtin_amdgcn_s_sleep(8); }
#endif
#ifdef MK_CLOCK_PROBE
    if (bx == 0 && wave == 0) { const unsigned long long dc = pc1 - pc0, dr = pr1 - pr0;
        const unsigned long long mhz = dr ? (dc * 100ull) / dr : 0ull;
        const unsigned long long t0 = __builtin_amdgcn_s_memrealtime(); const unsigned long long wait_ticks = mhz * 10ull;
        while (__builtin_amdgcn_s_memrealtime() - t0 < wait_ticks) __builtin_amdgcn_s_sleep(8); }
#endif
#undef IN
#undef SEAM
}

constexpr int NPHASE = 10;
#ifndef MK_ONE_LAUNCH
#define MK_ONE_LAUNCH 1
#endif
extern "C" void kernel_launch(void* const* d_in, const int* in_sizes, int n_in, void* d_out, int out_size, void* d_ws, size_t ws_size, hipStream_t stream) {
    static int grid = 0;
    if (grid == 0) {
        if (n_in != 23 || out_size != ML * DM || ws_size < WS_END) { fprintf(stderr, "kernel_launch: unexpected shapes n_in %d out %d ws %zu\n", n_in, out_size, ws_size); grid = -1; return; }
        int dev = 0, cus = 0, per_cu = 0;
        if (hipGetDevice(&dev) != hipSuccess || hipDeviceGetAttribute(&cus, hipDeviceAttributeMultiprocessorCount, dev) != hipSuccess) { grid = -1; return; }
        if (hipFuncSetAttribute((const void*)mega, hipFuncAttributeMaxDynamicSharedMemorySize, LDS_BYTES) != hipSuccess) { fprintf(stderr, "kernel_launch: hipFuncSetAttribute failed\n"); grid = -1; return; }
        if (hipOccupancyMaxActiveBlocksPerMultiprocessor(&per_cu, (const void*)mega, NTHREADS, LDS_BYTES) != hipSuccess || per_cu < 1) { fprintf(stderr, "kernel_launch: occupancy query says %d\n", per_cu); grid = -1; return; }
        grid = cus;
        if (grid != 256) fprintf(stderr, "kernel_launch: %d CUs (built for 256)\n", grid);
    }
    if (grid < 0) return;
    if (hipMemsetAsync(d_ws, 0, 16384, stream) != hipSuccess) { fprintf(stderr, "kernel_launch: memset failed\n"); return; }
    Args a{};
    for (int i = 0; i < 23; ++i) a.in[i] = (const float*)d_in[i];
    a.out = (float*)d_out; a.ws = (unsigned char*)d_ws;
#if MK_ONE_LAUNCH
    a.ph_lo = 0; a.ph_hi = NPHASE; a.coop = 1;
    void* args[] = {&a};
#ifdef MK_PLAIN_LAUNCH
    (void)args; hipLaunchKernelGGL(mega, dim3(grid), dim3(NTHREADS), LDS_BYTES, stream, a);
#else
    const hipError_t e = hipLaunchCooperativeKernel((const void*)mega, dim3(grid), dim3(NTHREADS), args, LDS_BYTES, stream);
    if (e != hipSuccess) fprintf(stderr, "kernel_launch: cooperative launch failed: %s (grid %d)\n", hipGetErrorString(e), grid);
#endif
#else
    for (int p = 0; p < NPHASE; ++p) { a.ph_lo = p; a.ph_hi = p + 1; a.coop = 0; hipLaunchKernelGGL(mega, dim3(grid), dim3(NTHREADS), LDS_BYTES, stream, a); }
    const hipError_t le = hipPeekAtLastError();
    if (le != hipSuccess) fprintf(stderr, "kernel_launch: launch failed: %s\n", hipGetErrorName(le));
#endif
}
```
